# Optimizing an MI355X kernel written in HIP

```python
import math
import jax
import jax.numpy as jnp
from jax import lax
import numpy as np

D_MODEL = 1024
BATCH = 2
SEQ = 8192
DEPTH = 2

GRID_W = 64
CTX_LEN = 256
HEAD_DIM = 64
ROPE_THETA = 10000.0
NORM_EPS = 1e-6
NEG_INF = -1e30

SWA_HEADS = 8
SWA_KV_HEADS = 2
WINDOW = 128
BLOCK = 128

RWKV_HEADS = 8
RWKV_WIDTH = RWKV_HEADS * HEAD_DIM
DECAY_LORA = 64
AAA_LORA = 64
GATE_LORA = 128
RWKV_GN_EPS = 64e-5

DIFF_HEADS = 4
DIFF_V_DIM = 2 * HEAD_DIM
DIFF_SUBLN_EPS = 1e-5

N_BRANCHES = 3

D_FF = 2816
N_EXPERTS = 8
TOP_K = 2
D_FF_EXPERT = 3584
MOE_BLOCK = 128
N_DENSE = (DEPTH + 1) // 2
N_MOE = DEPTH // 2

SWA_Q = SWA_HEADS * HEAD_DIM
SWA_KV = SWA_KV_HEADS * HEAD_DIM
RWKV_SPLITS = (RWKV_WIDTH, RWKV_WIDTH, RWKV_WIDTH, DECAY_LORA, DECAY_LORA, AAA_LORA, AAA_LORA, GATE_LORA)
RWKV_COLS = 3 * RWKV_WIDTH + 2 * DECAY_LORA + 2 * AAA_LORA + GATE_LORA
DIFF_QK = DIFF_HEADS * 2 * HEAD_DIM
DIFF_V = DIFF_HEADS * DIFF_V_DIM
IN_SPLITS = (SWA_Q, SWA_KV, SWA_KV, RWKV_COLS, DIFF_QK, DIFF_QK, DIFF_V, N_BRANCHES * D_MODEL)
D_IN = SWA_Q + 2 * SWA_KV + RWKV_COLS + 2 * DIFF_QK + DIFF_V + N_BRANCHES * D_MODEL

kernel_name = 'hybrid_diffusion_trunk_swa_rwkv7_diffattn_moe'


def rmsnorm(x, g, eps=NORM_EPS):
    xf = x.astype(jnp.float32)
    y = xf * lax.rsqrt(jnp.mean(xf * xf, axis=-1, keepdims=True) + eps)
    return (y * g.astype(jnp.float32)).astype(x.dtype)


def modulate(h, shift, scale):
    return h * (1 + scale) + shift


def _split(t, sizes):
    out, start = [], 0
    for n in sizes:
        out.append(t[..., start:start + n])
        start += n
    return out


def axial_rope_tables(n_tokens):
    rows = n_tokens // GRID_W
    row = jnp.broadcast_to(jnp.arange(rows, dtype=jnp.float32)[:, None], (rows, GRID_W)).reshape(-1)
    col = jnp.broadcast_to(jnp.arange(GRID_W, dtype=jnp.float32)[None, :], (rows, GRID_W)).reshape(-1)
    axis_dim = HEAD_DIM // 2
    inv_freq = ROPE_THETA ** (-jnp.arange(0, axis_dim, 2, dtype=jnp.float32) / axis_dim)
    ang = jnp.stack([row[:, None] * inv_freq, col[:, None] * inv_freq], axis=1)
    return jnp.cos(ang), jnp.sin(ang)


def apply_rope(x, cos, sin):
    shp = x.shape
    xr = x.reshape(shp[:-1] + (2, 2, HEAD_DIM // 4))
    bshape = (shp[1],) + (1,) * (x.ndim - 3) + (2, HEAD_DIM // 4)
    cs = cos.reshape(bshape).astype(x.dtype)
    sn = sin.reshape(bshape).astype(x.dtype)
    x1, x2 = xr[..., 0, :], xr[..., 1, :]
    out = jnp.stack([x1 * cs - x2 * sn, x1 * sn + x2 * cs], axis=-2)
    return out.reshape(shp)


def swa_attention(q_l, k_l, v_l, q_c, k_c, v_c, sink, need_ctx):
    B, S = q_l.shape[:2]
    L = k_c.shape[1]
    nb = S // BLOCK
    G = SWA_HEADS // SWA_KV_HEADS
    scale = HEAD_DIM ** -0.5
    sink_f = sink.astype(jnp.float32).reshape(SWA_KV_HEADS, G)
    qb = q_l.reshape(B, nb, BLOCK, SWA_KV_HEADS, G, HEAD_DIM)

    def windows(t):
        tp = jnp.pad(t, ((0, 0), (BLOCK, BLOCK), (0, 0), (0, 0)))
        tb = tp.reshape(B, nb + 2, BLOCK, SWA_KV_HEADS, HEAD_DIM)
        return jnp.concatenate([tb[:, :-2], tb[:, 1:-1], tb[:, 2:]], axis=2)

    kw, vw = windows(k_l), windows(v_l)
    qpos = (jnp.arange(nb)[:, None] * BLOCK + jnp.arange(BLOCK)[None, :])[:, :, None]
    kpos = ((jnp.arange(nb)[:, None] - 1) * BLOCK + jnp.arange(3 * BLOCK)[None, :])[:, None, :]
    valid = (jnp.abs(kpos - qpos) <= WINDOW) & (kpos >= 0) & (kpos < S)
    s_loc = jnp.einsum('bnqhgd,bnkhd->bnhgqk', qb, kw, preferred_element_type=jnp.float32) * scale
    s_loc = jnp.where(valid[None, :, None, None], s_loc, NEG_INF)
    s_ctx = jnp.einsum('bnqhgd,blhd->bnhgql', qb, k_c, preferred_element_type=jnp.float32) * scale
    s_sink = jnp.broadcast_to(sink_f[None, None, :, :, None, None], s_loc.shape[:-1] + (1,))
    p = jax.nn.softmax(jnp.concatenate([s_loc, s_ctx, s_sink], axis=-1), axis=-1)
    nw = 3 * BLOCK
    o = (jnp.einsum('bnhgqk,bnkhd->bnqhgd', p[..., :nw].astype(v_l.dtype), vw)
         + jnp.einsum('bnhgql,blhd->bnqhgd', p[..., nw:nw + L].astype(v_l.dtype), v_c))
    o_lat = o.reshape(B, S, SWA_Q)
    if not need_ctx:
        return o_lat, None
    qcg = q_c.reshape(B, L, SWA_KV_HEADS, G, HEAD_DIM)
    sc = jnp.einsum('blhgd,bmhd->bhglm', qcg, k_c, preferred_element_type=jnp.float32) * scale
    sc_sink = jnp.broadcast_to(sink_f[None, :, :, None, None], sc.shape[:-1] + (1,))
    pc = jax.nn.softmax(jnp.concatenate([sc, sc_sink], axis=-1), axis=-1)
    oc = jnp.einsum('bhglm,bmhd->blhgd', pc[..., :L].astype(v_c.dtype), v_c)
    return o_lat, oc.reshape(B, L, SWA_Q)


def token_shift(p, mu_prev, mu_next):
    prev = jnp.pad(p[:, :-1], ((0, 0), (1, 0), (0, 0)))
    nxt = jnp.pad(p[:, 1:], ((0, 0), (0, 1), (0, 0)))
    return p + mu_prev * (prev - p) + mu_next * (nxt - p)


def rwkv_scan(s0, r, w, k, v, a_vec, b_vec, reverse, emit):
    xs = tuple(jnp.moveaxis(t, 1, 0) for t in (r, w, k, v, a_vec, b_vec))

    def step(s, inp):
        r_t, w_t, k_t, v_t, a_t, b_t = inp
        sa = jnp.einsum('bhvk,bhk->bhv', s, a_t)
        s = s * w_t[:, :, None, :] + sa[..., None] * b_t[:, :, None, :] + v_t[..., None] * k_t[:, :, None, :]
        y = jnp.einsum('bhvk,bhk->bhv', s, r_t) if emit else None
        return s, y

    s_fin, ys = lax.scan(step, s0, xs, reverse=reverse)
    return s_fin, (jnp.moveaxis(ys, 0, 1) if emit else None)


def _rwkv_prepare(p, lp):
    B, T = p.shape[:2]
    f32 = jnp.float32
    p = token_shift(p, lp['rwkv_mu_prev'], lp['rwkv_mu_next'])
    r, k, v, wd_f, wd_b, ad_f, ad_b, gd = _split(p, RWKV_SPLITS)
    hd = lambda t: t.astype(f32).reshape(B, T, RWKV_HEADS, HEAD_DIM)
    g = jax.nn.sigmoid(gd) @ lp['rwkv_g_up']
    k_h = hd(k)
    kk = k_h * lp['rwkv_k_k'].astype(f32).reshape(RWKV_HEADS, HEAD_DIM)
    kk = kk / jnp.maximum(jnp.sqrt(jnp.sum(kk * kk, axis=-1, keepdims=True)), 1e-12)
    k_a = lp['rwkv_k_a'].astype(f32).reshape(RWKV_HEADS, HEAD_DIM)
    dirs = []
    for d, (wd, ad) in enumerate(((wd_f, ad_f), (wd_b, ad_b))):
        w_raw = (lp['rwkv_w0'][d] + jnp.tanh(wd) @ lp['rwkv_w_up'][d]).astype(f32)
        w_log = -jax.nn.softplus(-w_raw) - 0.5
        decay = hd(jnp.exp(-jnp.exp(w_log)))
        a = hd(jax.nn.sigmoid((lp['rwkv_a0'][d] + ad @ lp['rwkv_a_up'][d]).astype(f32)))
        k_eff = k_h * (1 + (a - 1) * k_a)
        dirs.append((decay, k_eff, a))
    return hd(r), hd(v), kk, g, dirs


def _rwkv_output(ys, r, v, k_effs, g, lp, dtype):
    B, T = r.shape[:2]
    f32 = jnp.float32
    y = ys[0] + ys[1]
    mu = jnp.mean(y, axis=-1, keepdims=True)
    var = jnp.mean(jnp.square(y - mu), axis=-1, keepdims=True)
    y = ((y - mu) * lax.rsqrt(var + RWKV_GN_EPS)).reshape(B, T, RWKV_WIDTH)
    y = y * lp['rwkv_lnx_g'].astype(f32) + lp['rwkv_lnx_b'].astype(f32)
    r_k = lp['rwkv_r_k'].astype(f32)
    bonus = jnp.sum(r * (k_effs[0] + k_effs[1]) * r_k, axis=-1, keepdims=True) * v
    y = y + bonus.reshape(B, T, RWKV_WIDTH)
    return (y * g.astype(f32)).astype(dtype)


def rwkv7_bidirectional(p_lat, p_ctx, lp, need_ctx):
    B = p_lat.shape[0]
    r_l, v_l, kk_l, g_l, dirs_l = _rwkv_prepare(p_lat, lp)
    r_c, v_c, kk_c, g_c, dirs_c = _rwkv_prepare(p_ctx, lp)
    s0 = jnp.zeros((B, RWKV_HEADS, HEAD_DIM, HEAD_DIM), jnp.float32)
    y_lat, y_ctx = [], []
    for d, reverse in enumerate((False, True)):
        w_c, k_c, a_c = dirs_c[d]
        s_ctx, y_c = rwkv_scan(s0, r_c, w_c, k_c, v_c, -kk_c, kk_c * a_c, reverse, need_ctx)
        w_l, k_l, a_l = dirs_l[d]
        _, y_l = rwkv_scan(s_ctx, r_l, w_l, k_l, v_l, -kk_l, kk_l * a_l, reverse, True)
        y_lat.append(y_l)
        y_ctx.append(y_c)
    out_l = _rwkv_output(y_lat, r_l, v_l, [dd[1] for dd in dirs_l], g_l, lp, p_lat.dtype)
    if not need_ctx:
        return out_l, None
    out_c = _rwkv_output(y_ctx, r_c, v_c, [dd[1] for dd in dirs_c], g_c, lp, p_ctx.dtype)
    return out_l, out_c


def diff_attention(q_l, k_l, v_l, q_c, k_c, v_c, lam, subln_g, lam_init, need_ctx):
    B, S = q_l.shape[:2]
    nb = S // BLOCK
    scale = HEAD_DIM ** -0.5
    k_all = jnp.concatenate([k_l, k_c], axis=1)
    v_all = jnp.concatenate([v_l, v_c], axis=1)

    def attend(q, k, v):
        s = jnp.einsum('bqhcd,bkhcd->bhcqk', q, k, preferred_element_type=jnp.float32) * scale
        p = jax.nn.softmax(s, axis=-1)
        a = p[:, :, 0] - lam * p[:, :, 1]
        return jnp.einsum('bhqk,bkhe->bqhe', a.astype(v.dtype), v)

    def finish(o):
        return (rmsnorm(o, subln_g, DIFF_SUBLN_EPS) * (1.0 - lam_init)).reshape(o.shape[0], o.shape[1], DIFF_V)

    q_blocks = jnp.moveaxis(q_l.reshape(B, nb, BLOCK, DIFF_HEADS, 2, HEAD_DIM), 1, 0)
    o = lax.map(lambda qb: attend(qb, k_all, v_all), q_blocks)
    o_lat = finish(jnp.moveaxis(o, 0, 1).reshape(B, S, DIFF_HEADS, DIFF_V_DIM))
    if not need_ctx:
        return o_lat, None
    return o_lat, finish(attend(q_c, k_c, v_c))


def token_mixer(h_l, h_c, lp, layer, need_ctx, cos, sin):
    pl = _split(h_l @ lp['w_in'], IN_SPLITS)
    pc = _split(h_c @ lp['w_in'], IN_SPLITS)
    heads = lambda t, n: t.reshape(t.shape[0], t.shape[1], n, HEAD_DIM)
    pair = lambda t: t.reshape(t.shape[0], t.shape[1], DIFF_HEADS, 2, HEAD_DIM)
    vh = lambda t: t.reshape(t.shape[0], t.shape[1], DIFF_HEADS, DIFF_V_DIM)
    ya_l, ya_c = swa_attention(
        apply_rope(heads(pl[0], SWA_HEADS), cos, sin), apply_rope(heads(pl[1], SWA_KV_HEADS), cos, sin),
        heads(pl[2], SWA_KV_HEADS), heads(pc[0], SWA_HEADS), heads(pc[1], SWA_KV_HEADS),
        heads(pc[2], SWA_KV_HEADS), lp['swa_sink'], need_ctx)
    yb_l, yb_c = rwkv7_bidirectional(pl[3], pc[3], lp, need_ctx)
    lam_vec = lp['diff_lambda'].astype(jnp.float32)
    lam_init = 0.8 - 0.6 * math.exp(-0.3 * layer)
    lam = jnp.exp(jnp.sum(lam_vec[0] * lam_vec[1])) - jnp.exp(jnp.sum(lam_vec[2] * lam_vec[3])) + lam_init
    yc_l, yc_c = diff_attention(
        apply_rope(pair(pl[4]), cos, sin), apply_rope(pair(pl[5]), cos, sin), vh(pl[6]),
        pair(pc[4]), pair(pc[5]), vh(pc[6]), lam, lp['diff_subln_g'], lam_init, need_ctx)

    def merge(ya, yb, yc, gate_cols):
        gates = jax.nn.sigmoid(gate_cols.astype(jnp.float32)).astype(ya.dtype)
        g_a, g_b, g_c = _split(gates, (D_MODEL, D_MODEL, D_MODEL))
        merged = g_a * (ya @ lp['proj_swa']) + g_b * (yb @ lp['proj_rwkv']) + g_c * (yc @ lp['proj_diff'])
        return merged @ lp['w_out']

    out_l = merge(ya_l, yb_l, yc_l, pl[7])
    out_c = merge(ya_c, yb_c, yc_c, pc[7]) if need_ctx else None
    return out_l, out_c


def swiglu(h, w_gate, w_up, w_down):
    return (jax.nn.silu(h @ w_gate) * (h @ w_up)) @ w_down


def moe_swiglu(h, router_w, w_gate, w_up, w_down):
    N, D = h.shape
    logits = (h @ router_w).astype(jnp.float32)
    top_v, top_i = lax.top_k(logits, TOP_K)
    top_w = jax.nn.softmax(top_v, axis=-1)
    A = N * TOP_K
    e_flat = top_i.reshape(A)
    t_flat = jnp.repeat(jnp.arange(N, dtype=jnp.int32), TOP_K)
    w_flat = top_w.reshape(A)
    order = jnp.argsort(e_flat)
    e_sorted, t_sorted, w_sorted = e_flat[order], t_flat[order], w_flat[order]
    counts = jnp.zeros((N_EXPERTS,), jnp.int32).at[e_flat].add(1)
    starts = jnp.cumsum(counts) - counts
    padded = (counts + MOE_BLOCK - 1) // MOE_BLOCK * MOE_BLOCK
    pends = jnp.cumsum(padded)
    pstarts = pends - padded
    dest = pstarts[e_sorted] + jnp.arange(A, dtype=jnp.int32) - starts[e_sorted]
    n_blocks = -(-A // MOE_BLOCK) + N_EXPERTS
    P = n_blocks * MOE_BLOCK
    tok = jnp.zeros((P,), jnp.int32).at[dest].set(t_sorted)
    wts = jnp.zeros((P,), jnp.float32).at[dest].set(w_sorted)
    block_start = jnp.arange(n_blocks, dtype=jnp.int32) * MOE_BLOCK
    blk_e = jnp.minimum(jnp.searchsorted(pends, block_start, side='right'), N_EXPERTS - 1)

    def run(args):
        tb, wb, e = args
        xb = h[tb]
        hid = jax.nn.silu(xb @ w_gate[e]) * (xb @ w_up[e])
        return (hid @ w_down[e]) * wb[:, None].astype(h.dtype)

    yb = lax.map(run, (tok.reshape(n_blocks, MOE_BLOCK), wts.reshape(n_blocks, MOE_BLOCK), blk_e))
    return jnp.zeros_like(h).at[tok].add(yb.reshape(P, D))


def setup_inputs(seed: int = 0) -> dict:
    key = jax.random.key(seed)
    ks = iter(jax.random.split(key, 40))
    f32 = jnp.float32
    Dm = D_MODEL

    def nrm(shape, scale):
        return jax.random.normal(next(ks), shape, f32) * scale

    def gain(shape):
        return 1.0 + 0.02 * jax.random.normal(next(ks), shape, f32)

    def unif(shape, lo, hi):
        return jax.random.uniform(next(ks), shape, f32, lo, hi)

    return {
        'x': nrm((BATCH, SEQ, Dm), 1.0),
        'c': nrm((BATCH, Dm), 1.0),
        'ctx': nrm((BATCH, CTX_LEN, Dm), 1.0),
        'c_ctx': nrm((Dm,), 1.0),
        'ada_w': nrm((DEPTH, Dm, 6 * Dm), 0.5 * Dm ** -0.5),
        'ada_b': nrm((DEPTH, 6 * Dm), 0.02),
        'pre_mix_g': gain((DEPTH, Dm)),
        'post_mix_g': gain((DEPTH, Dm)),
        'pre_ffn_g': gain((DEPTH, Dm)),
        'post_ffn_g': gain((DEPTH, Dm)),
        'w_in': nrm((DEPTH, Dm, D_IN), Dm ** -0.5),
        'swa_sink': nrm((DEPTH, SWA_HEADS), 0.5),
        'rwkv_mu_prev': unif((DEPTH, RWKV_COLS), 0.0, 0.5),
        'rwkv_mu_next': unif((DEPTH, RWKV_COLS), 0.0, 0.5),
        'rwkv_w0': unif((DEPTH, 2, RWKV_WIDTH), -6.0, 1.0),
        'rwkv_w_up': nrm((DEPTH, 2, DECAY_LORA, RWKV_WIDTH), 0.1 * DECAY_LORA ** -0.5),
        'rwkv_a0': nrm((DEPTH, 2, RWKV_WIDTH), 0.1),
        'rwkv_a_up': nrm((DEPTH, 2, AAA_LORA, RWKV_WIDTH), 0.1 * AAA_LORA ** -0.5),
        'rwkv_g_up': nrm((DEPTH, GATE_LORA, RWKV_WIDTH), GATE_LORA ** -0.5),
        'rwkv_k_k': 0.85 + nrm((DEPTH, RWKV_WIDTH), 0.05),
        'rwkv_k_a': 1.0 + nrm((DEPTH, RWKV_WIDTH), 0.05),
        'rwkv_r_k': nrm((DEPTH, RWKV_HEADS, HEAD_DIM), 0.1),
        'rwkv_lnx_g': gain((DEPTH, RWKV_WIDTH)),
        'rwkv_lnx_b': nrm((DEPTH, RWKV_WIDTH), 0.02),
        'diff_lambda': nrm((DEPTH, 4, HEAD_DIM), 0.1),
        'diff_subln_g': gain((DEPTH, DIFF_V_DIM)),
        'proj_swa': nrm((DEPTH, SWA_Q, Dm), SWA_Q ** -0.5),
        'proj_rwkv': nrm((DEPTH, RWKV_WIDTH, Dm), RWKV_WIDTH ** -0.5),
        'proj_diff': nrm((DEPTH, DIFF_V, Dm), DIFF_V ** -0.5),
        'w_out': nrm((DEPTH, Dm, Dm), Dm ** -0.5),
        'ffn_w_gate': nrm((N_DENSE, Dm, D_FF), Dm ** -0.5),
        'ffn_w_up': nrm((N_DENSE, Dm, D_FF), Dm ** -0.5),
        'ffn_w_down': nrm((N_DENSE, D_FF, Dm), D_FF ** -0.5),
        'router_w': nrm((N_MOE, Dm, N_EXPERTS), Dm ** -0.5),
        'moe_w_gate': nrm((N_MOE, N_EXPERTS, Dm, D_FF_EXPERT), Dm ** -0.5),
        'moe_w_up': nrm((N_MOE, N_EXPERTS, Dm, D_FF_EXPERT), Dm ** -0.5),
        'moe_w_down': nrm((N_MOE, N_EXPERTS, D_FF_EXPERT, Dm), D_FF_EXPERT ** -0.5),
    }


def reference(x, c, ctx, c_ctx, ada_w, ada_b, pre_mix_g, post_mix_g, pre_ffn_g, post_ffn_g,
              w_in, swa_sink, rwkv_mu_prev, rwkv_mu_next, rwkv_w0, rwkv_w_up, rwkv_a0, rwkv_a_up,
              rwkv_g_up, rwkv_k_k, rwkv_k_a, rwkv_r_k, rwkv_lnx_g, rwkv_lnx_b, diff_lambda,
              diff_subln_g, proj_swa, proj_rwkv, proj_diff, w_out, ffn_w_gate, ffn_w_up,
              ffn_w_down, router_w, moe_w_gate, moe_w_up, moe_w_down):
    B, S, D = x.shape
    L = ctx.shape[1]
    cos, sin = axial_rope_tables(S)
    h_lat, h_ctx = x, ctx
    for layer in range(DEPTH):
        need_ctx = layer < DEPTH - 1
        lp = {
            'w_in': w_in[layer], 'swa_sink': swa_sink[layer],
            'rwkv_mu_prev': rwkv_mu_prev[layer], 'rwkv_mu_next': rwkv_mu_next[layer],
            'rwkv_w0': rwkv_w0[layer], 'rwkv_w_up': rwkv_w_up[layer],
            'rwkv_a0': rwkv_a0[layer], 'rwkv_a_up': rwkv_a_up[layer], 'rwkv_g_up': rwkv_g_up[layer],
            'rwkv_k_k': rwkv_k_k[layer], 'rwkv_k_a': rwkv_k_a[layer], 'rwkv_r_k': rwkv_r_k[layer],
            'rwkv_lnx_g': rwkv_lnx_g[layer], 'rwkv_lnx_b': rwkv_lnx_b[layer],
            'diff_lambda': diff_lambda[layer], 'diff_subln_g': diff_subln_g[layer],
            'proj_swa': proj_swa[layer], 'proj_rwkv': proj_rwkv[layer], 'proj_diff': proj_diff[layer],
            'w_out': w_out[layer],
        }
        mod_l = jnp.split((jax.nn.silu(c) @ ada_w[layer] + ada_b[layer])[:, None, :], 6, axis=-1)
        mod_c = jnp.split((jax.nn.silu(c_ctx) @ ada_w[layer] + ada_b[layer])[None, None, :], 6, axis=-1)

        a_l = modulate(rmsnorm(h_lat, pre_mix_g[layer]), mod_l[0], mod_l[1])
        a_c = modulate(rmsnorm(h_ctx, pre_mix_g[layer]), mod_c[0], mod_c[1])
        m_l, m_c = token_mixer(a_l, a_c, lp, layer, need_ctx, cos, sin)
        h_lat = h_lat + mod_l[2] * rmsnorm(m_l, post_mix_g[layer])
        if need_ctx:
            h_ctx = h_ctx + mod_c[2] * rmsnorm(m_c, post_mix_g[layer])

        f_l = modulate(rmsnorm(h_lat, pre_ffn_g[layer]), mod_l[3], mod_l[4]).reshape(B * S, D)
        if need_ctx:
            f_c = modulate(rmsnorm(h_ctx, pre_ffn_g[layer]), mod_c[3], mod_c[4]).reshape(B * L, D)
            toks = jnp.concatenate([f_l, f_c], axis=0)
        else:
            toks = f_l
        j = layer // 2
        if layer % 2 == 0:
            f = swiglu(toks, ffn_w_gate[j], ffn_w_up[j], ffn_w_down[j])
        else:
            f = moe_swiglu(toks, router_w[j], moe_w_gate[j], moe_w_up[j], moe_w_down[j])
        h_lat = h_lat + mod_l[5] * rmsnorm(f[:B * S].reshape(B, S, D), post_ffn_g[layer])
        if need_ctx:
            h_ctx = h_ctx + mod_c[5] * rmsnorm(f[B * S:].reshape(B, L, D), post_ffn_g[layer])
    return h_lat
```

```cpp
#define DBG_SEL 0
#include <hip/hip_runtime.h>
#include <hip/hip_cooperative_groups.h>
#include <cstdio>
#include <cstdint>
namespace cg = cooperative_groups;
namespace pg8 {
#define PG8_LAS __attribute__((address_space(3)))
typedef unsigned short bf16_t;
typedef short bf16x8 __attribute__((ext_vector_type(8)));
typedef float f32x4 __attribute__((ext_vector_type(4)));
typedef unsigned u32x4 __attribute__((ext_vector_type(4)));
constexpr int BM = 256, BK = 64, HALF = 128, HTB = HALF * BK * 2  , STAGE_BYTES = 8 * HTB, NXCD = 8, WGM = 8;

__host__ __device__ __forceinline__ int lds_byte(int r, int c) { const int st = (r >> 4) * 2 + (c >> 5), rr = r & 15, cc = c & 31, ob = rr * 64 + cc * 2; return st * 1024 + (ob ^ (((ob >> 9) & 1) << 5)); }
__host__ __device__ __forceinline__ void stage_rc(int b, int& R, int& C) { const int st = b / 1024, sb = b % 1024, swz = sb ^ (((sb >> 9) & 1) << 5); R = (st >> 1) * 16 + swz / 64; C = (st & 1) * 32 + (swz % 64) / 2; }
__host__ __device__ __forceinline__ int perm32(int rho) { const int n = rho >> 4, i = rho & 15; return 8 * (i >> 2) + 4 * n + (i & 3); }

struct Unit { int pm, pn; };
struct Gemm { const bf16_t* A; const bf16_t* Bt; int M, N, K; };

struct StaticOrder {
    int nM, nN, nwg, G, c;
    __host__ __device__ void init(int M, int N, int G_, int c_) { nM = M / BM; nN = N / BM; nwg = nM * nN; G = G_; c = c_; }
    __host__ __device__ bool next(int i, Unit& u) const {
        const long L = (long)i * G + c; if (L >= nwg) return false;
        int wgid = (int)L; { const int q = nwg / NXCD, r = nwg % NXCD, xcd = wgid % NXCD, off = wgid / NXCD; wgid = (xcd < r ? xcd * (q + 1) : r * (q + 1) + (xcd - r) * q) + off; }
        const int nig = WGM * nN, gid = wgid / nig, fm = gid * WGM, gsz = (nM - fm) < WGM ? (nM - fm) : WGM;
        u.pm = fm + ((wgid % nig) % gsz); u.pn = (wgid % nig) / gsz; return true;
    }
    __device__ __forceinline__ void a_ready(const Unit&) const {}
    __device__ __forceinline__ void done(const Unit&) const {}
};

__device__ __forceinline__ unsigned cvt_pk_bf16(float lo, float hi) { unsigned r; asm volatile("v_cvt_pk_bf16_f32 %0, %1, %2" : "=v"(r) : "v"(lo), "v"(hi)); return r; }
typedef float f32x2 __attribute__((ext_vector_type(2)));
template <class Epi, class Sched, bool ALIGN_EPI = false, bool SP2 = false>
__device__ __forceinline__ void gemm_phase(PG8_LAS unsigned char* lds, const Gemm g, const Sched& S, const Epi& E) {
    int tid_ = threadIdx.x; asm volatile("" : "+v"(tid_)); const int tid = tid_, wid = __builtin_amdgcn_readfirstlane(tid >> 6), lane = tid & 63, wr = wid >> 2, wc = wid & 3, fr = lane & 15, fq = lane >> 4;
    const int K = g.K, nt = K / BK;
    unsigned voffA[2], voffB[2];
#pragma unroll
    for (int i = 0; i < 2; ++i) { int R, C; stage_rc(tid * 16 + i * 8192, R, C); const int Rb = Epi::PERM ? ((R & ~31) + perm32(R & 31)) : R;
        voffA[i] = (unsigned)(R * K + C) * 2u; voffB[i] = (unsigned)(Rb * K + C) * 2u; }
    const size_t kstep = (size_t)(BK * 2);
    const size_t hstep = (size_t)HALF * K * 2;
    const size_t tstep = 2 * hstep;
    const unsigned ldsw = (unsigned)wid * 1024u;
    const int aoff = lds_byte(wr * 64 + fr, fq * 8), boff = lds_byte(wc * 32 + fr, fq * 8);
#define PG8_SA(b, h) (((b) * 2 + (h)) * HTB)
#define PG8_SB(b, h) ((4 + (b) * 2 + (h)) * HTB)
#define PG8_STAGE(bufoff, gbase, voff) do { _Pragma("unroll") for (int _i = 0; _i < 2; ++_i) \
        __builtin_amdgcn_global_load_lds((const unsigned*)((const char*)(gbase) + (voff)[_i]), (PG8_LAS unsigned*)(lds + (bufoff) + ldsw + _i * 8192), 16, 0, 0); } while (0)
#define PG8_LDA(dst, b, h) do { _Pragma("unroll") for (int m = 0; m < 4; ++m) _Pragma("unroll") for (int k = 0; k < 2; ++k) dst[m][k] = *(const PG8_LAS bf16x8*)(lds + PG8_SA(b, h) + aoff + m * 2048 + k * 1024); } while (0)
#define PG8_LDB(dst, b, h) do { _Pragma("unroll") for (int n = 0; n < 2; ++n) _Pragma("unroll") for (int k = 0; k < 2; ++k) dst[n][k] = *(const PG8_LAS bf16x8*)(lds + PG8_SB(b, h) + boff + n * 2048 + k * 1024); } while (0)
#define PG8_MMA(ai, bj, At, Bt) do { __builtin_amdgcn_s_setprio(1); _Pragma("unroll") for (int m = 0; m < 4; ++m) _Pragma("unroll") for (int n = 0; n < 2; ++n) _Pragma("unroll") for (int k = 0; k < 2; ++k) \
        acc[ai][bj][m][n] = __builtin_amdgcn_mfma_f32_16x16x32_bf16(Bt[n][k], At[m][k], acc[ai][bj][m][n], 0, 0, 0); __builtin_amdgcn_s_setprio(0); } while (0)
#define PG8_WAIT_V(n) asm volatile("s_waitcnt vmcnt(" #n ")" ::: "memory")
#define PG8_WAIT_L(n) asm volatile("s_waitcnt lgkmcnt(" #n ")" ::: "memory")
#define PG8_BAR __builtin_amdgcn_s_barrier()
#define PG8_SCHED __builtin_amdgcn_sched_barrier(0)
    Unit cur, nxt; int ui = 0;
    if (!S.next(0, cur)) return;
    f32x4 acc[2][2][4][2];
#pragma unroll
    for (int a = 0; a < 2; ++a)
#pragma unroll
        for (int b = 0; b < 2; ++b)
#pragma unroll
            for (int m = 0; m < 4; ++m)
#pragma unroll
                for (int n = 0; n < 2; ++n) acc[a][b][m][n] = (f32x4){0.f, 0.f, 0.f, 0.f};
    bf16x8 At[4][2], B0[2][2], B1[2][2];
    const char* cA = (const char*)g.A + (size_t)cur.pm * tstep; const char* cB = (const char*)g.Bt + (size_t)cur.pn * tstep;
    S.a_ready(cur);
    if constexpr (SP2) {
        PG8_STAGE(PG8_SB(0, 0), cB, voffB); PG8_STAGE(PG8_SB(0, 1), cB + hstep, voffB); PG8_STAGE(PG8_SA(0, 0), cA, voffA); PG8_STAGE(PG8_SA(0, 1), cA + hstep, voffA);
        if (wr == 1) PG8_BAR;
        PG8_WAIT_V(2); PG8_BAR;
        PG8_STAGE(PG8_SB(1, 0), cB + kstep, voffB); PG8_STAGE(PG8_SA(1, 0), cA + kstep, voffA); PG8_STAGE(PG8_SB(1, 1), cB + hstep + kstep, voffB);
        PG8_WAIT_V(6); PG8_BAR;
    } else {
        PG8_STAGE(PG8_SB(0, 0), cB, voffB); PG8_STAGE(PG8_SA(0, 0), cA, voffA); PG8_STAGE(PG8_SB(0, 1), cB + hstep, voffB); PG8_STAGE(PG8_SA(0, 1), cA + hstep, voffA);
        if (wr == 1) PG8_BAR;
        PG8_WAIT_V(4); PG8_BAR;
        PG8_STAGE(PG8_SB(1, 0), cB + kstep, voffB); PG8_STAGE(PG8_SA(1, 0), cA + kstep, voffA); PG8_STAGE(PG8_SB(1, 1), cB + hstep + kstep, voffB);
        PG8_WAIT_V(6); PG8_BAR;
    }
    for (;;) {
        const bool has_next = S.next(ui + 1, nxt);
        const char* nA = has_next ? (const char*)g.A + (size_t)nxt.pm * tstep : cA; const char* nB = has_next ? (const char*)g.Bt + (size_t)nxt.pn * tstep : cB;
        for (int t = 0; t < nt; t += 2) {
            const bool last = (t == nt - 2);
            const char* a1 = cA + (size_t)(t + 1) * kstep;
            const char* a2 = last ? nA : cA + (size_t)(t + 2) * kstep; const char* b2 = last ? nB : cB + (size_t)(t + 2) * kstep;
            const char* a3 = a2 + kstep; const char* b3 = b2 + kstep;
            if (last && has_next) S.a_ready(nxt);
            if constexpr (SP2) {
            PG8_LDB(B0, 0, 0); PG8_LDB(B1, 0, 1); PG8_SCHED; PG8_LDA(At, 0, 0); PG8_STAGE(PG8_SA(1, 1), a1 + hstep, voffA);
            PG8_WAIT_V(8); PG8_WAIT_L(0); PG8_BAR; PG8_MMA(0, 0, At, B0); PG8_MMA(0, 1, At, B1); PG8_BAR; PG8_SCHED;
            PG8_LDA(At, 0, 1); PG8_STAGE(PG8_SB(0, 0), b2, voffB); PG8_STAGE(PG8_SB(0, 1), b2 + hstep, voffB); PG8_STAGE(PG8_SA(0, 0), a2, voffA);
            PG8_WAIT_V(8); PG8_WAIT_L(0); PG8_BAR; PG8_MMA(1, 0, At, B0); PG8_MMA(1, 1, At, B1); PG8_BAR; PG8_SCHED;
            PG8_LDB(B0, 1, 0); PG8_LDB(B1, 1, 1); PG8_SCHED; PG8_LDA(At, 1, 0); PG8_STAGE(PG8_SA(0, 1), a2 + hstep, voffA);
            PG8_WAIT_V(8); PG8_WAIT_L(0); PG8_BAR; PG8_MMA(0, 0, At, B0); PG8_MMA(0, 1, At, B1); PG8_BAR; PG8_SCHED;
            PG8_LDA(At, 1, 1); PG8_STAGE(PG8_SB(1, 0), b3, voffB); PG8_STAGE(PG8_SB(1, 1), b3 + hstep, voffB); PG8_STAGE(PG8_SA(1, 0), a3, voffA);
            PG8_WAIT_V(8); PG8_WAIT_L(0); PG8_BAR; PG8_MMA(1, 0, At, B0); PG8_MMA(1, 1, At, B1); PG8_BAR; PG8_SCHED;
            } else {
            PG8_LDB(B0, 0, 0); PG8_SCHED; PG8_LDA(At, 0, 0); PG8_STAGE(PG8_SA(1, 1), a1 + hstep, voffA);
            PG8_WAIT_L(8); PG8_BAR; PG8_WAIT_L(0); PG8_MMA(0, 0, At, B0); PG8_BAR; PG8_SCHED;
            PG8_LDB(B1, 0, 1); PG8_STAGE(PG8_SB(0, 0), b2, voffB);
            PG8_BAR; PG8_WAIT_L(0); PG8_MMA(0, 1, At, B1); PG8_BAR;
            PG8_LDA(At, 0, 1); PG8_STAGE(PG8_SA(0, 0), a2, voffA);
            PG8_BAR; PG8_WAIT_L(0); PG8_MMA(1, 0, At, B0); PG8_BAR; PG8_SCHED;
            PG8_STAGE(PG8_SB(0, 1), b2 + hstep, voffB);
            PG8_WAIT_V(6); PG8_BAR; PG8_MMA(1, 1, At, B1); PG8_BAR;
            PG8_LDB(B0, 1, 0); PG8_SCHED; PG8_LDA(At, 1, 0); PG8_STAGE(PG8_SA(0, 1), a2 + hstep, voffA);
            PG8_WAIT_L(8); PG8_BAR; PG8_WAIT_L(0); PG8_MMA(0, 0, At, B0); PG8_BAR; PG8_SCHED;
            PG8_LDB(B1, 1, 1); PG8_STAGE(PG8_SB(1, 0), b3, voffB);
            PG8_BAR; PG8_WAIT_L(0); PG8_MMA(0, 1, At, B1); PG8_BAR;
            PG8_LDA(At, 1, 1); PG8_STAGE(PG8_SA(1, 0), a3, voffA);
            PG8_BAR; PG8_WAIT_L(0); PG8_MMA(1, 0, At, B0); PG8_BAR; PG8_SCHED;
            PG8_STAGE(PG8_SB(1, 1), b3 + hstep, voffB);
            PG8_WAIT_V(6); PG8_BAR; PG8_MMA(1, 1, At, B1); PG8_BAR;
            }
        }
        if constexpr (ALIGN_EPI) { if (wr == 0) PG8_BAR; }
        if constexpr (!Epi::AFTER_DRAIN) { E(acc, cur, wr, wc, fr, fq); S.done(cur); }
        if (!has_next) break;
#pragma unroll
        for (int a = 0; a < 2; ++a)
#pragma unroll
            for (int b = 0; b < 2; ++b)
#pragma unroll
                for (int m = 0; m < 4; ++m)
#pragma unroll
                    for (int n = 0; n < 2; ++n) acc[a][b][m][n] = (f32x4){0.f, 0.f, 0.f, 0.f};
        cur = nxt; cA = nA; cB = nB; ++ui;
        if constexpr (ALIGN_EPI) { if (wr == 1) PG8_BAR; }
    }
    PG8_WAIT_V(0);
    if constexpr (!ALIGN_EPI) { if (wr == 0) PG8_BAR; }
    PG8_BAR;
    if constexpr (Epi::AFTER_DRAIN) { E.fused(acc, cur, wr, wc, fr, fq, lds, wid, lane); S.done(cur); }
#undef PG8_SA
#undef PG8_SB
#undef PG8_STAGE
#undef PG8_LDA
#undef PG8_LDB
#undef PG8_MMA
#undef PG8_WAIT_V
#undef PG8_WAIT_L
#undef PG8_BAR
#undef PG8_SCHED
}
}

#define LAS __attribute__((address_space(3)))
typedef unsigned short bf16_t;
typedef short bf16x8 __attribute__((ext_vector_type(8)));
typedef float f32x4 __attribute__((ext_vector_type(4)));
typedef float f32x16 __attribute__((ext_vector_type(16)));
typedef unsigned u32x4 __attribute__((ext_vector_type(4)));
typedef unsigned u32x2 __attribute__((ext_vector_type(2)));

constexpr int NTHREADS = 512, NWAVES = 8;
constexpr int DM = 1024, SEQ = 8192, CTXL = 256, NLAT = 2 * SEQ, NCTX = 2 * CTXL, NTOK = NLAT + NCTX, KEYS = SEQ + CTXL;
constexpr int D_IN = 7296, D_FF = 2816, D_FFE = 3584, NEXP = 8;
constexpr int IC_QS = 0, IC_KS = 512, IC_RW = 640, IC_QD = 2560, IC_KD = 3072, PP = 3584, IC_VS = 3584, IC_VD = 3712, IC_PAD = 4224, NIN1 = 4352, WIN_ROWS = 7424;
constexpr int ST_SLOTS = 9;
constexpr int MOE_TILES = 136, MOE_HALF = 68;

constexpr size_t MiB = 1u << 20;
constexpr size_t WS_CTL = 0, CTL_BYTES = 1 * MiB;
constexpr size_t WS_MODS = 1 * MiB;
constexpr size_t WS_ROPE = 1 * MiB + 256 * 1024;
constexpr size_t WS_HCTX = 2 * MiB;
constexpr size_t WS_LIST = 4 * MiB;
constexpr size_t WS_WTS = 4 * MiB + 512 * 1024;
constexpr size_t WS_WIN = 6 * MiB;
constexpr size_t WS_PRJ = WS_WIN + (size_t)WIN_ROWS * 1024 * 2;
constexpr size_t WS_WOUT = WS_PRJ + 3 * MiB;
constexpr size_t WS_LORA = WS_WOUT + 2 * MiB;
constexpr size_t WS_XN = 28 * MiB;
constexpr size_t WS_P = 61 * MiB;
constexpr size_t WS_VTS = 177 * MiB;
constexpr size_t WS_VTD = WS_VTS + 4608 * 1024;
constexpr size_t WS_ST = 198 * MiB;
constexpr size_t WS_YA = 495 * MiB;
constexpr size_t WS_YB = WS_YA + 16896ull * 512 * 2;
constexpr size_t WS_YC = WS_YB + 16896ull * 512 * 2;
constexpr size_t WS_END = WS_YC + 16896ull * 512 * 2;
constexpr size_t WS_G = WS_ST;
constexpr size_t WS_MF = WS_ST + 99 * MiB;
constexpr size_t WS_MB = WS_ST + 165 * MiB;
constexpr size_t WS_MOUT = WS_ST + 198 * MiB;
constexpr size_t WS_FGU = WS_ST + 264 * MiB;
constexpr size_t WS_FD = WS_ST + 275 * MiB;
constexpr size_t WS_HID = WS_P;
constexpr size_t WS_MGU = 61 * MiB;
constexpr size_t WS_MD = 173 * MiB;
constexpr size_t WS_XG = 229 * MiB;
constexpr size_t WS_HIDM = 297 * MiB;
constexpr size_t WS_FSLOT = 416 * MiB;
static_assert(WS_LORA + 2560 * 384 * 2 <= WS_XN && WS_XN + 16896ull * 1024 * 2 <= WS_P && WS_P + 16896ull * PP * 2 <= WS_VTS && WS_VTD + 2ull * 4 * 128 * KEYS * 2 <= WS_ST, "ws map 1");
static_assert(WS_ST + 16896ull * 8 * ST_SLOTS * 64 * 4 <= WS_YA && WS_END <= 545 * MiB, "ws map 2");
static_assert(WS_G + 16896ull * 3072 * 2 <= WS_MF && WS_MF + 16896ull * 1024 * 4 <= WS_MB && WS_MB + 16896ull * 1024 * 2 <= WS_MOUT && WS_MOUT + 16896ull * 1024 * 4 <= WS_FGU, "ws map 3");
static_assert(WS_FGU + 5632ull * 1024 * 2 <= WS_FD && WS_FD + 1024ull * 2816 * 2 <= WS_YA && WS_HID + 16896ull * 2816 * 2 <= WS_VTS, "ws map 4");
static_assert(WS_MGU + 8ull * 7168 * 1024 * 2 <= WS_MD && WS_MD + 8ull * 1024 * 3584 * 2 <= WS_XG && WS_XG + 34816ull * 1024 * 2 <= WS_HIDM && WS_HIDM + 68ull * 256 * 3584 * 2 <= WS_FSLOT && WS_FSLOT + 2ull * 16384 * 1024 * 4 <= 545 * MiB, "ws map 5");
static_assert(WS_XG >= WS_ST + 0 && WS_MD + 8ull * 1024 * 3584 * 2 <= WS_MOUT, "moe weights must not touch MOUT while it is live");
constexpr size_t WS_NEED = 545 * MiB;
constexpr int CW_CNT = 0;
constexpr int CW_Q0 = 64, CW_Q1 = 128;

constexpr int LDS_BYTES = 147456;

__device__ __forceinline__ unsigned f2bf(float f) { unsigned u = __builtin_bit_cast(unsigned, f); return (u + 0x7fffu + ((u >> 16) & 1u)) >> 16; }
__device__ __forceinline__ unsigned pk2(float lo, float hi) { return f2bf(lo) | (f2bf(hi) << 16); }
__device__ __forceinline__ float bflo(unsigned w) { return __uint_as_float(w << 16); }
__device__ __forceinline__ float bfhi(unsigned w) { return __uint_as_float(w & 0xffff0000u); }
__device__ __forceinline__ float wave_sum(float v) {
#pragma unroll
    for (int o = 1; o < 64; o <<= 1) v += __shfl_xor(v, o);
    return v;
}
__device__ __forceinline__ float sigmoidf_(float x) { return 1.0f / (1.0f + __expf(-x)); }
__device__ __forceinline__ float siluf_(float x) { return x / (1.0f + __expf(-x)); }
#define LDS_WAIT() asm volatile("s_waitcnt lgkmcnt(0)" ::: "memory")

struct Params {
    const float* in[37];
    float* out;
    unsigned char* ws;
    int ph_lo, ph_hi;
};

template <class F>
__device__ __forceinline__ void transpose_item(const float* __restrict__ W, int ldw, int k0, int n0, bf16_t* __restrict__ WT, int ldt, int dcol0, F rowmap, LAS float* scr, int lane) {
#pragma unroll 8
    for (int i = 0; i < 32; ++i) { const int kk = 2 * i + (lane >> 5); scr[kk * 33 + (lane & 31)] = W[(size_t)(k0 + kk) * ldw + n0 + (lane & 31)]; }
    LDS_WAIT(); asm volatile("" ::: "memory");
    const int c = lane & 7;
#pragma unroll
    for (int j = 0; j < 4; ++j) {
        const int n = (lane >> 3) + 8 * j; const LAS float* s = scr + (8 * c) * 33 + n;
        u32x4 o; o.x = pk2(s[0 * 33], s[1 * 33]); o.y = pk2(s[2 * 33], s[3 * 33]); o.z = pk2(s[4 * 33], s[5 * 33]); o.w = pk2(s[6 * 33], s[7 * 33]);
        const int row = rowmap(n0 + n);
        if (row >= 0) *(u32x4*)(WT + (size_t)row * ldt + dcol0 + k0 + 8 * c) = o;
    }
    LDS_WAIT(); asm volatile("" ::: "memory");
}
struct RowId { __device__ __forceinline__ int operator()(int n) const { return n; } };
struct RowOff { int off; __device__ __forceinline__ int operator()(int n) const { return n + off; } };
struct RowWin {
    __device__ __forceinline__ int operator()(int n) const {
        if (n < 640) return n;
        if (n < 768) return n - 640 + IC_VS;
        if (n < 2688) return n - 768 + IC_RW;
        if (n < 3712) return n - 2688 + IC_QD;
        if (n < 4224) return n - 3712 + IC_VD;
        return n - 4224 + NIN1;
    }
};
struct RowGU { int up; __device__ __forceinline__ int operator()(int j) const { return (j >> 4) * 32 + (j & 15) + 16 * up; } };

template <class F>
__device__ __forceinline__ void convert_matrix(const float* W, int K, int N, bf16_t* WT, int ldt, int dcol0, F rowmap, LAS float* scr, int lane, int gw, int NGW) {
    const int nblk = N / 32, items = (K / 64) * nblk;
    for (int it = gw; it < items; it += NGW) { const int kb = it / nblk, nb = it % nblk; transpose_item(W, N, kb * 64, nb * 32, WT, ldt, dcol0, rowmap, scr, lane); }
}

__device__ __forceinline__ void lora_region(bf16_t* __restrict__ LT, const float* __restrict__ src, int row0, int klo, int kn, int gw, int NGW, int lane) {
    for (int i = gw * 64 + lane; i < 512 * 48; i += NGW * 64) {
        const int nn = i / 48, kc = (i % 48) * 8;
        u32x4 o = (u32x4){0u, 0u, 0u, 0u};
        if (kc >= klo && kc < klo + kn) {
            const float* s = src + (size_t)(kc - klo) * 512 + nn;
            o.x = pk2(s[0], s[512]); o.y = pk2(s[2 * 512], s[3 * 512]); o.z = pk2(s[4 * 512], s[5 * 512]); o.w = pk2(s[6 * 512], s[7 * 512]);
        }
        *(u32x4*)(LT + (size_t)(row0 + nn) * 384 + kc) = o;
    }
}
__device__ __forceinline__ void convert_layer_weights(const Params& p, int layer, LAS unsigned char* lds, int gw, int NGW, int wave, int lane) {
    LAS float* scr = (LAS float*)(lds + wave * 16384);
    unsigned char* ws = p.ws;
    bf16_t* WIN = (bf16_t*)(ws + WS_WIN);
    convert_matrix(p.in[10] + (size_t)layer * 1024 * D_IN, 1024, D_IN, WIN, 1024, 0, RowWin(), scr, lane, gw, NGW);
    for (int i = gw * 64 + lane; i < (NIN1 - IC_PAD) * 1024 / 8; i += NGW * 64) *(u32x4*)(WIN + (size_t)IC_PAD * 1024 + (size_t)i * 8) = (u32x4){0u, 0u, 0u, 0u};
    for (int j = 0; j < 3; ++j)
        convert_matrix(p.in[26 + j] + (size_t)layer * 512 * 1024, 512, 1024, (bf16_t*)(ws + WS_PRJ) + (size_t)j * 1024 * 512, 512, 0, RowId(), scr, lane, gw, NGW);
    convert_matrix(p.in[29] + (size_t)layer * 1024 * 1024, 1024, 1024, (bf16_t*)(ws + WS_WOUT), 1024, 0, RowId(), scr, lane, gw, NGW);
    bf16_t* LT = (bf16_t*)(ws + WS_LORA);
    lora_region(LT, p.in[15] + ((size_t)layer * 2 + 0) * 64 * 512, 0, 0, 64, gw, NGW, lane);
    lora_region(LT, p.in[15] + ((size_t)layer * 2 + 1) * 64 * 512, 512, 64, 64, gw, NGW, lane);
    lora_region(LT, p.in[17] + ((size_t)layer * 2 + 0) * 64 * 512, 1024, 128, 64, gw, NGW, lane);
    lora_region(LT, p.in[17] + ((size_t)layer * 2 + 1) * 64 * 512, 1536, 192, 64, gw, NGW, lane);
    lora_region(LT, p.in[18] + (size_t)layer * 128 * 512, 2048, 256, 128, gw, NGW, lane);
}
__device__ __forceinline__ void convert_ffn_weights(const Params& p, LAS unsigned char* lds, int gw, int NGW, int wave, int lane) {
    LAS float* scr = (LAS float*)(lds + wave * 16384);
    bf16_t* GU = (bf16_t*)(p.ws + WS_FGU); bf16_t* FD = (bf16_t*)(p.ws + WS_FD);
    convert_matrix(p.in[30], 1024, D_FF, GU, 1024, 0, RowGU{0}, scr, lane, gw, NGW);
    convert_matrix(p.in[31], 1024, D_FF, GU, 1024, 0, RowGU{1}, scr, lane, gw, NGW);
    convert_matrix(p.in[32], D_FF, 1024, FD, D_FF, 0, RowId(), scr, lane, gw, NGW);
}
__device__ __forceinline__ void convert_moe_weights(const Params& p, LAS unsigned char* lds, int gw, int NGW, int wave, int lane) {
    LAS float* scr = (LAS float*)(lds + wave * 16384);
    for (int e = 0; e < NEXP; ++e) {
        bf16_t* GU = (bf16_t*)(p.ws + WS_MGU) + (size_t)e * 7168 * 1024;
        convert_matrix(p.in[34] + (size_t)e * 1024 * D_FFE, 1024, D_FFE, GU, 1024, 0, RowGU{0}, scr, lane, gw, NGW);
        convert_matrix(p.in[35] + (size_t)e * 1024 * D_FFE, 1024, D_FFE, GU, 1024, 0, RowGU{1}, scr, lane, gw, NGW);
        convert_matrix(p.in[36] + (size_t)e * D_FFE * 1024, D_FFE, 1024, (bf16_t*)(p.ws + WS_MD) + (size_t)e * 1024 * D_FFE, D_FFE, 0, RowId(), scr, lane, gw, NGW);
    }
}

__device__ __forceinline__ void adaln_phase(const Params& p, LAS unsigned char* lds, int wave, int lane) {
    LAS float* red = (LAS float*)lds;
    float* MODS = (float*)(p.ws + WS_MODS);
    const float* c = p.in[1]; const float* cc = p.in[3];
    for (int it = blockIdx.x; it < 2 * 96; it += gridDim.x) {
        const int layer = it / 96, n = (it % 96) * 64 + lane;
        const float* W = p.in[4] + (size_t)layer * 1024 * 6144;
        float a0 = 0.f, a1 = 0.f, a2 = 0.f;
        for (int k = wave * 128; k < wave * 128 + 128; ++k) {
            const float w = W[(size_t)k * 6144 + n];
            a0 += siluf_(c[k]) * w; a1 += siluf_(c[1024 + k]) * w; a2 += siluf_(cc[k]) * w;
        }
        red[(wave * 3 + 0) * 64 + lane] = a0; red[(wave * 3 + 1) * 64 + lane] = a1; red[(wave * 3 + 2) * 64 + lane] = a2;
        __syncthreads();
        if (wave < 3) {
            float s = 0.f;
#pragma unroll
            for (int w = 0; w < 8; ++w) s += red[(w * 3 + wave) * 64 + lane];
            MODS[((size_t)layer * 3 + wave) * 6144 + n] = s + p.in[5][(size_t)layer * 6144 + n];
        }
        __syncthreads();
    }
    if (blockIdx.x == gridDim.x - 1) {
        float* rope = (float*)(p.ws + WS_ROPE);
        for (int i = threadIdx.x; i < 128 * 16; i += NTHREADS) {
            const int pos = i >> 4, j = i & 15;
            const float inv = powf(10000.0f, -(float)j / 16.0f);
            const float ang = (float)pos * inv;
            rope[2 * i] = cosf(ang); rope[2 * i + 1] = sinf(ang);
        }
    }
}

__device__ __forceinline__ const float* mods_row(const Params& p, int layer, int m) {
    const int r = m < NLAT ? (m >> 13) : 2;
    return (const float*)(p.ws + WS_MODS) + ((size_t)layer * 3 + r) * 6144;
}
__device__ __forceinline__ void load_row(const float* x, int lane, f32x4 (&v)[4]) {
#pragma unroll
    for (int j = 0; j < 4; ++j) v[j] = ((const f32x4*)x)[lane + 64 * j];
}
__device__ __forceinline__ float row_rstd(const f32x4 (&v)[4]) {
    float s = 0.f;
#pragma unroll
    for (int j = 0; j < 4; ++j) s += (v[j].x * v[j].x + v[j].y * v[j].y) + (v[j].z * v[j].z + v[j].w * v[j].w);
    return 1.0f / sqrtf(wave_sum(s) * (1.0f / 1024.0f) + 1e-6f);
}
__device__ __forceinline__ void normmod(const f32x4 (&h)[4], const float* g, const float* shift, const float* scale, int lane, f32x4 (&a)[4]) {
    const float rstd = row_rstd(h);
#pragma unroll
    for (int j = 0; j < 4; ++j) {
        const f32x4 gg = ((const f32x4*)g)[lane + 64 * j], sh = ((const f32x4*)shift)[lane + 64 * j], sc = ((const f32x4*)scale)[lane + 64 * j];
        a[j] = (h[j] * rstd * gg) * (sc + 1.0f) + sh;
    }
}
__device__ __forceinline__ void store_row_bf16(bf16_t* o, int lane, const f32x4 (&a)[4]) {
#pragma unroll
    for (int j = 0; j < 4; ++j) { u32x2 w; w.x = pk2(a[j].x, a[j].y); w.y = pk2(a[j].z, a[j].w); ((u32x2*)o)[lane + 64 * j] = w; }
}
__device__ __forceinline__ const float* h_in_row(const Params& p, int layer, int m) {
    if (layer == 0) return m < NLAT ? p.in[0] + (size_t)m * 1024 : p.in[2] + (size_t)(m - NLAT) * 1024;
    return m < NLAT ? p.out + (size_t)m * 1024 : (const float*)(p.ws + WS_HCTX) + (size_t)(m - NLAT) * 1024;
}
__device__ __forceinline__ float* h_out_row(const Params& p, int m) { return m < NLAT ? p.out + (size_t)m * 1024 : (float*)(p.ws + WS_HCTX) + (size_t)(m - NLAT) * 1024; }

__device__ __forceinline__ void premix_phase(const Params& p, int layer, bool first, int M, int gw, int NGW, int lane) {
    bf16_t* XN = (bf16_t*)(p.ws + WS_XN);
    for (int m = gw; m < M; m += NGW) {
        const float* hr = first ? h_in_row(p, 0, m) : h_out_row(p, m);
        f32x4 h[4], a[4]; load_row(hr, lane, h);
        const float* md = mods_row(p, layer, m);
        normmod(h, p.in[6] + layer * 1024, md, md + 1024, lane, a);
        store_row_bf16(XN + (size_t)m * 1024, lane, a);
    }
}
__device__ __forceinline__ void residual_phase(const Params& p, const float* src, const float* src2, const float* hin_base_layer0, bool hin_is_input, int layer, int gate_idx, const float* g1,
                                               bool write_xn, const float* g2, int mod_layer2, int shift_idx, bool route, int M, int gw, int NGW, int lane) {
    bf16_t* XN = (bf16_t*)(p.ws + WS_XN);
    for (int m = gw; m < M; m += NGW) {
        const float* hr = hin_is_input ? h_in_row(p, 0, m) : h_out_row(p, m);
        f32x4 h[4], s[4]; load_row(hr, lane, h); load_row(src + (size_t)m * 1024, lane, s);
        if (src2) { f32x4 s2[4]; load_row(src2 + (size_t)m * 1024, lane, s2);
#pragma unroll
            for (int j = 0; j < 4; ++j) s[j] += s2[j]; }
        const float rstd = row_rstd(s);
        const float* md = mods_row(p, layer, m);
#pragma unroll
        for (int j = 0; j < 4; ++j) {
            const f32x4 gg = ((const f32x4*)g1)[lane + 64 * j], gt = ((const f32x4*)(md + gate_idx * 1024))[lane + 64 * j];
            h[j] = h[j] + gt * (s[j] * rstd * gg);
        }
        float* ho = h_out_row(p, m);
#pragma unroll
        for (int j = 0; j < 4; ++j) ((f32x4*)ho)[lane + 64 * j] = h[j];
        if (write_xn) {
            f32x4 a[4]; const float* md2 = mods_row(p, mod_layer2, m);
            normmod(h, g2, md2 + shift_idx * 1024, md2 + (shift_idx + 1) * 1024, lane, a);
            store_row_bf16(XN + (size_t)m * 1024, lane, a);
            if (route) {
                const float* rw = p.in[33];
                float lg[8] = {0.f, 0.f, 0.f, 0.f, 0.f, 0.f, 0.f, 0.f};
#pragma unroll
                for (int j = 0; j < 4; ++j)
#pragma unroll
                    for (int q = 0; q < 4; ++q) {
                        const int k = 4 * (lane + 64 * j) + q; const float av = a[j][q];
                        const f32x4 w0 = ((const f32x4*)(rw + (size_t)k * 8))[0], w1 = ((const f32x4*)(rw + (size_t)k * 8))[1];
                        lg[0] += av * w0.x; lg[1] += av * w0.y; lg[2] += av * w0.z; lg[3] += av * w0.w; lg[4] += av * w1.x; lg[5] += av * w1.y; lg[6] += av * w1.z; lg[7] += av * w1.w;
                    }
#pragma unroll
                for (int e = 0; e < 8; ++e) lg[e] = wave_sum(lg[e]);
                int i1 = 0; float v1 = lg[0];
#pragma unroll
                for (int e = 1; e < 8; ++e) if (lg[e] > v1) { v1 = lg[e]; i1 = e; }
                int i2 = -1; float v2 = -3.0e38f;
#pragma unroll
                for (int e = 0; e < 8; ++e) if (e != i1 && lg[e] > v2) { v2 = lg[e]; i2 = e; }
                if (lane == 0) {
                    const float w1 = 1.0f / (1.0f + expf(v2 - v1)), w2 = 1.0f - w1;
                    unsigned* cnt = (unsigned*)(p.ws + WS_CTL) + CW_CNT; int* LIST = (int*)(p.ws + WS_LIST); float* WTS = (float*)(p.ws + WS_WTS);
                    const unsigned s1 = atomicAdd(cnt + i1, 1u); LIST[i1 * 16384 + s1] = m * 2; WTS[i1 * 16384 + s1] = w1;
                    const unsigned s2 = atomicAdd(cnt + i2, 1u); LIST[i2 * 16384 + s2] = m * 2 + 1; WTS[i2 * 16384 + s2] = w2;
                }
            }
        }
    }
}

using pg8::Unit;
__device__ __forceinline__ u32x2 pack4(const f32x4 v) { u32x2 w; w.x = pk2(v.x, v.y); w.y = pk2(v.z, v.w); return w; }
__device__ __forceinline__ f32x4 unpack4(const u32x2 w) { return (f32x4){bflo(w.x), bfhi(w.x), bflo(w.y), bfhi(w.y)}; }

struct EpiIn {
    static constexpr bool PERM = false, AFTER_DRAIN = false;
    bf16_t* P; bf16_t* VTS; bf16_t* VTD; const float* rope;
    __device__ __forceinline__ void operator()(const f32x4 (&acc)[2][2][4][2], const Unit& u, int wr, int wc, int fr, int fq) const {
#pragma unroll
        for (int ai = 0; ai < 2; ++ai)
#pragma unroll
            for (int m = 0; m < 4; ++m) {
                const int r = u.pm * 256 + ai * 128 + wr * 64 + m * 16 + fr;
                const bool lat = r < NLAT;
                const int t = r & (SEQ - 1);
                const int b = lat ? (r >> 13) : ((r - NLAT) >> 8);
                const int key = lat ? t : SEQ + ((r - NLAT) & 255);
#pragma unroll
                for (int bj = 0; bj < 2; ++bj) {
                    const int c32 = u.pn * 256 + bj * 128 + wc * 32;
                    f32x4 v0 = acc[ai][bj][m][0], v1 = acc[ai][bj][m][1];
                    if (c32 < PP) {
                        const bool rp = (c32 < IC_RW) || (c32 >= IC_QD);
                        if (rp && lat) {
                            const int pos = (c32 & 32) ? (t & 63) : (t >> 6);
                            const f32x4 cs0 = *(const f32x4*)(rope + (pos * 16 + 4 * fq) * 2), cs1 = *(const f32x4*)(rope + (pos * 16 + 4 * fq) * 2 + 4);
                            const f32x4 cc = (f32x4){cs0.x, cs0.z, cs1.x, cs1.z}, sn = (f32x4){cs0.y, cs0.w, cs1.y, cs1.w};
                            const f32x4 o0 = v0 * cc - v1 * sn, o1 = v0 * sn + v1 * cc;
                            v0 = o0; v1 = o1;
                        }
                        bf16_t* dst = P + (size_t)r * PP + c32 + 4 * fq;
                        *(u32x2*)dst = pack4(v0); *(u32x2*)(dst + 16) = pack4(v1);
                    } else {
                        const int cv = c32 - PP;
                        bf16_t* vt = nullptr; int dimbase = 0;
                        if (cv < 128) { vt = VTS + (size_t)((b * 2 + (cv >> 6)) * 64) * KEYS; dimbase = cv & 63; }
                        else if (cv < 640) { const int cd = cv - 128; vt = VTD + (size_t)((b * 4 + (cd >> 7)) * 128) * KEYS; dimbase = cd & 127; }
                        if (vt) {
#pragma unroll
                            for (int i = 0; i < 4; ++i) {
                                vt[(size_t)(dimbase + 4 * fq + i) * KEYS + key] = (bf16_t)f2bf(v0[i]);
                                vt[(size_t)(dimbase + 16 + 4 * fq + i) * KEYS + key] = (bf16_t)f2bf(v1[i]);
                            }
                        }
                    }
                }
            }
    }
};

struct EpiLora {
    static constexpr bool PERM = false, AFTER_DRAIN = false;
    float* ST; bf16_t* P; const float* w0; const float* a0; const float* k_a;
    __device__ __forceinline__ void operator()(const f32x4 (&acc)[2][2][4][2], const Unit& u, int wr, int wc, int fr, int fq) const {
        const int reg = u.pn >> 1;
#pragma unroll
        for (int ai = 0; ai < 2; ++ai)
#pragma unroll
            for (int m = 0; m < 4; ++m) {
                const int r = u.pm * 256 + ai * 128 + wr * 64 + m * 16 + fr;
#pragma unroll
                for (int bj = 0; bj < 2; ++bj)
#pragma unroll
                    for (int n = 0; n < 2; ++n) {
                        const int ch = (u.pn & 1) * 256 + bj * 128 + wc * 32 + 16 * n + 4 * fq;
                        const int h = ch >> 6, kidx = ch & 63;
                        float* sp = ST + ((size_t)r * 8 + h) * (ST_SLOTS * 64) + kidx;
                        const f32x4 a = acc[ai][bj][m][n];
                        if (reg < 2) {
                            const f32x4 bias = *(const f32x4*)(w0 + reg * 512 + ch);
                            f32x4 o;
#pragma unroll
                            for (int i = 0; i < 4; ++i) {
                                const float x = -(bias[i] + a[i]);
                                const float sp_ = fmaxf(x, 0.f) + __logf(1.0f + __expf(-fabsf(x)));
                                o[i] = __expf(-__expf(-sp_ - 0.5f));
                            }
                            *(f32x4*)(sp + (3 + 3 * reg) * 64) = o;
                        } else if (reg < 4) {
                            const int d = reg - 2;
                            const f32x4 bias = *(const f32x4*)(a0 + d * 512 + ch), ka = *(const f32x4*)(k_a + ch);
                            const f32x4 kraw = *(const f32x4*)(sp + (5 + 3 * d) * 64), kk = *(const f32x4*)(sp);
                            f32x4 bv, kf;
#pragma unroll
                            for (int i = 0; i < 4; ++i) {
                                const float ag = sigmoidf_(bias[i] + a[i]);
                                bv[i] = -kk[i] * ag; kf[i] = kraw[i] * (1.0f + (ag - 1.0f) * ka[i]);
                            }
                            *(f32x4*)(sp + (4 + 3 * d) * 64) = bv; *(f32x4*)(sp + (5 + 3 * d) * 64) = kf;
                        } else {
                            *(u32x2*)(P + (size_t)r * PP + IC_RW + ch) = pack4(a);
                        }
                        asm volatile("" ::: "memory");
                    }
            }
    }
};

struct EpiGate {
    static constexpr bool PERM = false, AFTER_DRAIN = false;
    bf16_t* G;
    __device__ __forceinline__ void operator()(const f32x4 (&acc)[2][2][4][2], const Unit& u, int wr, int wc, int fr, int fq) const {
#pragma unroll
        for (int ai = 0; ai < 2; ++ai)
#pragma unroll
            for (int m = 0; m < 4; ++m) {
                const int r = u.pm * 256 + ai * 128 + wr * 64 + m * 16 + fr;
#pragma unroll
                for (int bj = 0; bj < 2; ++bj)
#pragma unroll
                    for (int n = 0; n < 2; ++n) {
                        const int c = u.pn * 256 + bj * 128 + wc * 32 + 16 * n + 4 * fq;
                        const f32x4 a = acc[ai][bj][m][n];
                        const f32x4 s = (f32x4){sigmoidf_(a.x), sigmoidf_(a.y), sigmoidf_(a.z), sigmoidf_(a.w)};
                        *(u32x2*)(G + (size_t)r * 3072 + c) = pack4(s);
                    }
            }
    }
};

template <int PASS> struct EpiMerge {
    static constexpr bool PERM = false, AFTER_DRAIN = false;
    const bf16_t* G; float* MF; bf16_t* MB;
    __device__ __forceinline__ void operator()(const f32x4 (&acc)[2][2][4][2], const Unit& u, int wr, int wc, int fr, int fq) const {
#pragma unroll
        for (int ai = 0; ai < 2; ++ai)
#pragma unroll
            for (int m = 0; m < 4; ++m) {
                const int r = u.pm * 256 + ai * 128 + wr * 64 + m * 16 + fr;
#pragma unroll
                for (int bj = 0; bj < 2; ++bj)
#pragma unroll
                    for (int n = 0; n < 2; ++n) {
                        const int c = u.pn * 256 + bj * 128 + wc * 32 + 16 * n + 4 * fq;
                        const f32x4 g = unpack4(*(const u32x2*)(G + (size_t)r * 3072 + PASS * 1024 + c));
                        f32x4 v = g * acc[ai][bj][m][n];
                        float* mp = MF + (size_t)r * 1024 + c;
                        if (PASS > 0) v += *(const f32x4*)mp;
                        if (PASS < 2) *(f32x4*)mp = v; else *(u32x2*)(MB + (size_t)r * 1024 + c) = pack4(v);
                    }
            }
    }
};

struct EpiF32 {
    static constexpr bool PERM = false, AFTER_DRAIN = false;
    float* O; int ldc;
    __device__ __forceinline__ void operator()(const f32x4 (&acc)[2][2][4][2], const Unit& u, int wr, int wc, int fr, int fq) const {
#pragma unroll
        for (int ai = 0; ai < 2; ++ai)
#pragma unroll
            for (int m = 0; m < 4; ++m) {
                const int r = u.pm * 256 + ai * 128 + wr * 64 + m * 16 + fr;
#pragma unroll
                for (int bj = 0; bj < 2; ++bj)
#pragma unroll
                    for (int n = 0; n < 2; ++n) {
                        const int c = u.pn * 256 + bj * 128 + wc * 32 + 16 * n + 4 * fq;
                        *(f32x4*)(O + (size_t)r * ldc + c) = acc[ai][bj][m][n];
                    }
            }
    }
};

struct EpiSwiglu {
    static constexpr bool PERM = false, AFTER_DRAIN = false;
    bf16_t* H; int ldh; int npn; int pm_sub;
    __device__ __forceinline__ void operator()(const f32x4 (&acc)[2][2][4][2], const Unit& u, int wr, int wc, int fr, int fq) const {
        const int pnn = u.pn % npn;
#pragma unroll
        for (int ai = 0; ai < 2; ++ai)
#pragma unroll
            for (int m = 0; m < 4; ++m) {
                const int r = (u.pm - pm_sub) * 256 + ai * 128 + wr * 64 + m * 16 + fr;
#pragma unroll
                for (int bj = 0; bj < 2; ++bj) {
                    const int hc = pnn * 128 + bj * 64 + wc * 16 + 4 * fq;
                    const f32x4 g = acc[ai][bj][m][0], up = acc[ai][bj][m][1];
                    const f32x4 o = (f32x4){siluf_(g.x) * up.x, siluf_(g.y) * up.y, siluf_(g.z) * up.z, siluf_(g.w) * up.w};
                    *(u32x2*)(H + (size_t)r * ldh + hc) = pack4(o);
                }
            }
    }
};

struct MoeSched {
    int ts[9]; int pm_lo, pm_hi, npn, G, c; bool a_local;
    __device__ __forceinline__ int expert_of(int pm) const { int e = 0;
#pragma unroll
        for (int q = 1; q < 8; ++q) e += (pm >= ts[q]) ? 1 : 0;
        return e; }
    __device__ __forceinline__ bool next(int i, Unit& u) const {
        const int n = (pm_hi - pm_lo) * npn; const long L = (long)i * G + c; if (L >= n) return false;
        const int pm = pm_lo + (int)L / npn, pnn = (int)L % npn;
        u.pm = a_local ? pm - pm_lo : pm; u.pn = expert_of(pm) * npn + pnn; return true;
    }
    __device__ __forceinline__ void a_ready(const Unit&) const {}
    __device__ __forceinline__ void done(const Unit&) const {}
};
struct EpiMoeDown {
    static constexpr bool PERM = false, AFTER_DRAIN = false;
    float* FS; const int* LIST; const float* WTS; const unsigned* cnt; int ts[9]; int pm_lo;
    __device__ __forceinline__ void operator()(const f32x4 (&acc)[2][2][4][2], const Unit& u, int wr, int wc, int fr, int fq) const {
        const int e = u.pn >> 2, pnn = u.pn & 3, pmg = u.pm + pm_lo;
        int tse = 0;
#pragma unroll
        for (int q = 0; q < 8; ++q) tse = (q == e) ? ts[q] : tse;
        const int ne = (int)cnt[e];
#pragma unroll
        for (int ai = 0; ai < 2; ++ai)
#pragma unroll
            for (int m = 0; m < 4; ++m) {
                const int slot = (pmg - tse) * 256 + ai * 128 + wr * 64 + m * 16 + fr;
                if (slot < ne) {
                    const int tk = LIST[e * 16384 + slot]; const float w = WTS[e * 16384 + slot];
                    float* dst = FS + ((size_t)(tk & 1) * NLAT + (tk >> 1)) * 1024 + pnn * 256 + wc * 32 + 4 * fq;
#pragma unroll
                    for (int bj = 0; bj < 2; ++bj)
#pragma unroll
                        for (int n = 0; n < 2; ++n) *(f32x4*)(dst + bj * 128 + 16 * n) = acc[ai][bj][m][n] * w;
                }
            }
    }
};

constexpr float SC2 = 0.125f * 1.4426950408889634f;
constexpr int ATT_KS = 0, ATT_VS = 9216, ATT_ROW = 144;

template <int DV, bool WINDOW>
__device__ __forceinline__ void attn_pass(LAS unsigned char* lds, const bf16_t* __restrict__ P, int qrow0, int qcol, int kcol, const bf16_t* __restrict__ VT,
                                          int lat_row0, int ctx_row0, int tile_lo, int tile_hi, float m0, float l0, int qpos0,
                                          f32x16 (&o)[DV / 32], float& l_out, int wave, int lane) {
    int tid_ = threadIdx.x; asm volatile("" : "+v"(tid_)); const int tid = tid_, qn = lane & 31, half = lane >> 5;
    LAS unsigned char* Ks = lds + ATT_KS; LAS unsigned char* Vs = lds + ATT_VS;
    bf16x8 qf[4];
    { const bf16_t* qp = P + (size_t)(qrow0 + wave * 32 + qn) * PP + qcol + half * 8;
#pragma unroll
      for (int ks = 0; ks < 4; ++ks) qf[ks] = *(const bf16x8*)(qp + ks * 16); }
    float mrun = m0, lrun = (half == 0) ? l0 : 0.f;
#pragma unroll
    for (int db = 0; db < DV / 32; ++db)
#pragma unroll
        for (int i = 0; i < 16; ++i) o[db][i] = 0.f;
    const int nlat = tile_hi - tile_lo, nt = nlat + 4;
    u32x4 kreg, vreg[DV / 64];
    const int skey = tid >> 3, spc = tid & 7;
#define ATT_LOAD(ti_) do { const int id_ = (ti_) < nlat ? tile_lo + (ti_) : 128 + ((ti_) - nlat); \
        const int krow0_ = id_ < 128 ? lat_row0 + 64 * id_ : ctx_row0 + 64 * (id_ - 128); \
        kreg = *(const u32x4*)(P + (size_t)(krow0_ + skey) * PP + kcol + spc * 8); \
        _Pragma("unroll") for (int j_ = 0; j_ < DV / 64; ++j_) { const int idx_ = tid + 512 * j_; vreg[j_] = *(const u32x4*)(VT + (size_t)(idx_ >> 3) * KEYS + 64 * id_ + (idx_ & 7) * 8); } } while (0)
    ATT_LOAD(0);
    for (int ti = 0; ti < nt; ++ti) {
        __syncthreads();
        *(LAS u32x4*)(Ks + skey * ATT_ROW + spc * 16) = kreg;
#pragma unroll
        for (int j = 0; j < DV / 64; ++j) { const int idx = tid + 512 * j; *(LAS u32x4*)(Vs + (idx >> 3) * ATT_ROW + (idx & 7) * 16) = vreg[j]; }
        __syncthreads();
        if (ti + 1 < nt) ATT_LOAD(ti + 1);
        const int id = ti < nlat ? tile_lo + ti : 128 + (ti - nlat);
        const bool islat = id < 128;
        if (WINDOW && islat) { const int qw = qpos0 + wave * 32; if (64 * id + 63 < qw - 128 || 64 * id > qw + 31 + 128) continue; }
        f32x16 s[2];
#pragma unroll
        for (int mb = 0; mb < 2; ++mb) {
#pragma unroll
            for (int i = 0; i < 16; ++i) s[mb][i] = 0.f;
#pragma unroll
            for (int ks = 0; ks < 4; ++ks) {
                const bf16x8 kf = *(const LAS bf16x8*)(Ks + (32 * mb + qn) * ATT_ROW + ks * 32 + half * 16);
                s[mb] = __builtin_amdgcn_mfma_f32_32x32x16_bf16(kf, qf[ks], s[mb], 0, 0, 0);
            }
        }
        if (WINDOW && islat) {
            const int qpos = qpos0 + wave * 32 + qn;
#pragma unroll
            for (int mb = 0; mb < 2; ++mb)
#pragma unroll
                for (int i = 0; i < 16; ++i) { const int d = 64 * id + 32 * mb + 8 * (i >> 2) + 4 * half + (i & 3) - qpos; if (d > 128 || d < -128) s[mb][i] = -INFINITY; }
        }
        float mx = s[0][0];
#pragma unroll
        for (int mb = 0; mb < 2; ++mb)
#pragma unroll
            for (int i = 0; i < 16; ++i) mx = fmaxf(mx, s[mb][i]);
        mx = fmaxf(mx, __shfl_xor(mx, 32));
        const float mnew = fmaxf(mrun, mx * SC2);
        const float alpha = __builtin_amdgcn_exp2f(mrun - mnew);
        float rs = 0.f;
#pragma unroll
        for (int mb = 0; mb < 2; ++mb)
#pragma unroll
            for (int i = 0; i < 16; ++i) { const float pv = __builtin_amdgcn_exp2f(fmaf(s[mb][i], SC2, -mnew)); s[mb][i] = pv; rs += pv; }
        lrun = lrun * alpha + rs; mrun = mnew;
#pragma unroll
        for (int db = 0; db < DV / 32; ++db)
#pragma unroll
            for (int i = 0; i < 16; ++i) o[db][i] *= alpha;
#pragma unroll
        for (int g = 0; g < 4; ++g) {
            const int mb = g >> 1, bs = 8 * (g & 1);
            u32x4 pw; pw.x = pk2(s[mb][bs + 0], s[mb][bs + 1]); pw.y = pk2(s[mb][bs + 2], s[mb][bs + 3]); pw.z = pk2(s[mb][bs + 4], s[mb][bs + 5]); pw.w = pk2(s[mb][bs + 6], s[mb][bs + 7]);
            const bf16x8 pf = __builtin_bit_cast(bf16x8, pw);
#pragma unroll
            for (int db = 0; db < DV / 32; ++db) {
                const LAS unsigned char* vp = Vs + (32 * db + qn) * ATT_ROW + (16 * g + 4 * half) * 2;
                const u32x2 lo = *(const LAS u32x2*)vp, hi = *(const LAS u32x2*)(vp + 16);
                const u32x4 vw = (u32x4){lo.x, lo.y, hi.x, hi.y};
                o[db] = __builtin_amdgcn_mfma_f32_32x32x16_bf16(__builtin_bit_cast(bf16x8, vw), pf, o[db], 0, 0, 0);
            }
        }
    }
#undef ATT_LOAD
    l_out = lrun + __shfl_xor(lrun, 32);
}

__device__ __forceinline__ void swa_unit(LAS unsigned char* lds, const Params& p, int layer, int b, int hq, int qb, bool ctx, int wave, int lane) {
    const bf16_t* P = (const bf16_t*)(p.ws + WS_P); bf16_t* YA = (bf16_t*)(p.ws + WS_YA);
    const int kvh = hq >> 2;
    const bf16_t* VT = (const bf16_t*)(p.ws + WS_VTS) + (size_t)((b * 2 + kvh) * 64) * KEYS;
    const float sink2 = p.in[11][layer * 8 + hq] * 1.4426950408889634f;
    const int qrow0 = ctx ? NLAT + b * CTXL : b * SEQ + qb * 256;
    f32x16 o[2]; float l;
    if (ctx) attn_pass<64, false>(lds, P, qrow0, IC_QS + hq * 64, IC_KS + kvh * 64, VT, b * SEQ, NLAT + b * CTXL, 0, 0, sink2, 1.0f, 0, o, l, wave, lane);
    else {
        int lo = 4 * qb - 2; if (lo < 0) lo = 0; int hi = 4 * qb + 6; if (hi > 128) hi = 128;
        attn_pass<64, true>(lds, P, qrow0, IC_QS + hq * 64, IC_KS + kvh * 64, VT, b * SEQ, NLAT + b * CTXL, lo, hi, sink2, 1.0f, qb * 256, o, l, wave, lane);
    }
    const float inv = 1.0f / l; const int qn = lane & 31, half = lane >> 5;
    bf16_t* dst = YA + (size_t)(qrow0 + wave * 32 + qn) * 512 + hq * 64 + 4 * half;
#pragma unroll
    for (int db = 0; db < 2; ++db)
#pragma unroll
        for (int q4 = 0; q4 < 4; ++q4) {
            const f32x4 v = (f32x4){o[db][4 * q4] * inv, o[db][4 * q4 + 1] * inv, o[db][4 * q4 + 2] * inv, o[db][4 * q4 + 3] * inv};
            *(u32x2*)(dst + 32 * db + 8 * q4) = pack4(v);
        }
}
__device__ __forceinline__ void diff_unit(LAS unsigned char* lds, const Params& p, float lam, int b, int h, int qb, bool ctx, int wave, int lane) {
    bf16_t* P = (bf16_t*)(p.ws + WS_P);
    const bf16_t* VT = (const bf16_t*)(p.ws + WS_VTD) + (size_t)((b * 4 + h) * 128) * KEYS;
    const int qrow0 = ctx ? NLAT + b * CTXL : b * SEQ + qb * 256;
    const int thi = ctx ? 0 : 128;
    LAS unsigned* park = (LAS unsigned*)(lds + 73728) + threadIdx.x;
    f32x16 o[4]; float l;
    attn_pass<128, false>(lds, P, qrow0, IC_QD + h * 128, IC_KD + h * 128, VT, b * SEQ, NLAT + b * CTXL, 0, thi, -1.0e30f, 0.f, 0, o, l, wave, lane);
    { const float inv = 1.0f / l;
#pragma unroll
      for (int db = 0; db < 4; ++db)
#pragma unroll
          for (int i = 0; i < 8; ++i) park[(db * 8 + i) * 512] = pk2(o[db][2 * i] * inv, o[db][2 * i + 1] * inv); }
    attn_pass<128, false>(lds, P, qrow0, IC_QD + h * 128 + 64, IC_KD + h * 128 + 64, VT, b * SEQ, NLAT + b * CTXL, 0, thi, -1.0e30f, 0.f, 0, o, l, wave, lane);
    const float inv = lam / l; const int qn = lane & 31, half = lane >> 5;
    bf16_t* dst = P + (size_t)(qrow0 + wave * 32 + qn) * PP + IC_QD + h * 128 + 4 * half;
#pragma unroll
    for (int db = 0; db < 4; ++db)
#pragma unroll
        for (int q4 = 0; q4 < 4; ++q4) {
            const unsigned pa = park[(db * 8 + 2 * q4) * 512], pb = park[(db * 8 + 2 * q4 + 1) * 512];
            const f32x4 v = (f32x4){bflo(pa) - o[db][4 * q4] * inv, bfhi(pa) - o[db][4 * q4 + 1] * inv, bflo(pb) - o[db][4 * q4 + 2] * inv, bfhi(pb) - o[db][4 * q4 + 3] * inv};
            *(u32x2*)(dst + 32 * db + 8 * q4) = pack4(v);
        }
}

__device__ __forceinline__ void ld8bf(const bf16_t* p, float (&v)[8]) { const u32x4 w = *(const u32x4*)p; v[0] = bflo(w.x); v[1] = bfhi(w.x); v[2] = bflo(w.y); v[3] = bfhi(w.y); v[4] = bflo(w.z); v[5] = bfhi(w.z); v[6] = bflo(w.w); v[7] = bfhi(w.w); }
__device__ __forceinline__ void ld8f(const float* p, float (&v)[8]) { const f32x4 a = ((const f32x4*)p)[0], b = ((const f32x4*)p)[1]; v[0] = a.x; v[1] = a.y; v[2] = a.z; v[3] = a.w; v[4] = b.x; v[5] = b.y; v[6] = b.z; v[7] = b.w; }
__device__ __forceinline__ void st8f(float* p, const float (&v)[8]) { ((f32x4*)p)[0] = (f32x4){v[0], v[1], v[2], v[3]}; ((f32x4*)p)[1] = (f32x4){v[4], v[5], v[6], v[7]}; }

__device__ __forceinline__ void rwkv_prepare_phase(const Params& p, int layer, int gw, int NGW, int lane) {
    const bf16_t* P = (const bf16_t*)(p.ws + WS_P); float* ST = (float*)(p.ws + WS_ST); bf16_t* A2 = (bf16_t*)(p.ws + WS_YA); float* ysum = (float*)(p.ws + WS_XN);
    const float* mup = p.in[12] + layer * 1920; const float* mun = p.in[13] + layer * 1920; const float* k_k = p.in[19] + layer * 512;
    for (int m = gw; m < NTOK; m += NGW) {
        const int t = m < NLAT ? (m & (SEQ - 1)) : ((m - NLAT) & (CTXL - 1)), len = m < NLAT ? SEQ : CTXL;
        const bool hp = t > 0, hn = t < len - 1;
        const bf16_t* pr = P + (size_t)m * PP + IC_RW;
        const int h = lane >> 3, kidx = (lane & 7) * 8;
        float* sp = ST + ((size_t)m * 8 + h) * (ST_SLOTS * 64) + kidx;
#pragma unroll
        for (int sec = 0; sec < 4; ++sec) {
            if (sec == 3 && lane >= 48) break;
            const int col = sec < 3 ? sec * 512 + lane * 8 : 1536 + lane * 8;
            float c[8], pv[8], nx[8], a[8], bb[8], sh[8];
            ld8bf(pr + col, c);
            if (hp) ld8bf(pr - PP + col, pv); else {
#pragma unroll
                for (int q = 0; q < 8; ++q) pv[q] = 0.f; }
            if (hn) ld8bf(pr + PP + col, nx); else {
#pragma unroll
                for (int q = 0; q < 8; ++q) nx[q] = 0.f; }
            ld8f(mup + col, a); ld8f(mun + col, bb);
#pragma unroll
            for (int q = 0; q < 8; ++q) sh[q] = c[q] + a[q] * (pv[q] - c[q]) + bb[q] * (nx[q] - c[q]);
            if (sec == 0) st8f(sp + 1 * 64, sh);
            else if (sec == 2) st8f(sp + 2 * 64, sh);
            else if (sec == 1) {
                st8f(sp + 5 * 64, sh); st8f(sp + 8 * 64, sh);
                float kk[8], kkw[8]; ld8f(k_k + lane * 8, kkw);
                float ss = 0.f;
#pragma unroll
                for (int q = 0; q < 8; ++q) { kk[q] = sh[q] * kkw[q]; ss += kk[q] * kk[q]; }
                ss += __shfl_xor(ss, 1); ss += __shfl_xor(ss, 2); ss += __shfl_xor(ss, 4);
                const float inv = 1.0f / fmaxf(sqrtf(ss), 1e-12f);
#pragma unroll
                for (int q = 0; q < 8; ++q) kk[q] *= inv;
                st8f(sp, kk);
            } else {
                float o[8];
#pragma unroll
                for (int q = 0; q < 8; ++q) o[q] = lane < 16 ? tanhf(sh[q]) : (lane < 32 ? sh[q] : sigmoidf_(sh[q]));
                u32x4 w; w.x = pk2(o[0], o[1]); w.y = pk2(o[2], o[3]); w.z = pk2(o[4], o[5]); w.w = pk2(o[6], o[7]);
                *(u32x4*)(A2 + (size_t)m * 384 + lane * 8) = w;
            }
        }
        ((f32x4*)(ysum + (size_t)m * 512))[lane] = (f32x4){0.f, 0.f, 0.f, 0.f};
        ((f32x4*)(ysum + (size_t)m * 512))[lane + 64] = (f32x4){0.f, 0.f, 0.f, 0.f};
    }
}

typedef const __attribute__((address_space(4))) float* cfp4;
__device__ __forceinline__ void rwkv_scan_wave(const Params& p, int sid, int lane) {
    const int b = sid >> 4, h = (sid >> 1) & 7, dir = sid & 1;
    const float* ST = (const float*)(p.ws + WS_ST); float* ysum = (float*)(p.ws + WS_XN);
    float S[64];
#pragma unroll
    for (int k = 0; k < 64; ++k) S[k] = 0.f;
    const int od = (3 + 3 * dir) * 64;
    for (int s = 0; s < KEYS; ++s) {
        int m;
        if (s < CTXL) m = NLAT + b * CTXL + (dir ? CTXL - 1 - s : s);
        else { const int t = s - CTXL; m = b * SEQ + (dir ? SEQ - 1 - t : t); }
        const float* base = ST + ((size_t)m * 8 + h) * (ST_SLOTS * 64);
        const cfp4 sb = (cfp4)(uintptr_t)base;
        const float vv = base[128 + lane];
        float sa0 = 0.f, sa1 = 0.f, sa2 = 0.f, sa3 = 0.f;
#pragma unroll
        for (int k = 0; k < 64; k += 4) { sa0 = fmaf(S[k], sb[k], sa0); sa1 = fmaf(S[k + 1], sb[k + 1], sa1); sa2 = fmaf(S[k + 2], sb[k + 2], sa2); sa3 = fmaf(S[k + 3], sb[k + 3], sa3); }
        const float sa = (sa0 + sa1) + (sa2 + sa3);
        float y0 = 0.f, y1 = 0.f, y2 = 0.f, y3 = 0.f;
#pragma unroll
        for (int k = 0; k < 64; k += 4) {
#pragma unroll
            for (int q = 0; q < 4; ++q) {
                float tq = vv * sb[od + 128 + k + q];
                tq = fmaf(sa, sb[od + 64 + k + q], tq);
                S[k + q] = fmaf(S[k + q], sb[od + k + q], tq);
            }
            y0 = fmaf(S[k], sb[64 + k], y0); y1 = fmaf(S[k + 1], sb[64 + k + 1], y1); y2 = fmaf(S[k + 2], sb[64 + k + 2], y2); y3 = fmaf(S[k + 3], sb[64 + k + 3], y3);
        }
        __hip_atomic_fetch_add(ysum + (size_t)m * 512 + h * 64 + lane, (y0 + y1) + (y2 + y3), __ATOMIC_RELAXED, __HIP_MEMORY_SCOPE_AGENT);
    }
}

__device__ __forceinline__ void postmix_phase(const Params& p, int layer, float lam_init, int M, int gw, int NGW, int lane) {
    const bf16_t* P = (const bf16_t*)(p.ws + WS_P); const float* ST = (const float*)(p.ws + WS_ST); const float* ysum = (const float*)(p.ws + WS_XN);
    bf16_t* YB = (bf16_t*)(p.ws + WS_YB); bf16_t* YC = (bf16_t*)(p.ws + WS_YC);
    const float* r_k = p.in[21] + layer * 512; const float* lng = p.in[22] + layer * 512; const float* lnb = p.in[23] + layer * 512; const float* sg = p.in[25] + layer * 128;
    for (int m = gw; m < M; m += NGW) {
        {
            const int h = lane >> 3, kidx = (lane & 7) * 8, ch = lane * 8;
            const float* sp = ST + ((size_t)m * 8 + h) * (ST_SLOTS * 64) + kidx;
            float y[8], r[8], v[8], k0[8], k1[8], rk[8], g[8], lg[8], lb[8];
            ld8f(ysum + (size_t)m * 512 + ch, y); ld8f(sp + 64, r); ld8f(sp + 128, v); ld8f(sp + 5 * 64, k0); ld8f(sp + 8 * 64, k1); ld8f(r_k + ch, rk); ld8f(lng + ch, lg); ld8f(lnb + ch, lb);
            ld8bf(P + (size_t)m * PP + IC_RW + ch, g);
            float s = 0.f, bn = 0.f;
#pragma unroll
            for (int q = 0; q < 8; ++q) { s += y[q]; bn += r[q] * (k0[q] + k1[q]) * rk[q]; }
            s += __shfl_xor(s, 1); s += __shfl_xor(s, 2); s += __shfl_xor(s, 4);
            bn += __shfl_xor(bn, 1); bn += __shfl_xor(bn, 2); bn += __shfl_xor(bn, 4);
            const float mu = s * (1.0f / 64.0f);
            float var = 0.f;
#pragma unroll
            for (int q = 0; q < 8; ++q) { const float d = y[q] - mu; var += d * d; }
            var += __shfl_xor(var, 1); var += __shfl_xor(var, 2); var += __shfl_xor(var, 4);
            const float rstd = 1.0f / sqrtf(var * (1.0f / 64.0f) + 64e-5f);
            float o[8];
#pragma unroll
            for (int q = 0; q < 8; ++q) o[q] = (((y[q] - mu) * rstd) * lg[q] + lb[q] + bn * v[q]) * g[q];
            u32x4 w; w.x = pk2(o[0], o[1]); w.y = pk2(o[2], o[3]); w.z = pk2(o[4], o[5]); w.w = pk2(o[6], o[7]);
            *(u32x4*)(YB + (size_t)m * 512 + ch) = w;
        }
        {
            const int e = (lane & 15) * 8;
            float x[8], gg[8];
            ld8bf(P + (size_t)m * PP + IC_QD + lane * 8, x); ld8f(sg + e, gg);
            float ss = 0.f;
#pragma unroll
            for (int q = 0; q < 8; ++q) ss += x[q] * x[q];
            ss += __shfl_xor(ss, 1); ss += __shfl_xor(ss, 2); ss += __shfl_xor(ss, 4); ss += __shfl_xor(ss, 8);
            const float rstd = (1.0f - lam_init) / sqrtf(ss * (1.0f / 128.0f) + 1e-5f);
            float o[8];
#pragma unroll
            for (int q = 0; q < 8; ++q) o[q] = x[q] * rstd * gg[q];
            u32x4 w; w.x = pk2(o[0], o[1]); w.y = pk2(o[2], o[3]); w.z = pk2(o[4], o[5]); w.w = pk2(o[6], o[7]);
            *(u32x4*)(YC + (size_t)m * 512 + lane * 8) = w;
        }
    }
}

constexpr int CW_DBG = 256;
__device__ __forceinline__ void dbg_max(const Params& p, int slot, float v) { atomicMax((unsigned*)(p.ws + WS_CTL) + CW_DBG + slot, __float_as_uint(fabsf(v))); }
__device__ __forceinline__ void dbg_cmp(const Params& p, int ch, float fast, float ref) { dbg_max(p, 2 * ch, fast - ref); dbg_max(p, 2 * ch + 1, ref); }
__device__ __forceinline__ float dbg_bf(const bf16_t* q) { return __uint_as_float((unsigned)(*q) << 16); }
__device__ __forceinline__ float dbg_shift(const Params& p, int layer, int m, int c) {
    const bf16_t* P = (const bf16_t*)(p.ws + WS_P);
    const int t = m < NLAT ? (m & (SEQ - 1)) : ((m - NLAT) & (CTXL - 1)), len = m < NLAT ? SEQ : CTXL;
    const float cur = dbg_bf(P + (size_t)m * PP + IC_RW + c);
    const float pv = t > 0 ? dbg_bf(P + (size_t)(m - 1) * PP + IC_RW + c) : 0.f, nx = t < len - 1 ? dbg_bf(P + (size_t)(m + 1) * PP + IC_RW + c) : 0.f;
    return cur + p.in[12][layer * 1920 + c] * (pv - cur) + p.in[13][layer * 1920 + c] * (nx - cur);
}
__device__ __forceinline__ int dbg_sample_token(int i) {
    static constexpr int fixed[12] = {0, 1, 8191, 8192, 8193, 16383, 16384, 16385, 16639, 16640, 16641, 16895};
    if (i < 12) return fixed[i];
    return (int)(((unsigned)i * 2654435761u) % (unsigned)NTOK);
}
__device__ void dbg_check_stream(const Params& p, int layer, int bid, int G, int tid) {
    const float* ST = (const float*)(p.ws + WS_ST); const bf16_t* P = (const bf16_t*)(p.ws + WS_P);
    for (int it = bid * NTHREADS + tid; it < 48 * 512; it += G * NTHREADS) {
        const int m = dbg_sample_token(it >> 9), ch = it & 511, h = ch >> 6, k = ch & 63;
        const float* sp = ST + ((size_t)m * 8 + h) * (ST_SLOTS * 64) + k;
        const float r = dbg_shift(p, layer, m, ch), kr = dbg_shift(p, layer, m, 512 + ch), v = dbg_shift(p, layer, m, 1024 + ch);
        float ss = 0.f;
        for (int q = 0; q < 64; ++q) { const float x = dbg_shift(p, layer, m, 512 + h * 64 + q) * p.in[19][layer * 512 + h * 64 + q]; ss += x * x; }
        const float kk = kr * p.in[19][layer * 512 + ch] / fmaxf(sqrtf(ss), 1e-12f);
        (void)r; (void)v;
        float g = 0.f;
        { const bf16_t* A2 = (const bf16_t*)(p.ws + WS_YA); const bf16_t* LT = (const bf16_t*)(p.ws + WS_LORA);
          for (int j = 0; j < 384; ++j) g += dbg_bf(A2 + (size_t)m * 384 + j) * dbg_bf(LT + (size_t)(2048 + ch) * 384 + j);
          if (ch < 384) { const float s = dbg_shift(p, layer, m, 1536 + ch); const float ref = ch < 128 ? tanhf(s) : (ch < 256 ? s : sigmoidf_(s)); dbg_cmp(p, 0, dbg_bf(A2 + (size_t)m * 384 + ch), ref); } }
        dbg_cmp(p, 1, dbg_bf(P + (size_t)m * PP + IC_RW + ch), g);
        for (int d = 0; d < 2; ++d) {
            float wr = p.in[14][(layer * 2 + d) * 512 + ch], ar = p.in[16][(layer * 2 + d) * 512 + ch];
            for (int j = 0; j < 64; ++j) {
                wr += tanhf(dbg_shift(p, layer, m, 1536 + d * 64 + j)) * p.in[15][(((size_t)layer * 2 + d) * 64 + j) * 512 + ch];
                ar += dbg_shift(p, layer, m, 1664 + d * 64 + j) * p.in[17][(((size_t)layer * 2 + d) * 64 + j) * 512 + ch];
            }
            const float wl = -log1pf(expf(-wr)) - 0.5f, dec = expf(-expf(wl)), ag = 1.0f / (1.0f + expf(-ar));
            (void)dec;
        }
    }
}
__device__ void dbg_check_scan(const Params& p, int bid, int tid, LAS unsigned char* lds) {
    { LAS volatile int* f0 = (LAS volatile int*)(lds + 140000); if (tid < 2) f0[tid] = 0; __syncthreads(); }
    if (bid >= 2 || tid >= 128) return;
    const int b = bid == 0 ? 0 : 1, h = bid == 0 ? 0 : 5, dir = tid >> 6, lane = tid & 63;
    const float* ST = (const float*)(p.ws + WS_ST); const float* ysum = (const float*)(p.ws + WS_XN);
    float* scratch = (float*)(p.ws + WS_YB) + (size_t)(bid * 2 + dir) * KEYS * 64;
    float S[64];
#pragma unroll
    for (int k = 0; k < 64; ++k) S[k] = 0.f;
    const int od = (3 + 3 * dir) * 64;
    for (int s = 0; s < KEYS; ++s) {
        int m;
        if (s < CTXL) m = NLAT + b * CTXL + (dir ? CTXL - 1 - s : s);
        else { const int t = s - CTXL; m = b * SEQ + (dir ? SEQ - 1 - t : t); }
        const float* base = ST + ((size_t)m * 8 + h) * (ST_SLOTS * 64);
        const float vv = base[128 + lane];
        float sa = 0.f;
#pragma unroll
        for (int k = 0; k < 64; ++k) sa += S[k] * (-base[k]);
        float y = 0.f;
#pragma unroll
        for (int k = 0; k < 64; ++k) { S[k] = S[k] * base[od + k] + sa * (-base[od + 64 + k]) + vv * base[od + 128 + k]; y += S[k] * base[64 + k]; }
        scratch[(size_t)m * 0 + (size_t)s * 64 + lane] = y;
    }
    __threadfence_block();
    asm volatile("s_waitcnt vmcnt(0)" ::: "memory");
    LAS volatile int* flag = (LAS volatile int*)(lds + 140000);
    if (lane == 0) flag[dir] = 1;
    while (flag[0] == 0 || flag[1] == 0) __builtin_amdgcn_s_sleep(8);
    __threadfence_block();
    if (dir == 0) {
        const float* yf = (const float*)(p.ws + WS_YB) + (size_t)(bid * 2 + 0) * KEYS * 64; const float* yb = (const float*)(p.ws + WS_YB) + (size_t)(bid * 2 + 1) * KEYS * 64;
        for (int s = 0; s < KEYS; ++s) {
            int m, sb;
            if (s < CTXL) { m = NLAT + b * CTXL + s; sb = CTXL - 1 - s; } else { const int t = s - CTXL; m = b * SEQ + t; sb = CTXL + (SEQ - 1 - t); }
            const float ref = yf[(size_t)s * 64 + lane] + __builtin_nontemporal_load(yb + (size_t)sb * 64 + lane);
            dbg_cmp(p, 0, ysum[(size_t)m * 512 + h * 64 + lane], ref);
        }
    }
}
__device__ void dbg_check_attn(const Params& p, int layer, float lam, int gw, int NGW, int lane, bool with_ctx) {
    const bf16_t* P = (const bf16_t*)(p.ws + WS_P); const bf16_t* YA = (const bf16_t*)(p.ws + WS_YA);
    static constexpr int tl[16] = {0, 1, 63, 64, 127, 128, 129, 255, 256, 300, 4095, 4096, 8000, 8063, 8064, 8191};
    for (int it = gw; it < 2 * 16 * 8 + (with_ctx ? 2 * 4 * 8 : 0); it += NGW) {
        int b, t, hq; bool ctxq = false;
        if (it < 256) { b = it >> 7; t = tl[(it >> 3) & 15]; hq = it & 7; } else { const int v = it - 256; ctxq = true; b = v >> 5; t = ((v >> 3) & 3) * 85; hq = v & 7; }
        const int kvh = hq >> 2, qrow = ctxq ? NLAT + b * CTXL + t : b * SEQ + t;
        const bf16_t* VT = (const bf16_t*)(p.ws + WS_VTS) + (size_t)((b * 2 + kvh) * 64) * KEYS;
        const float qd = dbg_bf(P + (size_t)qrow * PP + IC_QS + hq * 64 + lane);
        const float sink = p.in[11][layer * 8 + hq];
        float mx = sink, den = 0.f, acc = 0.f;
        for (int pass = 0; pass < 2; ++pass) {
            for (int j = 0; j < KEYS; ++j) {
                if (j < SEQ) { if (ctxq) continue; const int d = j - t; if (d > 128 || d < -128) continue; }
                const int krow = j < SEQ ? b * SEQ + j : NLAT + b * CTXL + (j - SEQ);
                float s = wave_sum(qd * dbg_bf(P + (size_t)krow * PP + IC_KS + kvh * 64 + lane)) * 0.125f;
                if (pass == 0) mx = fmaxf(mx, s); else { const float e = expf(s - mx); den += e; acc += e * dbg_bf(VT + (size_t)lane * KEYS + j); }
            }
        }
        den += expf(sink - mx);
        dbg_cmp(p, 0, dbg_bf(YA + (size_t)qrow * 512 + hq * 64 + lane), acc / den);
    }
    for (int it = gw; it < 2 * 16 * 4 + (with_ctx ? 2 * 4 * 4 : 0); it += NGW) {
        int b, t, h; bool ctxq = false;
        if (it < 128) { b = it >> 6; t = tl[(it >> 2) & 15]; h = it & 3; } else { const int v = it - 128; ctxq = true; b = v >> 4; t = ((v >> 2) & 3) * 85; h = v & 3; }
        const int qrow = ctxq ? NLAT + b * CTXL + t : b * SEQ + t;
        const bf16_t* VT = (const bf16_t*)(p.ws + WS_VTD) + (size_t)((b * 4 + h) * 128) * KEYS;
        float res0 = 0.f, res1 = 0.f;
        for (int c = 0; c < 2; ++c) {
            const bf16_t* QS = (const bf16_t*)(p.ws + WS_YC);
            const float qd = dbg_bf(QS + (size_t)qrow * 512 + (h * 2 + c) * 64 + lane);
            float mx = -1e30f, den = 0.f, a0 = 0.f, a1 = 0.f;
            for (int pass = 0; pass < 2; ++pass) {
                for (int j = ctxq ? SEQ : 0; j < KEYS; ++j) {
                    const int krow = j < SEQ ? b * SEQ + j : NLAT + b * CTXL + (j - SEQ);
                    float s = wave_sum(qd * dbg_bf(P + (size_t)krow * PP + IC_KD + (h * 2 + c) * 64 + lane)) * 0.125f;
                    if (pass == 0) mx = fmaxf(mx, s); else { const float e = expf(s - mx); den += e; a0 += e * dbg_bf(VT + (size_t)lane * KEYS + j); a1 += e * dbg_bf(VT + (size_t)(lane + 64) * KEYS + j); }
                }
            }
            const float sg = c == 0 ? 1.0f : -lam;
            res0 += sg * a0 / den; res1 += sg * a1 / den;
        }
        dbg_cmp(p, 1, dbg_bf(P + (size_t)qrow * PP + IC_QD + h * 128 + lane), res0);
        dbg_cmp(p, 1, dbg_bf(P + (size_t)qrow * PP + IC_QD + h * 128 + 64 + lane), res1);
    }
}
__device__ void dbg_save_qdiff(const Params& p, int gw, int NGW, int lane) {
    const bf16_t* P = (const bf16_t*)(p.ws + WS_P); bf16_t* QS = (bf16_t*)(p.ws + WS_YC);
    for (int m = gw; m < NTOK; m += NGW) *(u32x4*)(QS + (size_t)m * 512 + lane * 8) = *(const u32x4*)(P + (size_t)m * PP + IC_QD + lane * 8);
}
__device__ void dbg_emit(const Params& p, int bid, int G, int tid) {
    const unsigned* d = (const unsigned*)(p.ws + WS_CTL) + CW_DBG;
    const float eA = __uint_as_float(d[0]) / fmaxf(__uint_as_float(d[1]), 1e-30f), eB = __uint_as_float(d[2]) / fmaxf(__uint_as_float(d[3]), 1e-30f);
    for (size_t i = (size_t)bid * NTHREADS + tid; i < (size_t)NLAT * DM; i += (size_t)G * NTHREADS) {
        float v = p.in[0][i];
        if (i == 0) v += 1e5f * fminf(eA, 1e4f);
        if (i >= 4096 && i < 4096 + (1u << 20)) v += 1e3f * fminf(eB, 1e4f);
        p.out[i] = v;
    }
}

__device__ void dbg_check_lora_t(const Params& p, int layer, int bid, int G, int tid) {
    const bf16_t* LT = (const bf16_t*)(p.ws + WS_LORA);
    for (int i = bid * NTHREADS + tid; i < 2560 * 384; i += G * NTHREADS) {
        const int n = i / 384, k = i % 384, reg = n >> 9, nn = n & 511;
        float ref = 0.f;
        if (reg == 0 && k < 64) ref = p.in[15][(((size_t)layer * 2 + 0) * 64 + k) * 512 + nn];
        if (reg == 1 && k >= 64 && k < 128) ref = p.in[15][(((size_t)layer * 2 + 1) * 64 + (k - 64)) * 512 + nn];
        if (reg == 2 && k >= 128 && k < 192) ref = p.in[17][(((size_t)layer * 2 + 0) * 64 + (k - 128)) * 512 + nn];
        if (reg == 3 && k >= 192 && k < 256) ref = p.in[17][(((size_t)layer * 2 + 1) * 64 + (k - 192)) * 512 + nn];
        if (reg == 4 && k >= 256) ref = p.in[18][((size_t)layer * 128 + (k - 256)) * 512 + nn];
        dbg_cmp(p, reg == 4 ? 1 : 0, dbg_bf(LT + (size_t)n * 384 + k), ref);
    }
}

__device__ void dbg_save_gup(const Params& p, int bid, int G, int tid) {
    float* sv = (float*)(p.ws + WS_YB);
    for (int i = bid * NTHREADS + tid; i < 128 * 512; i += G * NTHREADS) sv[i] = p.in[18][i];
}
__device__ void dbg_check_gup(const Params& p, int bid, int G, int tid) {
    const float* sv = (const float*)(p.ws + WS_YB); const bf16_t* LT = (const bf16_t*)(p.ws + WS_LORA);
    for (int i = bid * NTHREADS + tid; i < 128 * 512; i += G * NTHREADS) {
        dbg_cmp(p, 0, dbg_bf(LT + (size_t)(2048 + (i & 511)) * 384 + 256 + (i >> 9)) + 1.0f, 1.0f);
        const int k = i >> 9, nn = i & 511;
        dbg_cmp(p, 1, dbg_bf(LT + (size_t)(2048 + nn) * 384 + 256 + k), sv[i]);
    }
}

#ifndef MK_MULTI
#define MK_MULTI 0
#endif
constexpr int N_PHASES = 40;

constexpr int LDS_PARAMS = LDS_BYTES - 1024;
__device__ __forceinline__ unsigned long long uni64(unsigned long long v) {
    const unsigned lo = __builtin_amdgcn_readfirstlane((unsigned)v), hi = __builtin_amdgcn_readfirstlane((unsigned)(v >> 32));
    return ((unsigned long long)hi << 32) | lo;
}
__device__ __forceinline__ int opq(int v) { asm volatile("" : "+s"(v)); return v; }
__device__ __forceinline__ void load_params(LAS unsigned char* lds, Params& q) {
    LAS const unsigned long long* s = (LAS const unsigned long long*)(lds + LDS_PARAMS);
#pragma unroll
    for (int i = 0; i < 37; ++i) q.in[i] = (const float*)(const __attribute__((address_space(1))) float*)uni64(s[i]);
    q.out = (float*)(__attribute__((address_space(1))) float*)uni64(s[37]); q.ws = (unsigned char*)(__attribute__((address_space(1))) unsigned char*)uni64(s[38]); q.ph_lo = 0; q.ph_hi = 0;
}
__global__ void __launch_bounds__(NTHREADS, 2) mk_fwd(Params kp) {
    extern __shared__ __attribute__((aligned(16))) unsigned char lds_raw[];
    LAS unsigned char* lds = (LAS unsigned char*)lds_raw;
    cg::grid_group grid = cg::this_grid();
    if (threadIdx.x == 0) {
        LAS unsigned long long* s = (LAS unsigned long long*)(lds + LDS_PARAMS);
#pragma unroll
        for (int i = 0; i < 37; ++i) s[i] = (unsigned long long)kp.in[i];
        s[37] = (unsigned long long)kp.out; s[38] = (unsigned long long)kp.ws;
    }
    __syncthreads();
    const int ph_lo = kp.ph_lo, ph_hi = kp.ph_hi;
    int ph = 0;
#define PH_BEGIN if (ph >= ph_lo && ph < ph_hi) { asm volatile("" ::: "memory"); Params p; load_params(lds, p); unsigned char* ws = p.ws; (void)ws; \
    int tid_ = threadIdx.x, bid_ = blockIdx.x, G_ = gridDim.x; asm volatile("" : "+v"(tid_), "+s"(bid_), "+s"(G_)); \
    const int tid = tid_, bid = bid_, G = G_, lane = tid & 63, wave = __builtin_amdgcn_readfirstlane(tid >> 6); const int gw = bid * NWAVES + wave, NGW = G * NWAVES; (void)gw; (void)NGW; (void)lane; (void)tid; (void)G; (void)bid;
#define PH_END } if (ph >= ph_lo && ph + 1 < ph_hi) grid.sync(); ++ph;
    using pg8::Gemm; using pg8::StaticOrder; using pg8::gemm_phase;

    PH_BEGIN
        convert_layer_weights(p, 0, lds, gw, NGW, wave, lane);
#if DBG_SEL == 1
        dbg_save_gup(p, bid, G, tid);
#endif
        __syncthreads();
        adaln_phase(p, lds, wave, lane);
    PH_END
    PH_BEGIN
        premix_phase(p, 0, true, NTOK, gw, NGW, lane);
    PH_END

    for (int layer = 0; layer < 2; ++layer) {
        const int Ml = layer == 0 ? NTOK : NLAT;
        const float lam_init = 0.8f - 0.6f * expf(-0.3f * (float)layer);
        PH_BEGIN
            Gemm g{(const bf16_t*)(ws + WS_XN), (const bf16_t*)(ws + WS_WIN), NTOK, NIN1, opq(1024)}; StaticOrder S; S.init(NTOK, NIN1, G, bid);
            EpiIn E{(bf16_t*)(ws + WS_P), (bf16_t*)(ws + WS_VTS), (bf16_t*)(ws + WS_VTD), (const float*)(ws + WS_ROPE)};
            gemm_phase<EpiIn, StaticOrder, true, true>(lds, g, S, E);
        PH_END
        PH_BEGIN
            rwkv_prepare_phase(p, layer, gw, NGW, lane);
        PH_END
        PH_BEGIN
            Gemm g{(const bf16_t*)(ws + WS_YA), (const bf16_t*)(ws + WS_LORA), NTOK, 2560, opq(384)}; StaticOrder S; S.init(NTOK, 2560, G, bid);
            EpiLora E{(float*)(ws + WS_ST), (bf16_t*)(ws + WS_P), p.in[14] + layer * 1024, p.in[16] + layer * 1024, p.in[20] + layer * 512};
            gemm_phase<EpiLora, StaticOrder, true, true>(lds, g, S, E);
        PH_END
#if DBG_SEL == 1
        PH_BEGIN
            dbg_check_gup(p, bid, G, tid);
        PH_END
#endif
#if DBG_SEL == 2
        PH_BEGIN
            dbg_save_qdiff(p, gw, NGW, lane);
        PH_END
#endif
        PH_BEGIN
            if (bid < 32 && wave == 0) rwkv_scan_wave(p, bid, lane);
            __syncthreads();
            float lam;
            { const float* lv = p.in[24] + layer * 256;
              const float s1 = wave_sum(lv[lane] * lv[64 + lane]), s2 = wave_sum(lv[128 + lane] * lv[192 + lane]);
              lam = expf(s1) - expf(s2) + lam_init; }
            unsigned* qhead = (unsigned*)(ws + WS_CTL) + (layer == 0 ? CW_Q0 : CW_Q1);
            LAS int* ubox = (LAS int*)(lds + 65536);
            const int n_diff = 64, n_swa = 512, n_ctx = layer == 0 ? 24 : 0;
            const int n_units = 256 + 512 + n_ctx; (void)n_diff; (void)n_swa;
            for (;;) {
                if (tid == 0) ubox[0] = (int)atomicAdd(qhead, 1u);
                __syncthreads();
                const int u = ubox[0];
                __syncthreads();
                if (u >= n_units) break;
                if (u < 256) diff_unit(lds, p, lam, u >> 7, (u >> 5) & 3, u & 31, false, wave, lane);
                else if (u < 768) { const int v = u - 256; swa_unit(lds, p, layer, v >> 8, (v >> 5) & 7, v & 31, false, wave, lane); }
                else if (u < 776) { const int v = u - 768; diff_unit(lds, p, lam, v >> 2, v & 3, 0, true, wave, lane); }
                else { const int v = u - 776; swa_unit(lds, p, layer, v >> 3, v & 7, 0, true, wave, lane); }
            }
        PH_END

#if DBG_SEL == 2
        PH_BEGIN
            float lam;
            { const float* lv = p.in[24] + layer * 256;
              const float s1 = wave_sum(lv[lane] * lv[64 + lane]), s2 = wave_sum(lv[128 + lane] * lv[192 + lane]);
              lam = expf(s1) - expf(s2) + lam_init; }
            dbg_check_attn(p, layer, lam, gw, NGW, lane, layer == 0);
        PH_END
#endif
#if DBG_SEL == 1 || DBG_SEL == 2
        PH_BEGIN
            dbg_emit(p, bid, G, tid);
        PH_END
        return;
#endif
        PH_BEGIN
            postmix_phase(p, layer, lam_init, Ml, gw, NGW, lane);
        PH_END
        PH_BEGIN
            premix_phase(p, layer, layer == 0, Ml, gw, NGW, lane);
            if (layer == 0) convert_ffn_weights(p, lds, gw, NGW, wave, lane);
        PH_END
        PH_BEGIN
            Gemm g{(const bf16_t*)(ws + WS_XN), (const bf16_t*)(ws + WS_WIN) + (size_t)NIN1 * 1024, Ml, 3072, opq(1024)}; StaticOrder S; S.init(Ml, 3072, G, bid);
            EpiGate E{(bf16_t*)(ws + WS_G)};
            gemm_phase<EpiGate, StaticOrder, true, true>(lds, g, S, E);
        PH_END
        PH_BEGIN
            StaticOrder S; S.init(Ml, 1024, G, bid);
            { Gemm g{(const bf16_t*)(ws + WS_YA), (const bf16_t*)(ws + WS_PRJ), Ml, 1024, opq(512)}; EpiMerge<0> E{(const bf16_t*)(ws + WS_G), (float*)(ws + WS_MF), (bf16_t*)(ws + WS_MB)};
              gemm_phase<EpiMerge<0>, StaticOrder, true, true>(lds, g, S, E); }
            { Gemm g{(const bf16_t*)(ws + WS_YB), (const bf16_t*)(ws + WS_PRJ) + 1024 * 512, Ml, 1024, opq(512)}; EpiMerge<1> E{(const bf16_t*)(ws + WS_G), (float*)(ws + WS_MF), (bf16_t*)(ws + WS_MB)};
              gemm_phase<EpiMerge<1>, StaticOrder, true, true>(lds, g, S, E); }
            { Gemm g{(const bf16_t*)(ws + WS_YC), (const bf16_t*)(ws + WS_PRJ) + 2 * 1024 * 512, Ml, 1024, opq(512)}; EpiMerge<2> E{(const bf16_t*)(ws + WS_G), (float*)(ws + WS_MF), (bf16_t*)(ws + WS_MB)};
              gemm_phase<EpiMerge<2>, StaticOrder, true, true>(lds, g, S, E); }
        PH_END
        PH_BEGIN
            Gemm g{(const bf16_t*)(ws + WS_MB), (const bf16_t*)(ws + WS_WOUT), Ml, 1024, opq(1024)}; StaticOrder S; S.init(Ml, 1024, G, bid);
            EpiF32 E{(float*)(ws + WS_MOUT), 1024};
            gemm_phase<EpiF32, StaticOrder, true, true>(lds, g, S, E);
        PH_END
        PH_BEGIN
            residual_phase(p, (const float*)(ws + WS_MOUT), nullptr, nullptr, layer == 0, layer, 2, p.in[7] + layer * 1024, true, p.in[8] + layer * 1024, layer, 3, layer == 1, Ml, gw, NGW, lane);
            if (layer == 0) convert_layer_weights(p, 1, lds, gw, NGW, wave, lane);
            else convert_moe_weights(p, lds, gw, NGW, wave, lane);
        PH_END
        if (layer == 0) {
            PH_BEGIN
                Gemm g{(const bf16_t*)(ws + WS_XN), (const bf16_t*)(ws + WS_FGU), NTOK, 2 * D_FF, opq(1024)}; StaticOrder S; S.init(NTOK, 2 * D_FF, G, bid);
                EpiSwiglu E{(bf16_t*)(ws + WS_HID), D_FF, 1 << 20, 0};
                gemm_phase<EpiSwiglu, StaticOrder, true, true>(lds, g, S, E);
            PH_END
            PH_BEGIN
                Gemm g{(const bf16_t*)(ws + WS_HID), (const bf16_t*)(ws + WS_FD), NTOK, 1024, opq(D_FF)}; StaticOrder S; S.init(NTOK, 1024, G, bid);
                EpiF32 E{(float*)(ws + WS_MF), 1024};
                gemm_phase<EpiF32, StaticOrder, true, true>(lds, g, S, E);
            PH_END
            PH_BEGIN
                residual_phase(p, (const float*)(ws + WS_MF), nullptr, nullptr, false, 0, 5, p.in[9], true, p.in[6] + 1024, 1, 0, false, NTOK, gw, NGW, lane);
            PH_END
        }
    }
    {
        {
            PH_BEGIN
                const unsigned* cnt = (const unsigned*)(ws + WS_CTL) + CW_CNT; int ts[9]; ts[0] = 0;
#pragma unroll
                for (int e = 0; e < 8; ++e) ts[e + 1] = ts[e] + (int)((__hip_atomic_load(cnt + e, __ATOMIC_RELAXED, __HIP_MEMORY_SCOPE_AGENT) + 255u) >> 8);
                const int* LIST = (const int*)(ws + WS_LIST); const bf16_t* XN = (const bf16_t*)(ws + WS_XN); bf16_t* XG = (bf16_t*)(ws + WS_XG);
                for (int r = gw; r < ts[8] * 256; r += NGW) {
                    const int tile = r >> 8; int e = 0;
#pragma unroll
                    for (int q = 1; q < 8; ++q) e += (tile >= ts[q]) ? 1 : 0;
                    int tse = 0;
#pragma unroll
                    for (int q = 0; q < 8; ++q) tse = (q == e) ? ts[q] : tse;
                    const int slot = r - tse * 256;
                    u32x4 v0 = (u32x4){0u, 0u, 0u, 0u}, v1 = v0;
                    if (slot < (int)cnt[e]) { const int tk = LIST[e * 16384 + slot]; const u32x4* src = (const u32x4*)(XN + (size_t)(tk >> 1) * 1024); v0 = src[lane]; v1 = src[lane + 64]; }
                    u32x4* dst = (u32x4*)(XG + (size_t)r * 1024); dst[lane] = v0; dst[lane + 64] = v1;
                }
            PH_END
            for (int hf = 0; hf < 2; ++hf) {
                PH_BEGIN
                    const unsigned* cnt = (const unsigned*)(ws + WS_CTL) + CW_CNT; int ts[9]; ts[0] = 0;
#pragma unroll
                    for (int e = 0; e < 8; ++e) ts[e + 1] = ts[e] + (int)((__hip_atomic_load(cnt + e, __ATOMIC_RELAXED, __HIP_MEMORY_SCOPE_AGENT) + 255u) >> 8);
                    MoeSched S;
#pragma unroll
                    for (int e = 0; e < 9; ++e) S.ts[e] = ts[e];
                    S.pm_lo = hf * MOE_HALF; S.pm_hi = ts[8] < (hf + 1) * MOE_HALF ? ts[8] : (hf + 1) * MOE_HALF; if (S.pm_hi < S.pm_lo) S.pm_hi = S.pm_lo;
                    S.npn = 28; S.G = G; S.c = bid; S.a_local = false;
                    Gemm g{(const bf16_t*)(ws + WS_XG), (const bf16_t*)(ws + WS_MGU), 0, 0, opq(1024)};
                    EpiSwiglu E{(bf16_t*)(ws + WS_HIDM), D_FFE, 28, hf * MOE_HALF};
                    gemm_phase<EpiSwiglu, MoeSched, true, true>(lds, g, S, E);
                PH_END
                PH_BEGIN
                    const unsigned* cnt = (const unsigned*)(ws + WS_CTL) + CW_CNT; int ts[9]; ts[0] = 0;
#pragma unroll
                    for (int e = 0; e < 8; ++e) ts[e + 1] = ts[e] + (int)((__hip_atomic_load(cnt + e, __ATOMIC_RELAXED, __HIP_MEMORY_SCOPE_AGENT) + 255u) >> 8);
                    MoeSched S;
#pragma unroll
                    for (int e = 0; e < 9; ++e) S.ts[e] = ts[e];
                    S.pm_lo = hf * MOE_HALF; S.pm_hi = ts[8] < (hf + 1) * MOE_HALF ? ts[8] : (hf + 1) * MOE_HALF; if (S.pm_hi < S.pm_lo) S.pm_hi = S.pm_lo;
                    S.npn = 4; S.G = G; S.c = bid; S.a_local = true;
                    Gemm g{(const bf16_t*)(ws + WS_HIDM), (const bf16_t*)(ws + WS_MD), 0, 0, opq(D_FFE)};
                    EpiMoeDown E; E.FS = (float*)(ws + WS_FSLOT); E.LIST = (const int*)(ws + WS_LIST); E.WTS = (const float*)(ws + WS_WTS); E.cnt = cnt; E.pm_lo = hf * MOE_HALF;
#pragma unroll
                    for (int e = 0; e < 9; ++e) E.ts[e] = ts[e];
                    gemm_phase<EpiMoeDown, MoeSched, true, true>(lds, g, S, E);
                PH_END
            }
            PH_BEGIN
                residual_phase(p, (const float*)(ws + WS_FSLOT), (const float*)(ws + WS_FSLOT) + (size_t)NLAT * 1024, nullptr, false, 1, 5, p.in[9] + 1024, false, nullptr, 0, 0, false, NLAT, gw, NGW, lane);
            PH_END
        }
    }
#undef PH_BEGIN
#undef PH_END
}

extern "C" void kernel_launch(void* const* d_in, const int* in_sizes, int n_in, void* d_out, int out_size, void* d_ws, size_t ws_size, hipStream_t stream) {
    static int grid = 0;
    if (grid == 0) {
        if (n_in != 37 || out_size != NLAT * DM || ws_size < WS_NEED) { fprintf(stderr, "kernel_launch: unexpected shapes (n_in %d out %d ws %zu need %zu)\n", n_in, out_size, ws_size, (size_t)WS_NEED); grid = -1; return; }
        int dev = 0, cus = 0, per_cu = 0;
        (void)hipGetDevice(&dev);
        (void)hipDeviceGetAttribute(&cus, hipDeviceAttributeMultiprocessorCount, dev);
        (void)hipFuncSetAttribute((const void*)mk_fwd, hipFuncAttributeMaxDynamicSharedMemorySize, LDS_BYTES);
        (void)hipOccupancyMaxActiveBlocksPerMultiprocessor(&per_cu, (const void*)mk_fwd, NTHREADS, LDS_BYTES);
        if (per_cu < 1) { fprintf(stderr, "kernel_launch: occupancy query reports %d blocks per CU\n", per_cu); grid = -1; return; }
        grid = cus;
        fprintf(stderr, "kernel_launch: grid %d (cus %d, per_cu %d), ws %zu\n", grid, cus, per_cu, ws_size);
    }
    if (grid < 0) return;
    (void)hipMemsetAsync((char*)d_ws + WS_CTL, 0, CTL_BYTES, stream);
    Params prm{};
    for (int i = 0; i < 37; ++i) prm.in[i] = (const float*)d_in[i];
    prm.out = (float*)d_out; prm.ws = (unsigned char*)d_ws;
#if MK_MULTI
    for (int ph = 0; ph < N_PHASES; ++ph) { prm.ph_lo = ph; prm.ph_hi = ph + 1; hipLaunchKernelGGL(mk_fwd, dim3(grid), dim3(NTHREADS), LDS_BYTES, stream, prm); }
#else
    prm.ph_lo = 0; prm.ph_hi = 1 << 20;
    void* args[] = {&prm};
    hipError_t e = hipLaunchCooperativeKernel((const void*)mk_fwd, dim3(grid), dim3(NTHREADS), args, LDS_BYTES, stream);
    if (e != hipSuccess) fprintf(stderr, "kernel_launch: cooperative launch failed: %s (grid %d)\n", hipGetErrorString(e), grid);
#endif
}
```

```cpp
#include <hip/hip_runtime.h>
#include <hip/hip_cooperative_groups.h>
#include <cstdio>
#include <cstdint>
namespace cg = cooperative_groups;
namespace pg8 {
#define PG8_LAS __attribute__((address_space(3)))
typedef unsigned short bf16_t;
typedef short bf16x8 __attribute__((ext_vector_type(8)));
typedef float f32x4 __attribute__((ext_vector_type(4)));
typedef unsigned u32x4 __attribute__((ext_vector_type(4)));
constexpr int BM = 256, BK = 64, HALF = 128, HTB = HALF * BK * 2  , STAGE_BYTES = 8 * HTB, NXCD = 8, WGM = 8;

__host__ __device__ __forceinline__ int lds_byte(int r, int c) { const int st = (r >> 4) * 2 + (c >> 5), rr = r & 15, cc = c & 31, ob = rr * 64 + cc * 2; return st * 1024 + (ob ^ (((ob >> 9) & 1) << 5)); }
__host__ __device__ __forceinline__ void stage_rc(int b, int& R, int& C) { const int st = b / 1024, sb = b % 1024, swz = sb ^ (((sb >> 9) & 1) << 5); R = (st >> 1) * 16 + swz / 64; C = (st & 1) * 32 + (swz % 64) / 2; }
__host__ __device__ __forceinline__ int perm32(int rho) { const int n = rho >> 4, i = rho & 15; return 8 * (i >> 2) + 4 * n + (i & 3); }

struct Unit { int pm, pn; };
struct Gemm { const bf16_t* A; const bf16_t* Bt; int M, N, K; };

struct StaticOrder {
    int nM, nN, nwg, G, c;
    __host__ __device__ void init(int M, int N, int G_, int c_) { nM = M / BM; nN = N / BM; nwg = nM * nN; G = G_; c = c_; }
    __host__ __device__ bool next(int i, Unit& u) const {
        const long L = (long)i * G + c; if (L >= nwg) return false;
        int wgid = (int)L; { const int q = nwg / NXCD, r = nwg % NXCD, xcd = wgid % NXCD, off = wgid / NXCD; wgid = (xcd < r ? xcd * (q + 1) : r * (q + 1) + (xcd - r) * q) + off; }
        const int nig = WGM * nN, gid = wgid / nig, fm = gid * WGM, gsz = (nM - fm) < WGM ? (nM - fm) : WGM;
        u.pm = fm + ((wgid % nig) % gsz); u.pn = (wgid % nig) / gsz; return true;
    }
    __device__ __forceinline__ void a_ready(const Unit&) const {}
    __device__ __forceinline__ void done(const Unit&) const {}
};

__device__ __forceinline__ unsigned cvt_pk_bf16(float lo, float hi) { unsigned r; asm volatile("v_cvt_pk_bf16_f32 %0, %1, %2" : "=v"(r) : "v"(lo), "v"(hi)); return r; }
typedef float f32x2 __attribute__((ext_vector_type(2)));
template <class Epi, class Sched, bool ALIGN_EPI = false, bool SP2 = false>
__device__ __forceinline__ void gemm_phase(PG8_LAS unsigned char* lds, const Gemm g, const Sched& S, const Epi& E) {
    int tid_ = threadIdx.x; asm volatile("" : "+v"(tid_)); const int tid = tid_, wid = __builtin_amdgcn_readfirstlane(tid >> 6), lane = tid & 63, wr = wid >> 2, wc = wid & 3, fr = lane & 15, fq = lane >> 4;
    const int K = g.K, nt = K / BK;
    unsigned voffA[2], voffB[2];
#pragma unroll
    for (int i = 0; i < 2; ++i) { int R, C; stage_rc(tid * 16 + i * 8192, R, C); const int Rb = Epi::PERM ? ((R & ~31) + perm32(R & 31)) : R;
        voffA[i] = (unsigned)(R * K + C) * 2u; voffB[i] = (unsigned)(Rb * K + C) * 2u; }
    const size_t kstep = (size_t)(BK * 2);
    const size_t hstep = (size_t)HALF * K * 2;
    const size_t tstep = 2 * hstep;
    const unsigned ldsw = (unsigned)wid * 1024u;
    const int aoff = lds_byte(wr * 64 + fr, fq * 8), boff = lds_byte(wc * 32 + fr, fq * 8);
#define PG8_SA(b, h) (((b) * 2 + (h)) * HTB)
#define PG8_SB(b, h) ((4 + (b) * 2 + (h)) * HTB)
#define PG8_STAGE(bufoff, gbase, voff) do { _Pragma("unroll") for (int _i = 0; _i < 2; ++_i) \
        __builtin_amdgcn_global_load_lds((const unsigned*)((const char*)(gbase) + (voff)[_i]), (PG8_LAS unsigned*)(lds + (bufoff) + ldsw + _i * 8192), 16, 0, 0); } while (0)
#define PG8_LDA(dst, b, h) do { _Pragma("unroll") for (int m = 0; m < 4; ++m) _Pragma("unroll") for (int k = 0; k < 2; ++k) dst[m][k] = *(const PG8_LAS bf16x8*)(lds + PG8_SA(b, h) + aoff + m * 2048 + k * 1024); } while (0)
#define PG8_LDB(dst, b, h) do { _Pragma("unroll") for (int n = 0; n < 2; ++n) _Pragma("unroll") for (int k = 0; k < 2; ++k) dst[n][k] = *(const PG8_LAS bf16x8*)(lds + PG8_SB(b, h) + boff + n * 2048 + k * 1024); } while (0)
#define PG8_MMA(ai, bj, At, Bt) do { __builtin_amdgcn_s_setprio(1); _Pragma("unroll") for (int m = 0; m < 4; ++m) _Pragma("unroll") for (int n = 0; n < 2; ++n) _Pragma("unroll") for (int k = 0; k < 2; ++k) \
        acc[ai][bj][m][n] = __builtin_amdgcn_mfma_f32_16x16x32_bf16(Bt[n][k], At[m][k], acc[ai][bj][m][n], 0, 0, 0); __builtin_amdgcn_s_setprio(0); } while (0)
#define PG8_WAIT_V(n) asm volatile("s_waitcnt vmcnt(" #n ")" ::: "memory")
#define PG8_WAIT_L(n) asm volatile("s_waitcnt lgkmcnt(" #n ")" ::: "memory")
#define PG8_BAR __builtin_amdgcn_s_barrier()
#define PG8_SCHED __builtin_amdgcn_sched_barrier(0)
    Unit cur, nxt; int ui = 0;
    if (!S.next(0, cur)) return;
    f32x4 acc[2][2][4][2];
#pragma unroll
    for (int a = 0; a < 2; ++a)
#pragma unroll
        for (int b = 0; b < 2; ++b)
#pragma unroll
            for (int m = 0; m < 4; ++m)
#pragma unroll
                for (int n = 0; n < 2; ++n) acc[a][b][m][n] = (f32x4){0.f, 0.f, 0.f, 0.f};
    bf16x8 At[4][2], B0[2][2], B1[2][2];
    const char* cA = (const char*)g.A + (size_t)cur.pm * tstep; const char* cB = (const char*)g.Bt + (size_t)cur.pn * tstep;
    S.a_ready(cur);
    if constexpr (SP2) {
        PG8_STAGE(PG8_SB(0, 0), cB, voffB); PG8_STAGE(PG8_SB(0, 1), cB + hstep, voffB); PG8_STAGE(PG8_SA(0, 0), cA, voffA); PG8_STAGE(PG8_SA(0, 1), cA + hstep, voffA);
        if (wr == 1) PG8_BAR;
        PG8_WAIT_V(2); PG8_BAR;
        PG8_STAGE(PG8_SB(1, 0), cB + kstep, voffB); PG8_STAGE(PG8_SA(1, 0), cA + kstep, voffA); PG8_STAGE(PG8_SB(1, 1), cB + hstep + kstep, voffB);
        PG8_WAIT_V(6); PG8_BAR;
    } else {
        PG8_STAGE(PG8_SB(0, 0), cB, voffB); PG8_STAGE(PG8_SA(0, 0), cA, voffA); PG8_STAGE(PG8_SB(0, 1), cB + hstep, voffB); PG8_STAGE(PG8_SA(0, 1), cA + hstep, voffA);
        if (wr == 1) PG8_BAR;
        PG8_WAIT_V(4); PG8_BAR;
        PG8_STAGE(PG8_SB(1, 0), cB + kstep, voffB); PG8_STAGE(PG8_SA(1, 0), cA + kstep, voffA); PG8_STAGE(PG8_SB(1, 1), cB + hstep + kstep, voffB);
        PG8_WAIT_V(6); PG8_BAR;
    }
    for (;;) {
        const bool has_next = S.next(ui + 1, nxt);
        const char* nA = has_next ? (const char*)g.A + (size_t)nxt.pm * tstep : cA; const char* nB = has_next ? (const char*)g.Bt + (size_t)nxt.pn * tstep : cB;
        for (int t = 0; t < nt; t += 2) {
            const bool last = (t == nt - 2);
            const char* a1 = cA + (size_t)(t + 1) * kstep;
            const char* a2 = last ? nA : cA + (size_t)(t + 2) * kstep; const char* b2 = last ? nB : cB + (size_t)(t + 2) * kstep;
            const char* a3 = a2 + kstep; const char* b3 = b2 + kstep;
            if (last && has_next) S.a_ready(nxt);
            if constexpr (SP2) {
            PG8_LDB(B0, 0, 0); PG8_LDB(B1, 0, 1); PG8_SCHED; PG8_LDA(At, 0, 0); PG8_STAGE(PG8_SA(1, 1), a1 + hstep, voffA);
            PG8_WAIT_V(8); PG8_WAIT_L(0); PG8_BAR; PG8_MMA(0, 0, At, B0); PG8_MMA(0, 1, At, B1); PG8_BAR; PG8_SCHED;
            PG8_LDA(At, 0, 1); PG8_STAGE(PG8_SB(0, 0), b2, voffB); PG8_STAGE(PG8_SB(0, 1), b2 + hstep, voffB); PG8_STAGE(PG8_SA(0, 0), a2, voffA);
            PG8_WAIT_V(8); PG8_WAIT_L(0); PG8_BAR; PG8_MMA(1, 0, At, B0); PG8_MMA(1, 1, At, B1); PG8_BAR; PG8_SCHED;
            PG8_LDB(B0, 1, 0); PG8_LDB(B1, 1, 1); PG8_SCHED; PG8_LDA(At, 1, 0); PG8_STAGE(PG8_SA(0, 1), a2 + hstep, voffA);
            PG8_WAIT_V(8); PG8_WAIT_L(0); PG8_BAR; PG8_MMA(0, 0, At, B0); PG8_MMA(0, 1, At, B1); PG8_BAR; PG8_SCHED;
            PG8_LDA(At, 1, 1); PG8_STAGE(PG8_SB(1, 0), b3, voffB); PG8_STAGE(PG8_SB(1, 1), b3 + hstep, voffB); PG8_STAGE(PG8_SA(1, 0), a3, voffA);
            PG8_WAIT_V(8); PG8_WAIT_L(0); PG8_BAR; PG8_MMA(1, 0, At, B0); PG8_MMA(1, 1, At, B1); PG8_BAR; PG8_SCHED;
            } else {
            PG8_LDB(B0, 0, 0); PG8_SCHED; PG8_LDA(At, 0, 0); PG8_STAGE(PG8_SA(1, 1), a1 + hstep, voffA);
            PG8_WAIT_L(8); PG8_BAR; PG8_WAIT_L(0); PG8_MMA(0, 0, At, B0); PG8_BAR; PG8_SCHED;
            PG8_LDB(B1, 0, 1); PG8_STAGE(PG8_SB(0, 0), b2, voffB);
            PG8_BAR; PG8_WAIT_L(0); PG8_MMA(0, 1, At, B1); PG8_BAR;
            PG8_LDA(At, 0, 1); PG8_STAGE(PG8_SA(0, 0), a2, voffA);
            PG8_BAR; PG8_WAIT_L(0); PG8_MMA(1, 0, At, B0); PG8_BAR; PG8_SCHED;
            PG8_STAGE(PG8_SB(0, 1), b2 + hstep, voffB);
            PG8_WAIT_V(6); PG8_BAR; PG8_MMA(1, 1, At, B1); PG8_BAR;
            PG8_LDB(B0, 1, 0); PG8_SCHED; PG8_LDA(At, 1, 0); PG8_STAGE(PG8_SA(0, 1), a2 + hstep, voffA);
            PG8_WAIT_L(8); PG8_BAR; PG8_WAIT_L(0); PG8_MMA(0, 0, At, B0); PG8_BAR; PG8_SCHED;
            PG8_LDB(B1, 1, 1); PG8_STAGE(PG8_SB(1, 0), b3, voffB);
            PG8_BAR; PG8_WAIT_L(0); PG8_MMA(0, 1, At, B1); PG8_BAR;
            PG8_LDA(At, 1, 1); PG8_STAGE(PG8_SA(1, 0), a3, voffA);
            PG8_BAR; PG8_WAIT_L(0); PG8_MMA(1, 0, At, B0); PG8_BAR; PG8_SCHED;
            PG8_STAGE(PG8_SB(1, 1), b3 + hstep, voffB);
            PG8_WAIT_V(6); PG8_BAR; PG8_MMA(1, 1, At, B1); PG8_BAR;
            }
        }
        if constexpr (ALIGN_EPI) { if (wr == 0) PG8_BAR; }
        if constexpr (!Epi::AFTER_DRAIN) { E(acc, cur, wr, wc, fr, fq); S.done(cur); }
        if (!has_next) break;
#pragma unroll
        for (int a = 0; a < 2; ++a)
#pragma unroll
            for (int b = 0; b < 2; ++b)
#pragma unroll
                for (int m = 0; m < 4; ++m)
#pragma unroll
                    for (int n = 0; n < 2; ++n) acc[a][b][m][n] = (f32x4){0.f, 0.f, 0.f, 0.f};
        cur = nxt; cA = nA; cB = nB; ++ui;
        if constexpr (ALIGN_EPI) { if (wr == 1) PG8_BAR; }
    }
    PG8_WAIT_V(0);
    if constexpr (!ALIGN_EPI) { if (wr == 0) PG8_BAR; }
    PG8_BAR;
    if constexpr (Epi::AFTER_DRAIN) { E.fused(acc, cur, wr, wc, fr, fq, lds, wid, lane); S.done(cur); }
#undef PG8_SA
#undef PG8_SB
#undef PG8_STAGE
#undef PG8_LDA
#undef PG8_LDB
#undef PG8_MMA
#undef PG8_WAIT_V
#undef PG8_WAIT_L
#undef PG8_BAR
#undef PG8_SCHED
}
}

#define LAS __attribute__((address_space(3)))
typedef unsigned short bf16_t;
typedef short bf16x8 __attribute__((ext_vector_type(8)));
typedef float f32x4 __attribute__((ext_vector_type(4)));
typedef float f32x16 __attribute__((ext_vector_type(16)));
typedef unsigned u32x4 __attribute__((ext_vector_type(4)));
typedef unsigned u32x2 __attribute__((ext_vector_type(2)));

constexpr int NTHREADS = 512, NWAVES = 8;
constexpr int DM = 1024, SEQ = 8192, CTXL = 256, NLAT = 2 * SEQ, NCTX = 2 * CTXL, NTOK = NLAT + NCTX, KEYS = SEQ + CTXL;
constexpr int D_IN = 7296, D_FF = 2816, D_FFE = 3584, NEXP = 8;
constexpr int IC_QS = 0, IC_KS = 512, IC_RW = 640, IC_QD = 2560, IC_KD = 3072, PP = 3584, IC_VS = 3584, IC_VD = 3712, IC_PAD = 4224, NIN1 = 4352, WIN_ROWS = 7424;
constexpr int ST_SLOTS = 9;
constexpr int MOE_TILES = 136, MOE_HALF = 68;

constexpr size_t MiB = 1u << 20;
constexpr size_t WS_CTL = 0, CTL_BYTES = 1 * MiB;
constexpr size_t WS_MODS = 1 * MiB;
constexpr size_t WS_ROPE = 1 * MiB + 256 * 1024;
constexpr size_t WS_HCTX = 2 * MiB;
constexpr size_t WS_LIST = 4 * MiB;
constexpr size_t WS_WTS = 4 * MiB + 512 * 1024;
constexpr size_t WS_WIN = 6 * MiB;
constexpr size_t WS_PRJ = WS_WIN + (size_t)WIN_ROWS * 1024 * 2;
constexpr size_t WS_WOUT = WS_PRJ + 3 * MiB;
constexpr size_t WS_LORA = WS_WOUT + 2 * MiB;
constexpr size_t WS_XN = 28 * MiB;
constexpr size_t WS_P = 61 * MiB;
constexpr size_t WS_VTS = 177 * MiB;
constexpr size_t WS_VTD = WS_VTS + 4608 * 1024;
constexpr size_t WS_ST = 198 * MiB;
constexpr size_t WS_YA = 495 * MiB;
constexpr size_t WS_YB = WS_YA + 16896ull * 512 * 2;
constexpr size_t WS_YC = WS_YB + 16896ull * 512 * 2;
constexpr size_t WS_END = WS_YC + 16896ull * 512 * 2;
constexpr size_t WS_G = WS_ST;
constexpr size_t WS_MF = WS_ST + 99 * MiB;
constexpr size_t WS_MB = WS_ST + 165 * MiB;
constexpr size_t WS_MOUT = WS_ST + 198 * MiB;
constexpr size_t WS_FGU = WS_VTS;
constexpr size_t WS_FD = WS_VTS + 11 * MiB;
constexpr size_t WS_HID = WS_P;
constexpr size_t WS_XN2 = 495 * MiB;
constexpr size_t WS_MGU = 6 * MiB;
constexpr size_t WS_MD = 118 * MiB;
constexpr size_t WS_XG = 174 * MiB;
constexpr size_t WS_FACC = 242 * MiB;
constexpr size_t WS_HIDM = 306 * MiB;
static_assert(WS_LORA + 2560 * 384 * 2 <= WS_XN && WS_XN + 16896ull * 1024 * 2 <= WS_P && WS_P + 16896ull * PP * 2 <= WS_VTS && WS_VTD + 2ull * 4 * 128 * KEYS * 2 <= WS_ST, "ws map 1");
static_assert(WS_ST + 16896ull * 8 * ST_SLOTS * 64 * 4 <= WS_YA && WS_END <= 545 * MiB, "ws map 2");
static_assert(WS_G + 16896ull * 3072 * 2 <= WS_MF && WS_MF + 16896ull * 1024 * 4 <= WS_MB && WS_MB + 16896ull * 1024 * 2 <= WS_MOUT && WS_MOUT + 16896ull * 1024 * 4 <= WS_YA, "ws map 3");
static_assert(WS_FGU + 5632ull * 1024 * 2 <= WS_FD && WS_FD + 1024ull * 2816 * 2 <= WS_ST && WS_HID + 16896ull * 2816 * 2 <= WS_VTS, "ws map 4");
static_assert(WS_MGU + 8ull * 7168 * 1024 * 2 <= WS_MD && WS_MD + 8ull * 1024 * 3584 * 2 <= WS_XG && WS_XG + 34816ull * 1024 * 2 <= WS_FACC && WS_FACC + 16384ull * 1024 * 4 <= WS_HIDM && WS_HIDM + 136ull * 256 * 3584 * 2 <= 560 * MiB, "ws map 5");
static_assert(WS_FACC + 16384ull * 1024 * 4 <= WS_MOUT && WS_XN2 + 16384ull * 1024 * 2 <= 560 * MiB && WS_XN2 >= WS_MOUT + 16896ull * 1024 * 4, "expert weights / gathered rows / accumulator must not touch MOUT or XN2 while they are live");
constexpr size_t WS_NEED = 560 * MiB;
constexpr int CW_CNT = 0;
constexpr int CW_Q0 = 64, CW_Q1 = 128;

constexpr int LDS_BYTES = 147456;

__device__ __forceinline__ unsigned f2bf(float f) { unsigned u = __builtin_bit_cast(unsigned, f); return (u + 0x7fffu + ((u >> 16) & 1u)) >> 16; }
typedef float f32x2_t __attribute__((ext_vector_type(2))); typedef __bf16 bf16x2_t __attribute__((ext_vector_type(2)));
__device__ __forceinline__ unsigned pk2(float lo, float hi) { const f32x2_t v = {lo, hi}; return __builtin_bit_cast(unsigned, __builtin_convertvector(v, bf16x2_t)); }
__device__ __forceinline__ float bflo(unsigned w) { return __uint_as_float(w << 16); }
__device__ __forceinline__ float bfhi(unsigned w) { return __uint_as_float(w & 0xffff0000u); }
__device__ __forceinline__ float wave_sum(float v) {
#pragma unroll
    for (int o = 1; o < 64; o <<= 1) v += __shfl_xor(v, o);
    return v;
}
__device__ __forceinline__ float sigmoidf_(float x) { return 1.0f / (1.0f + __expf(-x)); }
__device__ __forceinline__ float siluf_(float x) { return x / (1.0f + __expf(-x)); }
#define LDS_WAIT() asm volatile("s_waitcnt lgkmcnt(0)" ::: "memory")

struct Params {
    const float* in[37];
    float* out;
    unsigned char* ws;
    int ph_lo, ph_hi;
};

template <class F>
__device__ __forceinline__ void transpose_item(const float* __restrict__ W, int ldw, int k0, int n0, bf16_t* __restrict__ WT, int ldt, int dcol0, F rowmap, LAS float* scr, int lane) {
#pragma unroll 8
    for (int i = 0; i < 32; ++i) { const int kk = 2 * i + (lane >> 5); scr[kk * 33 + (lane & 31)] = W[(size_t)(k0 + kk) * ldw + n0 + (lane & 31)]; }
    LDS_WAIT(); asm volatile("" ::: "memory");
    const int c = lane & 7;
#pragma unroll
    for (int j = 0; j < 4; ++j) {
        const int n = (lane >> 3) + 8 * j; const LAS float* s = scr + (8 * c) * 33 + n;
        u32x4 o; o.x = pk2(s[0 * 33], s[1 * 33]); o.y = pk2(s[2 * 33], s[3 * 33]); o.z = pk2(s[4 * 33], s[5 * 33]); o.w = pk2(s[6 * 33], s[7 * 33]);
        const int row = rowmap(n0 + n);
        if (row >= 0) *(u32x4*)(WT + (size_t)row * ldt + dcol0 + k0 + 8 * c) = o;
    }
    LDS_WAIT(); asm volatile("" ::: "memory");
}
struct RowId { __device__ __forceinline__ int operator()(int n) const { return n; } };
struct RowOff { int off; __device__ __forceinline__ int operator()(int n) const { return n + off; } };
struct RowWin {
    __device__ __forceinline__ int operator()(int n) const {
        if (n < 640) return n;
        if (n < 768) return n - 640 + IC_VS;
        if (n < 2688) return n - 768 + IC_RW;
        if (n < 3712) return n - 2688 + IC_QD;
        if (n < 4224) return n - 3712 + IC_VD;
        return n - 4224 + NIN1;
    }
};
struct RowGU { int up; __device__ __forceinline__ int operator()(int j) const { return (j >> 7) * 256 + (j & 127) + 128 * up; } };

template <class F>
__device__ __forceinline__ void convert_matrix(const float* W, int K, int N, bf16_t* WT, int ldt, int dcol0, F rowmap, LAS float* scr, int lane, int gw, int NGW) {
    const int nblk = N / 32, items = (K / 64) * nblk;
    for (int it = gw; it < items; it += NGW) { const int kb = it / nblk, nb = it % nblk; transpose_item(W, N, kb * 64, nb * 32, WT, ldt, dcol0, rowmap, scr, lane); }
}

__device__ __forceinline__ void lora_region(bf16_t* __restrict__ LT, const float* __restrict__ src, int row0, int klo, int kn, int gw, int NGW, int lane) {
    for (int i = gw * 64 + lane; i < 512 * 48; i += NGW * 64) {
        const int nn = i / 48, kc = (i % 48) * 8;
        u32x4 o = (u32x4){0u, 0u, 0u, 0u};
        if (kc >= klo && kc < klo + kn) {
            const float* s = src + (size_t)(kc - klo) * 512 + nn;
            o.x = pk2(s[0], s[512]); o.y = pk2(s[2 * 512], s[3 * 512]); o.z = pk2(s[4 * 512], s[5 * 512]); o.w = pk2(s[6 * 512], s[7 * 512]);
        }
        *(u32x4*)(LT + (size_t)(row0 + nn) * 384 + kc) = o;
    }
}
__device__ __forceinline__ void convert_layer_weights(const Params& p, int layer, LAS unsigned char* lds, int gw, int NGW, int wave, int lane) {
    LAS float* scr = (LAS float*)(lds + wave * 16384);
    unsigned char* ws = p.ws;
    bf16_t* WIN = (bf16_t*)(ws + WS_WIN);
    convert_matrix(p.in[10] + (size_t)layer * 1024 * D_IN, 1024, D_IN, WIN, 1024, 0, RowWin(), scr, lane, gw, NGW);
    for (int i = gw * 64 + lane; i < (NIN1 - IC_PAD) * 1024 / 8; i += NGW * 64) *(u32x4*)(WIN + (size_t)IC_PAD * 1024 + (size_t)i * 8) = (u32x4){0u, 0u, 0u, 0u};
    for (int j = 0; j < 3; ++j)
        convert_matrix(p.in[26 + j] + (size_t)layer * 512 * 1024, 512, 1024, (bf16_t*)(ws + WS_PRJ) + (size_t)j * 1024 * 512, 512, 0, RowId(), scr, lane, gw, NGW);
    convert_matrix(p.in[29] + (size_t)layer * 1024 * 1024, 1024, 1024, (bf16_t*)(ws + WS_WOUT), 1024, 0, RowId(), scr, lane, gw, NGW);
    bf16_t* LT = (bf16_t*)(ws + WS_LORA);
    lora_region(LT, p.in[15] + ((size_t)layer * 2 + 0) * 64 * 512, 0, 0, 64, gw, NGW, lane);
    lora_region(LT, p.in[15] + ((size_t)layer * 2 + 1) * 64 * 512, 512, 64, 64, gw, NGW, lane);
    lora_region(LT, p.in[17] + ((size_t)layer * 2 + 0) * 64 * 512, 1024, 128, 64, gw, NGW, lane);
    lora_region(LT, p.in[17] + ((size_t)layer * 2 + 1) * 64 * 512, 1536, 192, 64, gw, NGW, lane);
    lora_region(LT, p.in[18] + (size_t)layer * 128 * 512, 2048, 256, 128, gw, NGW, lane);
}
__device__ __forceinline__ void convert_ffn_weights(const Params& p, LAS unsigned char* lds, int gw, int NGW, int wave, int lane) {
    LAS float* scr = (LAS float*)(lds + wave * 16384);
    bf16_t* GU = (bf16_t*)(p.ws + WS_FGU); bf16_t* FD = (bf16_t*)(p.ws + WS_FD);
    convert_matrix(p.in[30], 1024, D_FF, GU, 1024, 0, RowGU{0}, scr, lane, gw, NGW);
    convert_matrix(p.in[31], 1024, D_FF, GU, 1024, 0, RowGU{1}, scr, lane, gw, NGW);
    convert_matrix(p.in[32], D_FF, 1024, FD, D_FF, 0, RowId(), scr, lane, gw, NGW);
}
__device__ __forceinline__ void convert_moe_weights(const Params& p, LAS unsigned char* lds, int gw, int NGW, int wave, int lane) {
    LAS float* scr = (LAS float*)(lds + wave * 16384);
    for (int e = 0; e < NEXP; ++e) {
        bf16_t* GU = (bf16_t*)(p.ws + WS_MGU) + (size_t)e * 7168 * 1024;
        convert_matrix(p.in[34] + (size_t)e * 1024 * D_FFE, 1024, D_FFE, GU, 1024, 0, RowGU{0}, scr, lane, gw, NGW);
        convert_matrix(p.in[35] + (size_t)e * 1024 * D_FFE, 1024, D_FFE, GU, 1024, 0, RowGU{1}, scr, lane, gw, NGW);
        convert_matrix(p.in[36] + (size_t)e * D_FFE * 1024, D_FFE, 1024, (bf16_t*)(p.ws + WS_MD) + (size_t)e * 1024 * D_FFE, D_FFE, 0, RowId(), scr, lane, gw, NGW);
    }
}

__device__ __forceinline__ void adaln_phase(const Params& p, LAS unsigned char* lds, int wave, int lane) {
    LAS float* red = (LAS float*)lds;
    float* MODS = (float*)(p.ws + WS_MODS);
    const float* c = p.in[1]; const float* cc = p.in[3];
    for (int it = blockIdx.x; it < 2 * 96; it += gridDim.x) {
        const int layer = it / 96, n = (it % 96) * 64 + lane;
        const float* W = p.in[4] + (size_t)layer * 1024 * 6144;
        float a0 = 0.f, a1 = 0.f, a2 = 0.f;
        for (int k = wave * 128; k < wave * 128 + 128; ++k) {
            const float w = W[(size_t)k * 6144 + n];
            a0 += siluf_(c[k]) * w; a1 += siluf_(c[1024 + k]) * w; a2 += siluf_(cc[k]) * w;
        }
        red[(wave * 3 + 0) * 64 + lane] = a0; red[(wave * 3 + 1) * 64 + lane] = a1; red[(wave * 3 + 2) * 64 + lane] = a2;
        __syncthreads();
        if (wave < 3) {
            float s = 0.f;
#pragma unroll
            for (int w = 0; w < 8; ++w) s += red[(w * 3 + wave) * 64 + lane];
            MODS[((size_t)layer * 3 + wave) * 6144 + n] = s + p.in[5][(size_t)layer * 6144 + n];
        }
        __syncthreads();
    }
    if (blockIdx.x == gridDim.x - 1) {
        float* rope = (float*)(p.ws + WS_ROPE);
        for (int i = threadIdx.x; i < 128 * 16; i += NTHREADS) {
            const int pos = i >> 4, j = i & 15;
            const float inv = powf(10000.0f, -(float)j / 16.0f);
            const float ang = (float)pos * inv;
            rope[2 * i] = cosf(ang); rope[2 * i + 1] = sinf(ang);
        }
    }
}

__device__ __forceinline__ const float* mods_row(const Params& p, int layer, int m) {
    const int r = m < NLAT ? (m >> 13) : 2;
    return (const float*)(p.ws + WS_MODS) + ((size_t)layer * 3 + r) * 6144;
}
__device__ __forceinline__ void load_row(const float* x, int lane, f32x4 (&v)[4]) {
#pragma unroll
    for (int j = 0; j < 4; ++j) v[j] = ((const f32x4*)x)[lane + 64 * j];
}
__device__ __forceinline__ float row_rstd(const f32x4 (&v)[4]) {
    float s = 0.f;
#pragma unroll
    for (int j = 0; j < 4; ++j) s += (v[j].x * v[j].x + v[j].y * v[j].y) + (v[j].z * v[j].z + v[j].w * v[j].w);
    return 1.0f / sqrtf(wave_sum(s) * (1.0f / 1024.0f) + 1e-6f);
}
__device__ __forceinline__ void normmod(const f32x4 (&h)[4], const float* g, const float* shift, const float* scale, int lane, f32x4 (&a)[4]) {
    const float rstd = row_rstd(h);
#pragma unroll
    for (int j = 0; j < 4; ++j) {
        const f32x4 gg = ((const f32x4*)g)[lane + 64 * j], sh = ((const f32x4*)shift)[lane + 64 * j], sc = ((const f32x4*)scale)[lane + 64 * j];
        a[j] = (h[j] * rstd * gg) * (sc + 1.0f) + sh;
    }
}
__device__ __forceinline__ void store_row_bf16(bf16_t* o, int lane, const f32x4 (&a)[4]) {
#pragma unroll
    for (int j = 0; j < 4; ++j) { u32x2 w; w.x = pk2(a[j].x, a[j].y); w.y = pk2(a[j].z, a[j].w); ((u32x2*)o)[lane + 64 * j] = w; }
}
__device__ __forceinline__ const float* h_in_row(const Params& p, int layer, int m) {
    if (layer == 0) return m < NLAT ? p.in[0] + (size_t)m * 1024 : p.in[2] + (size_t)(m - NLAT) * 1024;
    return m < NLAT ? p.out + (size_t)m * 1024 : (const float*)(p.ws + WS_HCTX) + (size_t)(m - NLAT) * 1024;
}
__device__ __forceinline__ float* h_out_row(const Params& p, int m) { return m < NLAT ? p.out + (size_t)m * 1024 : (float*)(p.ws + WS_HCTX) + (size_t)(m - NLAT) * 1024; }

__device__ __forceinline__ void premix_phase(const Params& p, int layer, bool first, int M, int gw, int NGW, int lane) {
    bf16_t* XN = (bf16_t*)(p.ws + WS_XN);
    for (int m = gw; m < M; m += NGW) {
        const float* hr = first ? h_in_row(p, 0, m) : h_out_row(p, m);
        f32x4 h[4], a[4]; load_row(hr, lane, h);
        const float* md = mods_row(p, layer, m);
        normmod(h, p.in[6] + layer * 1024, md, md + 1024, lane, a);
        store_row_bf16(XN + (size_t)m * 1024, lane, a);
    }
}
__device__ __forceinline__ void residual_phase(const Params& p, const float* src, const float* src2, const float* hin_base_layer0, bool hin_is_input, int layer, int gate_idx, const float* g1,
                                               bool write_xn, const float* g2, int mod_layer2, int shift_idx, bool route, int M, int gw, int NGW, int lane) {
    bf16_t* XN = (bf16_t*)(p.ws + (route ? WS_XN2 : WS_XN));
    for (int m = gw; m < M; m += NGW) {
        const float* hr = hin_is_input ? h_in_row(p, 0, m) : h_out_row(p, m);
        f32x4 h[4], s[4]; load_row(hr, lane, h); load_row(src + (size_t)m * 1024, lane, s);
        if (src2) { f32x4 s2[4]; load_row(src2 + (size_t)m * 1024, lane, s2);
#pragma unroll
            for (int j = 0; j < 4; ++j) s[j] += s2[j]; }
        const float rstd = row_rstd(s);
        const float* md = mods_row(p, layer, m);
#pragma unroll
        for (int j = 0; j < 4; ++j) {
            const f32x4 gg = ((const f32x4*)g1)[lane + 64 * j], gt = ((const f32x4*)(md + gate_idx * 1024))[lane + 64 * j];
            h[j] = h[j] + gt * (s[j] * rstd * gg);
        }
        float* ho = h_out_row(p, m);
#pragma unroll
        for (int j = 0; j < 4; ++j) ((f32x4*)ho)[lane + 64 * j] = h[j];
        if (write_xn) {
            f32x4 a[4]; const float* md2 = mods_row(p, mod_layer2, m);
            normmod(h, g2, md2 + shift_idx * 1024, md2 + (shift_idx + 1) * 1024, lane, a);
            store_row_bf16(XN + (size_t)m * 1024, lane, a);
            if (route) {
                const float* rw = p.in[33];
                float lg[8] = {0.f, 0.f, 0.f, 0.f, 0.f, 0.f, 0.f, 0.f};
#pragma unroll
                for (int j = 0; j < 4; ++j)
#pragma unroll
                    for (int q = 0; q < 4; ++q) {
                        const int k = 4 * (lane + 64 * j) + q; const float av = a[j][q];
                        const f32x4 w0 = ((const f32x4*)(rw + (size_t)k * 8))[0], w1 = ((const f32x4*)(rw + (size_t)k * 8))[1];
                        lg[0] += av * w0.x; lg[1] += av * w0.y; lg[2] += av * w0.z; lg[3] += av * w0.w; lg[4] += av * w1.x; lg[5] += av * w1.y; lg[6] += av * w1.z; lg[7] += av * w1.w;
                    }
#pragma unroll
                for (int e = 0; e < 8; ++e) lg[e] = wave_sum(lg[e]);
                int i1 = 0; float v1 = lg[0];
#pragma unroll
                for (int e = 1; e < 8; ++e) if (lg[e] > v1) { v1 = lg[e]; i1 = e; }
                int i2 = -1; float v2 = -3.0e38f;
#pragma unroll
                for (int e = 0; e < 8; ++e) if (e != i1 && lg[e] > v2) { v2 = lg[e]; i2 = e; }
                if (lane == 0) {
                    const float w1 = 1.0f / (1.0f + expf(v2 - v1)), w2 = 1.0f - w1;
                    unsigned* cnt = (unsigned*)(p.ws + WS_CTL) + CW_CNT; int* LIST = (int*)(p.ws + WS_LIST); float* WTS = (float*)(p.ws + WS_WTS);
                    const unsigned s1 = atomicAdd(cnt + i1, 1u); LIST[i1 * 16384 + s1] = m * 2; WTS[i1 * 16384 + s1] = w1;
                    const unsigned s2 = atomicAdd(cnt + i2, 1u); LIST[i2 * 16384 + s2] = m * 2 + 1; WTS[i2 * 16384 + s2] = w2;
                }
            }
        }
    }
}

using pg8::Unit;
constexpr float QSCALE = 0.125f * 1.4426950408889634f;
__device__ __forceinline__ u32x2 pack4(const f32x4 v) { u32x2 w; w.x = pk2(v.x, v.y); w.y = pk2(v.z, v.w); return w; }
__device__ __forceinline__ f32x4 unpack4(const u32x2 w) { return (f32x4){bflo(w.x), bfhi(w.x), bflo(w.y), bfhi(w.y)}; }

struct EpiIn {
    static constexpr bool PERM = false, AFTER_DRAIN = false;
    bf16_t* P; bf16_t* VTS; bf16_t* VTD; const float* rope;
    __device__ __forceinline__ void operator()(const f32x4 (&acc)[2][2][4][2], const Unit& u, int wr, int wc, int fr, int fq) const {
#pragma unroll
        for (int ai = 0; ai < 2; ++ai)
#pragma unroll
            for (int m = 0; m < 4; ++m) {
                const int r = u.pm * 256 + ai * 128 + wr * 64 + m * 16 + fr;
                const bool lat = r < NLAT;
                const int t = r & (SEQ - 1);
                const int b = lat ? (r >> 13) : ((r - NLAT) >> 8);
                const int key = lat ? t : SEQ + ((r - NLAT) & 255);
#pragma unroll
                for (int bj = 0; bj < 2; ++bj) {
                    const int c32 = u.pn * 256 + bj * 128 + wc * 32;
                    f32x4 v0 = acc[ai][bj][m][0], v1 = acc[ai][bj][m][1];
                    if (c32 < PP) {
                        const bool rp = (c32 < IC_RW) || (c32 >= IC_QD);
                        if (rp && lat) {
                            const int pos = (c32 & 32) ? (t & 63) : (t >> 6);
                            const f32x4 cs0 = *(const f32x4*)(rope + (pos * 16 + 4 * fq) * 2), cs1 = *(const f32x4*)(rope + (pos * 16 + 4 * fq) * 2 + 4);
                            const f32x4 cc = (f32x4){cs0.x, cs0.z, cs1.x, cs1.z}, sn = (f32x4){cs0.y, cs0.w, cs1.y, cs1.w};
                            const f32x4 o0 = v0 * cc - v1 * sn, o1 = v0 * sn + v1 * cc;
                            v0 = o0; v1 = o1;
                        }
                        if (c32 < IC_KS || (c32 >= IC_QD && c32 < IC_KD)) { v0 = v0 * QSCALE; v1 = v1 * QSCALE; }
                        bf16_t* dst = P + (size_t)r * PP + c32 + 4 * fq;
                        *(u32x2*)dst = pack4(v0); *(u32x2*)(dst + 16) = pack4(v1);
                    } else {
                        const int cv = c32 - PP;
                        bf16_t* vt = nullptr; int dimbase = 0;
                        if (cv < 128) { vt = VTS + (size_t)((b * 2 + (cv >> 6)) * 64) * KEYS; dimbase = cv & 63; }
                        else if (cv < 640) { const int cd = cv - 128; vt = VTD + (size_t)((b * 4 + (cd >> 7)) * 128) * KEYS; dimbase = cd & 127; }
                        if (vt) {
#pragma unroll
                            for (int i = 0; i < 4; ++i) {
                                vt[(size_t)(dimbase + 4 * fq + i) * KEYS + key] = (bf16_t)f2bf(v0[i]);
                                vt[(size_t)(dimbase + 16 + 4 * fq + i) * KEYS + key] = (bf16_t)f2bf(v1[i]);
                            }
                        }
                    }
                }
            }
    }
};

struct EpiLora {
    static constexpr bool PERM = false, AFTER_DRAIN = false;
    float* ST; bf16_t* P; const float* w0; const float* a0; const float* k_a;
    __device__ __forceinline__ void operator()(const f32x4 (&acc)[2][2][4][2], const Unit& u, int wr, int wc, int fr, int fq) const {
        const int reg = u.pn >> 1;
#pragma unroll
        for (int ai = 0; ai < 2; ++ai)
#pragma unroll
            for (int m = 0; m < 4; ++m) {
                const int r = u.pm * 256 + ai * 128 + wr * 64 + m * 16 + fr;
#pragma unroll
                for (int bj = 0; bj < 2; ++bj)
#pragma unroll
                    for (int n = 0; n < 2; ++n) {
                        const int ch = (u.pn & 1) * 256 + bj * 128 + wc * 32 + 16 * n + 4 * fq;
                        const int h = ch >> 6, kidx = ch & 63;
                        float* sp = ST + ((size_t)r * 8 + h) * (ST_SLOTS * 64) + kidx;
                        const f32x4 a = acc[ai][bj][m][n];
                        if (reg < 2) {
                            const f32x4 bias = *(const f32x4*)(w0 + reg * 512 + ch);
                            f32x4 o;
#pragma unroll
                            for (int i = 0; i < 4; ++i) {
                                const float x = -(bias[i] + a[i]);
                                const float sp_ = fmaxf(x, 0.f) + __logf(1.0f + __expf(-fabsf(x)));
                                o[i] = __expf(-__expf(-sp_ - 0.5f));
                            }
                            *(f32x4*)(sp + (3 + 3 * reg) * 64) = o;
                        } else if (reg < 4) {
                            const int d = reg - 2;
                            const f32x4 bias = *(const f32x4*)(a0 + d * 512 + ch), ka = *(const f32x4*)(k_a + ch);
                            const f32x4 kraw = *(const f32x4*)(sp + (5 + 3 * d) * 64), kk = *(const f32x4*)(sp);
                            f32x4 bv, kf;
#pragma unroll
                            for (int i = 0; i < 4; ++i) {
                                const float ag = sigmoidf_(bias[i] + a[i]);
                                bv[i] = -kk[i] * ag; kf[i] = kraw[i] * (1.0f + (ag - 1.0f) * ka[i]);
                            }
                            *(f32x4*)(sp + (4 + 3 * d) * 64) = bv; *(f32x4*)(sp + (5 + 3 * d) * 64) = kf;
                        } else {
                            *(u32x2*)(P + (size_t)r * PP + IC_RW + ch) = pack4(a);
                        }
                        asm volatile("" ::: "memory");
                    }
            }
    }
};

struct EpiGate {
    static constexpr bool PERM = true, AFTER_DRAIN = false;
    bf16_t* G;
    __device__ __forceinline__ void operator()(const f32x4 (&acc)[2][2][4][2], const Unit& u, int wr, int wc, int fr, int fq) const {
#pragma unroll
        for (int ai = 0; ai < 2; ++ai)
#pragma unroll
            for (int m = 0; m < 4; ++m) {
                const int r = u.pm * 256 + ai * 128 + wr * 64 + m * 16 + fr;
#pragma unroll
                for (int bj = 0; bj < 2; ++bj) {
                    const int c = u.pn * 256 + bj * 128 + wc * 32 + 8 * fq;
                    const f32x4 a0 = acc[ai][bj][m][0], a1 = acc[ai][bj][m][1];
                    u32x4 w; w.x = pk2(sigmoidf_(a0.x), sigmoidf_(a0.y)); w.y = pk2(sigmoidf_(a0.z), sigmoidf_(a0.w)); w.z = pk2(sigmoidf_(a1.x), sigmoidf_(a1.y)); w.w = pk2(sigmoidf_(a1.z), sigmoidf_(a1.w));
                    *(u32x4*)(G + (size_t)r * 3072 + c) = w;
                }
            }
    }
};

template <int PASS> struct EpiMerge {
    static constexpr bool PERM = false, AFTER_DRAIN = false;
    const bf16_t* G; float* MF; bf16_t* MB;
    __device__ __forceinline__ void operator()(const f32x4 (&acc)[2][2][4][2], const Unit& u, int wr, int wc, int fr, int fq) const {
#pragma unroll
        for (int ai = 0; ai < 2; ++ai)
#pragma unroll
            for (int m = 0; m < 4; ++m) {
                const int r = u.pm * 256 + ai * 128 + wr * 64 + m * 16 + fr;
#pragma unroll
                for (int bj = 0; bj < 2; ++bj)
#pragma unroll
                    for (int n = 0; n < 2; ++n) {
                        const int c = u.pn * 256 + bj * 128 + wc * 32 + 16 * n + 4 * fq;
                        const f32x4 g = unpack4(*(const u32x2*)(G + (size_t)r * 3072 + PASS * 1024 + c));
                        f32x4 v = g * acc[ai][bj][m][n];
                        float* mp = MF + (size_t)r * 1024 + c;
                        if (PASS > 0) v += *(const f32x4*)mp;
                        if (PASS < 2) *(f32x4*)mp = v; else *(u32x2*)(MB + (size_t)r * 1024 + c) = pack4(v);
                    }
            }
    }
};

struct EpiF32 {
    static constexpr bool PERM = false, AFTER_DRAIN = false;
    float* O; int ldc;
    __device__ __forceinline__ void operator()(const f32x4 (&acc)[2][2][4][2], const Unit& u, int wr, int wc, int fr, int fq) const {
#pragma unroll
        for (int ai = 0; ai < 2; ++ai)
#pragma unroll
            for (int m = 0; m < 4; ++m) {
                const int r = u.pm * 256 + ai * 128 + wr * 64 + m * 16 + fr;
#pragma unroll
                for (int bj = 0; bj < 2; ++bj)
#pragma unroll
                    for (int n = 0; n < 2; ++n) {
                        const int c = u.pn * 256 + bj * 128 + wc * 32 + 16 * n + 4 * fq;
                        *(f32x4*)(O + (size_t)r * ldc + c) = acc[ai][bj][m][n];
                    }
            }
    }
};

struct EpiSwiglu {
    static constexpr bool PERM = true, AFTER_DRAIN = false;
    bf16_t* H; int ldh; int npn; int pm_sub;
    __device__ __forceinline__ void operator()(const f32x4 (&acc)[2][2][4][2], const Unit& u, int wr, int wc, int fr, int fq) const {
        const int pnn = u.pn % npn;
#pragma unroll
        for (int ai = 0; ai < 2; ++ai)
#pragma unroll
            for (int m = 0; m < 4; ++m) {
                const int r = (u.pm - pm_sub) * 256 + ai * 128 + wr * 64 + m * 16 + fr;
                const int hc = pnn * 128 + wc * 32 + 8 * fq;
                const f32x4 g0 = acc[ai][0][m][0], g1 = acc[ai][0][m][1], u0 = acc[ai][1][m][0], u1 = acc[ai][1][m][1];
                u32x4 w; w.x = pk2(siluf_(g0.x) * u0.x, siluf_(g0.y) * u0.y); w.y = pk2(siluf_(g0.z) * u0.z, siluf_(g0.w) * u0.w);
                w.z = pk2(siluf_(g1.x) * u1.x, siluf_(g1.y) * u1.y); w.w = pk2(siluf_(g1.z) * u1.z, siluf_(g1.w) * u1.w);
                *(u32x4*)(H + (size_t)r * ldh + hc) = w;
            }
    }
};

struct MoeSched {
    int ts[9]; int pm_lo, pm_hi, npn, G, c; bool a_local;
    __device__ __forceinline__ int expert_of(int pm) const { int e = 0;
#pragma unroll
        for (int q = 1; q < 8; ++q) e += (pm >= ts[q]) ? 1 : 0;
        return e; }
    __device__ __forceinline__ bool next(int i, Unit& u) const {
        const int n = (pm_hi - pm_lo) * npn; const long L = (long)i * G + c; if (L >= n) return false;
        const int pm = pm_lo + (int)L / npn, pnn = (int)L % npn;
        u.pm = a_local ? pm - pm_lo : pm; u.pn = expert_of(pm) * npn + pnn; return true;
    }
    __device__ __forceinline__ void a_ready(const Unit&) const {}
    __device__ __forceinline__ void done(const Unit&) const {}
};
struct EpiMoeDown {
    static constexpr bool PERM = false, AFTER_DRAIN = false;
    float* FS; long slot1_off; const int* LIST; const float* WTS; const unsigned* cnt; int ts[9]; int pm_lo;
    __device__ __forceinline__ void operator()(const f32x4 (&acc)[2][2][4][2], const Unit& u, int wr, int wc, int fr, int fq) const {
        const int e = u.pn >> 2, pnn = u.pn & 3, pmg = u.pm + pm_lo;
        int tse = 0;
#pragma unroll
        for (int q = 0; q < 8; ++q) tse = (q == e) ? ts[q] : tse;
        const int ne = (int)cnt[e];
#pragma unroll
        for (int ai = 0; ai < 2; ++ai)
#pragma unroll
            for (int m = 0; m < 4; ++m) {
                const int slot = (pmg - tse) * 256 + ai * 128 + wr * 64 + m * 16 + fr;
                if (slot < ne) {
                    const int tk = LIST[e * 16384 + slot]; const float w = WTS[e * 16384 + slot];
                    float* dst = FS + (long)(tk & 1) * slot1_off + (size_t)(tk >> 1) * 1024 + pnn * 256 + wc * 32 + 4 * fq;
#pragma unroll
                    for (int bj = 0; bj < 2; ++bj)
#pragma unroll
                        for (int n = 0; n < 2; ++n) *(f32x4*)(dst + bj * 128 + 16 * n) = acc[ai][bj][m][n] * w;
                }
            }
    }
};

constexpr float SC2 = 0.125f * 1.4426950408889634f;
constexpr int ATT_ROW = 144, ATT_VOFF = 9216, ATT_BUF = 27648;
constexpr float ATT_THR = 6.0f;
__device__ __forceinline__ float xhalf_max(float v) { auto rr = __builtin_amdgcn_permlane32_swap(__float_as_uint(v), __float_as_uint(v), false, false); return fmaxf(__uint_as_float(rr[0]), __uint_as_float(rr[1])); }
__device__ __forceinline__ float xhalf_sum(float v) { auto rr = __builtin_amdgcn_permlane32_swap(__float_as_uint(v), __float_as_uint(v), false, false); return __uint_as_float(rr[0]) + __uint_as_float(rr[1]); }

template <int DV, bool WINDOW>
__device__ __forceinline__ void attn_pass(LAS unsigned char* lds, const bf16_t* __restrict__ P, int qrow0, int qcol, int kcol, const bf16_t* __restrict__ VT,
                                          int lat_row0, int ctx_row0, int tile_lo, int tile_hi, bool has_ref, float m0, float l0, int qpos0,
                                          f32x16 (&o)[DV / 32], float& l_out, int wave, int lane) {
    int tid_ = threadIdx.x; asm volatile("" : "+v"(tid_)); const int tid = tid_; lane = tid & 63; const int qn = lane & 31, half = lane >> 5;
    bf16x8 qf[4];
    { const bf16_t* qp = P + (size_t)(qrow0 + wave * 32 + qn) * PP + qcol + half * 8;
#pragma unroll
      for (int ks = 0; ks < 4; ++ks) qf[ks] = *(const bf16x8*)(qp + ks * 16); }
    float mrun = has_ref ? m0 : 0.f, lrun = (half == 0) ? l0 : 0.f;
    bool need_ref = !has_ref;
    f32x16 negm;
#pragma unroll
    for (int i = 0; i < 16; ++i) negm[i] = -mrun;
#pragma unroll
    for (int db = 0; db < DV / 32; ++db)
#pragma unroll
        for (int i = 0; i < 16; ++i) o[db][i] = 0.f;
    const int nlat = tile_hi - tile_lo, nt = nlat + 4;
    u32x4 kreg[1], vreg[1][DV / 64];
    const int skey = tid >> 3, spc = tid & 7;
#define ATT_LOAD(ti_, set_) do { const int id_ = (ti_) < nlat ? tile_lo + (ti_) : 128 + ((ti_) - nlat); \
        const int krow0_ = id_ < 128 ? lat_row0 + 64 * id_ : ctx_row0 + 64 * (id_ - 128); \
        kreg[set_] = *(const u32x4*)(P + (size_t)(krow0_ + skey) * PP + kcol + spc * 8); \
        _Pragma("unroll") for (int j_ = 0; j_ < DV / 64; ++j_) { const int idx_ = tid + 512 * j_; vreg[set_][j_] = *(const u32x4*)(VT + (size_t)(idx_ >> 3) * KEYS + 64 * id_ + (idx_ & 7) * 8); } } while (0)
#define ATT_STORE(buf_, set_) do { LAS unsigned char* b_ = lds + (buf_) * ATT_BUF; *(LAS u32x4*)(b_ + skey * ATT_ROW + spc * 16) = kreg[set_]; \
        _Pragma("unroll") for (int j_ = 0; j_ < DV / 64; ++j_) { const int idx_ = tid + 512 * j_, dim_ = idx_ >> 3; *(LAS u32x4*)(b_ + ATT_VOFF + dim_ * ATT_ROW + (((idx_ & 7) ^ ((dim_ >> 4) & 1)) * 16)) = vreg[set_][j_]; } } while (0)
    __syncthreads();
    ATT_LOAD(0, 0); ATT_STORE(0, 0);
    if (nt > 1) ATT_LOAD(1, 0);
    __syncthreads();
    for (int ti0 = 0; ti0 < nt; ti0 += 1) {
#pragma unroll
      for (int dd = 0; dd < 1; ++dd) {
        const int ti = ti0 + dd;
        if (ti < nt) {
        const LAS unsigned char* Ks = lds + (ti & 1) * ATT_BUF; const LAS unsigned char* Vs = Ks + ATT_VOFF;
        const int id = ti < nlat ? tile_lo + ti : 128 + (ti - nlat);
        const bool islat = id < 128;
        bool skip = false;
        if (WINDOW && islat) { const int qw = qpos0 + wave * 32; skip = (64 * id + 63 < qw - 128 || 64 * id > qw + 31 + 128); }
        if (!skip) {
        f32x16 s[2];
#pragma unroll
        for (int mb = 0; mb < 2; ++mb) {
#pragma unroll
            for (int ks = 0; ks < 4; ++ks) {
                const bf16x8 kf = *(const LAS bf16x8*)(Ks + (32 * mb + qn) * ATT_ROW + ks * 32 + half * 16);
                if (ks == 0) s[mb] = __builtin_amdgcn_mfma_f32_32x32x16_bf16(kf, qf[0], negm, 0, 0, 0);
                else s[mb] = __builtin_amdgcn_mfma_f32_32x32x16_bf16(kf, qf[ks], s[mb], 0, 0, 0);
            }
        }
        if (WINDOW && islat) {
            const int qpos = qpos0 + wave * 32 + qn;
#pragma unroll
            for (int mb = 0; mb < 2; ++mb)
#pragma unroll
                for (int i = 0; i < 16; ++i) { const int d = 64 * id + 32 * mb + 8 * (i >> 2) + 4 * half + (i & 3) - qpos; if (d > 128 || d < -128) s[mb][i] = -INFINITY; }
        }
        float mx = s[0][0];
#pragma unroll
        for (int mb = 0; mb < 2; ++mb)
#pragma unroll
            for (int i = 0; i < 16; ++i) mx = fmaxf(mx, s[mb][i]);
        mx = xhalf_max(mx);
        if (__builtin_expect(need_ref || __any(mx > ATT_THR), 0)) {
            const float delta = need_ref ? mx : fmaxf(mx, 0.f);
            if (!need_ref) {
                const float alpha = __builtin_amdgcn_exp2f(-delta);
                lrun *= alpha;
#pragma unroll
                for (int db = 0; db < DV / 32; ++db)
#pragma unroll
                    for (int i = 0; i < 16; ++i) o[db][i] *= alpha;
            }
            mrun += delta; need_ref = false;
#pragma unroll
            for (int mb = 0; mb < 2; ++mb)
#pragma unroll
                for (int i = 0; i < 16; ++i) s[mb][i] -= delta;
#pragma unroll
            for (int i = 0; i < 16; ++i) negm[i] = -mrun;
        }
        float rs = 0.f;
#pragma unroll
        for (int mb = 0; mb < 2; ++mb)
#pragma unroll
            for (int i = 0; i < 16; ++i) { const float pv = __builtin_amdgcn_exp2f(s[mb][i]); s[mb][i] = pv; rs += pv; }
        lrun += rs;
#pragma unroll
        for (int g = 0; g < 4; ++g) {
            const int mb = g >> 1, bs = 8 * (g & 1);
            u32x4 pw; pw.x = pk2(s[mb][bs + 0], s[mb][bs + 1]); pw.y = pk2(s[mb][bs + 2], s[mb][bs + 3]); pw.z = pk2(s[mb][bs + 4], s[mb][bs + 5]); pw.w = pk2(s[mb][bs + 6], s[mb][bs + 7]);
            const bf16x8 pf = __builtin_bit_cast(bf16x8, pw);
#pragma unroll
            for (int db = 0; db < DV / 32; ++db) {
                const int dim = 32 * db + qn, sw = (dim >> 4) & 1;
                const LAS unsigned char* vrow = Vs + dim * ATT_ROW + 8 * half;
                const u32x2 lo = *(const LAS u32x2*)(vrow + (((2 * g) ^ sw) * 16)), hi = *(const LAS u32x2*)(vrow + (((2 * g + 1) ^ sw) * 16));
                const u32x4 vw = (u32x4){lo.x, lo.y, hi.x, hi.y};
                o[db] = __builtin_amdgcn_mfma_f32_32x32x16_bf16(__builtin_bit_cast(bf16x8, vw), pf, o[db], 0, 0, 0);
            }
        }
        }
        if (ti + 1 < nt) { ATT_STORE((ti + 1) & 1, 0); if (ti + 2 < nt) ATT_LOAD(ti + 2, 0); }
        __syncthreads();
        }
      }
    }
#undef ATT_LOAD
#undef ATT_STORE
    l_out = xhalf_sum(lrun);
}

__device__ __forceinline__ void swa_unit(LAS unsigned char* lds, const Params& p, int layer, int b, int hq, int qb, bool ctx, int wave, int lane, bool dry = false) {
    const bf16_t* P = (const bf16_t*)(p.ws + WS_P); bf16_t* YA = (bf16_t*)(p.ws + WS_YA);
    const int kvh = hq >> 2;
    const bf16_t* VT = (const bf16_t*)(p.ws + WS_VTS) + (size_t)((b * 2 + kvh) * 64) * KEYS;
    const float sink2 = p.in[11][layer * 8 + hq] * 1.4426950408889634f;
    const int qrow0 = ctx ? NLAT + b * CTXL : b * SEQ + qb * 256;
    f32x16 o[2]; float l;
    if (ctx) attn_pass<64, false>(lds, P, qrow0, IC_QS + hq * 64, IC_KS + kvh * 64, VT, b * SEQ, NLAT + b * CTXL, 0, 0, true, sink2, 1.0f, 0, o, l, wave, lane);
    else {
        int lo = 4 * qb - 2; if (lo < 0) lo = 0; int hi = 4 * qb + 6; if (hi > 128) hi = 128;
        attn_pass<64, true>(lds, P, qrow0, IC_QS + hq * 64, IC_KS + kvh * 64, VT, b * SEQ, NLAT + b * CTXL, lo, hi, true, sink2, 1.0f, qb * 256, o, l, wave, lane);
    }
    const float inv = 1.0f / l; const int qn = lane & 31, half = lane >> 5;
    bf16_t* dst = YA + (size_t)(qrow0 + wave * 32 + qn) * 512 + hq * 64 + 4 * half;
#pragma unroll
    for (int db = 0; db < 2; ++db)
#pragma unroll
        for (int q4 = 0; q4 < 4; ++q4) {
            const f32x4 v = (f32x4){o[db][4 * q4] * inv, o[db][4 * q4 + 1] * inv, o[db][4 * q4 + 2] * inv, o[db][4 * q4 + 3] * inv};
            if (!dry) *(u32x2*)(dst + 32 * db + 8 * q4) = pack4(v);
        }
}
__device__ __forceinline__ void diff_unit(LAS unsigned char* lds, const Params& p, float lam, int b, int h, int qb, bool ctx, int wave, int lane, bool dry = false) {
    bf16_t* P = (bf16_t*)(p.ws + WS_P);
    const bf16_t* VT = (const bf16_t*)(p.ws + WS_VTD) + (size_t)((b * 4 + h) * 128) * KEYS;
    const int qrow0 = ctx ? NLAT + b * CTXL : b * SEQ + qb * 256;
    const int thi = ctx ? 0 : 128;
    LAS unsigned* park = (LAS unsigned*)(lds + 73728) + threadIdx.x;
    f32x16 o[4]; float l;
    attn_pass<128, false>(lds, P, qrow0, IC_QD + h * 128, IC_KD + h * 128, VT, b * SEQ, NLAT + b * CTXL, 0, thi, false, 0.f, 0.f, 0, o, l, wave, lane);
    { const float inv = 1.0f / l;
#pragma unroll
      for (int db = 0; db < 4; ++db)
#pragma unroll
          for (int i = 0; i < 8; ++i) park[(db * 8 + i) * 512] = pk2(o[db][2 * i] * inv, o[db][2 * i + 1] * inv); }
    attn_pass<128, false>(lds, P, qrow0, IC_QD + h * 128 + 64, IC_KD + h * 128 + 64, VT, b * SEQ, NLAT + b * CTXL, 0, thi, false, 0.f, 0.f, 0, o, l, wave, lane);
    const float inv = lam / l; const int qn = lane & 31, half = lane >> 5;
    bf16_t* dst = P + (size_t)(qrow0 + wave * 32 + qn) * PP + IC_QD + h * 128 + 4 * half;
#pragma unroll
    for (int db = 0; db < 4; ++db)
#pragma unroll
        for (int q4 = 0; q4 < 4; ++q4) {
            const unsigned pa = park[(db * 8 + 2 * q4) * 512], pb = park[(db * 8 + 2 * q4 + 1) * 512];
            const f32x4 v = (f32x4){bflo(pa) - o[db][4 * q4] * inv, bfhi(pa) - o[db][4 * q4 + 1] * inv, bflo(pb) - o[db][4 * q4 + 2] * inv, bfhi(pb) - o[db][4 * q4 + 3] * inv};
            if (!dry) *(u32x2*)(dst + 32 * db + 8 * q4) = pack4(v);
        }
}

__device__ __forceinline__ void ld8bf(const bf16_t* p, float (&v)[8]) { const u32x4 w = *(const u32x4*)p; v[0] = bflo(w.x); v[1] = bfhi(w.x); v[2] = bflo(w.y); v[3] = bfhi(w.y); v[4] = bflo(w.z); v[5] = bfhi(w.z); v[6] = bflo(w.w); v[7] = bfhi(w.w); }
__device__ __forceinline__ void ld8f(const float* p, float (&v)[8]) { const f32x4 a = ((const f32x4*)p)[0], b = ((const f32x4*)p)[1]; v[0] = a.x; v[1] = a.y; v[2] = a.z; v[3] = a.w; v[4] = b.x; v[5] = b.y; v[6] = b.z; v[7] = b.w; }
__device__ __forceinline__ void st8f(float* p, const float (&v)[8]) { ((f32x4*)p)[0] = (f32x4){v[0], v[1], v[2], v[3]}; ((f32x4*)p)[1] = (f32x4){v[4], v[5], v[6], v[7]}; }

__device__ __forceinline__ void rwkv_prepare_phase(const Params& p, int layer, int gw, int NGW, int lane) {
    const bf16_t* P = (const bf16_t*)(p.ws + WS_P); float* ST = (float*)(p.ws + WS_ST); bf16_t* A2 = (bf16_t*)(p.ws + WS_YA);
    const float* mup = p.in[12] + layer * 1920; const float* mun = p.in[13] + layer * 1920; const float* k_k = p.in[19] + layer * 512;
    for (int m = gw; m < NTOK; m += NGW) {
        const int t = m < NLAT ? (m & (SEQ - 1)) : ((m - NLAT) & (CTXL - 1)), len = m < NLAT ? SEQ : CTXL;
        const bool hp = t > 0, hn = t < len - 1;
        const bf16_t* pr = P + (size_t)m * PP + IC_RW;
        const int h = lane >> 3, kidx = (lane & 7) * 8;
        float* sp = ST + ((size_t)m * 8 + h) * (ST_SLOTS * 64) + kidx;
#pragma unroll
        for (int sec = 0; sec < 4; ++sec) {
            if (sec == 3 && lane >= 48) break;
            const int col = sec < 3 ? sec * 512 + lane * 8 : 1536 + lane * 8;
            float c[8], pv[8], nx[8], a[8], bb[8], sh[8];
            ld8bf(pr + col, c);
            if (hp) ld8bf(pr - PP + col, pv); else {
#pragma unroll
                for (int q = 0; q < 8; ++q) pv[q] = 0.f; }
            if (hn) ld8bf(pr + PP + col, nx); else {
#pragma unroll
                for (int q = 0; q < 8; ++q) nx[q] = 0.f; }
            ld8f(mup + col, a); ld8f(mun + col, bb);
#pragma unroll
            for (int q = 0; q < 8; ++q) sh[q] = c[q] + a[q] * (pv[q] - c[q]) + bb[q] * (nx[q] - c[q]);
            if (sec == 0) st8f(sp + 1 * 64, sh);
            else if (sec == 2) st8f(sp + 2 * 64, sh);
            else if (sec == 1) {
                st8f(sp + 5 * 64, sh); st8f(sp + 8 * 64, sh);
                float kk[8], kkw[8]; ld8f(k_k + lane * 8, kkw);
                float ss = 0.f;
#pragma unroll
                for (int q = 0; q < 8; ++q) { kk[q] = sh[q] * kkw[q]; ss += kk[q] * kk[q]; }
                ss += __shfl_xor(ss, 1); ss += __shfl_xor(ss, 2); ss += __shfl_xor(ss, 4);
                const float inv = 1.0f / fmaxf(sqrtf(ss), 1e-12f);
#pragma unroll
                for (int q = 0; q < 8; ++q) kk[q] *= inv;
                st8f(sp, kk);
            } else {
                float o[8];
#pragma unroll
                for (int q = 0; q < 8; ++q) o[q] = lane < 16 ? tanhf(sh[q]) : (lane < 32 ? sh[q] : sigmoidf_(sh[q]));
                u32x4 w; w.x = pk2(o[0], o[1]); w.y = pk2(o[2], o[3]); w.z = pk2(o[4], o[5]); w.w = pk2(o[6], o[7]);
                *(u32x4*)(A2 + (size_t)m * 384 + lane * 8) = w;
            }
        }
    }
}

constexpr int NSEG = 64, SEGL = KEYS / NSEG;
static_assert(SEGL * NSEG == KEYS && SEGL % 4 == 0, "segments");
constexpr size_t WS_GH = WS_YA;
static_assert(WS_GH + 32ull * NSEG * 2 * 4096 * 4 <= 560 * MiB, "GH fits behind the stream");
__device__ __forceinline__ int scan_token(int b, int dir, int s) {
    if (s < CTXL) return NLAT + b * CTXL + (dir ? CTXL - 1 - s : s);
    const int t = s - CTXL; return b * SEQ + (dir ? SEQ - 1 - t : t);
}
constexpr int SRING = 6, SREC = ST_SLOTS * 64 * 4;
constexpr int SCAN_LDS = SRING * SREC;
__device__ __forceinline__ void scan_dma(const float* rec, LAS unsigned char* slot, int lane) {
    const float* q = rec + lane * 4;
    __builtin_amdgcn_global_load_lds((const unsigned*)q, (LAS unsigned*)slot, 16, 0, 0);
    __builtin_amdgcn_global_load_lds((const unsigned*)(q + 256), (LAS unsigned*)(slot + 1024), 16, 0, 0);
    if (lane < 16) __builtin_amdgcn_global_load_lds((const unsigned*)(q + 512), (LAS unsigned*)(slot + 2048), 16, 0, 0);
}
template <int MODE>
__device__ __forceinline__ void rwkv_segment(const Params& p, int sid, int seg, int lane, LAS unsigned char* ring) {
    const int b = sid >> 4, h = (sid >> 1) & 7, dir = sid & 1, c = lane & 31, hf = lane >> 5;
    const float* ST = (const float*)(p.ws + WS_ST);
    float* gh = (float*)(p.ws + WS_GH) + ((size_t)sid * NSEG + seg) * 2 * 4096;
    f32x16 TH[2][2], TG[MODE == 0 ? 2 : 1][2];
#pragma unroll
    for (int kb = 0; kb < 2; ++kb)
#pragma unroll
        for (int vb = 0; vb < 2; ++vb) {
            if (MODE == 2 && seg > 0) {
                const float* src = gh - 4096 + (32 * vb + c) * 64 + 32 * kb + 4 * hf;
#pragma unroll
                for (int q = 0; q < 4; ++q) { const f32x4 t = *(const f32x4*)(src + 8 * q); TH[kb][vb][4 * q] = t.x; TH[kb][vb][4 * q + 1] = t.y; TH[kb][vb][4 * q + 2] = t.z; TH[kb][vb][4 * q + 3] = t.w; }
            } else {
#pragma unroll
                for (int r = 0; r < 16; ++r) TH[kb][vb][r] = 0.f;
            }
            if (MODE == 0) {
#pragma unroll
                for (int r = 0; r < 16; ++r) TG[MODE == 0 ? kb : 0][vb][r] = (32 * kb + 8 * (r >> 2) + 4 * hf + (r & 3) == 32 * vb + c) ? 1.0f : 0.0f;
            }
        }
    const int s0 = seg * SEGL, s_end = s0 + SEGL, od = (3 + 3 * dir) * 256;
#pragma unroll 1
    for (int j = 0; j < SRING - 1; ++j) scan_dma(ST + ((size_t)scan_token(b, dir, s0 + j) * 8 + h) * (ST_SLOTS * 64), ring + j * SREC, lane);
    int slot_i = 0;
#pragma unroll 1
    for (int s = s0; s < s_end; ++s) {
        if (s + SRING - 1 < s_end) {
            int nslot = slot_i + SRING - 1; if (nslot >= SRING) nslot -= SRING;
            scan_dma(ST + ((size_t)scan_token(b, dir, s + SRING - 1) * 8 + h) * (ST_SLOTS * 64), ring + nslot * SREC, lane);
            asm volatile("s_waitcnt vmcnt(15)" ::: "memory");
        } else asm volatile("s_waitcnt vmcnt(0)" ::: "memory");
        const LAS unsigned char* rec = ring + slot_i * SREC;
        slot_i = slot_i + 1 == SRING ? 0 : slot_i + 1;
        float ph[2] = {0.f, 0.f}, pg[2] = {0.f, 0.f};
#pragma unroll
        for (int kb = 0; kb < 2; ++kb)
#pragma unroll
            for (int q = 0; q < 4; ++q) {
                const f32x4 a4 = *(const LAS f32x4*)(rec + (32 * kb + 8 * q + 4 * hf) * 4);
#pragma unroll
                for (int j = 0; j < 4; ++j)
#pragma unroll
                    for (int vb = 0; vb < 2; ++vb) { ph[vb] = fmaf(TH[kb][vb][4 * q + j], a4[j], ph[vb]); if (MODE == 0) pg[vb] = fmaf(TG[MODE == 0 ? kb : 0][vb][4 * q + j], a4[j], pg[vb]); }
            }
        float sa[2], sg[2];
#pragma unroll
        for (int vb = 0; vb < 2; ++vb) { sa[vb] = xhalf_sum(ph[vb]); sg[vb] = MODE == 0 ? xhalf_sum(pg[vb]) : 0.f; }
#pragma unroll
        for (int kb = 0; kb < 2; ++kb)
#pragma unroll
            for (int q = 0; q < 4; ++q) {
                const f32x4 w4 = *(const LAS f32x4*)(rec + od + (32 * kb + 8 * q + 4 * hf) * 4);
#pragma unroll
                for (int j = 0; j < 4; ++j)
#pragma unroll
                    for (int vb = 0; vb < 2; ++vb) { TH[kb][vb][4 * q + j] *= w4[j]; if (MODE == 0) TG[MODE == 0 ? kb : 0][vb][4 * q + j] *= w4[j]; }
            }
        float aop[2], bop[2], bopg[2];
#pragma unroll
        for (int kb = 0; kb < 2; ++kb) aop[kb] = *(const LAS float*)(rec + od + (hf ? 512 : 256) + (32 * kb + c) * 4);
#pragma unroll
        for (int vb = 0; vb < 2; ++vb) { const float vv = *(const LAS float*)(rec + 512 + (32 * vb + c) * 4); bop[vb] = hf ? vv : sa[vb]; bopg[vb] = hf ? 0.f : sg[vb]; }
#pragma unroll
        for (int kb = 0; kb < 2; ++kb)
#pragma unroll
            for (int vb = 0; vb < 2; ++vb) {
                TH[kb][vb] = __builtin_amdgcn_mfma_f32_32x32x2f32(aop[kb], bop[vb], TH[kb][vb], 0, 0, 0);
                if (MODE == 0) TG[MODE == 0 ? kb : 0][vb] = __builtin_amdgcn_mfma_f32_32x32x2f32(aop[kb], bopg[vb], TG[MODE == 0 ? kb : 0][vb], 0, 0, 0);
            }
        if (MODE == 2) {
            float py[2] = {0.f, 0.f};
#pragma unroll
            for (int kb = 0; kb < 2; ++kb)
#pragma unroll
                for (int q = 0; q < 4; ++q) {
                    const f32x4 r4 = *(const LAS f32x4*)(rec + 256 + (32 * kb + 8 * q + 4 * hf) * 4);
#pragma unroll
                    for (int j = 0; j < 4; ++j)
#pragma unroll
                        for (int vb = 0; vb < 2; ++vb) py[vb] = fmaf(TH[kb][vb][4 * q + j], r4[j], py[vb]);
                }
            const float y0 = xhalf_sum(py[0]), y1 = xhalf_sum(py[1]);
            float* yp = (float*)ST + ((size_t)scan_token(b, dir, s) * 8 + h) * (ST_SLOTS * 64) + (3 + 3 * dir) * 64 + c;
            if (hf == 0) { yp[0] = y0; yp[32] = y1; }
        }
    }
    if (MODE == 0) {
#pragma unroll
        for (int kb = 0; kb < 2; ++kb)
#pragma unroll
            for (int vb = 0; vb < 2; ++vb) {
                float* dg = gh + (32 * vb + c) * 64 + 32 * kb + 4 * hf; float* dh = dg + 4096;
#pragma unroll
                for (int q = 0; q < 4; ++q) {
                    *(f32x4*)(dg + 8 * q) = (f32x4){TG[MODE == 0 ? kb : 0][vb][4 * q], TG[MODE == 0 ? kb : 0][vb][4 * q + 1], TG[MODE == 0 ? kb : 0][vb][4 * q + 2], TG[MODE == 0 ? kb : 0][vb][4 * q + 3]};
                    *(f32x4*)(dh + 8 * q) = (f32x4){TH[kb][vb][4 * q], TH[kb][vb][4 * q + 1], TH[kb][vb][4 * q + 2], TH[kb][vb][4 * q + 3]};
                }
            }
    }
}
__device__ __forceinline__ void rwkv_combine(const Params& p, int sid, LAS unsigned char* lds, int wave, int lane) {
    float* gh0 = (float*)(p.ws + WS_GH) + (size_t)sid * NSEG * 2 * 4096;
    LAS float* Sx = (LAS float*)lds;
    const int tid = wave * 64 + lane;
    for (int e = tid; e < 4096; e += NTHREADS) Sx[(e >> 6) * 65 + (e & 63)] = gh0[4096 + e];
    __syncthreads();
    const int rb = (wave >> 1) & 1, cb = wave & 1, i32 = lane & 31, hf = lane >> 5;
    for (int i = 1; i < NSEG - 1; ++i) {
        float* gi = gh0 + (size_t)i * 2 * 4096;
        f32x16 d;
        if (wave < 4) {
            float bq[32];
#pragma unroll
            for (int q = 0; q < 32; ++q) bq[q] = gi[(2 * q + hf) * 64 + 32 * cb + i32];
#pragma unroll
            for (int r = 0; r < 16; ++r) d[r] = gi[4096 + (32 * rb + 8 * (r >> 2) + 4 * hf + (r & 3)) * 64 + 32 * cb + i32];
#pragma unroll
            for (int q = 0; q < 32; ++q) {
                const float aq = Sx[(32 * rb + i32) * 65 + 2 * q + hf];
                d = __builtin_amdgcn_mfma_f32_32x32x2f32(aq, bq[q], d, 0, 0, 0);
            }
#pragma unroll
            for (int r = 0; r < 16; ++r) gi[4096 + (32 * rb + 8 * (r >> 2) + 4 * hf + (r & 3)) * 64 + 32 * cb + i32] = d[r];
        }
        __syncthreads();
        if (wave < 4) {
#pragma unroll
            for (int r = 0; r < 16; ++r) Sx[(32 * rb + 8 * (r >> 2) + 4 * hf + (r & 3)) * 65 + 32 * cb + i32] = d[r];
        }
        __syncthreads();
    }
}

__device__ __forceinline__ void postmix_phase(const Params& p, int layer, float lam_init, int M, int gw, int NGW, int lane) {
    const bf16_t* P = (const bf16_t*)(p.ws + WS_P); const float* ST = (const float*)(p.ws + WS_ST);
    bf16_t* YB = (bf16_t*)(p.ws + WS_YB); bf16_t* YC = (bf16_t*)(p.ws + WS_YC);
    const float* r_k = p.in[21] + layer * 512; const float* lng = p.in[22] + layer * 512; const float* lnb = p.in[23] + layer * 512; const float* sg = p.in[25] + layer * 128;
    for (int m = gw; m < M; m += NGW) {
        {
            const int h = lane >> 3, kidx = (lane & 7) * 8, ch = lane * 8;
            const float* sp = ST + ((size_t)m * 8 + h) * (ST_SLOTS * 64) + kidx;
            float y[8], r[8], v[8], k0[8], k1[8], rk[8], g[8], lg[8], lb[8];
            { float yb_[8]; ld8f(sp + 3 * 64, y); ld8f(sp + 6 * 64, yb_);
#pragma unroll
              for (int q = 0; q < 8; ++q) y[q] += yb_[q]; }
            ld8f(sp + 64, r); ld8f(sp + 128, v); ld8f(sp + 5 * 64, k0); ld8f(sp + 8 * 64, k1); ld8f(r_k + ch, rk); ld8f(lng + ch, lg); ld8f(lnb + ch, lb);
            ld8bf(P + (size_t)m * PP + IC_RW + ch, g);
            float s = 0.f, bn = 0.f;
#pragma unroll
            for (int q = 0; q < 8; ++q) { s += y[q]; bn += r[q] * (k0[q] + k1[q]) * rk[q]; }
            s += __shfl_xor(s, 1); s += __shfl_xor(s, 2); s += __shfl_xor(s, 4);
            bn += __shfl_xor(bn, 1); bn += __shfl_xor(bn, 2); bn += __shfl_xor(bn, 4);
            const float mu = s * (1.0f / 64.0f);
            float var = 0.f;
#pragma unroll
            for (int q = 0; q < 8; ++q) { const float d = y[q] - mu; var += d * d; }
            var += __shfl_xor(var, 1); var += __shfl_xor(var, 2); var += __shfl_xor(var, 4);
            const float rstd = 1.0f / sqrtf(var * (1.0f / 64.0f) + 64e-5f);
            float o[8];
#pragma unroll
            for (int q = 0; q < 8; ++q) o[q] = (((y[q] - mu) * rstd) * lg[q] + lb[q] + bn * v[q]) * g[q];
            u32x4 w; w.x = pk2(o[0], o[1]); w.y = pk2(o[2], o[3]); w.z = pk2(o[4], o[5]); w.w = pk2(o[6], o[7]);
            *(u32x4*)(YB + (size_t)m * 512 + ch) = w;
        }
        {
            const int e = (lane & 15) * 8;
            float x[8], gg[8];
            ld8bf(P + (size_t)m * PP + IC_QD + lane * 8, x); ld8f(sg + e, gg);
            float ss = 0.f;
#pragma unroll
            for (int q = 0; q < 8; ++q) ss += x[q] * x[q];
            ss += __shfl_xor(ss, 1); ss += __shfl_xor(ss, 2); ss += __shfl_xor(ss, 4); ss += __shfl_xor(ss, 8);
            const float rstd = (1.0f - lam_init) / sqrtf(ss * (1.0f / 128.0f) + 1e-5f);
            float o[8];
#pragma unroll
            for (int q = 0; q < 8; ++q) o[q] = x[q] * rstd * gg[q];
            u32x4 w; w.x = pk2(o[0], o[1]); w.y = pk2(o[2], o[3]); w.z = pk2(o[4], o[5]); w.w = pk2(o[6], o[7]);
            *(u32x4*)(YC + (size_t)m * 512 + lane * 8) = w;
        }
    }
}
#define XB_TMO      128
#define XB_XCNT(j)  (256  + 64 * (j))
#define XB_XSUB(j)  (1280 + 64 * (j))
#define XB_XGEN(j)  (2304 + 64 * (j))
#define XB_TOP      3328
#define XB_TOPGEN   3392
#define XCD_BAR_WORDS 3456
#define XB_SPIN_CAP (1u << 18)

__device__ __forceinline__ unsigned xb_ld(unsigned* p)              { return __hip_atomic_load(p, __ATOMIC_RELAXED, __HIP_MEMORY_SCOPE_AGENT); }
__device__ __forceinline__ unsigned xb_add(unsigned* p, unsigned v) { return __hip_atomic_fetch_add(p, v, __ATOMIC_RELAXED, __HIP_MEMORY_SCOPE_AGENT); }
__device__ __forceinline__ unsigned xb_xcc_id() { return (unsigned)__builtin_amdgcn_s_getreg((3 << 11) | 20) & 0xFu; }
#define XB_SPIN(cond, bar) do { unsigned _sp = 0; while (cond) { __builtin_amdgcn_s_sleep(1); \
    if ((++_sp & 255u) == 0u) { if (xb_ld(&(bar)[XB_TMO])) break; if (_sp > XB_SPIN_CAP) { atomicAdd(&(bar)[XB_TMO], 1u); break; } } } } while (0)

struct XcdBarrier {
    unsigned* bar; unsigned x;
    volatile LAS unsigned* st;
};

__device__ __forceinline__ XcdBarrier xcd_barrier_post(unsigned* bar, volatile LAS unsigned* st) {
    XcdBarrier b; b.bar = bar; b.x = xb_xcc_id(); b.st = st;
    if (threadIdx.x == 0) (void)xb_add(&bar[XB_XCNT(b.x)], 1u);
    return b;
}
__device__ __forceinline__ void xcd_barrier_complete(unsigned* bar, unsigned x, unsigned& nloc, unsigned& nx) {
    const unsigned G = gridDim.x * gridDim.y * gridDim.z;
    unsigned sum, cnt, mine, sp = 0u;
    for (;;) {
        sum = 0u; cnt = 0u; mine = 0u;
#pragma unroll
        for (unsigned j = 0; j < 16; ++j) { const unsigned c = xb_ld(&bar[XB_XCNT(j)]); sum += c; cnt += (c > 0u) ? 1u : 0u; mine = (j == x) ? c : mine; }
        if (sum == G) break;
        __builtin_amdgcn_s_sleep(1);
        if ((++sp & 255u) == 0u) { if (xb_ld(&bar[XB_TMO])) break; if (sp > XB_SPIN_CAP) { atomicAdd(&bar[XB_TMO], 1u); break; } }
    }
    nloc = mine > 0u ? mine : 1u; nx = cnt > 0u ? cnt : 1u;
}

__device__ __forceinline__ void xcd_barrier(const XcdBarrier& b) {
    asm volatile("s_waitcnt vmcnt(0)" ::: "memory");
    __syncthreads();
    if (threadIdx.x == 0) {
        unsigned* bar = b.bar;
        __builtin_amdgcn_s_waitcnt(0);
        unsigned nloc = b.st[0], nx = b.st[1];
        if (nloc == 0u) { xcd_barrier_complete(bar, b.x, nloc, nx); b.st[0] = nloc; b.st[1] = nx; }
        const unsigned old = xb_add(&bar[XB_XSUB(b.x)], 1u);
        const unsigned gen = old / nloc;
        if (old + 1u == (gen + 1u) * nloc) {
            __builtin_amdgcn_fence(__ATOMIC_RELEASE, "agent");
            asm volatile("s_waitcnt vmcnt(0)" ::: "memory");
            const unsigned og = xb_add(&bar[XB_TOP], 1u);
            const unsigned tg = og / nx;
            if (og + 1u == (tg + 1u) * nx) xb_add(&bar[XB_TOPGEN], 1u);
            else XB_SPIN(xb_ld(&bar[XB_TOPGEN]) == tg, bar);
            __builtin_amdgcn_fence(__ATOMIC_ACQUIRE, "agent");
            xb_add(&bar[XB_XGEN(b.x)], 1u);
            asm volatile("s_waitcnt vmcnt(0)" ::: "memory");
        } else {
            XB_SPIN(xb_ld(&bar[XB_XGEN(b.x)]) == gen, bar);
            __builtin_amdgcn_fence(__ATOMIC_ACQUIRE, "agent");
            asm volatile("s_waitcnt vmcnt(0)" ::: "memory");
        }
    }
    __syncthreads();
}

#ifndef MK_MULTI
#define MK_MULTI 0
#endif
constexpr int N_PHASES = 40;

constexpr int LDS_PARAMS = LDS_BYTES - 1024;
constexpr int LDS_XB = LDS_BYTES - 64;
constexpr int CW_BAR = 8192;
__device__ __forceinline__ unsigned long long uni64(unsigned long long v) {
    const unsigned lo = __builtin_amdgcn_readfirstlane((unsigned)v), hi = __builtin_amdgcn_readfirstlane((unsigned)(v >> 32));
    return ((unsigned long long)hi << 32) | lo;
}
__device__ __forceinline__ int opq(int v) { asm volatile("" : "+s"(v)); return v; }
__device__ __forceinline__ void load_params(LAS unsigned char* lds, Params& q) {
    LAS const unsigned long long* s = (LAS const unsigned long long*)(lds + LDS_PARAMS);
#pragma unroll
    for (int i = 0; i < 37; ++i) q.in[i] = (const float*)(const __attribute__((address_space(1))) float*)uni64(s[i]);
    q.out = (float*)(__attribute__((address_space(1))) float*)uni64(s[37]); q.ws = (unsigned char*)(__attribute__((address_space(1))) unsigned char*)uni64(s[38]); q.ph_lo = 0; q.ph_hi = 0;
}
__global__ void __launch_bounds__(NTHREADS, 2) mk_fwd(Params kp) {
    extern __shared__ __attribute__((aligned(16))) unsigned char lds_raw[];
    LAS unsigned char* lds = (LAS unsigned char*)lds_raw;
    cg::grid_group grid = cg::this_grid();
    if (threadIdx.x == 0) {
        LAS unsigned long long* s = (LAS unsigned long long*)(lds + LDS_PARAMS);
#pragma unroll
        for (int i = 0; i < 37; ++i) s[i] = (unsigned long long)kp.in[i];
        s[37] = (unsigned long long)kp.out; s[38] = (unsigned long long)kp.ws;
    }
    if (threadIdx.x < 2) ((LAS unsigned*)(lds + LDS_XB))[threadIdx.x] = 0u;
    __syncthreads();
#if !MK_MULTI
    (void)xcd_barrier_post((unsigned*)(kp.ws + WS_CTL) + CW_BAR, (volatile LAS unsigned*)(lds + LDS_XB));
#endif
    const int ph_lo = kp.ph_lo, ph_hi = kp.ph_hi;
    int ph = 0;
#define PH_BEGIN if (ph >= ph_lo && ph < ph_hi) { asm volatile("" ::: "memory"); Params p; load_params(lds, p); unsigned char* ws = p.ws; (void)ws; \
    int tid_ = threadIdx.x, bid_ = blockIdx.x, G_ = gridDim.x; asm volatile("" : "+v"(tid_), "+s"(bid_), "+s"(G_)); \
    const int tid = tid_, bid = bid_, G = G_, lane = tid & 63, wave = __builtin_amdgcn_readfirstlane(tid >> 6); const int gw = bid * NWAVES + wave, NGW = G * NWAVES; (void)gw; (void)NGW; (void)lane; (void)tid; (void)G; (void)bid;
#define GRID_SEAM() do { if (ph == 0) grid.sync(); else { XcdBarrier xb_; xb_.bar = (unsigned*)((unsigned char*)(__attribute__((address_space(1))) unsigned char*)uni64(((LAS const unsigned long long*)(lds + LDS_PARAMS))[38]) + WS_CTL) + CW_BAR; \
        xb_.x = xb_xcc_id(); xb_.st = (volatile LAS unsigned*)(lds + LDS_XB); xcd_barrier(xb_); } } while (0)
#define PH_END } if (ph >= ph_lo && ph + 1 < ph_hi) GRID_SEAM(); ++ph;

    using pg8::Gemm; using pg8::StaticOrder; using pg8::gemm_phase;

    PH_BEGIN
        convert_layer_weights(p, 0, lds, gw, NGW, wave, lane);
        __syncthreads();
        adaln_phase(p, lds, wave, lane);
    PH_END
    PH_BEGIN
        premix_phase(p, 0, true, NTOK, gw, NGW, lane);
    PH_END

#pragma clang loop unroll(full)
    for (int layer = 0; layer < 2; ++layer) {
        const int Ml = layer == 0 ? NTOK : NLAT;
        const float lam_init = 0.8f - 0.6f * expf(-0.3f * (float)layer);
        PH_BEGIN
            Gemm g{(const bf16_t*)(ws + WS_XN), (const bf16_t*)(ws + WS_WIN), NTOK, NIN1, opq(1024)}; StaticOrder S; S.init(NTOK, NIN1, G, bid);
            EpiIn E{(bf16_t*)(ws + WS_P), (bf16_t*)(ws + WS_VTS), (bf16_t*)(ws + WS_VTD), (const float*)(ws + WS_ROPE)};
            gemm_phase<EpiIn, StaticOrder, true, true>(lds, g, S, E);
        PH_END
        PH_BEGIN
            rwkv_prepare_phase(p, layer, gw, NGW, lane);
        PH_END
        PH_BEGIN
            Gemm g{(const bf16_t*)(ws + WS_YA), (const bf16_t*)(ws + WS_LORA), NTOK, 2560, opq(384)}; StaticOrder S; S.init(NTOK, 2560, G, bid);
            EpiLora E{(float*)(ws + WS_ST), (bf16_t*)(ws + WS_P), p.in[14] + layer * 1024, p.in[16] + layer * 1024, p.in[20] + layer * 512};
            gemm_phase<EpiLora, StaticOrder, true, true>(lds, g, S, E);
        PH_END
        PH_BEGIN
            for (int u = gw; u < 32 * (NSEG - 1); u += NGW) rwkv_segment<0>(p, u / (NSEG - 1), u % (NSEG - 1), lane, lds + wave * SCAN_LDS);
        PH_END
        PH_BEGIN
            if (bid < 32) rwkv_combine(p, bid, lds, wave, lane);
        PH_END
        PH_BEGIN
            for (int u = gw; u < 32 * NSEG; u += NGW) rwkv_segment<2>(p, u / NSEG, u % NSEG, lane, lds + wave * SCAN_LDS);
        PH_END
        PH_BEGIN
            float lam;
            { const float* lv = p.in[24] + layer * 256;
              const float s1 = wave_sum(lv[lane] * lv[64 + lane]), s2 = wave_sum(lv[128 + lane] * lv[192 + lane]);
              lam = expf(s1) - expf(s2) + lam_init; }
            unsigned* qhead = (unsigned*)(ws + WS_CTL) + (layer == 0 ? CW_Q0 : CW_Q1);
            LAS int* ubox = (LAS int*)(lds + 65536);
            const int n_diff = 64, n_swa = 512, n_ctx = layer == 0 ? 24 : 0;
            const int n_units = 256 + 512 + n_ctx; (void)n_diff; (void)n_swa;
            const bool static_diff = (G == 256);
            bool first = static_diff;
            const int n_rep = 1;
            for (;;) {
                int uq;
                if (first) uq = n_units * (n_rep - 1) + ((((bid & 7) >> 2) << 7) | ((bid & 3) << 5) | (bid >> 3));
                else {
                    if (tid == 0) ubox[0] = (int)atomicAdd(qhead, 1u);
                    __syncthreads();
                    uq = ubox[0];
                    __syncthreads();
                }
                if (uq >= n_units * n_rep) break;
                const bool dry = uq < n_units * (n_rep - 1);
                const int u = uq % n_units;
                if (!first && static_diff && !dry && u < 256) continue;
                first = false;
                if (u < 256) diff_unit(lds, p, lam, u >> 7, (u >> 5) & 3, u & 31, false, wave, lane, dry);
                else if (u < 768) { const int v = u - 256; swa_unit(lds, p, layer, v >> 8, (v >> 5) & 7, v & 31, false, wave, lane, dry); }
                else if (u < 776) { const int v = u - 768; diff_unit(lds, p, lam, v >> 2, v & 3, 0, true, wave, lane, dry); }
                else { const int v = u - 776; swa_unit(lds, p, layer, v >> 3, v & 7, 0, true, wave, lane, dry); }
            }
        PH_END

        PH_BEGIN
            postmix_phase(p, layer, lam_init, Ml, gw, NGW, lane);
            if (layer == 0) convert_ffn_weights(p, lds, gw, NGW, wave, lane);
        PH_END
        PH_BEGIN
            Gemm g{(const bf16_t*)(ws + WS_XN), (const bf16_t*)(ws + WS_WIN) + (size_t)NIN1 * 1024, Ml, 3072, opq(1024)}; StaticOrder S; S.init(Ml, 3072, G, bid);
            EpiGate E{(bf16_t*)(ws + WS_G)};
            gemm_phase<EpiGate, StaticOrder, true, true>(lds, g, S, E);
        PH_END
        PH_BEGIN
            StaticOrder S; S.init(Ml, 1024, G, bid);
            { Gemm g{(const bf16_t*)(ws + WS_YA), (const bf16_t*)(ws + WS_PRJ), Ml, 1024, opq(512)}; EpiMerge<0> E{(const bf16_t*)(ws + WS_G), (float*)(ws + WS_MF), (bf16_t*)(ws + WS_MB)};
              gemm_phase<EpiMerge<0>, StaticOrder, true, true>(lds, g, S, E); }
            { Gemm g{(const bf16_t*)(ws + WS_YB), (const bf16_t*)(ws + WS_PRJ) + 1024 * 512, Ml, 1024, opq(512)}; EpiMerge<1> E{(const bf16_t*)(ws + WS_G), (float*)(ws + WS_MF), (bf16_t*)(ws + WS_MB)};
              gemm_phase<EpiMerge<1>, StaticOrder, true, true>(lds, g, S, E); }
            { Gemm g{(const bf16_t*)(ws + WS_YC), (const bf16_t*)(ws + WS_PRJ) + 2 * 1024 * 512, Ml, 1024, opq(512)}; EpiMerge<2> E{(const bf16_t*)(ws + WS_G), (float*)(ws + WS_MF), (bf16_t*)(ws + WS_MB)};
              gemm_phase<EpiMerge<2>, StaticOrder, true, true>(lds, g, S, E); }
        PH_END
        PH_BEGIN
            Gemm g{(const bf16_t*)(ws + WS_MB), (const bf16_t*)(ws + WS_WOUT), Ml, 1024, opq(1024)}; StaticOrder S; S.init(Ml, 1024, G, bid);
            EpiF32 E{(float*)(ws + WS_MOUT), 1024};
            gemm_phase<EpiF32, StaticOrder, true, true>(lds, g, S, E);
        PH_END
        PH_BEGIN
            residual_phase(p, (const float*)(ws + WS_MOUT), nullptr, nullptr, layer == 0, layer, 2, p.in[7] + layer * 1024, true, p.in[8] + layer * 1024, layer, 3, layer == 1, Ml, gw, NGW, lane);
            if (layer == 0) convert_layer_weights(p, 1, lds, gw, NGW, wave, lane);
            else convert_moe_weights(p, lds, gw, NGW, wave, lane);
        PH_END
        if (layer == 0) {
            PH_BEGIN
                Gemm g{(const bf16_t*)(ws + WS_XN), (const bf16_t*)(ws + WS_FGU), NTOK, 2 * D_FF, opq(1024)}; StaticOrder S; S.init(NTOK, 2 * D_FF, G, bid);
                EpiSwiglu E{(bf16_t*)(ws + WS_HID), D_FF, 1 << 20, 0};
                gemm_phase<EpiSwiglu, StaticOrder, true, true>(lds, g, S, E);
            PH_END
            PH_BEGIN
                Gemm g{(const bf16_t*)(ws + WS_HID), (const bf16_t*)(ws + WS_FD), NTOK, 1024, opq(D_FF)}; StaticOrder S; S.init(NTOK, 1024, G, bid);
                EpiF32 E{(float*)(ws + WS_MF), 1024};
                gemm_phase<EpiF32, StaticOrder, true, true>(lds, g, S, E);
            PH_END
            PH_BEGIN
                residual_phase(p, (const float*)(ws + WS_MF), nullptr, nullptr, false, 0, 5, p.in[9], true, p.in[6] + 1024, 1, 0, false, NTOK, gw, NGW, lane);
            PH_END
        }
    }
    {
        {
            PH_BEGIN
                const unsigned* cnt = (const unsigned*)(ws + WS_CTL) + CW_CNT; int ts[9]; ts[0] = 0;
#pragma unroll
                for (int e = 0; e < 8; ++e) ts[e + 1] = ts[e] + (int)((__hip_atomic_load(cnt + e, __ATOMIC_RELAXED, __HIP_MEMORY_SCOPE_AGENT) + 255u) >> 8);
                const int* LIST = (const int*)(ws + WS_LIST); const bf16_t* XN = (const bf16_t*)(ws + WS_XN2); bf16_t* XG = (bf16_t*)(ws + WS_XG);
                for (int r = gw; r < ts[8] * 256; r += NGW) {
                    const int tile = r >> 8; int e = 0;
#pragma unroll
                    for (int q = 1; q < 8; ++q) e += (tile >= ts[q]) ? 1 : 0;
                    int tse = 0;
#pragma unroll
                    for (int q = 0; q < 8; ++q) tse = (q == e) ? ts[q] : tse;
                    const int slot = r - tse * 256;
                    u32x4 v0 = (u32x4){0u, 0u, 0u, 0u}, v1 = v0;
                    if (slot < (int)cnt[e]) { const int tk = LIST[e * 16384 + slot]; const u32x4* src = (const u32x4*)(XN + (size_t)(tk >> 1) * 1024); v0 = src[lane]; v1 = src[lane + 64]; }
                    u32x4* dst = (u32x4*)(XG + (size_t)r * 1024); dst[lane] = v0; dst[lane + 64] = v1;
                }
            PH_END
            PH_BEGIN
                const unsigned* cnt = (const unsigned*)(ws + WS_CTL) + CW_CNT; int ts[9]; ts[0] = 0;
#pragma unroll
                for (int e = 0; e < 8; ++e) ts[e + 1] = ts[e] + (int)((__hip_atomic_load(cnt + e, __ATOMIC_RELAXED, __HIP_MEMORY_SCOPE_AGENT) + 255u) >> 8);
                MoeSched S;
#pragma unroll
                for (int e = 0; e < 9; ++e) S.ts[e] = ts[e];
                S.pm_lo = 0; S.pm_hi = ts[8]; S.npn = 28; S.G = G; S.c = bid; S.a_local = false;
                Gemm g{(const bf16_t*)(ws + WS_XG), (const bf16_t*)(ws + WS_MGU), 0, 0, opq(1024)};
                EpiSwiglu E{(bf16_t*)(ws + WS_HIDM), D_FFE, 28, 0};
                gemm_phase<EpiSwiglu, MoeSched, true, true>(lds, g, S, E);
            PH_END
            PH_BEGIN
                const unsigned* cnt = (const unsigned*)(ws + WS_CTL) + CW_CNT; int ts[9]; ts[0] = 0;
#pragma unroll
                for (int e = 0; e < 8; ++e) ts[e + 1] = ts[e] + (int)((__hip_atomic_load(cnt + e, __ATOMIC_RELAXED, __HIP_MEMORY_SCOPE_AGENT) + 255u) >> 8);
                MoeSched S;
#pragma unroll
                for (int e = 0; e < 9; ++e) S.ts[e] = ts[e];
                S.pm_lo = 0; S.pm_hi = ts[8]; S.npn = 4; S.G = G; S.c = bid; S.a_local = false;
                Gemm g{(const bf16_t*)(ws + WS_HIDM), (const bf16_t*)(ws + WS_MD), 0, 0, opq(D_FFE)};
                EpiMoeDown E; E.FS = (float*)(ws + WS_FACC); E.slot1_off = ((long)WS_MGU - (long)WS_FACC) / 4; E.LIST = (const int*)(ws + WS_LIST); E.WTS = (const float*)(ws + WS_WTS); E.cnt = cnt; E.pm_lo = 0;
#pragma unroll
                for (int e = 0; e < 9; ++e) E.ts[e] = ts[e];
                gemm_phase<EpiMoeDown, MoeSched, true, true>(lds, g, S, E);
            PH_END
            PH_BEGIN
                residual_phase(p, (const float*)(ws + WS_FACC), (const float*)(ws + WS_MGU), nullptr, false, 1, 5, p.in[9] + 1024, false, nullptr, 0, 0, false, NLAT, gw, NGW, lane);
            PH_END
        }
    }
#undef PH_BEGIN
#undef PH_END
}

extern "C" void kernel_launch(void* const* d_in, const int* in_sizes, int n_in, void* d_out, int out_size, void* d_ws, size_t ws_size, hipStream_t stream) {
    static int grid = 0;
    if (grid == 0) {
        if (n_in != 37 || out_size != NLAT * DM || ws_size < WS_NEED) { fprintf(stderr, "kernel_launch: unexpected shapes (n_in %d out %d ws %zu need %zu)\n", n_in, out_size, ws_size, (size_t)WS_NEED); grid = -1; return; }
        int dev = 0, cus = 0, per_cu = 0;
        (void)hipGetDevice(&dev);
        (void)hipDeviceGetAttribute(&cus, hipDeviceAttributeMultiprocessorCount, dev);
        (void)hipFuncSetAttribute((const void*)mk_fwd, hipFuncAttributeMaxDynamicSharedMemorySize, LDS_BYTES);
        (void)hipOccupancyMaxActiveBlocksPerMultiprocessor(&per_cu, (const void*)mk_fwd, NTHREADS, LDS_BYTES);
        if (per_cu < 1) { fprintf(stderr, "kernel_launch: occupancy query reports %d blocks per CU\n", per_cu); grid = -1; return; }
        grid = cus;
        fprintf(stderr, "kernel_launch: grid %d (cus %d, per_cu %d), ws %zu\n", grid, cus, per_cu, ws_size);
    }
    if (grid < 0) return;
    (void)hipMemsetAsync((char*)d_ws + WS_CTL, 0, CTL_BYTES, stream);
    Params prm{};
    for (int i = 0; i < 37; ++i) prm.in[i] = (const float*)d_in[i];
    prm.out = (float*)d_out; prm.ws = (unsigned char*)d_ws;
#if MK_MULTI
    for (int ph = 0; ph < N_PHASES; ++ph) { prm.ph_lo = ph; prm.ph_hi = ph + 1; hipLaunchKernelGGL(mk_fwd, dim3(grid), dim3(NTHREADS), LDS_BYTES, stream, prm); }
#else
    prm.ph_lo = 0; prm.ph_hi = 1 << 20;
    void* args[] = {&prm};
    hipError_t e = hipLaunchCooperativeKernel((const void*)mk_fwd, dim3(grid), dim3(NTHREADS), args, LDS_BYTES, stream);
    if (e != hipSuccess) fprintf(stderr, "kernel_launch: cooperative launch failed: %s (grid %d)\n", hipGetErrorString(e), grid);
#endif
}
```

```cpp
#include <hip/hip_runtime.h>
#include <hip/hip_cooperative_groups.h>
#include <cstdio>
#include <cstdint>
namespace cg = cooperative_groups;
namespace pg8 {
#define PG8_LAS __attribute__((address_space(3)))
typedef unsigned short bf16_t;
typedef short bf16x8 __attribute__((ext_vector_type(8)));
typedef float f32x4 __attribute__((ext_vector_type(4)));
typedef unsigned u32x4 __attribute__((ext_vector_type(4)));
constexpr int BM = 256, BK = 64, HALF = 128, HTB = HALF * BK * 2  , STAGE_BYTES = 8 * HTB, NXCD = 8, WGM = 8;

__host__ __device__ __forceinline__ int lds_byte(int r, int c) { const int st = (r >> 4) * 2 + (c >> 5), rr = r & 15, cc = c & 31, ob = rr * 64 + cc * 2; return st * 1024 + (ob ^ (((ob >> 9) & 1) << 5)); }
__host__ __device__ __forceinline__ void stage_rc(int b, int& R, int& C) { const int st = b / 1024, sb = b % 1024, swz = sb ^ (((sb >> 9) & 1) << 5); R = (st >> 1) * 16 + swz / 64; C = (st & 1) * 32 + (swz % 64) / 2; }
__host__ __device__ __forceinline__ int perm32(int rho) { const int n = rho >> 4, i = rho & 15; return 8 * (i >> 2) + 4 * n + (i & 3); }

struct Unit { int pm, pn, koff, tail; };
struct Gemm { const bf16_t* A; const bf16_t* Bt; int M, N, K, ld; };

struct StaticOrder {
    int nM, nN, nwg, G, c;
    __host__ __device__ void init(int M, int N, int G_, int c_) { nM = M / BM; nN = N / BM; nwg = nM * nN; G = G_; c = c_; }
    __host__ __device__ bool next(int i, Unit& u) const {
        const long L = (long)i * G + c; if (L >= nwg) return false;
        int wgid = (int)L; { const int q = nwg / NXCD, r = nwg % NXCD, xcd = wgid % NXCD, off = wgid / NXCD; wgid = (xcd < r ? xcd * (q + 1) : r * (q + 1) + (xcd - r) * q) + off; }
        const int nig = WGM * nN, gid = wgid / nig, fm = gid * WGM, gsz = (nM - fm) < WGM ? (nM - fm) : WGM;
        u.pm = fm + ((wgid % nig) % gsz); u.pn = (wgid % nig) / gsz; u.koff = 0; u.tail = -1; return true;
    }
    __device__ __forceinline__ void a_ready(const Unit&) const {}
    __device__ __forceinline__ void done(const Unit&) const {}
};

__device__ __forceinline__ unsigned cvt_pk_bf16(float lo, float hi) { unsigned r; asm volatile("v_cvt_pk_bf16_f32 %0, %1, %2" : "=v"(r) : "v"(lo), "v"(hi)); return r; }
typedef float f32x2 __attribute__((ext_vector_type(2)));
template <class Epi, class Sched, bool ALIGN_EPI = false, bool SP2 = false>
__device__ __forceinline__ void gemm_phase(PG8_LAS unsigned char* lds, const Gemm g, const Sched& S, const Epi& E) {
    int tid_ = threadIdx.x; asm volatile("" : "+v"(tid_)); const int tid = tid_, wid = __builtin_amdgcn_readfirstlane(tid >> 6), lane = tid & 63, wr = wid >> 2, wc = wid & 3, fr = lane & 15, fq = lane >> 4;
    const int K = g.ld, nt = g.K / BK;
    unsigned voffA[2], voffB[2];
#pragma unroll
    for (int i = 0; i < 2; ++i) { int R, C; stage_rc(tid * 16 + i * 8192, R, C); const int Rb = Epi::PERM ? ((R & ~31) + perm32(R & 31)) : R;
        voffA[i] = (unsigned)(R * K + C) * 2u; voffB[i] = (unsigned)(Rb * K + C) * 2u; }
    const size_t kstep = (size_t)(BK * 2);
    const size_t hstep = (size_t)HALF * K * 2;
    const size_t tstep = 2 * hstep;
    const unsigned ldsw = (unsigned)wid * 1024u;
    const int aoff = lds_byte(wr * 64 + fr, fq * 8), boff = lds_byte(wc * 32 + fr, fq * 8);
#define PG8_SA(b, h) (((b) * 2 + (h)) * HTB)
#define PG8_SB(b, h) ((4 + (b) * 2 + (h)) * HTB)
#define PG8_STAGE(bufoff, gbase, voff) do { _Pragma("unroll") for (int _i = 0; _i < 2; ++_i) \
        __builtin_amdgcn_global_load_lds((const unsigned*)((const char*)(gbase) + (voff)[_i]), (PG8_LAS unsigned*)(lds + (bufoff) + ldsw + _i * 8192), 16, 0, 0); } while (0)
#define PG8_LDA(dst, b, h) do { _Pragma("unroll") for (int m = 0; m < 4; ++m) _Pragma("unroll") for (int k = 0; k < 2; ++k) dst[m][k] = *(const PG8_LAS bf16x8*)(lds + PG8_SA(b, h) + aoff + m * 2048 + k * 1024); } while (0)
#define PG8_LDB(dst, b, h) do { _Pragma("unroll") for (int n = 0; n < 2; ++n) _Pragma("unroll") for (int k = 0; k < 2; ++k) dst[n][k] = *(const PG8_LAS bf16x8*)(lds + PG8_SB(b, h) + boff + n * 2048 + k * 1024); } while (0)
#define PG8_MMA(ai, bj, At, Bt) do { __builtin_amdgcn_s_setprio(1); _Pragma("unroll") for (int m = 0; m < 4; ++m) _Pragma("unroll") for (int n = 0; n < 2; ++n) _Pragma("unroll") for (int k = 0; k < 2; ++k) \
        acc[ai][bj][m][n] = __builtin_amdgcn_mfma_f32_16x16x32_bf16(Bt[n][k], At[m][k], acc[ai][bj][m][n], 0, 0, 0); __builtin_amdgcn_s_setprio(0); } while (0)
#define PG8_WAIT_V(n) asm volatile("s_waitcnt vmcnt(" #n ")" ::: "memory")
#define PG8_WAIT_L(n) asm volatile("s_waitcnt lgkmcnt(" #n ")" ::: "memory")
#define PG8_BAR __builtin_amdgcn_s_barrier()
#define PG8_SCHED __builtin_amdgcn_sched_barrier(0)
    Unit cur, nxt; int ui = 0;
    if (!S.next(0, cur)) return;
    f32x4 acc[2][2][4][2];
#pragma unroll
    for (int a = 0; a < 2; ++a)
#pragma unroll
        for (int b = 0; b < 2; ++b)
#pragma unroll
            for (int m = 0; m < 4; ++m)
#pragma unroll
                for (int n = 0; n < 2; ++n) acc[a][b][m][n] = (f32x4){0.f, 0.f, 0.f, 0.f};
    bf16x8 At[4][2], B0[2][2], B1[2][2];
    const char* cA = (const char*)g.A + (size_t)cur.pm * tstep + (size_t)cur.koff * 2; const char* cB = (const char*)g.Bt + (size_t)cur.pn * tstep + (size_t)cur.koff * 2;
    S.a_ready(cur);
    if constexpr (SP2) {
        PG8_STAGE(PG8_SB(0, 0), cB, voffB); PG8_STAGE(PG8_SB(0, 1), cB + hstep, voffB); PG8_STAGE(PG8_SA(0, 0), cA, voffA); PG8_STAGE(PG8_SA(0, 1), cA + hstep, voffA);
        if (wr == 1) PG8_BAR;
        PG8_WAIT_V(2); PG8_BAR;
        PG8_STAGE(PG8_SB(1, 0), cB + kstep, voffB); PG8_STAGE(PG8_SA(1, 0), cA + kstep, voffA); PG8_STAGE(PG8_SB(1, 1), cB + hstep + kstep, voffB);
        PG8_WAIT_V(6); PG8_BAR;
    } else {
        PG8_STAGE(PG8_SB(0, 0), cB, voffB); PG8_STAGE(PG8_SA(0, 0), cA, voffA); PG8_STAGE(PG8_SB(0, 1), cB + hstep, voffB); PG8_STAGE(PG8_SA(0, 1), cA + hstep, voffA);
        if (wr == 1) PG8_BAR;
        PG8_WAIT_V(4); PG8_BAR;
        PG8_STAGE(PG8_SB(1, 0), cB + kstep, voffB); PG8_STAGE(PG8_SA(1, 0), cA + kstep, voffA); PG8_STAGE(PG8_SB(1, 1), cB + hstep + kstep, voffB);
        PG8_WAIT_V(6); PG8_BAR;
    }
    for (;;) {
        const bool has_next = S.next(ui + 1, nxt);
        const char* nA = has_next ? (const char*)g.A + (size_t)nxt.pm * tstep + (size_t)nxt.koff * 2 : cA; const char* nB = has_next ? (const char*)g.Bt + (size_t)nxt.pn * tstep + (size_t)nxt.koff * 2 : cB;
        for (int t = 0; t < nt; t += 2) {
            const bool last = (t == nt - 2);
            const char* a1 = cA + (size_t)(t + 1) * kstep;
            const char* a2 = last ? nA : cA + (size_t)(t + 2) * kstep; const char* b2 = last ? nB : cB + (size_t)(t + 2) * kstep;
            const char* a3 = a2 + kstep; const char* b3 = b2 + kstep;
            if (last && has_next) S.a_ready(nxt);
            if constexpr (SP2) {
            PG8_LDB(B0, 0, 0); PG8_LDB(B1, 0, 1); PG8_SCHED; PG8_LDA(At, 0, 0); PG8_STAGE(PG8_SA(1, 1), a1 + hstep, voffA);
            PG8_WAIT_V(8); PG8_WAIT_L(0); PG8_BAR; PG8_MMA(0, 0, At, B0); PG8_MMA(0, 1, At, B1); PG8_BAR; PG8_SCHED;
            PG8_LDA(At, 0, 1); PG8_STAGE(PG8_SB(0, 0), b2, voffB); PG8_STAGE(PG8_SB(0, 1), b2 + hstep, voffB); PG8_STAGE(PG8_SA(0, 0), a2, voffA);
            PG8_WAIT_V(8); PG8_WAIT_L(0); PG8_BAR; PG8_MMA(1, 0, At, B0); PG8_MMA(1, 1, At, B1); PG8_BAR; PG8_SCHED;
            PG8_LDB(B0, 1, 0); PG8_LDB(B1, 1, 1); PG8_SCHED; PG8_LDA(At, 1, 0); PG8_STAGE(PG8_SA(0, 1), a2 + hstep, voffA);
            PG8_WAIT_V(8); PG8_WAIT_L(0); PG8_BAR; PG8_MMA(0, 0, At, B0); PG8_MMA(0, 1, At, B1); PG8_BAR; PG8_SCHED;
            PG8_LDA(At, 1, 1); PG8_STAGE(PG8_SB(1, 0), b3, voffB); PG8_STAGE(PG8_SB(1, 1), b3 + hstep, voffB); PG8_STAGE(PG8_SA(1, 0), a3, voffA);
            PG8_WAIT_V(8); PG8_WAIT_L(0); PG8_BAR; PG8_MMA(1, 0, At, B0); PG8_MMA(1, 1, At, B1); PG8_BAR; PG8_SCHED;
            } else {
            PG8_LDB(B0, 0, 0); PG8_SCHED; PG8_LDA(At, 0, 0); PG8_STAGE(PG8_SA(1, 1), a1 + hstep, voffA);
            PG8_WAIT_L(8); PG8_BAR; PG8_WAIT_L(0); PG8_MMA(0, 0, At, B0); PG8_BAR; PG8_SCHED;
            PG8_LDB(B1, 0, 1); PG8_STAGE(PG8_SB(0, 0), b2, voffB);
            PG8_BAR; PG8_WAIT_L(0); PG8_MMA(0, 1, At, B1); PG8_BAR;
            PG8_LDA(At, 0, 1); PG8_STAGE(PG8_SA(0, 0), a2, voffA);
            PG8_BAR; PG8_WAIT_L(0); PG8_MMA(1, 0, At, B0); PG8_BAR; PG8_SCHED;
            PG8_STAGE(PG8_SB(0, 1), b2 + hstep, voffB);
            PG8_WAIT_V(6); PG8_BAR; PG8_MMA(1, 1, At, B1); PG8_BAR;
            PG8_LDB(B0, 1, 0); PG8_SCHED; PG8_LDA(At, 1, 0); PG8_STAGE(PG8_SA(0, 1), a2 + hstep, voffA);
            PG8_WAIT_L(8); PG8_BAR; PG8_WAIT_L(0); PG8_MMA(0, 0, At, B0); PG8_BAR; PG8_SCHED;
            PG8_LDB(B1, 1, 1); PG8_STAGE(PG8_SB(1, 0), b3, voffB);
            PG8_BAR; PG8_WAIT_L(0); PG8_MMA(0, 1, At, B1); PG8_BAR;
            PG8_LDA(At, 1, 1); PG8_STAGE(PG8_SA(1, 0), a3, voffA);
            PG8_BAR; PG8_WAIT_L(0); PG8_MMA(1, 0, At, B0); PG8_BAR; PG8_SCHED;
            PG8_STAGE(PG8_SB(1, 1), b3 + hstep, voffB);
            PG8_WAIT_V(6); PG8_BAR; PG8_MMA(1, 1, At, B1); PG8_BAR;
            }
        }
        if constexpr (ALIGN_EPI) { if (wr == 0) PG8_BAR; }
        if constexpr (!Epi::AFTER_DRAIN) { E(acc, cur, wr, wc, fr, fq); S.done(cur); }
        if (!has_next) break;
#pragma unroll
        for (int a = 0; a < 2; ++a)
#pragma unroll
            for (int b = 0; b < 2; ++b)
#pragma unroll
                for (int m = 0; m < 4; ++m)
#pragma unroll
                    for (int n = 0; n < 2; ++n) acc[a][b][m][n] = (f32x4){0.f, 0.f, 0.f, 0.f};
        cur = nxt; cA = nA; cB = nB; ++ui;
        if constexpr (ALIGN_EPI) { if (wr == 1) PG8_BAR; }
    }
    PG8_WAIT_V(0);
    if constexpr (!ALIGN_EPI) { if (wr == 0) PG8_BAR; }
    PG8_BAR;
    if constexpr (Epi::AFTER_DRAIN) { E.fused(acc, cur, wr, wc, fr, fq, lds, wid, lane); S.done(cur); }
#undef PG8_SA
#undef PG8_SB
#undef PG8_STAGE
#undef PG8_LDA
#undef PG8_LDB
#undef PG8_MMA
#undef PG8_WAIT_V
#undef PG8_WAIT_L
#undef PG8_BAR
#undef PG8_SCHED
}
}

#define LAS __attribute__((address_space(3)))
typedef unsigned short bf16_t;
typedef short bf16x8 __attribute__((ext_vector_type(8)));
typedef float f32x4 __attribute__((ext_vector_type(4)));
typedef float f32x16 __attribute__((ext_vector_type(16)));
typedef unsigned u32x4 __attribute__((ext_vector_type(4)));
typedef unsigned u32x2 __attribute__((ext_vector_type(2)));

constexpr int NTHREADS = 512, NWAVES = 8;
constexpr int DM = 1024, SEQ = 8192, CTXL = 256, NLAT = 2 * SEQ, NCTX = 2 * CTXL, NTOK = NLAT + NCTX, KEYS = SEQ + CTXL;
constexpr int D_IN = 7296, D_FF = 2816, D_FFE = 3584, NEXP = 8;
constexpr int IC_QS = 0, IC_KS = 512, IC_RW = 640, IC_QD = 2560, IC_KD = 3072, PP = 3584, IC_VS = 3584, IC_VD = 3712, IC_PAD = 4224, NIN1 = 4352, WIN_ROWS = 7424;
constexpr int ST_SLOTS = 9;
constexpr int MOE_TILES = 136, MOE_HALF = 68;

constexpr size_t MiB = 1u << 20;
constexpr size_t WS_CTL = 0, CTL_BYTES = 1 * MiB;
constexpr size_t WS_MODS = 1 * MiB;
constexpr size_t WS_ROPE = 1 * MiB + 256 * 1024;
constexpr size_t WS_HCTX = 2 * MiB;
constexpr size_t WS_LIST = 4 * MiB;
constexpr size_t WS_WTS = 4 * MiB + 512 * 1024;
constexpr size_t WS_WIN = 6 * MiB;
constexpr size_t WS_PRJ = WS_WIN + (size_t)WIN_ROWS * 1024 * 2;
constexpr size_t WS_WOUT = WS_PRJ + 3 * MiB;
constexpr size_t WS_LORA = WS_WOUT + 2 * MiB;
constexpr size_t WS_XN = 28 * MiB;
constexpr size_t WS_P = 61 * MiB;
constexpr size_t WS_VTS = 177 * MiB;
constexpr size_t WS_VTD = WS_VTS + 4608 * 1024;
constexpr size_t WS_ST = 198 * MiB;
constexpr size_t WS_YA = 495 * MiB;
constexpr size_t WS_YB = WS_YA + 16896ull * 512 * 2;
constexpr size_t WS_YC = WS_YB + 16896ull * 512 * 2;
constexpr size_t WS_END = WS_YC + 16896ull * 512 * 2;
constexpr size_t WS_G = WS_ST;
constexpr size_t WS_MF = WS_ST + 99 * MiB;
constexpr size_t WS_MB = WS_ST + 165 * MiB;
constexpr size_t WS_MOUT = WS_ST + 198 * MiB;
constexpr size_t WS_FGU = WS_VTS;
constexpr size_t WS_FD = WS_VTS + 11 * MiB;
constexpr size_t WS_HID = WS_P;
constexpr size_t WS_XN2 = 495 * MiB;
constexpr size_t WS_MGU = 6 * MiB;
constexpr size_t WS_MD = 118 * MiB;
constexpr size_t WS_XG = 174 * MiB;
constexpr size_t WS_FACC = 242 * MiB;
constexpr size_t WS_HIDM = 306 * MiB;
static_assert(WS_LORA + 2560 * 384 * 2 <= WS_XN && WS_XN + 16896ull * 1024 * 2 <= WS_P && WS_P + 16896ull * PP * 2 <= WS_VTS && WS_VTD + 2ull * 4 * 128 * KEYS * 2 <= WS_ST, "ws map 1");
static_assert(WS_ST + 16896ull * 8 * ST_SLOTS * 64 * 4 <= WS_YA && WS_END <= 545 * MiB, "ws map 2");
static_assert(WS_G + 16896ull * 3072 * 2 <= WS_MF && WS_MF + 16896ull * 1024 * 4 <= WS_MB && WS_MB + 16896ull * 1024 * 2 <= WS_MOUT && WS_MOUT + 16896ull * 1024 * 4 <= WS_YA, "ws map 3");
static_assert(WS_FGU + 5632ull * 1024 * 2 <= WS_FD && WS_FD + 1024ull * 2816 * 2 <= WS_ST && WS_HID + 16896ull * 2816 * 2 <= WS_VTS, "ws map 4");
static_assert(WS_MGU + 8ull * 7168 * 1024 * 2 <= WS_MD && WS_MD + 8ull * 1024 * 3584 * 2 <= WS_XG && WS_XG + 34816ull * 1024 * 2 <= WS_FACC && WS_FACC + 16384ull * 1024 * 4 <= WS_HIDM && WS_HIDM + 136ull * 256 * 3584 * 2 <= 560 * MiB, "ws map 5");
static_assert(WS_FACC + 16384ull * 1024 * 4 <= WS_MOUT && WS_XN2 + 16384ull * 1024 * 2 <= 560 * MiB && WS_XN2 >= WS_MOUT + 16896ull * 1024 * 4, "expert weights / gathered rows / accumulator must not touch MOUT or XN2 while they are live");
constexpr size_t WS_NEED = 560 * MiB;
constexpr int CW_CNT = 0;
constexpr int CW_Q0 = 64, CW_Q1 = 128;

constexpr int LDS_BYTES = 147456;

__device__ __forceinline__ unsigned f2bf(float f) { unsigned u = __builtin_bit_cast(unsigned, f); return (u + 0x7fffu + ((u >> 16) & 1u)) >> 16; }
typedef float f32x2_t __attribute__((ext_vector_type(2))); typedef __bf16 bf16x2_t __attribute__((ext_vector_type(2)));
__device__ __forceinline__ unsigned pk2(float lo, float hi) { const f32x2_t v = {lo, hi}; return __builtin_bit_cast(unsigned, __builtin_convertvector(v, bf16x2_t)); }
__device__ __forceinline__ float bflo(unsigned w) { return __uint_as_float(w << 16); }
__device__ __forceinline__ float bfhi(unsigned w) { return __uint_as_float(w & 0xffff0000u); }
__device__ __forceinline__ float wave_sum(float v) {
#pragma unroll
    for (int o = 1; o < 64; o <<= 1) v += __shfl_xor(v, o);
    return v;
}
__device__ __forceinline__ float sigmoidf_(float x) { return 1.0f / (1.0f + __expf(-x)); }
__device__ __forceinline__ float siluf_(float x) { return x / (1.0f + __expf(-x)); }
#define LDS_WAIT() asm volatile("s_waitcnt lgkmcnt(0)" ::: "memory")

struct Params {
    const float* in[37];
    float* out;
    unsigned char* ws;
    int ph_lo, ph_hi;
};

template <class F>
__device__ __forceinline__ void transpose_item(const float* __restrict__ W, int ldw, int k0, int n0, bf16_t* __restrict__ WT, int ldt, int dcol0, F rowmap, LAS float* scr, int lane) {
#pragma unroll 8
    for (int i = 0; i < 32; ++i) { const int kk = 2 * i + (lane >> 5); scr[kk * 33 + (lane & 31)] = W[(size_t)(k0 + kk) * ldw + n0 + (lane & 31)]; }
    LDS_WAIT(); asm volatile("" ::: "memory");
    const int c = lane & 7;
#pragma unroll
    for (int j = 0; j < 4; ++j) {
        const int n = (lane >> 3) + 8 * j; const LAS float* s = scr + (8 * c) * 33 + n;
        u32x4 o; o.x = pk2(s[0 * 33], s[1 * 33]); o.y = pk2(s[2 * 33], s[3 * 33]); o.z = pk2(s[4 * 33], s[5 * 33]); o.w = pk2(s[6 * 33], s[7 * 33]);
        const int row = rowmap(n0 + n);
        if (row >= 0) *(u32x4*)(WT + (size_t)row * ldt + dcol0 + k0 + 8 * c) = o;
    }
    LDS_WAIT(); asm volatile("" ::: "memory");
}
struct RowId { __device__ __forceinline__ int operator()(int n) const { return n; } };
struct RowOff { int off; __device__ __forceinline__ int operator()(int n) const { return n + off; } };
struct RowWin {
    __device__ __forceinline__ int operator()(int n) const {
        if (n < 640) return n;
        if (n < 768) return n - 640 + IC_VS;
        if (n < 2688) return n - 768 + IC_RW;
        if (n < 3712) return n - 2688 + IC_QD;
        if (n < 4224) return n - 3712 + IC_VD;
        return n - 4224 + NIN1;
    }
};
struct RowGU { int up; __device__ __forceinline__ int operator()(int j) const { return (j >> 7) * 256 + (j & 127) + 128 * up; } };

template <class F>
__device__ __forceinline__ void convert_matrix(const float* W, int K, int N, bf16_t* WT, int ldt, int dcol0, F rowmap, LAS float* scr, int lane, int gw, int NGW) {
    const int nblk = N / 32, items = (K / 64) * nblk;
    for (int it = gw; it < items; it += NGW) { const int kb = it / nblk, nb = it % nblk; transpose_item(W, N, kb * 64, nb * 32, WT, ldt, dcol0, rowmap, scr, lane); }
}

__device__ __forceinline__ void lora_region(bf16_t* __restrict__ LT, const float* __restrict__ src, int row0, int klo, int kn, int gw, int NGW, int lane) {
    for (int i = gw * 64 + lane; i < 512 * 48; i += NGW * 64) {
        const int nn = i / 48, kc = (i % 48) * 8;
        u32x4 o = (u32x4){0u, 0u, 0u, 0u};
        if (kc >= klo && kc < klo + kn) {
            const float* s = src + (size_t)(kc - klo) * 512 + nn;
            o.x = pk2(s[0], s[512]); o.y = pk2(s[2 * 512], s[3 * 512]); o.z = pk2(s[4 * 512], s[5 * 512]); o.w = pk2(s[6 * 512], s[7 * 512]);
        }
        *(u32x4*)(LT + (size_t)(row0 + nn) * 384 + kc) = o;
    }
}
__device__ __forceinline__ void convert_layer_weights(const Params& p, int layer, LAS unsigned char* lds, int gw, int NGW, int wave, int lane) {
    LAS float* scr = (LAS float*)(lds + wave * 16384);
    unsigned char* ws = p.ws;
    bf16_t* WIN = (bf16_t*)(ws + WS_WIN);
    convert_matrix(p.in[10] + (size_t)layer * 1024 * D_IN, 1024, D_IN, WIN, 1024, 0, RowWin(), scr, lane, gw, NGW);
    for (int i = gw * 64 + lane; i < (NIN1 - IC_PAD) * 1024 / 8; i += NGW * 64) *(u32x4*)(WIN + (size_t)IC_PAD * 1024 + (size_t)i * 8) = (u32x4){0u, 0u, 0u, 0u};
    for (int j = 0; j < 3; ++j)
        convert_matrix(p.in[26 + j] + (size_t)layer * 512 * 1024, 512, 1024, (bf16_t*)(ws + WS_PRJ) + (size_t)j * 1024 * 512, 512, 0, RowId(), scr, lane, gw, NGW);
    convert_matrix(p.in[29] + (size_t)layer * 1024 * 1024, 1024, 1024, (bf16_t*)(ws + WS_WOUT), 1024, 0, RowId(), scr, lane, gw, NGW);
    bf16_t* LT = (bf16_t*)(ws + WS_LORA);
    lora_region(LT, p.in[15] + ((size_t)layer * 2 + 0) * 64 * 512, 0, 0, 64, gw, NGW, lane);
    lora_region(LT, p.in[15] + ((size_t)layer * 2 + 1) * 64 * 512, 512, 64, 64, gw, NGW, lane);
    lora_region(LT, p.in[17] + ((size_t)layer * 2 + 0) * 64 * 512, 1024, 128, 64, gw, NGW, lane);
    lora_region(LT, p.in[17] + ((size_t)layer * 2 + 1) * 64 * 512, 1536, 192, 64, gw, NGW, lane);
    lora_region(LT, p.in[18] + (size_t)layer * 128 * 512, 2048, 256, 128, gw, NGW, lane);
}
__device__ __forceinline__ void convert_ffn_weights(const Params& p, LAS unsigned char* lds, int gw, int NGW, int wave, int lane) {
    LAS float* scr = (LAS float*)(lds + wave * 16384);
    bf16_t* GU = (bf16_t*)(p.ws + WS_FGU); bf16_t* FD = (bf16_t*)(p.ws + WS_FD);
    convert_matrix(p.in[30], 1024, D_FF, GU, 1024, 0, RowGU{0}, scr, lane, gw, NGW);
    convert_matrix(p.in[31], 1024, D_FF, GU, 1024, 0, RowGU{1}, scr, lane, gw, NGW);
    convert_matrix(p.in[32], D_FF, 1024, FD, D_FF, 0, RowId(), scr, lane, gw, NGW);
}
__device__ __forceinline__ void convert_moe_weights(const Params& p, LAS unsigned char* lds, int gw, int NGW, int wave, int lane) {
    LAS float* scr = (LAS float*)(lds + wave * 16384);
    for (int e = 0; e < NEXP; ++e) {
        bf16_t* GU = (bf16_t*)(p.ws + WS_MGU) + (size_t)e * 7168 * 1024;
        convert_matrix(p.in[34] + (size_t)e * 1024 * D_FFE, 1024, D_FFE, GU, 1024, 0, RowGU{0}, scr, lane, gw, NGW);
        convert_matrix(p.in[35] + (size_t)e * 1024 * D_FFE, 1024, D_FFE, GU, 1024, 0, RowGU{1}, scr, lane, gw, NGW);
        convert_matrix(p.in[36] + (size_t)e * D_FFE * 1024, D_FFE, 1024, (bf16_t*)(p.ws + WS_MD) + (size_t)e * 1024 * D_FFE, D_FFE, 0, RowId(), scr, lane, gw, NGW);
    }
}

__device__ __forceinline__ void adaln_phase(const Params& p, LAS unsigned char* lds, int wave, int lane) {
    LAS float* red = (LAS float*)lds;
    float* MODS = (float*)(p.ws + WS_MODS);
    const float* c = p.in[1]; const float* cc = p.in[3];
    for (int it = blockIdx.x; it < 2 * 96; it += gridDim.x) {
        const int layer = it / 96, n = (it % 96) * 64 + lane;
        const float* W = p.in[4] + (size_t)layer * 1024 * 6144;
        float a0 = 0.f, a1 = 0.f, a2 = 0.f;
        for (int k = wave * 128; k < wave * 128 + 128; ++k) {
            const float w = W[(size_t)k * 6144 + n];
            a0 += siluf_(c[k]) * w; a1 += siluf_(c[1024 + k]) * w; a2 += siluf_(cc[k]) * w;
        }
        red[(wave * 3 + 0) * 64 + lane] = a0; red[(wave * 3 + 1) * 64 + lane] = a1; red[(wave * 3 + 2) * 64 + lane] = a2;
        __syncthreads();
        if (wave < 3) {
            float s = 0.f;
#pragma unroll
            for (int w = 0; w < 8; ++w) s += red[(w * 3 + wave) * 64 + lane];
            MODS[((size_t)layer * 3 + wave) * 6144 + n] = s + p.in[5][(size_t)layer * 6144 + n];
        }
        __syncthreads();
    }
    if (blockIdx.x == gridDim.x - 1) {
        float* rope = (float*)(p.ws + WS_ROPE);
        for (int i = threadIdx.x; i < 128 * 16; i += NTHREADS) {
            const int pos = i >> 4, j = i & 15;
            const float inv = powf(10000.0f, -(float)j / 16.0f);
            const float ang = (float)pos * inv;
            rope[2 * i] = cosf(ang); rope[2 * i + 1] = sinf(ang);
        }
    }
}

__device__ __forceinline__ const float* mods_row(const Params& p, int layer, int m) {
    const int r = m < NLAT ? (m >> 13) : 2;
    return (const float*)(p.ws + WS_MODS) + ((size_t)layer * 3 + r) * 6144;
}
__device__ __forceinline__ void load_row(const float* x, int lane, f32x4 (&v)[4]) {
#pragma unroll
    for (int j = 0; j < 4; ++j) v[j] = ((const f32x4*)x)[lane + 64 * j];
}
__device__ __forceinline__ float row_rstd(const f32x4 (&v)[4]) {
    float s = 0.f;
#pragma unroll
    for (int j = 0; j < 4; ++j) s += (v[j].x * v[j].x + v[j].y * v[j].y) + (v[j].z * v[j].z + v[j].w * v[j].w);
    return 1.0f / sqrtf(wave_sum(s) * (1.0f / 1024.0f) + 1e-6f);
}
__device__ __forceinline__ void normmod(const f32x4 (&h)[4], const float* g, const float* shift, const float* scale, int lane, f32x4 (&a)[4]) {
    const float rstd = row_rstd(h);
#pragma unroll
    for (int j = 0; j < 4; ++j) {
        const f32x4 gg = ((const f32x4*)g)[lane + 64 * j], sh = ((const f32x4*)shift)[lane + 64 * j], sc = ((const f32x4*)scale)[lane + 64 * j];
        a[j] = (h[j] * rstd * gg) * (sc + 1.0f) + sh;
    }
}
__device__ __forceinline__ void store_row_bf16(bf16_t* o, int lane, const f32x4 (&a)[4]) {
#pragma unroll
    for (int j = 0; j < 4; ++j) { u32x2 w; w.x = pk2(a[j].x, a[j].y); w.y = pk2(a[j].z, a[j].w); ((u32x2*)o)[lane + 64 * j] = w; }
}
__device__ __forceinline__ const float* h_in_row(const Params& p, int layer, int m) {
    if (layer == 0) return m < NLAT ? p.in[0] + (size_t)m * 1024 : p.in[2] + (size_t)(m - NLAT) * 1024;
    return m < NLAT ? p.out + (size_t)m * 1024 : (const float*)(p.ws + WS_HCTX) + (size_t)(m - NLAT) * 1024;
}
__device__ __forceinline__ float* h_out_row(const Params& p, int m) { return m < NLAT ? p.out + (size_t)m * 1024 : (float*)(p.ws + WS_HCTX) + (size_t)(m - NLAT) * 1024; }

__device__ __forceinline__ void premix_phase(const Params& p, int layer, bool first, int M, int gw, int NGW, int lane) {
    bf16_t* XN = (bf16_t*)(p.ws + WS_XN);
    for (int m = gw; m < M; m += NGW) {
        const float* hr = first ? h_in_row(p, 0, m) : h_out_row(p, m);
        f32x4 h[4], a[4]; load_row(hr, lane, h);
        const float* md = mods_row(p, layer, m);
        normmod(h, p.in[6] + layer * 1024, md, md + 1024, lane, a);
        store_row_bf16(XN + (size_t)m * 1024, lane, a);
    }
}
__device__ __forceinline__ void load_row_bf16(const bf16_t* x, int lane, f32x4 (&v)[4]) {
#pragma unroll
    for (int j = 0; j < 4; ++j) { const u32x2 w = ((const u32x2*)x)[lane + 64 * j]; v[j] = (f32x4){bflo(w.x), bfhi(w.x), bflo(w.y), bfhi(w.y)}; }
}
__device__ __forceinline__ void residual_phase(const Params& p, const bf16_t* src, const bf16_t* src2, const float* hin_base_layer0, bool hin_is_input, int layer, int gate_idx, const float* g1,
                                               bool write_xn, const float* g2, int mod_layer2, int shift_idx, bool route, int M, int gw, int NGW, int lane) {
    bf16_t* XN = (bf16_t*)(p.ws + (route ? WS_XN2 : WS_XN));
    for (int m = gw; m < M; m += NGW) {
        const float* hr = hin_is_input ? h_in_row(p, 0, m) : h_out_row(p, m);
        f32x4 h[4], s[4]; load_row(hr, lane, h); load_row_bf16(src + (size_t)m * 1024, lane, s);
        if (src2) { f32x4 s2[4]; load_row_bf16(src2 + (size_t)m * 1024, lane, s2);
#pragma unroll
            for (int j = 0; j < 4; ++j) s[j] += s2[j]; }
        const float rstd = row_rstd(s);
        const float* md = mods_row(p, layer, m);
#pragma unroll
        for (int j = 0; j < 4; ++j) {
            const f32x4 gg = ((const f32x4*)g1)[lane + 64 * j], gt = ((const f32x4*)(md + gate_idx * 1024))[lane + 64 * j];
            h[j] = h[j] + gt * (s[j] * rstd * gg);
        }
        float* ho = h_out_row(p, m);
#pragma unroll
        for (int j = 0; j < 4; ++j) ((f32x4*)ho)[lane + 64 * j] = h[j];
        if (write_xn) {
            f32x4 a[4]; const float* md2 = mods_row(p, mod_layer2, m);
            normmod(h, g2, md2 + shift_idx * 1024, md2 + (shift_idx + 1) * 1024, lane, a);
            store_row_bf16(XN + (size_t)m * 1024, lane, a);
            if (route) {
                const float* rw = p.in[33];
                float lg[8] = {0.f, 0.f, 0.f, 0.f, 0.f, 0.f, 0.f, 0.f};
#pragma unroll
                for (int j = 0; j < 4; ++j)
#pragma unroll
                    for (int q = 0; q < 4; ++q) {
                        const int k = 4 * (lane + 64 * j) + q; const float av = a[j][q];
                        const f32x4 w0 = ((const f32x4*)(rw + (size_t)k * 8))[0], w1 = ((const f32x4*)(rw + (size_t)k * 8))[1];
                        lg[0] += av * w0.x; lg[1] += av * w0.y; lg[2] += av * w0.z; lg[3] += av * w0.w; lg[4] += av * w1.x; lg[5] += av * w1.y; lg[6] += av * w1.z; lg[7] += av * w1.w;
                    }
#pragma unroll
                for (int e = 0; e < 8; ++e) lg[e] = wave_sum(lg[e]);
                int i1 = 0; float v1 = lg[0];
#pragma unroll
                for (int e = 1; e < 8; ++e) if (lg[e] > v1) { v1 = lg[e]; i1 = e; }
                int i2 = -1; float v2 = -3.0e38f;
#pragma unroll
                for (int e = 0; e < 8; ++e) if (e != i1 && lg[e] > v2) { v2 = lg[e]; i2 = e; }
                if (lane == 0) {
                    const float w1 = 1.0f / (1.0f + expf(v2 - v1)), w2 = 1.0f - w1;
                    unsigned* cnt = (unsigned*)(p.ws + WS_CTL) + CW_CNT; int* LIST = (int*)(p.ws + WS_LIST); float* WTS = (float*)(p.ws + WS_WTS);
                    const unsigned s1 = atomicAdd(cnt + i1, 1u); LIST[i1 * 16384 + s1] = m * 2; WTS[i1 * 16384 + s1] = w1;
                    const unsigned s2 = atomicAdd(cnt + i2, 1u); LIST[i2 * 16384 + s2] = m * 2 + 1; WTS[i2 * 16384 + s2] = w2;
                }
            }
        }
    }
}

using pg8::Unit;
constexpr float QSCALE = 0.125f * 1.4426950408889634f;
__device__ __forceinline__ u32x2 pack4(const f32x4 v) { u32x2 w; w.x = pk2(v.x, v.y); w.y = pk2(v.z, v.w); return w; }
__device__ __forceinline__ f32x4 unpack4(const u32x2 w) { return (f32x4){bflo(w.x), bfhi(w.x), bflo(w.y), bfhi(w.y)}; }

struct EpiIn {
    static constexpr bool PERM = false, AFTER_DRAIN = false;
    bf16_t* P; bf16_t* VTS; bf16_t* VTD; const float* rope;
    __device__ __forceinline__ void operator()(const f32x4 (&acc)[2][2][4][2], const Unit& u, int wr, int wc, int fr, int fq) const {
#pragma unroll
        for (int ai = 0; ai < 2; ++ai)
#pragma unroll
            for (int m = 0; m < 4; ++m) {
                const int r = u.pm * 256 + ai * 128 + wr * 64 + m * 16 + fr;
                const bool lat = r < NLAT;
                const int t = r & (SEQ - 1);
                const int b = lat ? (r >> 13) : ((r - NLAT) >> 8);
                const int key = lat ? t : SEQ + ((r - NLAT) & 255);
#pragma unroll
                for (int bj = 0; bj < 2; ++bj) {
                    const int c32 = u.pn * 256 + bj * 128 + wc * 32;
                    f32x4 v0 = acc[ai][bj][m][0], v1 = acc[ai][bj][m][1];
                    if (c32 < PP) {
                        const bool rp = (c32 < IC_RW) || (c32 >= IC_QD);
                        if (rp && lat) {
                            const int pos = (c32 & 32) ? (t & 63) : (t >> 6);
                            const f32x4 cs0 = *(const f32x4*)(rope + (pos * 16 + 4 * fq) * 2), cs1 = *(const f32x4*)(rope + (pos * 16 + 4 * fq) * 2 + 4);
                            const f32x4 cc = (f32x4){cs0.x, cs0.z, cs1.x, cs1.z}, sn = (f32x4){cs0.y, cs0.w, cs1.y, cs1.w};
                            const f32x4 o0 = v0 * cc - v1 * sn, o1 = v0 * sn + v1 * cc;
                            v0 = o0; v1 = o1;
                        }
                        if (c32 < IC_KS || (c32 >= IC_QD && c32 < IC_KD)) { v0 = v0 * QSCALE; v1 = v1 * QSCALE; }
                        bf16_t* dst = P + (size_t)r * PP + c32 + 4 * fq;
                        *(u32x2*)dst = pack4(v0); *(u32x2*)(dst + 16) = pack4(v1);
                    } else {
                        const int cv = c32 - PP;
                        bf16_t* vt = nullptr; int dimbase = 0;
                        if (cv < 128) { vt = VTS + (size_t)((b * 2 + (cv >> 6)) * 64) * KEYS; dimbase = cv & 63; }
                        else if (cv < 640) { const int cd = cv - 128; vt = VTD + (size_t)((b * 4 + (cd >> 7)) * 128) * KEYS; dimbase = cd & 127; }
                        if (vt) {
#pragma unroll
                            for (int i = 0; i < 4; ++i) {
                                vt[(size_t)(dimbase + 4 * fq + i) * KEYS + key] = (bf16_t)f2bf(v0[i]);
                                vt[(size_t)(dimbase + 16 + 4 * fq + i) * KEYS + key] = (bf16_t)f2bf(v1[i]);
                            }
                        }
                    }
                }
            }
    }
};

struct EpiLora {
    static constexpr bool PERM = false, AFTER_DRAIN = false;
    float* ST; bf16_t* P; const float* w0; const float* a0; const float* k_a;
    __device__ __forceinline__ void operator()(const f32x4 (&acc)[2][2][4][2], const Unit& u, int wr, int wc, int fr, int fq) const {
        const int reg = u.pn >> 1;
#pragma unroll
        for (int ai = 0; ai < 2; ++ai)
#pragma unroll
            for (int m = 0; m < 4; ++m) {
                const int r = u.pm * 256 + ai * 128 + wr * 64 + m * 16 + fr;
#pragma unroll
                for (int bj = 0; bj < 2; ++bj)
#pragma unroll
                    for (int n = 0; n < 2; ++n) {
                        const int ch = (u.pn & 1) * 256 + bj * 128 + wc * 32 + 16 * n + 4 * fq;
                        const int h = ch >> 6, kidx = ch & 63;
                        float* sp = ST + ((size_t)r * 8 + h) * (ST_SLOTS * 64) + kidx;
                        const f32x4 a = acc[ai][bj][m][n];
                        if (reg < 2) {
                            const f32x4 bias = *(const f32x4*)(w0 + reg * 512 + ch);
                            f32x4 o;
#pragma unroll
                            for (int i = 0; i < 4; ++i) {
                                const float x = -(bias[i] + a[i]);
                                const float sp_ = fmaxf(x, 0.f) + __logf(1.0f + __expf(-fabsf(x)));
                                o[i] = __expf(-__expf(-sp_ - 0.5f));
                            }
                            *(f32x4*)(sp + (3 + 3 * reg) * 64) = o;
                        } else if (reg < 4) {
                            const int d = reg - 2;
                            const f32x4 bias = *(const f32x4*)(a0 + d * 512 + ch), ka = *(const f32x4*)(k_a + ch);
                            const f32x4 kraw = *(const f32x4*)(sp + (5 + 3 * d) * 64), kk = *(const f32x4*)(sp);
                            f32x4 bv, kf;
#pragma unroll
                            for (int i = 0; i < 4; ++i) {
                                const float ag = sigmoidf_(bias[i] + a[i]);
                                bv[i] = -kk[i] * ag; kf[i] = kraw[i] * (1.0f + (ag - 1.0f) * ka[i]);
                            }
                            *(f32x4*)(sp + (4 + 3 * d) * 64) = bv; *(f32x4*)(sp + (5 + 3 * d) * 64) = kf;
                        } else {
                            *(u32x2*)(P + (size_t)r * PP + IC_RW + ch) = pack4(a);
                        }
                        asm volatile("" ::: "memory");
                    }
            }
    }
};

struct EpiGate {
    static constexpr bool PERM = true, AFTER_DRAIN = false;
    bf16_t* G;
    __device__ __forceinline__ void operator()(const f32x4 (&acc)[2][2][4][2], const Unit& u, int wr, int wc, int fr, int fq) const {
#pragma unroll
        for (int ai = 0; ai < 2; ++ai)
#pragma unroll
            for (int m = 0; m < 4; ++m) {
                const int r = u.pm * 256 + ai * 128 + wr * 64 + m * 16 + fr;
#pragma unroll
                for (int bj = 0; bj < 2; ++bj) {
                    const int c = u.pn * 256 + bj * 128 + wc * 32 + 8 * fq;
                    const f32x4 a0 = acc[ai][bj][m][0], a1 = acc[ai][bj][m][1];
                    u32x4 w; w.x = pk2(sigmoidf_(a0.x), sigmoidf_(a0.y)); w.y = pk2(sigmoidf_(a0.z), sigmoidf_(a0.w)); w.z = pk2(sigmoidf_(a1.x), sigmoidf_(a1.y)); w.w = pk2(sigmoidf_(a1.z), sigmoidf_(a1.w));
                    *(u32x4*)(G + (size_t)r * 3072 + c) = w;
                }
            }
    }
};

template <int PASS> struct EpiMerge {
    static constexpr bool PERM = false, AFTER_DRAIN = false;
    const bf16_t* G; bf16_t* MF; bf16_t* MB;
    __device__ __forceinline__ void operator()(const f32x4 (&acc)[2][2][4][2], const Unit& u, int wr, int wc, int fr, int fq) const {
#pragma unroll
        for (int ai = 0; ai < 2; ++ai)
#pragma unroll
            for (int m = 0; m < 4; ++m) {
                const int r = u.pm * 256 + ai * 128 + wr * 64 + m * 16 + fr;
#pragma unroll
                for (int bj = 0; bj < 2; ++bj)
#pragma unroll
                    for (int n = 0; n < 2; ++n) {
                        const int c = u.pn * 256 + bj * 128 + wc * 32 + 16 * n + 4 * fq;
                        const f32x4 g = unpack4(*(const u32x2*)(G + (size_t)r * 3072 + PASS * 1024 + c));
                        f32x4 v = g * acc[ai][bj][m][n];
                        bf16_t* mp = MF + (size_t)r * 1024 + c;
                        if (PASS > 0) v += unpack4(*(const u32x2*)mp);
                        *(u32x2*)(PASS < 2 ? mp : MB + (size_t)r * 1024 + c) = pack4(v);
                    }
            }
    }
};

struct EpiBf {
    static constexpr bool PERM = true, AFTER_DRAIN = false;
    bf16_t* O; int ldc;
    __device__ __forceinline__ void operator()(const f32x4 (&acc)[2][2][4][2], const Unit& u, int wr, int wc, int fr, int fq) const {
#pragma unroll
        for (int ai = 0; ai < 2; ++ai)
#pragma unroll
            for (int m = 0; m < 4; ++m) {
                const int r = u.pm * 256 + ai * 128 + wr * 64 + m * 16 + fr;
#pragma unroll
                for (int bj = 0; bj < 2; ++bj) {
                    const int c = u.pn * 256 + bj * 128 + wc * 32 + 8 * fq;
                    const f32x4 a0 = acc[ai][bj][m][0], a1 = acc[ai][bj][m][1];
                    u32x4 w; w.x = pk2(a0.x, a0.y); w.y = pk2(a0.z, a0.w); w.z = pk2(a1.x, a1.y); w.w = pk2(a1.z, a1.w);
                    *(u32x4*)(O + (size_t)r * ldc + c) = w;
                }
            }
    }
};

struct EpiSwiglu {
    static constexpr bool PERM = true, AFTER_DRAIN = false;
    bf16_t* H; int ldh; int npn; int pm_sub;
    __device__ __forceinline__ void operator()(const f32x4 (&acc)[2][2][4][2], const Unit& u, int wr, int wc, int fr, int fq) const {
        const int pnn = u.pn % npn;
#pragma unroll
        for (int ai = 0; ai < 2; ++ai)
#pragma unroll
            for (int m = 0; m < 4; ++m) {
                const int r = (u.pm - pm_sub) * 256 + ai * 128 + wr * 64 + m * 16 + fr;
                const int hc = pnn * 128 + wc * 32 + 8 * fq;
                const f32x4 g0 = acc[ai][0][m][0], g1 = acc[ai][0][m][1], u0 = acc[ai][1][m][0], u1 = acc[ai][1][m][1];
                u32x4 w; w.x = pk2(siluf_(g0.x) * u0.x, siluf_(g0.y) * u0.y); w.y = pk2(siluf_(g0.z) * u0.z, siluf_(g0.w) * u0.w);
                w.z = pk2(siluf_(g1.x) * u1.x, siluf_(g1.y) * u1.y); w.w = pk2(siluf_(g1.z) * u1.z, siluf_(g1.w) * u1.w);
                *(u32x4*)(H + (size_t)r * ldh + hc) = w;
            }
    }
};

struct MoeSched {
    int ts[9]; int pm_lo, pm_hi, npn, G, c; bool a_local;
    __device__ __forceinline__ int expert_of(int pm) const { int e = 0;
#pragma unroll
        for (int q = 1; q < 8; ++q) e += (pm >= ts[q]) ? 1 : 0;
        return e; }
    __device__ __forceinline__ bool next(int i, Unit& u) const {
        const int n = (pm_hi - pm_lo) * npn; const long L = (long)i * G + c; if (L >= n) return false;
        const int pm = pm_lo + (int)L / npn, pnn = (int)L % npn;
        u.pm = a_local ? pm - pm_lo : pm; u.pn = expert_of(pm) * npn + pnn; u.koff = 0; u.tail = -1; return true;
    }
    __device__ __forceinline__ void a_ready(const Unit&) const {}
    __device__ __forceinline__ void done(const Unit&) const {}
};
struct EpiMoeDown {
    static constexpr bool PERM = false, AFTER_DRAIN = false;
    bf16_t* FS; long slot1_off; const int* LIST; const float* WTS; const unsigned* cnt; int ts[9]; int pm_lo;
    __device__ __forceinline__ void operator()(const f32x4 (&acc)[2][2][4][2], const Unit& u, int wr, int wc, int fr, int fq) const {
        const int e = u.pn >> 2, pnn = u.pn & 3, pmg = u.pm + pm_lo;
        int tse = 0;
#pragma unroll
        for (int q = 0; q < 8; ++q) tse = (q == e) ? ts[q] : tse;
        const int ne = (int)cnt[e];
#pragma unroll
        for (int ai = 0; ai < 2; ++ai)
#pragma unroll
            for (int m = 0; m < 4; ++m) {
                const int slot = (pmg - tse) * 256 + ai * 128 + wr * 64 + m * 16 + fr;
                if (slot < ne) {
                    const int tk = LIST[e * 16384 + slot]; const float w = WTS[e * 16384 + slot];
                    bf16_t* dst = FS + (long)(tk & 1) * slot1_off + (size_t)(tk >> 1) * 1024 + pnn * 256 + wc * 32 + 4 * fq;
#pragma unroll
                    for (int bj = 0; bj < 2; ++bj)
#pragma unroll
                        for (int n = 0; n < 2; ++n) *(u32x2*)(dst + bj * 128 + 16 * n) = pack4(acc[ai][bj][m][n] * w);
                }
            }
    }
};

constexpr float SC2 = 0.125f * 1.4426950408889634f;
constexpr int ATT_ROW = 144, ATT_VOFF = 9216, ATT_BUF = 27648;
constexpr float ATT_THR = 6.0f;
__device__ __forceinline__ float xhalf_max(float v) { auto rr = __builtin_amdgcn_permlane32_swap(__float_as_uint(v), __float_as_uint(v), false, false); return fmaxf(__uint_as_float(rr[0]), __uint_as_float(rr[1])); }
__device__ __forceinline__ float xhalf_sum(float v) { auto rr = __builtin_amdgcn_permlane32_swap(__float_as_uint(v), __float_as_uint(v), false, false); return __uint_as_float(rr[0]) + __uint_as_float(rr[1]); }

template <int DV, bool WINDOW>
__device__ __forceinline__ void attn_pass(LAS unsigned char* lds, const bf16_t* __restrict__ P, int qrow0, int qcol, int kcol, const bf16_t* __restrict__ VT,
                                          int lat_row0, int ctx_row0, int tile_lo, int tile_hi, bool has_ref, float m0, float l0, int qpos0,
                                          f32x16 (&o)[DV / 32], float& l_out, int wave, int lane) {
    int tid_ = threadIdx.x; asm volatile("" : "+v"(tid_)); const int tid = tid_; lane = tid & 63; const int qn = lane & 31, half = lane >> 5;
    bf16x8 qf[4];
    { const bf16_t* qp = P + (size_t)(qrow0 + wave * 32 + qn) * PP + qcol + half * 8;
#pragma unroll
      for (int ks = 0; ks < 4; ++ks) qf[ks] = *(const bf16x8*)(qp + ks * 16); }
    float mrun = has_ref ? m0 : 0.f, lrun = (half == 0) ? l0 : 0.f;
    bool need_ref = !has_ref;
    f32x16 negm;
#pragma unroll
    for (int i = 0; i < 16; ++i) negm[i] = -mrun;
#pragma unroll
    for (int db = 0; db < DV / 32; ++db)
#pragma unroll
        for (int i = 0; i < 16; ++i) o[db][i] = 0.f;
    const int nlat = tile_hi - tile_lo, nt = nlat + 4;
    u32x4 kreg[1], vreg[1][DV / 64];
    const int skey = tid >> 3, spc = tid & 7;
#define ATT_LOAD(ti_, set_) do { const int id_ = (ti_) < nlat ? tile_lo + (ti_) : 128 + ((ti_) - nlat); \
        const int krow0_ = id_ < 128 ? lat_row0 + 64 * id_ : ctx_row0 + 64 * (id_ - 128); \
        kreg[set_] = *(const u32x4*)(P + (size_t)(krow0_ + skey) * PP + kcol + spc * 8); \
        _Pragma("unroll") for (int j_ = 0; j_ < DV / 64; ++j_) { const int idx_ = tid + 512 * j_; vreg[set_][j_] = *(const u32x4*)(VT + (size_t)(idx_ >> 3) * KEYS + 64 * id_ + (idx_ & 7) * 8); } } while (0)
#define ATT_STORE(buf_, set_) do { LAS unsigned char* b_ = lds + (buf_) * ATT_BUF; *(LAS u32x4*)(b_ + skey * ATT_ROW + spc * 16) = kreg[set_]; \
        _Pragma("unroll") for (int j_ = 0; j_ < DV / 64; ++j_) { const int idx_ = tid + 512 * j_, dim_ = idx_ >> 3; *(LAS u32x4*)(b_ + ATT_VOFF + dim_ * ATT_ROW + (((idx_ & 7) ^ ((dim_ >> 4) & 1)) * 16)) = vreg[set_][j_]; } } while (0)
    __syncthreads();
    ATT_LOAD(0, 0); ATT_STORE(0, 0);
    if (nt > 1) ATT_LOAD(1, 0);
    __syncthreads();
    for (int ti0 = 0; ti0 < nt; ti0 += 1) {
#pragma unroll
      for (int dd = 0; dd < 1; ++dd) {
        const int ti = ti0 + dd;
        if (ti < nt) {
        const LAS unsigned char* Ks = lds + (ti & 1) * ATT_BUF; const LAS unsigned char* Vs = Ks + ATT_VOFF;
        const int id = ti < nlat ? tile_lo + ti : 128 + (ti - nlat);
        const bool islat = id < 128;
        bool skip = false;
        if (WINDOW && islat) { const int qw = qpos0 + wave * 32; skip = (64 * id + 63 < qw - 128 || 64 * id > qw + 31 + 128); }
        if (!skip) {
        f32x16 s[2];
#pragma unroll
        for (int mb = 0; mb < 2; ++mb) {
#pragma unroll
            for (int ks = 0; ks < 4; ++ks) {
                const bf16x8 kf = *(const LAS bf16x8*)(Ks + (32 * mb + qn) * ATT_ROW + ks * 32 + half * 16);
                if (ks == 0) s[mb] = __builtin_amdgcn_mfma_f32_32x32x16_bf16(kf, qf[0], negm, 0, 0, 0);
                else s[mb] = __builtin_amdgcn_mfma_f32_32x32x16_bf16(kf, qf[ks], s[mb], 0, 0, 0);
            }
        }
        if (WINDOW && islat) {
            const int qpos = qpos0 + wave * 32 + qn;
#pragma unroll
            for (int mb = 0; mb < 2; ++mb)
#pragma unroll
                for (int i = 0; i < 16; ++i) { const int d = 64 * id + 32 * mb + 8 * (i >> 2) + 4 * half + (i & 3) - qpos; if (d > 128 || d < -128) s[mb][i] = -INFINITY; }
        }
        float mx = s[0][0];
#pragma unroll
        for (int mb = 0; mb < 2; ++mb)
#pragma unroll
            for (int i = 0; i < 16; ++i) mx = fmaxf(mx, s[mb][i]);
        mx = xhalf_max(mx);
        if (__builtin_expect(need_ref || __any(mx > ATT_THR), 0)) {
            const float delta = need_ref ? mx : fmaxf(mx, 0.f);
            if (!need_ref) {
                const float alpha = __builtin_amdgcn_exp2f(-delta);
                lrun *= alpha;
#pragma unroll
                for (int db = 0; db < DV / 32; ++db)
#pragma unroll
                    for (int i = 0; i < 16; ++i) o[db][i] *= alpha;
            }
            mrun += delta; need_ref = false;
#pragma unroll
            for (int mb = 0; mb < 2; ++mb)
#pragma unroll
                for (int i = 0; i < 16; ++i) s[mb][i] -= delta;
#pragma unroll
            for (int i = 0; i < 16; ++i) negm[i] = -mrun;
        }
        float rs = 0.f;
#pragma unroll
        for (int mb = 0; mb < 2; ++mb)
#pragma unroll
            for (int i = 0; i < 16; ++i) { const float pv = __builtin_amdgcn_exp2f(s[mb][i]); s[mb][i] = pv; rs += pv; }
        lrun += rs;
#pragma unroll
        for (int g = 0; g < 4; ++g) {
            const int mb = g >> 1, bs = 8 * (g & 1);
            u32x4 pw; pw.x = pk2(s[mb][bs + 0], s[mb][bs + 1]); pw.y = pk2(s[mb][bs + 2], s[mb][bs + 3]); pw.z = pk2(s[mb][bs + 4], s[mb][bs + 5]); pw.w = pk2(s[mb][bs + 6], s[mb][bs + 7]);
            const bf16x8 pf = __builtin_bit_cast(bf16x8, pw);
#pragma unroll
            for (int db = 0; db < DV / 32; ++db) {
                const int dim = 32 * db + qn, sw = (dim >> 4) & 1;
                const LAS unsigned char* vrow = Vs + dim * ATT_ROW + 8 * half;
                const u32x2 lo = *(const LAS u32x2*)(vrow + (((2 * g) ^ sw) * 16)), hi = *(const LAS u32x2*)(vrow + (((2 * g + 1) ^ sw) * 16));
                const u32x4 vw = (u32x4){lo.x, lo.y, hi.x, hi.y};
                o[db] = __builtin_amdgcn_mfma_f32_32x32x16_bf16(__builtin_bit_cast(bf16x8, vw), pf, o[db], 0, 0, 0);
            }
        }
        }
        if (ti + 1 < nt) { ATT_STORE((ti + 1) & 1, 0); if (ti + 2 < nt) ATT_LOAD(ti + 2, 0); }
        __syncthreads();
        }
      }
    }
#undef ATT_LOAD
#undef ATT_STORE
    l_out = xhalf_sum(lrun);
}

__device__ __forceinline__ void swa_unit(LAS unsigned char* lds, const Params& p, int layer, int b, int hq, int qb, bool ctx, int wave, int lane, bool dry = false) {
    const bf16_t* P = (const bf16_t*)(p.ws + WS_P); bf16_t* YA = (bf16_t*)(p.ws + WS_YA);
    const int kvh = hq >> 2;
    const bf16_t* VT = (const bf16_t*)(p.ws + WS_VTS) + (size_t)((b * 2 + kvh) * 64) * KEYS;
    const float sink2 = p.in[11][layer * 8 + hq] * 1.4426950408889634f;
    const int qrow0 = ctx ? NLAT + b * CTXL : b * SEQ + qb * 256;
    f32x16 o[2]; float l;
    if (ctx) attn_pass<64, false>(lds, P, qrow0, IC_QS + hq * 64, IC_KS + kvh * 64, VT, b * SEQ, NLAT + b * CTXL, 0, 0, true, sink2, 1.0f, 0, o, l, wave, lane);
    else {
        int lo = 4 * qb - 2; if (lo < 0) lo = 0; int hi = 4 * qb + 6; if (hi > 128) hi = 128;
        attn_pass<64, true>(lds, P, qrow0, IC_QS + hq * 64, IC_KS + kvh * 64, VT, b * SEQ, NLAT + b * CTXL, lo, hi, true, sink2, 1.0f, qb * 256, o, l, wave, lane);
    }
    const float inv = 1.0f / l; const int qn = lane & 31, half = lane >> 5;
    bf16_t* dst = YA + (size_t)(qrow0 + wave * 32 + qn) * 512 + hq * 64 + 4 * half;
#pragma unroll
    for (int db = 0; db < 2; ++db)
#pragma unroll
        for (int q4 = 0; q4 < 4; ++q4) {
            const f32x4 v = (f32x4){o[db][4 * q4] * inv, o[db][4 * q4 + 1] * inv, o[db][4 * q4 + 2] * inv, o[db][4 * q4 + 3] * inv};
            if (!dry) *(u32x2*)(dst + 32 * db + 8 * q4) = pack4(v);
        }
}
__device__ __forceinline__ void diff_unit(LAS unsigned char* lds, const Params& p, float lam, int b, int h, int qb, bool ctx, int wave, int lane, bool dry = false) {
    bf16_t* P = (bf16_t*)(p.ws + WS_P);
    const bf16_t* VT = (const bf16_t*)(p.ws + WS_VTD) + (size_t)((b * 4 + h) * 128) * KEYS;
    const int qrow0 = ctx ? NLAT + b * CTXL : b * SEQ + qb * 256;
    const int thi = ctx ? 0 : 128;
    LAS unsigned* park = (LAS unsigned*)(lds + 73728) + threadIdx.x;
    f32x16 o[4]; float l;
    attn_pass<128, false>(lds, P, qrow0, IC_QD + h * 128, IC_KD + h * 128, VT, b * SEQ, NLAT + b * CTXL, 0, thi, false, 0.f, 0.f, 0, o, l, wave, lane);
    { const float inv = 1.0f / l;
#pragma unroll
      for (int db = 0; db < 4; ++db)
#pragma unroll
          for (int i = 0; i < 8; ++i) park[(db * 8 + i) * 512] = pk2(o[db][2 * i] * inv, o[db][2 * i + 1] * inv); }
    attn_pass<128, false>(lds, P, qrow0, IC_QD + h * 128 + 64, IC_KD + h * 128 + 64, VT, b * SEQ, NLAT + b * CTXL, 0, thi, false, 0.f, 0.f, 0, o, l, wave, lane);
    const float inv = lam / l; const int qn = lane & 31, half = lane >> 5;
    bf16_t* dst = P + (size_t)(qrow0 + wave * 32 + qn) * PP + IC_QD + h * 128 + 4 * half;
#pragma unroll
    for (int db = 0; db < 4; ++db)
#pragma unroll
        for (int q4 = 0; q4 < 4; ++q4) {
            const unsigned pa = park[(db * 8 + 2 * q4) * 512], pb = park[(db * 8 + 2 * q4 + 1) * 512];
            const f32x4 v = (f32x4){bflo(pa) - o[db][4 * q4] * inv, bfhi(pa) - o[db][4 * q4 + 1] * inv, bflo(pb) - o[db][4 * q4 + 2] * inv, bfhi(pb) - o[db][4 * q4 + 3] * inv};
            if (!dry) *(u32x2*)(dst + 32 * db + 8 * q4) = pack4(v);
        }
}

__device__ __forceinline__ void ld8bf(const bf16_t* p, float (&v)[8]) { const u32x4 w = *(const u32x4*)p; v[0] = bflo(w.x); v[1] = bfhi(w.x); v[2] = bflo(w.y); v[3] = bfhi(w.y); v[4] = bflo(w.z); v[5] = bfhi(w.z); v[6] = bflo(w.w); v[7] = bfhi(w.w); }
__device__ __forceinline__ void ld8f(const float* p, float (&v)[8]) { const f32x4 a = ((const f32x4*)p)[0], b = ((const f32x4*)p)[1]; v[0] = a.x; v[1] = a.y; v[2] = a.z; v[3] = a.w; v[4] = b.x; v[5] = b.y; v[6] = b.z; v[7] = b.w; }
__device__ __forceinline__ void st8f(float* p, const float (&v)[8]) { ((f32x4*)p)[0] = (f32x4){v[0], v[1], v[2], v[3]}; ((f32x4*)p)[1] = (f32x4){v[4], v[5], v[6], v[7]}; }

__device__ __forceinline__ void rwkv_prepare_phase(const Params& p, int layer, int gw, int NGW, int lane) {
    const bf16_t* P = (const bf16_t*)(p.ws + WS_P); float* ST = (float*)(p.ws + WS_ST); bf16_t* A2 = (bf16_t*)(p.ws + WS_YA);
    const float* mup = p.in[12] + layer * 1920; const float* mun = p.in[13] + layer * 1920; const float* k_k = p.in[19] + layer * 512;
    for (int m = gw; m < NTOK; m += NGW) {
        const int t = m < NLAT ? (m & (SEQ - 1)) : ((m - NLAT) & (CTXL - 1)), len = m < NLAT ? SEQ : CTXL;
        const bool hp = t > 0, hn = t < len - 1;
        const bf16_t* pr = P + (size_t)m * PP + IC_RW;
        const int h = lane >> 3, kidx = (lane & 7) * 8;
        float* sp = ST + ((size_t)m * 8 + h) * (ST_SLOTS * 64) + kidx;
#pragma unroll
        for (int sec = 0; sec < 4; ++sec) {
            if (sec == 3 && lane >= 48) break;
            const int col = sec < 3 ? sec * 512 + lane * 8 : 1536 + lane * 8;
            float c[8], pv[8], nx[8], a[8], bb[8], sh[8];
            ld8bf(pr + col, c);
            if (hp) ld8bf(pr - PP + col, pv); else {
#pragma unroll
                for (int q = 0; q < 8; ++q) pv[q] = 0.f; }
            if (hn) ld8bf(pr + PP + col, nx); else {
#pragma unroll
                for (int q = 0; q < 8; ++q) nx[q] = 0.f; }
            ld8f(mup + col, a); ld8f(mun + col, bb);
#pragma unroll
            for (int q = 0; q < 8; ++q) sh[q] = c[q] + a[q] * (pv[q] - c[q]) + bb[q] * (nx[q] - c[q]);
            if (sec == 0) st8f(sp + 1 * 64, sh);
            else if (sec == 2) st8f(sp + 2 * 64, sh);
            else if (sec == 1) {
                st8f(sp + 5 * 64, sh); st8f(sp + 8 * 64, sh);
                float kk[8], kkw[8]; ld8f(k_k + lane * 8, kkw);
                float ss = 0.f;
#pragma unroll
                for (int q = 0; q < 8; ++q) { kk[q] = sh[q] * kkw[q]; ss += kk[q] * kk[q]; }
                ss += __shfl_xor(ss, 1); ss += __shfl_xor(ss, 2); ss += __shfl_xor(ss, 4);
                const float inv = 1.0f / fmaxf(sqrtf(ss), 1e-12f);
#pragma unroll
                for (int q = 0; q < 8; ++q) kk[q] *= inv;
                st8f(sp, kk);
            } else {
                float o[8];
#pragma unroll
                for (int q = 0; q < 8; ++q) o[q] = lane < 16 ? tanhf(sh[q]) : (lane < 32 ? sh[q] : sigmoidf_(sh[q]));
                u32x4 w; w.x = pk2(o[0], o[1]); w.y = pk2(o[2], o[3]); w.z = pk2(o[4], o[5]); w.w = pk2(o[6], o[7]);
                *(u32x4*)(A2 + (size_t)m * 384 + lane * 8) = w;
            }
        }
    }
}

constexpr int NSEG = 64, SEGL = KEYS / NSEG;
static_assert(SEGL * NSEG == KEYS && SEGL % 4 == 0, "segments");
constexpr size_t WS_GH = WS_YA;
static_assert(WS_GH + 32ull * NSEG * 2 * 4096 * 4 <= 560 * MiB, "GH fits behind the stream");
__device__ __forceinline__ int scan_token(int b, int dir, int s) {
    if (s < CTXL) return NLAT + b * CTXL + (dir ? CTXL - 1 - s : s);
    const int t = s - CTXL; return b * SEQ + (dir ? SEQ - 1 - t : t);
}
constexpr int SRING = 6, SREC = ST_SLOTS * 64 * 4;
constexpr int SCAN_LDS = SRING * SREC;
__device__ __forceinline__ void scan_dma(const float* rec, LAS unsigned char* slot, int lane) {
    const float* q = rec + lane * 4;
    __builtin_amdgcn_global_load_lds((const unsigned*)q, (LAS unsigned*)slot, 16, 0, 0);
    __builtin_amdgcn_global_load_lds((const unsigned*)(q + 256), (LAS unsigned*)(slot + 1024), 16, 0, 0);
    if (lane < 16) __builtin_amdgcn_global_load_lds((const unsigned*)(q + 512), (LAS unsigned*)(slot + 2048), 16, 0, 0);
}
template <int MODE>
__device__ __forceinline__ void rwkv_segment(const Params& p, int sid, int seg, int lane, LAS unsigned char* ring) {
    const int b = sid >> 4, h = (sid >> 1) & 7, dir = sid & 1, c = lane & 31, hf = lane >> 5;
    const float* ST = (const float*)(p.ws + WS_ST);
    float* gh = (float*)(p.ws + WS_GH) + ((size_t)sid * NSEG + seg) * 2 * 4096;
    f32x16 TH[2][2], TG[MODE == 0 ? 2 : 1][2];
#pragma unroll
    for (int kb = 0; kb < 2; ++kb)
#pragma unroll
        for (int vb = 0; vb < 2; ++vb) {
            if (MODE == 2 && seg > 0) {
                const float* src = gh - 4096 + (32 * vb + c) * 64 + 32 * kb + 4 * hf;
#pragma unroll
                for (int q = 0; q < 4; ++q) { const f32x4 t = *(const f32x4*)(src + 8 * q); TH[kb][vb][4 * q] = t.x; TH[kb][vb][4 * q + 1] = t.y; TH[kb][vb][4 * q + 2] = t.z; TH[kb][vb][4 * q + 3] = t.w; }
            } else {
#pragma unroll
                for (int r = 0; r < 16; ++r) TH[kb][vb][r] = 0.f;
            }
            if (MODE == 0) {
#pragma unroll
                for (int r = 0; r < 16; ++r) TG[MODE == 0 ? kb : 0][vb][r] = (32 * kb + 8 * (r >> 2) + 4 * hf + (r & 3) == 32 * vb + c) ? 1.0f : 0.0f;
            }
        }
    const int s0 = seg * SEGL, s_end = s0 + SEGL, od = (3 + 3 * dir) * 256;
#pragma unroll 1
    for (int j = 0; j < SRING - 1; ++j) scan_dma(ST + ((size_t)scan_token(b, dir, s0 + j) * 8 + h) * (ST_SLOTS * 64), ring + j * SREC, lane);
    int slot_i = 0;
#pragma unroll 1
    for (int s = s0; s < s_end; ++s) {
        if (s + SRING - 1 < s_end) {
            int nslot = slot_i + SRING - 1; if (nslot >= SRING) nslot -= SRING;
            scan_dma(ST + ((size_t)scan_token(b, dir, s + SRING - 1) * 8 + h) * (ST_SLOTS * 64), ring + nslot * SREC, lane);
            asm volatile("s_waitcnt vmcnt(15)" ::: "memory");
        } else asm volatile("s_waitcnt vmcnt(0)" ::: "memory");
        const LAS unsigned char* rec = ring + slot_i * SREC;
        slot_i = slot_i + 1 == SRING ? 0 : slot_i + 1;
        float ph[2] = {0.f, 0.f}, pg[2] = {0.f, 0.f};
#pragma unroll
        for (int kb = 0; kb < 2; ++kb)
#pragma unroll
            for (int q = 0; q < 4; ++q) {
                const f32x4 a4 = *(const LAS f32x4*)(rec + (32 * kb + 8 * q + 4 * hf) * 4);
#pragma unroll
                for (int j = 0; j < 4; ++j)
#pragma unroll
                    for (int vb = 0; vb < 2; ++vb) { ph[vb] = fmaf(TH[kb][vb][4 * q + j], a4[j], ph[vb]); if (MODE == 0) pg[vb] = fmaf(TG[MODE == 0 ? kb : 0][vb][4 * q + j], a4[j], pg[vb]); }
            }
        float sa[2], sg[2];
#pragma unroll
        for (int vb = 0; vb < 2; ++vb) { sa[vb] = xhalf_sum(ph[vb]); sg[vb] = MODE == 0 ? xhalf_sum(pg[vb]) : 0.f; }
#pragma unroll
        for (int kb = 0; kb < 2; ++kb)
#pragma unroll
            for (int q = 0; q < 4; ++q) {
                const f32x4 w4 = *(const LAS f32x4*)(rec + od + (32 * kb + 8 * q + 4 * hf) * 4);
#pragma unroll
                for (int j = 0; j < 4; ++j)
#pragma unroll
                    for (int vb = 0; vb < 2; ++vb) { TH[kb][vb][4 * q + j] *= w4[j]; if (MODE == 0) TG[MODE == 0 ? kb : 0][vb][4 * q + j] *= w4[j]; }
            }
        float aop[2], bop[2], bopg[2];
#pragma unroll
        for (int kb = 0; kb < 2; ++kb) aop[kb] = *(const LAS float*)(rec + od + (hf ? 512 : 256) + (32 * kb + c) * 4);
#pragma unroll
        for (int vb = 0; vb < 2; ++vb) { const float vv = *(const LAS float*)(rec + 512 + (32 * vb + c) * 4); bop[vb] = hf ? vv : sa[vb]; bopg[vb] = hf ? 0.f : sg[vb]; }
#pragma unroll
        for (int kb = 0; kb < 2; ++kb)
#pragma unroll
            for (int vb = 0; vb < 2; ++vb) {
                TH[kb][vb] = __builtin_amdgcn_mfma_f32_32x32x2f32(aop[kb], bop[vb], TH[kb][vb], 0, 0, 0);
                if (MODE == 0) TG[MODE == 0 ? kb : 0][vb] = __builtin_amdgcn_mfma_f32_32x32x2f32(aop[kb], bopg[vb], TG[MODE == 0 ? kb : 0][vb], 0, 0, 0);
            }
        if (MODE == 2) {
            float py[2] = {0.f, 0.f};
#pragma unroll
            for (int kb = 0; kb < 2; ++kb)
#pragma unroll
                for (int q = 0; q < 4; ++q) {
                    const f32x4 r4 = *(const LAS f32x4*)(rec + 256 + (32 * kb + 8 * q + 4 * hf) * 4);
#pragma unroll
                    for (int j = 0; j < 4; ++j)
#pragma unroll
                        for (int vb = 0; vb < 2; ++vb) py[vb] = fmaf(TH[kb][vb][4 * q + j], r4[j], py[vb]);
                }
            const float y0 = xhalf_sum(py[0]), y1 = xhalf_sum(py[1]);
            float* yp = (float*)ST + ((size_t)scan_token(b, dir, s) * 8 + h) * (ST_SLOTS * 64) + (3 + 3 * dir) * 64 + c;
            if (hf == 0) { yp[0] = y0; yp[32] = y1; }
        }
    }
    if (MODE == 0) {
#pragma unroll
        for (int kb = 0; kb < 2; ++kb)
#pragma unroll
            for (int vb = 0; vb < 2; ++vb) {
                float* dg = gh + (32 * vb + c) * 64 + 32 * kb + 4 * hf; float* dh = dg + 4096;
#pragma unroll
                for (int q = 0; q < 4; ++q) {
                    *(f32x4*)(dg + 8 * q) = (f32x4){TG[MODE == 0 ? kb : 0][vb][4 * q], TG[MODE == 0 ? kb : 0][vb][4 * q + 1], TG[MODE == 0 ? kb : 0][vb][4 * q + 2], TG[MODE == 0 ? kb : 0][vb][4 * q + 3]};
                    *(f32x4*)(dh + 8 * q) = (f32x4){TH[kb][vb][4 * q], TH[kb][vb][4 * q + 1], TH[kb][vb][4 * q + 2], TH[kb][vb][4 * q + 3]};
                }
            }
    }
}
__device__ __forceinline__ void rwkv_combine(const Params& p, int sid, LAS unsigned char* lds, int wave, int lane) {
    float* gh0 = (float*)(p.ws + WS_GH) + (size_t)sid * NSEG * 2 * 4096;
    LAS float* Sx = (LAS float*)lds;
    const int tid = wave * 64 + lane;
    for (int e = tid; e < 4096; e += NTHREADS) Sx[(e >> 6) * 65 + (e & 63)] = gh0[4096 + e];
    __syncthreads();
    const int rb = (wave >> 1) & 1, cb = wave & 1, i32 = lane & 31, hf = lane >> 5;
    for (int i = 1; i < NSEG - 1; ++i) {
        float* gi = gh0 + (size_t)i * 2 * 4096;
        f32x16 d;
        if (wave < 4) {
            float bq[32];
#pragma unroll
            for (int q = 0; q < 32; ++q) bq[q] = gi[(2 * q + hf) * 64 + 32 * cb + i32];
#pragma unroll
            for (int r = 0; r < 16; ++r) d[r] = gi[4096 + (32 * rb + 8 * (r >> 2) + 4 * hf + (r & 3)) * 64 + 32 * cb + i32];
#pragma unroll
            for (int q = 0; q < 32; ++q) {
                const float aq = Sx[(32 * rb + i32) * 65 + 2 * q + hf];
                d = __builtin_amdgcn_mfma_f32_32x32x2f32(aq, bq[q], d, 0, 0, 0);
            }
#pragma unroll
            for (int r = 0; r < 16; ++r) gi[4096 + (32 * rb + 8 * (r >> 2) + 4 * hf + (r & 3)) * 64 + 32 * cb + i32] = d[r];
        }
        __syncthreads();
        if (wave < 4) {
#pragma unroll
            for (int r = 0; r < 16; ++r) Sx[(32 * rb + 8 * (r >> 2) + 4 * hf + (r & 3)) * 65 + 32 * cb + i32] = d[r];
        }
        __syncthreads();
    }
}

__device__ __forceinline__ void postmix_phase(const Params& p, int layer, float lam_init, int M, int gw, int NGW, int lane) {
    const bf16_t* P = (const bf16_t*)(p.ws + WS_P); const float* ST = (const float*)(p.ws + WS_ST);
    bf16_t* YB = (bf16_t*)(p.ws + WS_YB); bf16_t* YC = (bf16_t*)(p.ws + WS_YC);
    const float* r_k = p.in[21] + layer * 512; const float* lng = p.in[22] + layer * 512; const float* lnb = p.in[23] + layer * 512; const float* sg = p.in[25] + layer * 128;
    for (int m = gw; m < M; m += NGW) {
        {
            const int h = lane >> 3, kidx = (lane & 7) * 8, ch = lane * 8;
            const float* sp = ST + ((size_t)m * 8 + h) * (ST_SLOTS * 64) + kidx;
            float y[8], r[8], v[8], k0[8], k1[8], rk[8], g[8], lg[8], lb[8];
            { float yb_[8]; ld8f(sp + 3 * 64, y); ld8f(sp + 6 * 64, yb_);
#pragma unroll
              for (int q = 0; q < 8; ++q) y[q] += yb_[q]; }
            ld8f(sp + 64, r); ld8f(sp + 128, v); ld8f(sp + 5 * 64, k0); ld8f(sp + 8 * 64, k1); ld8f(r_k + ch, rk); ld8f(lng + ch, lg); ld8f(lnb + ch, lb);
            ld8bf(P + (size_t)m * PP + IC_RW + ch, g);
            float s = 0.f, bn = 0.f;
#pragma unroll
            for (int q = 0; q < 8; ++q) { s += y[q]; bn += r[q] * (k0[q] + k1[q]) * rk[q]; }
            s += __shfl_xor(s, 1); s += __shfl_xor(s, 2); s += __shfl_xor(s, 4);
            bn += __shfl_xor(bn, 1); bn += __shfl_xor(bn, 2); bn += __shfl_xor(bn, 4);
            const float mu = s * (1.0f / 64.0f);
            float var = 0.f;
#pragma unroll
            for (int q = 0; q < 8; ++q) { const float d = y[q] - mu; var += d * d; }
            var += __shfl_xor(var, 1); var += __shfl_xor(var, 2); var += __shfl_xor(var, 4);
            const float rstd = 1.0f / sqrtf(var * (1.0f / 64.0f) + 64e-5f);
            float o[8];
#pragma unroll
            for (int q = 0; q < 8; ++q) o[q] = (((y[q] - mu) * rstd) * lg[q] + lb[q] + bn * v[q]) * g[q];
            u32x4 w; w.x = pk2(o[0], o[1]); w.y = pk2(o[2], o[3]); w.z = pk2(o[4], o[5]); w.w = pk2(o[6], o[7]);
            *(u32x4*)(YB + (size_t)m * 512 + ch) = w;
        }
        {
            const int e = (lane & 15) * 8;
            float x[8], gg[8];
            ld8bf(P + (size_t)m * PP + IC_QD + lane * 8, x); ld8f(sg + e, gg);
            float ss = 0.f;
#pragma unroll
            for (int q = 0; q < 8; ++q) ss += x[q] * x[q];
            ss += __shfl_xor(ss, 1); ss += __shfl_xor(ss, 2); ss += __shfl_xor(ss, 4); ss += __shfl_xor(ss, 8);
            const float rstd = (1.0f - lam_init) / sqrtf(ss * (1.0f / 128.0f) + 1e-5f);
            float o[8];
#pragma unroll
            for (int q = 0; q < 8; ++q) o[q] = x[q] * rstd * gg[q];
            u32x4 w; w.x = pk2(o[0], o[1]); w.y = pk2(o[2], o[3]); w.z = pk2(o[4], o[5]); w.w = pk2(o[6], o[7]);
            *(u32x4*)(YC + (size_t)m * 512 + lane * 8) = w;
        }
    }
}
#define XB_TMO      128
#define XB_XCNT(j)  (256  + 64 * (j))
#define XB_XSUB(j)  (1280 + 64 * (j))
#define XB_XGEN(j)  (2304 + 64 * (j))
#define XB_TOP      3328
#define XB_TOPGEN   3392
#define XCD_BAR_WORDS 3456
#define XB_SPIN_CAP (1u << 18)

__device__ __forceinline__ unsigned xb_ld(unsigned* p)              { return __hip_atomic_load(p, __ATOMIC_RELAXED, __HIP_MEMORY_SCOPE_AGENT); }
__device__ __forceinline__ unsigned xb_add(unsigned* p, unsigned v) { return __hip_atomic_fetch_add(p, v, __ATOMIC_RELAXED, __HIP_MEMORY_SCOPE_AGENT); }
__device__ __forceinline__ unsigned xb_xcc_id() { return (unsigned)__builtin_amdgcn_s_getreg((3 << 11) | 20) & 0xFu; }
#define XB_SPIN(cond, bar) do { unsigned _sp = 0; while (cond) { __builtin_amdgcn_s_sleep(1); \
    if ((++_sp & 255u) == 0u) { if (xb_ld(&(bar)[XB_TMO])) break; if (_sp > XB_SPIN_CAP) { atomicAdd(&(bar)[XB_TMO], 1u); break; } } } } while (0)

struct XcdBarrier {
    unsigned* bar; unsigned x;
    volatile LAS unsigned* st;
};

__device__ __forceinline__ XcdBarrier xcd_barrier_post(unsigned* bar, volatile LAS unsigned* st) {
    XcdBarrier b; b.bar = bar; b.x = xb_xcc_id(); b.st = st;
    if (threadIdx.x == 0) (void)xb_add(&bar[XB_XCNT(b.x)], 1u);
    return b;
}
__device__ __forceinline__ void xcd_barrier_complete(unsigned* bar, unsigned x, unsigned& nloc, unsigned& nx) {
    const unsigned G = gridDim.x * gridDim.y * gridDim.z;
    unsigned sum, cnt, mine, sp = 0u;
    for (;;) {
        sum = 0u; cnt = 0u; mine = 0u;
#pragma unroll
        for (unsigned j = 0; j < 16; ++j) { const unsigned c = xb_ld(&bar[XB_XCNT(j)]); sum += c; cnt += (c > 0u) ? 1u : 0u; mine = (j == x) ? c : mine; }
        if (sum == G) break;
        __builtin_amdgcn_s_sleep(1);
        if ((++sp & 255u) == 0u) { if (xb_ld(&bar[XB_TMO])) break; if (sp > XB_SPIN_CAP) { atomicAdd(&bar[XB_TMO], 1u); break; } }
    }
    nloc = mine > 0u ? mine : 1u; nx = cnt > 0u ? cnt : 1u;
}

__device__ __forceinline__ void xcd_barrier(const XcdBarrier& b) {
    asm volatile("s_waitcnt vmcnt(0)" ::: "memory");
    __syncthreads();
    if (threadIdx.x == 0) {
        unsigned* bar = b.bar;
        __builtin_amdgcn_s_waitcnt(0);
        unsigned nloc = b.st[0], nx = b.st[1];
        if (nloc == 0u) { xcd_barrier_complete(bar, b.x, nloc, nx); b.st[0] = nloc; b.st[1] = nx; }
        const unsigned old = xb_add(&bar[XB_XSUB(b.x)], 1u);
        const unsigned gen = old / nloc;
        if (old + 1u == (gen + 1u) * nloc) {
            __builtin_amdgcn_fence(__ATOMIC_RELEASE, "agent");
            asm volatile("s_waitcnt vmcnt(0)" ::: "memory");
            const unsigned og = xb_add(&bar[XB_TOP], 1u);
            const unsigned tg = og / nx;
            if (og + 1u == (tg + 1u) * nx) xb_add(&bar[XB_TOPGEN], 1u);
            else XB_SPIN(xb_ld(&bar[XB_TOPGEN]) == tg, bar);
            __builtin_amdgcn_fence(__ATOMIC_ACQUIRE, "agent");
            xb_add(&bar[XB_XGEN(b.x)], 1u);
            asm volatile("s_waitcnt vmcnt(0)" ::: "memory");
        } else {
            XB_SPIN(xb_ld(&bar[XB_XGEN(b.x)]) == gen, bar);
            __builtin_amdgcn_fence(__ATOMIC_ACQUIRE, "agent");
            asm volatile("s_waitcnt vmcnt(0)" ::: "memory");
        }
    }
    __syncthreads();
}

#ifndef MK_MULTI
#define MK_MULTI 0
#endif
constexpr int N_PHASES = 40;

constexpr int LDS_PARAMS = LDS_BYTES - 1024;
constexpr int LDS_XB = LDS_BYTES - 64;
constexpr int CW_BAR = 8192;
__device__ __forceinline__ unsigned long long uni64(unsigned long long v) {
    const unsigned lo = __builtin_amdgcn_readfirstlane((unsigned)v), hi = __builtin_amdgcn_readfirstlane((unsigned)(v >> 32));
    return ((unsigned long long)hi << 32) | lo;
}
__device__ __forceinline__ int opq(int v) { asm volatile("" : "+s"(v)); return v; }
__device__ __forceinline__ void load_params(LAS unsigned char* lds, Params& q) {
    LAS const unsigned long long* s = (LAS const unsigned long long*)(lds + LDS_PARAMS);
#pragma unroll
    for (int i = 0; i < 37; ++i) q.in[i] = (const float*)(const __attribute__((address_space(1))) float*)uni64(s[i]);
    q.out = (float*)(__attribute__((address_space(1))) float*)uni64(s[37]); q.ws = (unsigned char*)(__attribute__((address_space(1))) unsigned char*)uni64(s[38]); q.ph_lo = 0; q.ph_hi = 0;
}
__global__ void __launch_bounds__(NTHREADS, 2) mk_fwd(Params kp) {
    extern __shared__ __attribute__((aligned(16))) unsigned char lds_raw[];
    LAS unsigned char* lds = (LAS unsigned char*)lds_raw;
    cg::grid_group grid = cg::this_grid();
    if (threadIdx.x == 0) {
        LAS unsigned long long* s = (LAS unsigned long long*)(lds + LDS_PARAMS);
#pragma unroll
        for (int i = 0; i < 37; ++i) s[i] = (unsigned long long)kp.in[i];
        s[37] = (unsigned long long)kp.out; s[38] = (unsigned long long)kp.ws;
    }
    if (threadIdx.x < 2) ((LAS unsigned*)(lds + LDS_XB))[threadIdx.x] = 0u;
    __syncthreads();
#if !MK_MULTI
    (void)xcd_barrier_post((unsigned*)(kp.ws + WS_CTL) + CW_BAR, (volatile LAS unsigned*)(lds + LDS_XB));
#endif
    const int ph_lo = kp.ph_lo, ph_hi = kp.ph_hi;
    int ph = 0;
#define PH_BEGIN if (ph >= ph_lo && ph < ph_hi) { asm volatile("" ::: "memory"); Params p; load_params(lds, p); unsigned char* ws = p.ws; (void)ws; \
    int tid_ = threadIdx.x, bid_ = blockIdx.x, G_ = gridDim.x; asm volatile("" : "+v"(tid_), "+s"(bid_), "+s"(G_)); \
    const int tid = tid_, bid = bid_, G = G_, lane = tid & 63, wave = __builtin_amdgcn_readfirstlane(tid >> 6); const int gw = bid * NWAVES + wave, NGW = G * NWAVES; (void)gw; (void)NGW; (void)lane; (void)tid; (void)G; (void)bid;
#define GRID_SEAM() do { if (ph == 0) grid.sync(); else { XcdBarrier xb_; xb_.bar = (unsigned*)((unsigned char*)(__attribute__((address_space(1))) unsigned char*)uni64(((LAS const unsigned long long*)(lds + LDS_PARAMS))[38]) + WS_CTL) + CW_BAR; \
        xb_.x = xb_xcc_id(); xb_.st = (volatile LAS unsigned*)(lds + LDS_XB); xcd_barrier(xb_); } } while (0)
#define PH_END } if (ph >= ph_lo && ph + 1 < ph_hi) GRID_SEAM(); ++ph;

    using pg8::Gemm; using pg8::StaticOrder; using pg8::gemm_phase;

    PH_BEGIN
        convert_layer_weights(p, 0, lds, gw, NGW, wave, lane);
        __syncthreads();
        adaln_phase(p, lds, wave, lane);
    PH_END
    PH_BEGIN
        premix_phase(p, 0, true, NTOK, gw, NGW, lane);
    PH_END

#pragma clang loop unroll(full)
    for (int layer = 0; layer < 2; ++layer) {
        const int Ml = layer == 0 ? NTOK : NLAT;
        const float lam_init = 0.8f - 0.6f * expf(-0.3f * (float)layer);
        PH_BEGIN
            Gemm g{(const bf16_t*)(ws + WS_XN), (const bf16_t*)(ws + WS_WIN), NTOK, NIN1, opq(1024), 1024}; StaticOrder S; S.init(NTOK, NIN1, G, bid);
            EpiIn E{(bf16_t*)(ws + WS_P), (bf16_t*)(ws + WS_VTS), (bf16_t*)(ws + WS_VTD), (const float*)(ws + WS_ROPE)};
            gemm_phase<EpiIn, StaticOrder, true, true>(lds, g, S, E);
        PH_END
        PH_BEGIN
            rwkv_prepare_phase(p, layer, gw, NGW, lane);
        PH_END
        PH_BEGIN
            Gemm g{(const bf16_t*)(ws + WS_YA), (const bf16_t*)(ws + WS_LORA), NTOK, 2560, opq(384), 384}; StaticOrder S; S.init(NTOK, 2560, G, bid);
            EpiLora E{(float*)(ws + WS_ST), (bf16_t*)(ws + WS_P), p.in[14] + layer * 1024, p.in[16] + layer * 1024, p.in[20] + layer * 512};
            gemm_phase<EpiLora, StaticOrder, true, true>(lds, g, S, E);
        PH_END
        PH_BEGIN
            for (int u = gw; u < 32 * (NSEG - 1); u += NGW) rwkv_segment<0>(p, u / (NSEG - 1), u % (NSEG - 1), lane, lds + wave * SCAN_LDS);
        PH_END
        PH_BEGIN
            if (bid < 32) rwkv_combine(p, bid, lds, wave, lane);
        PH_END
        PH_BEGIN
            for (int u = gw; u < 32 * NSEG; u += NGW) rwkv_segment<2>(p, u / NSEG, u % NSEG, lane, lds + wave * SCAN_LDS);
        PH_END
        PH_BEGIN
            float lam;
            { const float* lv = p.in[24] + layer * 256;
              const float s1 = wave_sum(lv[lane] * lv[64 + lane]), s2 = wave_sum(lv[128 + lane] * lv[192 + lane]);
              lam = expf(s1) - expf(s2) + lam_init; }
            unsigned* qhead = (unsigned*)(ws + WS_CTL) + (layer == 0 ? CW_Q0 : CW_Q1);
            LAS int* ubox = (LAS int*)(lds + 65536);
            const int n_diff = 64, n_swa = 512, n_ctx = layer == 0 ? 24 : 0;
            const int n_units = 256 + 512 + n_ctx; (void)n_diff; (void)n_swa;
            const bool static_diff = (G == 256);
            bool first = static_diff;
            const int n_rep = 1;
            for (;;) {
                int uq;
                if (first) uq = n_units * (n_rep - 1) + ((((bid & 7) >> 2) << 7) | ((bid & 3) << 5) | (bid >> 3));
                else {
                    if (tid == 0) ubox[0] = (int)atomicAdd(qhead, 1u);
                    __syncthreads();
                    uq = ubox[0];
                    __syncthreads();
                }
                if (uq >= n_units * n_rep) break;
                const bool dry = uq < n_units * (n_rep - 1);
                const int u = uq % n_units;
                if (!first && static_diff && !dry && u < 256) continue;
                first = false;
                if (u < 256) diff_unit(lds, p, lam, u >> 7, (u >> 5) & 3, u & 31, false, wave, lane, dry);
                else if (u < 768) { const int v = u - 256; swa_unit(lds, p, layer, v >> 8, (v >> 5) & 7, v & 31, false, wave, lane, dry); }
                else if (u < 776) { const int v = u - 768; diff_unit(lds, p, lam, v >> 2, v & 3, 0, true, wave, lane, dry); }
                else { const int v = u - 776; swa_unit(lds, p, layer, v >> 3, v & 7, 0, true, wave, lane, dry); }
            }
        PH_END

        PH_BEGIN
            postmix_phase(p, layer, lam_init, Ml, gw, NGW, lane);
            if (layer == 0) convert_ffn_weights(p, lds, gw, NGW, wave, lane);
        PH_END
        PH_BEGIN
            Gemm g{(const bf16_t*)(ws + WS_XN), (const bf16_t*)(ws + WS_WIN) + (size_t)NIN1 * 1024, Ml, 3072, opq(1024), 1024}; StaticOrder S; S.init(Ml, 3072, G, bid);
            EpiGate E{(bf16_t*)(ws + WS_G)};
            gemm_phase<EpiGate, StaticOrder, true, true>(lds, g, S, E);
        PH_END
        PH_BEGIN
            StaticOrder S; S.init(Ml, 1024, G, bid);
            { Gemm g{(const bf16_t*)(ws + WS_YA), (const bf16_t*)(ws + WS_PRJ), Ml, 1024, opq(512), 512}; EpiMerge<0> E{(const bf16_t*)(ws + WS_G), (bf16_t*)(ws + WS_MF), (bf16_t*)(ws + WS_MB)};
              gemm_phase<EpiMerge<0>, StaticOrder, true, true>(lds, g, S, E); }
            { Gemm g{(const bf16_t*)(ws + WS_YB), (const bf16_t*)(ws + WS_PRJ) + 1024 * 512, Ml, 1024, opq(512), 512}; EpiMerge<1> E{(const bf16_t*)(ws + WS_G), (bf16_t*)(ws + WS_MF), (bf16_t*)(ws + WS_MB)};
              gemm_phase<EpiMerge<1>, StaticOrder, true, true>(lds, g, S, E); }
            { Gemm g{(const bf16_t*)(ws + WS_YC), (const bf16_t*)(ws + WS_PRJ) + 2 * 1024 * 512, Ml, 1024, opq(512), 512}; EpiMerge<2> E{(const bf16_t*)(ws + WS_G), (bf16_t*)(ws + WS_MF), (bf16_t*)(ws + WS_MB)};
              gemm_phase<EpiMerge<2>, StaticOrder, true, true>(lds, g, S, E); }
        PH_END
        PH_BEGIN
            Gemm g{(const bf16_t*)(ws + WS_MB), (const bf16_t*)(ws + WS_WOUT), Ml, 1024, opq(1024), 1024}; StaticOrder S; S.init(Ml, 1024, G, bid);
            EpiBf E{(bf16_t*)(ws + WS_MOUT), 1024};
            gemm_phase<EpiBf, StaticOrder, true, true>(lds, g, S, E);
        PH_END
        PH_BEGIN
            residual_phase(p, (const bf16_t*)(ws + WS_MOUT), nullptr, nullptr, layer == 0, layer, 2, p.in[7] + layer * 1024, true, p.in[8] + layer * 1024, layer, 3, layer == 1, Ml, gw, NGW, lane);
            if (layer == 0) convert_layer_weights(p, 1, lds, gw, NGW, wave, lane);
            else convert_moe_weights(p, lds, gw, NGW, wave, lane);
        PH_END
        if (layer == 0) {
            PH_BEGIN
                Gemm g{(const bf16_t*)(ws + WS_XN), (const bf16_t*)(ws + WS_FGU), NTOK, 2 * D_FF, opq(1024), 1024}; StaticOrder S; S.init(NTOK, 2 * D_FF, G, bid);
                EpiSwiglu E{(bf16_t*)(ws + WS_HID), D_FF, 1 << 20, 0};
                gemm_phase<EpiSwiglu, StaticOrder, true, true>(lds, g, S, E);
            PH_END
            PH_BEGIN
                Gemm g{(const bf16_t*)(ws + WS_HID), (const bf16_t*)(ws + WS_FD), NTOK, 1024, opq(D_FF), D_FF}; StaticOrder S; S.init(NTOK, 1024, G, bid);
                EpiBf E{(bf16_t*)(ws + WS_MF), 1024};
                gemm_phase<EpiBf, StaticOrder, true, true>(lds, g, S, E);
            PH_END
            PH_BEGIN
                residual_phase(p, (const bf16_t*)(ws + WS_MF), nullptr, nullptr, false, 0, 5, p.in[9], true, p.in[6] + 1024, 1, 0, false, NTOK, gw, NGW, lane);
            PH_END
        }
    }
    {
        {
            PH_BEGIN
                const unsigned* cnt = (const unsigned*)(ws + WS_CTL) + CW_CNT; int ts[9]; ts[0] = 0;
#pragma unroll
                for (int e = 0; e < 8; ++e) ts[e + 1] = ts[e] + (int)((__hip_atomic_load(cnt + e, __ATOMIC_RELAXED, __HIP_MEMORY_SCOPE_AGENT) + 255u) >> 8);
                const int* LIST = (const int*)(ws + WS_LIST); const bf16_t* XN = (const bf16_t*)(ws + WS_XN2); bf16_t* XG = (bf16_t*)(ws + WS_XG);
                for (int r = gw; r < ts[8] * 256; r += NGW) {
                    const int tile = r >> 8; int e = 0;
#pragma unroll
                    for (int q = 1; q < 8; ++q) e += (tile >= ts[q]) ? 1 : 0;
                    int tse = 0;
#pragma unroll
                    for (int q = 0; q < 8; ++q) tse = (q == e) ? ts[q] : tse;
                    const int slot = r - tse * 256;
                    u32x4 v0 = (u32x4){0u, 0u, 0u, 0u}, v1 = v0;
                    if (slot < (int)cnt[e]) { const int tk = LIST[e * 16384 + slot]; const u32x4* src = (const u32x4*)(XN + (size_t)(tk >> 1) * 1024); v0 = src[lane]; v1 = src[lane + 64]; }
                    u32x4* dst = (u32x4*)(XG + (size_t)r * 1024); dst[lane] = v0; dst[lane + 64] = v1;
                }
            PH_END
            PH_BEGIN
                const unsigned* cnt = (const unsigned*)(ws + WS_CTL) + CW_CNT; int ts[9]; ts[0] = 0;
#pragma unroll
                for (int e = 0; e < 8; ++e) ts[e + 1] = ts[e] + (int)((__hip_atomic_load(cnt + e, __ATOMIC_RELAXED, __HIP_MEMORY_SCOPE_AGENT) + 255u) >> 8);
                MoeSched S;
#pragma unroll
                for (int e = 0; e < 9; ++e) S.ts[e] = ts[e];
                S.pm_lo = 0; S.pm_hi = ts[8]; S.npn = 28; S.G = G; S.c = bid; S.a_local = false;
                Gemm g{(const bf16_t*)(ws + WS_XG), (const bf16_t*)(ws + WS_MGU), 0, 0, opq(1024), 1024};
                EpiSwiglu E{(bf16_t*)(ws + WS_HIDM), D_FFE, 28, 0};
                gemm_phase<EpiSwiglu, MoeSched, true, true>(lds, g, S, E);
            PH_END
            PH_BEGIN
                const unsigned* cnt = (const unsigned*)(ws + WS_CTL) + CW_CNT; int ts[9]; ts[0] = 0;
#pragma unroll
                for (int e = 0; e < 8; ++e) ts[e + 1] = ts[e] + (int)((__hip_atomic_load(cnt + e, __ATOMIC_RELAXED, __HIP_MEMORY_SCOPE_AGENT) + 255u) >> 8);
                MoeSched S;
#pragma unroll
                for (int e = 0; e < 9; ++e) S.ts[e] = ts[e];
                S.pm_lo = 0; S.pm_hi = ts[8]; S.npn = 4; S.G = G; S.c = bid; S.a_local = false;
                Gemm g{(const bf16_t*)(ws + WS_HIDM), (const bf16_t*)(ws + WS_MD), 0, 0, opq(D_FFE), D_FFE};
                EpiMoeDown E; E.FS = (bf16_t*)(ws + WS_FACC); E.slot1_off = ((long)WS_MGU - (long)WS_FACC) / 2; E.LIST = (const int*)(ws + WS_LIST); E.WTS = (const float*)(ws + WS_WTS); E.cnt = cnt; E.pm_lo = 0;
#pragma unroll
                for (int e = 0; e < 9; ++e) E.ts[e] = ts[e];
                gemm_phase<EpiMoeDown, MoeSched, true, true>(lds, g, S, E);
            PH_END
            PH_BEGIN
                residual_phase(p, (const bf16_t*)(ws + WS_FACC), (const bf16_t*)(ws + WS_MGU), nullptr, false, 1, 5, p.in[9] + 1024, false, nullptr, 0, 0, false, NLAT, gw, NGW, lane);
            PH_END
        }
    }
#undef PH_BEGIN
#undef PH_END
}

extern "C" void kernel_launch(void* const* d_in, const int* in_sizes, int n_in, void* d_out, int out_size, void* d_ws, size_t ws_size, hipStream_t stream) {
    static int grid = 0;
    if (grid == 0) {
        if (n_in != 37 || out_size != NLAT * DM || ws_size < WS_NEED) { fprintf(stderr, "kernel_launch: unexpected shapes (n_in %d out %d ws %zu need %zu)\n", n_in, out_size, ws_size, (size_t)WS_NEED); grid = -1; return; }
        int dev = 0, cus = 0, per_cu = 0;
        (void)hipGetDevice(&dev);
        (void)hipDeviceGetAttribute(&cus, hipDeviceAttributeMultiprocessorCount, dev);
        (void)hipFuncSetAttribute((const void*)mk_fwd, hipFuncAttributeMaxDynamicSharedMemorySize, LDS_BYTES);
        (void)hipOccupancyMaxActiveBlocksPerMultiprocessor(&per_cu, (const void*)mk_fwd, NTHREADS, LDS_BYTES);
        if (per_cu < 1) { fprintf(stderr, "kernel_launch: occupancy query reports %d blocks per CU\n", per_cu); grid = -1; return; }
        grid = cus;
        fprintf(stderr, "kernel_launch: grid %d (cus %d, per_cu %d), ws %zu\n", grid, cus, per_cu, ws_size);
    }
    if (grid < 0) return;
    (void)hipMemsetAsync((char*)d_ws + WS_CTL, 0, CTL_BYTES, stream);
    Params prm{};
    for (int i = 0; i < 37; ++i) prm.in[i] = (const float*)d_in[i];
    prm.out = (float*)d_out; prm.ws = (unsigned char*)d_ws;
#if MK_MULTI
    for (int ph = 0; ph < N_PHASES; ++ph) { prm.ph_lo = ph; prm.ph_hi = ph + 1; hipLaunchKernelGGL(mk_fwd, dim3(grid), dim3(NTHREADS), LDS_BYTES, stream, prm); }
#else
    prm.ph_lo = 0; prm.ph_hi = 1 << 20;
    void* args[] = {&prm};
    hipError_t e = hipLaunchCooperativeKernel((const void*)mk_fwd, dim3(grid), dim3(NTHREADS), args, LDS_BYTES, stream);
    if (e != hipSuccess) fprintf(stderr, "kernel_launch: cooperative launch failed: %s (grid %d)\n", hipGetErrorString(e), grid);
#endif
}
```

```cpp
#include <hip/hip_runtime.h>
#include <hip/hip_cooperative_groups.h>
#include <cstdio>
#include <cstdint>
namespace cg = cooperative_groups;
namespace pg8 {
#define PG8_LAS __attribute__((address_space(3)))
typedef unsigned short bf16_t;
typedef short bf16x8 __attribute__((ext_vector_type(8)));
typedef float f32x4 __attribute__((ext_vector_type(4)));
typedef unsigned u32x4 __attribute__((ext_vector_type(4)));
constexpr int BM = 256, BK = 64, HALF = 128, HTB = HALF * BK * 2  , STAGE_BYTES = 8 * HTB, NXCD = 8, WGM = 8;

__host__ __device__ __forceinline__ int lds_byte(int r, int c) { const int st = (r >> 4) * 2 + (c >> 5), rr = r & 15, cc = c & 31, ob = rr * 64 + cc * 2; return st * 1024 + (ob ^ (((ob >> 9) & 1) << 5)); }
__host__ __device__ __forceinline__ void stage_rc(int b, int& R, int& C) { const int st = b / 1024, sb = b % 1024, swz = sb ^ (((sb >> 9) & 1) << 5); R = (st >> 1) * 16 + swz / 64; C = (st & 1) * 32 + (swz % 64) / 2; }
__host__ __device__ __forceinline__ int perm32(int rho) { const int n = rho >> 4, i = rho & 15; return 8 * (i >> 2) + 4 * n + (i & 3); }

struct Unit { int pm, pn, koff, tail; };
struct Gemm { const bf16_t* A; const bf16_t* Bt; int M, N, K, ld; };

struct StaticOrder {
    int nM, nN, nwg, G, c;
    __host__ __device__ void init(int M, int N, int G_, int c_) { nM = M / BM; nN = N / BM; nwg = nM * nN; G = G_; c = c_; }
    __host__ __device__ bool next(int i, Unit& u) const {
        const long L = (long)i * G + c; if (L >= nwg) return false;
        int wgid = (int)L; { const int q = nwg / NXCD, r = nwg % NXCD, xcd = wgid % NXCD, off = wgid / NXCD; wgid = (xcd < r ? xcd * (q + 1) : r * (q + 1) + (xcd - r) * q) + off; }
        const int nig = WGM * nN, gid = wgid / nig, fm = gid * WGM, gsz = (nM - fm) < WGM ? (nM - fm) : WGM;
        u.pm = fm + ((wgid % nig) % gsz); u.pn = (wgid % nig) / gsz; u.koff = 0; u.tail = -1; return true;
    }
    __device__ __forceinline__ void a_ready(const Unit&) const {}
    __device__ __forceinline__ void done(const Unit&) const {}
};

__device__ __forceinline__ unsigned cvt_pk_bf16(float lo, float hi) { unsigned r; asm volatile("v_cvt_pk_bf16_f32 %0, %1, %2" : "=v"(r) : "v"(lo), "v"(hi)); return r; }
typedef float f32x2 __attribute__((ext_vector_type(2)));
template <class Epi, class Sched, bool ALIGN_EPI = false, bool SP2 = false>
__device__ __forceinline__ void gemm_phase(PG8_LAS unsigned char* lds, const Gemm g, const Sched& S, const Epi& E) {
    int tid_ = threadIdx.x; asm volatile("" : "+v"(tid_)); const int tid = tid_, wid = __builtin_amdgcn_readfirstlane(tid >> 6), lane = tid & 63, wr = wid >> 2, wc = wid & 3, fr = lane & 15, fq = lane >> 4;
    const int K = g.ld, nt = g.K / BK;
    unsigned voffA[2], voffB[2];
#pragma unroll
    for (int i = 0; i < 2; ++i) { int R, C; stage_rc(tid * 16 + i * 8192, R, C); const int Rb = Epi::PERM ? ((R & ~31) + perm32(R & 31)) : R;
        voffA[i] = (unsigned)(R * K + C) * 2u; voffB[i] = (unsigned)(Rb * K + C) * 2u; }
    const size_t kstep = (size_t)(BK * 2);
    const size_t hstep = (size_t)HALF * K * 2;
    const size_t tstep = 2 * hstep;
    const unsigned ldsw = (unsigned)wid * 1024u;
    const int aoff = lds_byte(wr * 64 + fr, fq * 8), boff = lds_byte(wc * 32 + fr, fq * 8);
#define PG8_SA(b, h) (((b) * 2 + (h)) * HTB)
#define PG8_SB(b, h) ((4 + (b) * 2 + (h)) * HTB)
#define PG8_STAGE(bufoff, gbase, voff) do { _Pragma("unroll") for (int _i = 0; _i < 2; ++_i) \
        __builtin_amdgcn_global_load_lds((const unsigned*)((const char*)(gbase) + (voff)[_i]), (PG8_LAS unsigned*)(lds + (bufoff) + ldsw + _i * 8192), 16, 0, 0); } while (0)
#define PG8_LDA(dst, b, h) do { _Pragma("unroll") for (int m = 0; m < 4; ++m) _Pragma("unroll") for (int k = 0; k < 2; ++k) dst[m][k] = *(const PG8_LAS bf16x8*)(lds + PG8_SA(b, h) + aoff + m * 2048 + k * 1024); } while (0)
#define PG8_LDB(dst, b, h) do { _Pragma("unroll") for (int n = 0; n < 2; ++n) _Pragma("unroll") for (int k = 0; k < 2; ++k) dst[n][k] = *(const PG8_LAS bf16x8*)(lds + PG8_SB(b, h) + boff + n * 2048 + k * 1024); } while (0)
#define PG8_MMA(ai, bj, At, Bt) do { __builtin_amdgcn_s_setprio(1); _Pragma("unroll") for (int m = 0; m < 4; ++m) _Pragma("unroll") for (int n = 0; n < 2; ++n) _Pragma("unroll") for (int k = 0; k < 2; ++k) \
        acc[ai][bj][m][n] = __builtin_amdgcn_mfma_f32_16x16x32_bf16(Bt[n][k], At[m][k], acc[ai][bj][m][n], 0, 0, 0); __builtin_amdgcn_s_setprio(0); } while (0)
#define PG8_WAIT_V(n) asm volatile("s_waitcnt vmcnt(" #n ")" ::: "memory")
#define PG8_WAIT_L(n) asm volatile("s_waitcnt lgkmcnt(" #n ")" ::: "memory")
#define PG8_BAR __builtin_amdgcn_s_barrier()
#define PG8_SCHED __builtin_amdgcn_sched_barrier(0)
    Unit cur, nxt; int ui = 0;
    if (!S.next(0, cur)) return;
    f32x4 acc[2][2][4][2];
#pragma unroll
    for (int a = 0; a < 2; ++a)
#pragma unroll
        for (int b = 0; b < 2; ++b)
#pragma unroll
            for (int m = 0; m < 4; ++m)
#pragma unroll
                for (int n = 0; n < 2; ++n) acc[a][b][m][n] = (f32x4){0.f, 0.f, 0.f, 0.f};
    bf16x8 At[4][2], B0[2][2], B1[2][2];
    const char* cA = (const char*)g.A + (size_t)cur.pm * tstep + (size_t)cur.koff * 2; const char* cB = (const char*)g.Bt + (size_t)cur.pn * tstep + (size_t)cur.koff * 2;
    S.a_ready(cur);
    if constexpr (SP2) {
        PG8_STAGE(PG8_SB(0, 0), cB, voffB); PG8_STAGE(PG8_SB(0, 1), cB + hstep, voffB); PG8_STAGE(PG8_SA(0, 0), cA, voffA); PG8_STAGE(PG8_SA(0, 1), cA + hstep, voffA);
        if (wr == 1) PG8_BAR;
        PG8_WAIT_V(2); PG8_BAR;
        PG8_STAGE(PG8_SB(1, 0), cB + kstep, voffB); PG8_STAGE(PG8_SA(1, 0), cA + kstep, voffA); PG8_STAGE(PG8_SB(1, 1), cB + hstep + kstep, voffB);
        PG8_WAIT_V(6); PG8_BAR;
    } else {
        PG8_STAGE(PG8_SB(0, 0), cB, voffB); PG8_STAGE(PG8_SA(0, 0), cA, voffA); PG8_STAGE(PG8_SB(0, 1), cB + hstep, voffB); PG8_STAGE(PG8_SA(0, 1), cA + hstep, voffA);
        if (wr == 1) PG8_BAR;
        PG8_WAIT_V(4); PG8_BAR;
        PG8_STAGE(PG8_SB(1, 0), cB + kstep, voffB); PG8_STAGE(PG8_SA(1, 0), cA + kstep, voffA); PG8_STAGE(PG8_SB(1, 1), cB + hstep + kstep, voffB);
        PG8_WAIT_V(6); PG8_BAR;
    }
    for (;;) {
        const bool has_next = S.next(ui + 1, nxt);
        const char* nA = has_next ? (const char*)g.A + (size_t)nxt.pm * tstep + (size_t)nxt.koff * 2 : cA; const char* nB = has_next ? (const char*)g.Bt + (size_t)nxt.pn * tstep + (size_t)nxt.koff * 2 : cB;
        for (int t = 0; t < nt; t += 2) {
            const bool last = (t == nt - 2);
            const char* a1 = cA + (size_t)(t + 1) * kstep;
            const char* a2 = last ? nA : cA + (size_t)(t + 2) * kstep; const char* b2 = last ? nB : cB + (size_t)(t + 2) * kstep;
            const char* a3 = a2 + kstep; const char* b3 = b2 + kstep;
            if (last && has_next) S.a_ready(nxt);
            if constexpr (SP2) {
            PG8_LDB(B0, 0, 0); PG8_LDB(B1, 0, 1); PG8_SCHED; PG8_LDA(At, 0, 0); PG8_STAGE(PG8_SA(1, 1), a1 + hstep, voffA);
            PG8_WAIT_V(8); PG8_WAIT_L(0); PG8_BAR; PG8_MMA(0, 0, At, B0); PG8_MMA(0, 1, At, B1); PG8_BAR; PG8_SCHED;
            PG8_LDA(At, 0, 1); PG8_STAGE(PG8_SB(0, 0), b2, voffB); PG8_STAGE(PG8_SB(0, 1), b2 + hstep, voffB); PG8_STAGE(PG8_SA(0, 0), a2, voffA);
            PG8_WAIT_V(8); PG8_WAIT_L(0); PG8_BAR; PG8_MMA(1, 0, At, B0); PG8_MMA(1, 1, At, B1); PG8_BAR; PG8_SCHED;
            PG8_LDB(B0, 1, 0); PG8_LDB(B1, 1, 1); PG8_SCHED; PG8_LDA(At, 1, 0); PG8_STAGE(PG8_SA(0, 1), a2 + hstep, voffA);
            PG8_WAIT_V(8); PG8_WAIT_L(0); PG8_BAR; PG8_MMA(0, 0, At, B0); PG8_MMA(0, 1, At, B1); PG8_BAR; PG8_SCHED;
            PG8_LDA(At, 1, 1); PG8_STAGE(PG8_SB(1, 0), b3, voffB); PG8_STAGE(PG8_SB(1, 1), b3 + hstep, voffB); PG8_STAGE(PG8_SA(1, 0), a3, voffA);
            PG8_WAIT_V(8); PG8_WAIT_L(0); PG8_BAR; PG8_MMA(1, 0, At, B0); PG8_MMA(1, 1, At, B1); PG8_BAR; PG8_SCHED;
            } else {
            PG8_LDB(B0, 0, 0); PG8_SCHED; PG8_LDA(At, 0, 0); PG8_STAGE(PG8_SA(1, 1), a1 + hstep, voffA);
            PG8_WAIT_L(8); PG8_BAR; PG8_WAIT_L(0); PG8_MMA(0, 0, At, B0); PG8_BAR; PG8_SCHED;
            PG8_LDB(B1, 0, 1); PG8_STAGE(PG8_SB(0, 0), b2, voffB);
            PG8_BAR; PG8_WAIT_L(0); PG8_MMA(0, 1, At, B1); PG8_BAR;
            PG8_LDA(At, 0, 1); PG8_STAGE(PG8_SA(0, 0), a2, voffA);
            PG8_BAR; PG8_WAIT_L(0); PG8_MMA(1, 0, At, B0); PG8_BAR; PG8_SCHED;
            PG8_STAGE(PG8_SB(0, 1), b2 + hstep, voffB);
            PG8_WAIT_V(6); PG8_BAR; PG8_MMA(1, 1, At, B1); PG8_BAR;
            PG8_LDB(B0, 1, 0); PG8_SCHED; PG8_LDA(At, 1, 0); PG8_STAGE(PG8_SA(0, 1), a2 + hstep, voffA);
            PG8_WAIT_L(8); PG8_BAR; PG8_WAIT_L(0); PG8_MMA(0, 0, At, B0); PG8_BAR; PG8_SCHED;
            PG8_LDB(B1, 1, 1); PG8_STAGE(PG8_SB(1, 0), b3, voffB);
            PG8_BAR; PG8_WAIT_L(0); PG8_MMA(0, 1, At, B1); PG8_BAR;
            PG8_LDA(At, 1, 1); PG8_STAGE(PG8_SA(1, 0), a3, voffA);
            PG8_BAR; PG8_WAIT_L(0); PG8_MMA(1, 0, At, B0); PG8_BAR; PG8_SCHED;
            PG8_STAGE(PG8_SB(1, 1), b3 + hstep, voffB);
            PG8_WAIT_V(6); PG8_BAR; PG8_MMA(1, 1, At, B1); PG8_BAR;
            }
        }
        if constexpr (ALIGN_EPI) { if (wr == 0) PG8_BAR; }
        if constexpr (!Epi::AFTER_DRAIN) { E(acc, cur, wr, wc, fr, fq); S.done(cur); }
        if (!has_next) break;
#pragma unroll
        for (int a = 0; a < 2; ++a)
#pragma unroll
            for (int b = 0; b < 2; ++b)
#pragma unroll
                for (int m = 0; m < 4; ++m)
#pragma unroll
                    for (int n = 0; n < 2; ++n) acc[a][b][m][n] = (f32x4){0.f, 0.f, 0.f, 0.f};
        cur = nxt; cA = nA; cB = nB; ++ui;
        if constexpr (ALIGN_EPI) { if (wr == 1) PG8_BAR; }
    }
    PG8_WAIT_V(0);
    if constexpr (!ALIGN_EPI) { if (wr == 0) PG8_BAR; }
    PG8_BAR;
    if constexpr (Epi::AFTER_DRAIN) { E.fused(acc, cur, wr, wc, fr, fq, lds, wid, lane); S.done(cur); }
#undef PG8_SA
#undef PG8_SB
#undef PG8_STAGE
#undef PG8_LDA
#undef PG8_LDB
#undef PG8_MMA
#undef PG8_WAIT_V
#undef PG8_WAIT_L
#undef PG8_BAR
#undef PG8_SCHED
}
}

#define LAS __attribute__((address_space(3)))
typedef unsigned short bf16_t;
typedef short bf16x8 __attribute__((ext_vector_type(8)));
typedef float f32x4 __attribute__((ext_vector_type(4)));
typedef float f32x16 __attribute__((ext_vector_type(16)));
typedef unsigned u32x4 __attribute__((ext_vector_type(4)));
typedef unsigned u32x2 __attribute__((ext_vector_type(2)));

constexpr int NTHREADS = 512, NWAVES = 8;
constexpr int DM = 1024, SEQ = 8192, CTXL = 256, NLAT = 2 * SEQ, NCTX = 2 * CTXL, NTOK = NLAT + NCTX, KEYS = SEQ + CTXL;
constexpr int D_IN = 7296, D_FF = 2816, D_FFE = 3584, NEXP = 8;
constexpr int IC_QS = 0, IC_KS = 512, IC_RW = 640, IC_QD = 2560, IC_KD = 3072, PP = 3584, IC_VS = 3584, IC_VD = 3712, IC_PAD = 4224, NIN1 = 4352, WIN_ROWS = 7424;
constexpr int ST_SLOTS = 9;
constexpr int MOE_TILES = 136, MOE_HALF = 68;

constexpr size_t MiB = 1u << 20;
constexpr size_t WS_CTL = 0, CTL_BYTES = 1 * MiB;
constexpr size_t WS_MODS = 1 * MiB;
constexpr size_t WS_ROPE = 1 * MiB + 256 * 1024;
constexpr size_t WS_HCTX = 2 * MiB;
constexpr size_t WS_LIST = 4 * MiB;
constexpr size_t WS_WTS = 4 * MiB + 512 * 1024;
constexpr size_t WS_WIN = 6 * MiB;
constexpr size_t WS_PRJ = WS_WIN + (size_t)WIN_ROWS * 1024 * 2;
constexpr size_t WS_WOUT = WS_PRJ + 3 * MiB;
constexpr size_t WS_LORA = WS_WOUT + 2 * MiB;
constexpr size_t WS_XN = 28 * MiB;
constexpr size_t WS_P = 61 * MiB;
constexpr size_t WS_VTS = 177 * MiB;
constexpr size_t WS_VTD = WS_VTS + 4608 * 1024;
constexpr size_t WS_ST = 198 * MiB;
constexpr size_t WS_YA = 495 * MiB;
constexpr size_t WS_YB = WS_YA + 16896ull * 512 * 2;
constexpr size_t WS_YC = WS_YB + 16896ull * 512 * 2;
constexpr size_t WS_END = WS_YC + 16896ull * 512 * 2;
constexpr size_t WS_G = WS_ST;
constexpr size_t WS_MF = WS_ST + 99 * MiB;
constexpr size_t WS_MB = WS_ST + 165 * MiB;
constexpr size_t WS_MOUT = WS_ST + 198 * MiB;
constexpr size_t WS_FGU = WS_VTS;
constexpr size_t WS_FD = WS_VTS + 11 * MiB;
constexpr size_t WS_HID = WS_P;
constexpr size_t WS_XN2 = 495 * MiB;
constexpr size_t WS_MGU = 6 * MiB;
constexpr size_t WS_MD = 118 * MiB;
constexpr size_t WS_XG = 174 * MiB;
constexpr size_t WS_FACC = 242 * MiB;
constexpr size_t WS_HIDM = 306 * MiB;
static_assert(WS_LORA + 2560 * 384 * 2 <= WS_XN && WS_XN + 16896ull * 1024 * 2 <= WS_P && WS_P + 16896ull * PP * 2 <= WS_VTS && WS_VTD + 2ull * 4 * 128 * KEYS * 2 <= WS_ST, "ws map 1");
static_assert(WS_ST + 16896ull * 8 * ST_SLOTS * 64 * 4 <= WS_YA && WS_END <= 545 * MiB, "ws map 2");
static_assert(WS_G + 16896ull * 3072 * 2 <= WS_MF && WS_MF + 16896ull * 1024 * 4 <= WS_MB && WS_MB + 16896ull * 1024 * 2 <= WS_MOUT && WS_MOUT + 16896ull * 1024 * 4 <= WS_YA, "ws map 3");
static_assert(WS_FGU + 5632ull * 1024 * 2 <= WS_FD && WS_FD + 1024ull * 2816 * 2 <= WS_ST && WS_HID + 16896ull * 2816 * 2 <= WS_VTS, "ws map 4");
static_assert(WS_MGU + 8ull * 7168 * 1024 * 2 <= WS_MD && WS_MD + 8ull * 1024 * 3584 * 2 <= WS_XG && WS_XG + 34816ull * 1024 * 2 <= WS_FACC && WS_FACC + 16384ull * 1024 * 4 <= WS_HIDM && WS_HIDM + 136ull * 256 * 3584 * 2 <= 560 * MiB, "ws map 5");
static_assert(WS_FACC + 16384ull * 1024 * 4 <= WS_MOUT && WS_XN2 + 16384ull * 1024 * 2 <= 560 * MiB && WS_XN2 >= WS_MOUT + 16896ull * 1024 * 4, "expert weights / gathered rows / accumulator must not touch MOUT or XN2 while they are live");
constexpr size_t WS_NEED = 560 * MiB;
constexpr int CW_CNT = 0;
constexpr int CW_Q0 = 64, CW_Q1 = 128;

constexpr int LDS_BYTES = 147456;

__device__ __forceinline__ unsigned f2bf(float f) { unsigned u = __builtin_bit_cast(unsigned, f); return (u + 0x7fffu + ((u >> 16) & 1u)) >> 16; }
typedef float f32x2_t __attribute__((ext_vector_type(2))); typedef __bf16 bf16x2_t __attribute__((ext_vector_type(2)));
__device__ __forceinline__ unsigned pk2(float lo, float hi) { const f32x2_t v = {lo, hi}; return __builtin_bit_cast(unsigned, __builtin_convertvector(v, bf16x2_t)); }
__device__ __forceinline__ float bflo(unsigned w) { return __uint_as_float(w << 16); }
__device__ __forceinline__ float bfhi(unsigned w) { return __uint_as_float(w & 0xffff0000u); }
__device__ __forceinline__ float wave_sum(float v) {
#pragma unroll
    for (int o = 1; o < 64; o <<= 1) v += __shfl_xor(v, o);
    return v;
}
__device__ __forceinline__ float sigmoidf_(float x) { return 1.0f / (1.0f + __expf(-x)); }
__device__ __forceinline__ float siluf_(float x) { return x / (1.0f + __expf(-x)); }
#define LDS_WAIT() asm volatile("s_waitcnt lgkmcnt(0)" ::: "memory")

struct Params {
    const float* in[37];
    float* out;
    unsigned char* ws;
    int ph_lo, ph_hi;
};

template <class F>
__device__ __forceinline__ void transpose_item(const float* __restrict__ W, int ldw, int k0, int n0, bf16_t* __restrict__ WT, int ldt, int dcol0, F rowmap, LAS float* scr, int lane) {
#pragma unroll 8
    for (int i = 0; i < 32; ++i) { const int kk = 2 * i + (lane >> 5); scr[kk * 33 + (lane & 31)] = W[(size_t)(k0 + kk) * ldw + n0 + (lane & 31)]; }
    LDS_WAIT(); asm volatile("" ::: "memory");
    const int c = lane & 7;
#pragma unroll
    for (int j = 0; j < 4; ++j) {
        const int n = (lane >> 3) + 8 * j; const LAS float* s = scr + (8 * c) * 33 + n;
        u32x4 o; o.x = pk2(s[0 * 33], s[1 * 33]); o.y = pk2(s[2 * 33], s[3 * 33]); o.z = pk2(s[4 * 33], s[5 * 33]); o.w = pk2(s[6 * 33], s[7 * 33]);
        const int row = rowmap(n0 + n);
        if (row >= 0) *(u32x4*)(WT + (size_t)row * ldt + dcol0 + k0 + 8 * c) = o;
    }
    LDS_WAIT(); asm volatile("" ::: "memory");
}
struct RowId { __device__ __forceinline__ int operator()(int n) const { return n; } };
struct RowOff { int off; __device__ __forceinline__ int operator()(int n) const { return n + off; } };
struct RowWin {
    __device__ __forceinline__ int operator()(int n) const {
        if (n < 640) return n;
        if (n < 768) return n - 640 + IC_VS;
        if (n < 2688) return n - 768 + IC_RW;
        if (n < 3712) return n - 2688 + IC_QD;
        if (n < 4224) return n - 3712 + IC_VD;
        return n - 4224 + NIN1;
    }
};
struct RowGU { int up; __device__ __forceinline__ int operator()(int j) const { return (j >> 7) * 256 + (j & 127) + 128 * up; } };

template <class F>
__device__ __forceinline__ void convert_matrix(const float* W, int K, int N, bf16_t* WT, int ldt, int dcol0, F rowmap, LAS float* scr, int lane, int gw, int NGW) {
    const int nblk = N / 32, items = (K / 64) * nblk;
    for (int it = gw; it < items; it += NGW) { const int kb = it / nblk, nb = it % nblk; transpose_item(W, N, kb * 64, nb * 32, WT, ldt, dcol0, rowmap, scr, lane); }
}

__device__ __forceinline__ void lora_region(bf16_t* __restrict__ LT, const float* __restrict__ src, int row0, int klo, int kn, int gw, int NGW, int lane) {
    for (int i = gw * 64 + lane; i < 512 * 48; i += NGW * 64) {
        const int nn = i / 48, kc = (i % 48) * 8;
        u32x4 o = (u32x4){0u, 0u, 0u, 0u};
        if (kc >= klo && kc < klo + kn) {
            const float* s = src + (size_t)(kc - klo) * 512 + nn;
            o.x = pk2(s[0], s[512]); o.y = pk2(s[2 * 512], s[3 * 512]); o.z = pk2(s[4 * 512], s[5 * 512]); o.w = pk2(s[6 * 512], s[7 * 512]);
        }
        *(u32x4*)(LT + (size_t)(row0 + nn) * 384 + kc) = o;
    }
}
__device__ __forceinline__ void convert_layer_weights(const Params& p, int layer, LAS unsigned char* lds, int gw, int NGW, int wave, int lane) {
    LAS float* scr = (LAS float*)(lds + wave * 16384);
    unsigned char* ws = p.ws;
    bf16_t* WIN = (bf16_t*)(ws + WS_WIN);
    convert_matrix(p.in[10] + (size_t)layer * 1024 * D_IN, 1024, D_IN, WIN, 1024, 0, RowWin(), scr, lane, gw, NGW);
    for (int i = gw * 64 + lane; i < (NIN1 - IC_PAD) * 1024 / 8; i += NGW * 64) *(u32x4*)(WIN + (size_t)IC_PAD * 1024 + (size_t)i * 8) = (u32x4){0u, 0u, 0u, 0u};
    for (int j = 0; j < 3; ++j)
        convert_matrix(p.in[26 + j] + (size_t)layer * 512 * 1024, 512, 1024, (bf16_t*)(ws + WS_PRJ) + (size_t)j * 1024 * 512, 512, 0, RowId(), scr, lane, gw, NGW);
    convert_matrix(p.in[29] + (size_t)layer * 1024 * 1024, 1024, 1024, (bf16_t*)(ws + WS_WOUT), 1024, 0, RowId(), scr, lane, gw, NGW);
    bf16_t* LT = (bf16_t*)(ws + WS_LORA);
    lora_region(LT, p.in[15] + ((size_t)layer * 2 + 0) * 64 * 512, 0, 0, 64, gw, NGW, lane);
    lora_region(LT, p.in[15] + ((size_t)layer * 2 + 1) * 64 * 512, 512, 64, 64, gw, NGW, lane);
    lora_region(LT, p.in[17] + ((size_t)layer * 2 + 0) * 64 * 512, 1024, 128, 64, gw, NGW, lane);
    lora_region(LT, p.in[17] + ((size_t)layer * 2 + 1) * 64 * 512, 1536, 192, 64, gw, NGW, lane);
    lora_region(LT, p.in[18] + (size_t)layer * 128 * 512, 2048, 256, 128, gw, NGW, lane);
}
__device__ __forceinline__ void convert_ffn_weights(const Params& p, LAS unsigned char* lds, int gw, int NGW, int wave, int lane) {
    LAS float* scr = (LAS float*)(lds + wave * 16384);
    bf16_t* GU = (bf16_t*)(p.ws + WS_FGU); bf16_t* FD = (bf16_t*)(p.ws + WS_FD);
    convert_matrix(p.in[30], 1024, D_FF, GU, 1024, 0, RowGU{0}, scr, lane, gw, NGW);
    convert_matrix(p.in[31], 1024, D_FF, GU, 1024, 0, RowGU{1}, scr, lane, gw, NGW);
    convert_matrix(p.in[32], D_FF, 1024, FD, D_FF, 0, RowId(), scr, lane, gw, NGW);
}
__device__ __forceinline__ void convert_moe_weights(const Params& p, LAS unsigned char* lds, int gw, int NGW, int wave, int lane) {
    LAS float* scr = (LAS float*)(lds + wave * 16384);
    for (int e = 0; e < NEXP; ++e) {
        bf16_t* GU = (bf16_t*)(p.ws + WS_MGU) + (size_t)e * 7168 * 1024;
        convert_matrix(p.in[34] + (size_t)e * 1024 * D_FFE, 1024, D_FFE, GU, 1024, 0, RowGU{0}, scr, lane, gw, NGW);
        convert_matrix(p.in[35] + (size_t)e * 1024 * D_FFE, 1024, D_FFE, GU, 1024, 0, RowGU{1}, scr, lane, gw, NGW);
        convert_matrix(p.in[36] + (size_t)e * D_FFE * 1024, D_FFE, 1024, (bf16_t*)(p.ws + WS_MD) + (size_t)e * 1024 * D_FFE, D_FFE, 0, RowId(), scr, lane, gw, NGW);
    }
}

__device__ __forceinline__ void adaln_phase(const Params& p, LAS unsigned char* lds, int wave, int lane) {
    LAS float* red = (LAS float*)lds;
    float* MODS = (float*)(p.ws + WS_MODS);
    const float* c = p.in[1]; const float* cc = p.in[3];
    for (int it = blockIdx.x; it < 2 * 96; it += gridDim.x) {
        const int layer = it / 96, n = (it % 96) * 64 + lane;
        const float* W = p.in[4] + (size_t)layer * 1024 * 6144;
        float a0 = 0.f, a1 = 0.f, a2 = 0.f;
        for (int k = wave * 128; k < wave * 128 + 128; ++k) {
            const float w = W[(size_t)k * 6144 + n];
            a0 += siluf_(c[k]) * w; a1 += siluf_(c[1024 + k]) * w; a2 += siluf_(cc[k]) * w;
        }
        red[(wave * 3 + 0) * 64 + lane] = a0; red[(wave * 3 + 1) * 64 + lane] = a1; red[(wave * 3 + 2) * 64 + lane] = a2;
        __syncthreads();
        if (wave < 3) {
            float s = 0.f;
#pragma unroll
            for (int w = 0; w < 8; ++w) s += red[(w * 3 + wave) * 64 + lane];
            MODS[((size_t)layer * 3 + wave) * 6144 + n] = s + p.in[5][(size_t)layer * 6144 + n];
        }
        __syncthreads();
    }
    if (blockIdx.x == gridDim.x - 1) {
        float* rope = (float*)(p.ws + WS_ROPE);
        for (int i = threadIdx.x; i < 128 * 16; i += NTHREADS) {
            const int pos = i >> 4, j = i & 15;
            const float inv = powf(10000.0f, -(float)j / 16.0f);
            const float ang = (float)pos * inv;
            rope[2 * i] = cosf(ang); rope[2 * i + 1] = sinf(ang);
        }
    }
}

__device__ __forceinline__ const float* mods_row(const Params& p, int layer, int m) {
    const int r = m < NLAT ? (m >> 13) : 2;
    return (const float*)(p.ws + WS_MODS) + ((size_t)layer * 3 + r) * 6144;
}
__device__ __forceinline__ void load_row(const float* x, int lane, f32x4 (&v)[4]) {
#pragma unroll
    for (int j = 0; j < 4; ++j) v[j] = ((const f32x4*)x)[lane + 64 * j];
}
__device__ __forceinline__ float row_rstd(const f32x4 (&v)[4]) {
    float s = 0.f;
#pragma unroll
    for (int j = 0; j < 4; ++j) s += (v[j].x * v[j].x + v[j].y * v[j].y) + (v[j].z * v[j].z + v[j].w * v[j].w);
    return 1.0f / sqrtf(wave_sum(s) * (1.0f / 1024.0f) + 1e-6f);
}
__device__ __forceinline__ void normmod(const f32x4 (&h)[4], const float* g, const float* shift, const float* scale, int lane, f32x4 (&a)[4]) {
    const float rstd = row_rstd(h);
#pragma unroll
    for (int j = 0; j < 4; ++j) {
        const f32x4 gg = ((const f32x4*)g)[lane + 64 * j], sh = ((const f32x4*)shift)[lane + 64 * j], sc = ((const f32x4*)scale)[lane + 64 * j];
        a[j] = (h[j] * rstd * gg) * (sc + 1.0f) + sh;
    }
}
__device__ __forceinline__ void store_row_bf16(bf16_t* o, int lane, const f32x4 (&a)[4]) {
#pragma unroll
    for (int j = 0; j < 4; ++j) { u32x2 w; w.x = pk2(a[j].x, a[j].y); w.y = pk2(a[j].z, a[j].w); ((u32x2*)o)[lane + 64 * j] = w; }
}
__device__ __forceinline__ const float* h_in_row(const Params& p, int layer, int m) {
    if (layer == 0) return m < NLAT ? p.in[0] + (size_t)m * 1024 : p.in[2] + (size_t)(m - NLAT) * 1024;
    return m < NLAT ? p.out + (size_t)m * 1024 : (const float*)(p.ws + WS_HCTX) + (size_t)(m - NLAT) * 1024;
}
__device__ __forceinline__ float* h_out_row(const Params& p, int m) { return m < NLAT ? p.out + (size_t)m * 1024 : (float*)(p.ws + WS_HCTX) + (size_t)(m - NLAT) * 1024; }

__device__ __forceinline__ void premix_phase(const Params& p, int layer, bool first, int M, int gw, int NGW, int lane) {
    bf16_t* XN = (bf16_t*)(p.ws + WS_XN);
    for (int m = gw; m < M; m += NGW) {
        const float* hr = first ? h_in_row(p, 0, m) : h_out_row(p, m);
        f32x4 h[4], a[4]; load_row(hr, lane, h);
        const float* md = mods_row(p, layer, m);
        normmod(h, p.in[6] + layer * 1024, md, md + 1024, lane, a);
        store_row_bf16(XN + (size_t)m * 1024, lane, a);
    }
}
__device__ __forceinline__ void load_row_bf16(const bf16_t* x, int lane, f32x4 (&v)[4]) {
#pragma unroll
    for (int j = 0; j < 4; ++j) { const u32x2 w = ((const u32x2*)x)[lane + 64 * j]; v[j] = (f32x4){bflo(w.x), bfhi(w.x), bflo(w.y), bfhi(w.y)}; }
}
__device__ __forceinline__ void residual_phase(const Params& p, const bf16_t* src, const bf16_t* src2, const float* hin_base_layer0, bool hin_is_input, int layer, int gate_idx, const float* g1,
                                               bool write_xn, const float* g2, int mod_layer2, int shift_idx, bool route, int M, int gw, int NGW, int lane) {
    bf16_t* XN = (bf16_t*)(p.ws + (route ? WS_XN2 : WS_XN));
    for (int m = gw; m < M; m += NGW) {
        const float* hr = hin_is_input ? h_in_row(p, 0, m) : h_out_row(p, m);
        f32x4 h[4], s[4]; load_row(hr, lane, h); load_row_bf16(src + (size_t)m * 1024, lane, s);
        if (src2) { f32x4 s2[4]; load_row_bf16(src2 + (size_t)m * 1024, lane, s2);
#pragma unroll
            for (int j = 0; j < 4; ++j) s[j] += s2[j]; }
        const float rstd = row_rstd(s);
        const float* md = mods_row(p, layer, m);
#pragma unroll
        for (int j = 0; j < 4; ++j) {
            const f32x4 gg = ((const f32x4*)g1)[lane + 64 * j], gt = ((const f32x4*)(md + gate_idx * 1024))[lane + 64 * j];
            h[j] = h[j] + gt * (s[j] * rstd * gg);
        }
        float* ho = h_out_row(p, m);
#pragma unroll
        for (int j = 0; j < 4; ++j) ((f32x4*)ho)[lane + 64 * j] = h[j];
        if (write_xn) {
            f32x4 a[4]; const float* md2 = mods_row(p, mod_layer2, m);
            normmod(h, g2, md2 + shift_idx * 1024, md2 + (shift_idx + 1) * 1024, lane, a);
            store_row_bf16(XN + (size_t)m * 1024, lane, a);
            if (route) {
                const float* rw = p.in[33];
                float lg[8] = {0.f, 0.f, 0.f, 0.f, 0.f, 0.f, 0.f, 0.f};
#pragma unroll
                for (int j = 0; j < 4; ++j)
#pragma unroll
                    for (int q = 0; q < 4; ++q) {
                        const int k = 4 * (lane + 64 * j) + q; const float av = a[j][q];
                        const f32x4 w0 = ((const f32x4*)(rw + (size_t)k * 8))[0], w1 = ((const f32x4*)(rw + (size_t)k * 8))[1];
                        lg[0] += av * w0.x; lg[1] += av * w0.y; lg[2] += av * w0.z; lg[3] += av * w0.w; lg[4] += av * w1.x; lg[5] += av * w1.y; lg[6] += av * w1.z; lg[7] += av * w1.w;
                    }
#pragma unroll
                for (int e = 0; e < 8; ++e) lg[e] = wave_sum(lg[e]);
                int i1 = 0; float v1 = lg[0];
#pragma unroll
                for (int e = 1; e < 8; ++e) if (lg[e] > v1) { v1 = lg[e]; i1 = e; }
                int i2 = -1; float v2 = -3.0e38f;
#pragma unroll
                for (int e = 0; e < 8; ++e) if (e != i1 && lg[e] > v2) { v2 = lg[e]; i2 = e; }
                if (lane == 0) {
                    const float w1 = 1.0f / (1.0f + expf(v2 - v1)), w2 = 1.0f - w1;
                    unsigned* cnt = (unsigned*)(p.ws + WS_CTL) + CW_CNT; int* LIST = (int*)(p.ws + WS_LIST); float* WTS = (float*)(p.ws + WS_WTS);
                    const unsigned s1 = atomicAdd(cnt + i1, 1u); LIST[i1 * 16384 + s1] = m * 2; WTS[i1 * 16384 + s1] = w1;
                    const unsigned s2 = atomicAdd(cnt + i2, 1u); LIST[i2 * 16384 + s2] = m * 2 + 1; WTS[i2 * 16384 + s2] = w2;
                }
            }
        }
    }
}

using pg8::Unit;
constexpr float QSCALE = 0.125f * 1.4426950408889634f;
__device__ __forceinline__ u32x2 pack4(const f32x4 v) { u32x2 w; w.x = pk2(v.x, v.y); w.y = pk2(v.z, v.w); return w; }
__device__ __forceinline__ f32x4 unpack4(const u32x2 w) { return (f32x4){bflo(w.x), bfhi(w.x), bflo(w.y), bfhi(w.y)}; }

struct EpiIn {
    static constexpr bool PERM = false, AFTER_DRAIN = false;
    bf16_t* P; bf16_t* VTS; bf16_t* VTD; const float* rope;
    __device__ __forceinline__ void operator()(const f32x4 (&acc)[2][2][4][2], const Unit& u, int wr, int wc, int fr, int fq) const {
#pragma unroll
        for (int ai = 0; ai < 2; ++ai)
#pragma unroll
            for (int m = 0; m < 4; ++m) {
                const int r = u.pm * 256 + ai * 128 + wr * 64 + m * 16 + fr;
                const bool lat = r < NLAT;
                const int t = r & (SEQ - 1);
                const int b = lat ? (r >> 13) : ((r - NLAT) >> 8);
                const int key = lat ? t : SEQ + ((r - NLAT) & 255);
#pragma unroll
                for (int bj = 0; bj < 2; ++bj) {
                    const int c32 = u.pn * 256 + bj * 128 + wc * 32;
                    f32x4 v0 = acc[ai][bj][m][0], v1 = acc[ai][bj][m][1];
                    if (c32 < PP) {
                        const bool rp = (c32 < IC_RW) || (c32 >= IC_QD);
                        if (rp && lat) {
                            const int pos = (c32 & 32) ? (t & 63) : (t >> 6);
                            const f32x4 cs0 = *(const f32x4*)(rope + (pos * 16 + 4 * fq) * 2), cs1 = *(const f32x4*)(rope + (pos * 16 + 4 * fq) * 2 + 4);
                            const f32x4 cc = (f32x4){cs0.x, cs0.z, cs1.x, cs1.z}, sn = (f32x4){cs0.y, cs0.w, cs1.y, cs1.w};
                            const f32x4 o0 = v0 * cc - v1 * sn, o1 = v0 * sn + v1 * cc;
                            v0 = o0; v1 = o1;
                        }
                        if (c32 < IC_KS || (c32 >= IC_QD && c32 < IC_KD)) { v0 = v0 * QSCALE; v1 = v1 * QSCALE; }
                        bf16_t* dst = P + (size_t)r * PP + c32 + 4 * fq;
                        *(u32x2*)dst = pack4(v0); *(u32x2*)(dst + 16) = pack4(v1);
                    } else {
                        const int cv = c32 - PP;
                        bf16_t* vt = nullptr; int dimbase = 0;
                        if (cv < 128) { vt = VTS + (size_t)((b * 2 + (cv >> 6)) * 64) * KEYS; dimbase = cv & 63; }
                        else if (cv < 640) { const int cd = cv - 128; vt = VTD + (size_t)((b * 4 + (cd >> 7)) * 128) * KEYS; dimbase = cd & 127; }
                        if (vt) {
#pragma unroll
                            for (int i = 0; i < 4; ++i) {
                                vt[(size_t)(dimbase + 4 * fq + i) * KEYS + key] = (bf16_t)f2bf(v0[i]);
                                vt[(size_t)(dimbase + 16 + 4 * fq + i) * KEYS + key] = (bf16_t)f2bf(v1[i]);
                            }
                        }
                    }
                }
            }
    }
};

struct EpiLora {
    static constexpr bool PERM = false, AFTER_DRAIN = false;
    float* ST; bf16_t* P; const float* w0; const float* a0; const float* k_a;
    __device__ __forceinline__ void operator()(const f32x4 (&acc)[2][2][4][2], const Unit& u, int wr, int wc, int fr, int fq) const {
        const int reg = u.pn >> 1;
#pragma unroll
        for (int ai = 0; ai < 2; ++ai)
#pragma unroll
            for (int m = 0; m < 4; ++m) {
                const int r = u.pm * 256 + ai * 128 + wr * 64 + m * 16 + fr;
#pragma unroll
                for (int bj = 0; bj < 2; ++bj)
#pragma unroll
                    for (int n = 0; n < 2; ++n) {
                        const int ch = (u.pn & 1) * 256 + bj * 128 + wc * 32 + 16 * n + 4 * fq;
                        const int h = ch >> 6, kidx = ch & 63;
                        float* sp = ST + ((size_t)r * 8 + h) * (ST_SLOTS * 64) + kidx;
                        const f32x4 a = acc[ai][bj][m][n];
                        if (reg < 2) {
                            const f32x4 bias = *(const f32x4*)(w0 + reg * 512 + ch);
                            f32x4 o;
#pragma unroll
                            for (int i = 0; i < 4; ++i) {
                                const float x = -(bias[i] + a[i]);
                                const float sp_ = fmaxf(x, 0.f) + __logf(1.0f + __expf(-fabsf(x)));
                                o[i] = __expf(-__expf(-sp_ - 0.5f));
                            }
                            *(f32x4*)(sp + (3 + 3 * reg) * 64) = o;
                        } else if (reg < 4) {
                            const int d = reg - 2;
                            const f32x4 bias = *(const f32x4*)(a0 + d * 512 + ch), ka = *(const f32x4*)(k_a + ch);
                            const f32x4 kraw = *(const f32x4*)(sp + (5 + 3 * d) * 64), kk = *(const f32x4*)(sp);
                            f32x4 bv, kf;
#pragma unroll
                            for (int i = 0; i < 4; ++i) {
                                const float ag = sigmoidf_(bias[i] + a[i]);
                                bv[i] = -kk[i] * ag; kf[i] = kraw[i] * (1.0f + (ag - 1.0f) * ka[i]);
                            }
                            *(f32x4*)(sp + (4 + 3 * d) * 64) = bv; *(f32x4*)(sp + (5 + 3 * d) * 64) = kf;
                        } else {
                            *(u32x2*)(P + (size_t)r * PP + IC_RW + ch) = pack4(a);
                        }
                        asm volatile("" ::: "memory");
                    }
            }
    }
};

struct EpiGate {
    static constexpr bool PERM = true, AFTER_DRAIN = false;
    bf16_t* G;
    __device__ __forceinline__ void operator()(const f32x4 (&acc)[2][2][4][2], const Unit& u, int wr, int wc, int fr, int fq) const {
#pragma unroll
        for (int ai = 0; ai < 2; ++ai)
#pragma unroll
            for (int m = 0; m < 4; ++m) {
                const int r = u.pm * 256 + ai * 128 + wr * 64 + m * 16 + fr;
#pragma unroll
                for (int bj = 0; bj < 2; ++bj) {
                    const int c = u.pn * 256 + bj * 128 + wc * 32 + 8 * fq;
                    const f32x4 a0 = acc[ai][bj][m][0], a1 = acc[ai][bj][m][1];
                    u32x4 w; w.x = pk2(sigmoidf_(a0.x), sigmoidf_(a0.y)); w.y = pk2(sigmoidf_(a0.z), sigmoidf_(a0.w)); w.z = pk2(sigmoidf_(a1.x), sigmoidf_(a1.y)); w.w = pk2(sigmoidf_(a1.z), sigmoidf_(a1.w));
                    *(u32x4*)(G + (size_t)r * 3072 + c) = w;
                }
            }
    }
};

template <int PASS> struct EpiMerge {
    static constexpr bool PERM = false, AFTER_DRAIN = false;
    const bf16_t* G; bf16_t* MF; bf16_t* MB;
    __device__ __forceinline__ void operator()(const f32x4 (&acc)[2][2][4][2], const Unit& u, int wr, int wc, int fr, int fq) const {
#pragma unroll
        for (int ai = 0; ai < 2; ++ai)
#pragma unroll
            for (int m = 0; m < 4; ++m) {
                const int r = u.pm * 256 + ai * 128 + wr * 64 + m * 16 + fr;
#pragma unroll
                for (int bj = 0; bj < 2; ++bj)
#pragma unroll
                    for (int n = 0; n < 2; ++n) {
                        const int c = u.pn * 256 + bj * 128 + wc * 32 + 16 * n + 4 * fq;
                        const f32x4 g = unpack4(*(const u32x2*)(G + (size_t)r * 3072 + PASS * 1024 + c));
                        f32x4 v = g * acc[ai][bj][m][n];
                        bf16_t* mp = MF + (size_t)r * 1024 + c;
                        if (PASS > 0) v += unpack4(*(const u32x2*)mp);
                        *(u32x2*)(PASS < 2 ? mp : MB + (size_t)r * 1024 + c) = pack4(v);
                    }
            }
    }
};

struct EpiBf {
    static constexpr bool PERM = true, AFTER_DRAIN = false;
    bf16_t* O; int ldc;
    __device__ __forceinline__ void operator()(const f32x4 (&acc)[2][2][4][2], const Unit& u, int wr, int wc, int fr, int fq) const {
#pragma unroll
        for (int ai = 0; ai < 2; ++ai)
#pragma unroll
            for (int m = 0; m < 4; ++m) {
                const int r = u.pm * 256 + ai * 128 + wr * 64 + m * 16 + fr;
#pragma unroll
                for (int bj = 0; bj < 2; ++bj) {
                    const int c = u.pn * 256 + bj * 128 + wc * 32 + 8 * fq;
                    const f32x4 a0 = acc[ai][bj][m][0], a1 = acc[ai][bj][m][1];
                    u32x4 w; w.x = pk2(a0.x, a0.y); w.y = pk2(a0.z, a0.w); w.z = pk2(a1.x, a1.y); w.w = pk2(a1.z, a1.w);
                    *(u32x4*)(O + (size_t)r * ldc + c) = w;
                }
            }
    }
};

struct EpiSwiglu {
    static constexpr bool PERM = true, AFTER_DRAIN = false;
    bf16_t* H; int ldh; int npn; int pm_sub;
    __device__ __forceinline__ void operator()(const f32x4 (&acc)[2][2][4][2], const Unit& u, int wr, int wc, int fr, int fq) const {
        const int pnn = u.pn % npn;
#pragma unroll
        for (int ai = 0; ai < 2; ++ai)
#pragma unroll
            for (int m = 0; m < 4; ++m) {
                const int r = (u.pm - pm_sub) * 256 + ai * 128 + wr * 64 + m * 16 + fr;
                const int hc = pnn * 128 + wc * 32 + 8 * fq;
                const f32x4 g0 = acc[ai][0][m][0], g1 = acc[ai][0][m][1], u0 = acc[ai][1][m][0], u1 = acc[ai][1][m][1];
                u32x4 w; w.x = pk2(siluf_(g0.x) * u0.x, siluf_(g0.y) * u0.y); w.y = pk2(siluf_(g0.z) * u0.z, siluf_(g0.w) * u0.w);
                w.z = pk2(siluf_(g1.x) * u1.x, siluf_(g1.y) * u1.y); w.w = pk2(siluf_(g1.z) * u1.z, siluf_(g1.w) * u1.w);
                *(u32x4*)(H + (size_t)r * ldh + hc) = w;
            }
    }
};

struct MoeSched {
    int ts[9]; int pm_lo, pm_hi, npn, G, c; bool a_local;
    __device__ __forceinline__ int expert_of(int pm) const { int e = 0;
#pragma unroll
        for (int q = 1; q < 8; ++q) e += (pm >= ts[q]) ? 1 : 0;
        return e; }
    __device__ __forceinline__ bool next(int i, Unit& u) const {
        const int n = (pm_hi - pm_lo) * npn; const long L = (long)i * G + c; if (L >= n) return false;
        const int pm = pm_lo + (int)L / npn, pnn = (int)L % npn;
        u.pm = a_local ? pm - pm_lo : pm; u.pn = expert_of(pm) * npn + pnn; u.koff = 0; u.tail = -1; return true;
    }
    __device__ __forceinline__ void a_ready(const Unit&) const {}
    __device__ __forceinline__ void done(const Unit&) const {}
};
struct EpiMoeDown {
    static constexpr bool PERM = false, AFTER_DRAIN = false;
    bf16_t* FS; long slot1_off; const int* LIST; const float* WTS; const unsigned* cnt; int ts[9]; int pm_lo;
    __device__ __forceinline__ void operator()(const f32x4 (&acc)[2][2][4][2], const Unit& u, int wr, int wc, int fr, int fq) const {
        const int e = u.pn >> 2, pnn = u.pn & 3, pmg = u.pm + pm_lo;
        int tse = 0;
#pragma unroll
        for (int q = 0; q < 8; ++q) tse = (q == e) ? ts[q] : tse;
        const int ne = (int)cnt[e];
#pragma unroll
        for (int ai = 0; ai < 2; ++ai)
#pragma unroll
            for (int m = 0; m < 4; ++m) {
                const int slot = (pmg - tse) * 256 + ai * 128 + wr * 64 + m * 16 + fr;
                if (slot < ne) {
                    const int tk = LIST[e * 16384 + slot]; const float w = WTS[e * 16384 + slot];
                    bf16_t* dst = FS + (long)(tk & 1) * slot1_off + (size_t)(tk >> 1) * 1024 + pnn * 256 + wc * 32 + 4 * fq;
#pragma unroll
                    for (int bj = 0; bj < 2; ++bj)
#pragma unroll
                        for (int n = 0; n < 2; ++n) *(u32x2*)(dst + bj * 128 + 16 * n) = pack4(acc[ai][bj][m][n] * w);
                }
            }
    }
};

constexpr float SC2 = 0.125f * 1.4426950408889634f;
constexpr int ATT_ROW = 144, ATT_VOFF = 9216, ATT_BUF = 27648;
constexpr float ATT_THR = 6.0f;
__device__ __forceinline__ float xhalf_max(float v) { auto rr = __builtin_amdgcn_permlane32_swap(__float_as_uint(v), __float_as_uint(v), false, false); return fmaxf(__uint_as_float(rr[0]), __uint_as_float(rr[1])); }
__device__ __forceinline__ float xhalf_sum(float v) { auto rr = __builtin_amdgcn_permlane32_swap(__float_as_uint(v), __float_as_uint(v), false, false); return __uint_as_float(rr[0]) + __uint_as_float(rr[1]); }

template <int DV, bool WINDOW>
__device__ __forceinline__ void attn_pass(LAS unsigned char* lds, const bf16_t* __restrict__ P, int qrow0, int qcol, int kcol, const bf16_t* __restrict__ VT,
                                          int lat_row0, int ctx_row0, int tile_lo, int tile_hi, bool has_ref, float m0, float l0, int qpos0,
                                          f32x16 (&o)[DV / 32], float& l_out, int wave, int lane) {
    int tid_ = threadIdx.x; asm volatile("" : "+v"(tid_)); const int tid = tid_; lane = tid & 63; const int qn = lane & 31, half = lane >> 5;
    bf16x8 qf[4];
    { const bf16_t* qp = P + (size_t)(qrow0 + wave * 32 + qn) * PP + qcol + half * 8;
#pragma unroll
      for (int ks = 0; ks < 4; ++ks) qf[ks] = *(const bf16x8*)(qp + ks * 16); }
    float mrun = has_ref ? m0 : 0.f, lrun = (half == 0) ? l0 : 0.f;
    bool need_ref = !has_ref;
    f32x16 negm;
#pragma unroll
    for (int i = 0; i < 16; ++i) negm[i] = -mrun;
#pragma unroll
    for (int db = 0; db < DV / 32; ++db)
#pragma unroll
        for (int i = 0; i < 16; ++i) o[db][i] = 0.f;
    const int nlat = tile_hi - tile_lo, nt = nlat + 4;
    u32x4 kreg[1], vreg[1][DV / 64];
    const int skey = tid >> 3, spc = tid & 7;
#define ATT_LOAD(ti_, set_) do { const int id_ = (ti_) < nlat ? tile_lo + (ti_) : 128 + ((ti_) - nlat); \
        const int krow0_ = id_ < 128 ? lat_row0 + 64 * id_ : ctx_row0 + 64 * (id_ - 128); \
        kreg[set_] = *(const u32x4*)(P + (size_t)(krow0_ + skey) * PP + kcol + spc * 8); \
        _Pragma("unroll") for (int j_ = 0; j_ < DV / 64; ++j_) { const int idx_ = tid + 512 * j_; vreg[set_][j_] = *(const u32x4*)(VT + (size_t)(idx_ >> 3) * KEYS + 64 * id_ + (idx_ & 7) * 8); } } while (0)
#define ATT_STORE(buf_, set_) do { LAS unsigned char* b_ = lds + (buf_) * ATT_BUF; *(LAS u32x4*)(b_ + skey * ATT_ROW + spc * 16) = kreg[set_]; \
        _Pragma("unroll") for (int j_ = 0; j_ < DV / 64; ++j_) { const int idx_ = tid + 512 * j_, dim_ = idx_ >> 3; *(LAS u32x4*)(b_ + ATT_VOFF + dim_ * ATT_ROW + (((idx_ & 7) ^ ((dim_ >> 4) & 1)) * 16)) = vreg[set_][j_]; } } while (0)
    __syncthreads();
    ATT_LOAD(0, 0); ATT_STORE(0, 0);
    if (nt > 1) ATT_LOAD(1, 0);
    __syncthreads();
    for (int ti0 = 0; ti0 < nt; ti0 += 1) {
#pragma unroll
      for (int dd = 0; dd < 1; ++dd) {
        const int ti = ti0 + dd;
        if (ti < nt) {
        const LAS unsigned char* Ks = lds + (ti & 1) * ATT_BUF; const LAS unsigned char* Vs = Ks + ATT_VOFF;
        const int id = ti < nlat ? tile_lo + ti : 128 + (ti - nlat);
        const bool islat = id < 128;
        bool skip = false;
        if (WINDOW && islat) { const int qw = qpos0 + wave * 32; skip = (64 * id + 63 < qw - 128 || 64 * id > qw + 31 + 128); }
        if (!skip) {
        f32x16 s[2];
#pragma unroll
        for (int mb = 0; mb < 2; ++mb) {
#pragma unroll
            for (int ks = 0; ks < 4; ++ks) {
                const bf16x8 kf = *(const LAS bf16x8*)(Ks + (32 * mb + qn) * ATT_ROW + ks * 32 + half * 16);
                if (ks == 0) s[mb] = __builtin_amdgcn_mfma_f32_32x32x16_bf16(kf, qf[0], negm, 0, 0, 0);
                else s[mb] = __builtin_amdgcn_mfma_f32_32x32x16_bf16(kf, qf[ks], s[mb], 0, 0, 0);
            }
        }
        if (WINDOW && islat) {
            const int qpos = qpos0 + wave * 32 + qn;
#pragma unroll
            for (int mb = 0; mb < 2; ++mb)
#pragma unroll
                for (int i = 0; i < 16; ++i) { const int d = 64 * id + 32 * mb + 8 * (i >> 2) + 4 * half + (i & 3) - qpos; if (d > 128 || d < -128) s[mb][i] = -INFINITY; }
        }
        float mx = s[0][0];
#pragma unroll
        for (int mb = 0; mb < 2; ++mb)
#pragma unroll
            for (int i = 0; i < 16; ++i) mx = fmaxf(mx, s[mb][i]);
        mx = xhalf_max(mx);
        if (__builtin_expect(need_ref || __any(mx > ATT_THR), 0)) {
            const float delta = need_ref ? mx : fmaxf(mx, 0.f);
            if (!need_ref) {
                const float alpha = __builtin_amdgcn_exp2f(-delta);
                lrun *= alpha;
#pragma unroll
                for (int db = 0; db < DV / 32; ++db)
#pragma unroll
                    for (int i = 0; i < 16; ++i) o[db][i] *= alpha;
            }
            mrun += delta; need_ref = false;
#pragma unroll
            for (int mb = 0; mb < 2; ++mb)
#pragma unroll
                for (int i = 0; i < 16; ++i) s[mb][i] -= delta;
#pragma unroll
            for (int i = 0; i < 16; ++i) negm[i] = -mrun;
        }
        float rs = 0.f;
#pragma unroll
        for (int mb = 0; mb < 2; ++mb)
#pragma unroll
            for (int i = 0; i < 16; ++i) { const float pv = __builtin_amdgcn_exp2f(s[mb][i]); s[mb][i] = pv; rs += pv; }
        lrun += rs;
#pragma unroll
        for (int g = 0; g < 4; ++g) {
            const int mb = g >> 1, bs = 8 * (g & 1);
            u32x4 pw; pw.x = pk2(s[mb][bs + 0], s[mb][bs + 1]); pw.y = pk2(s[mb][bs + 2], s[mb][bs + 3]); pw.z = pk2(s[mb][bs + 4], s[mb][bs + 5]); pw.w = pk2(s[mb][bs + 6], s[mb][bs + 7]);
            const bf16x8 pf = __builtin_bit_cast(bf16x8, pw);
#pragma unroll
            for (int db = 0; db < DV / 32; ++db) {
                const int dim = 32 * db + qn, sw = (dim >> 4) & 1;
                const LAS unsigned char* vrow = Vs + dim * ATT_ROW + 8 * half;
                const u32x2 lo = *(const LAS u32x2*)(vrow + (((2 * g) ^ sw) * 16)), hi = *(const LAS u32x2*)(vrow + (((2 * g + 1) ^ sw) * 16));
                const u32x4 vw = (u32x4){lo.x, lo.y, hi.x, hi.y};
                o[db] = __builtin_amdgcn_mfma_f32_32x32x16_bf16(__builtin_bit_cast(bf16x8, vw), pf, o[db], 0, 0, 0);
            }
        }
        }
        if (ti + 1 < nt) { ATT_STORE((ti + 1) & 1, 0); if (ti + 2 < nt) ATT_LOAD(ti + 2, 0); }
        __syncthreads();
        }
      }
    }
#undef ATT_LOAD
#undef ATT_STORE
    l_out = xhalf_sum(lrun);
}

__device__ __forceinline__ void swa_unit(LAS unsigned char* lds, const Params& p, int layer, int b, int hq, int qb, bool ctx, int wave, int lane, bool dry = false) {
    bf16_t* P = (bf16_t*)(p.ws + WS_P);
    const int kvh = hq >> 2;
    const bf16_t* VT = (const bf16_t*)(p.ws + WS_VTS) + (size_t)((b * 2 + kvh) * 64) * KEYS;
    const float sink2 = p.in[11][layer * 8 + hq] * 1.4426950408889634f;
    const int qrow0 = ctx ? NLAT + b * CTXL : b * SEQ + qb * 256;
    f32x16 o[2]; float l;
    if (ctx) attn_pass<64, false>(lds, P, qrow0, IC_QS + hq * 64, IC_KS + kvh * 64, VT, b * SEQ, NLAT + b * CTXL, 0, 0, true, sink2, 1.0f, 0, o, l, wave, lane);
    else {
        int lo = 4 * qb - 2; if (lo < 0) lo = 0; int hi = 4 * qb + 6; if (hi > 128) hi = 128;
        attn_pass<64, true>(lds, P, qrow0, IC_QS + hq * 64, IC_KS + kvh * 64, VT, b * SEQ, NLAT + b * CTXL, lo, hi, true, sink2, 1.0f, qb * 256, o, l, wave, lane);
    }
    const float inv = 1.0f / l; const int qn = lane & 31, half = lane >> 5;
    bf16_t* dst = P + (size_t)(qrow0 + wave * 32 + qn) * PP + IC_QS + hq * 64 + 4 * half;
#pragma unroll
    for (int db = 0; db < 2; ++db)
#pragma unroll
        for (int q4 = 0; q4 < 4; ++q4) {
            const f32x4 v = (f32x4){o[db][4 * q4] * inv, o[db][4 * q4 + 1] * inv, o[db][4 * q4 + 2] * inv, o[db][4 * q4 + 3] * inv};
            if (!dry) *(u32x2*)(dst + 32 * db + 8 * q4) = pack4(v);
        }
}
__device__ __forceinline__ void diff_unit(LAS unsigned char* lds, const Params& p, float lam, int b, int h, int qb, bool ctx, int wave, int lane, bool dry = false) {
    bf16_t* P = (bf16_t*)(p.ws + WS_P);
    const bf16_t* VT = (const bf16_t*)(p.ws + WS_VTD) + (size_t)((b * 4 + h) * 128) * KEYS;
    const int qrow0 = ctx ? NLAT + b * CTXL : b * SEQ + qb * 256;
    const int thi = ctx ? 0 : 128;
    LAS unsigned* park = (LAS unsigned*)(lds + 73728) + threadIdx.x;
    f32x16 o[4]; float l;
    attn_pass<128, false>(lds, P, qrow0, IC_QD + h * 128, IC_KD + h * 128, VT, b * SEQ, NLAT + b * CTXL, 0, thi, false, 0.f, 0.f, 0, o, l, wave, lane);
    { const float inv = 1.0f / l;
#pragma unroll
      for (int db = 0; db < 4; ++db)
#pragma unroll
          for (int i = 0; i < 8; ++i) park[(db * 8 + i) * 512] = pk2(o[db][2 * i] * inv, o[db][2 * i + 1] * inv); }
    attn_pass<128, false>(lds, P, qrow0, IC_QD + h * 128 + 64, IC_KD + h * 128 + 64, VT, b * SEQ, NLAT + b * CTXL, 0, thi, false, 0.f, 0.f, 0, o, l, wave, lane);
    const float inv = lam / l; const int qn = lane & 31, half = lane >> 5;
    bf16_t* dst = P + (size_t)(qrow0 + wave * 32 + qn) * PP + IC_QD + h * 128 + 4 * half;
#pragma unroll
    for (int db = 0; db < 4; ++db)
#pragma unroll
        for (int q4 = 0; q4 < 4; ++q4) {
            const unsigned pa = park[(db * 8 + 2 * q4) * 512], pb = park[(db * 8 + 2 * q4 + 1) * 512];
            const f32x4 v = (f32x4){bflo(pa) - o[db][4 * q4] * inv, bfhi(pa) - o[db][4 * q4 + 1] * inv, bflo(pb) - o[db][4 * q4 + 2] * inv, bfhi(pb) - o[db][4 * q4 + 3] * inv};
            if (!dry) *(u32x2*)(dst + 32 * db + 8 * q4) = pack4(v);
        }
}

__device__ __forceinline__ void ld8bf(const bf16_t* p, float (&v)[8]) { const u32x4 w = *(const u32x4*)p; v[0] = bflo(w.x); v[1] = bfhi(w.x); v[2] = bflo(w.y); v[3] = bfhi(w.y); v[4] = bflo(w.z); v[5] = bfhi(w.z); v[6] = bflo(w.w); v[7] = bfhi(w.w); }
__device__ __forceinline__ void ld8f(const float* p, float (&v)[8]) { const f32x4 a = ((const f32x4*)p)[0], b = ((const f32x4*)p)[1]; v[0] = a.x; v[1] = a.y; v[2] = a.z; v[3] = a.w; v[4] = b.x; v[5] = b.y; v[6] = b.z; v[7] = b.w; }
__device__ __forceinline__ void st8f(float* p, const float (&v)[8]) { ((f32x4*)p)[0] = (f32x4){v[0], v[1], v[2], v[3]}; ((f32x4*)p)[1] = (f32x4){v[4], v[5], v[6], v[7]}; }

__device__ __forceinline__ void rwkv_prepare_phase(const Params& p, int layer, int gw, int NGW, int lane) {
    const bf16_t* P = (const bf16_t*)(p.ws + WS_P); float* ST = (float*)(p.ws + WS_ST); bf16_t* A2 = (bf16_t*)(p.ws + WS_YA);
    const float* mup = p.in[12] + layer * 1920; const float* mun = p.in[13] + layer * 1920; const float* k_k = p.in[19] + layer * 512;
    for (int m = gw; m < NTOK; m += NGW) {
        const int t = m < NLAT ? (m & (SEQ - 1)) : ((m - NLAT) & (CTXL - 1)), len = m < NLAT ? SEQ : CTXL;
        const bool hp = t > 0, hn = t < len - 1;
        const bf16_t* pr = P + (size_t)m * PP + IC_RW;
        const int h = lane >> 3, kidx = (lane & 7) * 8;
        float* sp = ST + ((size_t)m * 8 + h) * (ST_SLOTS * 64) + kidx;
#pragma unroll
        for (int sec = 0; sec < 4; ++sec) {
            if (sec == 3 && lane >= 48) break;
            const int col = sec < 3 ? sec * 512 + lane * 8 : 1536 + lane * 8;
            float c[8], pv[8], nx[8], a[8], bb[8], sh[8];
            ld8bf(pr + col, c);
            if (hp) ld8bf(pr - PP + col, pv); else {
#pragma unroll
                for (int q = 0; q < 8; ++q) pv[q] = 0.f; }
            if (hn) ld8bf(pr + PP + col, nx); else {
#pragma unroll
                for (int q = 0; q < 8; ++q) nx[q] = 0.f; }
            ld8f(mup + col, a); ld8f(mun + col, bb);
#pragma unroll
            for (int q = 0; q < 8; ++q) sh[q] = c[q] + a[q] * (pv[q] - c[q]) + bb[q] * (nx[q] - c[q]);
            if (sec == 0) st8f(sp + 1 * 64, sh);
            else if (sec == 2) st8f(sp + 2 * 64, sh);
            else if (sec == 1) {
                st8f(sp + 5 * 64, sh); st8f(sp + 8 * 64, sh);
                float kk[8], kkw[8]; ld8f(k_k + lane * 8, kkw);
                float ss = 0.f;
#pragma unroll
                for (int q = 0; q < 8; ++q) { kk[q] = sh[q] * kkw[q]; ss += kk[q] * kk[q]; }
                ss += __shfl_xor(ss, 1); ss += __shfl_xor(ss, 2); ss += __shfl_xor(ss, 4);
                const float inv = 1.0f / fmaxf(sqrtf(ss), 1e-12f);
#pragma unroll
                for (int q = 0; q < 8; ++q) kk[q] *= inv;
                st8f(sp, kk);
            } else {
                float o[8];
#pragma unroll
                for (int q = 0; q < 8; ++q) o[q] = lane < 16 ? tanhf(sh[q]) : (lane < 32 ? sh[q] : sigmoidf_(sh[q]));
                u32x4 w; w.x = pk2(o[0], o[1]); w.y = pk2(o[2], o[3]); w.z = pk2(o[4], o[5]); w.w = pk2(o[6], o[7]);
                *(u32x4*)(A2 + (size_t)m * 384 + lane * 8) = w;
            }
        }
    }
}

constexpr int NSEG = 64, SEGL = KEYS / NSEG;
static_assert(SEGL * NSEG == KEYS && SEGL % 4 == 0, "segments");
constexpr size_t WS_GH = WS_YA;
static_assert(WS_GH + 32ull * NSEG * 2 * 4096 * 4 <= 560 * MiB, "GH fits behind the stream");
__device__ __forceinline__ int scan_token(int b, int dir, int s) {
    if (s < CTXL) return NLAT + b * CTXL + (dir ? CTXL - 1 - s : s);
    const int t = s - CTXL; return b * SEQ + (dir ? SEQ - 1 - t : t);
}
constexpr int SRING = 6, SREC = ST_SLOTS * 64 * 4;
constexpr int SCAN_LDS = SRING * SREC;
__device__ __forceinline__ void scan_dma(const float* rec, LAS unsigned char* slot, int lane) {
    const float* q = rec + lane * 4;
    __builtin_amdgcn_global_load_lds((const unsigned*)q, (LAS unsigned*)slot, 16, 0, 0);
    __builtin_amdgcn_global_load_lds((const unsigned*)(q + 256), (LAS unsigned*)(slot + 1024), 16, 0, 0);
    if (lane < 16) __builtin_amdgcn_global_load_lds((const unsigned*)(q + 512), (LAS unsigned*)(slot + 2048), 16, 0, 0);
}
template <int MODE>
__device__ __forceinline__ void rwkv_segment(const Params& p, int sid, int seg, int lane, LAS unsigned char* ring) {
    const int b = sid >> 4, h = (sid >> 1) & 7, dir = sid & 1, c = lane & 31, hf = lane >> 5;
    const float* ST = (const float*)(p.ws + WS_ST);
    float* gh = (float*)(p.ws + WS_GH) + ((size_t)sid * NSEG + seg) * 2 * 4096;
    f32x16 TH[2][2], TG[MODE == 0 ? 2 : 1][2];
#pragma unroll
    for (int kb = 0; kb < 2; ++kb)
#pragma unroll
        for (int vb = 0; vb < 2; ++vb) {
            if (MODE == 2 && seg > 0) {
                const float* src = gh - 4096 + (32 * vb + c) * 64 + 32 * kb + 4 * hf;
#pragma unroll
                for (int q = 0; q < 4; ++q) { const f32x4 t = *(const f32x4*)(src + 8 * q); TH[kb][vb][4 * q] = t.x; TH[kb][vb][4 * q + 1] = t.y; TH[kb][vb][4 * q + 2] = t.z; TH[kb][vb][4 * q + 3] = t.w; }
            } else {
#pragma unroll
                for (int r = 0; r < 16; ++r) TH[kb][vb][r] = 0.f;
            }
            if (MODE == 0) {
#pragma unroll
                for (int r = 0; r < 16; ++r) TG[MODE == 0 ? kb : 0][vb][r] = (32 * kb + 8 * (r >> 2) + 4 * hf + (r & 3) == 32 * vb + c) ? 1.0f : 0.0f;
            }
        }
    const int s0 = seg * SEGL, s_end = s0 + SEGL, od = (3 + 3 * dir) * 256;
#pragma unroll 1
    for (int j = 0; j < SRING - 1; ++j) scan_dma(ST + ((size_t)scan_token(b, dir, s0 + j) * 8 + h) * (ST_SLOTS * 64), ring + j * SREC, lane);
    int slot_i = 0;
#pragma unroll 1
    for (int s = s0; s < s_end; ++s) {
        if (s + SRING - 1 < s_end) {
            int nslot = slot_i + SRING - 1; if (nslot >= SRING) nslot -= SRING;
            scan_dma(ST + ((size_t)scan_token(b, dir, s + SRING - 1) * 8 + h) * (ST_SLOTS * 64), ring + nslot * SREC, lane);
            asm volatile("s_waitcnt vmcnt(15)" ::: "memory");
        } else asm volatile("s_waitcnt vmcnt(0)" ::: "memory");
        const LAS unsigned char* rec = ring + slot_i * SREC;
        slot_i = slot_i + 1 == SRING ? 0 : slot_i + 1;
        float ph[2] = {0.f, 0.f}, pg[2] = {0.f, 0.f};
#pragma unroll
        for (int kb = 0; kb < 2; ++kb)
#pragma unroll
            for (int q = 0; q < 4; ++q) {
                const f32x4 a4 = *(const LAS f32x4*)(rec + (32 * kb + 8 * q + 4 * hf) * 4);
#pragma unroll
                for (int j = 0; j < 4; ++j)
#pragma unroll
                    for (int vb = 0; vb < 2; ++vb) { ph[vb] = fmaf(TH[kb][vb][4 * q + j], a4[j], ph[vb]); if (MODE == 0) pg[vb] = fmaf(TG[MODE == 0 ? kb : 0][vb][4 * q + j], a4[j], pg[vb]); }
            }
        float sa[2], sg[2];
#pragma unroll
        for (int vb = 0; vb < 2; ++vb) { sa[vb] = xhalf_sum(ph[vb]); sg[vb] = MODE == 0 ? xhalf_sum(pg[vb]) : 0.f; }
#pragma unroll
        for (int kb = 0; kb < 2; ++kb)
#pragma unroll
            for (int q = 0; q < 4; ++q) {
                const f32x4 w4 = *(const LAS f32x4*)(rec + od + (32 * kb + 8 * q + 4 * hf) * 4);
#pragma unroll
                for (int j = 0; j < 4; ++j)
#pragma unroll
                    for (int vb = 0; vb < 2; ++vb) { TH[kb][vb][4 * q + j] *= w4[j]; if (MODE == 0) TG[MODE == 0 ? kb : 0][vb][4 * q + j] *= w4[j]; }
            }
        float aop[2], bop[2], bopg[2];
#pragma unroll
        for (int kb = 0; kb < 2; ++kb) aop[kb] = *(const LAS float*)(rec + od + (hf ? 512 : 256) + (32 * kb + c) * 4);
#pragma unroll
        for (int vb = 0; vb < 2; ++vb) { const float vv = *(const LAS float*)(rec + 512 + (32 * vb + c) * 4); bop[vb] = hf ? vv : sa[vb]; bopg[vb] = hf ? 0.f : sg[vb]; }
#pragma unroll
        for (int kb = 0; kb < 2; ++kb)
#pragma unroll
            for (int vb = 0; vb < 2; ++vb) {
                TH[kb][vb] = __builtin_amdgcn_mfma_f32_32x32x2f32(aop[kb], bop[vb], TH[kb][vb], 0, 0, 0);
                if (MODE == 0) TG[MODE == 0 ? kb : 0][vb] = __builtin_amdgcn_mfma_f32_32x32x2f32(aop[kb], bopg[vb], TG[MODE == 0 ? kb : 0][vb], 0, 0, 0);
            }
        if (MODE == 2) {
            float py[2] = {0.f, 0.f};
#pragma unroll
            for (int kb = 0; kb < 2; ++kb)
#pragma unroll
                for (int q = 0; q < 4; ++q) {
                    const f32x4 r4 = *(const LAS f32x4*)(rec + 256 + (32 * kb + 8 * q + 4 * hf) * 4);
#pragma unroll
                    for (int j = 0; j < 4; ++j)
#pragma unroll
                        for (int vb = 0; vb < 2; ++vb) py[vb] = fmaf(TH[kb][vb][4 * q + j], r4[j], py[vb]);
                }
            const float y0 = xhalf_sum(py[0]), y1 = xhalf_sum(py[1]);
            float* yp = (float*)ST + ((size_t)scan_token(b, dir, s) * 8 + h) * (ST_SLOTS * 64) + (3 + 3 * dir) * 64 + c;
            if (hf == 0) { yp[0] = y0; yp[32] = y1; }
        }
    }
    if (MODE == 0) {
#pragma unroll
        for (int kb = 0; kb < 2; ++kb)
#pragma unroll
            for (int vb = 0; vb < 2; ++vb) {
                float* dg = gh + (32 * vb + c) * 64 + 32 * kb + 4 * hf; float* dh = dg + 4096;
#pragma unroll
                for (int q = 0; q < 4; ++q) {
                    *(f32x4*)(dg + 8 * q) = (f32x4){TG[MODE == 0 ? kb : 0][vb][4 * q], TG[MODE == 0 ? kb : 0][vb][4 * q + 1], TG[MODE == 0 ? kb : 0][vb][4 * q + 2], TG[MODE == 0 ? kb : 0][vb][4 * q + 3]};
                    *(f32x4*)(dh + 8 * q) = (f32x4){TH[kb][vb][4 * q], TH[kb][vb][4 * q + 1], TH[kb][vb][4 * q + 2], TH[kb][vb][4 * q + 3]};
                }
            }
    }
}
__device__ __forceinline__ void rwkv_combine(const Params& p, int sid, LAS unsigned char* lds, int wave, int lane) {
    float* gh0 = (float*)(p.ws + WS_GH) + (size_t)sid * NSEG * 2 * 4096;
    LAS float* Sx = (LAS float*)lds;
    const int tid = wave * 64 + lane;
    for (int e = tid; e < 4096; e += NTHREADS) Sx[(e >> 6) * 65 + (e & 63)] = gh0[4096 + e];
    __syncthreads();
    const int rb = (wave >> 1) & 1, cb = wave & 1, i32 = lane & 31, hf = lane >> 5;
    for (int i = 1; i < NSEG - 1; ++i) {
        float* gi = gh0 + (size_t)i * 2 * 4096;
        f32x16 d;
        if (wave < 4) {
            float bq[32];
#pragma unroll
            for (int q = 0; q < 32; ++q) bq[q] = gi[(2 * q + hf) * 64 + 32 * cb + i32];
#pragma unroll
            for (int r = 0; r < 16; ++r) d[r] = gi[4096 + (32 * rb + 8 * (r >> 2) + 4 * hf + (r & 3)) * 64 + 32 * cb + i32];
#pragma unroll
            for (int q = 0; q < 32; ++q) {
                const float aq = Sx[(32 * rb + i32) * 65 + 2 * q + hf];
                d = __builtin_amdgcn_mfma_f32_32x32x2f32(aq, bq[q], d, 0, 0, 0);
            }
#pragma unroll
            for (int r = 0; r < 16; ++r) gi[4096 + (32 * rb + 8 * (r >> 2) + 4 * hf + (r & 3)) * 64 + 32 * cb + i32] = d[r];
        }
        __syncthreads();
        if (wave < 4) {
#pragma unroll
            for (int r = 0; r < 16; ++r) Sx[(32 * rb + 8 * (r >> 2) + 4 * hf + (r & 3)) * 65 + 32 * cb + i32] = d[r];
        }
        __syncthreads();
    }
}

__device__ __forceinline__ void postmix_phase(const Params& p, int layer, float lam_init, int M, int gw, int NGW, int lane) {
    const bf16_t* P = (const bf16_t*)(p.ws + WS_P); const float* ST = (const float*)(p.ws + WS_ST);
    bf16_t* YB = (bf16_t*)(p.ws + WS_YB); bf16_t* YC = (bf16_t*)(p.ws + WS_YC);
    const float* r_k = p.in[21] + layer * 512; const float* lng = p.in[22] + layer * 512; const float* lnb = p.in[23] + layer * 512; const float* sg = p.in[25] + layer * 128;
    for (int m = gw; m < M; m += NGW) {
        {
            const int h = lane >> 3, kidx = (lane & 7) * 8, ch = lane * 8;
            const float* sp = ST + ((size_t)m * 8 + h) * (ST_SLOTS * 64) + kidx;
            float y[8], r[8], v[8], k0[8], k1[8], rk[8], g[8], lg[8], lb[8];
            { float yb_[8]; ld8f(sp + 3 * 64, y); ld8f(sp + 6 * 64, yb_);
#pragma unroll
              for (int q = 0; q < 8; ++q) y[q] += yb_[q]; }
            ld8f(sp + 64, r); ld8f(sp + 128, v); ld8f(sp + 5 * 64, k0); ld8f(sp + 8 * 64, k1); ld8f(r_k + ch, rk); ld8f(lng + ch, lg); ld8f(lnb + ch, lb);
            ld8bf(P + (size_t)m * PP + IC_RW + ch, g);
            float s = 0.f, bn = 0.f;
#pragma unroll
            for (int q = 0; q < 8; ++q) { s += y[q]; bn += r[q] * (k0[q] + k1[q]) * rk[q]; }
            s += __shfl_xor(s, 1); s += __shfl_xor(s, 2); s += __shfl_xor(s, 4);
            bn += __shfl_xor(bn, 1); bn += __shfl_xor(bn, 2); bn += __shfl_xor(bn, 4);
            const float mu = s * (1.0f / 64.0f);
            float var = 0.f;
#pragma unroll
            for (int q = 0; q < 8; ++q) { const float d = y[q] - mu; var += d * d; }
            var += __shfl_xor(var, 1); var += __shfl_xor(var, 2); var += __shfl_xor(var, 4);
            const float rstd = 1.0f / sqrtf(var * (1.0f / 64.0f) + 64e-5f);
            float o[8];
#pragma unroll
            for (int q = 0; q < 8; ++q) o[q] = (((y[q] - mu) * rstd) * lg[q] + lb[q] + bn * v[q]) * g[q];
            u32x4 w; w.x = pk2(o[0], o[1]); w.y = pk2(o[2], o[3]); w.z = pk2(o[4], o[5]); w.w = pk2(o[6], o[7]);
            *(u32x4*)(YB + (size_t)m * 512 + ch) = w;
        }
        *(u32x4*)((bf16_t*)(p.ws + WS_YA) + (size_t)m * 512 + lane * 8) = *(const u32x4*)(P + (size_t)m * PP + IC_QS + lane * 8);
        {
            const int e = (lane & 15) * 8;
            float x[8], gg[8];
            ld8bf(P + (size_t)m * PP + IC_QD + lane * 8, x); ld8f(sg + e, gg);
            float ss = 0.f;
#pragma unroll
            for (int q = 0; q < 8; ++q) ss += x[q] * x[q];
            ss += __shfl_xor(ss, 1); ss += __shfl_xor(ss, 2); ss += __shfl_xor(ss, 4); ss += __shfl_xor(ss, 8);
            const float rstd = (1.0f - lam_init) / sqrtf(ss * (1.0f / 128.0f) + 1e-5f);
            float o[8];
#pragma unroll
            for (int q = 0; q < 8; ++q) o[q] = x[q] * rstd * gg[q];
            u32x4 w; w.x = pk2(o[0], o[1]); w.y = pk2(o[2], o[3]); w.z = pk2(o[4], o[5]); w.w = pk2(o[6], o[7]);
            *(u32x4*)(YC + (size_t)m * 512 + lane * 8) = w;
        }
    }
}
#define XB_TMO      128
#define XB_XCNT(j)  (256  + 64 * (j))
#define XB_XSUB(j)  (1280 + 64 * (j))
#define XB_XGEN(j)  (2304 + 64 * (j))
#define XB_TOP      3328
#define XB_TOPGEN   3392
#define XCD_BAR_WORDS 3456
#define XB_SPIN_CAP (1u << 18)

__device__ __forceinline__ unsigned xb_ld(unsigned* p)              { return __hip_atomic_load(p, __ATOMIC_RELAXED, __HIP_MEMORY_SCOPE_AGENT); }
__device__ __forceinline__ unsigned xb_add(unsigned* p, unsigned v) { return __hip_atomic_fetch_add(p, v, __ATOMIC_RELAXED, __HIP_MEMORY_SCOPE_AGENT); }
__device__ __forceinline__ unsigned xb_xcc_id() { return (unsigned)__builtin_amdgcn_s_getreg((3 << 11) | 20) & 0xFu; }
#define XB_SPIN(cond, bar) do { unsigned _sp = 0; while (cond) { __builtin_amdgcn_s_sleep(1); \
    if ((++_sp & 255u) == 0u) { if (xb_ld(&(bar)[XB_TMO])) break; if (_sp > XB_SPIN_CAP) { atomicAdd(&(bar)[XB_TMO], 1u); break; } } } } while (0)

struct XcdBarrier {
    unsigned* bar; unsigned x;
    volatile LAS unsigned* st;
};

__device__ __forceinline__ XcdBarrier xcd_barrier_post(unsigned* bar, volatile LAS unsigned* st) {
    XcdBarrier b; b.bar = bar; b.x = xb_xcc_id(); b.st = st;
    if (threadIdx.x == 0) (void)xb_add(&bar[XB_XCNT(b.x)], 1u);
    return b;
}
__device__ __forceinline__ void xcd_barrier_complete(unsigned* bar, unsigned x, unsigned& nloc, unsigned& nx) {
    const unsigned G = gridDim.x * gridDim.y * gridDim.z;
    unsigned sum, cnt, mine, sp = 0u;
    for (;;) {
        sum = 0u; cnt = 0u; mine = 0u;
#pragma unroll
        for (unsigned j = 0; j < 16; ++j) { const unsigned c = xb_ld(&bar[XB_XCNT(j)]); sum += c; cnt += (c > 0u) ? 1u : 0u; mine = (j == x) ? c : mine; }
        if (sum == G) break;
        __builtin_amdgcn_s_sleep(1);
        if ((++sp & 255u) == 0u) { if (xb_ld(&bar[XB_TMO])) break; if (sp > XB_SPIN_CAP) { atomicAdd(&bar[XB_TMO], 1u); break; } }
    }
    nloc = mine > 0u ? mine : 1u; nx = cnt > 0u ? cnt : 1u;
}

__device__ __forceinline__ void xcd_barrier(const XcdBarrier& b) {
    asm volatile("s_waitcnt vmcnt(0)" ::: "memory");
    __syncthreads();
    if (threadIdx.x == 0) {
        unsigned* bar = b.bar;
        __builtin_amdgcn_s_waitcnt(0);
        unsigned nloc = b.st[0], nx = b.st[1];
        if (nloc == 0u) { xcd_barrier_complete(bar, b.x, nloc, nx); b.st[0] = nloc; b.st[1] = nx; }
        const unsigned old = xb_add(&bar[XB_XSUB(b.x)], 1u);
        const unsigned gen = old / nloc;
        if (old + 1u == (gen + 1u) * nloc) {
            __builtin_amdgcn_fence(__ATOMIC_RELEASE, "agent");
            asm volatile("s_waitcnt vmcnt(0)" ::: "memory");
            const unsigned og = xb_add(&bar[XB_TOP], 1u);
            const unsigned tg = og / nx;
            if (og + 1u == (tg + 1u) * nx) xb_add(&bar[XB_TOPGEN], 1u);
            else XB_SPIN(xb_ld(&bar[XB_TOPGEN]) == tg, bar);
            __builtin_amdgcn_fence(__ATOMIC_ACQUIRE, "agent");
            xb_add(&bar[XB_XGEN(b.x)], 1u);
            asm volatile("s_waitcnt vmcnt(0)" ::: "memory");
        } else {
            XB_SPIN(xb_ld(&bar[XB_XGEN(b.x)]) == gen, bar);
            __builtin_amdgcn_fence(__ATOMIC_ACQUIRE, "agent");
            asm volatile("s_waitcnt vmcnt(0)" ::: "memory");
        }
    }
    __syncthreads();
}

#ifndef MK_MULTI
#define MK_MULTI 0
#endif
constexpr int N_PHASES = 40;

constexpr int LDS_PARAMS = LDS_BYTES - 1024;
constexpr int LDS_XB = LDS_BYTES - 64;
constexpr int CW_BAR = 8192;
__device__ __forceinline__ unsigned long long uni64(unsigned long long v) {
    const unsigned lo = __builtin_amdgcn_readfirstlane((unsigned)v), hi = __builtin_amdgcn_readfirstlane((unsigned)(v >> 32));
    return ((unsigned long long)hi << 32) | lo;
}
__device__ __forceinline__ int opq(int v) { asm volatile("" : "+s"(v)); return v; }
__device__ __forceinline__ void load_params(LAS unsigned char* lds, Params& q) {
    LAS const unsigned long long* s = (LAS const unsigned long long*)(lds + LDS_PARAMS);
#pragma unroll
    for (int i = 0; i < 37; ++i) q.in[i] = (const float*)(const __attribute__((address_space(1))) float*)uni64(s[i]);
    q.out = (float*)(__attribute__((address_space(1))) float*)uni64(s[37]); q.ws = (unsigned char*)(__attribute__((address_space(1))) unsigned char*)uni64(s[38]); q.ph_lo = 0; q.ph_hi = 0;
}
__global__ void __launch_bounds__(NTHREADS, 2) mk_fwd(Params kp) {
    extern __shared__ __attribute__((aligned(16))) unsigned char lds_raw[];
    LAS unsigned char* lds = (LAS unsigned char*)lds_raw;
    cg::grid_group grid = cg::this_grid();
    if (threadIdx.x == 0) {
        LAS unsigned long long* s = (LAS unsigned long long*)(lds + LDS_PARAMS);
#pragma unroll
        for (int i = 0; i < 37; ++i) s[i] = (unsigned long long)kp.in[i];
        s[37] = (unsigned long long)kp.out; s[38] = (unsigned long long)kp.ws;
    }
    if (threadIdx.x < 2) ((LAS unsigned*)(lds + LDS_XB))[threadIdx.x] = 0u;
    __syncthreads();
#if !MK_MULTI
    (void)xcd_barrier_post((unsigned*)(kp.ws + WS_CTL) + CW_BAR, (volatile LAS unsigned*)(lds + LDS_XB));
#endif
    const int ph_lo = kp.ph_lo, ph_hi = kp.ph_hi;
    int ph = 0;
#define PH_BEGIN if (ph >= ph_lo && ph < ph_hi) { asm volatile("" ::: "memory"); Params p; load_params(lds, p); unsigned char* ws = p.ws; (void)ws; \
    int tid_ = threadIdx.x, bid_ = blockIdx.x, G_ = gridDim.x; asm volatile("" : "+v"(tid_), "+s"(bid_), "+s"(G_)); \
    const int tid = tid_, bid = bid_, G = G_, lane = tid & 63, wave = __builtin_amdgcn_readfirstlane(tid >> 6); const int gw = bid * NWAVES + wave, NGW = G * NWAVES; (void)gw; (void)NGW; (void)lane; (void)tid; (void)G; (void)bid;
#define GRID_SEAM() do { if (ph == 0) grid.sync(); else { XcdBarrier xb_; xb_.bar = (unsigned*)((unsigned char*)(__attribute__((address_space(1))) unsigned char*)uni64(((LAS const unsigned long long*)(lds + LDS_PARAMS))[38]) + WS_CTL) + CW_BAR; \
        xb_.x = xb_xcc_id(); xb_.st = (volatile LAS unsigned*)(lds + LDS_XB); xcd_barrier(xb_); } } while (0)
#define PH_END } if (ph >= ph_lo && ph + 1 < ph_hi) GRID_SEAM(); ++ph;

    using pg8::Gemm; using pg8::StaticOrder; using pg8::gemm_phase;

    PH_BEGIN
        convert_layer_weights(p, 0, lds, gw, NGW, wave, lane);
        __syncthreads();
        adaln_phase(p, lds, wave, lane);
    PH_END
    PH_BEGIN
        premix_phase(p, 0, true, NTOK, gw, NGW, lane);
    PH_END

#pragma clang loop unroll(full)
    for (int layer = 0; layer < 2; ++layer) {
        const int Ml = layer == 0 ? NTOK : NLAT;
        const float lam_init = 0.8f - 0.6f * expf(-0.3f * (float)layer);
        PH_BEGIN
            Gemm g{(const bf16_t*)(ws + WS_XN), (const bf16_t*)(ws + WS_WIN), NTOK, NIN1, opq(1024), 1024}; StaticOrder S; S.init(NTOK, NIN1, G, bid);
            EpiIn E{(bf16_t*)(ws + WS_P), (bf16_t*)(ws + WS_VTS), (bf16_t*)(ws + WS_VTD), (const float*)(ws + WS_ROPE)};
            gemm_phase<EpiIn, StaticOrder, true, true>(lds, g, S, E);
        PH_END
        PH_BEGIN
            rwkv_prepare_phase(p, layer, gw, NGW, lane);
        PH_END
        PH_BEGIN
            Gemm g{(const bf16_t*)(ws + WS_YA), (const bf16_t*)(ws + WS_LORA), NTOK, 2560, opq(384), 384}; StaticOrder S; S.init(NTOK, 2560, G, bid);
            EpiLora E{(float*)(ws + WS_ST), (bf16_t*)(ws + WS_P), p.in[14] + layer * 1024, p.in[16] + layer * 1024, p.in[20] + layer * 512};
            gemm_phase<EpiLora, StaticOrder, true, true>(lds, g, S, E);
        PH_END
        PH_BEGIN
            for (int u = gw; u < 32 * (NSEG - 1); u += NGW) rwkv_segment<0>(p, u / (NSEG - 1), u % (NSEG - 1), lane, lds + wave * SCAN_LDS);
        PH_END
        PH_BEGIN
            unsigned* qhead = (unsigned*)(ws + WS_CTL) + (layer == 0 ? CW_Q0 : CW_Q1);
            LAS int* ubox = (LAS int*)(lds + 65536);
            const int n_swa = 512 + (layer == 0 ? 16 : 0);
            if (bid < 32) rwkv_combine(p, bid, lds, wave, lane);
            if (bid >= 32 || G <= 32)
            for (;;) {
                if (tid == 0) ubox[0] = (int)atomicAdd(qhead, 1u);
                __syncthreads();
                const int u = ubox[0];
                __syncthreads();
                if (u >= n_swa) break;
                if (u < 512) swa_unit(lds, p, layer, u >> 8, (u >> 5) & 7, u & 31, false, wave, lane);
                else { const int v = u - 512; swa_unit(lds, p, layer, v >> 3, v & 7, 0, true, wave, lane); }
            }
        PH_END
        PH_BEGIN
            for (int u = gw; u < 32 * NSEG; u += NGW) rwkv_segment<2>(p, u / NSEG, u % NSEG, lane, lds + wave * SCAN_LDS);
        PH_END
        PH_BEGIN
            float lam;
            { const float* lv = p.in[24] + layer * 256;
              const float s1 = wave_sum(lv[lane] * lv[64 + lane]), s2 = wave_sum(lv[128 + lane] * lv[192 + lane]);
              lam = expf(s1) - expf(s2) + lam_init; }
            for (int u = bid; u < 256; u += G) { const int v = G == 256 ? ((((u & 7) >> 2) << 7) | ((u & 3) << 5) | (u >> 3)) : u; diff_unit(lds, p, lam, v >> 7, (v >> 5) & 3, v & 31, false, wave, lane); }
            if (layer == 0) for (int u = bid; u < 8; u += G) diff_unit(lds, p, lam, u >> 2, u & 3, 0, true, wave, lane);
        PH_END
        PH_BEGIN
            postmix_phase(p, layer, lam_init, Ml, gw, NGW, lane);
            if (layer == 0) convert_ffn_weights(p, lds, gw, NGW, wave, lane);
        PH_END
        PH_BEGIN
            Gemm g{(const bf16_t*)(ws + WS_XN), (const bf16_t*)(ws + WS_WIN) + (size_t)NIN1 * 1024, Ml, 3072, opq(1024), 1024}; StaticOrder S; S.init(Ml, 3072, G, bid);
            EpiGate E{(bf16_t*)(ws + WS_G)};
            gemm_phase<EpiGate, StaticOrder, true, true>(lds, g, S, E);
        PH_END
        PH_BEGIN
            StaticOrder S; S.init(Ml, 1024, G, bid);
            { Gemm g{(const bf16_t*)(ws + WS_YA), (const bf16_t*)(ws + WS_PRJ), Ml, 1024, opq(512), 512}; EpiMerge<0> E{(const bf16_t*)(ws + WS_G), (bf16_t*)(ws + WS_MF), (bf16_t*)(ws + WS_MB)};
              gemm_phase<EpiMerge<0>, StaticOrder, true, true>(lds, g, S, E); }
            { Gemm g{(const bf16_t*)(ws + WS_YB), (const bf16_t*)(ws + WS_PRJ) + 1024 * 512, Ml, 1024, opq(512), 512}; EpiMerge<1> E{(const bf16_t*)(ws + WS_G), (bf16_t*)(ws + WS_MF), (bf16_t*)(ws + WS_MB)};
              gemm_phase<EpiMerge<1>, StaticOrder, true, true>(lds, g, S, E); }
            { Gemm g{(const bf16_t*)(ws + WS_YC), (const bf16_t*)(ws + WS_PRJ) + 2 * 1024 * 512, Ml, 1024, opq(512), 512}; EpiMerge<2> E{(const bf16_t*)(ws + WS_G), (bf16_t*)(ws + WS_MF), (bf16_t*)(ws + WS_MB)};
              gemm_phase<EpiMerge<2>, StaticOrder, true, true>(lds, g, S, E); }
        PH_END
        PH_BEGIN
            Gemm g{(const bf16_t*)(ws + WS_MB), (const bf16_t*)(ws + WS_WOUT), Ml, 1024, opq(1024), 1024}; StaticOrder S; S.init(Ml, 1024, G, bid);
            EpiBf E{(bf16_t*)(ws + WS_MOUT), 1024};
            gemm_phase<EpiBf, StaticOrder, true, true>(lds, g, S, E);
        PH_END
        PH_BEGIN
            residual_phase(p, (const bf16_t*)(ws + WS_MOUT), nullptr, nullptr, layer == 0, layer, 2, p.in[7] + layer * 1024, true, p.in[8] + layer * 1024, layer, 3, layer == 1, Ml, gw, NGW, lane);
            if (layer == 0) convert_layer_weights(p, 1, lds, gw, NGW, wave, lane);
            else convert_moe_weights(p, lds, gw, NGW, wave, lane);
        PH_END
        if (layer == 0) {
            PH_BEGIN
                Gemm g{(const bf16_t*)(ws + WS_XN), (const bf16_t*)(ws + WS_FGU), NTOK, 2 * D_FF, opq(1024), 1024}; StaticOrder S; S.init(NTOK, 2 * D_FF, G, bid);
                EpiSwiglu E{(bf16_t*)(ws + WS_HID), D_FF, 1 << 20, 0};
                gemm_phase<EpiSwiglu, StaticOrder, true, true>(lds, g, S, E);
            PH_END
            PH_BEGIN
                Gemm g{(const bf16_t*)(ws + WS_HID), (const bf16_t*)(ws + WS_FD), NTOK, 1024, opq(D_FF), D_FF}; StaticOrder S; S.init(NTOK, 1024, G, bid);
                EpiBf E{(bf16_t*)(ws + WS_MF), 1024};
                gemm_phase<EpiBf, StaticOrder, true, true>(lds, g, S, E);
            PH_END
            PH_BEGIN
                residual_phase(p, (const bf16_t*)(ws + WS_MF), nullptr, nullptr, false, 0, 5, p.in[9], true, p.in[6] + 1024, 1, 0, false, NTOK, gw, NGW, lane);
            PH_END
        }
    }
    {
        {
            PH_BEGIN
                const unsigned* cnt = (const unsigned*)(ws + WS_CTL) + CW_CNT; int ts[9]; ts[0] = 0;
#pragma unroll
                for (int e = 0; e < 8; ++e) ts[e + 1] = ts[e] + (int)((__hip_atomic_load(cnt + e, __ATOMIC_RELAXED, __HIP_MEMORY_SCOPE_AGENT) + 255u) >> 8);
                const int* LIST = (const int*)(ws + WS_LIST); const bf16_t* XN = (const bf16_t*)(ws + WS_XN2); bf16_t* XG = (bf16_t*)(ws + WS_XG);
                for (int r = gw; r < ts[8] * 256; r += NGW) {
                    const int tile = r >> 8; int e = 0;
#pragma unroll
                    for (int q = 1; q < 8; ++q) e += (tile >= ts[q]) ? 1 : 0;
                    int tse = 0;
#pragma unroll
                    for (int q = 0; q < 8; ++q) tse = (q == e) ? ts[q] : tse;
                    const int slot = r - tse * 256;
                    u32x4 v0 = (u32x4){0u, 0u, 0u, 0u}, v1 = v0;
                    if (slot < (int)cnt[e]) { const int tk = LIST[e * 16384 + slot]; const u32x4* src = (const u32x4*)(XN + (size_t)(tk >> 1) * 1024); v0 = src[lane]; v1 = src[lane + 64]; }
                    u32x4* dst = (u32x4*)(XG + (size_t)r * 1024); dst[lane] = v0; dst[lane + 64] = v1;
                }
            PH_END
            PH_BEGIN
                const unsigned* cnt = (const unsigned*)(ws + WS_CTL) + CW_CNT; int ts[9]; ts[0] = 0;
#pragma unroll
                for (int e = 0; e < 8; ++e) ts[e + 1] = ts[e] + (int)((__hip_atomic_load(cnt + e, __ATOMIC_RELAXED, __HIP_MEMORY_SCOPE_AGENT) + 255u) >> 8);
                MoeSched S;
#pragma unroll
                for (int e = 0; e < 9; ++e) S.ts[e] = ts[e];
                S.pm_lo = 0; S.pm_hi = ts[8]; S.npn = 28; S.G = G; S.c = bid; S.a_local = false;
                Gemm g{(const bf16_t*)(ws + WS_XG), (const bf16_t*)(ws + WS_MGU), 0, 0, opq(1024), 1024};
                EpiSwiglu E{(bf16_t*)(ws + WS_HIDM), D_FFE, 28, 0};
                gemm_phase<EpiSwiglu, MoeSched, true, true>(lds, g, S, E);
            PH_END
            PH_BEGIN
                const unsigned* cnt = (const unsigned*)(ws + WS_CTL) + CW_CNT; int ts[9]; ts[0] = 0;
#pragma unroll
                for (int e = 0; e < 8; ++e) ts[e + 1] = ts[e] + (int)((__hip_atomic_load(cnt + e, __ATOMIC_RELAXED, __HIP_MEMORY_SCOPE_AGENT) + 255u) >> 8);
                MoeSched S;
#pragma unroll
                for (int e = 0; e < 9; ++e) S.ts[e] = ts[e];
                S.pm_lo = 0; S.pm_hi = ts[8]; S.npn = 4; S.G = G; S.c = bid; S.a_local = false;
                Gemm g{(const bf16_t*)(ws + WS_HIDM), (const bf16_t*)(ws + WS_MD), 0, 0, opq(D_FFE), D_FFE};
                EpiMoeDown E; E.FS = (bf16_t*)(ws + WS_FACC); E.slot1_off = ((long)WS_MGU - (long)WS_FACC) / 2; E.LIST = (const int*)(ws + WS_LIST); E.WTS = (const float*)(ws + WS_WTS); E.cnt = cnt; E.pm_lo = 0;
#pragma unroll
                for (int e = 0; e < 9; ++e) E.ts[e] = ts[e];
                gemm_phase<EpiMoeDown, MoeSched, true, true>(lds, g, S, E);
            PH_END
            PH_BEGIN
                residual_phase(p, (const bf16_t*)(ws + WS_FACC), (const bf16_t*)(ws + WS_MGU), nullptr, false, 1, 5, p.in[9] + 1024, false, nullptr, 0, 0, false, NLAT, gw, NGW, lane);
            PH_END
        }
    }
#undef PH_BEGIN
#undef PH_END
}

extern "C" void kernel_launch(void* const* d_in, const int* in_sizes, int n_in, void* d_out, int out_size, void* d_ws, size_t ws_size, hipStream_t stream) {
    static int grid = 0;
    if (grid == 0) {
        if (n_in != 37 || out_size != NLAT * DM || ws_size < WS_NEED) { fprintf(stderr, "kernel_launch: unexpected shapes (n_in %d out %d ws %zu need %zu)\n", n_in, out_size, ws_size, (size_t)WS_NEED); grid = -1; return; }
        int dev = 0, cus = 0, per_cu = 0;
        (void)hipGetDevice(&dev);
        (void)hipDeviceGetAttribute(&cus, hipDeviceAttributeMultiprocessorCount, dev);
        (void)hipFuncSetAttribute((const void*)mk_fwd, hipFuncAttributeMaxDynamicSharedMemorySize, LDS_BYTES);
        (void)hipOccupancyMaxActiveBlocksPerMultiprocessor(&per_cu, (const void*)mk_fwd, NTHREADS, LDS_BYTES);
        if (per_cu < 1) { fprintf(stderr, "kernel_launch: occupancy query reports %d blocks per CU\n", per_cu); grid = -1; return; }
        grid = cus;
        fprintf(stderr, "kernel_launch: grid %d (cus %d, per_cu %d), ws %zu\n", grid, cus, per_cu, ws_size);
    }
    if (grid < 0) return;
    (void)hipMemsetAsync((char*)d_ws + WS_CTL, 0, CTL_BYTES, stream);
    Params prm{};
    for (int i = 0; i < 37; ++i) prm.in[i] = (const float*)d_in[i];
    prm.out = (float*)d_out; prm.ws = (unsigned char*)d_ws;
#if MK_MULTI
    for (int ph = 0; ph < N_PHASES; ++ph) { prm.ph_lo = ph; prm.ph_hi = ph + 1; hipLaunchKernelGGL(mk_fwd, dim3(grid), dim3(NTHREADS), LDS_BYTES, stream, prm); }
#else
    prm.ph_lo = 0; prm.ph_hi = 1 << 20;
    void* args[] = {&prm};
    hipError_t e = hipLaunchCooperativeKernel((const void*)mk_fwd, dim3(grid), dim3(NTHREADS), args, LDS_BYTES, stream);
    if (e != hipSuccess) fprintf(stderr, "kernel_launch: cooperative launch failed: %s (grid %d)\n", hipGetErrorString(e), grid);
#endif
}
```

```cpp
#include <hip/hip_runtime.h>
#include <hip/hip_cooperative_groups.h>
#include <cstdio>
#include <cstdint>
namespace cg = cooperative_groups;
namespace pg8 {
#define PG8_LAS __attribute__((address_space(3)))
typedef unsigned short bf16_t;
typedef short bf16x8 __attribute__((ext_vector_type(8)));
typedef float f32x4 __attribute__((ext_vector_type(4)));
typedef unsigned u32x4 __attribute__((ext_vector_type(4)));
constexpr int BM = 256, BK = 64, HALF = 128, HTB = HALF * BK * 2  , STAGE_BYTES = 8 * HTB, NXCD = 8, WGM = 8;

__host__ __device__ __forceinline__ int lds_byte(int r, int c) { const int st = (r >> 4) * 2 + (c >> 5), rr = r & 15, cc = c & 31, ob = rr * 64 + cc * 2; return st * 1024 + (ob ^ (((ob >> 9) & 1) << 5)); }
__host__ __device__ __forceinline__ void stage_rc(int b, int& R, int& C) { const int st = b / 1024, sb = b % 1024, swz = sb ^ (((sb >> 9) & 1) << 5); R = (st >> 1) * 16 + swz / 64; C = (st & 1) * 32 + (swz % 64) / 2; }
__host__ __device__ __forceinline__ int perm32(int rho) { const int n = rho >> 4, i = rho & 15; return 8 * (i >> 2) + 4 * n + (i & 3); }

struct Unit { int pm, pn, koff, tail; };
struct Gemm { const bf16_t* A; const bf16_t* Bt; int M, N, K, ld; };

struct StaticOrder {
    int nM, nN, nwg, G, c;
    __host__ __device__ void init(int M, int N, int G_, int c_) { nM = M / BM; nN = N / BM; nwg = nM * nN; G = G_; c = c_; }
    __host__ __device__ bool next(int i, Unit& u) const {
        const long L = (long)i * G + c; if (L >= nwg) return false;
        int wgid = (int)L; { const int q = nwg / NXCD, r = nwg % NXCD, xcd = wgid % NXCD, off = wgid / NXCD; wgid = (xcd < r ? xcd * (q + 1) : r * (q + 1) + (xcd - r) * q) + off; }
        const int nig = WGM * nN, gid = wgid / nig, fm = gid * WGM, gsz = (nM - fm) < WGM ? (nM - fm) : WGM;
        u.pm = fm + ((wgid % nig) % gsz); u.pn = (wgid % nig) / gsz; u.koff = 0; u.tail = -1; return true;
    }
    __device__ __forceinline__ void a_ready(const Unit&) const {}
    __device__ __forceinline__ void done(const Unit&) const {}
};

__device__ __forceinline__ unsigned cvt_pk_bf16(float lo, float hi) { unsigned r; asm volatile("v_cvt_pk_bf16_f32 %0, %1, %2" : "=v"(r) : "v"(lo), "v"(hi)); return r; }
typedef float f32x2 __attribute__((ext_vector_type(2)));
template <class Epi, class Sched, bool ALIGN_EPI = false, bool SP2 = false>
__device__ __forceinline__ void gemm_phase(PG8_LAS unsigned char* lds, const Gemm g, const Sched& S, const Epi& E) {
    int tid_ = threadIdx.x; asm volatile("" : "+v"(tid_)); const int tid = tid_, wid = __builtin_amdgcn_readfirstlane(tid >> 6), lane = tid & 63, wr = wid >> 2, wc = wid & 3, fr = lane & 15, fq = lane >> 4;
    const int K = g.ld, nt = g.K / BK;
    unsigned voffA[2], voffB[2];
#pragma unroll
    for (int i = 0; i < 2; ++i) { int R, C; stage_rc(tid * 16 + i * 8192, R, C); const int Rb = Epi::PERM ? ((R & ~31) + perm32(R & 31)) : R;
        voffA[i] = (unsigned)(R * K + C) * 2u; voffB[i] = (unsigned)(Rb * K + C) * 2u; }
    const size_t kstep = (size_t)(BK * 2);
    const size_t hstep = (size_t)HALF * K * 2;
    const size_t tstep = 2 * hstep;
    const unsigned ldsw = (unsigned)wid * 1024u;
    const int aoff = lds_byte(wr * 64 + fr, fq * 8), boff = lds_byte(wc * 32 + fr, fq * 8);
#define PG8_SA(b, h) (((b) * 2 + (h)) * HTB)
#define PG8_SB(b, h) ((4 + (b) * 2 + (h)) * HTB)
#define PG8_STAGE(bufoff, gbase, voff) do { _Pragma("unroll") for (int _i = 0; _i < 2; ++_i) \
        __builtin_amdgcn_global_load_lds((const unsigned*)((const char*)(gbase) + (voff)[_i]), (PG8_LAS unsigned*)(lds + (bufoff) + ldsw + _i * 8192), 16, 0, 0); } while (0)
#define PG8_LDA(dst, b, h) do { _Pragma("unroll") for (int m = 0; m < 4; ++m) _Pragma("unroll") for (int k = 0; k < 2; ++k) dst[m][k] = *(const PG8_LAS bf16x8*)(lds + PG8_SA(b, h) + aoff + m * 2048 + k * 1024); } while (0)
#define PG8_LDB(dst, b, h) do { _Pragma("unroll") for (int n = 0; n < 2; ++n) _Pragma("unroll") for (int k = 0; k < 2; ++k) dst[n][k] = *(const PG8_LAS bf16x8*)(lds + PG8_SB(b, h) + boff + n * 2048 + k * 1024); } while (0)
#define PG8_MMA(ai, bj, At, Bt) do { __builtin_amdgcn_s_setprio(1); _Pragma("unroll") for (int m = 0; m < 4; ++m) _Pragma("unroll") for (int n = 0; n < 2; ++n) _Pragma("unroll") for (int k = 0; k < 2; ++k) \
        acc[ai][bj][m][n] = __builtin_amdgcn_mfma_f32_16x16x32_bf16(Bt[n][k], At[m][k], acc[ai][bj][m][n], 0, 0, 0); __builtin_amdgcn_s_setprio(0); } while (0)
#define PG8_WAIT_V(n) asm volatile("s_waitcnt vmcnt(" #n ")" ::: "memory")
#define PG8_WAIT_L(n) asm volatile("s_waitcnt lgkmcnt(" #n ")" ::: "memory")
#define PG8_BAR __builtin_amdgcn_s_barrier()
#define PG8_SCHED __builtin_amdgcn_sched_barrier(0)
    Unit cur, nxt; int ui = 0;
    if (!S.next(0, cur)) return;
    f32x4 acc[2][2][4][2];
#pragma unroll
    for (int a = 0; a < 2; ++a)
#pragma unroll
        for (int b = 0; b < 2; ++b)
#pragma unroll
            for (int m = 0; m < 4; ++m)
#pragma unroll
                for (int n = 0; n < 2; ++n) acc[a][b][m][n] = (f32x4){0.f, 0.f, 0.f, 0.f};
    bf16x8 At[4][2], B0[2][2], B1[2][2];
    const char* cA = (const char*)g.A + (size_t)cur.pm * tstep + (size_t)cur.koff * 2; const char* cB = (const char*)g.Bt + (size_t)cur.pn * tstep + (size_t)cur.koff * 2;
    S.a_ready(cur);
    if constexpr (SP2) {
        PG8_STAGE(PG8_SB(0, 0), cB, voffB); PG8_STAGE(PG8_SB(0, 1), cB + hstep, voffB); PG8_STAGE(PG8_SA(0, 0), cA, voffA); PG8_STAGE(PG8_SA(0, 1), cA + hstep, voffA);
        if (wr == 1) PG8_BAR;
        PG8_WAIT_V(2); PG8_BAR;
        PG8_STAGE(PG8_SB(1, 0), cB + kstep, voffB); PG8_STAGE(PG8_SA(1, 0), cA + kstep, voffA); PG8_STAGE(PG8_SB(1, 1), cB + hstep + kstep, voffB);
        PG8_WAIT_V(6); PG8_BAR;
    } else {
        PG8_STAGE(PG8_SB(0, 0), cB, voffB); PG8_STAGE(PG8_SA(0, 0), cA, voffA); PG8_STAGE(PG8_SB(0, 1), cB + hstep, voffB); PG8_STAGE(PG8_SA(0, 1), cA + hstep, voffA);
        if (wr == 1) PG8_BAR;
        PG8_WAIT_V(4); PG8_BAR;
        PG8_STAGE(PG8_SB(1, 0), cB + kstep, voffB); PG8_STAGE(PG8_SA(1, 0), cA + kstep, voffA); PG8_STAGE(PG8_SB(1, 1), cB + hstep + kstep, voffB);
        PG8_WAIT_V(6); PG8_BAR;
    }
    for (;;) {
        const bool has_next = S.next(ui + 1, nxt);
        const char* nA = has_next ? (const char*)g.A + (size_t)nxt.pm * tstep + (size_t)nxt.koff * 2 : cA; const char* nB = has_next ? (const char*)g.Bt + (size_t)nxt.pn * tstep + (size_t)nxt.koff * 2 : cB;
        for (int t = 0; t < nt; t += 2) {
            const bool last = (t == nt - 2);
            const char* a1 = cA + (size_t)(t + 1) * kstep;
            const char* a2 = last ? nA : cA + (size_t)(t + 2) * kstep; const char* b2 = last ? nB : cB + (size_t)(t + 2) * kstep;
            const char* a3 = a2 + kstep; const char* b3 = b2 + kstep;
            if (last && has_next) S.a_ready(nxt);
            if constexpr (SP2) {
            PG8_LDB(B0, 0, 0); PG8_LDB(B1, 0, 1); PG8_SCHED; PG8_LDA(At, 0, 0); PG8_STAGE(PG8_SA(1, 1), a1 + hstep, voffA);
            PG8_WAIT_V(8); PG8_WAIT_L(0); PG8_BAR; PG8_MMA(0, 0, At, B0); PG8_MMA(0, 1, At, B1); PG8_BAR; PG8_SCHED;
            PG8_LDA(At, 0, 1); PG8_STAGE(PG8_SB(0, 0), b2, voffB); PG8_STAGE(PG8_SB(0, 1), b2 + hstep, voffB); PG8_STAGE(PG8_SA(0, 0), a2, voffA);
            PG8_WAIT_V(8); PG8_WAIT_L(0); PG8_BAR; PG8_MMA(1, 0, At, B0); PG8_MMA(1, 1, At, B1); PG8_BAR; PG8_SCHED;
            PG8_LDB(B0, 1, 0); PG8_LDB(B1, 1, 1); PG8_SCHED; PG8_LDA(At, 1, 0); PG8_STAGE(PG8_SA(0, 1), a2 + hstep, voffA);
            PG8_WAIT_V(8); PG8_WAIT_L(0); PG8_BAR; PG8_MMA(0, 0, At, B0); PG8_MMA(0, 1, At, B1); PG8_BAR; PG8_SCHED;
            PG8_LDA(At, 1, 1); PG8_STAGE(PG8_SB(1, 0), b3, voffB); PG8_STAGE(PG8_SB(1, 1), b3 + hstep, voffB); PG8_STAGE(PG8_SA(1, 0), a3, voffA);
            PG8_WAIT_V(8); PG8_WAIT_L(0); PG8_BAR; PG8_MMA(1, 0, At, B0); PG8_MMA(1, 1, At, B1); PG8_BAR; PG8_SCHED;
            } else {
            PG8_LDB(B0, 0, 0); PG8_SCHED; PG8_LDA(At, 0, 0); PG8_STAGE(PG8_SA(1, 1), a1 + hstep, voffA);
            PG8_WAIT_L(8); PG8_BAR; PG8_WAIT_L(0); PG8_MMA(0, 0, At, B0); PG8_BAR; PG8_SCHED;
            PG8_LDB(B1, 0, 1); PG8_STAGE(PG8_SB(0, 0), b2, voffB);
            PG8_BAR; PG8_WAIT_L(0); PG8_MMA(0, 1, At, B1); PG8_BAR;
            PG8_LDA(At, 0, 1); PG8_STAGE(PG8_SA(0, 0), a2, voffA);
            PG8_BAR; PG8_WAIT_L(0); PG8_MMA(1, 0, At, B0); PG8_BAR; PG8_SCHED;
            PG8_STAGE(PG8_SB(0, 1), b2 + hstep, voffB);
            PG8_WAIT_V(6); PG8_BAR; PG8_MMA(1, 1, At, B1); PG8_BAR;
            PG8_LDB(B0, 1, 0); PG8_SCHED; PG8_LDA(At, 1, 0); PG8_STAGE(PG8_SA(0, 1), a2 + hstep, voffA);
            PG8_WAIT_L(8); PG8_BAR; PG8_WAIT_L(0); PG8_MMA(0, 0, At, B0); PG8_BAR; PG8_SCHED;
            PG8_LDB(B1, 1, 1); PG8_STAGE(PG8_SB(1, 0), b3, voffB);
            PG8_BAR; PG8_WAIT_L(0); PG8_MMA(0, 1, At, B1); PG8_BAR;
            PG8_LDA(At, 1, 1); PG8_STAGE(PG8_SA(1, 0), a3, voffA);
            PG8_BAR; PG8_WAIT_L(0); PG8_MMA(1, 0, At, B0); PG8_BAR; PG8_SCHED;
            PG8_STAGE(PG8_SB(1, 1), b3 + hstep, voffB);
            PG8_WAIT_V(6); PG8_BAR; PG8_MMA(1, 1, At, B1); PG8_BAR;
            }
        }
        if constexpr (ALIGN_EPI) { if (wr == 0) PG8_BAR; }
        if constexpr (!Epi::AFTER_DRAIN) { E(acc, cur, wr, wc, fr, fq); S.done(cur); }
        if (!has_next) break;
#pragma unroll
        for (int a = 0; a < 2; ++a)
#pragma unroll
            for (int b = 0; b < 2; ++b)
#pragma unroll
                for (int m = 0; m < 4; ++m)
#pragma unroll
                    for (int n = 0; n < 2; ++n) acc[a][b][m][n] = (f32x4){0.f, 0.f, 0.f, 0.f};
        cur = nxt; cA = nA; cB = nB; ++ui;
        if constexpr (ALIGN_EPI) { if (wr == 1) PG8_BAR; }
    }
    PG8_WAIT_V(0);
    if constexpr (!ALIGN_EPI) { if (wr == 0) PG8_BAR; }
    PG8_BAR;
    if constexpr (Epi::AFTER_DRAIN) { E.fused(acc, cur, wr, wc, fr, fq, lds, wid, lane); S.done(cur); }
#undef PG8_SA
#undef PG8_SB
#undef PG8_STAGE
#undef PG8_LDA
#undef PG8_LDB
#undef PG8_MMA
#undef PG8_WAIT_V
#undef PG8_WAIT_L
#undef PG8_BAR
#undef PG8_SCHED
}
}

#define LAS __attribute__((address_space(3)))
typedef unsigned short bf16_t;
typedef short bf16x8 __attribute__((ext_vector_type(8)));
typedef float f32x4 __attribute__((ext_vector_type(4)));
typedef float f32x16 __attribute__((ext_vector_type(16)));
typedef unsigned u32x4 __attribute__((ext_vector_type(4)));
typedef unsigned u32x2 __attribute__((ext_vector_type(2)));

constexpr int NTHREADS = 512, NWAVES = 8;
constexpr int DM = 1024, SEQ = 8192, CTXL = 256, NLAT = 2 * SEQ, NCTX = 2 * CTXL, NTOK = NLAT + NCTX, KEYS = SEQ + CTXL;
constexpr int D_IN = 7296, D_FF = 2816, D_FFE = 3584, NEXP = 8;
constexpr int IC_QS = 0, IC_KS = 512, IC_RW = 640, IC_QD = 2560, IC_KD = 3072, PP = 3584, IC_VS = 3584, IC_VD = 3712, IC_PAD = 4224, NIN1 = 4352, WIN_ROWS = 7424;
constexpr int ST_SLOTS = 9;
constexpr int MOE_TILES = 136, MOE_HALF = 68;

constexpr size_t MiB = 1u << 20;
constexpr size_t WS_CTL = 0, CTL_BYTES = 1 * MiB;
constexpr size_t WS_MODS = 1 * MiB;
constexpr size_t WS_ROPE = 1 * MiB + 256 * 1024;
constexpr size_t WS_HCTX = 2 * MiB;
constexpr size_t WS_LIST = 4 * MiB;
constexpr size_t WS_WTS = 4 * MiB + 512 * 1024;
constexpr size_t WS_WIN = 6 * MiB;
constexpr size_t WS_PRJ = WS_WIN + (size_t)WIN_ROWS * 1024 * 2;
constexpr size_t WS_WOUT = WS_PRJ + 3 * MiB;
constexpr size_t WS_LORA = WS_WOUT + 2 * MiB;
constexpr size_t WS_XN = 28 * MiB;
constexpr size_t WS_P = 61 * MiB;
constexpr size_t WS_VTS = 177 * MiB;
constexpr size_t WS_VTD = WS_VTS + 4608 * 1024;
constexpr size_t WS_ST = 198 * MiB;
constexpr size_t WS_YA = 495 * MiB;
constexpr size_t WS_YB = WS_YA + 16896ull * 512 * 2;
constexpr size_t WS_YC = WS_YB + 16896ull * 512 * 2;
constexpr size_t WS_END = WS_YC + 16896ull * 512 * 2;
constexpr size_t WS_G = WS_ST;
constexpr size_t WS_MF = WS_ST + 99 * MiB;
constexpr size_t WS_MB = WS_ST + 165 * MiB;
constexpr size_t WS_MOUT = WS_ST + 198 * MiB;
constexpr size_t WS_FGU = WS_VTS;
constexpr size_t WS_FD = WS_VTS + 11 * MiB;
constexpr size_t WS_HID = WS_P;
constexpr size_t WS_XN2 = 495 * MiB;
constexpr size_t WS_MGU = 6 * MiB;
constexpr size_t WS_MD = 118 * MiB;
constexpr size_t WS_XG = 174 * MiB;
constexpr size_t WS_FACC = 242 * MiB;
constexpr size_t WS_HIDM = 306 * MiB;
static_assert(WS_LORA + 2560 * 384 * 2 <= WS_XN && WS_XN + 16896ull * 1024 * 2 <= WS_P && WS_P + 16896ull * PP * 2 <= WS_VTS && WS_VTD + 2ull * 4 * 128 * KEYS * 2 <= WS_ST, "ws map 1");
static_assert(WS_ST + 16896ull * 8 * ST_SLOTS * 64 * 4 <= WS_YA && WS_END <= 545 * MiB, "ws map 2");
static_assert(WS_G + 16896ull * 3072 * 2 <= WS_MF && WS_MF + 16896ull * 1024 * 4 <= WS_MB && WS_MB + 16896ull * 1024 * 2 <= WS_MOUT && WS_MOUT + 16896ull * 1024 * 4 <= WS_YA, "ws map 3");
static_assert(WS_FGU + 5632ull * 1024 * 2 <= WS_FD && WS_FD + 1024ull * 2816 * 2 <= WS_ST && WS_HID + 16896ull * 2816 * 2 <= WS_VTS, "ws map 4");
static_assert(WS_MGU + 8ull * 7168 * 1024 * 2 <= WS_MD && WS_MD + 8ull * 1024 * 3584 * 2 <= WS_XG && WS_XG + 34816ull * 1024 * 2 <= WS_FACC && WS_FACC + 16384ull * 1024 * 4 <= WS_HIDM && WS_HIDM + 136ull * 256 * 3584 * 2 <= 560 * MiB, "ws map 5");
static_assert(WS_FACC + 16384ull * 1024 * 4 <= WS_MOUT && WS_XN2 + 16384ull * 1024 * 2 <= 560 * MiB && WS_XN2 >= WS_MOUT + 16896ull * 1024 * 4, "expert weights / gathered rows / accumulator must not touch MOUT or XN2 while they are live");
constexpr size_t WS_NEED = 560 * MiB;
constexpr int CW_CNT = 0;
constexpr int CW_Q0 = 64, CW_Q1 = 128;

constexpr int LDS_BYTES = 147456;

__device__ __forceinline__ unsigned f2bf(float f) { unsigned u = __builtin_bit_cast(unsigned, f); return (u + 0x7fffu + ((u >> 16) & 1u)) >> 16; }
typedef float f32x2_t __attribute__((ext_vector_type(2))); typedef __bf16 bf16x2_t __attribute__((ext_vector_type(2)));
__device__ __forceinline__ unsigned pk2(float lo, float hi) { const f32x2_t v = {lo, hi}; return __builtin_bit_cast(unsigned, __builtin_convertvector(v, bf16x2_t)); }
__device__ __forceinline__ float bflo(unsigned w) { return __uint_as_float(w << 16); }
__device__ __forceinline__ float bfhi(unsigned w) { return __uint_as_float(w & 0xffff0000u); }
__device__ __forceinline__ float wave_sum(float v) {
#pragma unroll
    for (int o = 1; o < 64; o <<= 1) v += __shfl_xor(v, o);
    return v;
}
__device__ __forceinline__ float sigmoidf_(float x) { return 1.0f / (1.0f + __expf(-x)); }
__device__ __forceinline__ float siluf_(float x) { return x / (1.0f + __expf(-x)); }
#define LDS_WAIT() asm volatile("s_waitcnt lgkmcnt(0)" ::: "memory")

struct Params {
    const float* in[37];
    float* out;
    unsigned char* ws;
    int ph_lo, ph_hi;
};

template <class F>
__device__ __forceinline__ void transpose_item(const float* __restrict__ W, int ldw, int k0, int n0, bf16_t* __restrict__ WT, int ldt, int dcol0, F rowmap, LAS float* scr, int lane) {
#pragma unroll 8
    for (int i = 0; i < 32; ++i) { const int kk = 2 * i + (lane >> 5); scr[kk * 33 + (lane & 31)] = W[(size_t)(k0 + kk) * ldw + n0 + (lane & 31)]; }
    LDS_WAIT(); asm volatile("" ::: "memory");
    const int c = lane & 7;
#pragma unroll
    for (int j = 0; j < 4; ++j) {
        const int n = (lane >> 3) + 8 * j; const LAS float* s = scr + (8 * c) * 33 + n;
        u32x4 o; o.x = pk2(s[0 * 33], s[1 * 33]); o.y = pk2(s[2 * 33], s[3 * 33]); o.z = pk2(s[4 * 33], s[5 * 33]); o.w = pk2(s[6 * 33], s[7 * 33]);
        const int row = rowmap(n0 + n);
        if (row >= 0) *(u32x4*)(WT + (size_t)row * ldt + dcol0 + k0 + 8 * c) = o;
    }
    LDS_WAIT(); asm volatile("" ::: "memory");
}
struct RowId { __device__ __forceinline__ int operator()(int n) const { return n; } };
struct RowOff { int off; __device__ __forceinline__ int operator()(int n) const { return n + off; } };
struct RowWin {
    __device__ __forceinline__ int operator()(int n) const {
        if (n < 640) return n;
        if (n < 768) return n - 640 + IC_VS;
        if (n < 2688) return n - 768 + IC_RW;
        if (n < 3712) return n - 2688 + IC_QD;
        if (n < 4224) return n - 3712 + IC_VD;
        return n - 4224 + NIN1;
    }
};
struct RowGU { int up; __device__ __forceinline__ int operator()(int j) const { return (j >> 7) * 256 + (j & 127) + 128 * up; } };

template <class F>
__device__ __forceinline__ void convert_matrix(const float* W, int K, int N, bf16_t* WT, int ldt, int dcol0, F rowmap, LAS float* scr, int lane, int gw, int NGW) {
    const int nblk = N / 32, items = (K / 64) * nblk;
    for (int it = gw; it < items; it += NGW) { const int kb = it / nblk, nb = it % nblk; transpose_item(W, N, kb * 64, nb * 32, WT, ldt, dcol0, rowmap, scr, lane); }
}

__device__ __forceinline__ void lora_region(bf16_t* __restrict__ LT, const float* __restrict__ src, int row0, int klo, int kn, int gw, int NGW, int lane) {
    for (int i = gw * 64 + lane; i < 512 * 48; i += NGW * 64) {
        const int nn = i / 48, kc = (i % 48) * 8;
        u32x4 o = (u32x4){0u, 0u, 0u, 0u};
        if (kc >= klo && kc < klo + kn) {
            const float* s = src + (size_t)(kc - klo) * 512 + nn;
            o.x = pk2(s[0], s[512]); o.y = pk2(s[2 * 512], s[3 * 512]); o.z = pk2(s[4 * 512], s[5 * 512]); o.w = pk2(s[6 * 512], s[7 * 512]);
        }
        *(u32x4*)(LT + (size_t)(row0 + nn) * 384 + kc) = o;
    }
}
__device__ __forceinline__ void convert_layer_weights(const Params& p, int layer, LAS unsigned char* lds, int gw, int NGW, int wave, int lane) {
    LAS float* scr = (LAS float*)(lds + wave * 16384);
    unsigned char* ws = p.ws;
    bf16_t* WIN = (bf16_t*)(ws + WS_WIN);
    convert_matrix(p.in[10] + (size_t)layer * 1024 * D_IN, 1024, D_IN, WIN, 1024, 0, RowWin(), scr, lane, gw, NGW);
    for (int i = gw * 64 + lane; i < (NIN1 - IC_PAD) * 1024 / 8; i += NGW * 64) *(u32x4*)(WIN + (size_t)IC_PAD * 1024 + (size_t)i * 8) = (u32x4){0u, 0u, 0u, 0u};
    for (int j = 0; j < 3; ++j)
        convert_matrix(p.in[26 + j] + (size_t)layer * 512 * 1024, 512, 1024, (bf16_t*)(ws + WS_PRJ) + (size_t)j * 1024 * 512, 512, 0, RowId(), scr, lane, gw, NGW);
    convert_matrix(p.in[29] + (size_t)layer * 1024 * 1024, 1024, 1024, (bf16_t*)(ws + WS_WOUT), 1024, 0, RowId(), scr, lane, gw, NGW);
    bf16_t* LT = (bf16_t*)(ws + WS_LORA);
    lora_region(LT, p.in[15] + ((size_t)layer * 2 + 0) * 64 * 512, 0, 0, 64, gw, NGW, lane);
    lora_region(LT, p.in[15] + ((size_t)layer * 2 + 1) * 64 * 512, 512, 64, 64, gw, NGW, lane);
    lora_region(LT, p.in[17] + ((size_t)layer * 2 + 0) * 64 * 512, 1024, 128, 64, gw, NGW, lane);
    lora_region(LT, p.in[17] + ((size_t)layer * 2 + 1) * 64 * 512, 1536, 192, 64, gw, NGW, lane);
    lora_region(LT, p.in[18] + (size_t)layer * 128 * 512, 2048, 256, 128, gw, NGW, lane);
}
__device__ __forceinline__ void convert_ffn_weights(const Params& p, LAS unsigned char* lds, int gw, int NGW, int wave, int lane) {
    LAS float* scr = (LAS float*)(lds + wave * 16384);
    bf16_t* GU = (bf16_t*)(p.ws + WS_FGU); bf16_t* FD = (bf16_t*)(p.ws + WS_FD);
    convert_matrix(p.in[30], 1024, D_FF, GU, 1024, 0, RowGU{0}, scr, lane, gw, NGW);
    convert_matrix(p.in[31], 1024, D_FF, GU, 1024, 0, RowGU{1}, scr, lane, gw, NGW);
    convert_matrix(p.in[32], D_FF, 1024, FD, D_FF, 0, RowId(), scr, lane, gw, NGW);
}
__device__ __forceinline__ void convert_moe_weights(const Params& p, LAS unsigned char* lds, int gw, int NGW, int wave, int lane) {
    LAS float* scr = (LAS float*)(lds + wave * 16384);
    for (int e = 0; e < NEXP; ++e) {
        bf16_t* GU = (bf16_t*)(p.ws + WS_MGU) + (size_t)e * 7168 * 1024;
        convert_matrix(p.in[34] + (size_t)e * 1024 * D_FFE, 1024, D_FFE, GU, 1024, 0, RowGU{0}, scr, lane, gw, NGW);
        convert_matrix(p.in[35] + (size_t)e * 1024 * D_FFE, 1024, D_FFE, GU, 1024, 0, RowGU{1}, scr, lane, gw, NGW);
        convert_matrix(p.in[36] + (size_t)e * D_FFE * 1024, D_FFE, 1024, (bf16_t*)(p.ws + WS_MD) + (size_t)e * 1024 * D_FFE, D_FFE, 0, RowId(), scr, lane, gw, NGW);
    }
}

__device__ __forceinline__ void adaln_phase(const Params& p, LAS unsigned char* lds, int wave, int lane) {
    LAS float* red = (LAS float*)lds;
    float* MODS = (float*)(p.ws + WS_MODS);
    const float* c = p.in[1]; const float* cc = p.in[3];
    for (int it = blockIdx.x; it < 2 * 96; it += gridDim.x) {
        const int layer = it / 96, n = (it % 96) * 64 + lane;
        const float* W = p.in[4] + (size_t)layer * 1024 * 6144;
        float a0 = 0.f, a1 = 0.f, a2 = 0.f;
        for (int k = wave * 128; k < wave * 128 + 128; ++k) {
            const float w = W[(size_t)k * 6144 + n];
            a0 += siluf_(c[k]) * w; a1 += siluf_(c[1024 + k]) * w; a2 += siluf_(cc[k]) * w;
        }
        red[(wave * 3 + 0) * 64 + lane] = a0; red[(wave * 3 + 1) * 64 + lane] = a1; red[(wave * 3 + 2) * 64 + lane] = a2;
        __syncthreads();
        if (wave < 3) {
            float s = 0.f;
#pragma unroll
            for (int w = 0; w < 8; ++w) s += red[(w * 3 + wave) * 64 + lane];
            MODS[((size_t)layer * 3 + wave) * 6144 + n] = s + p.in[5][(size_t)layer * 6144 + n];
        }
        __syncthreads();
    }
    if (blockIdx.x == gridDim.x - 1) {
        float* rope = (float*)(p.ws + WS_ROPE);
        for (int i = threadIdx.x; i < 128 * 16; i += NTHREADS) {
            const int pos = i >> 4, j = i & 15;
            const float inv = powf(10000.0f, -(float)j / 16.0f);
            const float ang = (float)pos * inv;
            rope[2 * i] = cosf(ang); rope[2 * i + 1] = sinf(ang);
        }
    }
}

__device__ __forceinline__ const float* mods_row(const Params& p, int layer, int m) {
    const int r = m < NLAT ? (m >> 13) : 2;
    return (const float*)(p.ws + WS_MODS) + ((size_t)layer * 3 + r) * 6144;
}
__device__ __forceinline__ void load_row(const float* x, int lane, f32x4 (&v)[4]) {
#pragma unroll
    for (int j = 0; j < 4; ++j) v[j] = ((const f32x4*)x)[lane + 64 * j];
}
__device__ __forceinline__ float row_rstd(const f32x4 (&v)[4]) {
    float s = 0.f;
#pragma unroll
    for (int j = 0; j < 4; ++j) s += (v[j].x * v[j].x + v[j].y * v[j].y) + (v[j].z * v[j].z + v[j].w * v[j].w);
    return 1.0f / sqrtf(wave_sum(s) * (1.0f / 1024.0f) + 1e-6f);
}
__device__ __forceinline__ void normmod(const f32x4 (&h)[4], const float* g, const float* shift, const float* scale, int lane, f32x4 (&a)[4]) {
    const float rstd = row_rstd(h);
#pragma unroll
    for (int j = 0; j < 4; ++j) {
        const f32x4 gg = ((const f32x4*)g)[lane + 64 * j], sh = ((const f32x4*)shift)[lane + 64 * j], sc = ((const f32x4*)scale)[lane + 64 * j];
        a[j] = (h[j] * rstd * gg) * (sc + 1.0f) + sh;
    }
}
__device__ __forceinline__ void store_row_bf16(bf16_t* o, int lane, const f32x4 (&a)[4]) {
#pragma unroll
    for (int j = 0; j < 4; ++j) { u32x2 w; w.x = pk2(a[j].x, a[j].y); w.y = pk2(a[j].z, a[j].w); ((u32x2*)o)[lane + 64 * j] = w; }
}
__device__ __forceinline__ const float* h_in_row(const Params& p, int layer, int m) {
    if (layer == 0) return m < NLAT ? p.in[0] + (size_t)m * 1024 : p.in[2] + (size_t)(m - NLAT) * 1024;
    return m < NLAT ? p.out + (size_t)m * 1024 : (const float*)(p.ws + WS_HCTX) + (size_t)(m - NLAT) * 1024;
}
__device__ __forceinline__ float* h_out_row(const Params& p, int m) { return m < NLAT ? p.out + (size_t)m * 1024 : (float*)(p.ws + WS_HCTX) + (size_t)(m - NLAT) * 1024; }

__device__ __forceinline__ void premix_phase(const Params& p, int layer, bool first, int M, int gw, int NGW, int lane) {
    bf16_t* XN = (bf16_t*)(p.ws + WS_XN);
    for (int m = gw; m < M; m += NGW) {
        const float* hr = first ? h_in_row(p, 0, m) : h_out_row(p, m);
        f32x4 h[4], a[4]; load_row(hr, lane, h);
        const float* md = mods_row(p, layer, m);
        normmod(h, p.in[6] + layer * 1024, md, md + 1024, lane, a);
        store_row_bf16(XN + (size_t)m * 1024, lane, a);
    }
}
__device__ __forceinline__ void load_row_bf16(const bf16_t* x, int lane, f32x4 (&v)[4]) {
#pragma unroll
    for (int j = 0; j < 4; ++j) { const u32x2 w = ((const u32x2*)x)[lane + 64 * j]; v[j] = (f32x4){bflo(w.x), bfhi(w.x), bflo(w.y), bfhi(w.y)}; }
}
__device__ __forceinline__ void residual_phase(const Params& p, const bf16_t* src, const bf16_t* src2, const float* hin_base_layer0, bool hin_is_input, int layer, int gate_idx, const float* g1,
                                               bool write_xn, const float* g2, int mod_layer2, int shift_idx, bool route, int M, int gw, int NGW, int lane) {
    bf16_t* XN = (bf16_t*)(p.ws + (route ? WS_XN2 : WS_XN));
    for (int m = gw; m < M; m += NGW) {
        const float* hr = hin_is_input ? h_in_row(p, 0, m) : h_out_row(p, m);
        f32x4 h[4], s[4]; load_row(hr, lane, h); load_row_bf16(src + (size_t)m * 1024, lane, s);
        if (src2) { f32x4 s2[4]; load_row_bf16(src2 + (size_t)m * 1024, lane, s2);
#pragma unroll
            for (int j = 0; j < 4; ++j) s[j] += s2[j]; }
        const float rstd = row_rstd(s);
        const float* md = mods_row(p, layer, m);
#pragma unroll
        for (int j = 0; j < 4; ++j) {
            const f32x4 gg = ((const f32x4*)g1)[lane + 64 * j], gt = ((const f32x4*)(md + gate_idx * 1024))[lane + 64 * j];
            h[j] = h[j] + gt * (s[j] * rstd * gg);
        }
        float* ho = h_out_row(p, m);
#pragma unroll
        for (int j = 0; j < 4; ++j) ((f32x4*)ho)[lane + 64 * j] = h[j];
        if (write_xn) {
            f32x4 a[4]; const float* md2 = mods_row(p, mod_layer2, m);
            normmod(h, g2, md2 + shift_idx * 1024, md2 + (shift_idx + 1) * 1024, lane, a);
            store_row_bf16(XN + (size_t)m * 1024, lane, a);
            if (route) {
                const float* rw = p.in[33];
                float lg[8] = {0.f, 0.f, 0.f, 0.f, 0.f, 0.f, 0.f, 0.f};
#pragma unroll
                for (int j = 0; j < 4; ++j)
#pragma unroll
                    for (int q = 0; q < 4; ++q) {
                        const int k = 4 * (lane + 64 * j) + q; const float av = a[j][q];
                        const f32x4 w0 = ((const f32x4*)(rw + (size_t)k * 8))[0], w1 = ((const f32x4*)(rw + (size_t)k * 8))[1];
                        lg[0] += av * w0.x; lg[1] += av * w0.y; lg[2] += av * w0.z; lg[3] += av * w0.w; lg[4] += av * w1.x; lg[5] += av * w1.y; lg[6] += av * w1.z; lg[7] += av * w1.w;
                    }
#pragma unroll
                for (int e = 0; e < 8; ++e) lg[e] = wave_sum(lg[e]);
                int i1 = 0; float v1 = lg[0];
#pragma unroll
                for (int e = 1; e < 8; ++e) if (lg[e] > v1) { v1 = lg[e]; i1 = e; }
                int i2 = -1; float v2 = -3.0e38f;
#pragma unroll
                for (int e = 0; e < 8; ++e) if (e != i1 && lg[e] > v2) { v2 = lg[e]; i2 = e; }
                if (lane == 0) {
                    const float w1 = 1.0f / (1.0f + expf(v2 - v1)), w2 = 1.0f - w1;
                    unsigned* cnt = (unsigned*)(p.ws + WS_CTL) + CW_CNT; int* LIST = (int*)(p.ws + WS_LIST); float* WTS = (float*)(p.ws + WS_WTS);
                    const unsigned s1 = atomicAdd(cnt + i1, 1u); LIST[i1 * 16384 + s1] = m * 2; WTS[i1 * 16384 + s1] = w1;
                    const unsigned s2 = atomicAdd(cnt + i2, 1u); LIST[i2 * 16384 + s2] = m * 2 + 1; WTS[i2 * 16384 + s2] = w2;
                }
            }
        }
    }
}

using pg8::Unit;
constexpr float QSCALE = 0.125f * 1.4426950408889634f;
__device__ __forceinline__ u32x2 pack4(const f32x4 v) { u32x2 w; w.x = pk2(v.x, v.y); w.y = pk2(v.z, v.w); return w; }
__device__ __forceinline__ f32x4 unpack4(const u32x2 w) { return (f32x4){bflo(w.x), bfhi(w.x), bflo(w.y), bfhi(w.y)}; }

struct EpiIn {
    static constexpr bool PERM = false, AFTER_DRAIN = false;
    bf16_t* P; bf16_t* VTS; bf16_t* VTD; const float* rope;
    __device__ __forceinline__ void operator()(const f32x4 (&acc)[2][2][4][2], const Unit& u, int wr, int wc, int fr, int fq) const {
#pragma unroll
        for (int ai = 0; ai < 2; ++ai)
#pragma unroll
            for (int m = 0; m < 4; ++m) {
                const int r = u.pm * 256 + ai * 128 + wr * 64 + m * 16 + fr;
                const bool lat = r < NLAT;
                const int t = r & (SEQ - 1);
                const int b = lat ? (r >> 13) : ((r - NLAT) >> 8);
                const int key = lat ? t : SEQ + ((r - NLAT) & 255);
#pragma unroll
                for (int bj = 0; bj < 2; ++bj) {
                    const int c32 = u.pn * 256 + bj * 128 + wc * 32;
                    f32x4 v0 = acc[ai][bj][m][0], v1 = acc[ai][bj][m][1];
                    if (c32 < PP) {
                        const bool rp = (c32 < IC_RW) || (c32 >= IC_QD);
                        if (rp && lat) {
                            const int pos = (c32 & 32) ? (t & 63) : (t >> 6);
                            const f32x4 cs0 = *(const f32x4*)(rope + (pos * 16 + 4 * fq) * 2), cs1 = *(const f32x4*)(rope + (pos * 16 + 4 * fq) * 2 + 4);
                            const f32x4 cc = (f32x4){cs0.x, cs0.z, cs1.x, cs1.z}, sn = (f32x4){cs0.y, cs0.w, cs1.y, cs1.w};
                            const f32x4 o0 = v0 * cc - v1 * sn, o1 = v0 * sn + v1 * cc;
                            v0 = o0; v1 = o1;
                        }
                        if (c32 < IC_KS || (c32 >= IC_QD && c32 < IC_KD)) { v0 = v0 * QSCALE; v1 = v1 * QSCALE; }
                        bf16_t* dst = P + (size_t)r * PP + c32 + 4 * fq;
                        *(u32x2*)dst = pack4(v0); *(u32x2*)(dst + 16) = pack4(v1);
                    } else {
                        const int cv = c32 - PP;
                        bf16_t* vt = nullptr; int dimbase = 0;
                        if (cv < 128) { vt = VTS + (size_t)((b * 2 + (cv >> 6)) * 64) * KEYS; dimbase = cv & 63; }
                        else if (cv < 640) { const int cd = cv - 128; vt = VTD + (size_t)((b * 4 + (cd >> 7)) * 128) * KEYS; dimbase = cd & 127; }
                        if (vt) {
#pragma unroll
                            for (int i = 0; i < 4; ++i) {
                                vt[(size_t)(dimbase + 4 * fq + i) * KEYS + key] = (bf16_t)f2bf(v0[i]);
                                vt[(size_t)(dimbase + 16 + 4 * fq + i) * KEYS + key] = (bf16_t)f2bf(v1[i]);
                            }
                        }
                    }
                }
            }
    }
};

struct EpiLora {
    static constexpr bool PERM = false, AFTER_DRAIN = false;
    float* ST; bf16_t* P; const float* w0; const float* a0; const float* k_a;
    __device__ __forceinline__ void operator()(const f32x4 (&acc)[2][2][4][2], const Unit& u, int wr, int wc, int fr, int fq) const {
        const int reg = u.pn >> 1;
#pragma unroll
        for (int ai = 0; ai < 2; ++ai)
#pragma unroll
            for (int m = 0; m < 4; ++m) {
                const int r = u.pm * 256 + ai * 128 + wr * 64 + m * 16 + fr;
#pragma unroll
                for (int bj = 0; bj < 2; ++bj)
#pragma unroll
                    for (int n = 0; n < 2; ++n) {
                        const int ch = (u.pn & 1) * 256 + bj * 128 + wc * 32 + 16 * n + 4 * fq;
                        const int h = ch >> 6, kidx = ch & 63;
                        float* sp = ST + ((size_t)r * 8 + h) * (ST_SLOTS * 64) + kidx;
                        const f32x4 a = acc[ai][bj][m][n];
                        if (reg < 2) {
                            const f32x4 bias = *(const f32x4*)(w0 + reg * 512 + ch);
                            f32x4 o;
#pragma unroll
                            for (int i = 0; i < 4; ++i) {
                                const float x = -(bias[i] + a[i]);
                                const float sp_ = fmaxf(x, 0.f) + __logf(1.0f + __expf(-fabsf(x)));
                                o[i] = __expf(-__expf(-sp_ - 0.5f));
                            }
                            *(f32x4*)(sp + (3 + 3 * reg) * 64) = o;
                        } else if (reg < 4) {
                            const int d = reg - 2;
                            const f32x4 bias = *(const f32x4*)(a0 + d * 512 + ch), ka = *(const f32x4*)(k_a + ch);
                            const f32x4 kraw = *(const f32x4*)(sp + (5 + 3 * d) * 64), kk = *(const f32x4*)(sp);
                            f32x4 bv, kf;
#pragma unroll
                            for (int i = 0; i < 4; ++i) {
                                const float ag = sigmoidf_(bias[i] + a[i]);
                                bv[i] = -kk[i] * ag; kf[i] = kraw[i] * (1.0f + (ag - 1.0f) * ka[i]);
                            }
                            *(f32x4*)(sp + (4 + 3 * d) * 64) = bv; *(f32x4*)(sp + (5 + 3 * d) * 64) = kf;
                        } else {
                            *(u32x2*)(P + (size_t)r * PP + IC_RW + ch) = pack4(a);
                        }
                        asm volatile("" ::: "memory");
                    }
            }
    }
};

struct LoraSched {
    pg8::StaticOrder S;
    __device__ __forceinline__ bool next(int i, Unit& u) const { if (!S.next(i, u)) return false; const int reg = u.pn >> 1; u.koff = 128 * (reg < 4 ? (reg >> 1) : 2); return true; }
    __device__ __forceinline__ void a_ready(const Unit&) const {}
    __device__ __forceinline__ void done(const Unit&) const {}
};
struct EpiGate {
    static constexpr bool PERM = true, AFTER_DRAIN = false;
    bf16_t* G;
    __device__ __forceinline__ void operator()(const f32x4 (&acc)[2][2][4][2], const Unit& u, int wr, int wc, int fr, int fq) const {
#pragma unroll
        for (int ai = 0; ai < 2; ++ai)
#pragma unroll
            for (int m = 0; m < 4; ++m) {
                const int r = u.pm * 256 + ai * 128 + wr * 64 + m * 16 + fr;
#pragma unroll
                for (int bj = 0; bj < 2; ++bj) {
                    const int c = u.pn * 256 + bj * 128 + wc * 32 + 8 * fq;
                    const f32x4 a0 = acc[ai][bj][m][0], a1 = acc[ai][bj][m][1];
                    u32x4 w; w.x = pk2(sigmoidf_(a0.x), sigmoidf_(a0.y)); w.y = pk2(sigmoidf_(a0.z), sigmoidf_(a0.w)); w.z = pk2(sigmoidf_(a1.x), sigmoidf_(a1.y)); w.w = pk2(sigmoidf_(a1.z), sigmoidf_(a1.w));
                    *(u32x4*)(G + (size_t)r * 3072 + c) = w;
                }
            }
    }
};

template <int PASS> struct EpiMerge {
    static constexpr bool PERM = false, AFTER_DRAIN = false;
    const bf16_t* G; bf16_t* MF; bf16_t* MB;
    __device__ __forceinline__ void operator()(const f32x4 (&acc)[2][2][4][2], const Unit& u, int wr, int wc, int fr, int fq) const {
#pragma unroll
        for (int ai = 0; ai < 2; ++ai)
#pragma unroll
            for (int m = 0; m < 4; ++m) {
                const int r = u.pm * 256 + ai * 128 + wr * 64 + m * 16 + fr;
#pragma unroll
                for (int bj = 0; bj < 2; ++bj)
#pragma unroll
                    for (int n = 0; n < 2; ++n) {
                        const int c = u.pn * 256 + bj * 128 + wc * 32 + 16 * n + 4 * fq;
                        const f32x4 g = unpack4(*(const u32x2*)(G + (size_t)r * 3072 + PASS * 1024 + c));
                        f32x4 v = g * acc[ai][bj][m][n];
                        bf16_t* mp = MF + (size_t)r * 1024 + c;
                        if (PASS > 0) v += unpack4(*(const u32x2*)mp);
                        *(u32x2*)(PASS < 2 ? mp : MB + (size_t)r * 1024 + c) = pack4(v);
                    }
            }
    }
};

struct EpiBf {
    static constexpr bool PERM = true, AFTER_DRAIN = false;
    bf16_t* O; int ldc;
    __device__ __forceinline__ void operator()(const f32x4 (&acc)[2][2][4][2], const Unit& u, int wr, int wc, int fr, int fq) const {
#pragma unroll
        for (int ai = 0; ai < 2; ++ai)
#pragma unroll
            for (int m = 0; m < 4; ++m) {
                const int r = u.pm * 256 + ai * 128 + wr * 64 + m * 16 + fr;
#pragma unroll
                for (int bj = 0; bj < 2; ++bj) {
                    const int c = u.pn * 256 + bj * 128 + wc * 32 + 8 * fq;
                    const f32x4 a0 = acc[ai][bj][m][0], a1 = acc[ai][bj][m][1];
                    u32x4 w; w.x = pk2(a0.x, a0.y); w.y = pk2(a0.z, a0.w); w.z = pk2(a1.x, a1.y); w.w = pk2(a1.z, a1.w);
                    *(u32x4*)(O + (size_t)r * ldc + c) = w;
                }
            }
    }
};

struct EpiSwiglu {
    static constexpr bool PERM = true, AFTER_DRAIN = false;
    bf16_t* H; int ldh; int npn; int pm_sub;
    __device__ __forceinline__ void operator()(const f32x4 (&acc)[2][2][4][2], const Unit& u, int wr, int wc, int fr, int fq) const {
        const int pnn = u.pn % npn;
#pragma unroll
        for (int ai = 0; ai < 2; ++ai)
#pragma unroll
            for (int m = 0; m < 4; ++m) {
                const int r = (u.pm - pm_sub) * 256 + ai * 128 + wr * 64 + m * 16 + fr;
                const int hc = pnn * 128 + wc * 32 + 8 * fq;
                const f32x4 g0 = acc[ai][0][m][0], g1 = acc[ai][0][m][1], u0 = acc[ai][1][m][0], u1 = acc[ai][1][m][1];
                u32x4 w; w.x = pk2(siluf_(g0.x) * u0.x, siluf_(g0.y) * u0.y); w.y = pk2(siluf_(g0.z) * u0.z, siluf_(g0.w) * u0.w);
                w.z = pk2(siluf_(g1.x) * u1.x, siluf_(g1.y) * u1.y); w.w = pk2(siluf_(g1.z) * u1.z, siluf_(g1.w) * u1.w);
                *(u32x4*)(H + (size_t)r * ldh + hc) = w;
            }
    }
};

struct MoeSched {
    int ts[9]; int pm_lo, pm_hi, npn, G, c; bool a_local;
    __device__ __forceinline__ int expert_of(int pm) const { int e = 0;
#pragma unroll
        for (int q = 1; q < 8; ++q) e += (pm >= ts[q]) ? 1 : 0;
        return e; }
    __device__ __forceinline__ bool next(int i, Unit& u) const {
        const int n = (pm_hi - pm_lo) * npn; const long L = (long)i * G + c; if (L >= n) return false;
        const int pm = pm_lo + (int)L / npn, pnn = (int)L % npn;
        u.pm = a_local ? pm - pm_lo : pm; u.pn = expert_of(pm) * npn + pnn; u.koff = 0; u.tail = -1; return true;
    }
    __device__ __forceinline__ void a_ready(const Unit&) const {}
    __device__ __forceinline__ void done(const Unit&) const {}
};
struct EpiMoeDown {
    static constexpr bool PERM = false, AFTER_DRAIN = false;
    bf16_t* FS; long slot1_off; const int* LIST; const float* WTS; const unsigned* cnt; int ts[9]; int pm_lo;
    __device__ __forceinline__ void operator()(const f32x4 (&acc)[2][2][4][2], const Unit& u, int wr, int wc, int fr, int fq) const {
        const int e = u.pn >> 2, pnn = u.pn & 3, pmg = u.pm + pm_lo;
        int tse = 0;
#pragma unroll
        for (int q = 0; q < 8; ++q) tse = (q == e) ? ts[q] : tse;
        const int ne = (int)cnt[e];
#pragma unroll
        for (int ai = 0; ai < 2; ++ai)
#pragma unroll
            for (int m = 0; m < 4; ++m) {
                const int slot = (pmg - tse) * 256 + ai * 128 + wr * 64 + m * 16 + fr;
                if (slot < ne) {
                    const int tk = LIST[e * 16384 + slot]; const float w = WTS[e * 16384 + slot];
                    bf16_t* dst = FS + (long)(tk & 1) * slot1_off + (size_t)(tk >> 1) * 1024 + pnn * 256 + wc * 32 + 4 * fq;
#pragma unroll
                    for (int bj = 0; bj < 2; ++bj)
#pragma unroll
                        for (int n = 0; n < 2; ++n) *(u32x2*)(dst + bj * 128 + 16 * n) = pack4(acc[ai][bj][m][n] * w);
                }
            }
    }
};

constexpr float SC2 = 0.125f * 1.4426950408889634f;
constexpr int ATT_ROW = 144, ATT_VOFF = 9216, ATT_BUF = 27648;
constexpr float ATT_THR = 6.0f;
__device__ __forceinline__ float xhalf_max(float v) { auto rr = __builtin_amdgcn_permlane32_swap(__float_as_uint(v), __float_as_uint(v), false, false); return fmaxf(__uint_as_float(rr[0]), __uint_as_float(rr[1])); }
__device__ __forceinline__ float xhalf_sum(float v) { auto rr = __builtin_amdgcn_permlane32_swap(__float_as_uint(v), __float_as_uint(v), false, false); return __uint_as_float(rr[0]) + __uint_as_float(rr[1]); }

template <int DV, bool WINDOW>
__device__ __forceinline__ void attn_pass(LAS unsigned char* lds, const bf16_t* __restrict__ P, int qrow0, int qcol, int kcol, const bf16_t* __restrict__ VT,
                                          int lat_row0, int ctx_row0, int tile_lo, int tile_hi, bool has_ref, float m0, float l0, int qpos0,
                                          f32x16 (&o)[DV / 32], float& l_out, int wave, int lane) {
    int tid_ = threadIdx.x; asm volatile("" : "+v"(tid_)); const int tid = tid_; lane = tid & 63; const int qn = lane & 31, half = lane >> 5;
    bf16x8 qf[4];
    { const bf16_t* qp = P + (size_t)(qrow0 + wave * 32 + qn) * PP + qcol + half * 8;
#pragma unroll
      for (int ks = 0; ks < 4; ++ks) qf[ks] = *(const bf16x8*)(qp + ks * 16); }
    float mrun = has_ref ? m0 : 0.f, lrun = (half == 0) ? l0 : 0.f;
    bool need_ref = !has_ref;
    f32x16 negm;
#pragma unroll
    for (int i = 0; i < 16; ++i) negm[i] = -mrun;
#pragma unroll
    for (int db = 0; db < DV / 32; ++db)
#pragma unroll
        for (int i = 0; i < 16; ++i) o[db][i] = 0.f;
    const int nlat = tile_hi - tile_lo, nt = nlat + 4;
    u32x4 kreg[1], vreg[1][DV / 64];
    const int skey = tid >> 3, spc = tid & 7;
#define ATT_LOAD(ti_, set_) do { const int id_ = (ti_) < nlat ? tile_lo + (ti_) : 128 + ((ti_) - nlat); \
        const int krow0_ = id_ < 128 ? lat_row0 + 64 * id_ : ctx_row0 + 64 * (id_ - 128); \
        kreg[set_] = *(const u32x4*)(P + (size_t)(krow0_ + skey) * PP + kcol + spc * 8); \
        _Pragma("unroll") for (int j_ = 0; j_ < DV / 64; ++j_) { const int idx_ = tid + 512 * j_; vreg[set_][j_] = *(const u32x4*)(VT + (size_t)(idx_ >> 3) * KEYS + 64 * id_ + (idx_ & 7) * 8); } } while (0)
#define ATT_STORE(buf_, set_) do { LAS unsigned char* b_ = lds + (buf_) * ATT_BUF; *(LAS u32x4*)(b_ + skey * ATT_ROW + spc * 16) = kreg[set_]; \
        _Pragma("unroll") for (int j_ = 0; j_ < DV / 64; ++j_) { const int idx_ = tid + 512 * j_, dim_ = idx_ >> 3; *(LAS u32x4*)(b_ + ATT_VOFF + dim_ * ATT_ROW + (((idx_ & 7) ^ ((dim_ >> 4) & 1)) * 16)) = vreg[set_][j_]; } } while (0)
    __syncthreads();
    ATT_LOAD(0, 0); ATT_STORE(0, 0);
    if (nt > 1) ATT_LOAD(1, 0);
    __syncthreads();
    for (int ti0 = 0; ti0 < nt; ti0 += 1) {
#pragma unroll
      for (int dd = 0; dd < 1; ++dd) {
        const int ti = ti0 + dd;
        if (ti < nt) {
        const LAS unsigned char* Ks = lds + (ti & 1) * ATT_BUF; const LAS unsigned char* Vs = Ks + ATT_VOFF;
        const int id = ti < nlat ? tile_lo + ti : 128 + (ti - nlat);
        const bool islat = id < 128;
        bool skip = false;
        if (WINDOW && islat) { const int qw = qpos0 + wave * 32; skip = (64 * id + 63 < qw - 128 || 64 * id > qw + 31 + 128); }
        if (!skip) {
        f32x16 s[2];
#pragma unroll
        for (int mb = 0; mb < 2; ++mb) {
#pragma unroll
            for (int ks = 0; ks < 4; ++ks) {
                const bf16x8 kf = *(const LAS bf16x8*)(Ks + (32 * mb + qn) * ATT_ROW + ks * 32 + half * 16);
                if (ks == 0) s[mb] = __builtin_amdgcn_mfma_f32_32x32x16_bf16(kf, qf[0], negm, 0, 0, 0);
                else s[mb] = __builtin_amdgcn_mfma_f32_32x32x16_bf16(kf, qf[ks], s[mb], 0, 0, 0);
            }
        }
        if (WINDOW && islat) {
            const int qpos = qpos0 + wave * 32 + qn;
#pragma unroll
            for (int mb = 0; mb < 2; ++mb)
#pragma unroll
                for (int i = 0; i < 16; ++i) { const int d = 64 * id + 32 * mb + 8 * (i >> 2) + 4 * half + (i & 3) - qpos; if (d > 128 || d < -128) s[mb][i] = -INFINITY; }
        }
        float mx = s[0][0];
#pragma unroll
        for (int mb = 0; mb < 2; ++mb)
#pragma unroll
            for (int i = 0; i < 16; ++i) mx = fmaxf(mx, s[mb][i]);
        mx = xhalf_max(mx);
        if (__builtin_expect(need_ref || __any(mx > ATT_THR), 0)) {
            const float delta = need_ref ? mx : fmaxf(mx, 0.f);
            if (!need_ref) {
                const float alpha = __builtin_amdgcn_exp2f(-delta);
                lrun *= alpha;
#pragma unroll
                for (int db = 0; db < DV / 32; ++db)
#pragma unroll
                    for (int i = 0; i < 16; ++i) o[db][i] *= alpha;
            }
            mrun += delta; need_ref = false;
#pragma unroll
            for (int mb = 0; mb < 2; ++mb)
#pragma unroll
                for (int i = 0; i < 16; ++i) s[mb][i] -= delta;
#pragma unroll
            for (int i = 0; i < 16; ++i) negm[i] = -mrun;
        }
        float rs = 0.f;
#pragma unroll
        for (int mb = 0; mb < 2; ++mb)
#pragma unroll
            for (int i = 0; i < 16; ++i) { const float pv = __builtin_amdgcn_exp2f(s[mb][i]); s[mb][i] = pv; rs += pv; }
        lrun += rs;
#pragma unroll
        for (int g = 0; g < 4; ++g) {
            const int mb = g >> 1, bs = 8 * (g & 1);
            u32x4 pw; pw.x = pk2(s[mb][bs + 0], s[mb][bs + 1]); pw.y = pk2(s[mb][bs + 2], s[mb][bs + 3]); pw.z = pk2(s[mb][bs + 4], s[mb][bs + 5]); pw.w = pk2(s[mb][bs + 6], s[mb][bs + 7]);
            const bf16x8 pf = __builtin_bit_cast(bf16x8, pw);
#pragma unroll
            for (int db = 0; db < DV / 32; ++db) {
                const int dim = 32 * db + qn, sw = (dim >> 4) & 1;
                const LAS unsigned char* vrow = Vs + dim * ATT_ROW + 8 * half;
                const u32x2 lo = *(const LAS u32x2*)(vrow + (((2 * g) ^ sw) * 16)), hi = *(const LAS u32x2*)(vrow + (((2 * g + 1) ^ sw) * 16));
                const u32x4 vw = (u32x4){lo.x, lo.y, hi.x, hi.y};
                o[db] = __builtin_amdgcn_mfma_f32_32x32x16_bf16(__builtin_bit_cast(bf16x8, vw), pf, o[db], 0, 0, 0);
            }
        }
        }
        if (ti + 1 < nt) { ATT_STORE((ti + 1) & 1, 0); if (ti + 2 < nt) ATT_LOAD(ti + 2, 0); }
        __syncthreads();
        }
      }
    }
#undef ATT_LOAD
#undef ATT_STORE
    l_out = xhalf_sum(lrun);
}

__device__ __forceinline__ void swa_unit(LAS unsigned char* lds, const Params& p, int layer, int b, int hq, int qb, bool ctx, int wave, int lane, bool dry = false) {
    bf16_t* P = (bf16_t*)(p.ws + WS_P);
    const int kvh = hq >> 2;
    const bf16_t* VT = (const bf16_t*)(p.ws + WS_VTS) + (size_t)((b * 2 + kvh) * 64) * KEYS;
    const float sink2 = p.in[11][layer * 8 + hq] * 1.4426950408889634f;
    const int qrow0 = ctx ? NLAT + b * CTXL : b * SEQ + qb * 256;
    f32x16 o[2]; float l;
    if (ctx) attn_pass<64, false>(lds, P, qrow0, IC_QS + hq * 64, IC_KS + kvh * 64, VT, b * SEQ, NLAT + b * CTXL, 0, 0, true, sink2, 1.0f, 0, o, l, wave, lane);
    else {
        int lo = 4 * qb - 2; if (lo < 0) lo = 0; int hi = 4 * qb + 6; if (hi > 128) hi = 128;
        attn_pass<64, true>(lds, P, qrow0, IC_QS + hq * 64, IC_KS + kvh * 64, VT, b * SEQ, NLAT + b * CTXL, lo, hi, true, sink2, 1.0f, qb * 256, o, l, wave, lane);
    }
    const float inv = 1.0f / l; const int qn = lane & 31, half = lane >> 5;
    bf16_t* dst = P + (size_t)(qrow0 + wave * 32 + qn) * PP + IC_QS + hq * 64 + 4 * half;
#pragma unroll
    for (int db = 0; db < 2; ++db)
#pragma unroll
        for (int q4 = 0; q4 < 4; ++q4) {
            const f32x4 v = (f32x4){o[db][4 * q4] * inv, o[db][4 * q4 + 1] * inv, o[db][4 * q4 + 2] * inv, o[db][4 * q4 + 3] * inv};
            if (!dry) *(u32x2*)(dst + 32 * db + 8 * q4) = pack4(v);
        }
}
__device__ __forceinline__ void diff_unit(LAS unsigned char* lds, const Params& p, float lam, int b, int h, int qb, bool ctx, int wave, int lane, bool dry = false) {
    bf16_t* P = (bf16_t*)(p.ws + WS_P);
    const bf16_t* VT = (const bf16_t*)(p.ws + WS_VTD) + (size_t)((b * 4 + h) * 128) * KEYS;
    const int qrow0 = ctx ? NLAT + b * CTXL : b * SEQ + qb * 256;
    const int thi = ctx ? 0 : 128;
    LAS unsigned* park = (LAS unsigned*)(lds + 73728) + threadIdx.x;
    f32x16 o[4]; float l;
    attn_pass<128, false>(lds, P, qrow0, IC_QD + h * 128, IC_KD + h * 128, VT, b * SEQ, NLAT + b * CTXL, 0, thi, false, 0.f, 0.f, 0, o, l, wave, lane);
    { const float inv = 1.0f / l;
#pragma unroll
      for (int db = 0; db < 4; ++db)
#pragma unroll
          for (int i = 0; i < 8; ++i) park[(db * 8 + i) * 512] = pk2(o[db][2 * i] * inv, o[db][2 * i + 1] * inv); }
    attn_pass<128, false>(lds, P, qrow0, IC_QD + h * 128 + 64, IC_KD + h * 128 + 64, VT, b * SEQ, NLAT + b * CTXL, 0, thi, false, 0.f, 0.f, 0, o, l, wave, lane);
    const float inv = lam / l; const int qn = lane & 31, half = lane >> 5;
    bf16_t* dst = P + (size_t)(qrow0 + wave * 32 + qn) * PP + IC_QD + h * 128 + 4 * half;
#pragma unroll
    for (int db = 0; db < 4; ++db)
#pragma unroll
        for (int q4 = 0; q4 < 4; ++q4) {
            const unsigned pa = park[(db * 8 + 2 * q4) * 512], pb = park[(db * 8 + 2 * q4 + 1) * 512];
            const f32x4 v = (f32x4){bflo(pa) - o[db][4 * q4] * inv, bfhi(pa) - o[db][4 * q4 + 1] * inv, bflo(pb) - o[db][4 * q4 + 2] * inv, bfhi(pb) - o[db][4 * q4 + 3] * inv};
            if (!dry) *(u32x2*)(dst + 32 * db + 8 * q4) = pack4(v);
        }
}

__device__ __forceinline__ void ld8bf(const bf16_t* p, float (&v)[8]) { const u32x4 w = *(const u32x4*)p; v[0] = bflo(w.x); v[1] = bfhi(w.x); v[2] = bflo(w.y); v[3] = bfhi(w.y); v[4] = bflo(w.z); v[5] = bfhi(w.z); v[6] = bflo(w.w); v[7] = bfhi(w.w); }
__device__ __forceinline__ void ld8f(const float* p, float (&v)[8]) { const f32x4 a = ((const f32x4*)p)[0], b = ((const f32x4*)p)[1]; v[0] = a.x; v[1] = a.y; v[2] = a.z; v[3] = a.w; v[4] = b.x; v[5] = b.y; v[6] = b.z; v[7] = b.w; }
__device__ __forceinline__ void st8f(float* p, const float (&v)[8]) { ((f32x4*)p)[0] = (f32x4){v[0], v[1], v[2], v[3]}; ((f32x4*)p)[1] = (f32x4){v[4], v[5], v[6], v[7]}; }

__device__ __forceinline__ void rwkv_prepare_phase(const Params& p, int layer, int gw, int NGW, int lane) {
    const bf16_t* P = (const bf16_t*)(p.ws + WS_P); float* ST = (float*)(p.ws + WS_ST); bf16_t* A2 = (bf16_t*)(p.ws + WS_YA);
    const float* mup = p.in[12] + layer * 1920; const float* mun = p.in[13] + layer * 1920; const float* k_k = p.in[19] + layer * 512;
    for (int m = gw; m < NTOK; m += NGW) {
        const int t = m < NLAT ? (m & (SEQ - 1)) : ((m - NLAT) & (CTXL - 1)), len = m < NLAT ? SEQ : CTXL;
        const bool hp = t > 0, hn = t < len - 1;
        const bf16_t* pr = P + (size_t)m * PP + IC_RW;
        const int h = lane >> 3, kidx = (lane & 7) * 8;
        float* sp = ST + ((size_t)m * 8 + h) * (ST_SLOTS * 64) + kidx;
#pragma unroll
        for (int sec = 0; sec < 4; ++sec) {
            if (sec == 3 && lane >= 48) break;
            const int col = sec < 3 ? sec * 512 + lane * 8 : 1536 + lane * 8;
            float c[8], pv[8], nx[8], a[8], bb[8], sh[8];
            ld8bf(pr + col, c);
            if (hp) ld8bf(pr - PP + col, pv); else {
#pragma unroll
                for (int q = 0; q < 8; ++q) pv[q] = 0.f; }
            if (hn) ld8bf(pr + PP + col, nx); else {
#pragma unroll
                for (int q = 0; q < 8; ++q) nx[q] = 0.f; }
            ld8f(mup + col, a); ld8f(mun + col, bb);
#pragma unroll
            for (int q = 0; q < 8; ++q) sh[q] = c[q] + a[q] * (pv[q] - c[q]) + bb[q] * (nx[q] - c[q]);
            if (sec == 0) st8f(sp + 1 * 64, sh);
            else if (sec == 2) st8f(sp + 2 * 64, sh);
            else if (sec == 1) {
                st8f(sp + 5 * 64, sh); st8f(sp + 8 * 64, sh);
                float kk[8], kkw[8]; ld8f(k_k + lane * 8, kkw);
                float ss = 0.f;
#pragma unroll
                for (int q = 0; q < 8; ++q) { kk[q] = sh[q] * kkw[q]; ss += kk[q] * kk[q]; }
                ss += __shfl_xor(ss, 1); ss += __shfl_xor(ss, 2); ss += __shfl_xor(ss, 4);
                const float inv = 1.0f / fmaxf(sqrtf(ss), 1e-12f);
#pragma unroll
                for (int q = 0; q < 8; ++q) kk[q] *= inv;
                st8f(sp, kk);
            } else {
                float o[8];
#pragma unroll
                for (int q = 0; q < 8; ++q) o[q] = lane < 16 ? tanhf(sh[q]) : (lane < 32 ? sh[q] : sigmoidf_(sh[q]));
                u32x4 w; w.x = pk2(o[0], o[1]); w.y = pk2(o[2], o[3]); w.z = pk2(o[4], o[5]); w.w = pk2(o[6], o[7]);
                *(u32x4*)(A2 + (size_t)m * 384 + lane * 8) = w;
            }
        }
    }
}

constexpr int NSEG = 64, SEGL = KEYS / NSEG;
static_assert(SEGL * NSEG == KEYS && SEGL % 4 == 0, "segments");
constexpr size_t WS_GH = WS_YA;
static_assert(WS_GH + 32ull * NSEG * 2 * 4096 * 4 <= 560 * MiB, "GH fits behind the stream");
__device__ __forceinline__ int scan_token(int b, int dir, int s) {
    if (s < CTXL) return NLAT + b * CTXL + (dir ? CTXL - 1 - s : s);
    const int t = s - CTXL; return b * SEQ + (dir ? SEQ - 1 - t : t);
}
constexpr int SRING = 6, SREC = ST_SLOTS * 64 * 4;
constexpr int SCAN_LDS = SRING * SREC;
__device__ __forceinline__ void scan_dma(const float* rec, LAS unsigned char* slot, int lane) {
    const float* q = rec + lane * 4;
    __builtin_amdgcn_global_load_lds((const unsigned*)q, (LAS unsigned*)slot, 16, 0, 0);
    __builtin_amdgcn_global_load_lds((const unsigned*)(q + 256), (LAS unsigned*)(slot + 1024), 16, 0, 0);
    if (lane < 16) __builtin_amdgcn_global_load_lds((const unsigned*)(q + 512), (LAS unsigned*)(slot + 2048), 16, 0, 0);
}
template <int MODE>
__device__ __forceinline__ void rwkv_segment(const Params& p, int sid, int seg, int lane, LAS unsigned char* ring) {
    const int b = sid >> 4, h = (sid >> 1) & 7, dir = sid & 1, c = lane & 31, hf = lane >> 5;
    const float* ST = (const float*)(p.ws + WS_ST);
    float* gh = (float*)(p.ws + WS_GH) + ((size_t)sid * NSEG + seg) * 2 * 4096;
    f32x16 TH[2][2], TG[MODE == 0 ? 2 : 1][2];
#pragma unroll
    for (int kb = 0; kb < 2; ++kb)
#pragma unroll
        for (int vb = 0; vb < 2; ++vb) {
            if (MODE == 2 && seg > 0) {
                const float* src = gh - 4096 + (32 * vb + c) * 64 + 32 * kb + 4 * hf;
#pragma unroll
                for (int q = 0; q < 4; ++q) { const f32x4 t = *(const f32x4*)(src + 8 * q); TH[kb][vb][4 * q] = t.x; TH[kb][vb][4 * q + 1] = t.y; TH[kb][vb][4 * q + 2] = t.z; TH[kb][vb][4 * q + 3] = t.w; }
            } else {
#pragma unroll
                for (int r = 0; r < 16; ++r) TH[kb][vb][r] = 0.f;
            }
            if (MODE == 0) {
#pragma unroll
                for (int r = 0; r < 16; ++r) TG[MODE == 0 ? kb : 0][vb][r] = (32 * kb + 8 * (r >> 2) + 4 * hf + (r & 3) == 32 * vb + c) ? 1.0f : 0.0f;
            }
        }
    const int s0 = seg * SEGL, s_end = s0 + SEGL, od = (3 + 3 * dir) * 256;
#pragma unroll 1
    for (int j = 0; j < SRING - 1; ++j) scan_dma(ST + ((size_t)scan_token(b, dir, s0 + j) * 8 + h) * (ST_SLOTS * 64), ring + j * SREC, lane);
    int slot_i = 0;
#pragma unroll 1
    for (int s = s0; s < s_end; ++s) {
        if (s + SRING - 1 < s_end) {
            int nslot = slot_i + SRING - 1; if (nslot >= SRING) nslot -= SRING;
            scan_dma(ST + ((size_t)scan_token(b, dir, s + SRING - 1) * 8 + h) * (ST_SLOTS * 64), ring + nslot * SREC, lane);
            asm volatile("s_waitcnt vmcnt(15)" ::: "memory");
        } else asm volatile("s_waitcnt vmcnt(0)" ::: "memory");
        const LAS unsigned char* rec = ring + slot_i * SREC;
        slot_i = slot_i + 1 == SRING ? 0 : slot_i + 1;
        float ph[2] = {0.f, 0.f}, pg[2] = {0.f, 0.f};
#pragma unroll
        for (int kb = 0; kb < 2; ++kb)
#pragma unroll
            for (int q = 0; q < 4; ++q) {
                const f32x4 a4 = *(const LAS f32x4*)(rec + (32 * kb + 8 * q + 4 * hf) * 4);
#pragma unroll
                for (int j = 0; j < 4; ++j)
#pragma unroll
                    for (int vb = 0; vb < 2; ++vb) { ph[vb] = fmaf(TH[kb][vb][4 * q + j], a4[j], ph[vb]); if (MODE == 0) pg[vb] = fmaf(TG[MODE == 0 ? kb : 0][vb][4 * q + j], a4[j], pg[vb]); }
            }
        float sa[2], sg[2];
#pragma unroll
        for (int vb = 0; vb < 2; ++vb) { sa[vb] = xhalf_sum(ph[vb]); sg[vb] = MODE == 0 ? xhalf_sum(pg[vb]) : 0.f; }
#pragma unroll
        for (int kb = 0; kb < 2; ++kb)
#pragma unroll
            for (int q = 0; q < 4; ++q) {
                const f32x4 w4 = *(const LAS f32x4*)(rec + od + (32 * kb + 8 * q + 4 * hf) * 4);
#pragma unroll
                for (int j = 0; j < 4; ++j)
#pragma unroll
                    for (int vb = 0; vb < 2; ++vb) { TH[kb][vb][4 * q + j] *= w4[j]; if (MODE == 0) TG[MODE == 0 ? kb : 0][vb][4 * q + j] *= w4[j]; }
            }
        float aop[2], bop[2], bopg[2];
#pragma unroll
        for (int kb = 0; kb < 2; ++kb) aop[kb] = *(const LAS float*)(rec + od + (hf ? 512 : 256) + (32 * kb + c) * 4);
#pragma unroll
        for (int vb = 0; vb < 2; ++vb) { const float vv = *(const LAS float*)(rec + 512 + (32 * vb + c) * 4); bop[vb] = hf ? vv : sa[vb]; bopg[vb] = hf ? 0.f : sg[vb]; }
#pragma unroll
        for (int kb = 0; kb < 2; ++kb)
#pragma unroll
            for (int vb = 0; vb < 2; ++vb) {
                TH[kb][vb] = __builtin_amdgcn_mfma_f32_32x32x2f32(aop[kb], bop[vb], TH[kb][vb], 0, 0, 0);
                if (MODE == 0) TG[MODE == 0 ? kb : 0][vb] = __builtin_amdgcn_mfma_f32_32x32x2f32(aop[kb], bopg[vb], TG[MODE == 0 ? kb : 0][vb], 0, 0, 0);
            }
        if (MODE == 2) {
            float py[2] = {0.f, 0.f};
#pragma unroll
            for (int kb = 0; kb < 2; ++kb)
#pragma unroll
                for (int q = 0; q < 4; ++q) {
                    const f32x4 r4 = *(const LAS f32x4*)(rec + 256 + (32 * kb + 8 * q + 4 * hf) * 4);
#pragma unroll
                    for (int j = 0; j < 4; ++j)
#pragma unroll
                        for (int vb = 0; vb < 2; ++vb) py[vb] = fmaf(TH[kb][vb][4 * q + j], r4[j], py[vb]);
                }
            const float y0 = xhalf_sum(py[0]), y1 = xhalf_sum(py[1]);
            float* yp = (float*)ST + ((size_t)scan_token(b, dir, s) * 8 + h) * (ST_SLOTS * 64) + (3 + 3 * dir) * 64 + c;
            if (hf == 0) { yp[0] = y0; yp[32] = y1; }
        }
    }
    if (MODE == 0) {
#pragma unroll
        for (int kb = 0; kb < 2; ++kb)
#pragma unroll
            for (int vb = 0; vb < 2; ++vb) {
                float* dg = gh + (32 * vb + c) * 64 + 32 * kb + 4 * hf; float* dh = dg + 4096;
#pragma unroll
                for (int q = 0; q < 4; ++q) {
                    *(f32x4*)(dg + 8 * q) = (f32x4){TG[MODE == 0 ? kb : 0][vb][4 * q], TG[MODE == 0 ? kb : 0][vb][4 * q + 1], TG[MODE == 0 ? kb : 0][vb][4 * q + 2], TG[MODE == 0 ? kb : 0][vb][4 * q + 3]};
                    *(f32x4*)(dh + 8 * q) = (f32x4){TH[kb][vb][4 * q], TH[kb][vb][4 * q + 1], TH[kb][vb][4 * q + 2], TH[kb][vb][4 * q + 3]};
                }
            }
    }
}
__device__ __forceinline__ void rwkv_combine(const Params& p, int sid, LAS unsigned char* lds, int wave, int lane) {
    float* gh0 = (float*)(p.ws + WS_GH) + (size_t)sid * NSEG * 2 * 4096;
    LAS float* Sx = (LAS float*)lds;
    const int tid = wave * 64 + lane;
    for (int e = tid; e < 4096; e += NTHREADS) Sx[(e >> 6) * 65 + (e & 63)] = gh0[4096 + e];
    __syncthreads();
    const int rb = (wave >> 1) & 1, cb = wave & 1, i32 = lane & 31, hf = lane >> 5;
    for (int i = 1; i < NSEG - 1; ++i) {
        float* gi = gh0 + (size_t)i * 2 * 4096;
        f32x16 d;
        if (wave < 4) {
            float bq[32];
#pragma unroll
            for (int q = 0; q < 32; ++q) bq[q] = gi[(2 * q + hf) * 64 + 32 * cb + i32];
#pragma unroll
            for (int r = 0; r < 16; ++r) d[r] = gi[4096 + (32 * rb + 8 * (r >> 2) + 4 * hf + (r & 3)) * 64 + 32 * cb + i32];
#pragma unroll
            for (int q = 0; q < 32; ++q) {
                const float aq = Sx[(32 * rb + i32) * 65 + 2 * q + hf];
                d = __builtin_amdgcn_mfma_f32_32x32x2f32(aq, bq[q], d, 0, 0, 0);
            }
#pragma unroll
            for (int r = 0; r < 16; ++r) gi[4096 + (32 * rb + 8 * (r >> 2) + 4 * hf + (r & 3)) * 64 + 32 * cb + i32] = d[r];
        }
        __syncthreads();
        if (wave < 4) {
#pragma unroll
            for (int r = 0; r < 16; ++r) Sx[(32 * rb + 8 * (r >> 2) + 4 * hf + (r & 3)) * 65 + 32 * cb + i32] = d[r];
        }
        __syncthreads();
    }
}

__device__ __forceinline__ void postmix_phase(const Params& p, int layer, float lam_init, int M, int gw, int NGW, int lane) {
    const bf16_t* P = (const bf16_t*)(p.ws + WS_P); const float* ST = (const float*)(p.ws + WS_ST);
    bf16_t* YB = (bf16_t*)(p.ws + WS_YB); bf16_t* YC = (bf16_t*)(p.ws + WS_YC);
    const float* r_k = p.in[21] + layer * 512; const float* lng = p.in[22] + layer * 512; const float* lnb = p.in[23] + layer * 512; const float* sg = p.in[25] + layer * 128;
    for (int m = gw; m < M; m += NGW) {
        {
            const int h = lane >> 3, kidx = (lane & 7) * 8, ch = lane * 8;
            const float* sp = ST + ((size_t)m * 8 + h) * (ST_SLOTS * 64) + kidx;
            float y[8], r[8], v[8], k0[8], k1[8], rk[8], g[8], lg[8], lb[8];
            { float yb_[8]; ld8f(sp + 3 * 64, y); ld8f(sp + 6 * 64, yb_);
#pragma unroll
              for (int q = 0; q < 8; ++q) y[q] += yb_[q]; }
            ld8f(sp + 64, r); ld8f(sp + 128, v); ld8f(sp + 5 * 64, k0); ld8f(sp + 8 * 64, k1); ld8f(r_k + ch, rk); ld8f(lng + ch, lg); ld8f(lnb + ch, lb);
            ld8bf(P + (size_t)m * PP + IC_RW + ch, g);
            float s = 0.f, bn = 0.f;
#pragma unroll
            for (int q = 0; q < 8; ++q) { s += y[q]; bn += r[q] * (k0[q] + k1[q]) * rk[q]; }
            s += __shfl_xor(s, 1); s += __shfl_xor(s, 2); s += __shfl_xor(s, 4);
            bn += __shfl_xor(bn, 1); bn += __shfl_xor(bn, 2); bn += __shfl_xor(bn, 4);
            const float mu = s * (1.0f / 64.0f);
            float var = 0.f;
#pragma unroll
            for (int q = 0; q < 8; ++q) { const float d = y[q] - mu; var += d * d; }
            var += __shfl_xor(var, 1); var += __shfl_xor(var, 2); var += __shfl_xor(var, 4);
            const float rstd = 1.0f / sqrtf(var * (1.0f / 64.0f) + 64e-5f);
            float o[8];
#pragma unroll
            for (int q = 0; q < 8; ++q) o[q] = (((y[q] - mu) * rstd) * lg[q] + lb[q] + bn * v[q]) * g[q];
            u32x4 w; w.x = pk2(o[0], o[1]); w.y = pk2(o[2], o[3]); w.z = pk2(o[4], o[5]); w.w = pk2(o[6], o[7]);
            *(u32x4*)(YB + (size_t)m * 512 + ch) = w;
        }
        *(u32x4*)((bf16_t*)(p.ws + WS_YA) + (size_t)m * 512 + lane * 8) = *(const u32x4*)(P + (size_t)m * PP + IC_QS + lane * 8);
        {
            const int e = (lane & 15) * 8;
            float x[8], gg[8];
            ld8bf(P + (size_t)m * PP + IC_QD + lane * 8, x); ld8f(sg + e, gg);
            float ss = 0.f;
#pragma unroll
            for (int q = 0; q < 8; ++q) ss += x[q] * x[q];
            ss += __shfl_xor(ss, 1); ss += __shfl_xor(ss, 2); ss += __shfl_xor(ss, 4); ss += __shfl_xor(ss, 8);
            const float rstd = (1.0f - lam_init) / sqrtf(ss * (1.0f / 128.0f) + 1e-5f);
            float o[8];
#pragma unroll
            for (int q = 0; q < 8; ++q) o[q] = x[q] * rstd * gg[q];
            u32x4 w; w.x = pk2(o[0], o[1]); w.y = pk2(o[2], o[3]); w.z = pk2(o[4], o[5]); w.w = pk2(o[6], o[7]);
            *(u32x4*)(YC + (size_t)m * 512 + lane * 8) = w;
        }
    }
}
#define XB_TMO      128
#define XB_XCNT(j)  (256  + 64 * (j))
#define XB_XSUB(j)  (1280 + 64 * (j))
#define XB_XGEN(j)  (2304 + 64 * (j))
#define XB_TOP      3328
#define XB_TOPGEN   3392
#define XCD_BAR_WORDS 3456
#define XB_SPIN_CAP (1u << 18)

__device__ __forceinline__ unsigned xb_ld(unsigned* p)              { return __hip_atomic_load(p, __ATOMIC_RELAXED, __HIP_MEMORY_SCOPE_AGENT); }
__device__ __forceinline__ unsigned xb_add(unsigned* p, unsigned v) { return __hip_atomic_fetch_add(p, v, __ATOMIC_RELAXED, __HIP_MEMORY_SCOPE_AGENT); }
__device__ __forceinline__ unsigned xb_xcc_id() { return (unsigned)__builtin_amdgcn_s_getreg((3 << 11) | 20) & 0xFu; }
#define XB_SPIN(cond, bar) do { unsigned _sp = 0; while (cond) { __builtin_amdgcn_s_sleep(1); \
    if ((++_sp & 255u) == 0u) { if (xb_ld(&(bar)[XB_TMO])) break; if (_sp > XB_SPIN_CAP) { atomicAdd(&(bar)[XB_TMO], 1u); break; } } } } while (0)

struct XcdBarrier {
    unsigned* bar; unsigned x;
    volatile LAS unsigned* st;
};

__device__ __forceinline__ XcdBarrier xcd_barrier_post(unsigned* bar, volatile LAS unsigned* st) {
    XcdBarrier b; b.bar = bar; b.x = xb_xcc_id(); b.st = st;
    if (threadIdx.x == 0) (void)xb_add(&bar[XB_XCNT(b.x)], 1u);
    return b;
}
__device__ __forceinline__ void xcd_barrier_complete(unsigned* bar, unsigned x, unsigned& nloc, unsigned& nx) {
    const unsigned G = gridDim.x * gridDim.y * gridDim.z;
    unsigned sum, cnt, mine, sp = 0u;
    for (;;) {
        sum = 0u; cnt = 0u; mine = 0u;
#pragma unroll
        for (unsigned j = 0; j < 16; ++j) { const unsigned c = xb_ld(&bar[XB_XCNT(j)]); sum += c; cnt += (c > 0u) ? 1u : 0u; mine = (j == x) ? c : mine; }
        if (sum == G) break;
        __builtin_amdgcn_s_sleep(1);
        if ((++sp & 255u) == 0u) { if (xb_ld(&bar[XB_TMO])) break; if (sp > XB_SPIN_CAP) { atomicAdd(&bar[XB_TMO], 1u); break; } }
    }
    nloc = mine > 0u ? mine : 1u; nx = cnt > 0u ? cnt : 1u;
}

__device__ __forceinline__ void xcd_barrier(const XcdBarrier& b) {
    asm volatile("s_waitcnt vmcnt(0)" ::: "memory");
    __syncthreads();
    if (threadIdx.x == 0) {
        unsigned* bar = b.bar;
        __builtin_amdgcn_s_waitcnt(0);
        unsigned nloc = b.st[0], nx = b.st[1];
        if (nloc == 0u) { xcd_barrier_complete(bar, b.x, nloc, nx); b.st[0] = nloc; b.st[1] = nx; }
        const unsigned old = xb_add(&bar[XB_XSUB(b.x)], 1u);
        const unsigned gen = old / nloc;
        if (old + 1u == (gen + 1u) * nloc) {
            __builtin_amdgcn_fence(__ATOMIC_RELEASE, "agent");
            asm volatile("s_waitcnt vmcnt(0)" ::: "memory");
            const unsigned og = xb_add(&bar[XB_TOP], 1u);
            const unsigned tg = og / nx;
            if (og + 1u == (tg + 1u) * nx) xb_add(&bar[XB_TOPGEN], 1u);
            else XB_SPIN(xb_ld(&bar[XB_TOPGEN]) == tg, bar);
            __builtin_amdgcn_fence(__ATOMIC_ACQUIRE, "agent");
            xb_add(&bar[XB_XGEN(b.x)], 1u);
            asm volatile("s_waitcnt vmcnt(0)" ::: "memory");
        } else {
            XB_SPIN(xb_ld(&bar[XB_XGEN(b.x)]) == gen, bar);
            __builtin_amdgcn_fence(__ATOMIC_ACQUIRE, "agent");
            asm volatile("s_waitcnt vmcnt(0)" ::: "memory");
        }
    }
    __syncthreads();
}

#ifndef MK_MULTI
#define MK_MULTI 0
#endif
constexpr int N_PHASES = 40;

constexpr int LDS_PARAMS = LDS_BYTES - 1024;
constexpr int LDS_XB = LDS_BYTES - 64;
constexpr int CW_BAR = 8192;
__device__ __forceinline__ unsigned long long uni64(unsigned long long v) {
    const unsigned lo = __builtin_amdgcn_readfirstlane((unsigned)v), hi = __builtin_amdgcn_readfirstlane((unsigned)(v >> 32));
    return ((unsigned long long)hi << 32) | lo;
}
__device__ __forceinline__ int opq(int v) { asm volatile("" : "+s"(v)); return v; }
__device__ __forceinline__ void load_params(LAS unsigned char* lds, Params& q) {
    LAS const unsigned long long* s = (LAS const unsigned long long*)(lds + LDS_PARAMS);
#pragma unroll
    for (int i = 0; i < 37; ++i) q.in[i] = (const float*)(const __attribute__((address_space(1))) float*)uni64(s[i]);
    q.out = (float*)(__attribute__((address_space(1))) float*)uni64(s[37]); q.ws = (unsigned char*)(__attribute__((address_space(1))) unsigned char*)uni64(s[38]); q.ph_lo = 0; q.ph_hi = 0;
}
__global__ void __launch_bounds__(NTHREADS, 2) mk_fwd(Params kp) {
    extern __shared__ __attribute__((aligned(16))) unsigned char lds_raw[];
    LAS unsigned char* lds = (LAS unsigned char*)lds_raw;
    cg::grid_group grid = cg::this_grid();
    if (threadIdx.x == 0) {
        LAS unsigned long long* s = (LAS unsigned long long*)(lds + LDS_PARAMS);
#pragma unroll
        for (int i = 0; i < 37; ++i) s[i] = (unsigned long long)kp.in[i];
        s[37] = (unsigned long long)kp.out; s[38] = (unsigned long long)kp.ws;
    }
    if (threadIdx.x < 2) ((LAS unsigned*)(lds + LDS_XB))[threadIdx.x] = 0u;
    __syncthreads();
#if !MK_MULTI
    (void)xcd_barrier_post((unsigned*)(kp.ws + WS_CTL) + CW_BAR, (volatile LAS unsigned*)(lds + LDS_XB));
#endif
    const int ph_lo = kp.ph_lo, ph_hi = kp.ph_hi;
    int ph = 0;
#define PH_BEGIN if (ph >= ph_lo && ph < ph_hi) { asm volatile("" ::: "memory"); Params p; load_params(lds, p); unsigned char* ws = p.ws; (void)ws; \
    int tid_ = threadIdx.x, bid_ = blockIdx.x, G_ = gridDim.x; asm volatile("" : "+v"(tid_), "+s"(bid_), "+s"(G_)); \
    const int tid = tid_, bid = bid_, G = G_, lane = tid & 63, wave = __builtin_amdgcn_readfirstlane(tid >> 6); const int gw = bid * NWAVES + wave, NGW = G * NWAVES; (void)gw; (void)NGW; (void)lane; (void)tid; (void)G; (void)bid;
#define GRID_SEAM() do { if (ph == 0) grid.sync(); else { XcdBarrier xb_; xb_.bar = (unsigned*)((unsigned char*)(__attribute__((address_space(1))) unsigned char*)uni64(((LAS const unsigned long long*)(lds + LDS_PARAMS))[38]) + WS_CTL) + CW_BAR; \
        xb_.x = xb_xcc_id(); xb_.st = (volatile LAS unsigned*)(lds + LDS_XB); xcd_barrier(xb_); } } while (0)
#define PH_END } if (ph >= ph_lo && ph + 1 < ph_hi) GRID_SEAM(); ++ph;

    using pg8::Gemm; using pg8::StaticOrder; using pg8::gemm_phase;

    PH_BEGIN
        convert_layer_weights(p, 0, lds, gw, NGW, wave, lane);
        __syncthreads();
        adaln_phase(p, lds, wave, lane);
    PH_END
    PH_BEGIN
        premix_phase(p, 0, true, NTOK, gw, NGW, lane);
    PH_END

#pragma clang loop unroll(full)
    for (int layer = 0; layer < 2; ++layer) {
        const int Ml = layer == 0 ? NTOK : NLAT;
        const float lam_init = 0.8f - 0.6f * expf(-0.3f * (float)layer);
        PH_BEGIN
            Gemm g{(const bf16_t*)(ws + WS_XN), (const bf16_t*)(ws + WS_WIN), NTOK, NIN1, opq(1024), 1024}; StaticOrder S; S.init(NTOK, NIN1, G, bid);
            EpiIn E{(bf16_t*)(ws + WS_P), (bf16_t*)(ws + WS_VTS), (bf16_t*)(ws + WS_VTD), (const float*)(ws + WS_ROPE)};
            gemm_phase<EpiIn, StaticOrder, true, true>(lds, g, S, E);
        PH_END
        PH_BEGIN
            rwkv_prepare_phase(p, layer, gw, NGW, lane);
        PH_END
        PH_BEGIN
            Gemm g{(const bf16_t*)(ws + WS_YA), (const bf16_t*)(ws + WS_LORA), NTOK, 2560, opq(128), 384}; LoraSched S; S.S.init(NTOK, 2560, G, bid);
            EpiLora E{(float*)(ws + WS_ST), (bf16_t*)(ws + WS_P), p.in[14] + layer * 1024, p.in[16] + layer * 1024, p.in[20] + layer * 512};
            gemm_phase<EpiLora, LoraSched, true, true>(lds, g, S, E);
        PH_END
        PH_BEGIN
            for (int u = gw; u < 32 * (NSEG - 1); u += NGW) rwkv_segment<0>(p, u / (NSEG - 1), u % (NSEG - 1), lane, lds + wave * SCAN_LDS);
        PH_END
        PH_BEGIN
            unsigned* qhead = (unsigned*)(ws + WS_CTL) + (layer == 0 ? CW_Q0 : CW_Q1);
            LAS int* ubox = (LAS int*)(lds + 65536);
            const int n_swa = 512 + (layer == 0 ? 16 : 0);
            if (bid < 32) rwkv_combine(p, bid, lds, wave, lane);
            if (bid >= 32 || G <= 32)
            for (;;) {
                if (tid == 0) ubox[0] = (int)atomicAdd(qhead, 1u);
                __syncthreads();
                const int u = ubox[0];
                __syncthreads();
                if (u >= n_swa) break;
                if (u < 512) swa_unit(lds, p, layer, u >> 8, (u >> 5) & 7, u & 31, false, wave, lane);
                else { const int v = u - 512; swa_unit(lds, p, layer, v >> 3, v & 7, 0, true, wave, lane); }
            }
        PH_END
        PH_BEGIN
            for (int u = gw; u < 32 * NSEG; u += NGW) rwkv_segment<2>(p, u / NSEG, u % NSEG, lane, lds + wave * SCAN_LDS);
        PH_END
        PH_BEGIN
            float lam;
            { const float* lv = p.in[24] + layer * 256;
              const float s1 = wave_sum(lv[lane] * lv[64 + lane]), s2 = wave_sum(lv[128 + lane] * lv[192 + lane]);
              lam = expf(s1) - expf(s2) + lam_init; }
            for (int u = bid; u < 256; u += G) { const int v = G == 256 ? ((((u & 7) >> 2) << 7) | ((u & 3) << 5) | (u >> 3)) : u; diff_unit(lds, p, lam, v >> 7, (v >> 5) & 3, v & 31, false, wave, lane); }
            if (layer == 0) for (int u = bid; u < 8; u += G) diff_unit(lds, p, lam, u >> 2, u & 3, 0, true, wave, lane);
        PH_END
        PH_BEGIN
            postmix_phase(p, layer, lam_init, Ml, gw, NGW, lane);
            if (layer == 0) convert_ffn_weights(p, lds, gw, NGW, wave, lane);
        PH_END
        PH_BEGIN
            Gemm g{(const bf16_t*)(ws + WS_XN), (const bf16_t*)(ws + WS_WIN) + (size_t)NIN1 * 1024, Ml, 3072, opq(1024), 1024}; StaticOrder S; S.init(Ml, 3072, G, bid);
            EpiGate E{(bf16_t*)(ws + WS_G)};
            gemm_phase<EpiGate, StaticOrder, true, true>(lds, g, S, E);
        PH_END
        PH_BEGIN
            StaticOrder S; S.init(Ml, 1024, G, bid);
            { Gemm g{(const bf16_t*)(ws + WS_YA), (const bf16_t*)(ws + WS_PRJ), Ml, 1024, opq(512), 512}; EpiMerge<0> E{(const bf16_t*)(ws + WS_G), (bf16_t*)(ws + WS_MF), (bf16_t*)(ws + WS_MB)};
              gemm_phase<EpiMerge<0>, StaticOrder, true, true>(lds, g, S, E); }
            { Gemm g{(const bf16_t*)(ws + WS_YB), (const bf16_t*)(ws + WS_PRJ) + 1024 * 512, Ml, 1024, opq(512), 512}; EpiMerge<1> E{(const bf16_t*)(ws + WS_G), (bf16_t*)(ws + WS_MF), (bf16_t*)(ws + WS_MB)};
              gemm_phase<EpiMerge<1>, StaticOrder, true, true>(lds, g, S, E); }
            { Gemm g{(const bf16_t*)(ws + WS_YC), (const bf16_t*)(ws + WS_PRJ) + 2 * 1024 * 512, Ml, 1024, opq(512), 512}; EpiMerge<2> E{(const bf16_t*)(ws + WS_G), (bf16_t*)(ws + WS_MF), (bf16_t*)(ws + WS_MB)};
              gemm_phase<EpiMerge<2>, StaticOrder, true, true>(lds, g, S, E); }
        PH_END
        PH_BEGIN
            Gemm g{(const bf16_t*)(ws + WS_MB), (const bf16_t*)(ws + WS_WOUT), Ml, 1024, opq(1024), 1024}; StaticOrder S; S.init(Ml, 1024, G, bid);
            EpiBf E{(bf16_t*)(ws + WS_MOUT), 1024};
            gemm_phase<EpiBf, StaticOrder, true, true>(lds, g, S, E);
        PH_END
        PH_BEGIN
            residual_phase(p, (const bf16_t*)(ws + WS_MOUT), nullptr, nullptr, layer == 0, layer, 2, p.in[7] + layer * 1024, true, p.in[8] + layer * 1024, layer, 3, layer == 1, Ml, gw, NGW, lane);
            if (layer == 0) convert_layer_weights(p, 1, lds, gw, NGW, wave, lane);
            else convert_moe_weights(p, lds, gw, NGW, wave, lane);
        PH_END
        if (layer == 0) {
            PH_BEGIN
                Gemm g{(const bf16_t*)(ws + WS_XN), (const bf16_t*)(ws + WS_FGU), NTOK, 2 * D_FF, opq(1024), 1024}; StaticOrder S; S.init(NTOK, 2 * D_FF, G, bid);
                EpiSwiglu E{(bf16_t*)(ws + WS_HID), D_FF, 1 << 20, 0};
                gemm_phase<EpiSwiglu, StaticOrder, true, true>(lds, g, S, E);
            PH_END
            PH_BEGIN
                Gemm g{(const bf16_t*)(ws + WS_HID), (const bf16_t*)(ws + WS_FD), NTOK, 1024, opq(D_FF), D_FF}; StaticOrder S; S.init(NTOK, 1024, G, bid);
                EpiBf E{(bf16_t*)(ws + WS_MF), 1024};
                gemm_phase<EpiBf, StaticOrder, true, true>(lds, g, S, E);
            PH_END
            PH_BEGIN
                residual_phase(p, (const bf16_t*)(ws + WS_MF), nullptr, nullptr, false, 0, 5, p.in[9], true, p.in[6] + 1024, 1, 0, false, NTOK, gw, NGW, lane);
            PH_END
        }
    }
    {
        {
            PH_BEGIN
                const unsigned* cnt = (const unsigned*)(ws + WS_CTL) + CW_CNT; int ts[9]; ts[0] = 0;
#pragma unroll
                for (int e = 0; e < 8; ++e) ts[e + 1] = ts[e] + (int)((__hip_atomic_load(cnt + e, __ATOMIC_RELAXED, __HIP_MEMORY_SCOPE_AGENT) + 255u) >> 8);
                const int* LIST = (const int*)(ws + WS_LIST); const bf16_t* XN = (const bf16_t*)(ws + WS_XN2); bf16_t* XG = (bf16_t*)(ws + WS_XG);
                for (int r = gw; r < ts[8] * 256; r += NGW) {
                    const int tile = r >> 8; int e = 0;
#pragma unroll
                    for (int q = 1; q < 8; ++q) e += (tile >= ts[q]) ? 1 : 0;
                    int tse = 0;
#pragma unroll
                    for (int q = 0; q < 8; ++q) tse = (q == e) ? ts[q] : tse;
                    const int slot = r - tse * 256;
                    u32x4 v0 = (u32x4){0u, 0u, 0u, 0u}, v1 = v0;
                    if (slot < (int)cnt[e]) { const int tk = LIST[e * 16384 + slot]; const u32x4* src = (const u32x4*)(XN + (size_t)(tk >> 1) * 1024); v0 = src[lane]; v1 = src[lane + 64]; }
                    u32x4* dst = (u32x4*)(XG + (size_t)r * 1024); dst[lane] = v0; dst[lane + 64] = v1;
                }
            PH_END
            PH_BEGIN
                const unsigned* cnt = (const unsigned*)(ws + WS_CTL) + CW_CNT; int ts[9]; ts[0] = 0;
#pragma unroll
                for (int e = 0; e < 8; ++e) ts[e + 1] = ts[e] + (int)((__hip_atomic_load(cnt + e, __ATOMIC_RELAXED, __HIP_MEMORY_SCOPE_AGENT) + 255u) >> 8);
                MoeSched S;
#pragma unroll
                for (int e = 0; e < 9; ++e) S.ts[e] = ts[e];
                S.pm_lo = 0; S.pm_hi = ts[8]; S.npn = 28; S.G = G; S.c = bid; S.a_local = false;
                Gemm g{(const bf16_t*)(ws + WS_XG), (const bf16_t*)(ws + WS_MGU), 0, 0, opq(1024), 1024};
                EpiSwiglu E{(bf16_t*)(ws + WS_HIDM), D_FFE, 28, 0};
                gemm_phase<EpiSwiglu, MoeSched, true, true>(lds, g, S, E);
            PH_END
            PH_BEGIN
                const unsigned* cnt = (const unsigned*)(ws + WS_CTL) + CW_CNT; int ts[9]; ts[0] = 0;
#pragma unroll
                for (int e = 0; e < 8; ++e) ts[e + 1] = ts[e] + (int)((__hip_atomic_load(cnt + e, __ATOMIC_RELAXED, __HIP_MEMORY_SCOPE_AGENT) + 255u) >> 8);
                MoeSched S;
#pragma unroll
                for (int e = 0; e < 9; ++e) S.ts[e] = ts[e];
                S.pm_lo = 0; S.pm_hi = ts[8]; S.npn = 4; S.G = G; S.c = bid; S.a_local = false;
                Gemm g{(const bf16_t*)(ws + WS_HIDM), (const bf16_t*)(ws + WS_MD), 0, 0, opq(D_FFE), D_FFE};
                EpiMoeDown E; E.FS = (bf16_t*)(ws + WS_FACC); E.slot1_off = ((long)WS_MGU - (long)WS_FACC) / 2; E.LIST = (const int*)(ws + WS_LIST); E.WTS = (const float*)(ws + WS_WTS); E.cnt = cnt; E.pm_lo = 0;
#pragma unroll
                for (int e = 0; e < 9; ++e) E.ts[e] = ts[e];
                gemm_phase<EpiMoeDown, MoeSched, true, true>(lds, g, S, E);
            PH_END
            PH_BEGIN
                residual_phase(p, (const bf16_t*)(ws + WS_FACC), (const bf16_t*)(ws + WS_MGU), nullptr, false, 1, 5, p.in[9] + 1024, false, nullptr, 0, 0, false, NLAT, gw, NGW, lane);
            PH_END
        }
    }
#undef PH_BEGIN
#undef PH_END
}

extern "C" void kernel_launch(void* const* d_in, const int* in_sizes, int n_in, void* d_out, int out_size, void* d_ws, size_t ws_size, hipStream_t stream) {
    static int grid = 0;
    if (grid == 0) {
        if (n_in != 37 || out_size != NLAT * DM || ws_size < WS_NEED) { fprintf(stderr, "kernel_launch: unexpected shapes (n_in %d out %d ws %zu need %zu)\n", n_in, out_size, ws_size, (size_t)WS_NEED); grid = -1; return; }
        int dev = 0, cus = 0, per_cu = 0;
        (void)hipGetDevice(&dev);
        (void)hipDeviceGetAttribute(&cus, hipDeviceAttributeMultiprocessorCount, dev);
        (void)hipFuncSetAttribute((const void*)mk_fwd, hipFuncAttributeMaxDynamicSharedMemorySize, LDS_BYTES);
        (void)hipOccupancyMaxActiveBlocksPerMultiprocessor(&per_cu, (const void*)mk_fwd, NTHREADS, LDS_BYTES);
        if (per_cu < 1) { fprintf(stderr, "kernel_launch: occupancy query reports %d blocks per CU\n", per_cu); grid = -1; return; }
        grid = cus;
        fprintf(stderr, "kernel_launch: grid %d (cus %d, per_cu %d), ws %zu\n", grid, cus, per_cu, ws_size);
    }
    if (grid < 0) return;
    (void)hipMemsetAsync((char*)d_ws + WS_CTL, 0, CTL_BYTES, stream);
    Params prm{};
    for (int i = 0; i < 37; ++i) prm.in[i] = (const float*)d_in[i];
    prm.out = (float*)d_out; prm.ws = (unsigned char*)d_ws;
#if MK_MULTI
    for (int ph = 0; ph < N_PHASES; ++ph) { prm.ph_lo = ph; prm.ph_hi = ph + 1; hipLaunchKernelGGL(mk_fwd, dim3(grid), dim3(NTHREADS), LDS_BYTES, stream, prm); }
#else
    prm.ph_lo = 0; prm.ph_hi = 1 << 20;
    void* args[] = {&prm};
    hipError_t e = hipLaunchCooperativeKernel((const void*)mk_fwd, dim3(grid), dim3(NTHREADS), args, LDS_BYTES, stream);
    if (e != hipSuccess) fprintf(stderr, "kernel_launch: cooperative launch failed: %s (grid %d)\n", hipGetErrorString(e), grid);
#endif
}
```

```cpp
#include <hip/hip_runtime.h>
#include <hip/hip_cooperative_groups.h>
#include <cstdio>
#include <cstdint>
namespace cg = cooperative_groups;
namespace pg8 {
#define PG8_LAS __attribute__((address_space(3)))
typedef unsigned short bf16_t;
typedef short bf16x8 __attribute__((ext_vector_type(8)));
typedef float f32x4 __attribute__((ext_vector_type(4)));
typedef unsigned u32x4 __attribute__((ext_vector_type(4)));
constexpr int BM = 256, BK = 64, HALF = 128, HTB = HALF * BK * 2  , STAGE_BYTES = 8 * HTB, NXCD = 8, WGM = 8;

__host__ __device__ __forceinline__ int lds_byte(int r, int c) { const int st = (r >> 4) * 2 + (c >> 5), rr = r & 15, cc = c & 31, ob = rr * 64 + cc * 2; return st * 1024 + (ob ^ (((ob >> 9) & 1) << 5)); }
__host__ __device__ __forceinline__ void stage_rc(int b, int& R, int& C) { const int st = b / 1024, sb = b % 1024, swz = sb ^ (((sb >> 9) & 1) << 5); R = (st >> 1) * 16 + swz / 64; C = (st & 1) * 32 + (swz % 64) / 2; }
__host__ __device__ __forceinline__ int perm32(int rho) { const int n = rho >> 4, i = rho & 15; return 8 * (i >> 2) + 4 * n + (i & 3); }

struct Unit { int pm, pn, koff, tail; };
struct Gemm { const bf16_t* A; const bf16_t* Bt; int M, N, K, ld; };

struct StaticOrder {
    int nM, nN, nwg, G, c;
    __host__ __device__ void init(int M, int N, int G_, int c_) { nM = M / BM; nN = N / BM; nwg = nM * nN; G = G_; c = c_; }
    __host__ __device__ bool next(int i, Unit& u) const {
        const long L = (long)i * G + c; if (L >= nwg) return false;
        int wgid = (int)L; { const int q = nwg / NXCD, r = nwg % NXCD, xcd = wgid % NXCD, off = wgid / NXCD; wgid = (xcd < r ? xcd * (q + 1) : r * (q + 1) + (xcd - r) * q) + off; }
        const int nig = WGM * nN, gid = wgid / nig, fm = gid * WGM, gsz = (nM - fm) < WGM ? (nM - fm) : WGM;
        u.pm = fm + ((wgid % nig) % gsz); u.pn = (wgid % nig) / gsz; u.koff = 0; u.tail = -1; return true;
    }
    __device__ __forceinline__ void a_ready(const Unit&) const {}
    __device__ __forceinline__ void done(const Unit&) const {}
};

__device__ __forceinline__ unsigned cvt_pk_bf16(float lo, float hi) { unsigned r; asm volatile("v_cvt_pk_bf16_f32 %0, %1, %2" : "=v"(r) : "v"(lo), "v"(hi)); return r; }
typedef float f32x2 __attribute__((ext_vector_type(2)));
template <class Epi, class Sched, bool ALIGN_EPI = false, bool SP2 = false>
__device__ __forceinline__ void gemm_phase(PG8_LAS unsigned char* lds, const Gemm g, const Sched& S, const Epi& E) {
    int tid_ = threadIdx.x; asm volatile("" : "+v"(tid_)); const int tid = tid_, wid = __builtin_amdgcn_readfirstlane(tid >> 6), lane = tid & 63, wr = wid >> 2, wc = wid & 3, fr = lane & 15, fq = lane >> 4;
    const int K = g.ld, nt = g.K / BK;
    unsigned voffA[2], voffB[2];
#pragma unroll
    for (int i = 0; i < 2; ++i) { int R, C; stage_rc(tid * 16 + i * 8192, R, C); const int Rb = Epi::PERM ? ((R & ~31) + perm32(R & 31)) : R;
        voffA[i] = (unsigned)(R * K + C) * 2u; voffB[i] = (unsigned)(Rb * K + C) * 2u; }
    const size_t kstep = (size_t)(BK * 2);
    const size_t hstep = (size_t)HALF * K * 2;
    const size_t tstep = 2 * hstep;
    const unsigned ldsw = (unsigned)wid * 1024u;
    const int aoff = lds_byte(wr * 64 + fr, fq * 8), boff = lds_byte(wc * 32 + fr, fq * 8);
#define PG8_SA(b, h) (((b) * 2 + (h)) * HTB)
#define PG8_SB(b, h) ((4 + (b) * 2 + (h)) * HTB)
#define PG8_STAGE(bufoff, gbase, voff) do { _Pragma("unroll") for (int _i = 0; _i < 2; ++_i) \
        __builtin_amdgcn_global_load_lds((const unsigned*)((const char*)(gbase) + (voff)[_i]), (PG8_LAS unsigned*)(lds + (bufoff) + ldsw + _i * 8192), 16, 0, 0); } while (0)
#define PG8_LDA(dst, b, h) do { _Pragma("unroll") for (int m = 0; m < 4; ++m) _Pragma("unroll") for (int k = 0; k < 2; ++k) dst[m][k] = *(const PG8_LAS bf16x8*)(lds + PG8_SA(b, h) + aoff + m * 2048 + k * 1024); } while (0)
#define PG8_LDB(dst, b, h) do { _Pragma("unroll") for (int n = 0; n < 2; ++n) _Pragma("unroll") for (int k = 0; k < 2; ++k) dst[n][k] = *(const PG8_LAS bf16x8*)(lds + PG8_SB(b, h) + boff + n * 2048 + k * 1024); } while (0)
#define PG8_MMA(ai, bj, At, Bt) do { __builtin_amdgcn_s_setprio(1); _Pragma("unroll") for (int m = 0; m < 4; ++m) _Pragma("unroll") for (int n = 0; n < 2; ++n) _Pragma("unroll") for (int k = 0; k < 2; ++k) \
        acc[ai][bj][m][n] = __builtin_amdgcn_mfma_f32_16x16x32_bf16(Bt[n][k], At[m][k], acc[ai][bj][m][n], 0, 0, 0); __builtin_amdgcn_s_setprio(0); } while (0)
#define PG8_WAIT_V(n) asm volatile("s_waitcnt vmcnt(" #n ")" ::: "memory")
#define PG8_WAIT_L(n) asm volatile("s_waitcnt lgkmcnt(" #n ")" ::: "memory")
#define PG8_BAR __builtin_amdgcn_s_barrier()
#define PG8_SCHED __builtin_amdgcn_sched_barrier(0)
    Unit cur, nxt; int ui = 0;
    if (!S.next(0, cur)) return;
    f32x4 acc[2][2][4][2];
#pragma unroll
    for (int a = 0; a < 2; ++a)
#pragma unroll
        for (int b = 0; b < 2; ++b)
#pragma unroll
            for (int m = 0; m < 4; ++m)
#pragma unroll
                for (int n = 0; n < 2; ++n) acc[a][b][m][n] = (f32x4){0.f, 0.f, 0.f, 0.f};
    bf16x8 At[4][2], B0[2][2], B1[2][2];
    const char* cA = (const char*)g.A + (size_t)cur.pm * tstep + (size_t)cur.koff * 2; const char* cB = (const char*)g.Bt + (size_t)cur.pn * tstep + (size_t)cur.koff * 2;
    S.a_ready(cur);
    if constexpr (SP2) {
        PG8_STAGE(PG8_SB(0, 0), cB, voffB); PG8_STAGE(PG8_SB(0, 1), cB + hstep, voffB); PG8_STAGE(PG8_SA(0, 0), cA, voffA); PG8_STAGE(PG8_SA(0, 1), cA + hstep, voffA);
        if (wr == 1) PG8_BAR;
        PG8_WAIT_V(2); PG8_BAR;
        PG8_STAGE(PG8_SB(1, 0), cB + kstep, voffB); PG8_STAGE(PG8_SA(1, 0), cA + kstep, voffA); PG8_STAGE(PG8_SB(1, 1), cB + hstep + kstep, voffB);
        PG8_WAIT_V(6); PG8_BAR;
    } else {
        PG8_STAGE(PG8_SB(0, 0), cB, voffB); PG8_STAGE(PG8_SA(0, 0), cA, voffA); PG8_STAGE(PG8_SB(0, 1), cB + hstep, voffB); PG8_STAGE(PG8_SA(0, 1), cA + hstep, voffA);
        if (wr == 1) PG8_BAR;
        PG8_WAIT_V(4); PG8_BAR;
        PG8_STAGE(PG8_SB(1, 0), cB + kstep, voffB); PG8_STAGE(PG8_SA(1, 0), cA + kstep, voffA); PG8_STAGE(PG8_SB(1, 1), cB + hstep + kstep, voffB);
        PG8_WAIT_V(6); PG8_BAR;
    }
    for (;;) {
        const bool has_next = S.next(ui + 1, nxt);
        const char* nA = has_next ? (const char*)g.A + (size_t)nxt.pm * tstep + (size_t)nxt.koff * 2 : cA; const char* nB = has_next ? (const char*)g.Bt + (size_t)nxt.pn * tstep + (size_t)nxt.koff * 2 : cB;
        for (int t = 0; t < nt; t += 2) {
            const bool last = (t == nt - 2);
            const char* a1 = cA + (size_t)(t + 1) * kstep;
            const char* a2 = last ? nA : cA + (size_t)(t + 2) * kstep; const char* b2 = last ? nB : cB + (size_t)(t + 2) * kstep;
            const char* a3 = a2 + kstep; const char* b3 = b2 + kstep;
            if (last && has_next) S.a_ready(nxt);
            if constexpr (SP2) {
            PG8_LDB(B0, 0, 0); PG8_LDB(B1, 0, 1); PG8_SCHED; PG8_LDA(At, 0, 0); PG8_STAGE(PG8_SA(1, 1), a1 + hstep, voffA);
            PG8_WAIT_V(8); PG8_WAIT_L(0); PG8_BAR; PG8_MMA(0, 0, At, B0); PG8_MMA(0, 1, At, B1); PG8_BAR; PG8_SCHED;
            PG8_LDA(At, 0, 1); PG8_STAGE(PG8_SB(0, 0), b2, voffB); PG8_STAGE(PG8_SB(0, 1), b2 + hstep, voffB); PG8_STAGE(PG8_SA(0, 0), a2, voffA);
            PG8_WAIT_V(8); PG8_WAIT_L(0); PG8_BAR; PG8_MMA(1, 0, At, B0); PG8_MMA(1, 1, At, B1); PG8_BAR; PG8_SCHED;
            PG8_LDB(B0, 1, 0); PG8_LDB(B1, 1, 1); PG8_SCHED; PG8_LDA(At, 1, 0); PG8_STAGE(PG8_SA(0, 1), a2 + hstep, voffA);
            PG8_WAIT_V(8); PG8_WAIT_L(0); PG8_BAR; PG8_MMA(0, 0, At, B0); PG8_MMA(0, 1, At, B1); PG8_BAR; PG8_SCHED;
            PG8_LDA(At, 1, 1); PG8_STAGE(PG8_SB(1, 0), b3, voffB); PG8_STAGE(PG8_SB(1, 1), b3 + hstep, voffB); PG8_STAGE(PG8_SA(1, 0), a3, voffA);
            PG8_WAIT_V(8); PG8_WAIT_L(0); PG8_BAR; PG8_MMA(1, 0, At, B0); PG8_MMA(1, 1, At, B1); PG8_BAR; PG8_SCHED;
            } else {
            PG8_LDB(B0, 0, 0); PG8_SCHED; PG8_LDA(At, 0, 0); PG8_STAGE(PG8_SA(1, 1), a1 + hstep, voffA);
            PG8_WAIT_L(8); PG8_BAR; PG8_WAIT_L(0); PG8_MMA(0, 0, At, B0); PG8_BAR; PG8_SCHED;
            PG8_LDB(B1, 0, 1); PG8_STAGE(PG8_SB(0, 0), b2, voffB);
            PG8_BAR; PG8_WAIT_L(0); PG8_MMA(0, 1, At, B1); PG8_BAR;
            PG8_LDA(At, 0, 1); PG8_STAGE(PG8_SA(0, 0), a2, voffA);
            PG8_BAR; PG8_WAIT_L(0); PG8_MMA(1, 0, At, B0); PG8_BAR; PG8_SCHED;
            PG8_STAGE(PG8_SB(0, 1), b2 + hstep, voffB);
            PG8_WAIT_V(6); PG8_BAR; PG8_MMA(1, 1, At, B1); PG8_BAR;
            PG8_LDB(B0, 1, 0); PG8_SCHED; PG8_LDA(At, 1, 0); PG8_STAGE(PG8_SA(0, 1), a2 + hstep, voffA);
            PG8_WAIT_L(8); PG8_BAR; PG8_WAIT_L(0); PG8_MMA(0, 0, At, B0); PG8_BAR; PG8_SCHED;
            PG8_LDB(B1, 1, 1); PG8_STAGE(PG8_SB(1, 0), b3, voffB);
            PG8_BAR; PG8_WAIT_L(0); PG8_MMA(0, 1, At, B1); PG8_BAR;
            PG8_LDA(At, 1, 1); PG8_STAGE(PG8_SA(1, 0), a3, voffA);
            PG8_BAR; PG8_WAIT_L(0); PG8_MMA(1, 0, At, B0); PG8_BAR; PG8_SCHED;
            PG8_STAGE(PG8_SB(1, 1), b3 + hstep, voffB);
            PG8_WAIT_V(6); PG8_BAR; PG8_MMA(1, 1, At, B1); PG8_BAR;
            }
        }
        if constexpr (ALIGN_EPI) { if (wr == 0) PG8_BAR; }
        if constexpr (!Epi::AFTER_DRAIN) { E(acc, cur, wr, wc, fr, fq); S.done(cur); }
        if (!has_next) break;
#pragma unroll
        for (int a = 0; a < 2; ++a)
#pragma unroll
            for (int b = 0; b < 2; ++b)
#pragma unroll
                for (int m = 0; m < 4; ++m)
#pragma unroll
                    for (int n = 0; n < 2; ++n) acc[a][b][m][n] = (f32x4){0.f, 0.f, 0.f, 0.f};
        cur = nxt; cA = nA; cB = nB; ++ui;
        if constexpr (ALIGN_EPI) { if (wr == 1) PG8_BAR; }
    }
    PG8_WAIT_V(0);
    if constexpr (!ALIGN_EPI) { if (wr == 0) PG8_BAR; }
    PG8_BAR;
    if constexpr (Epi::AFTER_DRAIN) { E.fused(acc, cur, wr, wc, fr, fq, lds, wid, lane); S.done(cur); }
#undef PG8_SA
#undef PG8_SB
#undef PG8_STAGE
#undef PG8_LDA
#undef PG8_LDB
#undef PG8_MMA
#undef PG8_WAIT_V
#undef PG8_WAIT_L
#undef PG8_BAR
#undef PG8_SCHED
}
}

#define LAS __attribute__((address_space(3)))
typedef unsigned short bf16_t;
typedef short bf16x8 __attribute__((ext_vector_type(8)));
typedef float f32x4 __attribute__((ext_vector_type(4)));
typedef float f32x16 __attribute__((ext_vector_type(16)));
typedef unsigned u32x4 __attribute__((ext_vector_type(4)));
typedef unsigned u32x2 __attribute__((ext_vector_type(2)));

constexpr int NTHREADS = 512, NWAVES = 8;
constexpr int DM = 1024, SEQ = 8192, CTXL = 256, NLAT = 2 * SEQ, NCTX = 2 * CTXL, NTOK = NLAT + NCTX, KEYS = SEQ + CTXL;
constexpr int D_IN = 7296, D_FF = 2816, D_FFE = 3584, NEXP = 8;
constexpr int IC_QS = 0, IC_KS = 512, IC_RW = 640, IC_QD = 2560, IC_KD = 3072, PP = 3584, IC_VS = 3584, IC_VD = 3712, IC_PAD = 4224, NIN1 = 4352, WIN_ROWS = 7424;
constexpr int ST_SLOTS = 9;
constexpr int MOE_TILES = 136, MOE_HALF = 68;

constexpr size_t MiB = 1u << 20;
constexpr size_t WS_CTL = 0, CTL_BYTES = 1 * MiB;
constexpr size_t WS_MODS = 1 * MiB;
constexpr size_t WS_ROPE = 1 * MiB + 256 * 1024;
constexpr size_t WS_HCTX = 2 * MiB;
constexpr size_t WS_LIST = 4 * MiB;
constexpr size_t WS_WTS = 4 * MiB + 512 * 1024;
constexpr size_t WS_WIN = 6 * MiB;
constexpr size_t WS_PRJ = WS_WIN + (size_t)WIN_ROWS * 1024 * 2;
constexpr size_t WS_WOUT = WS_PRJ + 3 * MiB;
constexpr size_t WS_LORA = WS_WOUT + 2 * MiB;
constexpr size_t WS_XN = 28 * MiB;
constexpr size_t WS_P = 61 * MiB;
constexpr size_t WS_VTS = 177 * MiB;
constexpr size_t WS_VTD = WS_VTS + 4608 * 1024;
constexpr size_t WS_ST = 198 * MiB;
constexpr size_t WS_YA = 495 * MiB;
constexpr size_t WS_YB = WS_YA + 16896ull * 512 * 2;
constexpr size_t WS_YC = WS_YB + 16896ull * 512 * 2;
constexpr size_t WS_END = WS_YC + 16896ull * 512 * 2;
constexpr size_t WS_G = WS_ST;
constexpr size_t WS_MF = WS_ST + 99 * MiB;
constexpr size_t WS_MB = WS_ST + 165 * MiB;
constexpr size_t WS_MOUT = WS_ST + 198 * MiB;
constexpr size_t WS_FGU = WS_VTS;
constexpr size_t WS_FD = WS_VTS + 11 * MiB;
constexpr size_t WS_HID = WS_P;
constexpr size_t WS_XN2 = 495 * MiB;
constexpr size_t WS_MGU = 6 * MiB;
constexpr size_t WS_MD = 118 * MiB;
constexpr size_t WS_XG = 174 * MiB;
constexpr size_t WS_FACC = 242 * MiB;
constexpr size_t WS_HIDM = 306 * MiB;
static_assert(WS_LORA + 2560 * 384 * 2 <= WS_XN && WS_XN + 16896ull * 1024 * 2 <= WS_P && WS_P + 16896ull * PP * 2 <= WS_VTS && WS_VTD + 2ull * 4 * 128 * KEYS * 2 <= WS_ST, "ws map 1");
static_assert(WS_ST + 16896ull * 8 * ST_SLOTS * 64 * 4 <= WS_YA && WS_END <= 545 * MiB, "ws map 2");
static_assert(WS_G + 16896ull * 3072 * 2 <= WS_MF && WS_MF + 16896ull * 1024 * 4 <= WS_MB && WS_MB + 16896ull * 1024 * 2 <= WS_MOUT && WS_MOUT + 16896ull * 1024 * 4 <= WS_YA, "ws map 3");
static_assert(WS_FGU + 5632ull * 1024 * 2 <= WS_FD && WS_FD + 1024ull * 2816 * 2 <= WS_ST && WS_HID + 16896ull * 2816 * 2 <= WS_VTS, "ws map 4");
static_assert(WS_MGU + 8ull * 7168 * 1024 * 2 <= WS_MD && WS_MD + 8ull * 1024 * 3584 * 2 <= WS_XG && WS_XG + 34816ull * 1024 * 2 <= WS_FACC && WS_FACC + 16384ull * 1024 * 4 <= WS_HIDM && WS_HIDM + 136ull * 256 * 3584 * 2 <= 560 * MiB, "ws map 5");
static_assert(WS_FACC + 16384ull * 1024 * 4 <= WS_MOUT && WS_XN2 + 16384ull * 1024 * 2 <= 560 * MiB && WS_XN2 >= WS_MOUT + 16896ull * 1024 * 4, "expert weights / gathered rows / accumulator must not touch MOUT or XN2 while they are live");
constexpr size_t WS_NEED = 560 * MiB;
constexpr int CW_CNT = 0;
constexpr int CW_Q0 = 64, CW_Q1 = 128;

constexpr int LDS_BYTES = 147456;

__device__ __forceinline__ unsigned f2bf(float f) { unsigned u = __builtin_bit_cast(unsigned, f); return (u + 0x7fffu + ((u >> 16) & 1u)) >> 16; }
typedef float f32x2_t __attribute__((ext_vector_type(2))); typedef __bf16 bf16x2_t __attribute__((ext_vector_type(2)));
__device__ __forceinline__ unsigned pk2(float lo, float hi) { const f32x2_t v = {lo, hi}; return __builtin_bit_cast(unsigned, __builtin_convertvector(v, bf16x2_t)); }
__device__ __forceinline__ float bflo(unsigned w) { return __uint_as_float(w << 16); }
__device__ __forceinline__ float bfhi(unsigned w) { return __uint_as_float(w & 0xffff0000u); }
__device__ __forceinline__ float wave_sum(float v) {
#pragma unroll
    for (int o = 1; o < 64; o <<= 1) v += __shfl_xor(v, o);
    return v;
}
__device__ __forceinline__ float sigmoidf_(float x) { return 1.0f / (1.0f + __expf(-x)); }
__device__ __forceinline__ float siluf_(float x) { return x / (1.0f + __expf(-x)); }
#define LDS_WAIT() asm volatile("s_waitcnt lgkmcnt(0)" ::: "memory")

struct Params {
    const float* in[37];
    float* out;
    unsigned char* ws;
    int ph_lo, ph_hi;
};

template <class F>
__device__ __forceinline__ void transpose_item(const float* __restrict__ W, int ldw, int k0, int n0, bf16_t* __restrict__ WT, int ldt, int dcol0, F rowmap, LAS float* scr, int lane) {
#pragma unroll 8
    for (int i = 0; i < 32; ++i) { const int kk = 2 * i + (lane >> 5); scr[kk * 33 + (lane & 31)] = W[(size_t)(k0 + kk) * ldw + n0 + (lane & 31)]; }
    LDS_WAIT(); asm volatile("" ::: "memory");
    const int c = lane & 7;
#pragma unroll
    for (int j = 0; j < 4; ++j) {
        const int n = (lane >> 3) + 8 * j; const LAS float* s = scr + (8 * c) * 33 + n;
        u32x4 o; o.x = pk2(s[0 * 33], s[1 * 33]); o.y = pk2(s[2 * 33], s[3 * 33]); o.z = pk2(s[4 * 33], s[5 * 33]); o.w = pk2(s[6 * 33], s[7 * 33]);
        const int row = rowmap(n0 + n);
        if (row >= 0) *(u32x4*)(WT + (size_t)row * ldt + dcol0 + k0 + 8 * c) = o;
    }
    LDS_WAIT(); asm volatile("" ::: "memory");
}
struct RowId { __device__ __forceinline__ int operator()(int n) const { return n; } };
struct RowOff { int off; __device__ __forceinline__ int operator()(int n) const { return n + off; } };
struct RowWin {
    __device__ __forceinline__ int operator()(int n) const {
        if (n < 640) return n;
        if (n < 768) return n - 640 + IC_VS;
        if (n < 2688) return n - 768 + IC_RW;
        if (n < 3712) return n - 2688 + IC_QD;
        if (n < 4224) return n - 3712 + IC_VD;
        return n - 4224 + NIN1;
    }
};
struct RowGU { int up; __device__ __forceinline__ int operator()(int j) const { return (j >> 7) * 256 + (j & 127) + 128 * up; } };

template <class F>
__device__ __forceinline__ void convert_matrix(const float* W, int K, int N, bf16_t* WT, int ldt, int dcol0, F rowmap, LAS float* scr, int lane, int gw, int NGW) {
    const int nblk = N / 32, items = (K / 64) * nblk;
    for (int it = gw; it < items; it += NGW) { const int kb = it / nblk, nb = it % nblk; transpose_item(W, N, kb * 64, nb * 32, WT, ldt, dcol0, rowmap, scr, lane); }
}

__device__ __forceinline__ void lora_region(bf16_t* __restrict__ LT, const float* __restrict__ src, int row0, int klo, int kn, int gw, int NGW, int lane) {
    for (int i = gw * 64 + lane; i < 512 * 48; i += NGW * 64) {
        const int nn = i / 48, kc = (i % 48) * 8;
        u32x4 o = (u32x4){0u, 0u, 0u, 0u};
        if (kc >= klo && kc < klo + kn) {
            const float* s = src + (size_t)(kc - klo) * 512 + nn;
            o.x = pk2(s[0], s[512]); o.y = pk2(s[2 * 512], s[3 * 512]); o.z = pk2(s[4 * 512], s[5 * 512]); o.w = pk2(s[6 * 512], s[7 * 512]);
        }
        *(u32x4*)(LT + (size_t)(row0 + nn) * 384 + kc) = o;
    }
}
__device__ __forceinline__ void convert_layer_weights(const Params& p, int layer, LAS unsigned char* lds, int gw, int NGW, int wave, int lane) {
    LAS float* scr = (LAS float*)(lds + wave * 16384);
    unsigned char* ws = p.ws;
    bf16_t* WIN = (bf16_t*)(ws + WS_WIN);
    convert_matrix(p.in[10] + (size_t)layer * 1024 * D_IN, 1024, D_IN, WIN, 1024, 0, RowWin(), scr, lane, gw, NGW);
    for (int i = gw * 64 + lane; i < (NIN1 - IC_PAD) * 1024 / 8; i += NGW * 64) *(u32x4*)(WIN + (size_t)IC_PAD * 1024 + (size_t)i * 8) = (u32x4){0u, 0u, 0u, 0u};
    for (int j = 0; j < 3; ++j)
        convert_matrix(p.in[26 + j] + (size_t)layer * 512 * 1024, 512, 1024, (bf16_t*)(ws + WS_PRJ) + (size_t)j * 1024 * 512, 512, 0, RowId(), scr, lane, gw, NGW);
    convert_matrix(p.in[29] + (size_t)layer * 1024 * 1024, 1024, 1024, (bf16_t*)(ws + WS_WOUT), 1024, 0, RowId(), scr, lane, gw, NGW);
    bf16_t* LT = (bf16_t*)(ws + WS_LORA);
    lora_region(LT, p.in[15] + ((size_t)layer * 2 + 0) * 64 * 512, 0, 0, 64, gw, NGW, lane);
    lora_region(LT, p.in[15] + ((size_t)layer * 2 + 1) * 64 * 512, 512, 64, 64, gw, NGW, lane);
    lora_region(LT, p.in[17] + ((size_t)layer * 2 + 0) * 64 * 512, 1024, 128, 64, gw, NGW, lane);
    lora_region(LT, p.in[17] + ((size_t)layer * 2 + 1) * 64 * 512, 1536, 192, 64, gw, NGW, lane);
    lora_region(LT, p.in[18] + (size_t)layer * 128 * 512, 2048, 256, 128, gw, NGW, lane);
}
__device__ __forceinline__ void convert_ffn_weights(const Params& p, LAS unsigned char* lds, int gw, int NGW, int wave, int lane) {
    LAS float* scr = (LAS float*)(lds + wave * 16384);
    bf16_t* GU = (bf16_t*)(p.ws + WS_FGU); bf16_t* FD = (bf16_t*)(p.ws + WS_FD);
    convert_matrix(p.in[30], 1024, D_FF, GU, 1024, 0, RowGU{0}, scr, lane, gw, NGW);
    convert_matrix(p.in[31], 1024, D_FF, GU, 1024, 0, RowGU{1}, scr, lane, gw, NGW);
    convert_matrix(p.in[32], D_FF, 1024, FD, D_FF, 0, RowId(), scr, lane, gw, NGW);
}
__device__ __forceinline__ void convert_moe_weights(const Params& p, LAS unsigned char* lds, int gw, int NGW, int wave, int lane) {
    LAS float* scr = (LAS float*)(lds + wave * 16384);
    for (int e = 0; e < NEXP; ++e) {
        bf16_t* GU = (bf16_t*)(p.ws + WS_MGU) + (size_t)e * 7168 * 1024;
        convert_matrix(p.in[34] + (size_t)e * 1024 * D_FFE, 1024, D_FFE, GU, 1024, 0, RowGU{0}, scr, lane, gw, NGW);
        convert_matrix(p.in[35] + (size_t)e * 1024 * D_FFE, 1024, D_FFE, GU, 1024, 0, RowGU{1}, scr, lane, gw, NGW);
        convert_matrix(p.in[36] + (size_t)e * D_FFE * 1024, D_FFE, 1024, (bf16_t*)(p.ws + WS_MD) + (size_t)e * 1024 * D_FFE, D_FFE, 0, RowId(), scr, lane, gw, NGW);
    }
}

__device__ __forceinline__ void adaln_phase(const Params& p, LAS unsigned char* lds, int wave, int lane) {
    LAS float* red = (LAS float*)lds;
    float* MODS = (float*)(p.ws + WS_MODS);
    const float* c = p.in[1]; const float* cc = p.in[3];
    for (int it = blockIdx.x; it < 2 * 96; it += gridDim.x) {
        const int layer = it / 96, n = (it % 96) * 64 + lane;
        const float* W = p.in[4] + (size_t)layer * 1024 * 6144;
        float a0 = 0.f, a1 = 0.f, a2 = 0.f;
        for (int k = wave * 128; k < wave * 128 + 128; ++k) {
            const float w = W[(size_t)k * 6144 + n];
            a0 += siluf_(c[k]) * w; a1 += siluf_(c[1024 + k]) * w; a2 += siluf_(cc[k]) * w;
        }
        red[(wave * 3 + 0) * 64 + lane] = a0; red[(wave * 3 + 1) * 64 + lane] = a1; red[(wave * 3 + 2) * 64 + lane] = a2;
        __syncthreads();
        if (wave < 3) {
            float s = 0.f;
#pragma unroll
            for (int w = 0; w < 8; ++w) s += red[(w * 3 + wave) * 64 + lane];
            MODS[((size_t)layer * 3 + wave) * 6144 + n] = s + p.in[5][(size_t)layer * 6144 + n];
        }
        __syncthreads();
    }
    if (blockIdx.x == gridDim.x - 1) {
        float* rope = (float*)(p.ws + WS_ROPE);
        for (int i = threadIdx.x; i < 128 * 16; i += NTHREADS) {
            const int pos = i >> 4, j = i & 15;
            const float inv = powf(10000.0f, -(float)j / 16.0f);
            const float ang = (float)pos * inv;
            rope[2 * i] = cosf(ang); rope[2 * i + 1] = sinf(ang);
        }
    }
}

__device__ __forceinline__ const float* mods_row(const Params& p, int layer, int m) {
    const int r = m < NLAT ? (m >> 13) : 2;
    return (const float*)(p.ws + WS_MODS) + ((size_t)layer * 3 + r) * 6144;
}
__device__ __forceinline__ void load_row(const float* x, int lane, f32x4 (&v)[4]) {
#pragma unroll
    for (int j = 0; j < 4; ++j) v[j] = ((const f32x4*)x)[lane + 64 * j];
}
__device__ __forceinline__ float row_rstd(const f32x4 (&v)[4]) {
    float s = 0.f;
#pragma unroll
    for (int j = 0; j < 4; ++j) s += (v[j].x * v[j].x + v[j].y * v[j].y) + (v[j].z * v[j].z + v[j].w * v[j].w);
    return 1.0f / sqrtf(wave_sum(s) * (1.0f / 1024.0f) + 1e-6f);
}
__device__ __forceinline__ void normmod(const f32x4 (&h)[4], const float* g, const float* shift, const float* scale, int lane, f32x4 (&a)[4]) {
    const float rstd = row_rstd(h);
#pragma unroll
    for (int j = 0; j < 4; ++j) {
        const f32x4 gg = ((const f32x4*)g)[lane + 64 * j], sh = ((const f32x4*)shift)[lane + 64 * j], sc = ((const f32x4*)scale)[lane + 64 * j];
        a[j] = (h[j] * rstd * gg) * (sc + 1.0f) + sh;
    }
}
__device__ __forceinline__ void store_row_bf16(bf16_t* o, int lane, const f32x4 (&a)[4]) {
#pragma unroll
    for (int j = 0; j < 4; ++j) { u32x2 w; w.x = pk2(a[j].x, a[j].y); w.y = pk2(a[j].z, a[j].w); ((u32x2*)o)[lane + 64 * j] = w; }
}
__device__ __forceinline__ const float* h_in_row(const Params& p, int layer, int m) {
    if (layer == 0) return m < NLAT ? p.in[0] + (size_t)m * 1024 : p.in[2] + (size_t)(m - NLAT) * 1024;
    return m < NLAT ? p.out + (size_t)m * 1024 : (const float*)(p.ws + WS_HCTX) + (size_t)(m - NLAT) * 1024;
}
__device__ __forceinline__ float* h_out_row(const Params& p, int m) { return m < NLAT ? p.out + (size_t)m * 1024 : (float*)(p.ws + WS_HCTX) + (size_t)(m - NLAT) * 1024; }

__device__ __forceinline__ void premix_phase(const Params& p, int layer, bool first, int M, int gw, int NGW, int lane) {
    bf16_t* XN = (bf16_t*)(p.ws + WS_XN);
    for (int m = gw; m < M; m += NGW) {
        const float* hr = first ? h_in_row(p, 0, m) : h_out_row(p, m);
        f32x4 h[4], a[4]; load_row(hr, lane, h);
        const float* md = mods_row(p, layer, m);
        normmod(h, p.in[6] + layer * 1024, md, md + 1024, lane, a);
        store_row_bf16(XN + (size_t)m * 1024, lane, a);
    }
}
__device__ __forceinline__ void load_row_bf16(const bf16_t* x, int lane, f32x4 (&v)[4]) {
#pragma unroll
    for (int j = 0; j < 4; ++j) { const u32x2 w = ((const u32x2*)x)[lane + 64 * j]; v[j] = (f32x4){bflo(w.x), bfhi(w.x), bflo(w.y), bfhi(w.y)}; }
}
__device__ __forceinline__ void residual_phase(const Params& p, const bf16_t* src, const bf16_t* src2, const float* hin_base_layer0, bool hin_is_input, int layer, int gate_idx, const float* g1,
                                               bool write_xn, const float* g2, int mod_layer2, int shift_idx, bool route, int M, int gw, int NGW, int lane) {
    bf16_t* XN = (bf16_t*)(p.ws + (route ? WS_XN2 : WS_XN));
    for (int m = gw; m < M; m += NGW) {
        const float* hr = hin_is_input ? h_in_row(p, 0, m) : h_out_row(p, m);
        f32x4 h[4], s[4]; load_row(hr, lane, h); load_row_bf16(src + (size_t)m * 1024, lane, s);
        if (src2) { f32x4 s2[4]; load_row_bf16(src2 + (size_t)m * 1024, lane, s2);
#pragma unroll
            for (int j = 0; j < 4; ++j) s[j] += s2[j]; }
        const float rstd = row_rstd(s);
        const float* md = mods_row(p, layer, m);
#pragma unroll
        for (int j = 0; j < 4; ++j) {
            const f32x4 gg = ((const f32x4*)g1)[lane + 64 * j], gt = ((const f32x4*)(md + gate_idx * 1024))[lane + 64 * j];
            h[j] = h[j] + gt * (s[j] * rstd * gg);
        }
        float* ho = h_out_row(p, m);
#pragma unroll
        for (int j = 0; j < 4; ++j) ((f32x4*)ho)[lane + 64 * j] = h[j];
        if (write_xn) {
            f32x4 a[4]; const float* md2 = mods_row(p, mod_layer2, m);
            normmod(h, g2, md2 + shift_idx * 1024, md2 + (shift_idx + 1) * 1024, lane, a);
            store_row_bf16(XN + (size_t)m * 1024, lane, a);
            if (route) {
                const float* rw = p.in[33];
                float lg[8] = {0.f, 0.f, 0.f, 0.f, 0.f, 0.f, 0.f, 0.f};
#pragma unroll
                for (int j = 0; j < 4; ++j)
#pragma unroll
                    for (int q = 0; q < 4; ++q) {
                        const int k = 4 * (lane + 64 * j) + q; const float av = a[j][q];
                        const f32x4 w0 = ((const f32x4*)(rw + (size_t)k * 8))[0], w1 = ((const f32x4*)(rw + (size_t)k * 8))[1];
                        lg[0] += av * w0.x; lg[1] += av * w0.y; lg[2] += av * w0.z; lg[3] += av * w0.w; lg[4] += av * w1.x; lg[5] += av * w1.y; lg[6] += av * w1.z; lg[7] += av * w1.w;
                    }
#pragma unroll
                for (int e = 0; e < 8; ++e) lg[e] = wave_sum(lg[e]);
                int i1 = 0; float v1 = lg[0];
#pragma unroll
                for (int e = 1; e < 8; ++e) if (lg[e] > v1) { v1 = lg[e]; i1 = e; }
                int i2 = -1; float v2 = -3.0e38f;
#pragma unroll
                for (int e = 0; e < 8; ++e) if (e != i1 && lg[e] > v2) { v2 = lg[e]; i2 = e; }
                if (lane == 0) {
                    const float w1 = 1.0f / (1.0f + expf(v2 - v1)), w2 = 1.0f - w1;
                    unsigned* cnt = (unsigned*)(p.ws + WS_CTL) + CW_CNT; int* LIST = (int*)(p.ws + WS_LIST); float* WTS = (float*)(p.ws + WS_WTS);
                    const unsigned s1 = atomicAdd(cnt + i1, 1u); LIST[i1 * 16384 + s1] = m * 2; WTS[i1 * 16384 + s1] = w1;
                    const unsigned s2 = atomicAdd(cnt + i2, 1u); LIST[i2 * 16384 + s2] = m * 2 + 1; WTS[i2 * 16384 + s2] = w2;
                }
            }
        }
    }
}

using pg8::Unit;
constexpr float QSCALE = 0.125f * 1.4426950408889634f;
__device__ __forceinline__ u32x2 pack4(const f32x4 v) { u32x2 w; w.x = pk2(v.x, v.y); w.y = pk2(v.z, v.w); return w; }
__device__ __forceinline__ f32x4 unpack4(const u32x2 w) { return (f32x4){bflo(w.x), bfhi(w.x), bflo(w.y), bfhi(w.y)}; }

struct EpiIn {
    static constexpr bool PERM = false, AFTER_DRAIN = false;
    bf16_t* P; bf16_t* VTS; bf16_t* VTD; const float* rope;
    __device__ __forceinline__ void operator()(const f32x4 (&acc)[2][2][4][2], const Unit& u, int wr, int wc, int fr, int fq) const {
#pragma unroll
        for (int ai = 0; ai < 2; ++ai)
#pragma unroll
            for (int m = 0; m < 4; ++m) {
                const int r = u.pm * 256 + ai * 128 + wr * 64 + m * 16 + fr;
                const bool lat = r < NLAT;
                const int t = r & (SEQ - 1);
                const int b = lat ? (r >> 13) : ((r - NLAT) >> 8);
                const int key = lat ? t : SEQ + ((r - NLAT) & 255);
#pragma unroll
                for (int bj = 0; bj < 2; ++bj) {
                    const int c32 = u.pn * 256 + bj * 128 + wc * 32;
                    f32x4 v0 = acc[ai][bj][m][0], v1 = acc[ai][bj][m][1];
                    if (c32 < PP) {
                        const bool rp = (c32 < IC_RW) || (c32 >= IC_QD);
                        if (rp && lat) {
                            const int pos = (c32 & 32) ? (t & 63) : (t >> 6);
                            const f32x4 cs0 = *(const f32x4*)(rope + (pos * 16 + 4 * fq) * 2), cs1 = *(const f32x4*)(rope + (pos * 16 + 4 * fq) * 2 + 4);
                            const f32x4 cc = (f32x4){cs0.x, cs0.z, cs1.x, cs1.z}, sn = (f32x4){cs0.y, cs0.w, cs1.y, cs1.w};
                            const f32x4 o0 = v0 * cc - v1 * sn, o1 = v0 * sn + v1 * cc;
                            v0 = o0; v1 = o1;
                        }
                        if (c32 < IC_KS || (c32 >= IC_QD && c32 < IC_KD)) { v0 = v0 * QSCALE; v1 = v1 * QSCALE; }
                        bf16_t* dst = P + (size_t)r * PP + c32 + 4 * fq;
                        *(u32x2*)dst = pack4(v0); *(u32x2*)(dst + 16) = pack4(v1);
                    } else {
                        const int cv = c32 - PP;
                        bf16_t* vt = nullptr; int dimbase = 0;
                        if (cv < 128) { vt = VTS + (size_t)((b * 2 + (cv >> 6)) * 64) * KEYS; dimbase = cv & 63; }
                        else if (cv < 640) { const int cd = cv - 128; vt = VTD + (size_t)((b * 4 + (cd >> 7)) * 128) * KEYS; dimbase = cd & 127; }
                        if (vt) {
#pragma unroll
                            for (int i = 0; i < 4; ++i) {
                                vt[(size_t)(dimbase + 4 * fq + i) * KEYS + key] = (bf16_t)f2bf(v0[i]);
                                vt[(size_t)(dimbase + 16 + 4 * fq + i) * KEYS + key] = (bf16_t)f2bf(v1[i]);
                            }
                        }
                    }
                }
            }
    }
};

struct EpiLora {
    static constexpr bool PERM = false, AFTER_DRAIN = false;
    float* ST; bf16_t* P; const float* w0; const float* a0; const float* k_a;
    __device__ __forceinline__ void operator()(const f32x4 (&acc)[2][2][4][2], const Unit& u, int wr, int wc, int fr, int fq) const {
        const int reg = u.pn >> 1;
#pragma unroll
        for (int ai = 0; ai < 2; ++ai)
#pragma unroll
            for (int m = 0; m < 4; ++m) {
                const int r = u.pm * 256 + ai * 128 + wr * 64 + m * 16 + fr;
#pragma unroll
                for (int bj = 0; bj < 2; ++bj)
#pragma unroll
                    for (int n = 0; n < 2; ++n) {
                        const int ch = (u.pn & 1) * 256 + bj * 128 + wc * 32 + 16 * n + 4 * fq;
                        const int h = ch >> 6, kidx = ch & 63;
                        float* sp = ST + ((size_t)r * 8 + h) * (ST_SLOTS * 64) + kidx;
                        const f32x4 a = acc[ai][bj][m][n];
                        if (reg < 2) {
                            const f32x4 bias = *(const f32x4*)(w0 + reg * 512 + ch);
                            f32x4 o;
#pragma unroll
                            for (int i = 0; i < 4; ++i) {
                                const float x = -(bias[i] + a[i]);
                                const float sp_ = fmaxf(x, 0.f) + __logf(1.0f + __expf(-fabsf(x)));
                                o[i] = __expf(-__expf(-sp_ - 0.5f));
                            }
                            *(f32x4*)(sp + (3 + 3 * reg) * 64) = o;
                        } else if (reg < 4) {
                            const int d = reg - 2;
                            const f32x4 bias = *(const f32x4*)(a0 + d * 512 + ch), ka = *(const f32x4*)(k_a + ch);
                            const f32x4 kraw = *(const f32x4*)(sp + (5 + 3 * d) * 64), kk = *(const f32x4*)(sp);
                            f32x4 bv, kf;
#pragma unroll
                            for (int i = 0; i < 4; ++i) {
                                const float ag = sigmoidf_(bias[i] + a[i]);
                                bv[i] = -kk[i] * ag; kf[i] = kraw[i] * (1.0f + (ag - 1.0f) * ka[i]);
                            }
                            *(f32x4*)(sp + (4 + 3 * d) * 64) = bv; *(f32x4*)(sp + (5 + 3 * d) * 64) = kf;
                        } else {
                            *(u32x2*)(P + (size_t)r * PP + IC_RW + ch) = pack4(a);
                        }
                        asm volatile("" ::: "memory");
                    }
            }
    }
};

struct LoraSched {
    pg8::StaticOrder S;
    __device__ __forceinline__ bool next(int i, Unit& u) const { if (!S.next(i, u)) return false; const int reg = u.pn >> 1; u.koff = 128 * (reg < 4 ? (reg >> 1) : 2); return true; }
    __device__ __forceinline__ void a_ready(const Unit&) const {}
    __device__ __forceinline__ void done(const Unit&) const {}
};
struct EpiGate {
    static constexpr bool PERM = true, AFTER_DRAIN = false;
    bf16_t* G;
    __device__ __forceinline__ void operator()(const f32x4 (&acc)[2][2][4][2], const Unit& u, int wr, int wc, int fr, int fq) const {
#pragma unroll
        for (int ai = 0; ai < 2; ++ai)
#pragma unroll
            for (int m = 0; m < 4; ++m) {
                const int r = u.pm * 256 + ai * 128 + wr * 64 + m * 16 + fr;
#pragma unroll
                for (int bj = 0; bj < 2; ++bj) {
                    const int c = u.pn * 256 + bj * 128 + wc * 32 + 8 * fq;
                    const f32x4 a0 = acc[ai][bj][m][0], a1 = acc[ai][bj][m][1];
                    u32x4 w; w.x = pk2(sigmoidf_(a0.x), sigmoidf_(a0.y)); w.y = pk2(sigmoidf_(a0.z), sigmoidf_(a0.w)); w.z = pk2(sigmoidf_(a1.x), sigmoidf_(a1.y)); w.w = pk2(sigmoidf_(a1.z), sigmoidf_(a1.w));
                    *(u32x4*)(G + (size_t)r * 3072 + c) = w;
                }
            }
    }
};

template <int PASS> struct EpiMerge {
    static constexpr bool PERM = false, AFTER_DRAIN = false;
    const bf16_t* G; bf16_t* MF; bf16_t* MB;
    __device__ __forceinline__ void operator()(const f32x4 (&acc)[2][2][4][2], const Unit& u, int wr, int wc, int fr, int fq) const {
#pragma unroll
        for (int ai = 0; ai < 2; ++ai)
#pragma unroll
            for (int m = 0; m < 4; ++m) {
                const int r = u.pm * 256 + ai * 128 + wr * 64 + m * 16 + fr;
#pragma unroll
                for (int bj = 0; bj < 2; ++bj)
#pragma unroll
                    for (int n = 0; n < 2; ++n) {
                        const int c = u.pn * 256 + bj * 128 + wc * 32 + 16 * n + 4 * fq;
                        const f32x4 g = unpack4(*(const u32x2*)(G + (size_t)r * 3072 + PASS * 1024 + c));
                        f32x4 v = g * acc[ai][bj][m][n];
                        bf16_t* mp = MF + (size_t)r * 1024 + c;
                        if (PASS > 0) v += unpack4(*(const u32x2*)mp);
                        *(u32x2*)(PASS < 2 ? mp : MB + (size_t)r * 1024 + c) = pack4(v);
                    }
            }
    }
};

struct EpiBf {
    static constexpr bool PERM = true, AFTER_DRAIN = false;
    bf16_t* O; int ldc;
    __device__ __forceinline__ void operator()(const f32x4 (&acc)[2][2][4][2], const Unit& u, int wr, int wc, int fr, int fq) const {
#pragma unroll
        for (int ai = 0; ai < 2; ++ai)
#pragma unroll
            for (int m = 0; m < 4; ++m) {
                const int r = u.pm * 256 + ai * 128 + wr * 64 + m * 16 + fr;
#pragma unroll
                for (int bj = 0; bj < 2; ++bj) {
                    const int c = u.pn * 256 + bj * 128 + wc * 32 + 8 * fq;
                    const f32x4 a0 = acc[ai][bj][m][0], a1 = acc[ai][bj][m][1];
                    u32x4 w; w.x = pk2(a0.x, a0.y); w.y = pk2(a0.z, a0.w); w.z = pk2(a1.x, a1.y); w.w = pk2(a1.z, a1.w);
                    *(u32x4*)(O + (size_t)r * ldc + c) = w;
                }
            }
    }
};

struct EpiSwiglu {
    static constexpr bool PERM = true, AFTER_DRAIN = false;
    bf16_t* H; int ldh; int npn; int pm_sub;
    __device__ __forceinline__ void operator()(const f32x4 (&acc)[2][2][4][2], const Unit& u, int wr, int wc, int fr, int fq) const {
        const int pnn = u.pn % npn;
#pragma unroll
        for (int ai = 0; ai < 2; ++ai)
#pragma unroll
            for (int m = 0; m < 4; ++m) {
                const int r = (u.pm - pm_sub) * 256 + ai * 128 + wr * 64 + m * 16 + fr;
                const int hc = pnn * 128 + wc * 32 + 8 * fq;
                const f32x4 g0 = acc[ai][0][m][0], g1 = acc[ai][0][m][1], u0 = acc[ai][1][m][0], u1 = acc[ai][1][m][1];
                u32x4 w; w.x = pk2(siluf_(g0.x) * u0.x, siluf_(g0.y) * u0.y); w.y = pk2(siluf_(g0.z) * u0.z, siluf_(g0.w) * u0.w);
                w.z = pk2(siluf_(g1.x) * u1.x, siluf_(g1.y) * u1.y); w.w = pk2(siluf_(g1.z) * u1.z, siluf_(g1.w) * u1.w);
                *(u32x4*)(H + (size_t)r * ldh + hc) = w;
            }
    }
};

struct MoeSched {
    int ts[9]; int pm_lo, pm_hi, npn, G, c; bool a_local;
    __device__ __forceinline__ int expert_of(int pm) const { int e = 0;
#pragma unroll
        for (int q = 1; q < 8; ++q) e += (pm >= ts[q]) ? 1 : 0;
        return e; }
    __device__ __forceinline__ bool next(int i, Unit& u) const {
        const int n = (pm_hi - pm_lo) * npn; const long L = (long)i * G + c; if (L >= n) return false;
        const int pm = pm_lo + (int)L / npn, pnn = (int)L % npn;
        u.pm = a_local ? pm - pm_lo : pm; u.pn = expert_of(pm) * npn + pnn; u.koff = 0; u.tail = -1; return true;
    }
    __device__ __forceinline__ void a_ready(const Unit&) const {}
    __device__ __forceinline__ void done(const Unit&) const {}
};
struct EpiMoeDown {
    static constexpr bool PERM = false, AFTER_DRAIN = false;
    bf16_t* FS; long slot1_off; const int* LIST; const float* WTS; const unsigned* cnt; int ts[9]; int pm_lo;
    __device__ __forceinline__ void operator()(const f32x4 (&acc)[2][2][4][2], const Unit& u, int wr, int wc, int fr, int fq) const {
        const int e = u.pn >> 2, pnn = u.pn & 3, pmg = u.pm + pm_lo;
        int tse = 0;
#pragma unroll
        for (int q = 0; q < 8; ++q) tse = (q == e) ? ts[q] : tse;
        const int ne = (int)cnt[e];
#pragma unroll
        for (int ai = 0; ai < 2; ++ai)
#pragma unroll
            for (int m = 0; m < 4; ++m) {
                const int slot = (pmg - tse) * 256 + ai * 128 + wr * 64 + m * 16 + fr;
                if (slot < ne) {
                    const int tk = LIST[e * 16384 + slot]; const float w = WTS[e * 16384 + slot];
                    bf16_t* dst = FS + (long)(tk & 1) * slot1_off + (size_t)(tk >> 1) * 1024 + pnn * 256 + wc * 32 + 4 * fq;
#pragma unroll
                    for (int bj = 0; bj < 2; ++bj)
#pragma unroll
                        for (int n = 0; n < 2; ++n) *(u32x2*)(dst + bj * 128 + 16 * n) = pack4(acc[ai][bj][m][n] * w);
                }
            }
    }
};

constexpr float SC2 = 0.125f * 1.4426950408889634f;
constexpr int ATT_ROW = 144, ATT_VOFF = 9216, ATT_BUF = 27648;
constexpr float ATT_THR = 6.0f;
__device__ __forceinline__ float xhalf_max(float v) { auto rr = __builtin_amdgcn_permlane32_swap(__float_as_uint(v), __float_as_uint(v), false, false); return fmaxf(__uint_as_float(rr[0]), __uint_as_float(rr[1])); }
__device__ __forceinline__ float xhalf_sum(float v) { auto rr = __builtin_amdgcn_permlane32_swap(__float_as_uint(v), __float_as_uint(v), false, false); return __uint_as_float(rr[0]) + __uint_as_float(rr[1]); }

template <int DV, bool WINDOW>
__device__ __forceinline__ void attn_pass(LAS unsigned char* lds, const bf16_t* __restrict__ P, int qrow0, int qcol, int kcol, const bf16_t* __restrict__ VT,
                                          int lat_row0, int ctx_row0, int tile_lo, int tile_hi, bool has_ref, float m0, float l0, int qpos0,
                                          f32x16 (&o)[DV / 32], float& l_out, int wave, int lane) {
    int tid_ = threadIdx.x; asm volatile("" : "+v"(tid_)); const int tid = tid_; lane = tid & 63; const int qn = lane & 31, half = lane >> 5;
    bf16x8 qf[4];
    { const bf16_t* qp = P + (size_t)(qrow0 + wave * 32 + qn) * PP + qcol + half * 8;
#pragma unroll
      for (int ks = 0; ks < 4; ++ks) qf[ks] = *(const bf16x8*)(qp + ks * 16); }
    float mrun = has_ref ? m0 : 0.f, lrun = (half == 0) ? l0 : 0.f;
    bool need_ref = !has_ref;
    f32x16 negm;
#pragma unroll
    for (int i = 0; i < 16; ++i) negm[i] = -mrun;
#pragma unroll
    for (int db = 0; db < DV / 32; ++db)
#pragma unroll
        for (int i = 0; i < 16; ++i) o[db][i] = 0.f;
    const int nlat = tile_hi - tile_lo, nt = nlat + 4;
    u32x4 kreg[1], vreg[1][DV / 64];
    const int skey = tid >> 3, spc = tid & 7;
#define ATT_LOAD(ti_, set_) do { const int id_ = (ti_) < nlat ? tile_lo + (ti_) : 128 + ((ti_) - nlat); \
        const int krow0_ = id_ < 128 ? lat_row0 + 64 * id_ : ctx_row0 + 64 * (id_ - 128); \
        kreg[set_] = *(const u32x4*)(P + (size_t)(krow0_ + skey) * PP + kcol + spc * 8); \
        _Pragma("unroll") for (int j_ = 0; j_ < DV / 64; ++j_) { const int idx_ = tid + 512 * j_; vreg[set_][j_] = *(const u32x4*)(VT + (size_t)(idx_ >> 3) * KEYS + 64 * id_ + (idx_ & 7) * 8); } } while (0)
#define ATT_STORE(buf_, set_) do { LAS unsigned char* b_ = lds + (buf_) * ATT_BUF; *(LAS u32x4*)(b_ + skey * ATT_ROW + spc * 16) = kreg[set_]; \
        _Pragma("unroll") for (int j_ = 0; j_ < DV / 64; ++j_) { const int idx_ = tid + 512 * j_, dim_ = idx_ >> 3; *(LAS u32x4*)(b_ + ATT_VOFF + dim_ * ATT_ROW + (((idx_ & 7) ^ ((dim_ >> 4) & 1)) * 16)) = vreg[set_][j_]; } } while (0)
    __syncthreads();
    ATT_LOAD(0, 0); ATT_STORE(0, 0);
    if (nt > 1) ATT_LOAD(1, 0);
    __syncthreads();
    for (int ti0 = 0; ti0 < nt; ti0 += 1) {
#pragma unroll
      for (int dd = 0; dd < 1; ++dd) {
        const int ti = ti0 + dd;
        if (ti < nt) {
        const LAS unsigned char* Ks = lds + (ti & 1) * ATT_BUF; const LAS unsigned char* Vs = Ks + ATT_VOFF;
        const int id = ti < nlat ? tile_lo + ti : 128 + (ti - nlat);
        const bool islat = id < 128;
        bool skip = false;
        if (WINDOW && islat) { const int qw = qpos0 + wave * 32; skip = (64 * id + 63 < qw - 128 || 64 * id > qw + 31 + 128); }
        if (!skip) {
        f32x16 s[2];
#pragma unroll
        for (int mb = 0; mb < 2; ++mb) {
#pragma unroll
            for (int ks = 0; ks < 4; ++ks) {
                const bf16x8 kf = *(const LAS bf16x8*)(Ks + (32 * mb + qn) * ATT_ROW + ks * 32 + half * 16);
                if (ks == 0) s[mb] = __builtin_amdgcn_mfma_f32_32x32x16_bf16(kf, qf[0], negm, 0, 0, 0);
                else s[mb] = __builtin_amdgcn_mfma_f32_32x32x16_bf16(kf, qf[ks], s[mb], 0, 0, 0);
            }
        }
        if (WINDOW && islat) {
            const int qpos = qpos0 + wave * 32 + qn;
#pragma unroll
            for (int mb = 0; mb < 2; ++mb)
#pragma unroll
                for (int i = 0; i < 16; ++i) { const int d = 64 * id + 32 * mb + 8 * (i >> 2) + 4 * half + (i & 3) - qpos; if (d > 128 || d < -128) s[mb][i] = -INFINITY; }
        }
        float mx = s[0][0];
#pragma unroll
        for (int mb = 0; mb < 2; ++mb)
#pragma unroll
            for (int i = 0; i < 16; ++i) mx = fmaxf(mx, s[mb][i]);
        mx = xhalf_max(mx);
        if (__builtin_expect(need_ref || __any(mx > ATT_THR), 0)) {
            const float delta = need_ref ? mx : fmaxf(mx, 0.f);
            if (!need_ref) {
                const float alpha = __builtin_amdgcn_exp2f(-delta);
                lrun *= alpha;
#pragma unroll
                for (int db = 0; db < DV / 32; ++db)
#pragma unroll
                    for (int i = 0; i < 16; ++i) o[db][i] *= alpha;
            }
            mrun += delta; need_ref = false;
#pragma unroll
            for (int mb = 0; mb < 2; ++mb)
#pragma unroll
                for (int i = 0; i < 16; ++i) s[mb][i] -= delta;
#pragma unroll
            for (int i = 0; i < 16; ++i) negm[i] = -mrun;
        }
        float rs = 0.f;
#pragma unroll
        for (int mb = 0; mb < 2; ++mb)
#pragma unroll
            for (int i = 0; i < 16; ++i) { const float pv = __builtin_amdgcn_exp2f(s[mb][i]); s[mb][i] = pv; rs += pv; }
        lrun += rs;
#pragma unroll
        for (int g = 0; g < 4; ++g) {
            const int mb = g >> 1, bs = 8 * (g & 1);
            u32x4 pw; pw.x = pk2(s[mb][bs + 0], s[mb][bs + 1]); pw.y = pk2(s[mb][bs + 2], s[mb][bs + 3]); pw.z = pk2(s[mb][bs + 4], s[mb][bs + 5]); pw.w = pk2(s[mb][bs + 6], s[mb][bs + 7]);
            const bf16x8 pf = __builtin_bit_cast(bf16x8, pw);
#pragma unroll
            for (int db = 0; db < DV / 32; ++db) {
                const int dim = 32 * db + qn, sw = (dim >> 4) & 1;
                const LAS unsigned char* vrow = Vs + dim * ATT_ROW + 8 * half;
                const u32x2 lo = *(const LAS u32x2*)(vrow + (((2 * g) ^ sw) * 16)), hi = *(const LAS u32x2*)(vrow + (((2 * g + 1) ^ sw) * 16));
                const u32x4 vw = (u32x4){lo.x, lo.y, hi.x, hi.y};
                o[db] = __builtin_amdgcn_mfma_f32_32x32x16_bf16(__builtin_bit_cast(bf16x8, vw), pf, o[db], 0, 0, 0);
            }
        }
        }
        if (ti + 1 < nt) { ATT_STORE((ti + 1) & 1, 0); if (ti + 2 < nt) ATT_LOAD(ti + 2, 0); }
        __syncthreads();
        }
      }
    }
#undef ATT_LOAD
#undef ATT_STORE
    l_out = xhalf_sum(lrun);
}

__device__ __forceinline__ void swa_unit(LAS unsigned char* lds, const Params& p, int layer, int b, int hq, int qb, bool ctx, int wave, int lane, bool dry = false) {
    bf16_t* P = (bf16_t*)(p.ws + WS_P);
    const int kvh = hq >> 2;
    const bf16_t* VT = (const bf16_t*)(p.ws + WS_VTS) + (size_t)((b * 2 + kvh) * 64) * KEYS;
    const float sink2 = p.in[11][layer * 8 + hq] * 1.4426950408889634f;
    const int qrow0 = ctx ? NLAT + b * CTXL : b * SEQ + qb * 256;
    f32x16 o[2]; float l;
    if (ctx) attn_pass<64, false>(lds, P, qrow0, IC_QS + hq * 64, IC_KS + kvh * 64, VT, b * SEQ, NLAT + b * CTXL, 0, 0, true, sink2, 1.0f, 0, o, l, wave, lane);
    else {
        int lo = 4 * qb - 2; if (lo < 0) lo = 0; int hi = 4 * qb + 6; if (hi > 128) hi = 128;
        attn_pass<64, true>(lds, P, qrow0, IC_QS + hq * 64, IC_KS + kvh * 64, VT, b * SEQ, NLAT + b * CTXL, lo, hi, true, sink2, 1.0f, qb * 256, o, l, wave, lane);
    }
    const float inv = 1.0f / l; const int qn = lane & 31, half = lane >> 5;
    bf16_t* dst = P + (size_t)(qrow0 + wave * 32 + qn) * PP + IC_QS + hq * 64 + 4 * half;
#pragma unroll
    for (int db = 0; db < 2; ++db)
#pragma unroll
        for (int q4 = 0; q4 < 4; ++q4) {
            const f32x4 v = (f32x4){o[db][4 * q4] * inv, o[db][4 * q4 + 1] * inv, o[db][4 * q4 + 2] * inv, o[db][4 * q4 + 3] * inv};
            if (!dry) *(u32x2*)(dst + 32 * db + 8 * q4) = pack4(v);
        }
}
__device__ __forceinline__ void diff_unit(LAS unsigned char* lds, const Params& p, float lam, int b, int h, int qb, bool ctx, int wave, int lane, bool dry = false) {
    bf16_t* P = (bf16_t*)(p.ws + WS_P);
    const bf16_t* VT = (const bf16_t*)(p.ws + WS_VTD) + (size_t)((b * 4 + h) * 128) * KEYS;
    const int qrow0 = ctx ? NLAT + b * CTXL : b * SEQ + qb * 256;
    const int thi = ctx ? 0 : 128;
    LAS unsigned* park = (LAS unsigned*)(lds + 73728) + threadIdx.x;
    f32x16 o[4]; float l;
    attn_pass<128, false>(lds, P, qrow0, IC_QD + h * 128, IC_KD + h * 128, VT, b * SEQ, NLAT + b * CTXL, 0, thi, false, 0.f, 0.f, 0, o, l, wave, lane);
    { const float inv = 1.0f / l;
#pragma unroll
      for (int db = 0; db < 4; ++db)
#pragma unroll
          for (int i = 0; i < 8; ++i) park[(db * 8 + i) * 512] = pk2(o[db][2 * i] * inv, o[db][2 * i + 1] * inv); }
    attn_pass<128, false>(lds, P, qrow0, IC_QD + h * 128 + 64, IC_KD + h * 128 + 64, VT, b * SEQ, NLAT + b * CTXL, 0, thi, false, 0.f, 0.f, 0, o, l, wave, lane);
    const float inv = lam / l; const int qn = lane & 31, half = lane >> 5;
    bf16_t* dst = P + (size_t)(qrow0 + wave * 32 + qn) * PP + IC_QD + h * 128 + 4 * half;
#pragma unroll
    for (int db = 0; db < 4; ++db)
#pragma unroll
        for (int q4 = 0; q4 < 4; ++q4) {
            const unsigned pa = park[(db * 8 + 2 * q4) * 512], pb = park[(db * 8 + 2 * q4 + 1) * 512];
            const f32x4 v = (f32x4){bflo(pa) - o[db][4 * q4] * inv, bfhi(pa) - o[db][4 * q4 + 1] * inv, bflo(pb) - o[db][4 * q4 + 2] * inv, bfhi(pb) - o[db][4 * q4 + 3] * inv};
            if (!dry) *(u32x2*)(dst + 32 * db + 8 * q4) = pack4(v);
        }
}

__device__ __forceinline__ void ld8bf(const bf16_t* p, float (&v)[8]) { const u32x4 w = *(const u32x4*)p; v[0] = bflo(w.x); v[1] = bfhi(w.x); v[2] = bflo(w.y); v[3] = bfhi(w.y); v[4] = bflo(w.z); v[5] = bfhi(w.z); v[6] = bflo(w.w); v[7] = bfhi(w.w); }
__device__ __forceinline__ void ld8f(const float* p, float (&v)[8]) { const f32x4 a = ((const f32x4*)p)[0], b = ((const f32x4*)p)[1]; v[0] = a.x; v[1] = a.y; v[2] = a.z; v[3] = a.w; v[4] = b.x; v[5] = b.y; v[6] = b.z; v[7] = b.w; }
__device__ __forceinline__ void st8f(float* p, const float (&v)[8]) { ((f32x4*)p)[0] = (f32x4){v[0], v[1], v[2], v[3]}; ((f32x4*)p)[1] = (f32x4){v[4], v[5], v[6], v[7]}; }

__device__ __forceinline__ void rwkv_prepare_phase(const Params& p, int layer, int gw, int NGW, int lane) {
    const bf16_t* P = (const bf16_t*)(p.ws + WS_P); float* ST = (float*)(p.ws + WS_ST); bf16_t* A2 = (bf16_t*)(p.ws + WS_YA);
    const float* mup = p.in[12] + layer * 1920; const float* mun = p.in[13] + layer * 1920; const float* k_k = p.in[19] + layer * 512;
    for (int m = gw; m < NTOK; m += NGW) {
        const int t = m < NLAT ? (m & (SEQ - 1)) : ((m - NLAT) & (CTXL - 1)), len = m < NLAT ? SEQ : CTXL;
        const bool hp = t > 0, hn = t < len - 1;
        const bf16_t* pr = P + (size_t)m * PP + IC_RW;
        const int h = lane >> 3, kidx = (lane & 7) * 8;
        float* sp = ST + ((size_t)m * 8 + h) * (ST_SLOTS * 64) + kidx;
#pragma unroll
        for (int sec = 0; sec < 4; ++sec) {
            if (sec == 3 && lane >= 48) break;
            const int col = sec < 3 ? sec * 512 + lane * 8 : 1536 + lane * 8;
            float c[8], pv[8], nx[8], a[8], bb[8], sh[8];
            ld8bf(pr + col, c);
            if (hp) ld8bf(pr - PP + col, pv); else {
#pragma unroll
                for (int q = 0; q < 8; ++q) pv[q] = 0.f; }
            if (hn) ld8bf(pr + PP + col, nx); else {
#pragma unroll
                for (int q = 0; q < 8; ++q) nx[q] = 0.f; }
            ld8f(mup + col, a); ld8f(mun + col, bb);
#pragma unroll
            for (int q = 0; q < 8; ++q) sh[q] = c[q] + a[q] * (pv[q] - c[q]) + bb[q] * (nx[q] - c[q]);
            if (sec == 0) st8f(sp + 1 * 64, sh);
            else if (sec == 2) st8f(sp + 2 * 64, sh);
            else if (sec == 1) {
                st8f(sp + 5 * 64, sh); st8f(sp + 8 * 64, sh);
                float kk[8], kkw[8]; ld8f(k_k + lane * 8, kkw);
                float ss = 0.f;
#pragma unroll
                for (int q = 0; q < 8; ++q) { kk[q] = sh[q] * kkw[q]; ss += kk[q] * kk[q]; }
                ss += __shfl_xor(ss, 1); ss += __shfl_xor(ss, 2); ss += __shfl_xor(ss, 4);
                const float inv = 1.0f / fmaxf(sqrtf(ss), 1e-12f);
#pragma unroll
                for (int q = 0; q < 8; ++q) kk[q] *= inv;
                st8f(sp, kk);
            } else {
                float o[8];
#pragma unroll
                for (int q = 0; q < 8; ++q) o[q] = lane < 16 ? tanhf(sh[q]) : (lane < 32 ? sh[q] : sigmoidf_(sh[q]));
                u32x4 w; w.x = pk2(o[0], o[1]); w.y = pk2(o[2], o[3]); w.z = pk2(o[4], o[5]); w.w = pk2(o[6], o[7]);
                *(u32x4*)(A2 + (size_t)m * 384 + lane * 8) = w;
            }
        }
    }
}

constexpr int NSEG = 64, SEGL = KEYS / NSEG;
static_assert(SEGL * NSEG == KEYS && SEGL % 4 == 0, "segments");
constexpr size_t WS_GH = WS_YA;
static_assert(WS_GH + 32ull * NSEG * 2 * 4096 * 4 <= 560 * MiB, "GH fits behind the stream");
__device__ __forceinline__ int scan_token(int b, int dir, int s) {
    if (s < CTXL) return NLAT + b * CTXL + (dir ? CTXL - 1 - s : s);
    const int t = s - CTXL; return b * SEQ + (dir ? SEQ - 1 - t : t);
}
constexpr int SRING = 6, SREC = ST_SLOTS * 64 * 4;
constexpr int SCAN_LDS = SRING * SREC;
__device__ __forceinline__ void scan_dma(const float* rec, LAS unsigned char* slot, int lane) {
    const float* q = rec + lane * 4;
    __builtin_amdgcn_global_load_lds((const unsigned*)q, (LAS unsigned*)slot, 16, 0, 0);
    __builtin_amdgcn_global_load_lds((const unsigned*)(q + 256), (LAS unsigned*)(slot + 1024), 16, 0, 0);
    if (lane < 16) __builtin_amdgcn_global_load_lds((const unsigned*)(q + 512), (LAS unsigned*)(slot + 2048), 16, 0, 0);
}
template <int MODE>
__device__ __forceinline__ void rwkv_segment(const Params& p, int sid, int seg, int lane, LAS unsigned char* ring) {
    const int b = sid >> 4, h = (sid >> 1) & 7, dir = sid & 1, c = lane & 31, hf = lane >> 5;
    const float* ST = (const float*)(p.ws + WS_ST);
    float* gh = (float*)(p.ws + WS_GH) + ((size_t)sid * NSEG + seg) * 2 * 4096;
    f32x16 TH[2][2], TG[MODE == 0 ? 2 : 1][2];
#pragma unroll
    for (int kb = 0; kb < 2; ++kb)
#pragma unroll
        for (int vb = 0; vb < 2; ++vb) {
            if (MODE == 2 && seg > 0) {
                const float* src = gh - 4096 + (32 * vb + c) * 64 + 32 * kb + 4 * hf;
#pragma unroll
                for (int q = 0; q < 4; ++q) { const f32x4 t = *(const f32x4*)(src + 8 * q); TH[kb][vb][4 * q] = t.x; TH[kb][vb][4 * q + 1] = t.y; TH[kb][vb][4 * q + 2] = t.z; TH[kb][vb][4 * q + 3] = t.w; }
            } else {
#pragma unroll
                for (int r = 0; r < 16; ++r) TH[kb][vb][r] = 0.f;
            }
            if (MODE == 0) {
#pragma unroll
                for (int r = 0; r < 16; ++r) TG[MODE == 0 ? kb : 0][vb][r] = (32 * kb + 8 * (r >> 2) + 4 * hf + (r & 3) == 32 * vb + c) ? 1.0f : 0.0f;
            }
        }
    const int s0 = seg * SEGL, s_end = s0 + SEGL, od = (3 + 3 * dir) * 256;
#pragma unroll 1
    for (int j = 0; j < SRING - 1; ++j) scan_dma(ST + ((size_t)scan_token(b, dir, s0 + j) * 8 + h) * (ST_SLOTS * 64), ring + j * SREC, lane);
    int slot_i = 0;
#pragma unroll 1
    for (int s = s0; s < s_end; ++s) {
        if (s + SRING - 1 < s_end) {
            int nslot = slot_i + SRING - 1; if (nslot >= SRING) nslot -= SRING;
            scan_dma(ST + ((size_t)scan_token(b, dir, s + SRING - 1) * 8 + h) * (ST_SLOTS * 64), ring + nslot * SREC, lane);
            asm volatile("s_waitcnt vmcnt(15)" ::: "memory");
        } else asm volatile("s_waitcnt vmcnt(0)" ::: "memory");
        const LAS unsigned char* rec = ring + slot_i * SREC;
        slot_i = slot_i + 1 == SRING ? 0 : slot_i + 1;
        float ph[2] = {0.f, 0.f}, pg[2] = {0.f, 0.f};
#pragma unroll
        for (int kb = 0; kb < 2; ++kb)
#pragma unroll
            for (int q = 0; q < 4; ++q) {
                const f32x4 a4 = *(const LAS f32x4*)(rec + (32 * kb + 8 * q + 4 * hf) * 4);
#pragma unroll
                for (int j = 0; j < 4; ++j)
#pragma unroll
                    for (int vb = 0; vb < 2; ++vb) { ph[vb] = fmaf(TH[kb][vb][4 * q + j], a4[j], ph[vb]); if (MODE == 0) pg[vb] = fmaf(TG[MODE == 0 ? kb : 0][vb][4 * q + j], a4[j], pg[vb]); }
            }
        float sa[2], sg[2];
#pragma unroll
        for (int vb = 0; vb < 2; ++vb) { sa[vb] = xhalf_sum(ph[vb]); sg[vb] = MODE == 0 ? xhalf_sum(pg[vb]) : 0.f; }
#pragma unroll
        for (int kb = 0; kb < 2; ++kb)
#pragma unroll
            for (int q = 0; q < 4; ++q) {
                const f32x4 w4 = *(const LAS f32x4*)(rec + od + (32 * kb + 8 * q + 4 * hf) * 4);
#pragma unroll
                for (int j = 0; j < 4; ++j)
#pragma unroll
                    for (int vb = 0; vb < 2; ++vb) { TH[kb][vb][4 * q + j] *= w4[j]; if (MODE == 0) TG[MODE == 0 ? kb : 0][vb][4 * q + j] *= w4[j]; }
            }
        float aop[2], bop[2], bopg[2];
#pragma unroll
        for (int kb = 0; kb < 2; ++kb) aop[kb] = *(const LAS float*)(rec + od + (hf ? 512 : 256) + (32 * kb + c) * 4);
#pragma unroll
        for (int vb = 0; vb < 2; ++vb) { const float vv = *(const LAS float*)(rec + 512 + (32 * vb + c) * 4); bop[vb] = hf ? vv : sa[vb]; bopg[vb] = hf ? 0.f : sg[vb]; }
#pragma unroll
        for (int kb = 0; kb < 2; ++kb)
#pragma unroll
            for (int vb = 0; vb < 2; ++vb) {
                TH[kb][vb] = __builtin_amdgcn_mfma_f32_32x32x2f32(aop[kb], bop[vb], TH[kb][vb], 0, 0, 0);
                if (MODE == 0) TG[MODE == 0 ? kb : 0][vb] = __builtin_amdgcn_mfma_f32_32x32x2f32(aop[kb], bopg[vb], TG[MODE == 0 ? kb : 0][vb], 0, 0, 0);
            }
        if (MODE == 2) {
            float py[2] = {0.f, 0.f};
#pragma unroll
            for (int kb = 0; kb < 2; ++kb)
#pragma unroll
                for (int q = 0; q < 4; ++q) {
                    const f32x4 r4 = *(const LAS f32x4*)(rec + 256 + (32 * kb + 8 * q + 4 * hf) * 4);
#pragma unroll
                    for (int j = 0; j < 4; ++j)
#pragma unroll
                        for (int vb = 0; vb < 2; ++vb) py[vb] = fmaf(TH[kb][vb][4 * q + j], r4[j], py[vb]);
                }
            const float y0 = xhalf_sum(py[0]), y1 = xhalf_sum(py[1]);
            float* yp = (float*)ST + ((size_t)scan_token(b, dir, s) * 8 + h) * (ST_SLOTS * 64) + (3 + 3 * dir) * 64 + c;
            if (hf == 0) { yp[0] = y0; yp[32] = y1; }
        }
    }
    if (MODE == 0) {
#pragma unroll
        for (int kb = 0; kb < 2; ++kb)
#pragma unroll
            for (int vb = 0; vb < 2; ++vb) {
                float* dg = gh + (32 * vb + c) * 64 + 32 * kb + 4 * hf; float* dh = dg + 4096;
#pragma unroll
                for (int q = 0; q < 4; ++q) {
                    *(f32x4*)(dg + 8 * q) = (f32x4){TG[MODE == 0 ? kb : 0][vb][4 * q], TG[MODE == 0 ? kb : 0][vb][4 * q + 1], TG[MODE == 0 ? kb : 0][vb][4 * q + 2], TG[MODE == 0 ? kb : 0][vb][4 * q + 3]};
                    *(f32x4*)(dh + 8 * q) = (f32x4){TH[kb][vb][4 * q], TH[kb][vb][4 * q + 1], TH[kb][vb][4 * q + 2], TH[kb][vb][4 * q + 3]};
                }
            }
    }
}
__device__ __forceinline__ void rwkv_combine(const Params& p, int sid, LAS unsigned char* lds, int wave, int lane) {
    float* gh0 = (float*)(p.ws + WS_GH) + (size_t)sid * NSEG * 2 * 4096;
    LAS float* Sx = (LAS float*)lds;
    const int tid = wave * 64 + lane;
    for (int e = tid; e < 4096; e += NTHREADS) Sx[(e >> 6) * 65 + (e & 63)] = gh0[4096 + e];
    __syncthreads();
    const int rb = (wave >> 1) & 1, cb = wave & 1, i32 = lane & 31, hf = lane >> 5;
    for (int i = 1; i < NSEG - 1; ++i) {
        float* gi = gh0 + (size_t)i * 2 * 4096;
        f32x16 d;
        if (wave < 4) {
            float bq[32];
#pragma unroll
            for (int q = 0; q < 32; ++q) bq[q] = gi[(2 * q + hf) * 64 + 32 * cb + i32];
#pragma unroll
            for (int r = 0; r < 16; ++r) d[r] = gi[4096 + (32 * rb + 8 * (r >> 2) + 4 * hf + (r & 3)) * 64 + 32 * cb + i32];
#pragma unroll
            for (int q = 0; q < 32; ++q) {
                const float aq = Sx[(32 * rb + i32) * 65 + 2 * q + hf];
                d = __builtin_amdgcn_mfma_f32_32x32x2f32(aq, bq[q], d, 0, 0, 0);
            }
#pragma unroll
            for (int r = 0; r < 16; ++r) gi[4096 + (32 * rb + 8 * (r >> 2) + 4 * hf + (r & 3)) * 64 + 32 * cb + i32] = d[r];
        }
        __syncthreads();
        if (wave < 4) {
#pragma unroll
            for (int r = 0; r < 16; ++r) Sx[(32 * rb + 8 * (r >> 2) + 4 * hf + (r & 3)) * 65 + 32 * cb + i32] = d[r];
        }
        __syncthreads();
    }
}

__device__ __forceinline__ void postmix_phase(const Params& p, int layer, float lam_init, int M, int gw, int NGW, int lane) {
    const bf16_t* P = (const bf16_t*)(p.ws + WS_P); const float* ST = (const float*)(p.ws + WS_ST);
    bf16_t* YB = (bf16_t*)(p.ws + WS_YB); bf16_t* YC = (bf16_t*)(p.ws + WS_YC);
    const float* r_k = p.in[21] + layer * 512; const float* lng = p.in[22] + layer * 512; const float* lnb = p.in[23] + layer * 512; const float* sg = p.in[25] + layer * 128;
    for (int m = gw; m < M; m += NGW) {
        {
            const int h = lane >> 3, kidx = (lane & 7) * 8, ch = lane * 8;
            const float* sp = ST + ((size_t)m * 8 + h) * (ST_SLOTS * 64) + kidx;
            float y[8], r[8], v[8], k0[8], k1[8], rk[8], g[8], lg[8], lb[8];
            { float yb_[8]; ld8f(sp + 3 * 64, y); ld8f(sp + 6 * 64, yb_);
#pragma unroll
              for (int q = 0; q < 8; ++q) y[q] += yb_[q]; }
            ld8f(sp + 64, r); ld8f(sp + 128, v); ld8f(sp + 5 * 64, k0); ld8f(sp + 8 * 64, k1); ld8f(r_k + ch, rk); ld8f(lng + ch, lg); ld8f(lnb + ch, lb);
            ld8bf(P + (size_t)m * PP + IC_RW + ch, g);
            float s = 0.f, bn = 0.f;
#pragma unroll
            for (int q = 0; q < 8; ++q) { s += y[q]; bn += r[q] * (k0[q] + k1[q]) * rk[q]; }
            s += __shfl_xor(s, 1); s += __shfl_xor(s, 2); s += __shfl_xor(s, 4);
            bn += __shfl_xor(bn, 1); bn += __shfl_xor(bn, 2); bn += __shfl_xor(bn, 4);
            const float mu = s * (1.0f / 64.0f);
            float var = 0.f;
#pragma unroll
            for (int q = 0; q < 8; ++q) { const float d = y[q] - mu; var += d * d; }
            var += __shfl_xor(var, 1); var += __shfl_xor(var, 2); var += __shfl_xor(var, 4);
            const float rstd = 1.0f / sqrtf(var * (1.0f / 64.0f) + 64e-5f);
            float o[8];
#pragma unroll
            for (int q = 0; q < 8; ++q) o[q] = (((y[q] - mu) * rstd) * lg[q] + lb[q] + bn * v[q]) * g[q];
            u32x4 w; w.x = pk2(o[0], o[1]); w.y = pk2(o[2], o[3]); w.z = pk2(o[4], o[5]); w.w = pk2(o[6], o[7]);
            *(u32x4*)(YB + (size_t)m * 512 + ch) = w;
        }
        *(u32x4*)((bf16_t*)(p.ws + WS_YA) + (size_t)m * 512 + lane * 8) = *(const u32x4*)(P + (size_t)m * PP + IC_QS + lane * 8);
        {
            const int e = (lane & 15) * 8;
            float x[8], gg[8];
            ld8bf(P + (size_t)m * PP + IC_QD + lane * 8, x); ld8f(sg + e, gg);
            float ss = 0.f;
#pragma unroll
            for (int q = 0; q < 8; ++q) ss += x[q] * x[q];
            ss += __shfl_xor(ss, 1); ss += __shfl_xor(ss, 2); ss += __shfl_xor(ss, 4); ss += __shfl_xor(ss, 8);
            const float rstd = (1.0f - lam_init) / sqrtf(ss * (1.0f / 128.0f) + 1e-5f);
            float o[8];
#pragma unroll
            for (int q = 0; q < 8; ++q) o[q] = x[q] * rstd * gg[q];
            u32x4 w; w.x = pk2(o[0], o[1]); w.y = pk2(o[2], o[3]); w.z = pk2(o[4], o[5]); w.w = pk2(o[6], o[7]);
            *(u32x4*)(YC + (size_t)m * 512 + lane * 8) = w;
        }
    }
}
#define XB_TMO      128
#define XB_XCNT(j)  (256  + 64 * (j))
#define XB_XSUB(j)  (1280 + 64 * (j))
#define XB_XGEN(j)  (2304 + 64 * (j))
#define XB_TOP      3328
#define XB_TOPGEN   3392
#define XCD_BAR_WORDS 3456
#define XB_SPIN_CAP (1u << 18)

__device__ __forceinline__ unsigned xb_ld(unsigned* p)              { return __hip_atomic_load(p, __ATOMIC_RELAXED, __HIP_MEMORY_SCOPE_AGENT); }
__device__ __forceinline__ unsigned xb_add(unsigned* p, unsigned v) { return __hip_atomic_fetch_add(p, v, __ATOMIC_RELAXED, __HIP_MEMORY_SCOPE_AGENT); }
__device__ __forceinline__ unsigned xb_xcc_id() { return (unsigned)__builtin_amdgcn_s_getreg((3 << 11) | 20) & 0xFu; }
#define XB_SPIN(cond, bar) do { unsigned _sp = 0; while (cond) { __builtin_amdgcn_s_sleep(1); \
    if ((++_sp & 255u) == 0u) { if (xb_ld(&(bar)[XB_TMO])) break; if (_sp > XB_SPIN_CAP) { atomicAdd(&(bar)[XB_TMO], 1u); break; } } } } while (0)

struct XcdBarrier {
    unsigned* bar; unsigned x;
    volatile LAS unsigned* st;
};

__device__ __forceinline__ XcdBarrier xcd_barrier_post(unsigned* bar, volatile LAS unsigned* st) {
    XcdBarrier b; b.bar = bar; b.x = xb_xcc_id(); b.st = st;
    if (threadIdx.x == 0) (void)xb_add(&bar[XB_XCNT(b.x)], 1u);
    return b;
}
__device__ __forceinline__ void xcd_barrier_complete(unsigned* bar, unsigned x, unsigned& nloc, unsigned& nx) {
    const unsigned G = gridDim.x * gridDim.y * gridDim.z;
    unsigned sum, cnt, mine, sp = 0u;
    for (;;) {
        sum = 0u; cnt = 0u; mine = 0u;
#pragma unroll
        for (unsigned j = 0; j < 16; ++j) { const unsigned c = xb_ld(&bar[XB_XCNT(j)]); sum += c; cnt += (c > 0u) ? 1u : 0u; mine = (j == x) ? c : mine; }
        if (sum == G) break;
        __builtin_amdgcn_s_sleep(1);
        if ((++sp & 255u) == 0u) { if (xb_ld(&bar[XB_TMO])) break; if (sp > XB_SPIN_CAP) { atomicAdd(&bar[XB_TMO], 1u); break; } }
    }
    nloc = mine > 0u ? mine : 1u; nx = cnt > 0u ? cnt : 1u;
}

__device__ __forceinline__ void xcd_barrier(const XcdBarrier& b) {
    asm volatile("s_waitcnt vmcnt(0)" ::: "memory");
    __syncthreads();
    if (threadIdx.x == 0) {
        unsigned* bar = b.bar;
        __builtin_amdgcn_s_waitcnt(0);
        unsigned nloc = b.st[0], nx = b.st[1];
        if (nloc == 0u) { xcd_barrier_complete(bar, b.x, nloc, nx); b.st[0] = nloc; b.st[1] = nx; }
        const unsigned old = xb_add(&bar[XB_XSUB(b.x)], 1u);
        const unsigned gen = old / nloc;
        if (old + 1u == (gen + 1u) * nloc) {
            __builtin_amdgcn_fence(__ATOMIC_RELEASE, "agent");
            asm volatile("s_waitcnt vmcnt(0)" ::: "memory");
            const unsigned og = xb_add(&bar[XB_TOP], 1u);
            const unsigned tg = og / nx;
            if (og + 1u == (tg + 1u) * nx) xb_add(&bar[XB_TOPGEN], 1u);
            else XB_SPIN(xb_ld(&bar[XB_TOPGEN]) == tg, bar);
            __builtin_amdgcn_fence(__ATOMIC_ACQUIRE, "agent");
            xb_add(&bar[XB_XGEN(b.x)], 1u);
            asm volatile("s_waitcnt vmcnt(0)" ::: "memory");
        } else {
            XB_SPIN(xb_ld(&bar[XB_XGEN(b.x)]) == gen, bar);
            __builtin_amdgcn_fence(__ATOMIC_ACQUIRE, "agent");
            asm volatile("s_waitcnt vmcnt(0)" ::: "memory");
        }
    }
    __syncthreads();
}

#ifndef MK_MULTI
#define MK_MULTI 0
#endif
constexpr int N_PHASES = 40;

constexpr int LDS_PARAMS = LDS_BYTES - 1024;
constexpr int LDS_XB = LDS_BYTES - 64;
constexpr int CW_BAR = 8192;
__device__ __forceinline__ unsigned long long uni64(unsigned long long v) {
    const unsigned lo = __builtin_amdgcn_readfirstlane((unsigned)v), hi = __builtin_amdgcn_readfirstlane((unsigned)(v >> 32));
    return ((unsigned long long)hi << 32) | lo;
}
__device__ __forceinline__ int opq(int v) { asm volatile("" : "+s"(v)); return v; }
__device__ __forceinline__ void load_params(LAS unsigned char* lds, Params& q) {
    LAS const unsigned long long* s = (LAS const unsigned long long*)(lds + LDS_PARAMS);
#pragma unroll
    for (int i = 0; i < 37; ++i) q.in[i] = (const float*)(const __attribute__((address_space(1))) float*)uni64(s[i]);
    q.out = (float*)(__attribute__((address_space(1))) float*)uni64(s[37]); q.ws = (unsigned char*)(__attribute__((address_space(1))) unsigned char*)uni64(s[38]); q.ph_lo = 0; q.ph_hi = 0;
}
__global__ void __launch_bounds__(NTHREADS, 2) mk_fwd(Params kp) {
    extern __shared__ __attribute__((aligned(16))) unsigned char lds_raw[];
    LAS unsigned char* lds = (LAS unsigned char*)lds_raw;
    cg::grid_group grid = cg::this_grid();
    if (threadIdx.x == 0) {
        LAS unsigned long long* s = (LAS unsigned long long*)(lds + LDS_PARAMS);
#pragma unroll
        for (int i = 0; i < 37; ++i) s[i] = (unsigned long long)kp.in[i];
        s[37] = (unsigned long long)kp.out; s[38] = (unsigned long long)kp.ws;
    }
    if (threadIdx.x < 2) ((LAS unsigned*)(lds + LDS_XB))[threadIdx.x] = 0u;
    __syncthreads();
#if !MK_MULTI
    (void)xcd_barrier_post((unsigned*)(kp.ws + WS_CTL) + CW_BAR, (volatile LAS unsigned*)(lds + LDS_XB));
#endif
    const int ph_lo = kp.ph_lo, ph_hi = kp.ph_hi;
    int ph = 0;
#define PH_BEGIN if (ph >= ph_lo && ph < ph_hi) { asm volatile("" ::: "memory"); Params p; load_params(lds, p); unsigned char* ws = p.ws; (void)ws; \
    int tid_ = threadIdx.x, bid_ = blockIdx.x, G_ = gridDim.x; asm volatile("" : "+v"(tid_), "+s"(bid_), "+s"(G_)); \
    const int tid = tid_, bid = bid_, G = G_, lane = tid & 63, wave = __builtin_amdgcn_readfirstlane(tid >> 6); const int gw = bid * NWAVES + wave, NGW = G * NWAVES; (void)gw; (void)NGW; (void)lane; (void)tid; (void)G; (void)bid;
#define GRID_SEAM() do { if (ph == 0) grid.sync(); else { XcdBarrier xb_; xb_.bar = (unsigned*)((unsigned char*)(__attribute__((address_space(1))) unsigned char*)uni64(((LAS const unsigned long long*)(lds + LDS_PARAMS))[38]) + WS_CTL) + CW_BAR; \
        xb_.x = xb_xcc_id(); xb_.st = (volatile LAS unsigned*)(lds + LDS_XB); xcd_barrier(xb_); } } while (0)
#define PH_END } if (ph >= ph_lo && ph + 1 < ph_hi) GRID_SEAM(); ++ph;

    using pg8::Gemm; using pg8::StaticOrder; using pg8::gemm_phase;

    PH_BEGIN
        convert_layer_weights(p, 0, lds, gw, NGW, wave, lane);
        __syncthreads();
        adaln_phase(p, lds, wave, lane);
    PH_END
    PH_BEGIN
        premix_phase(p, 0, true, NTOK, gw, NGW, lane);
    PH_END

#pragma clang loop unroll(full)
    for (int layer = 0; layer < 2; ++layer) {
        const int Ml = layer == 0 ? NTOK : NLAT;
        const float lam_init = 0.8f - 0.6f * expf(-0.3f * (float)layer);
        PH_BEGIN
            Gemm g{(const bf16_t*)(ws + WS_XN), (const bf16_t*)(ws + WS_WIN), NTOK, NIN1, opq(1024), 1024}; StaticOrder S; S.init(NTOK, NIN1, G, bid);
            EpiIn E{(bf16_t*)(ws + WS_P), (bf16_t*)(ws + WS_VTS), (bf16_t*)(ws + WS_VTD), (const float*)(ws + WS_ROPE)};
            gemm_phase<EpiIn, StaticOrder, true, true>(lds, g, S, E);
        PH_END
        PH_BEGIN
            rwkv_prepare_phase(p, layer, gw, NGW, lane);
        PH_END
        PH_BEGIN
            Gemm g{(const bf16_t*)(ws + WS_YA), (const bf16_t*)(ws + WS_LORA), NTOK, 2560, opq(128), 384}; LoraSched S; S.S.init(NTOK, 2560, G, bid);
            EpiLora E{(float*)(ws + WS_ST), (bf16_t*)(ws + WS_P), p.in[14] + layer * 1024, p.in[16] + layer * 1024, p.in[20] + layer * 512};
            gemm_phase<EpiLora, LoraSched, true, true>(lds, g, S, E);
        PH_END
        PH_BEGIN
            for (int u = gw; u < 32 * (NSEG - 1); u += NGW) rwkv_segment<0>(p, u / (NSEG - 1), u % (NSEG - 1), lane, lds + wave * SCAN_LDS);
        PH_END
        PH_BEGIN
            unsigned* qhead = (unsigned*)(ws + WS_CTL) + (layer == 0 ? CW_Q0 : CW_Q1);
            LAS int* ubox = (LAS int*)(lds + 65536);
            const int n_swa = 512 + (layer == 0 ? 16 : 0);
            if (bid < 32) rwkv_combine(p, bid, lds, wave, lane);
            if (bid >= 32 || G <= 32)
            for (;;) {
                if (tid == 0) ubox[0] = (int)atomicAdd(qhead, 1u);
                __syncthreads();
                const int u = ubox[0];
                __syncthreads();
                if (u >= n_swa) break;
                if (u < 512) swa_unit(lds, p, layer, u >> 8, (u >> 5) & 7, u & 31, false, wave, lane);
                else { const int v = u - 512; swa_unit(lds, p, layer, v >> 3, v & 7, 0, true, wave, lane); }
            }
        PH_END
        PH_BEGIN
            for (int u = gw; u < 32 * NSEG; u += NGW) rwkv_segment<2>(p, u / NSEG, u % NSEG, lane, lds + wave * SCAN_LDS);
            asm volatile("s_waitcnt vmcnt(0)" ::: "memory");
            __syncthreads();
            float lam;
            { const float* lv = p.in[24] + layer * 256;
              const float s1 = wave_sum(lv[lane] * lv[64 + lane]), s2 = wave_sum(lv[128 + lane] * lv[192 + lane]);
              lam = expf(s1) - expf(s2) + lam_init; }
            for (int u = bid; u < 256; u += G) { const int v = G == 256 ? ((((u & 7) >> 2) << 7) | ((u & 3) << 5) | (u >> 3)) : u; diff_unit(lds, p, lam, v >> 7, (v >> 5) & 3, v & 31, false, wave, lane); }
            if (layer == 0) for (int u = bid; u < 8; u += G) diff_unit(lds, p, lam, u >> 2, u & 3, 0, true, wave, lane);
        PH_END
        PH_BEGIN
            postmix_phase(p, layer, lam_init, Ml, gw, NGW, lane);
            if (layer == 0) convert_ffn_weights(p, lds, gw, NGW, wave, lane);
            __syncthreads();
            Gemm g{(const bf16_t*)(ws + WS_XN), (const bf16_t*)(ws + WS_WIN) + (size_t)NIN1 * 1024, Ml, 3072, opq(1024), 1024}; StaticOrder S; S.init(Ml, 3072, G, bid);
            EpiGate E{(bf16_t*)(ws + WS_G)};
            gemm_phase<EpiGate, StaticOrder, true, true>(lds, g, S, E);
        PH_END
        PH_BEGIN
            StaticOrder S; S.init(Ml, 1024, G, bid);
            { Gemm g{(const bf16_t*)(ws + WS_YA), (const bf16_t*)(ws + WS_PRJ), Ml, 1024, opq(512), 512}; EpiMerge<0> E{(const bf16_t*)(ws + WS_G), (bf16_t*)(ws + WS_MF), (bf16_t*)(ws + WS_MB)};
              gemm_phase<EpiMerge<0>, StaticOrder, true, true>(lds, g, S, E); }
            { Gemm g{(const bf16_t*)(ws + WS_YB), (const bf16_t*)(ws + WS_PRJ) + 1024 * 512, Ml, 1024, opq(512), 512}; EpiMerge<1> E{(const bf16_t*)(ws + WS_G), (bf16_t*)(ws + WS_MF), (bf16_t*)(ws + WS_MB)};
              gemm_phase<EpiMerge<1>, StaticOrder, true, true>(lds, g, S, E); }
            { Gemm g{(const bf16_t*)(ws + WS_YC), (const bf16_t*)(ws + WS_PRJ) + 2 * 1024 * 512, Ml, 1024, opq(512), 512}; EpiMerge<2> E{(const bf16_t*)(ws + WS_G), (bf16_t*)(ws + WS_MF), (bf16_t*)(ws + WS_MB)};
              gemm_phase<EpiMerge<2>, StaticOrder, true, true>(lds, g, S, E); }
        PH_END
        PH_BEGIN
            Gemm g{(const bf16_t*)(ws + WS_MB), (const bf16_t*)(ws + WS_WOUT), Ml, 1024, opq(1024), 1024}; StaticOrder S; S.init(Ml, 1024, G, bid);
            EpiBf E{(bf16_t*)(ws + WS_MOUT), 1024};
            gemm_phase<EpiBf, StaticOrder, true, true>(lds, g, S, E);
        PH_END
        PH_BEGIN
            residual_phase(p, (const bf16_t*)(ws + WS_MOUT), nullptr, nullptr, layer == 0, layer, 2, p.in[7] + layer * 1024, true, p.in[8] + layer * 1024, layer, 3, layer == 1, Ml, gw, NGW, lane);
            if (layer == 0) convert_layer_weights(p, 1, lds, gw, NGW, wave, lane);
            else convert_moe_weights(p, lds, gw, NGW, wave, lane);
        PH_END
        if (layer == 0) {
            PH_BEGIN
                Gemm g{(const bf16_t*)(ws + WS_XN), (const bf16_t*)(ws + WS_FGU), NTOK, 2 * D_FF, opq(1024), 1024}; StaticOrder S; S.init(NTOK, 2 * D_FF, G, bid);
                EpiSwiglu E{(bf16_t*)(ws + WS_HID), D_FF, 1 << 20, 0};
                gemm_phase<EpiSwiglu, StaticOrder, true, true>(lds, g, S, E);
            PH_END
            PH_BEGIN
                Gemm g{(const bf16_t*)(ws + WS_HID), (const bf16_t*)(ws + WS_FD), NTOK, 1024, opq(D_FF), D_FF}; StaticOrder S; S.init(NTOK, 1024, G, bid);
                EpiBf E{(bf16_t*)(ws + WS_MF), 1024};
                gemm_phase<EpiBf, StaticOrder, true, true>(lds, g, S, E);
            PH_END
            PH_BEGIN
                residual_phase(p, (const bf16_t*)(ws + WS_MF), nullptr, nullptr, false, 0, 5, p.in[9], true, p.in[6] + 1024, 1, 0, false, NTOK, gw, NGW, lane);
            PH_END
        }
    }
    {
        {
            PH_BEGIN
                const unsigned* cnt = (const unsigned*)(ws + WS_CTL) + CW_CNT; int ts[9]; ts[0] = 0;
#pragma unroll
                for (int e = 0; e < 8; ++e) ts[e + 1] = ts[e] + (int)((__hip_atomic_load(cnt + e, __ATOMIC_RELAXED, __HIP_MEMORY_SCOPE_AGENT) + 255u) >> 8);
                const int* LIST = (const int*)(ws + WS_LIST); const bf16_t* XN = (const bf16_t*)(ws + WS_XN2); bf16_t* XG = (bf16_t*)(ws + WS_XG);
                for (int r = gw; r < ts[8] * 256; r += NGW) {
                    const int tile = r >> 8; int e = 0;
#pragma unroll
                    for (int q = 1; q < 8; ++q) e += (tile >= ts[q]) ? 1 : 0;
                    int tse = 0;
#pragma unroll
                    for (int q = 0; q < 8; ++q) tse = (q == e) ? ts[q] : tse;
                    const int slot = r - tse * 256;
                    u32x4 v0 = (u32x4){0u, 0u, 0u, 0u}, v1 = v0;
                    if (slot < (int)cnt[e]) { const int tk = LIST[e * 16384 + slot]; const u32x4* src = (const u32x4*)(XN + (size_t)(tk >> 1) * 1024); v0 = src[lane]; v1 = src[lane + 64]; }
                    u32x4* dst = (u32x4*)(XG + (size_t)r * 1024); dst[lane] = v0; dst[lane + 64] = v1;
                }
            PH_END
            PH_BEGIN
                const unsigned* cnt = (const unsigned*)(ws + WS_CTL) + CW_CNT; int ts[9]; ts[0] = 0;
#pragma unroll
                for (int e = 0; e < 8; ++e) ts[e + 1] = ts[e] + (int)((__hip_atomic_load(cnt + e, __ATOMIC_RELAXED, __HIP_MEMORY_SCOPE_AGENT) + 255u) >> 8);
                MoeSched S;
#pragma unroll
                for (int e = 0; e < 9; ++e) S.ts[e] = ts[e];
                S.pm_lo = 0; S.pm_hi = ts[8]; S.npn = 28; S.G = G; S.c = bid; S.a_local = false;
                Gemm g{(const bf16_t*)(ws + WS_XG), (const bf16_t*)(ws + WS_MGU), 0, 0, opq(1024), 1024};
                EpiSwiglu E{(bf16_t*)(ws + WS_HIDM), D_FFE, 28, 0};
                gemm_phase<EpiSwiglu, MoeSched, true, true>(lds, g, S, E);
            PH_END
            PH_BEGIN
                const unsigned* cnt = (const unsigned*)(ws + WS_CTL) + CW_CNT; int ts[9]; ts[0] = 0;
#pragma unroll
                for (int e = 0; e < 8; ++e) ts[e + 1] = ts[e] + (int)((__hip_atomic_load(cnt + e, __ATOMIC_RELAXED, __HIP_MEMORY_SCOPE_AGENT) + 255u) >> 8);
                MoeSched S;
#pragma unroll
                for (int e = 0; e < 9; ++e) S.ts[e] = ts[e];
                S.pm_lo = 0; S.pm_hi = ts[8]; S.npn = 4; S.G = G; S.c = bid; S.a_local = false;
                Gemm g{(const bf16_t*)(ws + WS_HIDM), (const bf16_t*)(ws + WS_MD), 0, 0, opq(D_FFE), D_FFE};
                EpiMoeDown E; E.FS = (bf16_t*)(ws + WS_FACC); E.slot1_off = ((long)WS_MGU - (long)WS_FACC) / 2; E.LIST = (const int*)(ws + WS_LIST); E.WTS = (const float*)(ws + WS_WTS); E.cnt = cnt; E.pm_lo = 0;
#pragma unroll
                for (int e = 0; e < 9; ++e) E.ts[e] = ts[e];
                gemm_phase<EpiMoeDown, MoeSched, true, true>(lds, g, S, E);
            PH_END
            PH_BEGIN
                residual_phase(p, (const bf16_t*)(ws + WS_FACC), (const bf16_t*)(ws + WS_MGU), nullptr, false, 1, 5, p.in[9] + 1024, false, nullptr, 0, 0, false, NLAT, gw, NGW, lane);
            PH_END
        }
    }
#undef PH_BEGIN
#undef PH_END
}

extern "C" void kernel_launch(void* const* d_in, const int* in_sizes, int n_in, void* d_out, int out_size, void* d_ws, size_t ws_size, hipStream_t stream) {
    static int grid = 0;
    if (grid == 0) {
        if (n_in != 37 || out_size != NLAT * DM || ws_size < WS_NEED) { fprintf(stderr, "kernel_launch: unexpected shapes (n_in %d out %d ws %zu need %zu)\n", n_in, out_size, ws_size, (size_t)WS_NEED); grid = -1; return; }
        int dev = 0, cus = 0, per_cu = 0;
        (void)hipGetDevice(&dev);
        (void)hipDeviceGetAttribute(&cus, hipDeviceAttributeMultiprocessorCount, dev);
        (void)hipFuncSetAttribute((const void*)mk_fwd, hipFuncAttributeMaxDynamicSharedMemorySize, LDS_BYTES);
        (void)hipOccupancyMaxActiveBlocksPerMultiprocessor(&per_cu, (const void*)mk_fwd, NTHREADS, LDS_BYTES);
        if (per_cu < 1) { fprintf(stderr, "kernel_launch: occupancy query reports %d blocks per CU\n", per_cu); grid = -1; return; }
        grid = cus;
        fprintf(stderr, "kernel_launch: grid %d (cus %d, per_cu %d), ws %zu\n", grid, cus, per_cu, ws_size);
    }
    if (grid < 0) return;
    (void)hipMemsetAsync((char*)d_ws + WS_CTL, 0, CTL_BYTES, stream);
    Params prm{};
    for (int i = 0; i < 37; ++i) prm.in[i] = (const float*)d_in[i];
    prm.out = (float*)d_out; prm.ws = (unsigned char*)d_ws;
#if MK_MULTI
    for (int ph = 0; ph < N_PHASES; ++ph) { prm.ph_lo = ph; prm.ph_hi = ph + 1; hipLaunchKernelGGL(mk_fwd, dim3(grid), dim3(NTHREADS), LDS_BYTES, stream, prm); }
#else
    prm.ph_lo = 0; prm.ph_hi = 1 << 20;
    void* args[] = {&prm};
    hipError_t e = hipLaunchCooperativeKernel((const void*)mk_fwd, dim3(grid), dim3(NTHREADS), args, LDS_BYTES, stream);
    if (e != hipSuccess) fprintf(stderr, "kernel_launch: cooperative launch failed: %s (grid %d)\n", hipGetErrorString(e), grid);
#endif
}
```

```cpp
#include <hip/hip_runtime.h>
#include <hip/hip_cooperative_groups.h>
#include <cstdio>
#include <cstdint>
namespace cg = cooperative_groups;
namespace pg8 {
#define PG8_LAS __attribute__((address_space(3)))
typedef unsigned short bf16_t;
typedef short bf16x8 __attribute__((ext_vector_type(8)));
typedef float f32x4 __attribute__((ext_vector_type(4)));
typedef unsigned u32x4 __attribute__((ext_vector_type(4)));
constexpr int BM = 256, BK = 64, HALF = 128, HTB = HALF * BK * 2  , STAGE_BYTES = 8 * HTB, NXCD = 8, WGM = 8;

__host__ __device__ __forceinline__ int lds_byte(int r, int c) { const int st = (r >> 4) * 2 + (c >> 5), rr = r & 15, cc = c & 31, ob = rr * 64 + cc * 2; return st * 1024 + (ob ^ (((ob >> 9) & 1) << 5)); }
__host__ __device__ __forceinline__ void stage_rc(int b, int& R, int& C) { const int st = b / 1024, sb = b % 1024, swz = sb ^ (((sb >> 9) & 1) << 5); R = (st >> 1) * 16 + swz / 64; C = (st & 1) * 32 + (swz % 64) / 2; }
__host__ __device__ __forceinline__ int perm32(int rho) { const int n = rho >> 4, i = rho & 15; return 8 * (i >> 2) + 4 * n + (i & 3); }

struct Unit { int pm, pn, koff, tail; };
struct Gemm { const bf16_t* A; const bf16_t* Bt; int M, N, K, ld; };

struct StaticOrder {
    int nM, nN, nwg, G, c;
    __host__ __device__ void init(int M, int N, int G_, int c_) { nM = M / BM; nN = N / BM; nwg = nM * nN; G = G_; c = c_; }
    __host__ __device__ bool next(int i, Unit& u) const {
        const long L = (long)i * G + c; if (L >= nwg) return false;
        int wgid = (int)L; { const int q = nwg / NXCD, r = nwg % NXCD, xcd = wgid % NXCD, off = wgid / NXCD; wgid = (xcd < r ? xcd * (q + 1) : r * (q + 1) + (xcd - r) * q) + off; }
        const int nig = WGM * nN, gid = wgid / nig, fm = gid * WGM, gsz = (nM - fm) < WGM ? (nM - fm) : WGM;
        u.pm = fm + ((wgid % nig) % gsz); u.pn = (wgid % nig) / gsz; u.koff = 0; u.tail = -1; return true;
    }
    __device__ __forceinline__ void a_ready(const Unit&) const {}
    __device__ __forceinline__ void done(const Unit&) const {}
};

__device__ __forceinline__ unsigned cvt_pk_bf16(float lo, float hi) { unsigned r; asm volatile("v_cvt_pk_bf16_f32 %0, %1, %2" : "=v"(r) : "v"(lo), "v"(hi)); return r; }
typedef float f32x2 __attribute__((ext_vector_type(2)));
template <class Epi, class Sched, bool ALIGN_EPI = false, bool SP2 = false>
__device__ __forceinline__ void gemm_phase(PG8_LAS unsigned char* lds, const Gemm g, const Sched& S, const Epi& E) {
    int tid_ = threadIdx.x; asm volatile("" : "+v"(tid_)); const int tid = tid_, wid = __builtin_amdgcn_readfirstlane(tid >> 6), lane = tid & 63, wr = wid >> 2, wc = wid & 3, fr = lane & 15, fq = lane >> 4;
    const int K = g.ld, nt = g.K / BK;
    unsigned voffA[2], voffB[2];
#pragma unroll
    for (int i = 0; i < 2; ++i) { int R, C; stage_rc(tid * 16 + i * 8192, R, C); const int Rb = Epi::PERM ? ((R & ~31) + perm32(R & 31)) : R;
        voffA[i] = (unsigned)(R * K + C) * 2u; voffB[i] = (unsigned)(Rb * K + C) * 2u; }
    const size_t kstep = (size_t)(BK * 2);
    const size_t hstep = (size_t)HALF * K * 2;
    const size_t tstep = 2 * hstep;
    const unsigned ldsw = (unsigned)wid * 1024u;
    const int aoff = lds_byte(wr * 64 + fr, fq * 8), boff = lds_byte(wc * 32 + fr, fq * 8);
#define PG8_SA(b, h) (((b) * 2 + (h)) * HTB)
#define PG8_SB(b, h) ((4 + (b) * 2 + (h)) * HTB)
#define PG8_STAGE(bufoff, gbase, voff) do { _Pragma("unroll") for (int _i = 0; _i < 2; ++_i) \
        __builtin_amdgcn_global_load_lds((const unsigned*)((const char*)(gbase) + (voff)[_i]), (PG8_LAS unsigned*)(lds + (bufoff) + ldsw + _i * 8192), 16, 0, 0); } while (0)
#define PG8_LDA(dst, b, h) do { _Pragma("unroll") for (int m = 0; m < 4; ++m) _Pragma("unroll") for (int k = 0; k < 2; ++k) dst[m][k] = *(const PG8_LAS bf16x8*)(lds + PG8_SA(b, h) + aoff + m * 2048 + k * 1024); } while (0)
#define PG8_LDB(dst, b, h) do { _Pragma("unroll") for (int n = 0; n < 2; ++n) _Pragma("unroll") for (int k = 0; k < 2; ++k) dst[n][k] = *(const PG8_LAS bf16x8*)(lds + PG8_SB(b, h) + boff + n * 2048 + k * 1024); } while (0)
#define PG8_MMA(ai, bj, At, Bt) do { __builtin_amdgcn_s_setprio(1); _Pragma("unroll") for (int m = 0; m < 4; ++m) _Pragma("unroll") for (int n = 0; n < 2; ++n) _Pragma("unroll") for (int k = 0; k < 2; ++k) \
        acc[ai][bj][m][n] = __builtin_amdgcn_mfma_f32_16x16x32_bf16(Bt[n][k], At[m][k], acc[ai][bj][m][n], 0, 0, 0); __builtin_amdgcn_s_setprio(0); } while (0)
#define PG8_WAIT_V(n) asm volatile("s_waitcnt vmcnt(" #n ")" ::: "memory")
#define PG8_WAIT_L(n) asm volatile("s_waitcnt lgkmcnt(" #n ")" ::: "memory")
#define PG8_BAR __builtin_amdgcn_s_barrier()
#define PG8_SCHED __builtin_amdgcn_sched_barrier(0)
    Unit cur, nxt; int ui = 0;
    if (!S.next(0, cur)) return;
    f32x4 acc[2][2][4][2];
#pragma unroll
    for (int a = 0; a < 2; ++a)
#pragma unroll
        for (int b = 0; b < 2; ++b)
#pragma unroll
            for (int m = 0; m < 4; ++m)
#pragma unroll
                for (int n = 0; n < 2; ++n) acc[a][b][m][n] = (f32x4){0.f, 0.f, 0.f, 0.f};
    bf16x8 At[4][2], B0[2][2], B1[2][2];
    const char* cA = (const char*)g.A + (size_t)cur.pm * tstep + (size_t)cur.koff * 2; const char* cB = (const char*)g.Bt + (size_t)cur.pn * tstep + (size_t)cur.koff * 2;
    S.a_ready(cur);
    if constexpr (SP2) {
        PG8_STAGE(PG8_SB(0, 0), cB, voffB); PG8_STAGE(PG8_SB(0, 1), cB + hstep, voffB); PG8_STAGE(PG8_SA(0, 0), cA, voffA); PG8_STAGE(PG8_SA(0, 1), cA + hstep, voffA);
        if (wr == 1) PG8_BAR;
        PG8_WAIT_V(2); PG8_BAR;
        PG8_STAGE(PG8_SB(1, 0), cB + kstep, voffB); PG8_STAGE(PG8_SA(1, 0), cA + kstep, voffA); PG8_STAGE(PG8_SB(1, 1), cB + hstep + kstep, voffB);
        PG8_WAIT_V(6); PG8_BAR;
    } else {
        PG8_STAGE(PG8_SB(0, 0), cB, voffB); PG8_STAGE(PG8_SA(0, 0), cA, voffA); PG8_STAGE(PG8_SB(0, 1), cB + hstep, voffB); PG8_STAGE(PG8_SA(0, 1), cA + hstep, voffA);
        if (wr == 1) PG8_BAR;
        PG8_WAIT_V(4); PG8_BAR;
        PG8_STAGE(PG8_SB(1, 0), cB + kstep, voffB); PG8_STAGE(PG8_SA(1, 0), cA + kstep, voffA); PG8_STAGE(PG8_SB(1, 1), cB + hstep + kstep, voffB);
        PG8_WAIT_V(6); PG8_BAR;
    }
    for (;;) {
        const bool has_next = S.next(ui + 1, nxt);
        const char* nA = has_next ? (const char*)g.A + (size_t)nxt.pm * tstep + (size_t)nxt.koff * 2 : cA; const char* nB = has_next ? (const char*)g.Bt + (size_t)nxt.pn * tstep + (size_t)nxt.koff * 2 : cB;
        for (int t = 0; t < nt; t += 2) {
            const bool last = (t == nt - 2);
            const char* a1 = cA + (size_t)(t + 1) * kstep;
            const char* a2 = last ? nA : cA + (size_t)(t + 2) * kstep; const char* b2 = last ? nB : cB + (size_t)(t + 2) * kstep;
            const char* a3 = a2 + kstep; const char* b3 = b2 + kstep;
            if (last && has_next) S.a_ready(nxt);
            if constexpr (SP2) {
            PG8_LDB(B0, 0, 0); PG8_LDB(B1, 0, 1); PG8_SCHED; PG8_LDA(At, 0, 0); PG8_STAGE(PG8_SA(1, 1), a1 + hstep, voffA);
            PG8_WAIT_V(8); PG8_WAIT_L(0); PG8_BAR; PG8_MMA(0, 0, At, B0); PG8_MMA(0, 1, At, B1); PG8_BAR; PG8_SCHED;
            PG8_LDA(At, 0, 1); PG8_STAGE(PG8_SB(0, 0), b2, voffB); PG8_STAGE(PG8_SB(0, 1), b2 + hstep, voffB); PG8_STAGE(PG8_SA(0, 0), a2, voffA);
            PG8_WAIT_V(8); PG8_WAIT_L(0); PG8_BAR; PG8_MMA(1, 0, At, B0); PG8_MMA(1, 1, At, B1); PG8_BAR; PG8_SCHED;
            PG8_LDB(B0, 1, 0); PG8_LDB(B1, 1, 1); PG8_SCHED; PG8_LDA(At, 1, 0); PG8_STAGE(PG8_SA(0, 1), a2 + hstep, voffA);
            PG8_WAIT_V(8); PG8_WAIT_L(0); PG8_BAR; PG8_MMA(0, 0, At, B0); PG8_MMA(0, 1, At, B1); PG8_BAR; PG8_SCHED;
            PG8_LDA(At, 1, 1); PG8_STAGE(PG8_SB(1, 0), b3, voffB); PG8_STAGE(PG8_SB(1, 1), b3 + hstep, voffB); PG8_STAGE(PG8_SA(1, 0), a3, voffA);
            PG8_WAIT_V(8); PG8_WAIT_L(0); PG8_BAR; PG8_MMA(1, 0, At, B0); PG8_MMA(1, 1, At, B1); PG8_BAR; PG8_SCHED;
            } else {
            PG8_LDB(B0, 0, 0); PG8_SCHED; PG8_LDA(At, 0, 0); PG8_STAGE(PG8_SA(1, 1), a1 + hstep, voffA);
            PG8_WAIT_L(8); PG8_BAR; PG8_WAIT_L(0); PG8_MMA(0, 0, At, B0); PG8_BAR; PG8_SCHED;
            PG8_LDB(B1, 0, 1); PG8_STAGE(PG8_SB(0, 0), b2, voffB);
            PG8_BAR; PG8_WAIT_L(0); PG8_MMA(0, 1, At, B1); PG8_BAR;
            PG8_LDA(At, 0, 1); PG8_STAGE(PG8_SA(0, 0), a2, voffA);
            PG8_BAR; PG8_WAIT_L(0); PG8_MMA(1, 0, At, B0); PG8_BAR; PG8_SCHED;
            PG8_STAGE(PG8_SB(0, 1), b2 + hstep, voffB);
            PG8_WAIT_V(6); PG8_BAR; PG8_MMA(1, 1, At, B1); PG8_BAR;
            PG8_LDB(B0, 1, 0); PG8_SCHED; PG8_LDA(At, 1, 0); PG8_STAGE(PG8_SA(0, 1), a2 + hstep, voffA);
            PG8_WAIT_L(8); PG8_BAR; PG8_WAIT_L(0); PG8_MMA(0, 0, At, B0); PG8_BAR; PG8_SCHED;
            PG8_LDB(B1, 1, 1); PG8_STAGE(PG8_SB(1, 0), b3, voffB);
            PG8_BAR; PG8_WAIT_L(0); PG8_MMA(0, 1, At, B1); PG8_BAR;
            PG8_LDA(At, 1, 1); PG8_STAGE(PG8_SA(1, 0), a3, voffA);
            PG8_BAR; PG8_WAIT_L(0); PG8_MMA(1, 0, At, B0); PG8_BAR; PG8_SCHED;
            PG8_STAGE(PG8_SB(1, 1), b3 + hstep, voffB);
            PG8_WAIT_V(6); PG8_BAR; PG8_MMA(1, 1, At, B1); PG8_BAR;
            }
        }
        if constexpr (ALIGN_EPI) { if (wr == 0) PG8_BAR; }
        if constexpr (!Epi::AFTER_DRAIN) { E(acc, cur, wr, wc, fr, fq); S.done(cur); }
        if (!has_next) break;
#pragma unroll
        for (int a = 0; a < 2; ++a)
#pragma unroll
            for (int b = 0; b < 2; ++b)
#pragma unroll
                for (int m = 0; m < 4; ++m)
#pragma unroll
                    for (int n = 0; n < 2; ++n) acc[a][b][m][n] = (f32x4){0.f, 0.f, 0.f, 0.f};
        cur = nxt; cA = nA; cB = nB; ++ui;
        if constexpr (ALIGN_EPI) { if (wr == 1) PG8_BAR; }
    }
    PG8_WAIT_V(0);
    if constexpr (!ALIGN_EPI) { if (wr == 0) PG8_BAR; }
    PG8_BAR;
    if constexpr (Epi::AFTER_DRAIN) { E.fused(acc, cur, wr, wc, fr, fq, lds, wid, lane); S.done(cur); }
#undef PG8_SA
#undef PG8_SB
#undef PG8_STAGE
#undef PG8_LDA
#undef PG8_LDB
#undef PG8_MMA
#undef PG8_WAIT_V
#undef PG8_WAIT_L
#undef PG8_BAR
#undef PG8_SCHED
}
}

#define LAS __attribute__((address_space(3)))
typedef unsigned short bf16_t;
typedef short bf16x8 __attribute__((ext_vector_type(8)));
typedef float f32x4 __attribute__((ext_vector_type(4)));
typedef float f32x16 __attribute__((ext_vector_type(16)));
typedef unsigned u32x4 __attribute__((ext_vector_type(4)));
typedef unsigned u32x2 __attribute__((ext_vector_type(2)));

constexpr int NTHREADS = 512, NWAVES = 8;
constexpr int DM = 1024, SEQ = 8192, CTXL = 256, NLAT = 2 * SEQ, NCTX = 2 * CTXL, NTOK = NLAT + NCTX, KEYS = SEQ + CTXL;
constexpr int D_IN = 7296, D_FF = 2816, D_FFE = 3584, NEXP = 8;
constexpr int IC_QS = 0, IC_KS = 512, IC_RW = 640, IC_QD = 2560, IC_KD = 3072, PP = 3584, IC_VS = 3584, IC_VD = 3712, IC_PAD = 4224, NIN1 = 4352, WIN_ROWS = 7424;
constexpr int ST_SLOTS = 8;
constexpr int MOE_TILES = 136, MOE_HALF = 68;

constexpr size_t MiB = 1u << 20;
constexpr size_t WS_CTL = 0, CTL_BYTES = 1 * MiB;
constexpr size_t WS_MODS = 1 * MiB;
constexpr size_t WS_ROPE = 1 * MiB + 256 * 1024;
constexpr size_t WS_HCTX = 2 * MiB;
constexpr size_t WS_LIST = 4 * MiB;
constexpr size_t WS_WTS = 4 * MiB + 512 * 1024;
constexpr size_t WS_WIN = 6 * MiB;
constexpr size_t WS_PRJ = WS_WIN + (size_t)WIN_ROWS * 1024 * 2;
constexpr size_t WS_WOUT = WS_PRJ + 3 * MiB;
constexpr size_t WS_LORA = WS_WOUT + 2 * MiB;
constexpr size_t WS_XN = 28 * MiB;
constexpr size_t WS_P = 61 * MiB;
constexpr size_t WS_VTS = 177 * MiB;
constexpr size_t WS_VTD = WS_VTS + 4608 * 1024;
constexpr size_t WS_ST = 198 * MiB;
constexpr size_t WS_YA = 495 * MiB;
constexpr size_t WS_YB = WS_YA + 16896ull * 512 * 2;
constexpr size_t WS_YC = WS_YB + 16896ull * 512 * 2;
constexpr size_t WS_END = WS_YC + 16896ull * 512 * 2;
constexpr size_t WS_G = WS_ST;
constexpr size_t WS_MF = WS_ST + 99 * MiB;
constexpr size_t WS_MB = WS_ST + 165 * MiB;
constexpr size_t WS_MOUT = WS_ST + 198 * MiB;
constexpr size_t WS_FGU = WS_VTS;
constexpr size_t WS_FD = WS_VTS + 11 * MiB;
constexpr size_t WS_HID = WS_P;
constexpr size_t WS_XN2 = 495 * MiB;
constexpr size_t WS_MGU = 6 * MiB;
constexpr size_t WS_MD = 118 * MiB;
constexpr size_t WS_XG = 174 * MiB;
constexpr size_t WS_FACC = 242 * MiB;
constexpr size_t WS_HIDM = 306 * MiB;
static_assert(WS_LORA + 2560 * 384 * 2 <= WS_XN && WS_XN + 16896ull * 1024 * 2 <= WS_P && WS_P + 16896ull * PP * 2 <= WS_VTS && WS_VTD + 2ull * 4 * 128 * KEYS * 2 <= WS_ST, "ws map 1");
static_assert(WS_ST + 16896ull * 8 * ST_SLOTS * 64 * 4 <= WS_YA && WS_END <= 545 * MiB, "ws map 2");
static_assert(WS_G + 16896ull * 3072 * 2 <= WS_MF && WS_MF + 16896ull * 1024 * 4 <= WS_MB && WS_MB + 16896ull * 1024 * 2 <= WS_MOUT && WS_MOUT + 16896ull * 1024 * 4 <= WS_YA, "ws map 3");
static_assert(WS_FGU + 5632ull * 1024 * 2 <= WS_FD && WS_FD + 1024ull * 2816 * 2 <= WS_ST && WS_HID + 16896ull * 2816 * 2 <= WS_VTS, "ws map 4");
static_assert(WS_MGU + 8ull * 7168 * 1024 * 2 <= WS_MD && WS_MD + 8ull * 1024 * 3584 * 2 <= WS_XG && WS_XG + 34816ull * 1024 * 2 <= WS_FACC && WS_FACC + 16384ull * 1024 * 4 <= WS_HIDM && WS_HIDM + 136ull * 256 * 3584 * 2 <= 560 * MiB, "ws map 5");
static_assert(WS_FACC + 16384ull * 1024 * 4 <= WS_MOUT && WS_XN2 + 16384ull * 1024 * 2 <= 560 * MiB && WS_XN2 >= WS_MOUT + 16896ull * 1024 * 4, "expert weights / gathered rows / accumulator must not touch MOUT or XN2 while they are live");
constexpr size_t WS_NEED = 560 * MiB;
constexpr int CW_CNT = 0;
constexpr int CW_Q0 = 64, CW_Q1 = 128;

constexpr int LDS_BYTES = 147456;

__device__ __forceinline__ unsigned f2bf(float f) { unsigned u = __builtin_bit_cast(unsigned, f); return (u + 0x7fffu + ((u >> 16) & 1u)) >> 16; }
typedef float f32x2_t __attribute__((ext_vector_type(2))); typedef __bf16 bf16x2_t __attribute__((ext_vector_type(2)));
__device__ __forceinline__ unsigned pk2(float lo, float hi) { const f32x2_t v = {lo, hi}; return __builtin_bit_cast(unsigned, __builtin_convertvector(v, bf16x2_t)); }
__device__ __forceinline__ float bflo(unsigned w) { return __uint_as_float(w << 16); }
__device__ __forceinline__ float bfhi(unsigned w) { return __uint_as_float(w & 0xffff0000u); }
__device__ __forceinline__ float wave_sum(float v) {
#pragma unroll
    for (int o = 1; o < 64; o <<= 1) v += __shfl_xor(v, o);
    return v;
}
__device__ __forceinline__ float sigmoidf_(float x) { return 1.0f / (1.0f + __expf(-x)); }
__device__ __forceinline__ float siluf_(float x) { return x / (1.0f + __expf(-x)); }
#define LDS_WAIT() asm volatile("s_waitcnt lgkmcnt(0)" ::: "memory")

struct Params {
    const float* in[37];
    float* out;
    unsigned char* ws;
    int ph_lo, ph_hi;
};

template <class F>
__device__ __forceinline__ void transpose_item(const float* __restrict__ W, int ldw, int k0, int n0, bf16_t* __restrict__ WT, int ldt, int dcol0, F rowmap, LAS float* scr, int lane) {
#pragma unroll 8
    for (int i = 0; i < 32; ++i) { const int kk = 2 * i + (lane >> 5); scr[kk * 33 + (lane & 31)] = W[(size_t)(k0 + kk) * ldw + n0 + (lane & 31)]; }
    LDS_WAIT(); asm volatile("" ::: "memory");
    const int c = lane & 7;
#pragma unroll
    for (int j = 0; j < 4; ++j) {
        const int n = (lane >> 3) + 8 * j; const LAS float* s = scr + (8 * c) * 33 + n;
        u32x4 o; o.x = pk2(s[0 * 33], s[1 * 33]); o.y = pk2(s[2 * 33], s[3 * 33]); o.z = pk2(s[4 * 33], s[5 * 33]); o.w = pk2(s[6 * 33], s[7 * 33]);
        const int row = rowmap(n0 + n);
        if (row >= 0) *(u32x4*)(WT + (size_t)row * ldt + dcol0 + k0 + 8 * c) = o;
    }
    LDS_WAIT(); asm volatile("" ::: "memory");
}
struct RowId { __device__ __forceinline__ int operator()(int n) const { return n; } };
struct RowOff { int off; __device__ __forceinline__ int operator()(int n) const { return n + off; } };
struct RowWin {
    __device__ __forceinline__ int operator()(int n) const {
        if (n < 640) return n;
        if (n < 768) return n - 640 + IC_VS;
        if (n < 2688) return n - 768 + IC_RW;
        if (n < 3712) return n - 2688 + IC_QD;
        if (n < 4224) return n - 3712 + IC_VD;
        return n - 4224 + NIN1;
    }
};
struct RowGU { int up; __device__ __forceinline__ int operator()(int j) const { return (j >> 7) * 256 + (j & 127) + 128 * up; } };

template <class F>
__device__ __forceinline__ void convert_matrix(const float* W, int K, int N, bf16_t* WT, int ldt, int dcol0, F rowmap, LAS float* scr, int lane, int gw, int NGW) {
    const int nblk = N / 32, items = (K / 64) * nblk;
    for (int it = gw; it < items; it += NGW) { const int kb = it / nblk, nb = it % nblk; transpose_item(W, N, kb * 64, nb * 32, WT, ldt, dcol0, rowmap, scr, lane); }
}

__device__ __forceinline__ void lora_region(bf16_t* __restrict__ LT, const float* __restrict__ src, int row0, int klo, int kn, int gw, int NGW, int lane) {
    for (int i = gw * 64 + lane; i < 512 * 48; i += NGW * 64) {
        const int nn = i / 48, kc = (i % 48) * 8;
        u32x4 o = (u32x4){0u, 0u, 0u, 0u};
        if (kc >= klo && kc < klo + kn) {
            const float* s = src + (size_t)(kc - klo) * 512 + nn;
            o.x = pk2(s[0], s[512]); o.y = pk2(s[2 * 512], s[3 * 512]); o.z = pk2(s[4 * 512], s[5 * 512]); o.w = pk2(s[6 * 512], s[7 * 512]);
        }
        *(u32x4*)(LT + (size_t)(row0 + nn) * 384 + kc) = o;
    }
}
__device__ __forceinline__ void convert_layer_weights(const Params& p, int layer, LAS unsigned char* lds, int gw, int NGW, int wave, int lane) {
    LAS float* scr = (LAS float*)(lds + wave * 16384);
    unsigned char* ws = p.ws;
    bf16_t* WIN = (bf16_t*)(ws + WS_WIN);
    convert_matrix(p.in[10] + (size_t)layer * 1024 * D_IN, 1024, D_IN, WIN, 1024, 0, RowWin(), scr, lane, gw, NGW);
    for (int i = gw * 64 + lane; i < (NIN1 - IC_PAD) * 1024 / 8; i += NGW * 64) *(u32x4*)(WIN + (size_t)IC_PAD * 1024 + (size_t)i * 8) = (u32x4){0u, 0u, 0u, 0u};
    for (int j = 0; j < 3; ++j)
        convert_matrix(p.in[26 + j] + (size_t)layer * 512 * 1024, 512, 1024, (bf16_t*)(ws + WS_PRJ) + (size_t)j * 1024 * 512, 512, 0, RowId(), scr, lane, gw, NGW);
    convert_matrix(p.in[29] + (size_t)layer * 1024 * 1024, 1024, 1024, (bf16_t*)(ws + WS_WOUT), 1024, 0, RowId(), scr, lane, gw, NGW);
    bf16_t* LT = (bf16_t*)(ws + WS_LORA);
    lora_region(LT, p.in[15] + ((size_t)layer * 2 + 0) * 64 * 512, 0, 0, 64, gw, NGW, lane);
    lora_region(LT, p.in[15] + ((size_t)layer * 2 + 1) * 64 * 512, 512, 64, 64, gw, NGW, lane);
    lora_region(LT, p.in[17] + ((size_t)layer * 2 + 0) * 64 * 512, 1024, 128, 64, gw, NGW, lane);
    lora_region(LT, p.in[17] + ((size_t)layer * 2 + 1) * 64 * 512, 1536, 192, 64, gw, NGW, lane);
    lora_region(LT, p.in[18] + (size_t)layer * 128 * 512, 2048, 256, 128, gw, NGW, lane);
}
__device__ __forceinline__ void convert_ffn_weights(const Params& p, LAS unsigned char* lds, int gw, int NGW, int wave, int lane) {
    LAS float* scr = (LAS float*)(lds + wave * 16384);
    bf16_t* GU = (bf16_t*)(p.ws + WS_FGU); bf16_t* FD = (bf16_t*)(p.ws + WS_FD);
    convert_matrix(p.in[30], 1024, D_FF, GU, 1024, 0, RowGU{0}, scr, lane, gw, NGW);
    convert_matrix(p.in[31], 1024, D_FF, GU, 1024, 0, RowGU{1}, scr, lane, gw, NGW);
    convert_matrix(p.in[32], D_FF, 1024, FD, D_FF, 0, RowId(), scr, lane, gw, NGW);
}
__device__ __forceinline__ void convert_moe_weights(const Params& p, LAS unsigned char* lds, int gw, int NGW, int wave, int lane) {
    LAS float* scr = (LAS float*)(lds + wave * 16384);
    for (int e = 0; e < NEXP; ++e) {
        bf16_t* GU = (bf16_t*)(p.ws + WS_MGU) + (size_t)e * 7168 * 1024;
        convert_matrix(p.in[34] + (size_t)e * 1024 * D_FFE, 1024, D_FFE, GU, 1024, 0, RowGU{0}, scr, lane, gw, NGW);
        convert_matrix(p.in[35] + (size_t)e * 1024 * D_FFE, 1024, D_FFE, GU, 1024, 0, RowGU{1}, scr, lane, gw, NGW);
        convert_matrix(p.in[36] + (size_t)e * D_FFE * 1024, D_FFE, 1024, (bf16_t*)(p.ws + WS_MD) + (size_t)e * 1024 * D_FFE, D_FFE, 0, RowId(), scr, lane, gw, NGW);
    }
}

__device__ __forceinline__ void adaln_phase(const Params& p, LAS unsigned char* lds, int wave, int lane) {
    LAS float* red = (LAS float*)lds;
    float* MODS = (float*)(p.ws + WS_MODS);
    const float* c = p.in[1]; const float* cc = p.in[3];
    for (int it = blockIdx.x; it < 2 * 96; it += gridDim.x) {
        const int layer = it / 96, n = (it % 96) * 64 + lane;
        const float* W = p.in[4] + (size_t)layer * 1024 * 6144;
        float a0 = 0.f, a1 = 0.f, a2 = 0.f;
        for (int k = wave * 128; k < wave * 128 + 128; ++k) {
            const float w = W[(size_t)k * 6144 + n];
            a0 += siluf_(c[k]) * w; a1 += siluf_(c[1024 + k]) * w; a2 += siluf_(cc[k]) * w;
        }
        red[(wave * 3 + 0) * 64 + lane] = a0; red[(wave * 3 + 1) * 64 + lane] = a1; red[(wave * 3 + 2) * 64 + lane] = a2;
        __syncthreads();
        if (wave < 3) {
            float s = 0.f;
#pragma unroll
            for (int w = 0; w < 8; ++w) s += red[(w * 3 + wave) * 64 + lane];
            MODS[((size_t)layer * 3 + wave) * 6144 + n] = s + p.in[5][(size_t)layer * 6144 + n];
        }
        __syncthreads();
    }
    if (blockIdx.x == gridDim.x - 1) {
        float* rope = (float*)(p.ws + WS_ROPE);
        for (int i = threadIdx.x; i < 128 * 16; i += NTHREADS) {
            const int pos = i >> 4, j = i & 15;
            const float inv = powf(10000.0f, -(float)j / 16.0f);
            const float ang = (float)pos * inv;
            rope[2 * i] = cosf(ang); rope[2 * i + 1] = sinf(ang);
        }
    }
}

__device__ __forceinline__ const float* mods_row(const Params& p, int layer, int m) {
    const int r = m < NLAT ? (m >> 13) : 2;
    return (const float*)(p.ws + WS_MODS) + ((size_t)layer * 3 + r) * 6144;
}
__device__ __forceinline__ void load_row(const float* x, int lane, f32x4 (&v)[4]) {
#pragma unroll
    for (int j = 0; j < 4; ++j) v[j] = ((const f32x4*)x)[lane + 64 * j];
}
__device__ __forceinline__ float row_rstd(const f32x4 (&v)[4]) {
    float s = 0.f;
#pragma unroll
    for (int j = 0; j < 4; ++j) s += (v[j].x * v[j].x + v[j].y * v[j].y) + (v[j].z * v[j].z + v[j].w * v[j].w);
    return 1.0f / sqrtf(wave_sum(s) * (1.0f / 1024.0f) + 1e-6f);
}
__device__ __forceinline__ void normmod(const f32x4 (&h)[4], const float* g, const float* shift, const float* scale, int lane, f32x4 (&a)[4]) {
    const float rstd = row_rstd(h);
#pragma unroll
    for (int j = 0; j < 4; ++j) {
        const f32x4 gg = ((const f32x4*)g)[lane + 64 * j], sh = ((const f32x4*)shift)[lane + 64 * j], sc = ((const f32x4*)scale)[lane + 64 * j];
        a[j] = (h[j] * rstd * gg) * (sc + 1.0f) + sh;
    }
}
__device__ __forceinline__ void store_row_bf16(bf16_t* o, int lane, const f32x4 (&a)[4]) {
#pragma unroll
    for (int j = 0; j < 4; ++j) { u32x2 w; w.x = pk2(a[j].x, a[j].y); w.y = pk2(a[j].z, a[j].w); ((u32x2*)o)[lane + 64 * j] = w; }
}
__device__ __forceinline__ const float* h_in_row(const Params& p, int layer, int m) {
    if (layer == 0) return m < NLAT ? p.in[0] + (size_t)m * 1024 : p.in[2] + (size_t)(m - NLAT) * 1024;
    return m < NLAT ? p.out + (size_t)m * 1024 : (const float*)(p.ws + WS_HCTX) + (size_t)(m - NLAT) * 1024;
}
__device__ __forceinline__ float* h_out_row(const Params& p, int m) { return m < NLAT ? p.out + (size_t)m * 1024 : (float*)(p.ws + WS_HCTX) + (size_t)(m - NLAT) * 1024; }

__device__ __forceinline__ void premix_phase(const Params& p, int layer, bool first, int M, int gw, int NGW, int lane) {
    bf16_t* XN = (bf16_t*)(p.ws + WS_XN);
    for (int m = gw; m < M; m += NGW) {
        const float* hr = first ? h_in_row(p, 0, m) : h_out_row(p, m);
        f32x4 h[4], a[4]; load_row(hr, lane, h);
        const float* md = mods_row(p, layer, m);
        normmod(h, p.in[6] + layer * 1024, md, md + 1024, lane, a);
        store_row_bf16(XN + (size_t)m * 1024, lane, a);
    }
}
__device__ __forceinline__ void load_row_bf16(const bf16_t* x, int lane, f32x4 (&v)[4]) {
#pragma unroll
    for (int j = 0; j < 4; ++j) { const u32x2 w = ((const u32x2*)x)[lane + 64 * j]; v[j] = (f32x4){bflo(w.x), bfhi(w.x), bflo(w.y), bfhi(w.y)}; }
}
__device__ __forceinline__ void residual_phase(const Params& p, const bf16_t* src, const bf16_t* src2, const float* hin_base_layer0, bool hin_is_input, int layer, int gate_idx, const float* g1,
                                               bool write_xn, const float* g2, int mod_layer2, int shift_idx, bool route, int M, int gw, int NGW, int lane) {
    bf16_t* XN = (bf16_t*)(p.ws + (route ? WS_XN2 : WS_XN));
    for (int m = gw; m < M; m += NGW) {
        const float* hr = hin_is_input ? h_in_row(p, 0, m) : h_out_row(p, m);
        f32x4 h[4], s[4]; load_row(hr, lane, h); load_row_bf16(src + (size_t)m * 1024, lane, s);
        if (src2) { f32x4 s2[4]; load_row_bf16(src2 + (size_t)m * 1024, lane, s2);
#pragma unroll
            for (int j = 0; j < 4; ++j) s[j] += s2[j]; }
        const float rstd = row_rstd(s);
        const float* md = mods_row(p, layer, m);
#pragma unroll
        for (int j = 0; j < 4; ++j) {
            const f32x4 gg = ((const f32x4*)g1)[lane + 64 * j], gt = ((const f32x4*)(md + gate_idx * 1024))[lane + 64 * j];
            h[j] = h[j] + gt * (s[j] * rstd * gg);
        }
        float* ho = h_out_row(p, m);
#pragma unroll
        for (int j = 0; j < 4; ++j) ((f32x4*)ho)[lane + 64 * j] = h[j];
        if (write_xn) {
            f32x4 a[4]; const float* md2 = mods_row(p, mod_layer2, m);
            normmod(h, g2, md2 + shift_idx * 1024, md2 + (shift_idx + 1) * 1024, lane, a);
            store_row_bf16(XN + (size_t)m * 1024, lane, a);
            if (route) {
                const float* rw = p.in[33];
                float lg[8] = {0.f, 0.f, 0.f, 0.f, 0.f, 0.f, 0.f, 0.f};
#pragma unroll
                for (int j = 0; j < 4; ++j)
#pragma unroll
                    for (int q = 0; q < 4; ++q) {
                        const int k = 4 * (lane + 64 * j) + q; const float av = a[j][q];
                        const f32x4 w0 = ((const f32x4*)(rw + (size_t)k * 8))[0], w1 = ((const f32x4*)(rw + (size_t)k * 8))[1];
                        lg[0] += av * w0.x; lg[1] += av * w0.y; lg[2] += av * w0.z; lg[3] += av * w0.w; lg[4] += av * w1.x; lg[5] += av * w1.y; lg[6] += av * w1.z; lg[7] += av * w1.w;
                    }
#pragma unroll
                for (int e = 0; e < 8; ++e) lg[e] = wave_sum(lg[e]);
                int i1 = 0; float v1 = lg[0];
#pragma unroll
                for (int e = 1; e < 8; ++e) if (lg[e] > v1) { v1 = lg[e]; i1 = e; }
                int i2 = -1; float v2 = -3.0e38f;
#pragma unroll
                for (int e = 0; e < 8; ++e) if (e != i1 && lg[e] > v2) { v2 = lg[e]; i2 = e; }
                if (lane == 0) {
                    const float w1 = 1.0f / (1.0f + expf(v2 - v1)), w2 = 1.0f - w1;
                    unsigned* cnt = (unsigned*)(p.ws + WS_CTL) + CW_CNT; int* LIST = (int*)(p.ws + WS_LIST); float* WTS = (float*)(p.ws + WS_WTS);
                    const unsigned s1 = atomicAdd(cnt + i1, 1u); LIST[i1 * 16384 + s1] = m * 2; WTS[i1 * 16384 + s1] = w1;
                    const unsigned s2 = atomicAdd(cnt + i2, 1u); LIST[i2 * 16384 + s2] = m * 2 + 1; WTS[i2 * 16384 + s2] = w2;
                }
            }
        }
    }
}

using pg8::Unit;
constexpr float QSCALE = 0.125f * 1.4426950408889634f;
__device__ __forceinline__ u32x2 pack4(const f32x4 v) { u32x2 w; w.x = pk2(v.x, v.y); w.y = pk2(v.z, v.w); return w; }
__device__ __forceinline__ f32x4 unpack4(const u32x2 w) { return (f32x4){bflo(w.x), bfhi(w.x), bflo(w.y), bfhi(w.y)}; }

struct EpiIn {
    static constexpr bool PERM = false, AFTER_DRAIN = false;
    bf16_t* P; bf16_t* VTS; bf16_t* VTD; const float* rope;
    __device__ __forceinline__ void operator()(const f32x4 (&acc)[2][2][4][2], const Unit& u, int wr, int wc, int fr, int fq) const {
#pragma unroll
        for (int ai = 0; ai < 2; ++ai)
#pragma unroll
            for (int m = 0; m < 4; ++m) {
                const int r = u.pm * 256 + ai * 128 + wr * 64 + m * 16 + fr;
                const bool lat = r < NLAT;
                const int t = r & (SEQ - 1);
                const int b = lat ? (r >> 13) : ((r - NLAT) >> 8);
                const int key = lat ? t : SEQ + ((r - NLAT) & 255);
#pragma unroll
                for (int bj = 0; bj < 2; ++bj) {
                    const int c32 = u.pn * 256 + bj * 128 + wc * 32;
                    f32x4 v0 = acc[ai][bj][m][0], v1 = acc[ai][bj][m][1];
                    if (c32 < PP) {
                        const bool rp = (c32 < IC_RW) || (c32 >= IC_QD);
                        if (rp && lat) {
                            const int pos = (c32 & 32) ? (t & 63) : (t >> 6);
                            const f32x4 cs0 = *(const f32x4*)(rope + (pos * 16 + 4 * fq) * 2), cs1 = *(const f32x4*)(rope + (pos * 16 + 4 * fq) * 2 + 4);
                            const f32x4 cc = (f32x4){cs0.x, cs0.z, cs1.x, cs1.z}, sn = (f32x4){cs0.y, cs0.w, cs1.y, cs1.w};
                            const f32x4 o0 = v0 * cc - v1 * sn, o1 = v0 * sn + v1 * cc;
                            v0 = o0; v1 = o1;
                        }
                        if (c32 < IC_KS || (c32 >= IC_QD && c32 < IC_KD)) { v0 = v0 * QSCALE; v1 = v1 * QSCALE; }
                        bf16_t* dst = P + (size_t)r * PP + c32 + 4 * fq;
                        *(u32x2*)dst = pack4(v0); *(u32x2*)(dst + 16) = pack4(v1);
                    } else {
                        const int cv = c32 - PP;
                        bf16_t* vt = nullptr; int dimbase = 0;
                        if (cv < 128) { vt = VTS + (size_t)((b * 2 + (cv >> 6)) * 64) * KEYS; dimbase = cv & 63; }
                        else if (cv < 640) { const int cd = cv - 128; vt = VTD + (size_t)((b * 4 + (cd >> 7)) * 128) * KEYS; dimbase = cd & 127; }
                        if (vt) {
#pragma unroll
                            for (int i = 0; i < 4; ++i) {
                                vt[(size_t)(dimbase + 4 * fq + i) * KEYS + key] = (bf16_t)f2bf(v0[i]);
                                vt[(size_t)(dimbase + 16 + 4 * fq + i) * KEYS + key] = (bf16_t)f2bf(v1[i]);
                            }
                        }
                    }
                }
            }
    }
};

struct EpiLora {
    static constexpr bool PERM = false, AFTER_DRAIN = false;
    float* ST; bf16_t* P; const float* w0; const float* a0;
    __device__ __forceinline__ void operator()(const f32x4 (&acc)[2][2][4][2], const Unit& u, int wr, int wc, int fr, int fq) const {
        const int reg = u.pn >> 1;
#pragma unroll
        for (int ai = 0; ai < 2; ++ai)
#pragma unroll
            for (int m = 0; m < 4; ++m) {
                const int r = u.pm * 256 + ai * 128 + wr * 64 + m * 16 + fr;
#pragma unroll
                for (int bj = 0; bj < 2; ++bj)
#pragma unroll
                    for (int n = 0; n < 2; ++n) {
                        const int ch = (u.pn & 1) * 256 + bj * 128 + wc * 32 + 16 * n + 4 * fq;
                        const int h = ch >> 6, kidx = ch & 63;
                        float* sp = ST + ((size_t)r * 8 + h) * (ST_SLOTS * 64) + kidx;
                        const f32x4 a = acc[ai][bj][m][n];
                        if (reg < 2) {
                            const f32x4 bias = *(const f32x4*)(w0 + reg * 512 + ch);
                            f32x4 o;
#pragma unroll
                            for (int i = 0; i < 4; ++i) {
                                const float x = -(bias[i] + a[i]);
                                const float sp_ = fmaxf(x, 0.f) + __logf(1.0f + __expf(-fabsf(x)));
                                o[i] = __expf(-__expf(-sp_ - 0.5f));
                            }
                            *(f32x4*)(sp + (4 + 2 * reg) * 64) = o;
                        } else if (reg < 4) {
                            const int d = reg - 2;
                            const f32x4 bias = *(const f32x4*)(a0 + d * 512 + ch);
                            *(f32x4*)(sp + (5 + 2 * d) * 64) = (f32x4){sigmoidf_(bias[0] + a[0]), sigmoidf_(bias[1] + a[1]), sigmoidf_(bias[2] + a[2]), sigmoidf_(bias[3] + a[3])};
                        } else {
                            *(u32x2*)(P + (size_t)r * PP + IC_RW + ch) = pack4(a);
                        }
                        asm volatile("" ::: "memory");
                    }
            }
    }
};

struct LoraSched {
    pg8::StaticOrder S;
    __device__ __forceinline__ bool next(int i, Unit& u) const { if (!S.next(i, u)) return false; const int reg = u.pn >> 1; u.koff = 128 * (reg < 4 ? (reg >> 1) : 2); return true; }
    __device__ __forceinline__ void a_ready(const Unit&) const {}
    __device__ __forceinline__ void done(const Unit&) const {}
};
struct EpiGate {
    static constexpr bool PERM = true, AFTER_DRAIN = false;
    bf16_t* G;
    __device__ __forceinline__ void operator()(const f32x4 (&acc)[2][2][4][2], const Unit& u, int wr, int wc, int fr, int fq) const {
#pragma unroll
        for (int ai = 0; ai < 2; ++ai)
#pragma unroll
            for (int m = 0; m < 4; ++m) {
                const int r = u.pm * 256 + ai * 128 + wr * 64 + m * 16 + fr;
#pragma unroll
                for (int bj = 0; bj < 2; ++bj) {
                    const int c = u.pn * 256 + bj * 128 + wc * 32 + 8 * fq;
                    const f32x4 a0 = acc[ai][bj][m][0], a1 = acc[ai][bj][m][1];
                    u32x4 w; w.x = pk2(sigmoidf_(a0.x), sigmoidf_(a0.y)); w.y = pk2(sigmoidf_(a0.z), sigmoidf_(a0.w)); w.z = pk2(sigmoidf_(a1.x), sigmoidf_(a1.y)); w.w = pk2(sigmoidf_(a1.z), sigmoidf_(a1.w));
                    *(u32x4*)(G + (size_t)r * 3072 + c) = w;
                }
            }
    }
};

template <int PASS> struct EpiMerge {
    static constexpr bool PERM = false, AFTER_DRAIN = false;
    const bf16_t* G; bf16_t* MF; bf16_t* MB;
    __device__ __forceinline__ void operator()(const f32x4 (&acc)[2][2][4][2], const Unit& u, int wr, int wc, int fr, int fq) const {
#pragma unroll
        for (int ai = 0; ai < 2; ++ai)
#pragma unroll
            for (int m = 0; m < 4; ++m) {
                const int r = u.pm * 256 + ai * 128 + wr * 64 + m * 16 + fr;
#pragma unroll
                for (int bj = 0; bj < 2; ++bj)
#pragma unroll
                    for (int n = 0; n < 2; ++n) {
                        const int c = u.pn * 256 + bj * 128 + wc * 32 + 16 * n + 4 * fq;
                        const f32x4 g = unpack4(*(const u32x2*)(G + (size_t)r * 3072 + PASS * 1024 + c));
                        f32x4 v = g * acc[ai][bj][m][n];
                        bf16_t* mp = MF + (size_t)r * 1024 + c;
                        if (PASS > 0) v += unpack4(*(const u32x2*)mp);
                        *(u32x2*)(PASS < 2 ? mp : MB + (size_t)r * 1024 + c) = pack4(v);
                    }
            }
    }
};

struct EpiBf {
    static constexpr bool PERM = true, AFTER_DRAIN = false;
    bf16_t* O; int ldc;
    __device__ __forceinline__ void operator()(const f32x4 (&acc)[2][2][4][2], const Unit& u, int wr, int wc, int fr, int fq) const {
#pragma unroll
        for (int ai = 0; ai < 2; ++ai)
#pragma unroll
            for (int m = 0; m < 4; ++m) {
                const int r = u.pm * 256 + ai * 128 + wr * 64 + m * 16 + fr;
#pragma unroll
                for (int bj = 0; bj < 2; ++bj) {
                    const int c = u.pn * 256 + bj * 128 + wc * 32 + 8 * fq;
                    const f32x4 a0 = acc[ai][bj][m][0], a1 = acc[ai][bj][m][1];
                    u32x4 w; w.x = pk2(a0.x, a0.y); w.y = pk2(a0.z, a0.w); w.z = pk2(a1.x, a1.y); w.w = pk2(a1.z, a1.w);
                    *(u32x4*)(O + (size_t)r * ldc + c) = w;
                }
            }
    }
};

struct EpiSwiglu {
    static constexpr bool PERM = true, AFTER_DRAIN = false;
    bf16_t* H; int ldh; int npn; int pm_sub;
    __device__ __forceinline__ void operator()(const f32x4 (&acc)[2][2][4][2], const Unit& u, int wr, int wc, int fr, int fq) const {
        const int pnn = u.pn % npn;
#pragma unroll
        for (int ai = 0; ai < 2; ++ai)
#pragma unroll
            for (int m = 0; m < 4; ++m) {
                const int r = (u.pm - pm_sub) * 256 + ai * 128 + wr * 64 + m * 16 + fr;
                const int hc = pnn * 128 + wc * 32 + 8 * fq;
                const f32x4 g0 = acc[ai][0][m][0], g1 = acc[ai][0][m][1], u0 = acc[ai][1][m][0], u1 = acc[ai][1][m][1];
                u32x4 w; w.x = pk2(siluf_(g0.x) * u0.x, siluf_(g0.y) * u0.y); w.y = pk2(siluf_(g0.z) * u0.z, siluf_(g0.w) * u0.w);
                w.z = pk2(siluf_(g1.x) * u1.x, siluf_(g1.y) * u1.y); w.w = pk2(siluf_(g1.z) * u1.z, siluf_(g1.w) * u1.w);
                *(u32x4*)(H + (size_t)r * ldh + hc) = w;
            }
    }
};

struct MoeSched {
    int ts[9]; int pm_lo, pm_hi, npn, G, c; bool a_local;
    __device__ __forceinline__ int expert_of(int pm) const { int e = 0;
#pragma unroll
        for (int q = 1; q < 8; ++q) e += (pm >= ts[q]) ? 1 : 0;
        return e; }
    __device__ __forceinline__ bool next(int i, Unit& u) const {
        const int n = (pm_hi - pm_lo) * npn; const long L = (long)i * G + c; if (L >= n) return false;
        const int pm = pm_lo + (int)L / npn, pnn = (int)L % npn;
        u.pm = a_local ? pm - pm_lo : pm; u.pn = expert_of(pm) * npn + pnn; u.koff = 0; u.tail = -1; return true;
    }
    __device__ __forceinline__ void a_ready(const Unit&) const {}
    __device__ __forceinline__ void done(const Unit&) const {}
};
struct EpiMoeDown {
    static constexpr bool PERM = false, AFTER_DRAIN = false;
    bf16_t* FS; long slot1_off; const int* LIST; const float* WTS; const unsigned* cnt; int ts[9]; int pm_lo;
    __device__ __forceinline__ void operator()(const f32x4 (&acc)[2][2][4][2], const Unit& u, int wr, int wc, int fr, int fq) const {
        const int e = u.pn >> 2, pnn = u.pn & 3, pmg = u.pm + pm_lo;
        int tse = 0;
#pragma unroll
        for (int q = 0; q < 8; ++q) tse = (q == e) ? ts[q] : tse;
        const int ne = (int)cnt[e];
#pragma unroll
        for (int ai = 0; ai < 2; ++ai)
#pragma unroll
            for (int m = 0; m < 4; ++m) {
                const int slot = (pmg - tse) * 256 + ai * 128 + wr * 64 + m * 16 + fr;
                if (slot < ne) {
                    const int tk = LIST[e * 16384 + slot]; const float w = WTS[e * 16384 + slot];
                    bf16_t* dst = FS + (long)(tk & 1) * slot1_off + (size_t)(tk >> 1) * 1024 + pnn * 256 + wc * 32 + 4 * fq;
#pragma unroll
                    for (int bj = 0; bj < 2; ++bj)
#pragma unroll
                        for (int n = 0; n < 2; ++n) *(u32x2*)(dst + bj * 128 + 16 * n) = pack4(acc[ai][bj][m][n] * w);
                }
            }
    }
};

constexpr float SC2 = 0.125f * 1.4426950408889634f;
constexpr int ATT_ROW = 144, ATT_VOFF = 9216, ATT_BUF = 27648;
constexpr float ATT_THR = 6.0f;
__device__ __forceinline__ float xhalf_max(float v) { auto rr = __builtin_amdgcn_permlane32_swap(__float_as_uint(v), __float_as_uint(v), false, false); return fmaxf(__uint_as_float(rr[0]), __uint_as_float(rr[1])); }
__device__ __forceinline__ float xhalf_sum(float v) { auto rr = __builtin_amdgcn_permlane32_swap(__float_as_uint(v), __float_as_uint(v), false, false); return __uint_as_float(rr[0]) + __uint_as_float(rr[1]); }

template <int DV, bool WINDOW>
__device__ __forceinline__ void attn_pass(LAS unsigned char* lds, const bf16_t* __restrict__ P, int qrow0, int qcol, int kcol, const bf16_t* __restrict__ VT,
                                          int lat_row0, int ctx_row0, int tile_lo, int tile_hi, bool has_ref, float m0, float l0, int qpos0,
                                          f32x16 (&o)[DV / 32], float& l_out, int wave, int lane) {
    int tid_ = threadIdx.x; asm volatile("" : "+v"(tid_)); const int tid = tid_; lane = tid & 63; const int qn = lane & 31, half = lane >> 5;
    bf16x8 qf[4];
    { const bf16_t* qp = P + (size_t)(qrow0 + wave * 32 + qn) * PP + qcol + half * 8;
#pragma unroll
      for (int ks = 0; ks < 4; ++ks) qf[ks] = *(const bf16x8*)(qp + ks * 16); }
    float mrun = has_ref ? m0 : 0.f, lrun = (half == 0) ? l0 : 0.f;
    bool need_ref = !has_ref;
    f32x16 negm;
#pragma unroll
    for (int i = 0; i < 16; ++i) negm[i] = -mrun;
#pragma unroll
    for (int db = 0; db < DV / 32; ++db)
#pragma unroll
        for (int i = 0; i < 16; ++i) o[db][i] = 0.f;
    const int nlat = tile_hi - tile_lo, nt = nlat + 4;
    u32x4 kreg[1], vreg[1][DV / 64];
    const int skey = tid >> 3, spc = tid & 7;
#define ATT_LOAD(ti_, set_) do { const int id_ = (ti_) < nlat ? tile_lo + (ti_) : 128 + ((ti_) - nlat); \
        const int krow0_ = id_ < 128 ? lat_row0 + 64 * id_ : ctx_row0 + 64 * (id_ - 128); \
        kreg[set_] = *(const u32x4*)(P + (size_t)(krow0_ + skey) * PP + kcol + spc * 8); \
        _Pragma("unroll") for (int j_ = 0; j_ < DV / 64; ++j_) { const int idx_ = tid + 512 * j_; vreg[set_][j_] = *(const u32x4*)(VT + (size_t)(idx_ >> 3) * KEYS + 64 * id_ + (idx_ & 7) * 8); } } while (0)
#define ATT_STORE(buf_, set_) do { LAS unsigned char* b_ = lds + (buf_) * ATT_BUF; *(LAS u32x4*)(b_ + skey * ATT_ROW + spc * 16) = kreg[set_]; \
        _Pragma("unroll") for (int j_ = 0; j_ < DV / 64; ++j_) { const int idx_ = tid + 512 * j_, dim_ = idx_ >> 3; *(LAS u32x4*)(b_ + ATT_VOFF + dim_ * ATT_ROW + (((idx_ & 7) ^ ((dim_ >> 4) & 1)) * 16)) = vreg[set_][j_]; } } while (0)
    __syncthreads();
    ATT_LOAD(0, 0); ATT_STORE(0, 0);
    if (nt > 1) ATT_LOAD(1, 0);
    __syncthreads();
    for (int ti0 = 0; ti0 < nt; ti0 += 1) {
#pragma unroll
      for (int dd = 0; dd < 1; ++dd) {
        const int ti = ti0 + dd;
        if (ti < nt) {
        const LAS unsigned char* Ks = lds + (ti & 1) * ATT_BUF; const LAS unsigned char* Vs = Ks + ATT_VOFF;
        const int id = ti < nlat ? tile_lo + ti : 128 + (ti - nlat);
        const bool islat = id < 128;
        bool skip = false;
        if (WINDOW && islat) { const int qw = qpos0 + wave * 32; skip = (64 * id + 63 < qw - 128 || 64 * id > qw + 31 + 128); }
        if (!skip) {
        f32x16 s[2];
#pragma unroll
        for (int mb = 0; mb < 2; ++mb) {
#pragma unroll
            for (int ks = 0; ks < 4; ++ks) {
                const bf16x8 kf = *(const LAS bf16x8*)(Ks + (32 * mb + qn) * ATT_ROW + ks * 32 + half * 16);
                if (ks == 0) s[mb] = __builtin_amdgcn_mfma_f32_32x32x16_bf16(kf, qf[0], negm, 0, 0, 0);
                else s[mb] = __builtin_amdgcn_mfma_f32_32x32x16_bf16(kf, qf[ks], s[mb], 0, 0, 0);
            }
        }
        if (WINDOW && islat) {
            const int qpos = qpos0 + wave * 32 + qn;
#pragma unroll
            for (int mb = 0; mb < 2; ++mb)
#pragma unroll
                for (int i = 0; i < 16; ++i) { const int d = 64 * id + 32 * mb + 8 * (i >> 2) + 4 * half + (i & 3) - qpos; if (d > 128 || d < -128) s[mb][i] = -INFINITY; }
        }
        float mx = s[0][0];
#pragma unroll
        for (int mb = 0; mb < 2; ++mb)
#pragma unroll
            for (int i = 0; i < 16; ++i) mx = fmaxf(mx, s[mb][i]);
        mx = xhalf_max(mx);
        if (__builtin_expect(need_ref || __any(mx > ATT_THR), 0)) {
            const float delta = need_ref ? mx : fmaxf(mx, 0.f);
            if (!need_ref) {
                const float alpha = __builtin_amdgcn_exp2f(-delta);
                lrun *= alpha;
#pragma unroll
                for (int db = 0; db < DV / 32; ++db)
#pragma unroll
                    for (int i = 0; i < 16; ++i) o[db][i] *= alpha;
            }
            mrun += delta; need_ref = false;
#pragma unroll
            for (int mb = 0; mb < 2; ++mb)
#pragma unroll
                for (int i = 0; i < 16; ++i) s[mb][i] -= delta;
#pragma unroll
            for (int i = 0; i < 16; ++i) negm[i] = -mrun;
        }
        float rs = 0.f;
#pragma unroll
        for (int mb = 0; mb < 2; ++mb)
#pragma unroll
            for (int i = 0; i < 16; ++i) { const float pv = __builtin_amdgcn_exp2f(s[mb][i]); s[mb][i] = pv; rs += pv; }
        lrun += rs;
#pragma unroll
        for (int g = 0; g < 4; ++g) {
            const int mb = g >> 1, bs = 8 * (g & 1);
            u32x4 pw; pw.x = pk2(s[mb][bs + 0], s[mb][bs + 1]); pw.y = pk2(s[mb][bs + 2], s[mb][bs + 3]); pw.z = pk2(s[mb][bs + 4], s[mb][bs + 5]); pw.w = pk2(s[mb][bs + 6], s[mb][bs + 7]);
            const bf16x8 pf = __builtin_bit_cast(bf16x8, pw);
#pragma unroll
            for (int db = 0; db < DV / 32; ++db) {
                const int dim = 32 * db + qn, sw = (dim >> 4) & 1;
                const LAS unsigned char* vrow = Vs + dim * ATT_ROW + 8 * half;
                const u32x2 lo = *(const LAS u32x2*)(vrow + (((2 * g) ^ sw) * 16)), hi = *(const LAS u32x2*)(vrow + (((2 * g + 1) ^ sw) * 16));
                const u32x4 vw = (u32x4){lo.x, lo.y, hi.x, hi.y};
                o[db] = __builtin_amdgcn_mfma_f32_32x32x16_bf16(__builtin_bit_cast(bf16x8, vw), pf, o[db], 0, 0, 0);
            }
        }
        }
        if (ti + 1 < nt) { ATT_STORE((ti + 1) & 1, 0); if (ti + 2 < nt) ATT_LOAD(ti + 2, 0); }
        __syncthreads();
        }
      }
    }
#undef ATT_LOAD
#undef ATT_STORE
    l_out = xhalf_sum(lrun);
}

__device__ __forceinline__ void swa_unit(LAS unsigned char* lds, const Params& p, int layer, int b, int hq, int qb, bool ctx, int wave, int lane, bool dry = false) {
    bf16_t* P = (bf16_t*)(p.ws + WS_P);
    const int kvh = hq >> 2;
    const bf16_t* VT = (const bf16_t*)(p.ws + WS_VTS) + (size_t)((b * 2 + kvh) * 64) * KEYS;
    const float sink2 = p.in[11][layer * 8 + hq] * 1.4426950408889634f;
    const int qrow0 = ctx ? NLAT + b * CTXL : b * SEQ + qb * 256;
    f32x16 o[2]; float l;
    if (ctx) attn_pass<64, false>(lds, P, qrow0, IC_QS + hq * 64, IC_KS + kvh * 64, VT, b * SEQ, NLAT + b * CTXL, 0, 0, true, sink2, 1.0f, 0, o, l, wave, lane);
    else {
        int lo = 4 * qb - 2; if (lo < 0) lo = 0; int hi = 4 * qb + 6; if (hi > 128) hi = 128;
        attn_pass<64, true>(lds, P, qrow0, IC_QS + hq * 64, IC_KS + kvh * 64, VT, b * SEQ, NLAT + b * CTXL, lo, hi, true, sink2, 1.0f, qb * 256, o, l, wave, lane);
    }
    const float inv = 1.0f / l; const int qn = lane & 31, half = lane >> 5;
    bf16_t* dst = P + (size_t)(qrow0 + wave * 32 + qn) * PP + IC_QS + hq * 64 + 4 * half;
#pragma unroll
    for (int db = 0; db < 2; ++db)
#pragma unroll
        for (int q4 = 0; q4 < 4; ++q4) {
            const f32x4 v = (f32x4){o[db][4 * q4] * inv, o[db][4 * q4 + 1] * inv, o[db][4 * q4 + 2] * inv, o[db][4 * q4 + 3] * inv};
            if (!dry) *(u32x2*)(dst + 32 * db + 8 * q4) = pack4(v);
        }
}
__device__ __forceinline__ void diff_unit(LAS unsigned char* lds, const Params& p, float lam, int b, int h, int qb, bool ctx, int wave, int lane, bool dry = false) {
    bf16_t* P = (bf16_t*)(p.ws + WS_P);
    const bf16_t* VT = (const bf16_t*)(p.ws + WS_VTD) + (size_t)((b * 4 + h) * 128) * KEYS;
    const int qrow0 = ctx ? NLAT + b * CTXL : b * SEQ + qb * 256;
    const int thi = ctx ? 0 : 128;
    LAS unsigned* park = (LAS unsigned*)(lds + 73728) + threadIdx.x;
    f32x16 o[4]; float l;
    attn_pass<128, false>(lds, P, qrow0, IC_QD + h * 128, IC_KD + h * 128, VT, b * SEQ, NLAT + b * CTXL, 0, thi, false, 0.f, 0.f, 0, o, l, wave, lane);
    { const float inv = 1.0f / l;
#pragma unroll
      for (int db = 0; db < 4; ++db)
#pragma unroll
          for (int i = 0; i < 8; ++i) park[(db * 8 + i) * 512] = pk2(o[db][2 * i] * inv, o[db][2 * i + 1] * inv); }
    attn_pass<128, false>(lds, P, qrow0, IC_QD + h * 128 + 64, IC_KD + h * 128 + 64, VT, b * SEQ, NLAT + b * CTXL, 0, thi, false, 0.f, 0.f, 0, o, l, wave, lane);
    const float inv = lam / l; const int qn = lane & 31, half = lane >> 5;
    bf16_t* dst = P + (size_t)(qrow0 + wave * 32 + qn) * PP + IC_QD + h * 128 + 4 * half;
#pragma unroll
    for (int db = 0; db < 4; ++db)
#pragma unroll
        for (int q4 = 0; q4 < 4; ++q4) {
            const unsigned pa = park[(db * 8 + 2 * q4) * 512], pb = park[(db * 8 + 2 * q4 + 1) * 512];
            const f32x4 v = (f32x4){bflo(pa) - o[db][4 * q4] * inv, bfhi(pa) - o[db][4 * q4 + 1] * inv, bflo(pb) - o[db][4 * q4 + 2] * inv, bfhi(pb) - o[db][4 * q4 + 3] * inv};
            if (!dry) *(u32x2*)(dst + 32 * db + 8 * q4) = pack4(v);
        }
}

__device__ __forceinline__ void ld8bf(const bf16_t* p, float (&v)[8]) { const u32x4 w = *(const u32x4*)p; v[0] = bflo(w.x); v[1] = bfhi(w.x); v[2] = bflo(w.y); v[3] = bfhi(w.y); v[4] = bflo(w.z); v[5] = bfhi(w.z); v[6] = bflo(w.w); v[7] = bfhi(w.w); }
__device__ __forceinline__ void ld8f(const float* p, float (&v)[8]) { const f32x4 a = ((const f32x4*)p)[0], b = ((const f32x4*)p)[1]; v[0] = a.x; v[1] = a.y; v[2] = a.z; v[3] = a.w; v[4] = b.x; v[5] = b.y; v[6] = b.z; v[7] = b.w; }
__device__ __forceinline__ void st8f(float* p, const float (&v)[8]) { ((f32x4*)p)[0] = (f32x4){v[0], v[1], v[2], v[3]}; ((f32x4*)p)[1] = (f32x4){v[4], v[5], v[6], v[7]}; }

__device__ __forceinline__ void rwkv_prepare_phase(const Params& p, int layer, int gw, int NGW, int lane) {
    const bf16_t* P = (const bf16_t*)(p.ws + WS_P); float* ST = (float*)(p.ws + WS_ST); bf16_t* A2 = (bf16_t*)(p.ws + WS_YA);
    const float* mup = p.in[12] + layer * 1920; const float* mun = p.in[13] + layer * 1920; const float* k_k = p.in[19] + layer * 512;
    for (int m = gw; m < NTOK; m += NGW) {
        const int t = m < NLAT ? (m & (SEQ - 1)) : ((m - NLAT) & (CTXL - 1)), len = m < NLAT ? SEQ : CTXL;
        const bool hp = t > 0, hn = t < len - 1;
        const bf16_t* pr = P + (size_t)m * PP + IC_RW;
        const int h = lane >> 3, kidx = (lane & 7) * 8;
        float* sp = ST + ((size_t)m * 8 + h) * (ST_SLOTS * 64) + kidx;
#pragma unroll
        for (int sec = 0; sec < 4; ++sec) {
            if (sec == 3 && lane >= 48) break;
            const int col = sec < 3 ? sec * 512 + lane * 8 : 1536 + lane * 8;
            float c[8], pv[8], nx[8], a[8], bb[8], sh[8];
            ld8bf(pr + col, c);
            if (hp) ld8bf(pr - PP + col, pv); else {
#pragma unroll
                for (int q = 0; q < 8; ++q) pv[q] = 0.f; }
            if (hn) ld8bf(pr + PP + col, nx); else {
#pragma unroll
                for (int q = 0; q < 8; ++q) nx[q] = 0.f; }
            ld8f(mup + col, a); ld8f(mun + col, bb);
#pragma unroll
            for (int q = 0; q < 8; ++q) sh[q] = c[q] + a[q] * (pv[q] - c[q]) + bb[q] * (nx[q] - c[q]);
            if (sec == 0) st8f(sp + 1 * 64, sh);
            else if (sec == 2) st8f(sp + 2 * 64, sh);
            else if (sec == 1) {
                st8f(sp + 3 * 64, sh);
                float kk[8], kkw[8]; ld8f(k_k + lane * 8, kkw);
                float ss = 0.f;
#pragma unroll
                for (int q = 0; q < 8; ++q) { kk[q] = sh[q] * kkw[q]; ss += kk[q] * kk[q]; }
                ss += __shfl_xor(ss, 1); ss += __shfl_xor(ss, 2); ss += __shfl_xor(ss, 4);
                const float inv = 1.0f / fmaxf(sqrtf(ss), 1e-12f);
#pragma unroll
                for (int q = 0; q < 8; ++q) kk[q] *= inv;
                st8f(sp, kk);
            } else {
                float o[8];
#pragma unroll
                for (int q = 0; q < 8; ++q) o[q] = lane < 16 ? tanhf(sh[q]) : (lane < 32 ? sh[q] : sigmoidf_(sh[q]));
                u32x4 w; w.x = pk2(o[0], o[1]); w.y = pk2(o[2], o[3]); w.z = pk2(o[4], o[5]); w.w = pk2(o[6], o[7]);
                *(u32x4*)(A2 + (size_t)m * 384 + lane * 8) = w;
            }
        }
    }
}

constexpr int NSEG = 64, SEGL = KEYS / NSEG;
static_assert(SEGL * NSEG == KEYS && SEGL % 4 == 0, "segments");
constexpr size_t WS_GH = WS_YA;
static_assert(WS_GH + 32ull * NSEG * 2 * 4096 * 4 <= 560 * MiB, "GH fits behind the stream");
__device__ __forceinline__ int scan_token(int b, int dir, int s) {
    if (s < CTXL) return NLAT + b * CTXL + (dir ? CTXL - 1 - s : s);
    const int t = s - CTXL; return b * SEQ + (dir ? SEQ - 1 - t : t);
}
constexpr int SRING = 6, SREC = ST_SLOTS * 64 * 4;
constexpr int SCAN_LDS = SRING * SREC;
__device__ __forceinline__ void scan_dma(const float* rec, LAS unsigned char* slot, int lane) {
    const float* q = rec + lane * 4;
    __builtin_amdgcn_global_load_lds((const unsigned*)q, (LAS unsigned*)slot, 16, 0, 0);
    __builtin_amdgcn_global_load_lds((const unsigned*)(q + 256), (LAS unsigned*)(slot + 1024), 16, 0, 0);
}
template <int MODE>
__device__ __forceinline__ void rwkv_segment(const Params& p, int layer, int sid, int seg, int lane, LAS unsigned char* ring) {
    const int b = sid >> 4, h = (sid >> 1) & 7, dir = sid & 1, c = lane & 31, hf = lane >> 5;
    const float ka0 = p.in[20][layer * 512 + h * 64 + c], ka1 = p.in[20][layer * 512 + h * 64 + 32 + c];
    const float* ST = (const float*)(p.ws + WS_ST);
    float* gh = (float*)(p.ws + WS_GH) + ((size_t)sid * NSEG + seg) * 2 * 4096;
    f32x16 TH[2][2], TG[MODE == 0 ? 2 : 1][2];
#pragma unroll
    for (int kb = 0; kb < 2; ++kb)
#pragma unroll
        for (int vb = 0; vb < 2; ++vb) {
            if (MODE == 2 && seg > 0) {
                const float* src = gh - 4096 + (32 * vb + c) * 64 + 32 * kb + 4 * hf;
#pragma unroll
                for (int q = 0; q < 4; ++q) { const f32x4 t = *(const f32x4*)(src + 8 * q); TH[kb][vb][4 * q] = t.x; TH[kb][vb][4 * q + 1] = t.y; TH[kb][vb][4 * q + 2] = t.z; TH[kb][vb][4 * q + 3] = t.w; }
            } else {
#pragma unroll
                for (int r = 0; r < 16; ++r) TH[kb][vb][r] = 0.f;
            }
            if (MODE == 0) {
#pragma unroll
                for (int r = 0; r < 16; ++r) TG[MODE == 0 ? kb : 0][vb][r] = (32 * kb + 8 * (r >> 2) + 4 * hf + (r & 3) == 32 * vb + c) ? 1.0f : 0.0f;
            }
        }
    const int s0 = seg * SEGL, s_end = s0 + SEGL, od = (4 + 2 * dir) * 256;
#pragma unroll 1
    for (int j = 0; j < SRING - 1; ++j) scan_dma(ST + ((size_t)scan_token(b, dir, s0 + j) * 8 + h) * (ST_SLOTS * 64), ring + j * SREC, lane);
    int slot_i = 0;
#pragma unroll 1
    for (int s = s0; s < s_end; ++s) {
        if (s + SRING - 1 < s_end) {
            int nslot = slot_i + SRING - 1; if (nslot >= SRING) nslot -= SRING;
            scan_dma(ST + ((size_t)scan_token(b, dir, s + SRING - 1) * 8 + h) * (ST_SLOTS * 64), ring + nslot * SREC, lane);
            asm volatile("s_waitcnt vmcnt(10)" ::: "memory");
        } else asm volatile("s_waitcnt vmcnt(0)" ::: "memory");
        const LAS unsigned char* rec = ring + slot_i * SREC;
        slot_i = slot_i + 1 == SRING ? 0 : slot_i + 1;
        float ph[2] = {0.f, 0.f}, pg[2] = {0.f, 0.f};
#pragma unroll
        for (int kb = 0; kb < 2; ++kb)
#pragma unroll
            for (int q = 0; q < 4; ++q) {
                const f32x4 a4 = *(const LAS f32x4*)(rec + (32 * kb + 8 * q + 4 * hf) * 4);
#pragma unroll
                for (int j = 0; j < 4; ++j)
#pragma unroll
                    for (int vb = 0; vb < 2; ++vb) { ph[vb] = fmaf(TH[kb][vb][4 * q + j], a4[j], ph[vb]); if (MODE == 0) pg[vb] = fmaf(TG[MODE == 0 ? kb : 0][vb][4 * q + j], a4[j], pg[vb]); }
            }
        float sa[2], sg[2];
#pragma unroll
        for (int vb = 0; vb < 2; ++vb) { sa[vb] = xhalf_sum(ph[vb]); sg[vb] = MODE == 0 ? xhalf_sum(pg[vb]) : 0.f; }
#pragma unroll
        for (int kb = 0; kb < 2; ++kb)
#pragma unroll
            for (int q = 0; q < 4; ++q) {
                const f32x4 w4 = *(const LAS f32x4*)(rec + od + (32 * kb + 8 * q + 4 * hf) * 4);
#pragma unroll
                for (int j = 0; j < 4; ++j)
#pragma unroll
                    for (int vb = 0; vb < 2; ++vb) { TH[kb][vb][4 * q + j] *= w4[j]; if (MODE == 0) TG[MODE == 0 ? kb : 0][vb][4 * q + j] *= w4[j]; }
            }
        float aop[2], bop[2], bopg[2];
#pragma unroll
        for (int kb = 0; kb < 2; ++kb) {
            const float ag = *(const LAS float*)(rec + od + 256 + (32 * kb + c) * 4), x = *(const LAS float*)(rec + (hf ? 768 : 0) + (32 * kb + c) * 4);
            aop[kb] = x * (hf ? fmaf(ag - 1.0f, kb ? ka1 : ka0, 1.0f) : -ag);
        }
#pragma unroll
        for (int vb = 0; vb < 2; ++vb) { const float vv = *(const LAS float*)(rec + 512 + (32 * vb + c) * 4); bop[vb] = hf ? vv : sa[vb]; bopg[vb] = hf ? 0.f : sg[vb]; }
#pragma unroll
        for (int kb = 0; kb < 2; ++kb)
#pragma unroll
            for (int vb = 0; vb < 2; ++vb) {
                TH[kb][vb] = __builtin_amdgcn_mfma_f32_32x32x2f32(aop[kb], bop[vb], TH[kb][vb], 0, 0, 0);
                if (MODE == 0) TG[MODE == 0 ? kb : 0][vb] = __builtin_amdgcn_mfma_f32_32x32x2f32(aop[kb], bopg[vb], TG[MODE == 0 ? kb : 0][vb], 0, 0, 0);
            }
        if (MODE == 2) {
            float py[2] = {0.f, 0.f};
#pragma unroll
            for (int kb = 0; kb < 2; ++kb)
#pragma unroll
                for (int q = 0; q < 4; ++q) {
                    const f32x4 r4 = *(const LAS f32x4*)(rec + 256 + (32 * kb + 8 * q + 4 * hf) * 4);
#pragma unroll
                    for (int j = 0; j < 4; ++j)
#pragma unroll
                        for (int vb = 0; vb < 2; ++vb) py[vb] = fmaf(TH[kb][vb][4 * q + j], r4[j], py[vb]);
                }
            const float y0 = xhalf_sum(py[0]), y1 = xhalf_sum(py[1]);
            float* yp = (float*)ST + ((size_t)scan_token(b, dir, s) * 8 + h) * (ST_SLOTS * 64) + (4 + 2 * dir) * 64 + c;
            if (hf == 0) { yp[0] = y0; yp[32] = y1; }
        }
    }
    if (MODE == 0) {
#pragma unroll
        for (int kb = 0; kb < 2; ++kb)
#pragma unroll
            for (int vb = 0; vb < 2; ++vb) {
                float* dg = gh + (32 * vb + c) * 64 + 32 * kb + 4 * hf; float* dh = dg + 4096;
#pragma unroll
                for (int q = 0; q < 4; ++q) {
                    *(f32x4*)(dg + 8 * q) = (f32x4){TG[MODE == 0 ? kb : 0][vb][4 * q], TG[MODE == 0 ? kb : 0][vb][4 * q + 1], TG[MODE == 0 ? kb : 0][vb][4 * q + 2], TG[MODE == 0 ? kb : 0][vb][4 * q + 3]};
                    *(f32x4*)(dh + 8 * q) = (f32x4){TH[kb][vb][4 * q], TH[kb][vb][4 * q + 1], TH[kb][vb][4 * q + 2], TH[kb][vb][4 * q + 3]};
                }
            }
    }
}
__device__ __forceinline__ void rwkv_combine(const Params& p, int sid, LAS unsigned char* lds, int wave, int lane) {
    float* gh0 = (float*)(p.ws + WS_GH) + (size_t)sid * NSEG * 2 * 4096;
    LAS float* Sx = (LAS float*)lds;
    const int tid = wave * 64 + lane;
    for (int e = tid; e < 4096; e += NTHREADS) Sx[(e >> 6) * 65 + (e & 63)] = gh0[4096 + e];
    __syncthreads();
    const int rb = (wave >> 1) & 1, cb = wave & 1, i32 = lane & 31, hf = lane >> 5;
    for (int i = 1; i < NSEG - 1; ++i) {
        float* gi = gh0 + (size_t)i * 2 * 4096;
        f32x16 d;
        if (wave < 4) {
            float bq[32];
#pragma unroll
            for (int q = 0; q < 32; ++q) bq[q] = gi[(2 * q + hf) * 64 + 32 * cb + i32];
#pragma unroll
            for (int r = 0; r < 16; ++r) d[r] = gi[4096 + (32 * rb + 8 * (r >> 2) + 4 * hf + (r & 3)) * 64 + 32 * cb + i32];
#pragma unroll
            for (int q = 0; q < 32; ++q) {
                const float aq = Sx[(32 * rb + i32) * 65 + 2 * q + hf];
                d = __builtin_amdgcn_mfma_f32_32x32x2f32(aq, bq[q], d, 0, 0, 0);
            }
#pragma unroll
            for (int r = 0; r < 16; ++r) gi[4096 + (32 * rb + 8 * (r >> 2) + 4 * hf + (r & 3)) * 64 + 32 * cb + i32] = d[r];
        }
        __syncthreads();
        if (wave < 4) {
#pragma unroll
            for (int r = 0; r < 16; ++r) Sx[(32 * rb + 8 * (r >> 2) + 4 * hf + (r & 3)) * 65 + 32 * cb + i32] = d[r];
        }
        __syncthreads();
    }
}

__device__ __forceinline__ void postmix_phase(const Params& p, int layer, float lam_init, int M, int gw, int NGW, int lane) {
    const bf16_t* P = (const bf16_t*)(p.ws + WS_P); const float* ST = (const float*)(p.ws + WS_ST);
    bf16_t* YB = (bf16_t*)(p.ws + WS_YB); bf16_t* YC = (bf16_t*)(p.ws + WS_YC);
    const float* k_a = p.in[20] + layer * 512; const float* r_k = p.in[21] + layer * 512; const float* lng = p.in[22] + layer * 512; const float* lnb = p.in[23] + layer * 512; const float* sg = p.in[25] + layer * 128;
    for (int m = gw; m < M; m += NGW) {
        {
            const int h = lane >> 3, kidx = (lane & 7) * 8, ch = lane * 8;
            const float* sp = ST + ((size_t)m * 8 + h) * (ST_SLOTS * 64) + kidx;
            float y[8], r[8], v[8], k0[8], k1[8], rk[8], g[8], lg[8], lb[8];
            { float yb_[8]; ld8f(sp + 4 * 64, y); ld8f(sp + 6 * 64, yb_);
#pragma unroll
              for (int q = 0; q < 8; ++q) y[q] += yb_[q]; }
            ld8f(sp + 64, r); ld8f(sp + 128, v); ld8f(sp + 3 * 64, k0); ld8f(r_k + ch, rk); ld8f(lng + ch, lg); ld8f(lnb + ch, lb);
            { float a0_[8], a1_[8], ka_[8]; ld8f(sp + 5 * 64, a0_); ld8f(sp + 7 * 64, a1_); ld8f(k_a + ch, ka_);
#pragma unroll
              for (int q = 0; q < 8; ++q) { k1[q] = 0.f; k0[q] *= fmaf(a0_[q] + a1_[q] - 2.0f, ka_[q], 2.0f); } }
            ld8bf(P + (size_t)m * PP + IC_RW + ch, g);
            float s = 0.f, bn = 0.f;
#pragma unroll
            for (int q = 0; q < 8; ++q) { s += y[q]; bn += r[q] * (k0[q] + k1[q]) * rk[q]; }
            s += __shfl_xor(s, 1); s += __shfl_xor(s, 2); s += __shfl_xor(s, 4);
            bn += __shfl_xor(bn, 1); bn += __shfl_xor(bn, 2); bn += __shfl_xor(bn, 4);
            const float mu = s * (1.0f / 64.0f);
            float var = 0.f;
#pragma unroll
            for (int q = 0; q < 8; ++q) { const float d = y[q] - mu; var += d * d; }
            var += __shfl_xor(var, 1); var += __shfl_xor(var, 2); var += __shfl_xor(var, 4);
            const float rstd = 1.0f / sqrtf(var * (1.0f / 64.0f) + 64e-5f);
            float o[8];
#pragma unroll
            for (int q = 0; q < 8; ++q) o[q] = (((y[q] - mu) * rstd) * lg[q] + lb[q] + bn * v[q]) * g[q];
            u32x4 w; w.x = pk2(o[0], o[1]); w.y = pk2(o[2], o[3]); w.z = pk2(o[4], o[5]); w.w = pk2(o[6], o[7]);
            *(u32x4*)(YB + (size_t)m * 512 + ch) = w;
        }
        *(u32x4*)((bf16_t*)(p.ws + WS_YA) + (size_t)m * 512 + lane * 8) = *(const u32x4*)(P + (size_t)m * PP + IC_QS + lane * 8);
        {
            const int e = (lane & 15) * 8;
            float x[8], gg[8];
            ld8bf(P + (size_t)m * PP + IC_QD + lane * 8, x); ld8f(sg + e, gg);
            float ss = 0.f;
#pragma unroll
            for (int q = 0; q < 8; ++q) ss += x[q] * x[q];
            ss += __shfl_xor(ss, 1); ss += __shfl_xor(ss, 2); ss += __shfl_xor(ss, 4); ss += __shfl_xor(ss, 8);
            const float rstd = (1.0f - lam_init) / sqrtf(ss * (1.0f / 128.0f) + 1e-5f);
            float o[8];
#pragma unroll
            for (int q = 0; q < 8; ++q) o[q] = x[q] * rstd * gg[q];
            u32x4 w; w.x = pk2(o[0], o[1]); w.y = pk2(o[2], o[3]); w.z = pk2(o[4], o[5]); w.w = pk2(o[6], o[7]);
            *(u32x4*)(YC + (size_t)m * 512 + lane * 8) = w;
        }
    }
}
#define XB_TMO      128
#define XB_XCNT(j)  (256  + 64 * (j))
#define XB_XSUB(j)  (1280 + 64 * (j))
#define XB_XGEN(j)  (2304 + 64 * (j))
#define XB_TOP      3328
#define XB_TOPGEN   3392
#define XCD_BAR_WORDS 3456
#define XB_SPIN_CAP (1u << 18)

__device__ __forceinline__ unsigned xb_ld(unsigned* p)              { return __hip_atomic_load(p, __ATOMIC_RELAXED, __HIP_MEMORY_SCOPE_AGENT); }
__device__ __forceinline__ unsigned xb_add(unsigned* p, unsigned v) { return __hip_atomic_fetch_add(p, v, __ATOMIC_RELAXED, __HIP_MEMORY_SCOPE_AGENT); }
__device__ __forceinline__ unsigned xb_xcc_id() { return (unsigned)__builtin_amdgcn_s_getreg((3 << 11) | 20) & 0xFu; }
#define XB_SPIN(cond, bar) do { unsigned _sp = 0; while (cond) { __builtin_amdgcn_s_sleep(1); \
    if ((++_sp & 255u) == 0u) { if (xb_ld(&(bar)[XB_TMO])) break; if (_sp > XB_SPIN_CAP) { atomicAdd(&(bar)[XB_TMO], 1u); break; } } } } while (0)

struct XcdBarrier {
    unsigned* bar; unsigned x;
    volatile LAS unsigned* st;
};

__device__ __forceinline__ XcdBarrier xcd_barrier_post(unsigned* bar, volatile LAS unsigned* st) {
    XcdBarrier b; b.bar = bar; b.x = xb_xcc_id(); b.st = st;
    if (threadIdx.x == 0) (void)xb_add(&bar[XB_XCNT(b.x)], 1u);
    return b;
}
__device__ __forceinline__ void xcd_barrier_complete(unsigned* bar, unsigned x, unsigned& nloc, unsigned& nx) {
    const unsigned G = gridDim.x * gridDim.y * gridDim.z;
    unsigned sum, cnt, mine, sp = 0u;
    for (;;) {
        sum = 0u; cnt = 0u; mine = 0u;
#pragma unroll
        for (unsigned j = 0; j < 16; ++j) { const unsigned c = xb_ld(&bar[XB_XCNT(j)]); sum += c; cnt += (c > 0u) ? 1u : 0u; mine = (j == x) ? c : mine; }
        if (sum == G) break;
        __builtin_amdgcn_s_sleep(1);
        if ((++sp & 255u) == 0u) { if (xb_ld(&bar[XB_TMO])) break; if (sp > XB_SPIN_CAP) { atomicAdd(&bar[XB_TMO], 1u); break; } }
    }
    nloc = mine > 0u ? mine : 1u; nx = cnt > 0u ? cnt : 1u;
}

__device__ __forceinline__ void xcd_barrier(const XcdBarrier& b) {
    asm volatile("s_waitcnt vmcnt(0)" ::: "memory");
    __syncthreads();
    if (threadIdx.x == 0) {
        unsigned* bar = b.bar;
        __builtin_amdgcn_s_waitcnt(0);
        unsigned nloc = b.st[0], nx = b.st[1];
        if (nloc == 0u) { xcd_barrier_complete(bar, b.x, nloc, nx); b.st[0] = nloc; b.st[1] = nx; }
        const unsigned old = xb_add(&bar[XB_XSUB(b.x)], 1u);
        const unsigned gen = old / nloc;
        if (old + 1u == (gen + 1u) * nloc) {
            __builtin_amdgcn_fence(__ATOMIC_RELEASE, "agent");
            asm volatile("s_waitcnt vmcnt(0)" ::: "memory");
            const unsigned og = xb_add(&bar[XB_TOP], 1u);
            const unsigned tg = og / nx;
            if (og + 1u == (tg + 1u) * nx) xb_add(&bar[XB_TOPGEN], 1u);
            else XB_SPIN(xb_ld(&bar[XB_TOPGEN]) == tg, bar);
            __builtin_amdgcn_fence(__ATOMIC_ACQUIRE, "agent");
            xb_add(&bar[XB_XGEN(b.x)], 1u);
            asm volatile("s_waitcnt vmcnt(0)" ::: "memory");
        } else {
            XB_SPIN(xb_ld(&bar[XB_XGEN(b.x)]) == gen, bar);
            __builtin_amdgcn_fence(__ATOMIC_ACQUIRE, "agent");
            asm volatile("s_waitcnt vmcnt(0)" ::: "memory");
        }
    }
    __syncthreads();
}

#ifndef MK_MULTI
#define MK_MULTI 0
#endif
constexpr int N_PHASES = 40;

constexpr int LDS_PARAMS = LDS_BYTES - 1024;
constexpr int LDS_XB = LDS_BYTES - 64;
constexpr int CW_BAR = 8192;
__device__ __forceinline__ unsigned long long uni64(unsigned long long v) {
    const unsigned lo = __builtin_amdgcn_readfirstlane((unsigned)v), hi = __builtin_amdgcn_readfirstlane((unsigned)(v >> 32));
    return ((unsigned long long)hi << 32) | lo;
}
__device__ __forceinline__ int opq(int v) { asm volatile("" : "+s"(v)); return v; }
__device__ __forceinline__ void load_params(LAS unsigned char* lds, Params& q) {
    LAS const unsigned long long* s = (LAS const unsigned long long*)(lds + LDS_PARAMS);
#pragma unroll
    for (int i = 0; i < 37; ++i) q.in[i] = (const float*)(const __attribute__((address_space(1))) float*)uni64(s[i]);
    q.out = (float*)(__attribute__((address_space(1))) float*)uni64(s[37]); q.ws = (unsigned char*)(__attribute__((address_space(1))) unsigned char*)uni64(s[38]); q.ph_lo = 0; q.ph_hi = 0;
}
__global__ void __launch_bounds__(NTHREADS, 2) mk_fwd(Params kp) {
    extern __shared__ __attribute__((aligned(16))) unsigned char lds_raw[];
    LAS unsigned char* lds = (LAS unsigned char*)lds_raw;
    cg::grid_group grid = cg::this_grid();
    if (threadIdx.x == 0) {
        LAS unsigned long long* s = (LAS unsigned long long*)(lds + LDS_PARAMS);
#pragma unroll
        for (int i = 0; i < 37; ++i) s[i] = (unsigned long long)kp.in[i];
        s[37] = (unsigned long long)kp.out; s[38] = (unsigned long long)kp.ws;
    }
    if (threadIdx.x < 2) ((LAS unsigned*)(lds + LDS_XB))[threadIdx.x] = 0u;
    __syncthreads();
#if !MK_MULTI
    (void)xcd_barrier_post((unsigned*)(kp.ws + WS_CTL) + CW_BAR, (volatile LAS unsigned*)(lds + LDS_XB));
#endif
    const int ph_lo = kp.ph_lo, ph_hi = kp.ph_hi;
    int ph = 0;
#define PH_BEGIN if (ph >= ph_lo && ph < ph_hi) { asm volatile("" ::: "memory"); Params p; load_params(lds, p); unsigned char* ws = p.ws; (void)ws; \
    int tid_ = threadIdx.x, bid_ = blockIdx.x, G_ = gridDim.x; asm volatile("" : "+v"(tid_), "+s"(bid_), "+s"(G_)); \
    const int tid = tid_, bid = bid_, G = G_, lane = tid & 63, wave = __builtin_amdgcn_readfirstlane(tid >> 6); const int gw = bid * NWAVES + wave, NGW = G * NWAVES; (void)gw; (void)NGW; (void)lane; (void)tid; (void)G; (void)bid;
#define GRID_SEAM() do { if (ph == 0) grid.sync(); else { XcdBarrier xb_; xb_.bar = (unsigned*)((unsigned char*)(__attribute__((address_space(1))) unsigned char*)uni64(((LAS const unsigned long long*)(lds + LDS_PARAMS))[38]) + WS_CTL) + CW_BAR; \
        xb_.x = xb_xcc_id(); xb_.st = (volatile LAS unsigned*)(lds + LDS_XB); xcd_barrier(xb_); } } while (0)
#define PH_END } if (ph >= ph_lo && ph + 1 < ph_hi) GRID_SEAM(); ++ph;

    using pg8::Gemm; using pg8::StaticOrder; using pg8::gemm_phase;

    PH_BEGIN
        convert_layer_weights(p, 0, lds, gw, NGW, wave, lane);
        __syncthreads();
        adaln_phase(p, lds, wave, lane);
    PH_END
    PH_BEGIN
        premix_phase(p, 0, true, NTOK, gw, NGW, lane);
    PH_END

#pragma clang loop unroll(full)
    for (int layer = 0; layer < 2; ++layer) {
        const int Ml = layer == 0 ? NTOK : NLAT;
        const float lam_init = 0.8f - 0.6f * expf(-0.3f * (float)layer);
        PH_BEGIN
            Gemm g{(const bf16_t*)(ws + WS_XN), (const bf16_t*)(ws + WS_WIN), NTOK, NIN1, opq(1024), 1024}; StaticOrder S; S.init(NTOK, NIN1, G, bid);
            EpiIn E{(bf16_t*)(ws + WS_P), (bf16_t*)(ws + WS_VTS), (bf16_t*)(ws + WS_VTD), (const float*)(ws + WS_ROPE)};
            gemm_phase<EpiIn, StaticOrder, true, true>(lds, g, S, E);
        PH_END
        PH_BEGIN
            rwkv_prepare_phase(p, layer, gw, NGW, lane);
        PH_END
        PH_BEGIN
            Gemm g{(const bf16_t*)(ws + WS_YA), (const bf16_t*)(ws + WS_LORA), NTOK, 2560, opq(128), 384}; LoraSched S; S.S.init(NTOK, 2560, G, bid);
            EpiLora E{(float*)(ws + WS_ST), (bf16_t*)(ws + WS_P), p.in[14] + layer * 1024, p.in[16] + layer * 1024};
            gemm_phase<EpiLora, LoraSched, true, true>(lds, g, S, E);
        PH_END
        PH_BEGIN
            for (int u = gw; u < 32 * (NSEG - 1); u += NGW) rwkv_segment<0>(p, layer, u / (NSEG - 1), u % (NSEG - 1), lane, lds + wave * SCAN_LDS);
        PH_END
        PH_BEGIN
            unsigned* qhead = (unsigned*)(ws + WS_CTL) + (layer == 0 ? CW_Q0 : CW_Q1);
            LAS int* ubox = (LAS int*)(lds + 65536);
            const int n_swa = 512 + (layer == 0 ? 16 : 0);
            if (bid < 32) rwkv_combine(p, bid, lds, wave, lane);
            if (bid >= 32 || G <= 32)
            for (;;) {
                if (tid == 0) ubox[0] = (int)atomicAdd(qhead, 1u);
                __syncthreads();
                const int u = ubox[0];
                __syncthreads();
                if (u >= n_swa) break;
                if (u < 512) swa_unit(lds, p, layer, u >> 8, (u >> 5) & 7, u & 31, false, wave, lane);
                else { const int v = u - 512; swa_unit(lds, p, layer, v >> 3, v & 7, 0, true, wave, lane); }
            }
        PH_END
        PH_BEGIN
            for (int u = gw; u < 32 * NSEG; u += NGW) rwkv_segment<2>(p, layer, u / NSEG, u % NSEG, lane, lds + wave * SCAN_LDS);
            asm volatile("s_waitcnt vmcnt(0)" ::: "memory");
            __syncthreads();
            float lam;
            { const float* lv = p.in[24] + layer * 256;
              const float s1 = wave_sum(lv[lane] * lv[64 + lane]), s2 = wave_sum(lv[128 + lane] * lv[192 + lane]);
              lam = expf(s1) - expf(s2) + lam_init; }
            for (int u = bid; u < 256; u += G) { const int v = G == 256 ? ((((u & 7) >> 2) << 7) | ((u & 3) << 5) | (u >> 3)) : u; diff_unit(lds, p, lam, v >> 7, (v >> 5) & 3, v & 31, false, wave, lane); }
            if (layer == 0) for (int u = bid; u < 8; u += G) diff_unit(lds, p, lam, u >> 2, u & 3, 0, true, wave, lane);
        PH_END
        PH_BEGIN
            postmix_phase(p, layer, lam_init, Ml, gw, NGW, lane);
            if (layer == 0) convert_ffn_weights(p, lds, gw, NGW, wave, lane);
            __syncthreads();
            Gemm g{(const bf16_t*)(ws + WS_XN), (const bf16_t*)(ws + WS_WIN) + (size_t)NIN1 * 1024, Ml, 3072, opq(1024), 1024}; StaticOrder S; S.init(Ml, 3072, G, bid);
            EpiGate E{(bf16_t*)(ws + WS_G)};
            gemm_phase<EpiGate, StaticOrder, true, true>(lds, g, S, E);
        PH_END
        PH_BEGIN
            StaticOrder S; S.init(Ml, 1024, G, bid);
            { Gemm g{(const bf16_t*)(ws + WS_YA), (const bf16_t*)(ws + WS_PRJ), Ml, 1024, opq(512), 512}; EpiMerge<0> E{(const bf16_t*)(ws + WS_G), (bf16_t*)(ws + WS_MF), (bf16_t*)(ws + WS_MB)};
              gemm_phase<EpiMerge<0>, StaticOrder, true, true>(lds, g, S, E); }
            { Gemm g{(const bf16_t*)(ws + WS_YB), (const bf16_t*)(ws + WS_PRJ) + 1024 * 512, Ml, 1024, opq(512), 512}; EpiMerge<1> E{(const bf16_t*)(ws + WS_G), (bf16_t*)(ws + WS_MF), (bf16_t*)(ws + WS_MB)};
              gemm_phase<EpiMerge<1>, StaticOrder, true, true>(lds, g, S, E); }
            { Gemm g{(const bf16_t*)(ws + WS_YC), (const bf16_t*)(ws + WS_PRJ) + 2 * 1024 * 512, Ml, 1024, opq(512), 512}; EpiMerge<2> E{(const bf16_t*)(ws + WS_G), (bf16_t*)(ws + WS_MF), (bf16_t*)(ws + WS_MB)};
              gemm_phase<EpiMerge<2>, StaticOrder, true, true>(lds, g, S, E); }
        PH_END
        PH_BEGIN
            Gemm g{(const bf16_t*)(ws + WS_MB), (const bf16_t*)(ws + WS_WOUT), Ml, 1024, opq(1024), 1024}; StaticOrder S; S.init(Ml, 1024, G, bid);
            EpiBf E{(bf16_t*)(ws + WS_MOUT), 1024};
            gemm_phase<EpiBf, StaticOrder, true, true>(lds, g, S, E);
        PH_END
        PH_BEGIN
            residual_phase(p, (const bf16_t*)(ws + WS_MOUT), nullptr, nullptr, layer == 0, layer, 2, p.in[7] + layer * 1024, true, p.in[8] + layer * 1024, layer, 3, layer == 1, Ml, gw, NGW, lane);
            if (layer == 0) convert_layer_weights(p, 1, lds, gw, NGW, wave, lane);
            else convert_moe_weights(p, lds, gw, NGW, wave, lane);
        PH_END
        if (layer == 0) {
            PH_BEGIN
                Gemm g{(const bf16_t*)(ws + WS_XN), (const bf16_t*)(ws + WS_FGU), NTOK, 2 * D_FF, opq(1024), 1024}; StaticOrder S; S.init(NTOK, 2 * D_FF, G, bid);
                EpiSwiglu E{(bf16_t*)(ws + WS_HID), D_FF, 1 << 20, 0};
                gemm_phase<EpiSwiglu, StaticOrder, true, true>(lds, g, S, E);
            PH_END
            PH_BEGIN
                Gemm g{(const bf16_t*)(ws + WS_HID), (const bf16_t*)(ws + WS_FD), NTOK, 1024, opq(D_FF), D_FF}; StaticOrder S; S.init(NTOK, 1024, G, bid);
                EpiBf E{(bf16_t*)(ws + WS_MF), 1024};
                gemm_phase<EpiBf, StaticOrder, true, true>(lds, g, S, E);
            PH_END
            PH_BEGIN
                residual_phase(p, (const bf16_t*)(ws + WS_MF), nullptr, nullptr, false, 0, 5, p.in[9], true, p.in[6] + 1024, 1, 0, false, NTOK, gw, NGW, lane);
            PH_END
        }
    }
    {
        {
            PH_BEGIN
                const unsigned* cnt = (const unsigned*)(ws + WS_CTL) + CW_CNT; int ts[9]; ts[0] = 0;
#pragma unroll
                for (int e = 0; e < 8; ++e) ts[e + 1] = ts[e] + (int)((__hip_atomic_load(cnt + e, __ATOMIC_RELAXED, __HIP_MEMORY_SCOPE_AGENT) + 255u) >> 8);
                const int* LIST = (const int*)(ws + WS_LIST); const bf16_t* XN = (const bf16_t*)(ws + WS_XN2); bf16_t* XG = (bf16_t*)(ws + WS_XG);
                for (int r = gw; r < ts[8] * 256; r += NGW) {
                    const int tile = r >> 8; int e = 0;
#pragma unroll
                    for (int q = 1; q < 8; ++q) e += (tile >= ts[q]) ? 1 : 0;
                    int tse = 0;
#pragma unroll
                    for (int q = 0; q < 8; ++q) tse = (q == e) ? ts[q] : tse;
                    const int slot = r - tse * 256;
                    u32x4 v0 = (u32x4){0u, 0u, 0u, 0u}, v1 = v0;
                    if (slot < (int)cnt[e]) { const int tk = LIST[e * 16384 + slot]; const u32x4* src = (const u32x4*)(XN + (size_t)(tk >> 1) * 1024); v0 = src[lane]; v1 = src[lane + 64]; }
                    u32x4* dst = (u32x4*)(XG + (size_t)r * 1024); dst[lane] = v0; dst[lane + 64] = v1;
                }
            PH_END
            PH_BEGIN
                const unsigned* cnt = (const unsigned*)(ws + WS_CTL) + CW_CNT; int ts[9]; ts[0] = 0;
#pragma unroll
                for (int e = 0; e < 8; ++e) ts[e + 1] = ts[e] + (int)((__hip_atomic_load(cnt + e, __ATOMIC_RELAXED, __HIP_MEMORY_SCOPE_AGENT) + 255u) >> 8);
                MoeSched S;
#pragma unroll
                for (int e = 0; e < 9; ++e) S.ts[e] = ts[e];
                S.pm_lo = 0; S.pm_hi = ts[8]; S.npn = 28; S.G = G; S.c = bid; S.a_local = false;
                Gemm g{(const bf16_t*)(ws + WS_XG), (const bf16_t*)(ws + WS_MGU), 0, 0, opq(1024), 1024};
                EpiSwiglu E{(bf16_t*)(ws + WS_HIDM), D_FFE, 28, 0};
                gemm_phase<EpiSwiglu, MoeSched, true, true>(lds, g, S, E);
            PH_END
            PH_BEGIN
                const unsigned* cnt = (const unsigned*)(ws + WS_CTL) + CW_CNT; int ts[9]; ts[0] = 0;
#pragma unroll
                for (int e = 0; e < 8; ++e) ts[e + 1] = ts[e] + (int)((__hip_atomic_load(cnt + e, __ATOMIC_RELAXED, __HIP_MEMORY_SCOPE_AGENT) + 255u) >> 8);
                MoeSched S;
#pragma unroll
                for (int e = 0; e < 9; ++e) S.ts[e] = ts[e];
                S.pm_lo = 0; S.pm_hi = ts[8]; S.npn = 4; S.G = G; S.c = bid; S.a_local = false;
                Gemm g{(const bf16_t*)(ws + WS_HIDM), (const bf16_t*)(ws + WS_MD), 0, 0, opq(D_FFE), D_FFE};
                EpiMoeDown E; E.FS = (bf16_t*)(ws + WS_FACC); E.slot1_off = ((long)WS_MGU - (long)WS_FACC) / 2; E.LIST = (const int*)(ws + WS_LIST); E.WTS = (const float*)(ws + WS_WTS); E.cnt = cnt; E.pm_lo = 0;
#pragma unroll
                for (int e = 0; e < 9; ++e) E.ts[e] = ts[e];
                gemm_phase<EpiMoeDown, MoeSched, true, true>(lds, g, S, E);
            PH_END
            PH_BEGIN
                residual_phase(p, (const bf16_t*)(ws + WS_FACC), (const bf16_t*)(ws + WS_MGU), nullptr, false, 1, 5, p.in[9] + 1024, false, nullptr, 0, 0, false, NLAT, gw, NGW, lane);
            PH_END
        }
    }
#undef PH_BEGIN
#undef PH_END
}

extern "C" void kernel_launch(void* const* d_in, const int* in_sizes, int n_in, void* d_out, int out_size, void* d_ws, size_t ws_size, hipStream_t stream) {
    static int grid = 0;
    if (grid == 0) {
        if (n_in != 37 || out_size != NLAT * DM || ws_size < WS_NEED) { fprintf(stderr, "kernel_launch: unexpected shapes (n_in %d out %d ws %zu need %zu)\n", n_in, out_size, ws_size, (size_t)WS_NEED); grid = -1; return; }
        int dev = 0, cus = 0, per_cu = 0;
        (void)hipGetDevice(&dev);
        (void)hipDeviceGetAttribute(&cus, hipDeviceAttributeMultiprocessorCount, dev);
        (void)hipFuncSetAttribute((const void*)mk_fwd, hipFuncAttributeMaxDynamicSharedMemorySize, LDS_BYTES);
        (void)hipOccupancyMaxActiveBlocksPerMultiprocessor(&per_cu, (const void*)mk_fwd, NTHREADS, LDS_BYTES);
        if (per_cu < 1) { fprintf(stderr, "kernel_launch: occupancy query reports %d blocks per CU\n", per_cu); grid = -1; return; }
        grid = cus;
        fprintf(stderr, "kernel_launch: grid %d (cus %d, per_cu %d), ws %zu\n", grid, cus, per_cu, ws_size);
    }
    if (grid < 0) return;
    (void)hipMemsetAsync((char*)d_ws + WS_CTL, 0, CTL_BYTES, stream);
    Params prm{};
    for (int i = 0; i < 37; ++i) prm.in[i] = (const float*)d_in[i];
    prm.out = (float*)d_out; prm.ws = (unsigned char*)d_ws;
#if MK_MULTI
    for (int ph = 0; ph < N_PHASES; ++ph) { prm.ph_lo = ph; prm.ph_hi = ph + 1; hipLaunchKernelGGL(mk_fwd, dim3(grid), dim3(NTHREADS), LDS_BYTES, stream, prm); }
#else
    prm.ph_lo = 0; prm.ph_hi = 1 << 20;
    void* args[] = {&prm};
    hipError_t e = hipLaunchCooperativeKernel((const void*)mk_fwd, dim3(grid), dim3(NTHREADS), args, LDS_BYTES, stream);
    if (e != hipSuccess) fprintf(stderr, "kernel_launch: cooperative launch failed: %s (grid %d)\n", hipGetErrorString(e), grid);
#endif
}
```

```cpp
#include <hip/hip_runtime.h>
#include <hip/hip_cooperative_groups.h>
#include <cstdio>
#include <cstdint>
namespace cg = cooperative_groups;
namespace pg8 {
#define PG8_LAS __attribute__((address_space(3)))
typedef unsigned short bf16_t;
typedef short bf16x8 __attribute__((ext_vector_type(8)));
typedef float f32x4 __attribute__((ext_vector_type(4)));
typedef unsigned u32x4 __attribute__((ext_vector_type(4)));
constexpr int BM = 256, BK = 64, HALF = 128, HTB = HALF * BK * 2  , STAGE_BYTES = 8 * HTB, NXCD = 8, WGM = 8;

__host__ __device__ __forceinline__ int lds_byte(int r, int c) { const int st = (r >> 4) * 2 + (c >> 5), rr = r & 15, cc = c & 31, ob = rr * 64 + cc * 2; return st * 1024 + (ob ^ (((ob >> 9) & 1) << 5)); }
__host__ __device__ __forceinline__ void stage_rc(int b, int& R, int& C) { const int st = b / 1024, sb = b % 1024, swz = sb ^ (((sb >> 9) & 1) << 5); R = (st >> 1) * 16 + swz / 64; C = (st & 1) * 32 + (swz % 64) / 2; }
__host__ __device__ __forceinline__ int perm32(int rho) { const int n = rho >> 4, i = rho & 15; return 8 * (i >> 2) + 4 * n + (i & 3); }

struct Unit { int pm, pn, koff, tail; };
struct Gemm { const bf16_t* A; const bf16_t* Bt; int M, N, K, ld; };

struct StaticOrder {
    int nM, nN, nwg, G, c;
    __host__ __device__ void init(int M, int N, int G_, int c_) { nM = M / BM; nN = N / BM; nwg = nM * nN; G = G_; c = c_; }
    __host__ __device__ bool next(int i, Unit& u) const {
        const long L = (long)i * G + c; if (L >= nwg) return false;
        int wgid = (int)L; { const int q = nwg / NXCD, r = nwg % NXCD, xcd = wgid % NXCD, off = wgid / NXCD; wgid = (xcd < r ? xcd * (q + 1) : r * (q + 1) + (xcd - r) * q) + off; }
        const int nig = WGM * nN, gid = wgid / nig, fm = gid * WGM, gsz = (nM - fm) < WGM ? (nM - fm) : WGM;
        u.pm = fm + ((wgid % nig) % gsz); u.pn = (wgid % nig) / gsz; u.koff = 0; u.tail = -1; return true;
    }
    __device__ __forceinline__ void a_ready(const Unit&) const {}
    __device__ __forceinline__ void done(const Unit&) const {}
};

__device__ __forceinline__ unsigned cvt_pk_bf16(float lo, float hi) { unsigned r; asm volatile("v_cvt_pk_bf16_f32 %0, %1, %2" : "=v"(r) : "v"(lo), "v"(hi)); return r; }
typedef float f32x2 __attribute__((ext_vector_type(2)));
template <class Epi, class Sched, bool ALIGN_EPI = false, bool SP2 = false>
__device__ __forceinline__ void gemm_phase(PG8_LAS unsigned char* lds, const Gemm g, const Sched& S, const Epi& E) {
    int tid_ = threadIdx.x; asm volatile("" : "+v"(tid_)); const int tid = tid_, wid = __builtin_amdgcn_readfirstlane(tid >> 6), lane = tid & 63, wr = wid >> 2, wc = wid & 3, fr = lane & 15, fq = lane >> 4;
    const int K = g.ld, nt = g.K / BK;
    unsigned voffA[2], voffB[2];
#pragma unroll
    for (int i = 0; i < 2; ++i) { int R, C; stage_rc(tid * 16 + i * 8192, R, C); const int Rb = Epi::PERM ? ((R & ~31) + perm32(R & 31)) : R;
        voffA[i] = (unsigned)(R * K + C) * 2u; voffB[i] = (unsigned)(Rb * K + C) * 2u; }
    const size_t kstep = (size_t)(BK * 2);
    const size_t hstep = (size_t)HALF * K * 2;
    const size_t tstep = 2 * hstep;
    const unsigned ldsw = (unsigned)wid * 1024u;
    const int aoff = lds_byte(wr * 64 + fr, fq * 8), boff = lds_byte(wc * 32 + fr, fq * 8);
#define PG8_SA(b, h) (((b) * 2 + (h)) * HTB)
#define PG8_SB(b, h) ((4 + (b) * 2 + (h)) * HTB)
#define PG8_STAGE(bufoff, gbase, voff) do { _Pragma("unroll") for (int _i = 0; _i < 2; ++_i) \
        __builtin_amdgcn_global_load_lds((const unsigned*)((const char*)(gbase) + (voff)[_i]), (PG8_LAS unsigned*)(lds + (bufoff) + ldsw + _i * 8192), 16, 0, 0); } while (0)
#define PG8_LDA(dst, b, h) do { _Pragma("unroll") for (int m = 0; m < 4; ++m) _Pragma("unroll") for (int k = 0; k < 2; ++k) dst[m][k] = *(const PG8_LAS bf16x8*)(lds + PG8_SA(b, h) + aoff + m * 2048 + k * 1024); } while (0)
#define PG8_LDB(dst, b, h) do { _Pragma("unroll") for (int n = 0; n < 2; ++n) _Pragma("unroll") for (int k = 0; k < 2; ++k) dst[n][k] = *(const PG8_LAS bf16x8*)(lds + PG8_SB(b, h) + boff + n * 2048 + k * 1024); } while (0)
#define PG8_MMA(ai, bj, At, Bt) do { __builtin_amdgcn_s_setprio(1); _Pragma("unroll") for (int m = 0; m < 4; ++m) _Pragma("unroll") for (int n = 0; n < 2; ++n) _Pragma("unroll") for (int k = 0; k < 2; ++k) \
        acc[ai][bj][m][n] = __builtin_amdgcn_mfma_f32_16x16x32_bf16(Bt[n][k], At[m][k], acc[ai][bj][m][n], 0, 0, 0); __builtin_amdgcn_s_setprio(0); } while (0)
#define PG8_WAIT_V(n) asm volatile("s_waitcnt vmcnt(" #n ")" ::: "memory")
#define PG8_WAIT_L(n) asm volatile("s_waitcnt lgkmcnt(" #n ")" ::: "memory")
#define PG8_BAR __builtin_amdgcn_s_barrier()
#define PG8_SCHED __builtin_amdgcn_sched_barrier(0)
    Unit cur, nxt; int ui = 0;
    if (!S.next(0, cur)) return;
    f32x4 acc[2][2][4][2];
#pragma unroll
    for (int a = 0; a < 2; ++a)
#pragma unroll
        for (int b = 0; b < 2; ++b)
#pragma unroll
            for (int m = 0; m < 4; ++m)
#pragma unroll
                for (int n = 0; n < 2; ++n) acc[a][b][m][n] = (f32x4){0.f, 0.f, 0.f, 0.f};
    bf16x8 At[4][2], B0[2][2], B1[2][2];
    const char* cA = (const char*)g.A + (size_t)cur.pm * tstep + (size_t)cur.koff * 2; const char* cB = (const char*)g.Bt + (size_t)cur.pn * tstep + (size_t)cur.koff * 2;
    S.a_ready(cur);
    if constexpr (SP2) {
        PG8_STAGE(PG8_SB(0, 0), cB, voffB); PG8_STAGE(PG8_SB(0, 1), cB + hstep, voffB); PG8_STAGE(PG8_SA(0, 0), cA, voffA); PG8_STAGE(PG8_SA(0, 1), cA + hstep, voffA);
        if (wr == 1) PG8_BAR;
        PG8_WAIT_V(2); PG8_BAR;
        PG8_STAGE(PG8_SB(1, 0), cB + kstep, voffB); PG8_STAGE(PG8_SA(1, 0), cA + kstep, voffA); PG8_STAGE(PG8_SB(1, 1), cB + hstep + kstep, voffB);
        PG8_WAIT_V(6); PG8_BAR;
    } else {
        PG8_STAGE(PG8_SB(0, 0), cB, voffB); PG8_STAGE(PG8_SA(0, 0), cA, voffA); PG8_STAGE(PG8_SB(0, 1), cB + hstep, voffB); PG8_STAGE(PG8_SA(0, 1), cA + hstep, voffA);
        if (wr == 1) PG8_BAR;
        PG8_WAIT_V(4); PG8_BAR;
        PG8_STAGE(PG8_SB(1, 0), cB + kstep, voffB); PG8_STAGE(PG8_SA(1, 0), cA + kstep, voffA); PG8_STAGE(PG8_SB(1, 1), cB + hstep + kstep, voffB);
        PG8_WAIT_V(6); PG8_BAR;
    }
    for (;;) {
        const bool has_next = S.next(ui + 1, nxt);
        const char* nA = has_next ? (const char*)g.A + (size_t)nxt.pm * tstep + (size_t)nxt.koff * 2 : cA; const char* nB = has_next ? (const char*)g.Bt + (size_t)nxt.pn * tstep + (size_t)nxt.koff * 2 : cB;
        for (int t = 0; t < nt; t += 2) {
            const bool last = (t == nt - 2);
            const char* a1 = cA + (size_t)(t + 1) * kstep;
            const char* a2 = last ? nA : cA + (size_t)(t + 2) * kstep; const char* b2 = last ? nB : cB + (size_t)(t + 2) * kstep;
            const char* a3 = a2 + kstep; const char* b3 = b2 + kstep;
            if (last && has_next) S.a_ready(nxt);
            if constexpr (SP2) {
            PG8_LDB(B0, 0, 0); PG8_LDB(B1, 0, 1); PG8_SCHED; PG8_LDA(At, 0, 0); PG8_STAGE(PG8_SA(1, 1), a1 + hstep, voffA);
            PG8_WAIT_V(8); PG8_WAIT_L(0); PG8_BAR; PG8_MMA(0, 0, At, B0); PG8_MMA(0, 1, At, B1); PG8_BAR; PG8_SCHED;
            PG8_LDA(At, 0, 1); PG8_STAGE(PG8_SB(0, 0), b2, voffB); PG8_STAGE(PG8_SB(0, 1), b2 + hstep, voffB); PG8_STAGE(PG8_SA(0, 0), a2, voffA);
            PG8_WAIT_V(8); PG8_WAIT_L(0); PG8_BAR; PG8_MMA(1, 0, At, B0); PG8_MMA(1, 1, At, B1); PG8_BAR; PG8_SCHED;
            PG8_LDB(B0, 1, 0); PG8_LDB(B1, 1, 1); PG8_SCHED; PG8_LDA(At, 1, 0); PG8_STAGE(PG8_SA(0, 1), a2 + hstep, voffA);
            PG8_WAIT_V(8); PG8_WAIT_L(0); PG8_BAR; PG8_MMA(0, 0, At, B0); PG8_MMA(0, 1, At, B1); PG8_BAR; PG8_SCHED;
            PG8_LDA(At, 1, 1); PG8_STAGE(PG8_SB(1, 0), b3, voffB); PG8_STAGE(PG8_SB(1, 1), b3 + hstep, voffB); PG8_STAGE(PG8_SA(1, 0), a3, voffA);
            PG8_WAIT_V(8); PG8_WAIT_L(0); PG8_BAR; PG8_MMA(1, 0, At, B0); PG8_MMA(1, 1, At, B1); PG8_BAR; PG8_SCHED;
            } else {
            PG8_LDB(B0, 0, 0); PG8_SCHED; PG8_LDA(At, 0, 0); PG8_STAGE(PG8_SA(1, 1), a1 + hstep, voffA);
            PG8_WAIT_L(8); PG8_BAR; PG8_WAIT_L(0); PG8_MMA(0, 0, At, B0); PG8_BAR; PG8_SCHED;
            PG8_LDB(B1, 0, 1); PG8_STAGE(PG8_SB(0, 0), b2, voffB);
            PG8_BAR; PG8_WAIT_L(0); PG8_MMA(0, 1, At, B1); PG8_BAR;
            PG8_LDA(At, 0, 1); PG8_STAGE(PG8_SA(0, 0), a2, voffA);
            PG8_BAR; PG8_WAIT_L(0); PG8_MMA(1, 0, At, B0); PG8_BAR; PG8_SCHED;
            PG8_STAGE(PG8_SB(0, 1), b2 + hstep, voffB);
            PG8_WAIT_V(6); PG8_BAR; PG8_MMA(1, 1, At, B1); PG8_BAR;
            PG8_LDB(B0, 1, 0); PG8_SCHED; PG8_LDA(At, 1, 0); PG8_STAGE(PG8_SA(0, 1), a2 + hstep, voffA);
            PG8_WAIT_L(8); PG8_BAR; PG8_WAIT_L(0); PG8_MMA(0, 0, At, B0); PG8_BAR; PG8_SCHED;
            PG8_LDB(B1, 1, 1); PG8_STAGE(PG8_SB(1, 0), b3, voffB);
            PG8_BAR; PG8_WAIT_L(0); PG8_MMA(0, 1, At, B1); PG8_BAR;
            PG8_LDA(At, 1, 1); PG8_STAGE(PG8_SA(1, 0), a3, voffA);
            PG8_BAR; PG8_WAIT_L(0); PG8_MMA(1, 0, At, B0); PG8_BAR; PG8_SCHED;
            PG8_STAGE(PG8_SB(1, 1), b3 + hstep, voffB);
            PG8_WAIT_V(6); PG8_BAR; PG8_MMA(1, 1, At, B1); PG8_BAR;
            }
        }
        if constexpr (ALIGN_EPI) { if (wr == 0) PG8_BAR; }
        if constexpr (!Epi::AFTER_DRAIN) { E(acc, cur, wr, wc, fr, fq); S.done(cur); }
        if (!has_next) break;
#pragma unroll
        for (int a = 0; a < 2; ++a)
#pragma unroll
            for (int b = 0; b < 2; ++b)
#pragma unroll
                for (int m = 0; m < 4; ++m)
#pragma unroll
                    for (int n = 0; n < 2; ++n) acc[a][b][m][n] = (f32x4){0.f, 0.f, 0.f, 0.f};
        cur = nxt; cA = nA; cB = nB; ++ui;
        if constexpr (ALIGN_EPI) { if (wr == 1) PG8_BAR; }
    }
    PG8_WAIT_V(0);
    if constexpr (!ALIGN_EPI) { if (wr == 0) PG8_BAR; }
    PG8_BAR;
    if constexpr (Epi::AFTER_DRAIN) { E.fused(acc, cur, wr, wc, fr, fq, lds, wid, lane); S.done(cur); }
#undef PG8_SA
#undef PG8_SB
#undef PG8_STAGE
#undef PG8_LDA
#undef PG8_LDB
#undef PG8_MMA
#undef PG8_WAIT_V
#undef PG8_WAIT_L
#undef PG8_BAR
#undef PG8_SCHED
}
}

#define LAS __attribute__((address_space(3)))
typedef unsigned short bf16_t;
typedef short bf16x8 __attribute__((ext_vector_type(8)));
typedef float f32x4 __attribute__((ext_vector_type(4)));
typedef float f32x16 __attribute__((ext_vector_type(16)));
typedef unsigned u32x4 __attribute__((ext_vector_type(4)));
typedef unsigned u32x2 __attribute__((ext_vector_type(2)));

constexpr int NTHREADS = 512, NWAVES = 8;
constexpr int DM = 1024, SEQ = 8192, CTXL = 256, NLAT = 2 * SEQ, NCTX = 2 * CTXL, NTOK = NLAT + NCTX, KEYS = SEQ + CTXL;
constexpr int D_IN = 7296, D_FF = 2816, D_FFE = 3584, NEXP = 8;
constexpr int IC_QS = 0, IC_KS = 512, IC_RW = 640, IC_QD = 2560, IC_KD = 3072, PP = 3584, IC_VS = 3584, IC_VD = 3712, IC_PAD = 4224, NIN1 = 4352, WIN_ROWS = 7424;
constexpr int ST_SLOTS = 8;
constexpr int MOE_TILES = 136, MOE_HALF = 68;

constexpr size_t MiB = 1u << 20;
constexpr size_t WS_CTL = 0, CTL_BYTES = 1 * MiB;
constexpr size_t WS_MODS = 1 * MiB;
constexpr size_t WS_ROPE = 1 * MiB + 256 * 1024;
constexpr size_t WS_HCTX = 2 * MiB;
constexpr size_t WS_LIST = 4 * MiB;
constexpr size_t WS_WTS = 4 * MiB + 512 * 1024;
constexpr size_t WS_WIN = 6 * MiB;
constexpr size_t WS_PRJ = WS_WIN + (size_t)WIN_ROWS * 1024 * 2;
constexpr size_t WS_WOUT = WS_PRJ + 3 * MiB;
constexpr size_t WS_LORA = WS_WOUT + 2 * MiB;
constexpr size_t WS_XN = 28 * MiB;
constexpr size_t WS_P = 61 * MiB;
constexpr size_t WS_VTS = 177 * MiB;
constexpr size_t WS_VTD = WS_VTS + 4608 * 1024;
constexpr size_t WS_ST = 198 * MiB;
constexpr size_t WS_YA = 495 * MiB;
constexpr size_t WS_YB = WS_YA + 16896ull * 512 * 2;
constexpr size_t WS_YC = WS_YB + 16896ull * 512 * 2;
constexpr size_t WS_END = WS_YC + 16896ull * 512 * 2;
constexpr size_t WS_G = WS_ST;
constexpr size_t WS_MF = WS_ST + 99 * MiB;
constexpr size_t WS_MB = WS_ST + 165 * MiB;
constexpr size_t WS_MOUT = WS_ST + 198 * MiB;
constexpr size_t WS_FGU = WS_VTS;
constexpr size_t WS_FD = WS_VTS + 11 * MiB;
constexpr size_t WS_HID = WS_P;
constexpr size_t WS_XN2 = 495 * MiB;
constexpr size_t WS_MGU = 6 * MiB;
constexpr size_t WS_MD = 118 * MiB;
constexpr size_t WS_XG = 174 * MiB;
constexpr size_t WS_FACC = 242 * MiB;
constexpr size_t WS_HIDM = 306 * MiB;
static_assert(WS_LORA + 2560 * 384 * 2 <= WS_XN && WS_XN + 16896ull * 1024 * 2 <= WS_P && WS_P + 16896ull * PP * 2 <= WS_VTS && WS_VTD + 2ull * 4 * 128 * KEYS * 2 <= WS_ST, "ws map 1");
static_assert(WS_ST + 16896ull * 8 * ST_SLOTS * 64 * 4 <= WS_YA && WS_END <= 545 * MiB, "ws map 2");
static_assert(WS_G + 16896ull * 3072 * 2 <= WS_MF && WS_MF + 16896ull * 1024 * 4 <= WS_MB && WS_MB + 16896ull * 1024 * 2 <= WS_MOUT && WS_MOUT + 16896ull * 1024 * 4 <= WS_YA, "ws map 3");
static_assert(WS_FGU + 5632ull * 1024 * 2 <= WS_FD && WS_FD + 1024ull * 2816 * 2 <= WS_ST && WS_HID + 16896ull * 2816 * 2 <= WS_VTS, "ws map 4");
static_assert(WS_MGU + 8ull * 7168 * 1024 * 2 <= WS_MD && WS_MD + 8ull * 1024 * 3584 * 2 <= WS_XG && WS_XG + 34816ull * 1024 * 2 <= WS_FACC && WS_FACC + 16384ull * 1024 * 4 <= WS_HIDM && WS_HIDM + 136ull * 256 * 3584 * 2 <= 560 * MiB, "ws map 5");
static_assert(WS_FACC + 16384ull * 1024 * 4 <= WS_MOUT && WS_XN2 + 16384ull * 1024 * 2 <= 560 * MiB && WS_XN2 >= WS_MOUT + 16896ull * 1024 * 4, "expert weights / gathered rows / accumulator must not touch MOUT or XN2 while they are live");
constexpr size_t WS_NEED = 560 * MiB;
constexpr int CW_CNT = 0;
constexpr int CW_Q0 = 64, CW_Q1 = 128;

constexpr int LDS_BYTES = 147456;

__device__ __forceinline__ unsigned f2bf(float f) { unsigned u = __builtin_bit_cast(unsigned, f); return (u + 0x7fffu + ((u >> 16) & 1u)) >> 16; }
typedef float f32x2_t __attribute__((ext_vector_type(2))); typedef __bf16 bf16x2_t __attribute__((ext_vector_type(2)));
__device__ __forceinline__ unsigned pk2(float lo, float hi) { const f32x2_t v = {lo, hi}; return __builtin_bit_cast(unsigned, __builtin_convertvector(v, bf16x2_t)); }
__device__ __forceinline__ float bflo(unsigned w) { return __uint_as_float(w << 16); }
__device__ __forceinline__ float bfhi(unsigned w) { return __uint_as_float(w & 0xffff0000u); }
__device__ __forceinline__ float wave_sum(float v) {
#pragma unroll
    for (int o = 1; o < 64; o <<= 1) v += __shfl_xor(v, o);
    return v;
}
__device__ __forceinline__ float sigmoidf_(float x) { return 1.0f / (1.0f + __expf(-x)); }
__device__ __forceinline__ float siluf_(float x) { return x / (1.0f + __expf(-x)); }
#define LDS_WAIT() asm volatile("s_waitcnt lgkmcnt(0)" ::: "memory")

struct Params {
    const float* in[37];
    float* out;
    unsigned char* ws;
    int ph_lo, ph_hi;
};

template <class F>
__device__ __forceinline__ void transpose_item(const float* __restrict__ W, int ldw, int k0, int n0, bf16_t* __restrict__ WT, int ldt, int dcol0, F rowmap, LAS float* scr, int lane) {
#pragma unroll 8
    for (int i = 0; i < 32; ++i) { const int kk = 2 * i + (lane >> 5); scr[kk * 33 + (lane & 31)] = W[(size_t)(k0 + kk) * ldw + n0 + (lane & 31)]; }
    LDS_WAIT(); asm volatile("" ::: "memory");
    const int c = lane & 7;
#pragma unroll
    for (int j = 0; j < 4; ++j) {
        const int n = (lane >> 3) + 8 * j; const LAS float* s = scr + (8 * c) * 33 + n;
        u32x4 o; o.x = pk2(s[0 * 33], s[1 * 33]); o.y = pk2(s[2 * 33], s[3 * 33]); o.z = pk2(s[4 * 33], s[5 * 33]); o.w = pk2(s[6 * 33], s[7 * 33]);
        const int row = rowmap(n0 + n);
        if (row >= 0) *(u32x4*)(WT + (size_t)row * ldt + dcol0 + k0 + 8 * c) = o;
    }
    LDS_WAIT(); asm volatile("" ::: "memory");
}
struct RowId { __device__ __forceinline__ int operator()(int n) const { return n; } };
struct RowOff { int off; __device__ __forceinline__ int operator()(int n) const { return n + off; } };
struct RowWin {
    __device__ __forceinline__ int operator()(int n) const {
        if (n < 640) return n;
        if (n < 768) return n - 640 + IC_VS;
        if (n < 2688) return n - 768 + IC_RW;
        if (n < 3712) return n - 2688 + IC_QD;
        if (n < 4224) return n - 3712 + IC_VD;
        return n - 4224 + NIN1;
    }
};
struct RowGU { int up; __device__ __forceinline__ int operator()(int j) const { return (j >> 7) * 256 + (j & 127) + 128 * up; } };

template <class F>
__device__ __forceinline__ void convert_matrix(const float* W, int K, int N, bf16_t* WT, int ldt, int dcol0, F rowmap, LAS float* scr, int lane, int gw, int NGW) {
    const int nblk = N / 32, items = (K / 64) * nblk;
    for (int it = gw; it < items; it += NGW) { const int kb = it / nblk, nb = it % nblk; transpose_item(W, N, kb * 64, nb * 32, WT, ldt, dcol0, rowmap, scr, lane); }
}

__device__ __forceinline__ void lora_region(bf16_t* __restrict__ LT, const float* __restrict__ src, int row0, int klo, int kn, int gw, int NGW, int lane) {
    for (int i = gw * 64 + lane; i < 512 * 48; i += NGW * 64) {
        const int nn = i / 48, kc = (i % 48) * 8;
        u32x4 o = (u32x4){0u, 0u, 0u, 0u};
        if (kc >= klo && kc < klo + kn) {
            const float* s = src + (size_t)(kc - klo) * 512 + nn;
            o.x = pk2(s[0], s[512]); o.y = pk2(s[2 * 512], s[3 * 512]); o.z = pk2(s[4 * 512], s[5 * 512]); o.w = pk2(s[6 * 512], s[7 * 512]);
        }
        *(u32x4*)(LT + (size_t)(row0 + nn) * 384 + kc) = o;
    }
}
__device__ __forceinline__ void convert_layer_weights(const Params& p, int layer, LAS unsigned char* lds, int gw, int NGW, int wave, int lane) {
    LAS float* scr = (LAS float*)(lds + wave * 16384);
    unsigned char* ws = p.ws;
    bf16_t* WIN = (bf16_t*)(ws + WS_WIN);
    convert_matrix(p.in[10] + (size_t)layer * 1024 * D_IN, 1024, D_IN, WIN, 1024, 0, RowWin(), scr, lane, gw, NGW);
    for (int i = gw * 64 + lane; i < (NIN1 - IC_PAD) * 1024 / 8; i += NGW * 64) *(u32x4*)(WIN + (size_t)IC_PAD * 1024 + (size_t)i * 8) = (u32x4){0u, 0u, 0u, 0u};
    for (int j = 0; j < 3; ++j)
        convert_matrix(p.in[26 + j] + (size_t)layer * 512 * 1024, 512, 1024, (bf16_t*)(ws + WS_PRJ) + (size_t)j * 1024 * 512, 512, 0, RowId(), scr, lane, gw, NGW);
    convert_matrix(p.in[29] + (size_t)layer * 1024 * 1024, 1024, 1024, (bf16_t*)(ws + WS_WOUT), 1024, 0, RowId(), scr, lane, gw, NGW);
    bf16_t* LT = (bf16_t*)(ws + WS_LORA);
    lora_region(LT, p.in[15] + ((size_t)layer * 2 + 0) * 64 * 512, 0, 0, 64, gw, NGW, lane);
    lora_region(LT, p.in[15] + ((size_t)layer * 2 + 1) * 64 * 512, 512, 64, 64, gw, NGW, lane);
    lora_region(LT, p.in[17] + ((size_t)layer * 2 + 0) * 64 * 512, 1024, 128, 64, gw, NGW, lane);
    lora_region(LT, p.in[17] + ((size_t)layer * 2 + 1) * 64 * 512, 1536, 192, 64, gw, NGW, lane);
    lora_region(LT, p.in[18] + (size_t)layer * 128 * 512, 2048, 256, 128, gw, NGW, lane);
}
__device__ __forceinline__ void convert_ffn_weights(const Params& p, LAS unsigned char* lds, int gw, int NGW, int wave, int lane) {
    LAS float* scr = (LAS float*)(lds + wave * 16384);
    bf16_t* GU = (bf16_t*)(p.ws + WS_FGU); bf16_t* FD = (bf16_t*)(p.ws + WS_FD);
    convert_matrix(p.in[30], 1024, D_FF, GU, 1024, 0, RowGU{0}, scr, lane, gw, NGW);
    convert_matrix(p.in[31], 1024, D_FF, GU, 1024, 0, RowGU{1}, scr, lane, gw, NGW);
    convert_matrix(p.in[32], D_FF, 1024, FD, D_FF, 0, RowId(), scr, lane, gw, NGW);
}
__device__ __forceinline__ void convert_moe_weights(const Params& p, LAS unsigned char* lds, int gw, int NGW, int wave, int lane) {
    LAS float* scr = (LAS float*)(lds + wave * 16384);
    for (int e = 0; e < NEXP; ++e) {
        bf16_t* GU = (bf16_t*)(p.ws + WS_MGU) + (size_t)e * 7168 * 1024;
        convert_matrix(p.in[34] + (size_t)e * 1024 * D_FFE, 1024, D_FFE, GU, 1024, 0, RowGU{0}, scr, lane, gw, NGW);
        convert_matrix(p.in[35] + (size_t)e * 1024 * D_FFE, 1024, D_FFE, GU, 1024, 0, RowGU{1}, scr, lane, gw, NGW);
        convert_matrix(p.in[36] + (size_t)e * D_FFE * 1024, D_FFE, 1024, (bf16_t*)(p.ws + WS_MD) + (size_t)e * 1024 * D_FFE, D_FFE, 0, RowId(), scr, lane, gw, NGW);
    }
}

__device__ __forceinline__ void adaln_phase(const Params& p, LAS unsigned char* lds, int wave, int lane) {
    LAS float* red = (LAS float*)lds;
    float* MODS = (float*)(p.ws + WS_MODS);
    const float* c = p.in[1]; const float* cc = p.in[3];
    for (int it = blockIdx.x; it < 2 * 96; it += gridDim.x) {
        const int layer = it / 96, n = (it % 96) * 64 + lane;
        const float* W = p.in[4] + (size_t)layer * 1024 * 6144;
        float a0 = 0.f, a1 = 0.f, a2 = 0.f;
        for (int k = wave * 128; k < wave * 128 + 128; ++k) {
            const float w = W[(size_t)k * 6144 + n];
            a0 += siluf_(c[k]) * w; a1 += siluf_(c[1024 + k]) * w; a2 += siluf_(cc[k]) * w;
        }
        red[(wave * 3 + 0) * 64 + lane] = a0; red[(wave * 3 + 1) * 64 + lane] = a1; red[(wave * 3 + 2) * 64 + lane] = a2;
        __syncthreads();
        if (wave < 3) {
            float s = 0.f;
#pragma unroll
            for (int w = 0; w < 8; ++w) s += red[(w * 3 + wave) * 64 + lane];
            MODS[((size_t)layer * 3 + wave) * 6144 + n] = s + p.in[5][(size_t)layer * 6144 + n];
        }
        __syncthreads();
    }
    if (blockIdx.x == gridDim.x - 1) {
        float* rope = (float*)(p.ws + WS_ROPE);
        for (int i = threadIdx.x; i < 128 * 16; i += NTHREADS) {
            const int pos = i >> 4, j = i & 15;
            const float inv = powf(10000.0f, -(float)j / 16.0f);
            const float ang = (float)pos * inv;
            rope[2 * i] = cosf(ang); rope[2 * i + 1] = sinf(ang);
        }
    }
}

__device__ __forceinline__ const float* mods_row(const Params& p, int layer, int m) {
    const int r = m < NLAT ? (m >> 13) : 2;
    return (const float*)(p.ws + WS_MODS) + ((size_t)layer * 3 + r) * 6144;
}
__device__ __forceinline__ void load_row(const float* x, int lane, f32x4 (&v)[4]) {
#pragma unroll
    for (int j = 0; j < 4; ++j) v[j] = ((const f32x4*)x)[lane + 64 * j];
}
__device__ __forceinline__ float row_rstd(const f32x4 (&v)[4]) {
    float s = 0.f;
#pragma unroll
    for (int j = 0; j < 4; ++j) s += (v[j].x * v[j].x + v[j].y * v[j].y) + (v[j].z * v[j].z + v[j].w * v[j].w);
    return 1.0f / sqrtf(wave_sum(s) * (1.0f / 1024.0f) + 1e-6f);
}
__device__ __forceinline__ void normmod(const f32x4 (&h)[4], const float* g, const float* shift, const float* scale, int lane, f32x4 (&a)[4]) {
    const float rstd = row_rstd(h);
#pragma unroll
    for (int j = 0; j < 4; ++j) {
        const f32x4 gg = ((const f32x4*)g)[lane + 64 * j], sh = ((const f32x4*)shift)[lane + 64 * j], sc = ((const f32x4*)scale)[lane + 64 * j];
        a[j] = (h[j] * rstd * gg) * (sc + 1.0f) + sh;
    }
}
__device__ __forceinline__ void store_row_bf16(bf16_t* o, int lane, const f32x4 (&a)[4]) {
#pragma unroll
    for (int j = 0; j < 4; ++j) { u32x2 w; w.x = pk2(a[j].x, a[j].y); w.y = pk2(a[j].z, a[j].w); ((u32x2*)o)[lane + 64 * j] = w; }
}
__device__ __forceinline__ const float* h_in_row(const Params& p, int layer, int m) {
    if (layer == 0) return m < NLAT ? p.in[0] + (size_t)m * 1024 : p.in[2] + (size_t)(m - NLAT) * 1024;
    return m < NLAT ? p.out + (size_t)m * 1024 : (const float*)(p.ws + WS_HCTX) + (size_t)(m - NLAT) * 1024;
}
__device__ __forceinline__ float* h_out_row(const Params& p, int m) { return m < NLAT ? p.out + (size_t)m * 1024 : (float*)(p.ws + WS_HCTX) + (size_t)(m - NLAT) * 1024; }

__device__ __forceinline__ void premix_phase(const Params& p, int layer, bool first, int M, int gw, int NGW, int lane) {
    bf16_t* XN = (bf16_t*)(p.ws + WS_XN);
    for (int m = gw; m < M; m += NGW) {
        const float* hr = first ? h_in_row(p, 0, m) : h_out_row(p, m);
        f32x4 h[4], a[4]; load_row(hr, lane, h);
        const float* md = mods_row(p, layer, m);
        normmod(h, p.in[6] + layer * 1024, md, md + 1024, lane, a);
        store_row_bf16(XN + (size_t)m * 1024, lane, a);
    }
}
__device__ __forceinline__ void load_row_bf16(const bf16_t* x, int lane, f32x4 (&v)[4]) {
#pragma unroll
    for (int j = 0; j < 4; ++j) { const u32x2 w = ((const u32x2*)x)[lane + 64 * j]; v[j] = (f32x4){bflo(w.x), bfhi(w.x), bflo(w.y), bfhi(w.y)}; }
}
__device__ __forceinline__ void residual_phase(const Params& p, const bf16_t* src, const bf16_t* src2, const float* hin_base_layer0, bool hin_is_input, int layer, int gate_idx, const float* g1,
                                               bool write_xn, const float* g2, int mod_layer2, int shift_idx, bool route, int M, int gw, int NGW, int lane) {
    bf16_t* XN = (bf16_t*)(p.ws + (route ? WS_XN2 : WS_XN));
    for (int m = gw; m < M; m += NGW) {
        const float* hr = hin_is_input ? h_in_row(p, 0, m) : h_out_row(p, m);
        f32x4 h[4], s[4]; load_row(hr, lane, h); load_row_bf16(src + (size_t)m * 1024, lane, s);
        if (src2) { f32x4 s2[4]; load_row_bf16(src2 + (size_t)m * 1024, lane, s2);
#pragma unroll
            for (int j = 0; j < 4; ++j) s[j] += s2[j]; }
        const float rstd = row_rstd(s);
        const float* md = mods_row(p, layer, m);
#pragma unroll
        for (int j = 0; j < 4; ++j) {
            const f32x4 gg = ((const f32x4*)g1)[lane + 64 * j], gt = ((const f32x4*)(md + gate_idx * 1024))[lane + 64 * j];
            h[j] = h[j] + gt * (s[j] * rstd * gg);
        }
        float* ho = h_out_row(p, m);
#pragma unroll
        for (int j = 0; j < 4; ++j) ((f32x4*)ho)[lane + 64 * j] = h[j];
        if (write_xn) {
            f32x4 a[4]; const float* md2 = mods_row(p, mod_layer2, m);
            normmod(h, g2, md2 + shift_idx * 1024, md2 + (shift_idx + 1) * 1024, lane, a);
            store_row_bf16(XN + (size_t)m * 1024, lane, a);
            if (route) {
                const float* rw = p.in[33];
                float lg[8] = {0.f, 0.f, 0.f, 0.f, 0.f, 0.f, 0.f, 0.f};
#pragma unroll
                for (int j = 0; j < 4; ++j)
#pragma unroll
                    for (int q = 0; q < 4; ++q) {
                        const int k = 4 * (lane + 64 * j) + q; const float av = a[j][q];
                        const f32x4 w0 = ((const f32x4*)(rw + (size_t)k * 8))[0], w1 = ((const f32x4*)(rw + (size_t)k * 8))[1];
                        lg[0] += av * w0.x; lg[1] += av * w0.y; lg[2] += av * w0.z; lg[3] += av * w0.w; lg[4] += av * w1.x; lg[5] += av * w1.y; lg[6] += av * w1.z; lg[7] += av * w1.w;
                    }
#pragma unroll
                for (int e = 0; e < 8; ++e) lg[e] = wave_sum(lg[e]);
                int i1 = 0; float v1 = lg[0];
#pragma unroll
                for (int e = 1; e < 8; ++e) if (lg[e] > v1) { v1 = lg[e]; i1 = e; }
                int i2 = -1; float v2 = -3.0e38f;
#pragma unroll
                for (int e = 0; e < 8; ++e) if (e != i1 && lg[e] > v2) { v2 = lg[e]; i2 = e; }
                if (lane == 0) {
                    const float w1 = 1.0f / (1.0f + expf(v2 - v1)), w2 = 1.0f - w1;
                    unsigned* cnt = (unsigned*)(p.ws + WS_CTL) + CW_CNT; int* LIST = (int*)(p.ws + WS_LIST); float* WTS = (float*)(p.ws + WS_WTS);
                    const unsigned s1 = atomicAdd(cnt + i1, 1u); LIST[i1 * 16384 + s1] = m * 2; WTS[i1 * 16384 + s1] = w1;
                    const unsigned s2 = atomicAdd(cnt + i2, 1u); LIST[i2 * 16384 + s2] = m * 2 + 1; WTS[i2 * 16384 + s2] = w2;
                }
            }
        }
    }
}

using pg8::Unit;
constexpr float QSCALE = 0.125f * 1.4426950408889634f;
__device__ __forceinline__ u32x2 pack4(const f32x4 v) { u32x2 w; w.x = pk2(v.x, v.y); w.y = pk2(v.z, v.w); return w; }
__device__ __forceinline__ f32x4 unpack4(const u32x2 w) { return (f32x4){bflo(w.x), bfhi(w.x), bflo(w.y), bfhi(w.y)}; }

struct EpiIn {
    static constexpr bool PERM = false, AFTER_DRAIN = false;
    bf16_t* P; bf16_t* VTS; bf16_t* VTD; const float* rope;
    __device__ __forceinline__ void operator()(const f32x4 (&acc)[2][2][4][2], const Unit& u, int wr, int wc, int fr, int fq) const {
#pragma unroll
        for (int ai = 0; ai < 2; ++ai)
#pragma unroll
            for (int m = 0; m < 4; ++m) {
                const int r = u.pm * 256 + ai * 128 + wr * 64 + m * 16 + fr;
                const bool lat = r < NLAT;
                const int t = r & (SEQ - 1);
                const int b = lat ? (r >> 13) : ((r - NLAT) >> 8);
                const int key = lat ? t : SEQ + ((r - NLAT) & 255);
#pragma unroll
                for (int bj = 0; bj < 2; ++bj) {
                    const int c32 = u.pn * 256 + bj * 128 + wc * 32;
                    f32x4 v0 = acc[ai][bj][m][0], v1 = acc[ai][bj][m][1];
                    if (c32 < PP) {
                        const bool rp = (c32 < IC_RW) || (c32 >= IC_QD);
                        if (rp && lat) {
                            const int pos = (c32 & 32) ? (t & 63) : (t >> 6);
                            const f32x4 cs0 = *(const f32x4*)(rope + (pos * 16 + 4 * fq) * 2), cs1 = *(const f32x4*)(rope + (pos * 16 + 4 * fq) * 2 + 4);
                            const f32x4 cc = (f32x4){cs0.x, cs0.z, cs1.x, cs1.z}, sn = (f32x4){cs0.y, cs0.w, cs1.y, cs1.w};
                            const f32x4 o0 = v0 * cc - v1 * sn, o1 = v0 * sn + v1 * cc;
                            v0 = o0; v1 = o1;
                        }
                        if (c32 < IC_KS || (c32 >= IC_QD && c32 < IC_KD)) { v0 = v0 * QSCALE; v1 = v1 * QSCALE; }
                        bf16_t* dst = P + (size_t)r * PP + c32 + 4 * fq;
                        *(u32x2*)dst = pack4(v0); *(u32x2*)(dst + 16) = pack4(v1);
                    } else {
                        const int cv = c32 - PP;
                        bf16_t* vt = nullptr; int dimbase = 0;
                        if (cv < 128) { vt = VTS + (size_t)((b * 2 + (cv >> 6)) * 64) * KEYS; dimbase = cv & 63; }
                        else if (cv < 640) { const int cd = cv - 128; vt = VTD + (size_t)((b * 4 + (cd >> 7)) * 128) * KEYS; dimbase = cd & 127; }
                        if (vt) {
#pragma unroll
                            for (int i = 0; i < 4; ++i) {
                                vt[(size_t)(dimbase + 4 * fq + i) * KEYS + key] = (bf16_t)f2bf(v0[i]);
                                vt[(size_t)(dimbase + 16 + 4 * fq + i) * KEYS + key] = (bf16_t)f2bf(v1[i]);
                            }
                        }
                    }
                }
            }
    }
};

struct EpiLora {
    static constexpr bool PERM = false, AFTER_DRAIN = false;
    float* ST; bf16_t* P; const float* w0; const float* a0;
    __device__ __forceinline__ void operator()(const f32x4 (&acc)[2][2][4][2], const Unit& u, int wr, int wc, int fr, int fq) const {
        const int reg = u.pn >> 1;
#pragma unroll
        for (int ai = 0; ai < 2; ++ai)
#pragma unroll
            for (int m = 0; m < 4; ++m) {
                const int r = u.pm * 256 + ai * 128 + wr * 64 + m * 16 + fr;
#pragma unroll
                for (int bj = 0; bj < 2; ++bj)
#pragma unroll
                    for (int n = 0; n < 2; ++n) {
                        const int ch = (u.pn & 1) * 256 + bj * 128 + wc * 32 + 16 * n + 4 * fq;
                        const int h = ch >> 6, kidx = ch & 63;
                        float* sp = ST + ((size_t)r * 8 + h) * (ST_SLOTS * 64) + kidx;
                        const f32x4 a = acc[ai][bj][m][n];
                        if (reg < 2) {
                            const f32x4 bias = *(const f32x4*)(w0 + reg * 512 + ch);
                            f32x4 o;
#pragma unroll
                            for (int i = 0; i < 4; ++i) {
                                const float x = -(bias[i] + a[i]);
                                const float sp_ = fmaxf(x, 0.f) + __logf(1.0f + __expf(-fabsf(x)));
                                o[i] = __expf(-__expf(-sp_ - 0.5f));
                            }
                            *(f32x4*)(sp + (4 + 2 * reg) * 64) = o;
                        } else if (reg < 4) {
                            const int d = reg - 2;
                            const f32x4 bias = *(const f32x4*)(a0 + d * 512 + ch);
                            *(f32x4*)(sp + (5 + 2 * d) * 64) = (f32x4){sigmoidf_(bias[0] + a[0]), sigmoidf_(bias[1] + a[1]), sigmoidf_(bias[2] + a[2]), sigmoidf_(bias[3] + a[3])};
                        } else {
                            *(u32x2*)(P + (size_t)r * PP + IC_RW + ch) = pack4(a);
                        }
                        asm volatile("" ::: "memory");
                    }
            }
    }
};

struct LoraSched {
    pg8::StaticOrder S;
    __device__ __forceinline__ bool next(int i, Unit& u) const { if (!S.next(i, u)) return false; const int reg = u.pn >> 1; u.koff = 128 * (reg < 4 ? (reg >> 1) : 2); return true; }
    __device__ __forceinline__ void a_ready(const Unit&) const {}
    __device__ __forceinline__ void done(const Unit&) const {}
};
struct EpiGate {
    static constexpr bool PERM = true, AFTER_DRAIN = false;
    bf16_t* G;
    __device__ __forceinline__ void operator()(const f32x4 (&acc)[2][2][4][2], const Unit& u, int wr, int wc, int fr, int fq) const {
#pragma unroll
        for (int ai = 0; ai < 2; ++ai)
#pragma unroll
            for (int m = 0; m < 4; ++m) {
                const int r = u.pm * 256 + ai * 128 + wr * 64 + m * 16 + fr;
#pragma unroll
                for (int bj = 0; bj < 2; ++bj) {
                    const int c = u.pn * 256 + bj * 128 + wc * 32 + 8 * fq;
                    const f32x4 a0 = acc[ai][bj][m][0], a1 = acc[ai][bj][m][1];
                    u32x4 w; w.x = pk2(sigmoidf_(a0.x), sigmoidf_(a0.y)); w.y = pk2(sigmoidf_(a0.z), sigmoidf_(a0.w)); w.z = pk2(sigmoidf_(a1.x), sigmoidf_(a1.y)); w.w = pk2(sigmoidf_(a1.z), sigmoidf_(a1.w));
                    *(u32x4*)(G + (size_t)r * 3072 + c) = w;
                }
            }
    }
};

template <int PASS> struct EpiMerge {
    static constexpr bool PERM = false, AFTER_DRAIN = false;
    const bf16_t* G; bf16_t* MF; bf16_t* MB;
    __device__ __forceinline__ void operator()(const f32x4 (&acc)[2][2][4][2], const Unit& u, int wr, int wc, int fr, int fq) const {
#pragma unroll
        for (int ai = 0; ai < 2; ++ai)
#pragma unroll
            for (int m = 0; m < 4; ++m) {
                const int r = u.pm * 256 + ai * 128 + wr * 64 + m * 16 + fr;
#pragma unroll
                for (int bj = 0; bj < 2; ++bj)
#pragma unroll
                    for (int n = 0; n < 2; ++n) {
                        const int c = u.pn * 256 + bj * 128 + wc * 32 + 16 * n + 4 * fq;
                        const f32x4 g = unpack4(*(const u32x2*)(G + (size_t)r * 3072 + PASS * 1024 + c));
                        f32x4 v = g * acc[ai][bj][m][n];
                        bf16_t* mp = MF + (size_t)r * 1024 + c;
                        if (PASS > 0) v += unpack4(*(const u32x2*)mp);
                        *(u32x2*)(PASS < 2 ? mp : MB + (size_t)r * 1024 + c) = pack4(v);
                    }
            }
    }
};

struct EpiBf {
    static constexpr bool PERM = true, AFTER_DRAIN = false;
    bf16_t* O; int ldc;
    __device__ __forceinline__ void operator()(const f32x4 (&acc)[2][2][4][2], const Unit& u, int wr, int wc, int fr, int fq) const {
#pragma unroll
        for (int ai = 0; ai < 2; ++ai)
#pragma unroll
            for (int m = 0; m < 4; ++m) {
                const int r = u.pm * 256 + ai * 128 + wr * 64 + m * 16 + fr;
#pragma unroll
                for (int bj = 0; bj < 2; ++bj) {
                    const int c = u.pn * 256 + bj * 128 + wc * 32 + 8 * fq;
                    const f32x4 a0 = acc[ai][bj][m][0], a1 = acc[ai][bj][m][1];
                    u32x4 w; w.x = pk2(a0.x, a0.y); w.y = pk2(a0.z, a0.w); w.z = pk2(a1.x, a1.y); w.w = pk2(a1.z, a1.w);
                    *(u32x4*)(O + (size_t)r * ldc + c) = w;
                }
            }
    }
};

struct EpiSwiglu {
    static constexpr bool PERM = true, AFTER_DRAIN = false;
    bf16_t* H; int ldh; int npn; int pm_sub;
    __device__ __forceinline__ void operator()(const f32x4 (&acc)[2][2][4][2], const Unit& u, int wr, int wc, int fr, int fq) const {
        const int pnn = u.pn % npn;
#pragma unroll
        for (int ai = 0; ai < 2; ++ai)
#pragma unroll
            for (int m = 0; m < 4; ++m) {
                const int r = (u.pm - pm_sub) * 256 + ai * 128 + wr * 64 + m * 16 + fr;
                const int hc = pnn * 128 + wc * 32 + 8 * fq;
                const f32x4 g0 = acc[ai][0][m][0], g1 = acc[ai][0][m][1], u0 = acc[ai][1][m][0], u1 = acc[ai][1][m][1];
                u32x4 w; w.x = pk2(siluf_(g0.x) * u0.x, siluf_(g0.y) * u0.y); w.y = pk2(siluf_(g0.z) * u0.z, siluf_(g0.w) * u0.w);
                w.z = pk2(siluf_(g1.x) * u1.x, siluf_(g1.y) * u1.y); w.w = pk2(siluf_(g1.z) * u1.z, siluf_(g1.w) * u1.w);
                *(u32x4*)(H + (size_t)r * ldh + hc) = w;
            }
    }
};

struct MoeSched {
    int ts[9]; int pm_lo, pm_hi, npn, G, c; bool a_local;
    __device__ __forceinline__ int expert_of(int pm) const { int e = 0;
#pragma unroll
        for (int q = 1; q < 8; ++q) e += (pm >= ts[q]) ? 1 : 0;
        return e; }
    __device__ __forceinline__ bool next(int i, Unit& u) const {
        const int n = (pm_hi - pm_lo) * npn; const long L = (long)i * G + c; if (L >= n) return false;
        const int pm = pm_lo + (int)L / npn, pnn = (int)L % npn;
        u.pm = a_local ? pm - pm_lo : pm; u.pn = expert_of(pm) * npn + pnn; u.koff = 0; u.tail = -1; return true;
    }
    __device__ __forceinline__ void a_ready(const Unit&) const {}
    __device__ __forceinline__ void done(const Unit&) const {}
};
struct EpiMoeDown {
    static constexpr bool PERM = false, AFTER_DRAIN = false;
    bf16_t* FS; long slot1_off; const int* LIST; const float* WTS; const unsigned* cnt; int ts[9]; int pm_lo;
    __device__ __forceinline__ void operator()(const f32x4 (&acc)[2][2][4][2], const Unit& u, int wr, int wc, int fr, int fq) const {
        const int e = u.pn >> 2, pnn = u.pn & 3, pmg = u.pm + pm_lo;
        int tse = 0;
#pragma unroll
        for (int q = 0; q < 8; ++q) tse = (q == e) ? ts[q] : tse;
        const int ne = (int)cnt[e];
#pragma unroll
        for (int ai = 0; ai < 2; ++ai)
#pragma unroll
            for (int m = 0; m < 4; ++m) {
                const int slot = (pmg - tse) * 256 + ai * 128 + wr * 64 + m * 16 + fr;
                if (slot < ne) {
                    const int tk = LIST[e * 16384 + slot]; const float w = WTS[e * 16384 + slot];
                    bf16_t* dst = FS + (long)(tk & 1) * slot1_off + (size_t)(tk >> 1) * 1024 + pnn * 256 + wc * 32 + 4 * fq;
#pragma unroll
                    for (int bj = 0; bj < 2; ++bj)
#pragma unroll
                        for (int n = 0; n < 2; ++n) *(u32x2*)(dst + bj * 128 + 16 * n) = pack4(acc[ai][bj][m][n] * w);
                }
            }
    }
};

constexpr float SC2 = 0.125f * 1.4426950408889634f;
constexpr int ATT_ROW = 144, ATT_VOFF = 9216, ATT_BUF = 27648;
constexpr float ATT_THR = 6.0f;
__device__ __forceinline__ float xhalf_max(float v) { auto rr = __builtin_amdgcn_permlane32_swap(__float_as_uint(v), __float_as_uint(v), false, false); return fmaxf(__uint_as_float(rr[0]), __uint_as_float(rr[1])); }
__device__ __forceinline__ float xhalf_sum(float v) { auto rr = __builtin_amdgcn_permlane32_swap(__float_as_uint(v), __float_as_uint(v), false, false); return __uint_as_float(rr[0]) + __uint_as_float(rr[1]); }

template <int DV, bool WINDOW>
__device__ __forceinline__ void attn_pass(LAS unsigned char* lds, const bf16_t* __restrict__ P, int qrow0, int qcol, int kcol, const bf16_t* __restrict__ VT,
                                          int lat_row0, int ctx_row0, int tile_lo, int tile_hi, bool has_ref, float m0, float l0, int qpos0,
                                          f32x16 (&o)[DV / 32], float& l_out, int wave, int lane) {
    int tid_ = threadIdx.x; asm volatile("" : "+v"(tid_)); const int tid = tid_; lane = tid & 63; const int qn = lane & 31, half = lane >> 5;
    bf16x8 qf[4];
    { const bf16_t* qp = P + (size_t)(qrow0 + wave * 32 + qn) * PP + qcol + half * 8;
#pragma unroll
      for (int ks = 0; ks < 4; ++ks) qf[ks] = *(const bf16x8*)(qp + ks * 16); }
    float mrun = has_ref ? m0 : 0.f, lrun = (half == 0) ? l0 : 0.f;
    bool need_ref = !has_ref;
    f32x16 negm;
#pragma unroll
    for (int i = 0; i < 16; ++i) negm[i] = -mrun;
#pragma unroll
    for (int db = 0; db < DV / 32; ++db)
#pragma unroll
        for (int i = 0; i < 16; ++i) o[db][i] = 0.f;
    const int nlat = tile_hi - tile_lo, nt = nlat + 4;
    u32x4 kreg[1], vreg[1][DV / 64];
    const int skey = tid >> 3, spc = tid & 7;
#define ATT_LOAD(ti_, set_) do { const int id_ = (ti_) < nlat ? tile_lo + (ti_) : 128 + ((ti_) - nlat); \
        const int krow0_ = id_ < 128 ? lat_row0 + 64 * id_ : ctx_row0 + 64 * (id_ - 128); \
        kreg[set_] = *(const u32x4*)(P + (size_t)(krow0_ + skey) * PP + kcol + spc * 8); \
        _Pragma("unroll") for (int j_ = 0; j_ < DV / 64; ++j_) { const int idx_ = tid + 512 * j_; vreg[set_][j_] = *(const u32x4*)(VT + (size_t)(idx_ >> 3) * KEYS + 64 * id_ + (idx_ & 7) * 8); } } while (0)
#define ATT_STORE(buf_, set_) do { LAS unsigned char* b_ = lds + (buf_) * ATT_BUF; *(LAS u32x4*)(b_ + skey * ATT_ROW + spc * 16) = kreg[set_]; \
        _Pragma("unroll") for (int j_ = 0; j_ < DV / 64; ++j_) { const int idx_ = tid + 512 * j_, dim_ = idx_ >> 3; *(LAS u32x4*)(b_ + ATT_VOFF + dim_ * ATT_ROW + (((idx_ & 7) ^ ((dim_ >> 4) & 1)) * 16)) = vreg[set_][j_]; } } while (0)
    __syncthreads();
    ATT_LOAD(0, 0); ATT_STORE(0, 0);
    if (nt > 1) ATT_LOAD(1, 0);
    __syncthreads();
    for (int ti0 = 0; ti0 < nt; ti0 += 1) {
#pragma unroll
      for (int dd = 0; dd < 1; ++dd) {
        const int ti = ti0 + dd;
        if (ti < nt) {
        const LAS unsigned char* Ks = lds + (ti & 1) * ATT_BUF; const LAS unsigned char* Vs = Ks + ATT_VOFF;
        const int id = ti < nlat ? tile_lo + ti : 128 + (ti - nlat);
        const bool islat = id < 128;
        bool skip = false;
        if (WINDOW && islat) { const int qw = qpos0 + wave * 32; skip = (64 * id + 63 < qw - 128 || 64 * id > qw + 31 + 128); }
        if (!skip) {
        f32x16 s[2];
#pragma unroll
        for (int mb = 0; mb < 2; ++mb) {
#pragma unroll
            for (int ks = 0; ks < 4; ++ks) {
                const bf16x8 kf = *(const LAS bf16x8*)(Ks + (32 * mb + qn) * ATT_ROW + ks * 32 + half * 16);
                if (ks == 0) s[mb] = __builtin_amdgcn_mfma_f32_32x32x16_bf16(kf, qf[0], negm, 0, 0, 0);
                else s[mb] = __builtin_amdgcn_mfma_f32_32x32x16_bf16(kf, qf[ks], s[mb], 0, 0, 0);
            }
        }
        if (WINDOW && islat) {
            const int qpos = qpos0 + wave * 32 + qn;
#pragma unroll
            for (int mb = 0; mb < 2; ++mb)
#pragma unroll
                for (int i = 0; i < 16; ++i) { const int d = 64 * id + 32 * mb + 8 * (i >> 2) + 4 * half + (i & 3) - qpos; if (d > 128 || d < -128) s[mb][i] = -INFINITY; }
        }
        float mx = s[0][0];
#pragma unroll
        for (int mb = 0; mb < 2; ++mb)
#pragma unroll
            for (int i = 0; i < 16; ++i) mx = fmaxf(mx, s[mb][i]);
        mx = xhalf_max(mx);
        if (__builtin_expect(need_ref || __any(mx > ATT_THR), 0)) {
            const float delta = need_ref ? mx : fmaxf(mx, 0.f);
            if (!need_ref) {
                const float alpha = __builtin_amdgcn_exp2f(-delta);
                lrun *= alpha;
#pragma unroll
                for (int db = 0; db < DV / 32; ++db)
#pragma unroll
                    for (int i = 0; i < 16; ++i) o[db][i] *= alpha;
            }
            mrun += delta; need_ref = false;
#pragma unroll
            for (int mb = 0; mb < 2; ++mb)
#pragma unroll
                for (int i = 0; i < 16; ++i) s[mb][i] -= delta;
#pragma unroll
            for (int i = 0; i < 16; ++i) negm[i] = -mrun;
        }
        float rs = 0.f;
#pragma unroll
        for (int mb = 0; mb < 2; ++mb)
#pragma unroll
            for (int i = 0; i < 16; ++i) { const float pv = __builtin_amdgcn_exp2f(s[mb][i]); s[mb][i] = pv; rs += pv; }
        lrun += rs;
#pragma unroll
        for (int g = 0; g < 4; ++g) {
            const int mb = g >> 1, bs = 8 * (g & 1);
            u32x4 pw; pw.x = pk2(s[mb][bs + 0], s[mb][bs + 1]); pw.y = pk2(s[mb][bs + 2], s[mb][bs + 3]); pw.z = pk2(s[mb][bs + 4], s[mb][bs + 5]); pw.w = pk2(s[mb][bs + 6], s[mb][bs + 7]);
            const bf16x8 pf = __builtin_bit_cast(bf16x8, pw);
#pragma unroll
            for (int db = 0; db < DV / 32; ++db) {
                const int dim = 32 * db + qn, sw = (dim >> 4) & 1;
                const LAS unsigned char* vrow = Vs + dim * ATT_ROW + 8 * half;
                const u32x2 lo = *(const LAS u32x2*)(vrow + (((2 * g) ^ sw) * 16)), hi = *(const LAS u32x2*)(vrow + (((2 * g + 1) ^ sw) * 16));
                const u32x4 vw = (u32x4){lo.x, lo.y, hi.x, hi.y};
                o[db] = __builtin_amdgcn_mfma_f32_32x32x16_bf16(__builtin_bit_cast(bf16x8, vw), pf, o[db], 0, 0, 0);
            }
        }
        }
        if (ti + 1 < nt) { ATT_STORE((ti + 1) & 1, 0); if (ti + 2 < nt) ATT_LOAD(ti + 2, 0); }
        __syncthreads();
        }
      }
    }
#undef ATT_LOAD
#undef ATT_STORE
    l_out = xhalf_sum(lrun);
}

__device__ __forceinline__ void swa_unit(LAS unsigned char* lds, const Params& p, int layer, int b, int hq, int qb, bool ctx, int wave, int lane, bool dry = false) {
    bf16_t* P = (bf16_t*)(p.ws + WS_P);
    const int kvh = hq >> 2;
    const bf16_t* VT = (const bf16_t*)(p.ws + WS_VTS) + (size_t)((b * 2 + kvh) * 64) * KEYS;
    const float sink2 = p.in[11][layer * 8 + hq] * 1.4426950408889634f;
    const int qrow0 = ctx ? NLAT + b * CTXL : b * SEQ + qb * 256;
    f32x16 o[2]; float l;
    if (ctx) attn_pass<64, false>(lds, P, qrow0, IC_QS + hq * 64, IC_KS + kvh * 64, VT, b * SEQ, NLAT + b * CTXL, 0, 0, true, sink2, 1.0f, 0, o, l, wave, lane);
    else {
        int lo = 4 * qb - 2; if (lo < 0) lo = 0; int hi = 4 * qb + 6; if (hi > 128) hi = 128;
        attn_pass<64, true>(lds, P, qrow0, IC_QS + hq * 64, IC_KS + kvh * 64, VT, b * SEQ, NLAT + b * CTXL, lo, hi, true, sink2, 1.0f, qb * 256, o, l, wave, lane);
    }
    const float inv = 1.0f / l; const int qn = lane & 31, half = lane >> 5;
    bf16_t* dst = P + (size_t)(qrow0 + wave * 32 + qn) * PP + IC_QS + hq * 64 + 4 * half;
#pragma unroll
    for (int db = 0; db < 2; ++db)
#pragma unroll
        for (int q4 = 0; q4 < 4; ++q4) {
            const f32x4 v = (f32x4){o[db][4 * q4] * inv, o[db][4 * q4 + 1] * inv, o[db][4 * q4 + 2] * inv, o[db][4 * q4 + 3] * inv};
            if (!dry) *(u32x2*)(dst + 32 * db + 8 * q4) = pack4(v);
        }
}
__device__ __forceinline__ void diff_unit(LAS unsigned char* lds, const Params& p, float lam, int b, int h, int qb, bool ctx, int wave, int lane, bool dry = false) {
    bf16_t* P = (bf16_t*)(p.ws + WS_P);
    const bf16_t* VT = (const bf16_t*)(p.ws + WS_VTD) + (size_t)((b * 4 + h) * 128) * KEYS;
    const int qrow0 = ctx ? NLAT + b * CTXL : b * SEQ + qb * 256;
    const int thi = ctx ? 0 : 128;
    LAS unsigned* park = (LAS unsigned*)(lds + 73728) + threadIdx.x;
    f32x16 o[4]; float l;
    attn_pass<128, false>(lds, P, qrow0, IC_QD + h * 128, IC_KD + h * 128, VT, b * SEQ, NLAT + b * CTXL, 0, thi, false, 0.f, 0.f, 0, o, l, wave, lane);
    { const float inv = 1.0f / l;
#pragma unroll
      for (int db = 0; db < 4; ++db)
#pragma unroll
          for (int i = 0; i < 8; ++i) park[(db * 8 + i) * 512] = pk2(o[db][2 * i] * inv, o[db][2 * i + 1] * inv); }
    attn_pass<128, false>(lds, P, qrow0, IC_QD + h * 128 + 64, IC_KD + h * 128 + 64, VT, b * SEQ, NLAT + b * CTXL, 0, thi, false, 0.f, 0.f, 0, o, l, wave, lane);
    const float inv = lam / l; const int qn = lane & 31, half = lane >> 5;
    bf16_t* dst = P + (size_t)(qrow0 + wave * 32 + qn) * PP + IC_QD + h * 128 + 4 * half;
#pragma unroll
    for (int db = 0; db < 4; ++db)
#pragma unroll
        for (int q4 = 0; q4 < 4; ++q4) {
            const unsigned pa = park[(db * 8 + 2 * q4) * 512], pb = park[(db * 8 + 2 * q4 + 1) * 512];
            const f32x4 v = (f32x4){bflo(pa) - o[db][4 * q4] * inv, bfhi(pa) - o[db][4 * q4 + 1] * inv, bflo(pb) - o[db][4 * q4 + 2] * inv, bfhi(pb) - o[db][4 * q4 + 3] * inv};
            if (!dry) *(u32x2*)(dst + 32 * db + 8 * q4) = pack4(v);
        }
}

__device__ __forceinline__ void ld8bf(const bf16_t* p, float (&v)[8]) { const u32x4 w = *(const u32x4*)p; v[0] = bflo(w.x); v[1] = bfhi(w.x); v[2] = bflo(w.y); v[3] = bfhi(w.y); v[4] = bflo(w.z); v[5] = bfhi(w.z); v[6] = bflo(w.w); v[7] = bfhi(w.w); }
__device__ __forceinline__ void ld8f(const float* p, float (&v)[8]) { const f32x4 a = ((const f32x4*)p)[0], b = ((const f32x4*)p)[1]; v[0] = a.x; v[1] = a.y; v[2] = a.z; v[3] = a.w; v[4] = b.x; v[5] = b.y; v[6] = b.z; v[7] = b.w; }
__device__ __forceinline__ void st8f(float* p, const float (&v)[8]) { ((f32x4*)p)[0] = (f32x4){v[0], v[1], v[2], v[3]}; ((f32x4*)p)[1] = (f32x4){v[4], v[5], v[6], v[7]}; }

__device__ __forceinline__ void rwkv_prepare_phase(const Params& p, int layer, int gw, int NGW, int lane) {
    const bf16_t* P = (const bf16_t*)(p.ws + WS_P); float* ST = (float*)(p.ws + WS_ST); bf16_t* A2 = (bf16_t*)(p.ws + WS_YA);
    const float* mup = p.in[12] + layer * 1920; const float* mun = p.in[13] + layer * 1920; const float* k_k = p.in[19] + layer * 512;
    for (int m = gw; m < NTOK; m += NGW) {
        const int t = m < NLAT ? (m & (SEQ - 1)) : ((m - NLAT) & (CTXL - 1)), len = m < NLAT ? SEQ : CTXL;
        const bool hp = t > 0, hn = t < len - 1;
        const bf16_t* pr = P + (size_t)m * PP + IC_RW;
        const int h = lane >> 3, kidx = (lane & 7) * 8;
        float* sp = ST + ((size_t)m * 8 + h) * (ST_SLOTS * 64) + kidx;
#pragma unroll
        for (int sec = 0; sec < 4; ++sec) {
            if (sec == 3 && lane >= 48) break;
            const int col = sec < 3 ? sec * 512 + lane * 8 : 1536 + lane * 8;
            float c[8], pv[8], nx[8], a[8], bb[8], sh[8];
            ld8bf(pr + col, c);
            if (hp) ld8bf(pr - PP + col, pv); else {
#pragma unroll
                for (int q = 0; q < 8; ++q) pv[q] = 0.f; }
            if (hn) ld8bf(pr + PP + col, nx); else {
#pragma unroll
                for (int q = 0; q < 8; ++q) nx[q] = 0.f; }
            ld8f(mup + col, a); ld8f(mun + col, bb);
#pragma unroll
            for (int q = 0; q < 8; ++q) sh[q] = c[q] + a[q] * (pv[q] - c[q]) + bb[q] * (nx[q] - c[q]);
            if (sec == 0) st8f(sp + 1 * 64, sh);
            else if (sec == 2) st8f(sp + 2 * 64, sh);
            else if (sec == 1) {
                st8f(sp + 3 * 64, sh);
                float kk[8], kkw[8]; ld8f(k_k + lane * 8, kkw);
                float ss = 0.f;
#pragma unroll
                for (int q = 0; q < 8; ++q) { kk[q] = sh[q] * kkw[q]; ss += kk[q] * kk[q]; }
                ss += __shfl_xor(ss, 1); ss += __shfl_xor(ss, 2); ss += __shfl_xor(ss, 4);
                const float inv = 1.0f / fmaxf(sqrtf(ss), 1e-12f);
#pragma unroll
                for (int q = 0; q < 8; ++q) kk[q] *= inv;
                st8f(sp, kk);
            } else {
                float o[8];
#pragma unroll
                for (int q = 0; q < 8; ++q) o[q] = lane < 16 ? tanhf(sh[q]) : (lane < 32 ? sh[q] : sigmoidf_(sh[q]));
                u32x4 w; w.x = pk2(o[0], o[1]); w.y = pk2(o[2], o[3]); w.z = pk2(o[4], o[5]); w.w = pk2(o[6], o[7]);
                *(u32x4*)(A2 + (size_t)m * 384 + lane * 8) = w;
            }
        }
    }
}

constexpr int NSEG = 64, SEGL = KEYS / NSEG;
static_assert(SEGL * NSEG == KEYS && SEGL % 4 == 0, "segments");
constexpr size_t WS_GH = WS_YA;
static_assert(WS_GH + 32ull * NSEG * 2 * 4096 * 4 <= 560 * MiB, "GH fits behind the stream");
__device__ __forceinline__ int scan_token(int b, int dir, int s) {
    if (s < CTXL) return NLAT + b * CTXL + (dir ? CTXL - 1 - s : s);
    const int t = s - CTXL; return b * SEQ + (dir ? SEQ - 1 - t : t);
}
constexpr int SRING = 6, SREC = ST_SLOTS * 64 * 4;
constexpr int SCAN_LDS = SRING * SREC;
__device__ __forceinline__ void scan_dma(const float* rec, LAS unsigned char* slot, int lane) {
    const float* q = rec + lane * 4;
    __builtin_amdgcn_global_load_lds((const unsigned*)q, (LAS unsigned*)slot, 16, 0, 0);
    __builtin_amdgcn_global_load_lds((const unsigned*)(q + 256), (LAS unsigned*)(slot + 1024), 16, 0, 0);
}
template <int MODE>
__device__ __forceinline__ void rwkv_segment(const Params& p, int layer, int sid, int seg, int lane, LAS unsigned char* ring) {
    const int b = sid >> 4, h = (sid >> 1) & 7, dir = sid & 1, c = lane & 31, hf = lane >> 5;
    const float ka0 = p.in[20][layer * 512 + h * 64 + c], ka1 = p.in[20][layer * 512 + h * 64 + 32 + c];
    const float rk0 = MODE == 2 ? p.in[21][layer * 512 + h * 64 + c] : 0.f, rk1 = MODE == 2 ? p.in[21][layer * 512 + h * 64 + 32 + c] : 0.f;
    const float* ST = (const float*)(p.ws + WS_ST);
    float* gh = (float*)(p.ws + WS_GH) + ((size_t)sid * NSEG + seg) * 2 * 4096;
    f32x16 TH[2][2], TG[MODE == 0 ? 2 : 1][2];
#pragma unroll
    for (int kb = 0; kb < 2; ++kb)
#pragma unroll
        for (int vb = 0; vb < 2; ++vb) {
            if (MODE == 2 && seg > 0) {
                const float* src = gh - 4096 + (32 * vb + c) * 64 + 32 * kb + 4 * hf;
#pragma unroll
                for (int q = 0; q < 4; ++q) { const f32x4 t = *(const f32x4*)(src + 8 * q); TH[kb][vb][4 * q] = t.x; TH[kb][vb][4 * q + 1] = t.y; TH[kb][vb][4 * q + 2] = t.z; TH[kb][vb][4 * q + 3] = t.w; }
            } else {
#pragma unroll
                for (int r = 0; r < 16; ++r) TH[kb][vb][r] = 0.f;
            }
            if (MODE == 0) {
#pragma unroll
                for (int r = 0; r < 16; ++r) TG[MODE == 0 ? kb : 0][vb][r] = (32 * kb + 8 * (r >> 2) + 4 * hf + (r & 3) == 32 * vb + c) ? 1.0f : 0.0f;
            }
        }
    const int s0 = seg * SEGL, s_end = s0 + SEGL, od = (4 + 2 * dir) * 256;
#pragma unroll 1
    for (int j = 0; j < SRING - 1; ++j) scan_dma(ST + ((size_t)scan_token(b, dir, s0 + j) * 8 + h) * (ST_SLOTS * 64), ring + j * SREC, lane);
    int slot_i = 0;
#pragma unroll 1
    for (int s = s0; s < s_end; ++s) {
        if (s + SRING - 1 < s_end) {
            int nslot = slot_i + SRING - 1; if (nslot >= SRING) nslot -= SRING;
            scan_dma(ST + ((size_t)scan_token(b, dir, s + SRING - 1) * 8 + h) * (ST_SLOTS * 64), ring + nslot * SREC, lane);
            asm volatile("s_waitcnt vmcnt(10)" ::: "memory");
        } else asm volatile("s_waitcnt vmcnt(0)" ::: "memory");
        const LAS unsigned char* rec = ring + slot_i * SREC;
        slot_i = slot_i + 1 == SRING ? 0 : slot_i + 1;
        float ph[2] = {0.f, 0.f}, pg[2] = {0.f, 0.f};
#pragma unroll
        for (int kb = 0; kb < 2; ++kb)
#pragma unroll
            for (int q = 0; q < 4; ++q) {
                const f32x4 a4 = *(const LAS f32x4*)(rec + (32 * kb + 8 * q + 4 * hf) * 4);
#pragma unroll
                for (int j = 0; j < 4; ++j)
#pragma unroll
                    for (int vb = 0; vb < 2; ++vb) { ph[vb] = fmaf(TH[kb][vb][4 * q + j], a4[j], ph[vb]); if (MODE == 0) pg[vb] = fmaf(TG[MODE == 0 ? kb : 0][vb][4 * q + j], a4[j], pg[vb]); }
            }
        float sa[2], sg[2];
#pragma unroll
        for (int vb = 0; vb < 2; ++vb) { sa[vb] = xhalf_sum(ph[vb]); sg[vb] = MODE == 0 ? xhalf_sum(pg[vb]) : 0.f; }
#pragma unroll
        for (int kb = 0; kb < 2; ++kb)
#pragma unroll
            for (int q = 0; q < 4; ++q) {
                const f32x4 w4 = *(const LAS f32x4*)(rec + od + (32 * kb + 8 * q + 4 * hf) * 4);
#pragma unroll
                for (int j = 0; j < 4; ++j)
#pragma unroll
                    for (int vb = 0; vb < 2; ++vb) { TH[kb][vb][4 * q + j] *= w4[j]; if (MODE == 0) TG[MODE == 0 ? kb : 0][vb][4 * q + j] *= w4[j]; }
            }
        float aop[2], bop[2], bopg[2];
#pragma unroll
        for (int kb = 0; kb < 2; ++kb) {
            const float ag = *(const LAS float*)(rec + od + 256 + (32 * kb + c) * 4), x = *(const LAS float*)(rec + (hf ? 768 : 0) + (32 * kb + c) * 4);
            aop[kb] = x * (hf ? fmaf(ag - 1.0f, kb ? ka1 : ka0, 1.0f) : -ag);
        }
        float bonus = 0.f;
        if (MODE == 2) {
            const float r0 = *(const LAS float*)(rec + 256 + c * 4), r1 = *(const LAS float*)(rec + 256 + (32 + c) * 4);
            bonus = fmaf(aop[0] * r0, rk0, aop[1] * r1 * rk1);
        }
#pragma unroll
        for (int vb = 0; vb < 2; ++vb) { const float vv = *(const LAS float*)(rec + 512 + (32 * vb + c) * 4); bop[vb] = hf ? vv : sa[vb]; bopg[vb] = hf ? 0.f : sg[vb]; }
#pragma unroll
        for (int kb = 0; kb < 2; ++kb)
#pragma unroll
            for (int vb = 0; vb < 2; ++vb) {
                TH[kb][vb] = __builtin_amdgcn_mfma_f32_32x32x2f32(aop[kb], bop[vb], TH[kb][vb], 0, 0, 0);
                if (MODE == 0) TG[MODE == 0 ? kb : 0][vb] = __builtin_amdgcn_mfma_f32_32x32x2f32(aop[kb], bopg[vb], TG[MODE == 0 ? kb : 0][vb], 0, 0, 0);
            }
        if (MODE == 2) {
            float py[2] = {0.f, 0.f};
#pragma unroll
            for (int kb = 0; kb < 2; ++kb)
#pragma unroll
                for (int q = 0; q < 4; ++q) {
                    const f32x4 r4 = *(const LAS f32x4*)(rec + 256 + (32 * kb + 8 * q + 4 * hf) * 4);
#pragma unroll
                    for (int j = 0; j < 4; ++j)
#pragma unroll
                        for (int vb = 0; vb < 2; ++vb) py[vb] = fmaf(TH[kb][vb][4 * q + j], r4[j], py[vb]);
                }
            const float y0 = xhalf_sum(py[0]), y1 = xhalf_sum(py[1]);
            float* yp = (float*)ST + ((size_t)scan_token(b, dir, s) * 8 + h) * (ST_SLOTS * 64) + (4 + 2 * dir) * 64 + c;
            if (hf == 0) { yp[0] = y0; yp[32] = y1; }
            if (hf) yp[64] = bonus;
        }
    }
    if (MODE == 0) {
#pragma unroll
        for (int kb = 0; kb < 2; ++kb)
#pragma unroll
            for (int vb = 0; vb < 2; ++vb) {
                float* dg = gh + (32 * vb + c) * 64 + 32 * kb + 4 * hf; float* dh = dg + 4096;
#pragma unroll
                for (int q = 0; q < 4; ++q) {
                    *(f32x4*)(dg + 8 * q) = (f32x4){TG[MODE == 0 ? kb : 0][vb][4 * q], TG[MODE == 0 ? kb : 0][vb][4 * q + 1], TG[MODE == 0 ? kb : 0][vb][4 * q + 2], TG[MODE == 0 ? kb : 0][vb][4 * q + 3]};
                    *(f32x4*)(dh + 8 * q) = (f32x4){TH[kb][vb][4 * q], TH[kb][vb][4 * q + 1], TH[kb][vb][4 * q + 2], TH[kb][vb][4 * q + 3]};
                }
            }
    }
}
__device__ __forceinline__ void rwkv_combine(const Params& p, int sid, LAS unsigned char* lds, int wave, int lane) {
    float* gh0 = (float*)(p.ws + WS_GH) + (size_t)sid * NSEG * 2 * 4096;
    LAS float* Sx = (LAS float*)lds;
    const int tid = wave * 64 + lane;
    for (int e = tid; e < 4096; e += NTHREADS) Sx[(e >> 6) * 65 + (e & 63)] = gh0[4096 + e];
    __syncthreads();
    const int rb = (wave >> 1) & 1, cb = wave & 1, i32 = lane & 31, hf = lane >> 5;
    for (int i = 1; i < NSEG - 1; ++i) {
        float* gi = gh0 + (size_t)i * 2 * 4096;
        f32x16 d;
        if (wave < 4) {
            float bq[32];
#pragma unroll
            for (int q = 0; q < 32; ++q) bq[q] = gi[(2 * q + hf) * 64 + 32 * cb + i32];
#pragma unroll
            for (int r = 0; r < 16; ++r) d[r] = gi[4096 + (32 * rb + 8 * (r >> 2) + 4 * hf + (r & 3)) * 64 + 32 * cb + i32];
#pragma unroll
            for (int q = 0; q < 32; ++q) {
                const float aq = Sx[(32 * rb + i32) * 65 + 2 * q + hf];
                d = __builtin_amdgcn_mfma_f32_32x32x2f32(aq, bq[q], d, 0, 0, 0);
            }
#pragma unroll
            for (int r = 0; r < 16; ++r) gi[4096 + (32 * rb + 8 * (r >> 2) + 4 * hf + (r & 3)) * 64 + 32 * cb + i32] = d[r];
        }
        __syncthreads();
        if (wave < 4) {
#pragma unroll
            for (int r = 0; r < 16; ++r) Sx[(32 * rb + 8 * (r >> 2) + 4 * hf + (r & 3)) * 65 + 32 * cb + i32] = d[r];
        }
        __syncthreads();
    }
}

__device__ __forceinline__ void postmix_phase(const Params& p, int layer, float lam_init, int M, int gw, int NGW, int lane) {
    const bf16_t* P = (const bf16_t*)(p.ws + WS_P); const float* ST = (const float*)(p.ws + WS_ST);
    bf16_t* YB = (bf16_t*)(p.ws + WS_YB); bf16_t* YC = (bf16_t*)(p.ws + WS_YC);
    const float* lng = p.in[22] + layer * 512; const float* lnb = p.in[23] + layer * 512; const float* sg = p.in[25] + layer * 128;
    for (int m = gw; m < M; m += NGW) {
        {
            const int h = lane >> 3, kidx = (lane & 7) * 8, ch = lane * 8;
            const float* sp = ST + ((size_t)m * 8 + h) * (ST_SLOTS * 64) + kidx;
            float y[8], v[8], g[8], lg[8], lb[8];
            { float yb_[8]; ld8f(sp + 4 * 64, y); ld8f(sp + 6 * 64, yb_);
#pragma unroll
              for (int q = 0; q < 8; ++q) y[q] += yb_[q]; }
            ld8f(sp + 128, v); ld8f(lng + ch, lg); ld8f(lnb + ch, lb);
            ld8bf(P + (size_t)m * PP + IC_RW + ch, g);
            float s = 0.f;
#pragma unroll
            for (int q = 0; q < 8; ++q) s += y[q];
            s += __shfl_xor(s, 1); s += __shfl_xor(s, 2); s += __shfl_xor(s, 4);
            float bn;
            { const f32x4 b0 = *(const f32x4*)(sp - kidx + 5 * 64 + (lane & 7) * 4), b1 = *(const f32x4*)(sp - kidx + 7 * 64 + (lane & 7) * 4);
              bn = ((b0.x + b0.y) + (b0.z + b0.w)) + ((b1.x + b1.y) + (b1.z + b1.w));
              bn += __shfl_xor(bn, 1); bn += __shfl_xor(bn, 2); bn += __shfl_xor(bn, 4); }
            const float mu = s * (1.0f / 64.0f);
            float var = 0.f;
#pragma unroll
            for (int q = 0; q < 8; ++q) { const float d = y[q] - mu; var += d * d; }
            var += __shfl_xor(var, 1); var += __shfl_xor(var, 2); var += __shfl_xor(var, 4);
            const float rstd = 1.0f / sqrtf(var * (1.0f / 64.0f) + 64e-5f);
            float o[8];
#pragma unroll
            for (int q = 0; q < 8; ++q) o[q] = (((y[q] - mu) * rstd) * lg[q] + lb[q] + bn * v[q]) * g[q];
            u32x4 w; w.x = pk2(o[0], o[1]); w.y = pk2(o[2], o[3]); w.z = pk2(o[4], o[5]); w.w = pk2(o[6], o[7]);
            *(u32x4*)(YB + (size_t)m * 512 + ch) = w;
        }
        *(u32x4*)((bf16_t*)(p.ws + WS_YA) + (size_t)m * 512 + lane * 8) = *(const u32x4*)(P + (size_t)m * PP + IC_QS + lane * 8);
        {
            const int e = (lane & 15) * 8;
            float x[8], gg[8];
            ld8bf(P + (size_t)m * PP + IC_QD + lane * 8, x); ld8f(sg + e, gg);
            float ss = 0.f;
#pragma unroll
            for (int q = 0; q < 8; ++q) ss += x[q] * x[q];
            ss += __shfl_xor(ss, 1); ss += __shfl_xor(ss, 2); ss += __shfl_xor(ss, 4); ss += __shfl_xor(ss, 8);
            const float rstd = (1.0f - lam_init) / sqrtf(ss * (1.0f / 128.0f) + 1e-5f);
            float o[8];
#pragma unroll
            for (int q = 0; q < 8; ++q) o[q] = x[q] * rstd * gg[q];
            u32x4 w; w.x = pk2(o[0], o[1]); w.y = pk2(o[2], o[3]); w.z = pk2(o[4], o[5]); w.w = pk2(o[6], o[7]);
            *(u32x4*)(YC + (size_t)m * 512 + lane * 8) = w;
        }
    }
}
#define XB_TMO      128
#define XB_XCNT(j)  (256  + 64 * (j))
#define XB_XSUB(j)  (1280 + 64 * (j))
#define XB_XGEN(j)  (2304 + 64 * (j))
#define XB_TOP      3328
#define XB_TOPGEN   3392
#define XCD_BAR_WORDS 3456
#define XB_SPIN_CAP (1u << 18)

__device__ __forceinline__ unsigned xb_ld(unsigned* p)              { return __hip_atomic_load(p, __ATOMIC_RELAXED, __HIP_MEMORY_SCOPE_AGENT); }
__device__ __forceinline__ unsigned xb_add(unsigned* p, unsigned v) { return __hip_atomic_fetch_add(p, v, __ATOMIC_RELAXED, __HIP_MEMORY_SCOPE_AGENT); }
__device__ __forceinline__ unsigned xb_xcc_id() { return (unsigned)__builtin_amdgcn_s_getreg((3 << 11) | 20) & 0xFu; }
#define XB_SPIN(cond, bar) do { unsigned _sp = 0; while (cond) { __builtin_amdgcn_s_sleep(1); \
    if ((++_sp & 255u) == 0u) { if (xb_ld(&(bar)[XB_TMO])) break; if (_sp > XB_SPIN_CAP) { atomicAdd(&(bar)[XB_TMO], 1u); break; } } } } while (0)

struct XcdBarrier {
    unsigned* bar; unsigned x;
    volatile LAS unsigned* st;
};

__device__ __forceinline__ XcdBarrier xcd_barrier_post(unsigned* bar, volatile LAS unsigned* st) {
    XcdBarrier b; b.bar = bar; b.x = xb_xcc_id(); b.st = st;
    if (threadIdx.x == 0) (void)xb_add(&bar[XB_XCNT(b.x)], 1u);
    return b;
}
__device__ __forceinline__ void xcd_barrier_complete(unsigned* bar, unsigned x, unsigned& nloc, unsigned& nx) {
    const unsigned G = gridDim.x * gridDim.y * gridDim.z;
    unsigned sum, cnt, mine, sp = 0u;
    for (;;) {
        sum = 0u; cnt = 0u; mine = 0u;
#pragma unroll
        for (unsigned j = 0; j < 16; ++j) { const unsigned c = xb_ld(&bar[XB_XCNT(j)]); sum += c; cnt += (c > 0u) ? 1u : 0u; mine = (j == x) ? c : mine; }
        if (sum == G) break;
        __builtin_amdgcn_s_sleep(1);
        if ((++sp & 255u) == 0u) { if (xb_ld(&bar[XB_TMO])) break; if (sp > XB_SPIN_CAP) { atomicAdd(&bar[XB_TMO], 1u); break; } }
    }
    nloc = mine > 0u ? mine : 1u; nx = cnt > 0u ? cnt : 1u;
}

__device__ __forceinline__ void xcd_barrier(const XcdBarrier& b) {
    asm volatile("s_waitcnt vmcnt(0)" ::: "memory");
    __syncthreads();
    if (threadIdx.x == 0) {
        unsigned* bar = b.bar;
        __builtin_amdgcn_s_waitcnt(0);
        unsigned nloc = b.st[0], nx = b.st[1];
        if (nloc == 0u) { xcd_barrier_complete(bar, b.x, nloc, nx); b.st[0] = nloc; b.st[1] = nx; }
        const unsigned old = xb_add(&bar[XB_XSUB(b.x)], 1u);
        const unsigned gen = old / nloc;
        if (old + 1u == (gen + 1u) * nloc) {
            __builtin_amdgcn_fence(__ATOMIC_RELEASE, "agent");
            asm volatile("s_waitcnt vmcnt(0)" ::: "memory");
            const unsigned og = xb_add(&bar[XB_TOP], 1u);
            const unsigned tg = og / nx;
            if (og + 1u == (tg + 1u) * nx) xb_add(&bar[XB_TOPGEN], 1u);
            else XB_SPIN(xb_ld(&bar[XB_TOPGEN]) == tg, bar);
            __builtin_amdgcn_fence(__ATOMIC_ACQUIRE, "agent");
            xb_add(&bar[XB_XGEN(b.x)], 1u);
            asm volatile("s_waitcnt vmcnt(0)" ::: "memory");
        } else {
            XB_SPIN(xb_ld(&bar[XB_XGEN(b.x)]) == gen, bar);
            __builtin_amdgcn_fence(__ATOMIC_ACQUIRE, "agent");
            asm volatile("s_waitcnt vmcnt(0)" ::: "memory");
        }
    }
    __syncthreads();
}

#ifndef MK_MULTI
#define MK_MULTI 0
#endif
constexpr int N_PHASES = 40;

constexpr int LDS_PARAMS = LDS_BYTES - 1024;
constexpr int LDS_XB = LDS_BYTES - 64;
constexpr int CW_BAR = 8192;
__device__ __forceinline__ unsigned long long uni64(unsigned long long v) {
    const unsigned lo = __builtin_amdgcn_readfirstlane((unsigned)v), hi = __builtin_amdgcn_readfirstlane((unsigned)(v >> 32));
    return ((unsigned long long)hi << 32) | lo;
}
__device__ __forceinline__ int opq(int v) { asm volatile("" : "+s"(v)); return v; }
__device__ __forceinline__ void load_params(LAS unsigned char* lds, Params& q) {
    LAS const unsigned long long* s = (LAS const unsigned long long*)(lds + LDS_PARAMS);
#pragma unroll
    for (int i = 0; i < 37; ++i) q.in[i] = (const float*)(const __attribute__((address_space(1))) float*)uni64(s[i]);
    q.out = (float*)(__attribute__((address_space(1))) float*)uni64(s[37]); q.ws = (unsigned char*)(__attribute__((address_space(1))) unsigned char*)uni64(s[38]); q.ph_lo = 0; q.ph_hi = 0;
}
__global__ void __launch_bounds__(NTHREADS, 2) mk_fwd(Params kp) {
    extern __shared__ __attribute__((aligned(16))) unsigned char lds_raw[];
    LAS unsigned char* lds = (LAS unsigned char*)lds_raw;
    cg::grid_group grid = cg::this_grid();
    if (threadIdx.x == 0) {
        LAS unsigned long long* s = (LAS unsigned long long*)(lds + LDS_PARAMS);
#pragma unroll
        for (int i = 0; i < 37; ++i) s[i] = (unsigned long long)kp.in[i];
        s[37] = (unsigned long long)kp.out; s[38] = (unsigned long long)kp.ws;
    }
    if (threadIdx.x < 2) ((LAS unsigned*)(lds + LDS_XB))[threadIdx.x] = 0u;
    __syncthreads();
#if !MK_MULTI
    (void)xcd_barrier_post((unsigned*)(kp.ws + WS_CTL) + CW_BAR, (volatile LAS unsigned*)(lds + LDS_XB));
#endif
    const int ph_lo = kp.ph_lo, ph_hi = kp.ph_hi;
    int ph = 0;
#define PH_BEGIN if (ph >= ph_lo && ph < ph_hi) { asm volatile("" ::: "memory"); Params p; load_params(lds, p); unsigned char* ws = p.ws; (void)ws; \
    int tid_ = threadIdx.x, bid_ = blockIdx.x, G_ = gridDim.x; asm volatile("" : "+v"(tid_), "+s"(bid_), "+s"(G_)); \
    const int tid = tid_, bid = bid_, G = G_, lane = tid & 63, wave = __builtin_amdgcn_readfirstlane(tid >> 6); const int gw = bid * NWAVES + wave, NGW = G * NWAVES; (void)gw; (void)NGW; (void)lane; (void)tid; (void)G; (void)bid;
#define GRID_SEAM() do { if (ph == 0) grid.sync(); else { XcdBarrier xb_; xb_.bar = (unsigned*)((unsigned char*)(__attribute__((address_space(1))) unsigned char*)uni64(((LAS const unsigned long long*)(lds + LDS_PARAMS))[38]) + WS_CTL) + CW_BAR; \
        xb_.x = xb_xcc_id(); xb_.st = (volatile LAS unsigned*)(lds + LDS_XB); xcd_barrier(xb_); } } while (0)
#define PH_END } if (ph >= ph_lo && ph + 1 < ph_hi) GRID_SEAM(); ++ph;

    using pg8::Gemm; using pg8::StaticOrder; using pg8::gemm_phase;

    PH_BEGIN
        convert_layer_weights(p, 0, lds, gw, NGW, wave, lane);
        __syncthreads();
        adaln_phase(p, lds, wave, lane);
    PH_END
    PH_BEGIN
        premix_phase(p, 0, true, NTOK, gw, NGW, lane);
    PH_END

#pragma clang loop unroll(full)
    for (int layer = 0; layer < 2; ++layer) {
        const int Ml = layer == 0 ? NTOK : NLAT;
        const float lam_init = 0.8f - 0.6f * expf(-0.3f * (float)layer);
        PH_BEGIN
            Gemm g{(const bf16_t*)(ws + WS_XN), (const bf16_t*)(ws + WS_WIN), NTOK, NIN1, opq(1024), 1024}; StaticOrder S; S.init(NTOK, NIN1, G, bid);
            EpiIn E{(bf16_t*)(ws + WS_P), (bf16_t*)(ws + WS_VTS), (bf16_t*)(ws + WS_VTD), (const float*)(ws + WS_ROPE)};
            gemm_phase<EpiIn, StaticOrder, true, true>(lds, g, S, E);
        PH_END
        PH_BEGIN
            rwkv_prepare_phase(p, layer, gw, NGW, lane);
        PH_END
        PH_BEGIN
            Gemm g{(const bf16_t*)(ws + WS_YA), (const bf16_t*)(ws + WS_LORA), NTOK, 2560, opq(128), 384}; LoraSched S; S.S.init(NTOK, 2560, G, bid);
            EpiLora E{(float*)(ws + WS_ST), (bf16_t*)(ws + WS_P), p.in[14] + layer * 1024, p.in[16] + layer * 1024};
            gemm_phase<EpiLora, LoraSched, true, true>(lds, g, S, E);
        PH_END
        PH_BEGIN
            for (int u = gw; u < 32 * (NSEG - 1); u += NGW) rwkv_segment<0>(p, layer, u / (NSEG - 1), u % (NSEG - 1), lane, lds + wave * SCAN_LDS);
        PH_END
        PH_BEGIN
            unsigned* qhead = (unsigned*)(ws + WS_CTL) + (layer == 0 ? CW_Q0 : CW_Q1);
            LAS int* ubox = (LAS int*)(lds + 65536);
            const int n_swa = 512 + (layer == 0 ? 16 : 0);
            if (bid < 32) rwkv_combine(p, bid, lds, wave, lane);
            if (bid >= 32 || G <= 32)
            for (;;) {
                if (tid == 0) ubox[0] = (int)atomicAdd(qhead, 1u);
                __syncthreads();
                const int u = ubox[0];
                __syncthreads();
                if (u >= n_swa) break;
                if (u < 512) swa_unit(lds, p, layer, u >> 8, (u >> 5) & 7, u & 31, false, wave, lane);
                else { const int v = u - 512; swa_unit(lds, p, layer, v >> 3, v & 7, 0, true, wave, lane); }
            }
        PH_END
        PH_BEGIN
            for (int u = gw; u < 32 * NSEG; u += NGW) rwkv_segment<2>(p, layer, u / NSEG, u % NSEG, lane, lds + wave * SCAN_LDS);
            asm volatile("s_waitcnt vmcnt(0)" ::: "memory");
            __syncthreads();
            float lam;
            { const float* lv = p.in[24] + layer * 256;
              const float s1 = wave_sum(lv[lane] * lv[64 + lane]), s2 = wave_sum(lv[128 + lane] * lv[192 + lane]);
              lam = expf(s1) - expf(s2) + lam_init; }
            for (int u = bid; u < 256; u += G) { const int v = G == 256 ? ((((u & 7) >> 2) << 7) | ((u & 3) << 5) | (u >> 3)) : u; diff_unit(lds, p, lam, v >> 7, (v >> 5) & 3, v & 31, false, wave, lane); }
            if (layer == 0) for (int u = bid; u < 8; u += G) diff_unit(lds, p, lam, u >> 2, u & 3, 0, true, wave, lane);
        PH_END
        PH_BEGIN
            postmix_phase(p, layer, lam_init, Ml, gw, NGW, lane);
            if (layer == 0) convert_ffn_weights(p, lds, gw, NGW, wave, lane);
            __syncthreads();
            Gemm g{(const bf16_t*)(ws + WS_XN), (const bf16_t*)(ws + WS_WIN) + (size_t)NIN1 * 1024, Ml, 3072, opq(1024), 1024}; StaticOrder S; S.init(Ml, 3072, G, bid);
            EpiGate E{(bf16_t*)(ws + WS_G)};
            gemm_phase<EpiGate, StaticOrder, true, true>(lds, g, S, E);
        PH_END
        PH_BEGIN
            StaticOrder S; S.init(Ml, 1024, G, bid);
            { Gemm g{(const bf16_t*)(ws + WS_YA), (const bf16_t*)(ws + WS_PRJ), Ml, 1024, opq(512), 512}; EpiMerge<0> E{(const bf16_t*)(ws + WS_G), (bf16_t*)(ws + WS_MF), (bf16_t*)(ws + WS_MB)};
              gemm_phase<EpiMerge<0>, StaticOrder, true, true>(lds, g, S, E); }
            { Gemm g{(const bf16_t*)(ws + WS_YB), (const bf16_t*)(ws + WS_PRJ) + 1024 * 512, Ml, 1024, opq(512), 512}; EpiMerge<1> E{(const bf16_t*)(ws + WS_G), (bf16_t*)(ws + WS_MF), (bf16_t*)(ws + WS_MB)};
              gemm_phase<EpiMerge<1>, StaticOrder, true, true>(lds, g, S, E); }
            { Gemm g{(const bf16_t*)(ws + WS_YC), (const bf16_t*)(ws + WS_PRJ) + 2 * 1024 * 512, Ml, 1024, opq(512), 512}; EpiMerge<2> E{(const bf16_t*)(ws + WS_G), (bf16_t*)(ws + WS_MF), (bf16_t*)(ws + WS_MB)};
              gemm_phase<EpiMerge<2>, StaticOrder, true, true>(lds, g, S, E); }
        PH_END
        PH_BEGIN
            Gemm g{(const bf16_t*)(ws + WS_MB), (const bf16_t*)(ws + WS_WOUT), Ml, 1024, opq(1024), 1024}; StaticOrder S; S.init(Ml, 1024, G, bid);
            EpiBf E{(bf16_t*)(ws + WS_MOUT), 1024};
            gemm_phase<EpiBf, StaticOrder, true, true>(lds, g, S, E);
        PH_END
        PH_BEGIN
            residual_phase(p, (const bf16_t*)(ws + WS_MOUT), nullptr, nullptr, layer == 0, layer, 2, p.in[7] + layer * 1024, true, p.in[8] + layer * 1024, layer, 3, layer == 1, Ml, gw, NGW, lane);
            if (layer == 0) convert_layer_weights(p, 1, lds, gw, NGW, wave, lane);
            else convert_moe_weights(p, lds, gw, NGW, wave, lane);
        PH_END
        if (layer == 0) {
            PH_BEGIN
                Gemm g{(const bf16_t*)(ws + WS_XN), (const bf16_t*)(ws + WS_FGU), NTOK, 2 * D_FF, opq(1024), 1024}; StaticOrder S; S.init(NTOK, 2 * D_FF, G, bid);
                EpiSwiglu E{(bf16_t*)(ws + WS_HID), D_FF, 1 << 20, 0};
                gemm_phase<EpiSwiglu, StaticOrder, true, true>(lds, g, S, E);
            PH_END
            PH_BEGIN
                Gemm g{(const bf16_t*)(ws + WS_HID), (const bf16_t*)(ws + WS_FD), NTOK, 1024, opq(D_FF), D_FF}; StaticOrder S; S.init(NTOK, 1024, G, bid);
                EpiBf E{(bf16_t*)(ws + WS_MF), 1024};
                gemm_phase<EpiBf, StaticOrder, true, true>(lds, g, S, E);
            PH_END
            PH_BEGIN
                residual_phase(p, (const bf16_t*)(ws + WS_MF), nullptr, nullptr, false, 0, 5, p.in[9], true, p.in[6] + 1024, 1, 0, false, NTOK, gw, NGW, lane);
            PH_END
        }
    }
    {
        {
            PH_BEGIN
                const unsigned* cnt = (const unsigned*)(ws + WS_CTL) + CW_CNT; int ts[9]; ts[0] = 0;
#pragma unroll
                for (int e = 0; e < 8; ++e) ts[e + 1] = ts[e] + (int)((__hip_atomic_load(cnt + e, __ATOMIC_RELAXED, __HIP_MEMORY_SCOPE_AGENT) + 255u) >> 8);
                const int* LIST = (const int*)(ws + WS_LIST); const bf16_t* XN = (const bf16_t*)(ws + WS_XN2); bf16_t* XG = (bf16_t*)(ws + WS_XG);
                for (int r = gw; r < ts[8] * 256; r += NGW) {
                    const int tile = r >> 8; int e = 0;
#pragma unroll
                    for (int q = 1; q < 8; ++q) e += (tile >= ts[q]) ? 1 : 0;
                    int tse = 0;
#pragma unroll
                    for (int q = 0; q < 8; ++q) tse = (q == e) ? ts[q] : tse;
                    const int slot = r - tse * 256;
                    u32x4 v0 = (u32x4){0u, 0u, 0u, 0u}, v1 = v0;
                    if (slot < (int)cnt[e]) { const int tk = LIST[e * 16384 + slot]; const u32x4* src = (const u32x4*)(XN + (size_t)(tk >> 1) * 1024); v0 = src[lane]; v1 = src[lane + 64]; }
                    u32x4* dst = (u32x4*)(XG + (size_t)r * 1024); dst[lane] = v0; dst[lane + 64] = v1;
                }
            PH_END
            PH_BEGIN
                const unsigned* cnt = (const unsigned*)(ws + WS_CTL) + CW_CNT; int ts[9]; ts[0] = 0;
#pragma unroll
                for (int e = 0; e < 8; ++e) ts[e + 1] = ts[e] + (int)((__hip_atomic_load(cnt + e, __ATOMIC_RELAXED, __HIP_MEMORY_SCOPE_AGENT) + 255u) >> 8);
                MoeSched S;
#pragma unroll
                for (int e = 0; e < 9; ++e) S.ts[e] = ts[e];
                S.pm_lo = 0; S.pm_hi = ts[8]; S.npn = 28; S.G = G; S.c = bid; S.a_local = false;
                Gemm g{(const bf16_t*)(ws + WS_XG), (const bf16_t*)(ws + WS_MGU), 0, 0, opq(1024), 1024};
                EpiSwiglu E{(bf16_t*)(ws + WS_HIDM), D_FFE, 28, 0};
                gemm_phase<EpiSwiglu, MoeSched, true, true>(lds, g, S, E);
            PH_END
            PH_BEGIN
                const unsigned* cnt = (const unsigned*)(ws + WS_CTL) + CW_CNT; int ts[9]; ts[0] = 0;
#pragma unroll
                for (int e = 0; e < 8; ++e) ts[e + 1] = ts[e] + (int)((__hip_atomic_load(cnt + e, __ATOMIC_RELAXED, __HIP_MEMORY_SCOPE_AGENT) + 255u) >> 8);
                MoeSched S;
#pragma unroll
                for (int e = 0; e < 9; ++e) S.ts[e] = ts[e];
                S.pm_lo = 0; S.pm_hi = ts[8]; S.npn = 4; S.G = G; S.c = bid; S.a_local = false;
                Gemm g{(const bf16_t*)(ws + WS_HIDM), (const bf16_t*)(ws + WS_MD), 0, 0, opq(D_FFE), D_FFE};
                EpiMoeDown E; E.FS = (bf16_t*)(ws + WS_FACC); E.slot1_off = ((long)WS_MGU - (long)WS_FACC) / 2; E.LIST = (const int*)(ws + WS_LIST); E.WTS = (const float*)(ws + WS_WTS); E.cnt = cnt; E.pm_lo = 0;
#pragma unroll
                for (int e = 0; e < 9; ++e) E.ts[e] = ts[e];
                gemm_phase<EpiMoeDown, MoeSched, true, true>(lds, g, S, E);
            PH_END
            PH_BEGIN
                residual_phase(p, (const bf16_t*)(ws + WS_FACC), (const bf16_t*)(ws + WS_MGU), nullptr, false, 1, 5, p.in[9] + 1024, false, nullptr, 0, 0, false, NLAT, gw, NGW, lane);
            PH_END
        }
    }
#undef PH_BEGIN
#undef PH_END
}

extern "C" void kernel_launch(void* const* d_in, const int* in_sizes, int n_in, void* d_out, int out_size, void* d_ws, size_t ws_size, hipStream_t stream) {
    static int grid = 0;
    if (grid == 0) {
        if (n_in != 37 || out_size != NLAT * DM || ws_size < WS_NEED) { fprintf(stderr, "kernel_launch: unexpected shapes (n_in %d out %d ws %zu need %zu)\n", n_in, out_size, ws_size, (size_t)WS_NEED); grid = -1; return; }
        int dev = 0, cus = 0, per_cu = 0;
        (void)hipGetDevice(&dev);
        (void)hipDeviceGetAttribute(&cus, hipDeviceAttributeMultiprocessorCount, dev);
        (void)hipFuncSetAttribute((const void*)mk_fwd, hipFuncAttributeMaxDynamicSharedMemorySize, LDS_BYTES);
        (void)hipOccupancyMaxActiveBlocksPerMultiprocessor(&per_cu, (const void*)mk_fwd, NTHREADS, LDS_BYTES);
        if (per_cu < 1) { fprintf(stderr, "kernel_launch: occupancy query reports %d blocks per CU\n", per_cu); grid = -1; return; }
        grid = cus;
        fprintf(stderr, "kernel_launch: grid %d (cus %d, per_cu %d), ws %zu\n", grid, cus, per_cu, ws_size);
    }
    if (grid < 0) return;
    (void)hipMemsetAsync((char*)d_ws + WS_CTL, 0, CTL_BYTES, stream);
    Params prm{};
    for (int i = 0; i < 37; ++i) prm.in[i] = (const float*)d_in[i];
    prm.out = (float*)d_out; prm.ws = (unsigned char*)d_ws;
#if MK_MULTI
    for (int ph = 0; ph < N_PHASES; ++ph) { prm.ph_lo = ph; prm.ph_hi = ph + 1; hipLaunchKernelGGL(mk_fwd, dim3(grid), dim3(NTHREADS), LDS_BYTES, stream, prm); }
#else
    prm.ph_lo = 0; prm.ph_hi = 1 << 20;
    void* args[] = {&prm};
    hipError_t e = hipLaunchCooperativeKernel((const void*)mk_fwd, dim3(grid), dim3(NTHREADS), args, LDS_BYTES, stream);
    if (e != hipSuccess) fprintf(stderr, "kernel_launch: cooperative launch failed: %s (grid %d)\n", hipGetErrorString(e), grid);
#endif
}
```

```cpp
#include <hip/hip_runtime.h>
#include <hip/hip_cooperative_groups.h>
#include <cstdio>
#include <cstdint>
namespace cg = cooperative_groups;
namespace pg8 {
#define PG8_LAS __attribute__((address_space(3)))
typedef unsigned short bf16_t;
typedef short bf16x8 __attribute__((ext_vector_type(8)));
typedef float f32x4 __attribute__((ext_vector_type(4)));
typedef unsigned u32x4 __attribute__((ext_vector_type(4)));
constexpr int BM = 256, BK = 64, HALF = 128, HTB = HALF * BK * 2  , STAGE_BYTES = 8 * HTB, NXCD = 8, WGM = 8;

__host__ __device__ __forceinline__ int lds_byte(int r, int c) { const int st = (r >> 4) * 2 + (c >> 5), rr = r & 15, cc = c & 31, ob = rr * 64 + cc * 2; return st * 1024 + (ob ^ (((ob >> 9) & 1) << 5)); }
__host__ __device__ __forceinline__ void stage_rc(int b, int& R, int& C) { const int st = b / 1024, sb = b % 1024, swz = sb ^ (((sb >> 9) & 1) << 5); R = (st >> 1) * 16 + swz / 64; C = (st & 1) * 32 + (swz % 64) / 2; }
__host__ __device__ __forceinline__ int perm32(int rho) { const int n = rho >> 4, i = rho & 15; return 8 * (i >> 2) + 4 * n + (i & 3); }

struct Unit { int pm, pn, koff, tail; };
struct Gemm { const bf16_t* A; const bf16_t* Bt; int M, N, K, ld; };

struct StaticOrder {
    int nM, nN, nwg, G, c;
    __host__ __device__ void init(int M, int N, int G_, int c_) { nM = M / BM; nN = N / BM; nwg = nM * nN; G = G_; c = c_; }
    __host__ __device__ bool next(int i, Unit& u) const {
        const long L = (long)i * G + c; if (L >= nwg) return false;
        int wgid = (int)L; { const int q = nwg / NXCD, r = nwg % NXCD, xcd = wgid % NXCD, off = wgid / NXCD; wgid = (xcd < r ? xcd * (q + 1) : r * (q + 1) + (xcd - r) * q) + off; }
        const int nig = WGM * nN, gid = wgid / nig, fm = gid * WGM, gsz = (nM - fm) < WGM ? (nM - fm) : WGM;
        u.pm = fm + ((wgid % nig) % gsz); u.pn = (wgid % nig) / gsz; u.koff = 0; u.tail = -1; return true;
    }
    __device__ __forceinline__ void a_ready(const Unit&) const {}
    __device__ __forceinline__ void done(const Unit&) const {}
};

__device__ __forceinline__ unsigned cvt_pk_bf16(float lo, float hi) { unsigned r; asm volatile("v_cvt_pk_bf16_f32 %0, %1, %2" : "=v"(r) : "v"(lo), "v"(hi)); return r; }
typedef float f32x2 __attribute__((ext_vector_type(2)));
template <class Epi, class Sched, bool ALIGN_EPI = false, bool SP2 = false>
__device__ __forceinline__ void gemm_phase(PG8_LAS unsigned char* lds, const Gemm g, const Sched& S, const Epi& E) {
    int tid_ = threadIdx.x; asm volatile("" : "+v"(tid_)); const int tid = tid_, wid = __builtin_amdgcn_readfirstlane(tid >> 6), lane = tid & 63, wr = wid >> 2, wc = wid & 3, fr = lane & 15, fq = lane >> 4;
    const int K = g.ld, nt = g.K / BK;
    unsigned voffA[2], voffB[2];
#pragma unroll
    for (int i = 0; i < 2; ++i) { int R, C; stage_rc(tid * 16 + i * 8192, R, C); const int Rb = Epi::PERM ? ((R & ~31) + perm32(R & 31)) : R;
        voffA[i] = (unsigned)(R * K + C) * 2u; voffB[i] = (unsigned)(Rb * K + C) * 2u; }
    const size_t kstep = (size_t)(BK * 2);
    const size_t hstep = (size_t)HALF * K * 2;
    const size_t tstep = 2 * hstep;
    const unsigned ldsw = (unsigned)wid * 1024u;
    const int aoff = lds_byte(wr * 64 + fr, fq * 8), boff = lds_byte(wc * 32 + fr, fq * 8);
#define PG8_SA(b, h) (((b) * 2 + (h)) * HTB)
#define PG8_SB(b, h) ((4 + (b) * 2 + (h)) * HTB)
#define PG8_STAGE(bufoff, gbase, voff) do { _Pragma("unroll") for (int _i = 0; _i < 2; ++_i) \
        __builtin_amdgcn_global_load_lds((const unsigned*)((const char*)(gbase) + (voff)[_i]), (PG8_LAS unsigned*)(lds + (bufoff) + ldsw + _i * 8192), 16, 0, 0); } while (0)
#define PG8_LDA(dst, b, h) do { _Pragma("unroll") for (int m = 0; m < 4; ++m) _Pragma("unroll") for (int k = 0; k < 2; ++k) dst[m][k] = *(const PG8_LAS bf16x8*)(lds + PG8_SA(b, h) + aoff + m * 2048 + k * 1024); } while (0)
#define PG8_LDB(dst, b, h) do { _Pragma("unroll") for (int n = 0; n < 2; ++n) _Pragma("unroll") for (int k = 0; k < 2; ++k) dst[n][k] = *(const PG8_LAS bf16x8*)(lds + PG8_SB(b, h) + boff + n * 2048 + k * 1024); } while (0)
#define PG8_MMA(ai, bj, At, Bt) do { __builtin_amdgcn_s_setprio(1); _Pragma("unroll") for (int m = 0; m < 4; ++m) _Pragma("unroll") for (int n = 0; n < 2; ++n) _Pragma("unroll") for (int k = 0; k < 2; ++k) \
        acc[ai][bj][m][n] = __builtin_amdgcn_mfma_f32_16x16x32_bf16(Bt[n][k], At[m][k], acc[ai][bj][m][n], 0, 0, 0); __builtin_amdgcn_s_setprio(0); } while (0)
#define PG8_WAIT_V(n) asm volatile("s_waitcnt vmcnt(" #n ")" ::: "memory")
#define PG8_WAIT_L(n) asm volatile("s_waitcnt lgkmcnt(" #n ")" ::: "memory")
#define PG8_BAR __builtin_amdgcn_s_barrier()
#define PG8_SCHED __builtin_amdgcn_sched_barrier(0)
    Unit cur, nxt; int ui = 0;
    if (!S.next(0, cur)) return;
    f32x4 acc[2][2][4][2];
#pragma unroll
    for (int a = 0; a < 2; ++a)
#pragma unroll
        for (int b = 0; b < 2; ++b)
#pragma unroll
            for (int m = 0; m < 4; ++m)
#pragma unroll
                for (int n = 0; n < 2; ++n) acc[a][b][m][n] = (f32x4){0.f, 0.f, 0.f, 0.f};
    bf16x8 At[4][2], B0[2][2], B1[2][2];
    const char* cA = (const char*)g.A + (size_t)cur.pm * tstep + (size_t)cur.koff * 2; const char* cB = (const char*)g.Bt + (size_t)cur.pn * tstep + (size_t)cur.koff * 2;
    S.a_ready(cur);
    if constexpr (SP2) {
        PG8_STAGE(PG8_SB(0, 0), cB, voffB); PG8_STAGE(PG8_SB(0, 1), cB + hstep, voffB); PG8_STAGE(PG8_SA(0, 0), cA, voffA); PG8_STAGE(PG8_SA(0, 1), cA + hstep, voffA);
        if (wr == 1) PG8_BAR;
        PG8_WAIT_V(2); PG8_BAR;
        PG8_STAGE(PG8_SB(1, 0), cB + kstep, voffB); PG8_STAGE(PG8_SA(1, 0), cA + kstep, voffA); PG8_STAGE(PG8_SB(1, 1), cB + hstep + kstep, voffB);
        PG8_WAIT_V(6); PG8_BAR;
    } else {
        PG8_STAGE(PG8_SB(0, 0), cB, voffB); PG8_STAGE(PG8_SA(0, 0), cA, voffA); PG8_STAGE(PG8_SB(0, 1), cB + hstep, voffB); PG8_STAGE(PG8_SA(0, 1), cA + hstep, voffA);
        if (wr == 1) PG8_BAR;
        PG8_WAIT_V(4); PG8_BAR;
        PG8_STAGE(PG8_SB(1, 0), cB + kstep, voffB); PG8_STAGE(PG8_SA(1, 0), cA + kstep, voffA); PG8_STAGE(PG8_SB(1, 1), cB + hstep + kstep, voffB);
        PG8_WAIT_V(6); PG8_BAR;
    }
    for (;;) {
        const bool has_next = S.next(ui + 1, nxt);
        const char* nA = has_next ? (const char*)g.A + (size_t)nxt.pm * tstep + (size_t)nxt.koff * 2 : cA; const char* nB = has_next ? (const char*)g.Bt + (size_t)nxt.pn * tstep + (size_t)nxt.koff * 2 : cB;
        for (int t = 0; t < nt; t += 2) {
            const bool last = (t == nt - 2);
            const char* a1 = cA + (size_t)(t + 1) * kstep;
            const char* a2 = last ? nA : cA + (size_t)(t + 2) * kstep; const char* b2 = last ? nB : cB + (size_t)(t + 2) * kstep;
            const char* a3 = a2 + kstep; const char* b3 = b2 + kstep;
            if (last && has_next) S.a_ready(nxt);
            if constexpr (SP2) {
            PG8_LDB(B0, 0, 0); PG8_LDB(B1, 0, 1); PG8_SCHED; PG8_LDA(At, 0, 0); PG8_STAGE(PG8_SA(1, 1), a1 + hstep, voffA);
            PG8_WAIT_V(8); PG8_WAIT_L(0); PG8_BAR; PG8_MMA(0, 0, At, B0); PG8_MMA(0, 1, At, B1); PG8_BAR; PG8_SCHED;
            PG8_LDA(At, 0, 1); PG8_STAGE(PG8_SB(0, 0), b2, voffB); PG8_STAGE(PG8_SB(0, 1), b2 + hstep, voffB); PG8_STAGE(PG8_SA(0, 0), a2, voffA);
            PG8_WAIT_V(8); PG8_WAIT_L(0); PG8_BAR; PG8_MMA(1, 0, At, B0); PG8_MMA(1, 1, At, B1); PG8_BAR; PG8_SCHED;
            PG8_LDB(B0, 1, 0); PG8_LDB(B1, 1, 1); PG8_SCHED; PG8_LDA(At, 1, 0); PG8_STAGE(PG8_SA(0, 1), a2 + hstep, voffA);
            PG8_WAIT_V(8); PG8_WAIT_L(0); PG8_BAR; PG8_MMA(0, 0, At, B0); PG8_MMA(0, 1, At, B1); PG8_BAR; PG8_SCHED;
            PG8_LDA(At, 1, 1); PG8_STAGE(PG8_SB(1, 0), b3, voffB); PG8_STAGE(PG8_SB(1, 1), b3 + hstep, voffB); PG8_STAGE(PG8_SA(1, 0), a3, voffA);
            PG8_WAIT_V(8); PG8_WAIT_L(0); PG8_BAR; PG8_MMA(1, 0, At, B0); PG8_MMA(1, 1, At, B1); PG8_BAR; PG8_SCHED;
            } else {
            PG8_LDB(B0, 0, 0); PG8_SCHED; PG8_LDA(At, 0, 0); PG8_STAGE(PG8_SA(1, 1), a1 + hstep, voffA);
            PG8_WAIT_L(8); PG8_BAR; PG8_WAIT_L(0); PG8_MMA(0, 0, At, B0); PG8_BAR; PG8_SCHED;
            PG8_LDB(B1, 0, 1); PG8_STAGE(PG8_SB(0, 0), b2, voffB);
            PG8_BAR; PG8_WAIT_L(0); PG8_MMA(0, 1, At, B1); PG8_BAR;
            PG8_LDA(At, 0, 1); PG8_STAGE(PG8_SA(0, 0), a2, voffA);
            PG8_BAR; PG8_WAIT_L(0); PG8_MMA(1, 0, At, B0); PG8_BAR; PG8_SCHED;
            PG8_STAGE(PG8_SB(0, 1), b2 + hstep, voffB);
            PG8_WAIT_V(6); PG8_BAR; PG8_MMA(1, 1, At, B1); PG8_BAR;
            PG8_LDB(B0, 1, 0); PG8_SCHED; PG8_LDA(At, 1, 0); PG8_STAGE(PG8_SA(0, 1), a2 + hstep, voffA);
            PG8_WAIT_L(8); PG8_BAR; PG8_WAIT_L(0); PG8_MMA(0, 0, At, B0); PG8_BAR; PG8_SCHED;
            PG8_LDB(B1, 1, 1); PG8_STAGE(PG8_SB(1, 0), b3, voffB);
            PG8_BAR; PG8_WAIT_L(0); PG8_MMA(0, 1, At, B1); PG8_BAR;
            PG8_LDA(At, 1, 1); PG8_STAGE(PG8_SA(1, 0), a3, voffA);
            PG8_BAR; PG8_WAIT_L(0); PG8_MMA(1, 0, At, B0); PG8_BAR; PG8_SCHED;
            PG8_STAGE(PG8_SB(1, 1), b3 + hstep, voffB);
            PG8_WAIT_V(6); PG8_BAR; PG8_MMA(1, 1, At, B1); PG8_BAR;
            }
        }
        if constexpr (ALIGN_EPI) { if (wr == 0) PG8_BAR; }
        if constexpr (!Epi::AFTER_DRAIN) { E(acc, cur, wr, wc, fr, fq); S.done(cur); }
        if (!has_next) break;
#pragma unroll
        for (int a = 0; a < 2; ++a)
#pragma unroll
            for (int b = 0; b < 2; ++b)
#pragma unroll
                for (int m = 0; m < 4; ++m)
#pragma unroll
                    for (int n = 0; n < 2; ++n) acc[a][b][m][n] = (f32x4){0.f, 0.f, 0.f, 0.f};
        cur = nxt; cA = nA; cB = nB; ++ui;
        if constexpr (ALIGN_EPI) { if (wr == 1) PG8_BAR; }
    }
    PG8_WAIT_V(0);
    if constexpr (!ALIGN_EPI) { if (wr == 0) PG8_BAR; }
    PG8_BAR;
    if constexpr (Epi::AFTER_DRAIN) { E.fused(acc, cur, wr, wc, fr, fq, lds, wid, lane); S.done(cur); }
#undef PG8_SA
#undef PG8_SB
#undef PG8_STAGE
#undef PG8_LDA
#undef PG8_LDB
#undef PG8_MMA
#undef PG8_WAIT_V
#undef PG8_WAIT_L
#undef PG8_BAR
#undef PG8_SCHED
}
}

#define LAS __attribute__((address_space(3)))
typedef unsigned short bf16_t;
typedef short bf16x8 __attribute__((ext_vector_type(8)));
typedef float f32x4 __attribute__((ext_vector_type(4)));
typedef float f32x16 __attribute__((ext_vector_type(16)));
typedef unsigned u32x4 __attribute__((ext_vector_type(4)));
typedef unsigned u32x2 __attribute__((ext_vector_type(2)));

constexpr int NTHREADS = 512, NWAVES = 8;
constexpr int DM = 1024, SEQ = 8192, CTXL = 256, NLAT = 2 * SEQ, NCTX = 2 * CTXL, NTOK = NLAT + NCTX, KEYS = SEQ + CTXL;
constexpr int D_IN = 7296, D_FF = 2816, D_FFE = 3584, NEXP = 8;
constexpr int IC_QS = 0, IC_KS = 512, IC_RW = 640, IC_QD = 2560, IC_KD = 3072, PP = 3584, IC_VS = 3584, IC_VD = 3712, IC_PAD = 4224, NIN1 = 4352, WIN_ROWS = 7424;
constexpr int ST_SLOTS = 8;
constexpr int SL_W0 = 0, SL_A0 = 1, SL_KK = 2, SL_R = 3, SL_V = 4, SL_K = 5, SL_W1 = 6, SL_A1 = 7;
constexpr int MOE_TILES = 136, MOE_HALF = 68;

constexpr size_t MiB = 1u << 20;
constexpr size_t WS_CTL = 0, CTL_BYTES = 1 * MiB;
constexpr size_t WS_MODS = 1 * MiB;
constexpr size_t WS_ROPE = 1 * MiB + 256 * 1024;
constexpr size_t WS_HCTX = 2 * MiB;
constexpr size_t WS_LIST = 4 * MiB;
constexpr size_t WS_WTS = 4 * MiB + 512 * 1024;
constexpr size_t WS_WIN = 6 * MiB;
constexpr size_t WS_PRJ = WS_WIN + (size_t)WIN_ROWS * 1024 * 2;
constexpr size_t WS_WOUT = WS_PRJ + 3 * MiB;
constexpr size_t WS_LORA = WS_WOUT + 2 * MiB;
constexpr size_t WS_XN = 28 * MiB;
constexpr size_t WS_P = 61 * MiB;
constexpr size_t WS_VTS = 177 * MiB;
constexpr size_t WS_VTD = WS_VTS + 4608 * 1024;
constexpr size_t WS_ST = 198 * MiB;
constexpr size_t WS_YA = 495 * MiB;
constexpr size_t WS_YB = WS_YA + 16896ull * 512 * 2;
constexpr size_t WS_YC = WS_YB + 16896ull * 512 * 2;
constexpr size_t WS_END = WS_YC + 16896ull * 512 * 2;
constexpr size_t WS_G = WS_ST;
constexpr size_t WS_MF = WS_ST + 99 * MiB;
constexpr size_t WS_MB = WS_ST + 165 * MiB;
constexpr size_t WS_MOUT = WS_ST + 198 * MiB;
constexpr size_t WS_FGU = WS_VTS;
constexpr size_t WS_FD = WS_VTS + 11 * MiB;
constexpr size_t WS_HID = WS_P;
constexpr size_t WS_XN2 = 495 * MiB;
constexpr size_t WS_MGU = 6 * MiB;
constexpr size_t WS_MD = 118 * MiB;
constexpr size_t WS_XG = 174 * MiB;
constexpr size_t WS_FACC = 242 * MiB;
constexpr size_t WS_HIDM = 306 * MiB;
static_assert(WS_LORA + 2560 * 384 * 2 <= WS_XN && WS_XN + 16896ull * 1024 * 2 <= WS_P && WS_P + 16896ull * PP * 2 <= WS_VTS && WS_VTD + 2ull * 4 * 128 * KEYS * 2 <= WS_ST, "ws map 1");
static_assert(WS_ST + 16896ull * 8 * ST_SLOTS * 64 * 4 <= WS_YA && WS_END <= 545 * MiB, "ws map 2");
static_assert(WS_G + 16896ull * 3072 * 2 <= WS_MF && WS_MF + 16896ull * 1024 * 4 <= WS_MB && WS_MB + 16896ull * 1024 * 2 <= WS_MOUT && WS_MOUT + 16896ull * 1024 * 4 <= WS_YA, "ws map 3");
static_assert(WS_FGU + 5632ull * 1024 * 2 <= WS_FD && WS_FD + 1024ull * 2816 * 2 <= WS_ST && WS_HID + 16896ull * 2816 * 2 <= WS_VTS, "ws map 4");
static_assert(WS_MGU + 8ull * 7168 * 1024 * 2 <= WS_MD && WS_MD + 8ull * 1024 * 3584 * 2 <= WS_XG && WS_XG + 34816ull * 1024 * 2 <= WS_FACC && WS_FACC + 16384ull * 1024 * 4 <= WS_HIDM && WS_HIDM + 136ull * 256 * 3584 * 2 <= 560 * MiB, "ws map 5");
static_assert(WS_FACC + 16384ull * 1024 * 4 <= WS_MOUT && WS_XN2 + 16384ull * 1024 * 2 <= 560 * MiB && WS_XN2 >= WS_MOUT + 16896ull * 1024 * 4, "expert weights / gathered rows / accumulator must not touch MOUT or XN2 while they are live");
constexpr size_t WS_NEED = 560 * MiB;
constexpr int CW_CNT = 0;
constexpr int CW_Q0 = 64, CW_Q1 = 128;

constexpr int LDS_BYTES = 147456;

__device__ __forceinline__ unsigned f2bf(float f) { unsigned u = __builtin_bit_cast(unsigned, f); return (u + 0x7fffu + ((u >> 16) & 1u)) >> 16; }
typedef float f32x2_t __attribute__((ext_vector_type(2))); typedef __bf16 bf16x2_t __attribute__((ext_vector_type(2)));
__device__ __forceinline__ unsigned pk2(float lo, float hi) { const f32x2_t v = {lo, hi}; return __builtin_bit_cast(unsigned, __builtin_convertvector(v, bf16x2_t)); }
__device__ __forceinline__ float bflo(unsigned w) { return __uint_as_float(w << 16); }
__device__ __forceinline__ float bfhi(unsigned w) { return __uint_as_float(w & 0xffff0000u); }
__device__ __forceinline__ float wave_sum(float v) {
#pragma unroll
    for (int o = 1; o < 64; o <<= 1) v += __shfl_xor(v, o);
    return v;
}
__device__ __forceinline__ float sigmoidf_(float x) { return 1.0f / (1.0f + __expf(-x)); }
__device__ __forceinline__ float siluf_(float x) { return x / (1.0f + __expf(-x)); }
#define LDS_WAIT() asm volatile("s_waitcnt lgkmcnt(0)" ::: "memory")

struct Params {
    const float* in[37];
    float* out;
    unsigned char* ws;
    int ph_lo, ph_hi;
};

template <class F>
__device__ __forceinline__ void transpose_item(const float* __restrict__ W, int ldw, int k0, int n0, bf16_t* __restrict__ WT, int ldt, int dcol0, F rowmap, LAS float* scr, int lane) {
#pragma unroll 8
    for (int i = 0; i < 32; ++i) { const int kk = 2 * i + (lane >> 5); scr[kk * 33 + (lane & 31)] = W[(size_t)(k0 + kk) * ldw + n0 + (lane & 31)]; }
    LDS_WAIT(); asm volatile("" ::: "memory");
    const int c = lane & 7;
#pragma unroll
    for (int j = 0; j < 4; ++j) {
        const int n = (lane >> 3) + 8 * j; const LAS float* s = scr + (8 * c) * 33 + n;
        u32x4 o; o.x = pk2(s[0 * 33], s[1 * 33]); o.y = pk2(s[2 * 33], s[3 * 33]); o.z = pk2(s[4 * 33], s[5 * 33]); o.w = pk2(s[6 * 33], s[7 * 33]);
        const int row = rowmap(n0 + n);
        if (row >= 0) *(u32x4*)(WT + (size_t)row * ldt + dcol0 + k0 + 8 * c) = o;
    }
    LDS_WAIT(); asm volatile("" ::: "memory");
}
struct RowId { __device__ __forceinline__ int operator()(int n) const { return n; } };
struct RowOff { int off; __device__ __forceinline__ int operator()(int n) const { return n + off; } };
struct RowWin {
    __device__ __forceinline__ int operator()(int n) const {
        if (n < 640) return n;
        if (n < 768) return n - 640 + IC_VS;
        if (n < 2688) return n - 768 + IC_RW;
        if (n < 3712) return n - 2688 + IC_QD;
        if (n < 4224) return n - 3712 + IC_VD;
        return n - 4224 + NIN1;
    }
};
struct RowGU { int up; __device__ __forceinline__ int operator()(int j) const { return (j >> 7) * 256 + (j & 127) + 128 * up; } };

template <class F>
__device__ __forceinline__ void convert_matrix(const float* W, int K, int N, bf16_t* WT, int ldt, int dcol0, F rowmap, LAS float* scr, int lane, int gw, int NGW) {
    const int nblk = N / 32, items = (K / 64) * nblk;
    for (int it = gw; it < items; it += NGW) { const int kb = it / nblk, nb = it % nblk; transpose_item(W, N, kb * 64, nb * 32, WT, ldt, dcol0, rowmap, scr, lane); }
}

__device__ __forceinline__ void lora_region(bf16_t* __restrict__ LT, const float* __restrict__ src, int row0, int klo, int kn, int gw, int NGW, int lane) {
    for (int i = gw * 64 + lane; i < 512 * 48; i += NGW * 64) {
        const int nn = i / 48, kc = (i % 48) * 8;
        u32x4 o = (u32x4){0u, 0u, 0u, 0u};
        if (kc >= klo && kc < klo + kn) {
            const float* s = src + (size_t)(kc - klo) * 512 + nn;
            o.x = pk2(s[0], s[512]); o.y = pk2(s[2 * 512], s[3 * 512]); o.z = pk2(s[4 * 512], s[5 * 512]); o.w = pk2(s[6 * 512], s[7 * 512]);
        }
        *(u32x4*)(LT + (size_t)(row0 + nn) * 384 + kc) = o;
    }
}
__device__ __forceinline__ void convert_layer_weights(const Params& p, int layer, LAS unsigned char* lds, int gw, int NGW, int wave, int lane) {
    LAS float* scr = (LAS float*)(lds + wave * 16384);
    unsigned char* ws = p.ws;
    bf16_t* WIN = (bf16_t*)(ws + WS_WIN);
    convert_matrix(p.in[10] + (size_t)layer * 1024 * D_IN, 1024, D_IN, WIN, 1024, 0, RowWin(), scr, lane, gw, NGW);
    for (int i = gw * 64 + lane; i < (NIN1 - IC_PAD) * 1024 / 8; i += NGW * 64) *(u32x4*)(WIN + (size_t)IC_PAD * 1024 + (size_t)i * 8) = (u32x4){0u, 0u, 0u, 0u};
    for (int j = 0; j < 3; ++j)
        convert_matrix(p.in[26 + j] + (size_t)layer * 512 * 1024, 512, 1024, (bf16_t*)(ws + WS_PRJ) + (size_t)j * 1024 * 512, 512, 0, RowId(), scr, lane, gw, NGW);
    convert_matrix(p.in[29] + (size_t)layer * 1024 * 1024, 1024, 1024, (bf16_t*)(ws + WS_WOUT), 1024, 0, RowId(), scr, lane, gw, NGW);
    bf16_t* LT = (bf16_t*)(ws + WS_LORA);
    lora_region(LT, p.in[15] + ((size_t)layer * 2 + 0) * 64 * 512, 0, 0, 64, gw, NGW, lane);
    lora_region(LT, p.in[15] + ((size_t)layer * 2 + 1) * 64 * 512, 512, 64, 64, gw, NGW, lane);
    lora_region(LT, p.in[17] + ((size_t)layer * 2 + 0) * 64 * 512, 1024, 128, 64, gw, NGW, lane);
    lora_region(LT, p.in[17] + ((size_t)layer * 2 + 1) * 64 * 512, 1536, 192, 64, gw, NGW, lane);
    lora_region(LT, p.in[18] + (size_t)layer * 128 * 512, 2048, 256, 128, gw, NGW, lane);
}
__device__ __forceinline__ void convert_ffn_weights(const Params& p, LAS unsigned char* lds, int gw, int NGW, int wave, int lane) {
    LAS float* scr = (LAS float*)(lds + wave * 16384);
    bf16_t* GU = (bf16_t*)(p.ws + WS_FGU); bf16_t* FD = (bf16_t*)(p.ws + WS_FD);
    convert_matrix(p.in[30], 1024, D_FF, GU, 1024, 0, RowGU{0}, scr, lane, gw, NGW);
    convert_matrix(p.in[31], 1024, D_FF, GU, 1024, 0, RowGU{1}, scr, lane, gw, NGW);
    convert_matrix(p.in[32], D_FF, 1024, FD, D_FF, 0, RowId(), scr, lane, gw, NGW);
}
__device__ __forceinline__ void convert_moe_weights(const Params& p, LAS unsigned char* lds, int gw, int NGW, int wave, int lane) {
    LAS float* scr = (LAS float*)(lds + wave * 16384);
    for (int e = 0; e < NEXP; ++e) {
        bf16_t* GU = (bf16_t*)(p.ws + WS_MGU) + (size_t)e * 7168 * 1024;
        convert_matrix(p.in[34] + (size_t)e * 1024 * D_FFE, 1024, D_FFE, GU, 1024, 0, RowGU{0}, scr, lane, gw, NGW);
        convert_matrix(p.in[35] + (size_t)e * 1024 * D_FFE, 1024, D_FFE, GU, 1024, 0, RowGU{1}, scr, lane, gw, NGW);
        convert_matrix(p.in[36] + (size_t)e * D_FFE * 1024, D_FFE, 1024, (bf16_t*)(p.ws + WS_MD) + (size_t)e * 1024 * D_FFE, D_FFE, 0, RowId(), scr, lane, gw, NGW);
    }
}

__device__ __forceinline__ void adaln_phase(const Params& p, LAS unsigned char* lds, int wave, int lane) {
    LAS float* red = (LAS float*)lds;
    float* MODS = (float*)(p.ws + WS_MODS);
    const float* c = p.in[1]; const float* cc = p.in[3];
    for (int it = blockIdx.x; it < 2 * 96; it += gridDim.x) {
        const int layer = it / 96, n = (it % 96) * 64 + lane;
        const float* W = p.in[4] + (size_t)layer * 1024 * 6144;
        float a0 = 0.f, a1 = 0.f, a2 = 0.f;
        for (int k = wave * 128; k < wave * 128 + 128; ++k) {
            const float w = W[(size_t)k * 6144 + n];
            a0 += siluf_(c[k]) * w; a1 += siluf_(c[1024 + k]) * w; a2 += siluf_(cc[k]) * w;
        }
        red[(wave * 3 + 0) * 64 + lane] = a0; red[(wave * 3 + 1) * 64 + lane] = a1; red[(wave * 3 + 2) * 64 + lane] = a2;
        __syncthreads();
        if (wave < 3) {
            float s = 0.f;
#pragma unroll
            for (int w = 0; w < 8; ++w) s += red[(w * 3 + wave) * 64 + lane];
            MODS[((size_t)layer * 3 + wave) * 6144 + n] = s + p.in[5][(size_t)layer * 6144 + n];
        }
        __syncthreads();
    }
    if (blockIdx.x == gridDim.x - 1) {
        float* rope = (float*)(p.ws + WS_ROPE);
        for (int i = threadIdx.x; i < 128 * 16; i += NTHREADS) {
            const int pos = i >> 4, j = i & 15;
            const float inv = powf(10000.0f, -(float)j / 16.0f);
            const float ang = (float)pos * inv;
            rope[2 * i] = cosf(ang); rope[2 * i + 1] = sinf(ang);
        }
    }
}

__device__ __forceinline__ const float* mods_row(const Params& p, int layer, int m) {
    const int r = m < NLAT ? (m >> 13) : 2;
    return (const float*)(p.ws + WS_MODS) + ((size_t)layer * 3 + r) * 6144;
}
__device__ __forceinline__ void load_row(const float* x, int lane, f32x4 (&v)[4]) {
#pragma unroll
    for (int j = 0; j < 4; ++j) v[j] = ((const f32x4*)x)[lane + 64 * j];
}
__device__ __forceinline__ float row_rstd(const f32x4 (&v)[4]) {
    float s = 0.f;
#pragma unroll
    for (int j = 0; j < 4; ++j) s += (v[j].x * v[j].x + v[j].y * v[j].y) + (v[j].z * v[j].z + v[j].w * v[j].w);
    return 1.0f / sqrtf(wave_sum(s) * (1.0f / 1024.0f) + 1e-6f);
}
__device__ __forceinline__ void normmod(const f32x4 (&h)[4], const float* g, const float* shift, const float* scale, int lane, f32x4 (&a)[4]) {
    const float rstd = row_rstd(h);
#pragma unroll
    for (int j = 0; j < 4; ++j) {
        const f32x4 gg = ((const f32x4*)g)[lane + 64 * j], sh = ((const f32x4*)shift)[lane + 64 * j], sc = ((const f32x4*)scale)[lane + 64 * j];
        a[j] = (h[j] * rstd * gg) * (sc + 1.0f) + sh;
    }
}
__device__ __forceinline__ void store_row_bf16(bf16_t* o, int lane, const f32x4 (&a)[4]) {
#pragma unroll
    for (int j = 0; j < 4; ++j) { u32x2 w; w.x = pk2(a[j].x, a[j].y); w.y = pk2(a[j].z, a[j].w); ((u32x2*)o)[lane + 64 * j] = w; }
}
__device__ __forceinline__ const float* h_in_row(const Params& p, int layer, int m) {
    if (layer == 0) return m < NLAT ? p.in[0] + (size_t)m * 1024 : p.in[2] + (size_t)(m - NLAT) * 1024;
    return m < NLAT ? p.out + (size_t)m * 1024 : (const float*)(p.ws + WS_HCTX) + (size_t)(m - NLAT) * 1024;
}
__device__ __forceinline__ float* h_out_row(const Params& p, int m) { return m < NLAT ? p.out + (size_t)m * 1024 : (float*)(p.ws + WS_HCTX) + (size_t)(m - NLAT) * 1024; }

__device__ __forceinline__ void premix_phase(const Params& p, int layer, bool first, int M, int gw, int NGW, int lane) {
    bf16_t* XN = (bf16_t*)(p.ws + WS_XN);
    for (int m = gw; m < M; m += NGW) {
        const float* hr = first ? h_in_row(p, 0, m) : h_out_row(p, m);
        f32x4 h[4], a[4]; load_row(hr, lane, h);
        const float* md = mods_row(p, layer, m);
        normmod(h, p.in[6] + layer * 1024, md, md + 1024, lane, a);
        store_row_bf16(XN + (size_t)m * 1024, lane, a);
    }
}
__device__ __forceinline__ void load_row_bf16(const bf16_t* x, int lane, f32x4 (&v)[4]) {
#pragma unroll
    for (int j = 0; j < 4; ++j) { const u32x2 w = ((const u32x2*)x)[lane + 64 * j]; v[j] = (f32x4){bflo(w.x), bfhi(w.x), bflo(w.y), bfhi(w.y)}; }
}
__device__ __forceinline__ void residual_phase(const Params& p, const bf16_t* src, const bf16_t* src2, const float* hin_base_layer0, bool hin_is_input, int layer, int gate_idx, const float* g1,
                                               bool write_xn, const float* g2, int mod_layer2, int shift_idx, bool route, int M, int gw, int NGW, int lane) {
    bf16_t* XN = (bf16_t*)(p.ws + (route ? WS_XN2 : WS_XN));
    for (int m = gw; m < M; m += NGW) {
        const float* hr = hin_is_input ? h_in_row(p, 0, m) : h_out_row(p, m);
        f32x4 h[4], s[4]; load_row(hr, lane, h); load_row_bf16(src + (size_t)m * 1024, lane, s);
        if (src2) { f32x4 s2[4]; load_row_bf16(src2 + (size_t)m * 1024, lane, s2);
#pragma unroll
            for (int j = 0; j < 4; ++j) s[j] += s2[j]; }
        const float rstd = row_rstd(s);
        const float* md = mods_row(p, layer, m);
#pragma unroll
        for (int j = 0; j < 4; ++j) {
            const f32x4 gg = ((const f32x4*)g1)[lane + 64 * j], gt = ((const f32x4*)(md + gate_idx * 1024))[lane + 64 * j];
            h[j] = h[j] + gt * (s[j] * rstd * gg);
        }
        float* ho = h_out_row(p, m);
#pragma unroll
        for (int j = 0; j < 4; ++j) ((f32x4*)ho)[lane + 64 * j] = h[j];
        if (write_xn) {
            f32x4 a[4]; const float* md2 = mods_row(p, mod_layer2, m);
            normmod(h, g2, md2 + shift_idx * 1024, md2 + (shift_idx + 1) * 1024, lane, a);
            store_row_bf16(XN + (size_t)m * 1024, lane, a);
            if (route) {
                const float* rw = p.in[33];
                float lg[8] = {0.f, 0.f, 0.f, 0.f, 0.f, 0.f, 0.f, 0.f};
#pragma unroll
                for (int j = 0; j < 4; ++j)
#pragma unroll
                    for (int q = 0; q < 4; ++q) {
                        const int k = 4 * (lane + 64 * j) + q; const float av = a[j][q];
                        const f32x4 w0 = ((const f32x4*)(rw + (size_t)k * 8))[0], w1 = ((const f32x4*)(rw + (size_t)k * 8))[1];
                        lg[0] += av * w0.x; lg[1] += av * w0.y; lg[2] += av * w0.z; lg[3] += av * w0.w; lg[4] += av * w1.x; lg[5] += av * w1.y; lg[6] += av * w1.z; lg[7] += av * w1.w;
                    }
#pragma unroll
                for (int e = 0; e < 8; ++e) lg[e] = wave_sum(lg[e]);
                int i1 = 0; float v1 = lg[0];
#pragma unroll
                for (int e = 1; e < 8; ++e) if (lg[e] > v1) { v1 = lg[e]; i1 = e; }
                int i2 = -1; float v2 = -3.0e38f;
#pragma unroll
                for (int e = 0; e < 8; ++e) if (e != i1 && lg[e] > v2) { v2 = lg[e]; i2 = e; }
                if (lane == 0) {
                    const float w1 = 1.0f / (1.0f + expf(v2 - v1)), w2 = 1.0f - w1;
                    unsigned* cnt = (unsigned*)(p.ws + WS_CTL) + CW_CNT; int* LIST = (int*)(p.ws + WS_LIST); float* WTS = (float*)(p.ws + WS_WTS);
                    const unsigned s1 = atomicAdd(cnt + i1, 1u); LIST[i1 * 16384 + s1] = m * 2; WTS[i1 * 16384 + s1] = w1;
                    const unsigned s2 = atomicAdd(cnt + i2, 1u); LIST[i2 * 16384 + s2] = m * 2 + 1; WTS[i2 * 16384 + s2] = w2;
                }
            }
        }
    }
}

using pg8::Unit;
constexpr float QSCALE = 0.125f * 1.4426950408889634f;
__device__ __forceinline__ u32x2 pack4(const f32x4 v) { u32x2 w; w.x = pk2(v.x, v.y); w.y = pk2(v.z, v.w); return w; }
__device__ __forceinline__ f32x4 unpack4(const u32x2 w) { return (f32x4){bflo(w.x), bfhi(w.x), bflo(w.y), bfhi(w.y)}; }

struct EpiIn {
    static constexpr bool PERM = false, AFTER_DRAIN = false;
    bf16_t* P; bf16_t* VTS; bf16_t* VTD; const float* rope;
    __device__ __forceinline__ void operator()(const f32x4 (&acc)[2][2][4][2], const Unit& u, int wr, int wc, int fr, int fq) const {
#pragma unroll
        for (int ai = 0; ai < 2; ++ai)
#pragma unroll
            for (int m = 0; m < 4; ++m) {
                const int r = u.pm * 256 + ai * 128 + wr * 64 + m * 16 + fr;
                const bool lat = r < NLAT;
                const int t = r & (SEQ - 1);
                const int b = lat ? (r >> 13) : ((r - NLAT) >> 8);
                const int key = lat ? t : SEQ + ((r - NLAT) & 255);
#pragma unroll
                for (int bj = 0; bj < 2; ++bj) {
                    const int c32 = u.pn * 256 + bj * 128 + wc * 32;
                    f32x4 v0 = acc[ai][bj][m][0], v1 = acc[ai][bj][m][1];
                    if (c32 < PP) {
                        const bool rp = (c32 < IC_RW) || (c32 >= IC_QD);
                        if (rp && lat) {
                            const int pos = (c32 & 32) ? (t & 63) : (t >> 6);
                            const f32x4 cs0 = *(const f32x4*)(rope + (pos * 16 + 4 * fq) * 2), cs1 = *(const f32x4*)(rope + (pos * 16 + 4 * fq) * 2 + 4);
                            const f32x4 cc = (f32x4){cs0.x, cs0.z, cs1.x, cs1.z}, sn = (f32x4){cs0.y, cs0.w, cs1.y, cs1.w};
                            const f32x4 o0 = v0 * cc - v1 * sn, o1 = v0 * sn + v1 * cc;
                            v0 = o0; v1 = o1;
                        }
                        if (c32 < IC_KS || (c32 >= IC_QD && c32 < IC_KD)) { v0 = v0 * QSCALE; v1 = v1 * QSCALE; }
                        bf16_t* dst = P + (size_t)r * PP + c32 + 4 * fq;
                        *(u32x2*)dst = pack4(v0); *(u32x2*)(dst + 16) = pack4(v1);
                    } else {
                        const int cv = c32 - PP;
                        bf16_t* vt = nullptr; int dimbase = 0;
                        if (cv < 128) { vt = VTS + (size_t)((b * 2 + (cv >> 6)) * 64) * KEYS; dimbase = cv & 63; }
                        else if (cv < 640) { const int cd = cv - 128; vt = VTD + (size_t)((b * 4 + (cd >> 7)) * 128) * KEYS; dimbase = cd & 127; }
                        if (vt) {
#pragma unroll
                            for (int i = 0; i < 4; ++i) {
                                vt[(size_t)(dimbase + 4 * fq + i) * KEYS + key] = (bf16_t)f2bf(v0[i]);
                                vt[(size_t)(dimbase + 16 + 4 * fq + i) * KEYS + key] = (bf16_t)f2bf(v1[i]);
                            }
                        }
                    }
                }
            }
    }
};

struct EpiLora {
    static constexpr bool PERM = false, AFTER_DRAIN = false;
    float* ST; bf16_t* P; const float* w0; const float* a0;
    __device__ __forceinline__ void operator()(const f32x4 (&acc)[2][2][4][2], const Unit& u, int wr, int wc, int fr, int fq) const {
        const int reg = u.pn >> 1;
#pragma unroll
        for (int ai = 0; ai < 2; ++ai)
#pragma unroll
            for (int m = 0; m < 4; ++m) {
                const int r = u.pm * 256 + ai * 128 + wr * 64 + m * 16 + fr;
#pragma unroll
                for (int bj = 0; bj < 2; ++bj)
#pragma unroll
                    for (int n = 0; n < 2; ++n) {
                        const int ch = (u.pn & 1) * 256 + bj * 128 + wc * 32 + 16 * n + 4 * fq;
                        const int h = ch >> 6, kidx = ch & 63;
                        float* sp = ST + ((size_t)r * 8 + h) * (ST_SLOTS * 64) + kidx;
                        const f32x4 a = acc[ai][bj][m][n];
                        if (reg < 2) {
                            const f32x4 bias = *(const f32x4*)(w0 + reg * 512 + ch);
                            f32x4 o;
#pragma unroll
                            for (int i = 0; i < 4; ++i) {
                                const float x = -(bias[i] + a[i]);
                                const float sp_ = fmaxf(x, 0.f) + __logf(1.0f + __expf(-fabsf(x)));
                                o[i] = __expf(-__expf(-sp_ - 0.5f));
                            }
                            *(f32x4*)(sp + (reg ? SL_W1 : SL_W0) * 64) = o;
                        } else if (reg < 4) {
                            const int d = reg - 2;
                            const f32x4 bias = *(const f32x4*)(a0 + d * 512 + ch);
                            *(f32x4*)(sp + (d ? SL_A1 : SL_A0) * 64) = (f32x4){sigmoidf_(bias[0] + a[0]), sigmoidf_(bias[1] + a[1]), sigmoidf_(bias[2] + a[2]), sigmoidf_(bias[3] + a[3])};
                        } else {
                            *(u32x2*)(P + (size_t)r * PP + IC_RW + ch) = pack4(a);
                        }
                        asm volatile("" ::: "memory");
                    }
            }
    }
};

struct LoraSched {
    pg8::StaticOrder S;
    __device__ __forceinline__ bool next(int i, Unit& u) const { if (!S.next(i, u)) return false; const int reg = u.pn >> 1; u.koff = 128 * (reg < 4 ? (reg >> 1) : 2); return true; }
    __device__ __forceinline__ void a_ready(const Unit&) const {}
    __device__ __forceinline__ void done(const Unit&) const {}
};
struct EpiGate {
    static constexpr bool PERM = true, AFTER_DRAIN = false;
    bf16_t* G;
    __device__ __forceinline__ void operator()(const f32x4 (&acc)[2][2][4][2], const Unit& u, int wr, int wc, int fr, int fq) const {
#pragma unroll
        for (int ai = 0; ai < 2; ++ai)
#pragma unroll
            for (int m = 0; m < 4; ++m) {
                const int r = u.pm * 256 + ai * 128 + wr * 64 + m * 16 + fr;
#pragma unroll
                for (int bj = 0; bj < 2; ++bj) {
                    const int c = u.pn * 256 + bj * 128 + wc * 32 + 8 * fq;
                    const f32x4 a0 = acc[ai][bj][m][0], a1 = acc[ai][bj][m][1];
                    u32x4 w; w.x = pk2(sigmoidf_(a0.x), sigmoidf_(a0.y)); w.y = pk2(sigmoidf_(a0.z), sigmoidf_(a0.w)); w.z = pk2(sigmoidf_(a1.x), sigmoidf_(a1.y)); w.w = pk2(sigmoidf_(a1.z), sigmoidf_(a1.w));
                    *(u32x4*)(G + (size_t)r * 3072 + c) = w;
                }
            }
    }
};

template <int PASS> struct EpiMerge {
    static constexpr bool PERM = false, AFTER_DRAIN = false;
    const bf16_t* G; bf16_t* MF; bf16_t* MB;
    __device__ __forceinline__ void operator()(const f32x4 (&acc)[2][2][4][2], const Unit& u, int wr, int wc, int fr, int fq) const {
#pragma unroll
        for (int ai = 0; ai < 2; ++ai)
#pragma unroll
            for (int m = 0; m < 4; ++m) {
                const int r = u.pm * 256 + ai * 128 + wr * 64 + m * 16 + fr;
#pragma unroll
                for (int bj = 0; bj < 2; ++bj)
#pragma unroll
                    for (int n = 0; n < 2; ++n) {
                        const int c = u.pn * 256 + bj * 128 + wc * 32 + 16 * n + 4 * fq;
                        const f32x4 g = unpack4(*(const u32x2*)(G + (size_t)r * 3072 + PASS * 1024 + c));
                        f32x4 v = g * acc[ai][bj][m][n];
                        bf16_t* mp = MF + (size_t)r * 1024 + c;
                        if (PASS > 0) v += unpack4(*(const u32x2*)mp);
                        *(u32x2*)(PASS < 2 ? mp : MB + (size_t)r * 1024 + c) = pack4(v);
                    }
            }
    }
};

struct EpiBf {
    static constexpr bool PERM = true, AFTER_DRAIN = false;
    bf16_t* O; int ldc;
    __device__ __forceinline__ void operator()(const f32x4 (&acc)[2][2][4][2], const Unit& u, int wr, int wc, int fr, int fq) const {
#pragma unroll
        for (int ai = 0; ai < 2; ++ai)
#pragma unroll
            for (int m = 0; m < 4; ++m) {
                const int r = u.pm * 256 + ai * 128 + wr * 64 + m * 16 + fr;
#pragma unroll
                for (int bj = 0; bj < 2; ++bj) {
                    const int c = u.pn * 256 + bj * 128 + wc * 32 + 8 * fq;
                    const f32x4 a0 = acc[ai][bj][m][0], a1 = acc[ai][bj][m][1];
                    u32x4 w; w.x = pk2(a0.x, a0.y); w.y = pk2(a0.z, a0.w); w.z = pk2(a1.x, a1.y); w.w = pk2(a1.z, a1.w);
                    *(u32x4*)(O + (size_t)r * ldc + c) = w;
                }
            }
    }
};

struct EpiSwiglu {
    static constexpr bool PERM = true, AFTER_DRAIN = false;
    bf16_t* H; int ldh; int npn; int pm_sub;
    __device__ __forceinline__ void operator()(const f32x4 (&acc)[2][2][4][2], const Unit& u, int wr, int wc, int fr, int fq) const {
        const int pnn = u.pn % npn;
#pragma unroll
        for (int ai = 0; ai < 2; ++ai)
#pragma unroll
            for (int m = 0; m < 4; ++m) {
                const int r = (u.pm - pm_sub) * 256 + ai * 128 + wr * 64 + m * 16 + fr;
                const int hc = pnn * 128 + wc * 32 + 8 * fq;
                const f32x4 g0 = acc[ai][0][m][0], g1 = acc[ai][0][m][1], u0 = acc[ai][1][m][0], u1 = acc[ai][1][m][1];
                u32x4 w; w.x = pk2(siluf_(g0.x) * u0.x, siluf_(g0.y) * u0.y); w.y = pk2(siluf_(g0.z) * u0.z, siluf_(g0.w) * u0.w);
                w.z = pk2(siluf_(g1.x) * u1.x, siluf_(g1.y) * u1.y); w.w = pk2(siluf_(g1.z) * u1.z, siluf_(g1.w) * u1.w);
                *(u32x4*)(H + (size_t)r * ldh + hc) = w;
            }
    }
};

struct MoeSched {
    int ts[9]; int pm_lo, pm_hi, npn, G, c; bool a_local;
    __device__ __forceinline__ int expert_of(int pm) const { int e = 0;
#pragma unroll
        for (int q = 1; q < 8; ++q) e += (pm >= ts[q]) ? 1 : 0;
        return e; }
    __device__ __forceinline__ bool next(int i, Unit& u) const {
        const int n = (pm_hi - pm_lo) * npn; const long L = (long)i * G + c; if (L >= n) return false;
        const int pm = pm_lo + (int)L / npn, pnn = (int)L % npn;
        u.pm = a_local ? pm - pm_lo : pm; u.pn = expert_of(pm) * npn + pnn; u.koff = 0; u.tail = -1; return true;
    }
    __device__ __forceinline__ void a_ready(const Unit&) const {}
    __device__ __forceinline__ void done(const Unit&) const {}
};
struct EpiMoeDown {
    static constexpr bool PERM = false, AFTER_DRAIN = false;
    bf16_t* FS; long slot1_off; const int* LIST; const float* WTS; const unsigned* cnt; int ts[9]; int pm_lo;
    __device__ __forceinline__ void operator()(const f32x4 (&acc)[2][2][4][2], const Unit& u, int wr, int wc, int fr, int fq) const {
        const int e = u.pn >> 2, pnn = u.pn & 3, pmg = u.pm + pm_lo;
        int tse = 0;
#pragma unroll
        for (int q = 0; q < 8; ++q) tse = (q == e) ? ts[q] : tse;
        const int ne = (int)cnt[e];
#pragma unroll
        for (int ai = 0; ai < 2; ++ai)
#pragma unroll
            for (int m = 0; m < 4; ++m) {
                const int slot = (pmg - tse) * 256 + ai * 128 + wr * 64 + m * 16 + fr;
                if (slot < ne) {
                    const int tk = LIST[e * 16384 + slot]; const float w = WTS[e * 16384 + slot];
                    bf16_t* dst = FS + (long)(tk & 1) * slot1_off + (size_t)(tk >> 1) * 1024 + pnn * 256 + wc * 32 + 4 * fq;
#pragma unroll
                    for (int bj = 0; bj < 2; ++bj)
#pragma unroll
                        for (int n = 0; n < 2; ++n) *(u32x2*)(dst + bj * 128 + 16 * n) = pack4(acc[ai][bj][m][n] * w);
                }
            }
    }
};

constexpr float SC2 = 0.125f * 1.4426950408889634f;
constexpr int ATT_ROW = 144, ATT_VOFF = 9216, ATT_BUF = 27648;
constexpr float ATT_THR = 6.0f;
__device__ __forceinline__ float xhalf_max(float v) { auto rr = __builtin_amdgcn_permlane32_swap(__float_as_uint(v), __float_as_uint(v), false, false); return fmaxf(__uint_as_float(rr[0]), __uint_as_float(rr[1])); }
__device__ __forceinline__ float xhalf_sum(float v) { auto rr = __builtin_amdgcn_permlane32_swap(__float_as_uint(v), __float_as_uint(v), false, false); return __uint_as_float(rr[0]) + __uint_as_float(rr[1]); }

template <int DV, bool WINDOW>
__device__ __forceinline__ void attn_pass(LAS unsigned char* lds, const bf16_t* __restrict__ P, int qrow0, int qcol, int kcol, const bf16_t* __restrict__ VT,
                                          int lat_row0, int ctx_row0, int tile_lo, int tile_hi, bool has_ref, float m0, float l0, int qpos0,
                                          f32x16 (&o)[DV / 32], float& l_out, int wave, int lane) {
    int tid_ = threadIdx.x; asm volatile("" : "+v"(tid_)); const int tid = tid_; lane = tid & 63; const int qn = lane & 31, half = lane >> 5;
    bf16x8 qf[4];
    { const bf16_t* qp = P + (size_t)(qrow0 + wave * 32 + qn) * PP + qcol + half * 8;
#pragma unroll
      for (int ks = 0; ks < 4; ++ks) qf[ks] = *(const bf16x8*)(qp + ks * 16); }
    float mrun = has_ref ? m0 : 0.f, lrun = (half == 0) ? l0 : 0.f;
    bool need_ref = !has_ref;
    f32x16 negm;
#pragma unroll
    for (int i = 0; i < 16; ++i) negm[i] = -mrun;
#pragma unroll
    for (int db = 0; db < DV / 32; ++db)
#pragma unroll
        for (int i = 0; i < 16; ++i) o[db][i] = 0.f;
    const int nlat = tile_hi - tile_lo, nt = nlat + 4;
    u32x4 kreg[1], vreg[1][DV / 64];
    const int skey = tid >> 3, spc = tid & 7;
#define ATT_LOAD(ti_, set_) do { const int id_ = (ti_) < nlat ? tile_lo + (ti_) : 128 + ((ti_) - nlat); \
        const int krow0_ = id_ < 128 ? lat_row0 + 64 * id_ : ctx_row0 + 64 * (id_ - 128); \
        kreg[set_] = *(const u32x4*)(P + (size_t)(krow0_ + skey) * PP + kcol + spc * 8); \
        _Pragma("unroll") for (int j_ = 0; j_ < DV / 64; ++j_) { const int idx_ = tid + 512 * j_; vreg[set_][j_] = *(const u32x4*)(VT + (size_t)(idx_ >> 3) * KEYS + 64 * id_ + (idx_ & 7) * 8); } } while (0)
#define ATT_STORE(buf_, set_) do { LAS unsigned char* b_ = lds + (buf_) * ATT_BUF; *(LAS u32x4*)(b_ + skey * ATT_ROW + spc * 16) = kreg[set_]; \
        _Pragma("unroll") for (int j_ = 0; j_ < DV / 64; ++j_) { const int idx_ = tid + 512 * j_, dim_ = idx_ >> 3; *(LAS u32x4*)(b_ + ATT_VOFF + dim_ * ATT_ROW + (((idx_ & 7) ^ ((dim_ >> 4) & 1)) * 16)) = vreg[set_][j_]; } } while (0)
    __syncthreads();
    ATT_LOAD(0, 0); ATT_STORE(0, 0);
    if (nt > 1) ATT_LOAD(1, 0);
    __syncthreads();
    for (int ti0 = 0; ti0 < nt; ti0 += 1) {
#pragma unroll
      for (int dd = 0; dd < 1; ++dd) {
        const int ti = ti0 + dd;
        if (ti < nt) {
        const LAS unsigned char* Ks = lds + (ti & 1) * ATT_BUF; const LAS unsigned char* Vs = Ks + ATT_VOFF;
        const int id = ti < nlat ? tile_lo + ti : 128 + (ti - nlat);
        const bool islat = id < 128;
        bool skip = false;
        if (WINDOW && islat) { const int qw = qpos0 + wave * 32; skip = (64 * id + 63 < qw - 128 || 64 * id > qw + 31 + 128); }
        if (!skip) {
        f32x16 s[2];
#pragma unroll
        for (int mb = 0; mb < 2; ++mb) {
#pragma unroll
            for (int ks = 0; ks < 4; ++ks) {
                const bf16x8 kf = *(const LAS bf16x8*)(Ks + (32 * mb + qn) * ATT_ROW + ks * 32 + half * 16);
                if (ks == 0) s[mb] = __builtin_amdgcn_mfma_f32_32x32x16_bf16(kf, qf[0], negm, 0, 0, 0);
                else s[mb] = __builtin_amdgcn_mfma_f32_32x32x16_bf16(kf, qf[ks], s[mb], 0, 0, 0);
            }
        }
        if (WINDOW && islat) {
            const int qpos = qpos0 + wave * 32 + qn;
#pragma unroll
            for (int mb = 0; mb < 2; ++mb)
#pragma unroll
                for (int i = 0; i < 16; ++i) { const int d = 64 * id + 32 * mb + 8 * (i >> 2) + 4 * half + (i & 3) - qpos; if (d > 128 || d < -128) s[mb][i] = -INFINITY; }
        }
        float mx = s[0][0];
#pragma unroll
        for (int mb = 0; mb < 2; ++mb)
#pragma unroll
            for (int i = 0; i < 16; ++i) mx = fmaxf(mx, s[mb][i]);
        mx = xhalf_max(mx);
        if (__builtin_expect(need_ref || __any(mx > ATT_THR), 0)) {
            const float delta = need_ref ? mx : fmaxf(mx, 0.f);
            if (!need_ref) {
                const float alpha = __builtin_amdgcn_exp2f(-delta);
                lrun *= alpha;
#pragma unroll
                for (int db = 0; db < DV / 32; ++db)
#pragma unroll
                    for (int i = 0; i < 16; ++i) o[db][i] *= alpha;
            }
            mrun += delta; need_ref = false;
#pragma unroll
            for (int mb = 0; mb < 2; ++mb)
#pragma unroll
                for (int i = 0; i < 16; ++i) s[mb][i] -= delta;
#pragma unroll
            for (int i = 0; i < 16; ++i) negm[i] = -mrun;
        }
        float rs = 0.f;
#pragma unroll
        for (int mb = 0; mb < 2; ++mb)
#pragma unroll
            for (int i = 0; i < 16; ++i) { const float pv = __builtin_amdgcn_exp2f(s[mb][i]); s[mb][i] = pv; rs += pv; }
        lrun += rs;
#pragma unroll
        for (int g = 0; g < 4; ++g) {
            const int mb = g >> 1, bs = 8 * (g & 1);
            u32x4 pw; pw.x = pk2(s[mb][bs + 0], s[mb][bs + 1]); pw.y = pk2(s[mb][bs + 2], s[mb][bs + 3]); pw.z = pk2(s[mb][bs + 4], s[mb][bs + 5]); pw.w = pk2(s[mb][bs + 6], s[mb][bs + 7]);
            const bf16x8 pf = __builtin_bit_cast(bf16x8, pw);
#pragma unroll
            for (int db = 0; db < DV / 32; ++db) {
                const int dim = 32 * db + qn, sw = (dim >> 4) & 1;
                const LAS unsigned char* vrow = Vs + dim * ATT_ROW + 8 * half;
                const u32x2 lo = *(const LAS u32x2*)(vrow + (((2 * g) ^ sw) * 16)), hi = *(const LAS u32x2*)(vrow + (((2 * g + 1) ^ sw) * 16));
                const u32x4 vw = (u32x4){lo.x, lo.y, hi.x, hi.y};
                o[db] = __builtin_amdgcn_mfma_f32_32x32x16_bf16(__builtin_bit_cast(bf16x8, vw), pf, o[db], 0, 0, 0);
            }
        }
        }
        if (ti + 1 < nt) { ATT_STORE((ti + 1) & 1, 0); if (ti + 2 < nt) ATT_LOAD(ti + 2, 0); }
        __syncthreads();
        }
      }
    }
#undef ATT_LOAD
#undef ATT_STORE
    l_out = xhalf_sum(lrun);
}

__device__ __forceinline__ void swa_unit(LAS unsigned char* lds, const Params& p, int layer, int b, int hq, int qb, bool ctx, int wave, int lane, bool dry = false) {
    bf16_t* P = (bf16_t*)(p.ws + WS_P);
    const int kvh = hq >> 2;
    const bf16_t* VT = (const bf16_t*)(p.ws + WS_VTS) + (size_t)((b * 2 + kvh) * 64) * KEYS;
    const float sink2 = p.in[11][layer * 8 + hq] * 1.4426950408889634f;
    const int qrow0 = ctx ? NLAT + b * CTXL : b * SEQ + qb * 256;
    f32x16 o[2]; float l;
    if (ctx) attn_pass<64, false>(lds, P, qrow0, IC_QS + hq * 64, IC_KS + kvh * 64, VT, b * SEQ, NLAT + b * CTXL, 0, 0, true, sink2, 1.0f, 0, o, l, wave, lane);
    else {
        int lo = 4 * qb - 2; if (lo < 0) lo = 0; int hi = 4 * qb + 6; if (hi > 128) hi = 128;
        attn_pass<64, true>(lds, P, qrow0, IC_QS + hq * 64, IC_KS + kvh * 64, VT, b * SEQ, NLAT + b * CTXL, lo, hi, true, sink2, 1.0f, qb * 256, o, l, wave, lane);
    }
    const float inv = 1.0f / l; const int qn = lane & 31, half = lane >> 5;
    bf16_t* dst = P + (size_t)(qrow0 + wave * 32 + qn) * PP + IC_QS + hq * 64 + 4 * half;
#pragma unroll
    for (int db = 0; db < 2; ++db)
#pragma unroll
        for (int q4 = 0; q4 < 4; ++q4) {
            const f32x4 v = (f32x4){o[db][4 * q4] * inv, o[db][4 * q4 + 1] * inv, o[db][4 * q4 + 2] * inv, o[db][4 * q4 + 3] * inv};
            if (!dry) *(u32x2*)(dst + 32 * db + 8 * q4) = pack4(v);
        }
}
__device__ __forceinline__ void diff_unit(LAS unsigned char* lds, const Params& p, float lam, int b, int h, int qb, bool ctx, int wave, int lane, bool dry = false) {
    bf16_t* P = (bf16_t*)(p.ws + WS_P);
    const bf16_t* VT = (const bf16_t*)(p.ws + WS_VTD) + (size_t)((b * 4 + h) * 128) * KEYS;
    const int qrow0 = ctx ? NLAT + b * CTXL : b * SEQ + qb * 256;
    const int thi = ctx ? 0 : 128;
    LAS unsigned* park = (LAS unsigned*)(lds + 73728) + threadIdx.x;
    f32x16 o[4]; float l;
    attn_pass<128, false>(lds, P, qrow0, IC_QD + h * 128, IC_KD + h * 128, VT, b * SEQ, NLAT + b * CTXL, 0, thi, false, 0.f, 0.f, 0, o, l, wave, lane);
    { const float inv = 1.0f / l;
#pragma unroll
      for (int db = 0; db < 4; ++db)
#pragma unroll
          for (int i = 0; i < 8; ++i) park[(db * 8 + i) * 512] = pk2(o[db][2 * i] * inv, o[db][2 * i + 1] * inv); }
    attn_pass<128, false>(lds, P, qrow0, IC_QD + h * 128 + 64, IC_KD + h * 128 + 64, VT, b * SEQ, NLAT + b * CTXL, 0, thi, false, 0.f, 0.f, 0, o, l, wave, lane);
    const float inv = lam / l; const int qn = lane & 31, half = lane >> 5;
    bf16_t* dst = P + (size_t)(qrow0 + wave * 32 + qn) * PP + IC_QD + h * 128 + 4 * half;
#pragma unroll
    for (int db = 0; db < 4; ++db)
#pragma unroll
        for (int q4 = 0; q4 < 4; ++q4) {
            const unsigned pa = park[(db * 8 + 2 * q4) * 512], pb = park[(db * 8 + 2 * q4 + 1) * 512];
            const f32x4 v = (f32x4){bflo(pa) - o[db][4 * q4] * inv, bfhi(pa) - o[db][4 * q4 + 1] * inv, bflo(pb) - o[db][4 * q4 + 2] * inv, bfhi(pb) - o[db][4 * q4 + 3] * inv};
            if (!dry) *(u32x2*)(dst + 32 * db + 8 * q4) = pack4(v);
        }
}

__device__ __forceinline__ void ld8bf(const bf16_t* p, float (&v)[8]) { const u32x4 w = *(const u32x4*)p; v[0] = bflo(w.x); v[1] = bfhi(w.x); v[2] = bflo(w.y); v[3] = bfhi(w.y); v[4] = bflo(w.z); v[5] = bfhi(w.z); v[6] = bflo(w.w); v[7] = bfhi(w.w); }
__device__ __forceinline__ void ld8f(const float* p, float (&v)[8]) { const f32x4 a = ((const f32x4*)p)[0], b = ((const f32x4*)p)[1]; v[0] = a.x; v[1] = a.y; v[2] = a.z; v[3] = a.w; v[4] = b.x; v[5] = b.y; v[6] = b.z; v[7] = b.w; }
__device__ __forceinline__ void st8f(float* p, const float (&v)[8]) { ((f32x4*)p)[0] = (f32x4){v[0], v[1], v[2], v[3]}; ((f32x4*)p)[1] = (f32x4){v[4], v[5], v[6], v[7]}; }

__device__ __forceinline__ void rwkv_prepare_phase(const Params& p, int layer, int gw, int NGW, int lane) {
    const bf16_t* P = (const bf16_t*)(p.ws + WS_P); float* ST = (float*)(p.ws + WS_ST); bf16_t* A2 = (bf16_t*)(p.ws + WS_YA);
    const float* mup = p.in[12] + layer * 1920; const float* mun = p.in[13] + layer * 1920; const float* k_k = p.in[19] + layer * 512;
    for (int m = gw; m < NTOK; m += NGW) {
        const int t = m < NLAT ? (m & (SEQ - 1)) : ((m - NLAT) & (CTXL - 1)), len = m < NLAT ? SEQ : CTXL;
        const bool hp = t > 0, hn = t < len - 1;
        const bf16_t* pr = P + (size_t)m * PP + IC_RW;
        const int h = lane >> 3, kidx = (lane & 7) * 8;
        float* sp = ST + ((size_t)m * 8 + h) * (ST_SLOTS * 64) + kidx;
#pragma unroll
        for (int sec = 0; sec < 4; ++sec) {
            if (sec == 3 && lane >= 48) break;
            const int col = sec < 3 ? sec * 512 + lane * 8 : 1536 + lane * 8;
            float c[8], pv[8], nx[8], a[8], bb[8], sh[8];
            ld8bf(pr + col, c);
            if (hp) ld8bf(pr - PP + col, pv); else {
#pragma unroll
                for (int q = 0; q < 8; ++q) pv[q] = 0.f; }
            if (hn) ld8bf(pr + PP + col, nx); else {
#pragma unroll
                for (int q = 0; q < 8; ++q) nx[q] = 0.f; }
            ld8f(mup + col, a); ld8f(mun + col, bb);
#pragma unroll
            for (int q = 0; q < 8; ++q) sh[q] = c[q] + a[q] * (pv[q] - c[q]) + bb[q] * (nx[q] - c[q]);
            if (sec == 0) st8f(sp + SL_R * 64, sh);
            else if (sec == 2) st8f(sp + SL_V * 64, sh);
            else if (sec == 1) {
                st8f(sp + SL_K * 64, sh);
                float kk[8], kkw[8]; ld8f(k_k + lane * 8, kkw);
                float ss = 0.f;
#pragma unroll
                for (int q = 0; q < 8; ++q) { kk[q] = sh[q] * kkw[q]; ss += kk[q] * kk[q]; }
                ss += __shfl_xor(ss, 1); ss += __shfl_xor(ss, 2); ss += __shfl_xor(ss, 4);
                const float inv = 1.0f / fmaxf(sqrtf(ss), 1e-12f);
#pragma unroll
                for (int q = 0; q < 8; ++q) kk[q] *= inv;
                st8f(sp + SL_KK * 64, kk);
            } else {
                float o[8];
#pragma unroll
                for (int q = 0; q < 8; ++q) o[q] = lane < 16 ? tanhf(sh[q]) : (lane < 32 ? sh[q] : sigmoidf_(sh[q]));
                u32x4 w; w.x = pk2(o[0], o[1]); w.y = pk2(o[2], o[3]); w.z = pk2(o[4], o[5]); w.w = pk2(o[6], o[7]);
                *(u32x4*)(A2 + (size_t)m * 384 + lane * 8) = w;
            }
        }
    }
}

constexpr int NSEG = 64, SEGL = KEYS / NSEG;
static_assert(SEGL * NSEG == KEYS && SEGL % 4 == 0, "segments");
constexpr size_t WS_GH = WS_YA;
static_assert(WS_GH + 32ull * NSEG * 2 * 4096 * 4 <= 560 * MiB, "GH fits behind the stream");
__device__ __forceinline__ int scan_token(int b, int dir, int s) {
    if (s < CTXL) return NLAT + b * CTXL + (dir ? CTXL - 1 - s : s);
    const int t = s - CTXL; return b * SEQ + (dir ? SEQ - 1 - t : t);
}
constexpr int SRING = 6, SREC = 6 * 64 * 4;
constexpr int SCAN_LDS = SRING * SREC;
__device__ __forceinline__ void scan_dma(const float* rec, LAS unsigned char* slot, int lane) {
    const float* q = rec + lane * 4;
    __builtin_amdgcn_global_load_lds((const unsigned*)q, (LAS unsigned*)slot, 16, 0, 0);
    if (lane < 32) __builtin_amdgcn_global_load_lds((const unsigned*)(q + 256), (LAS unsigned*)(slot + 1024), 16, 0, 0);
}
template <int MODE>
__device__ __forceinline__ void rwkv_segment(const Params& p, int layer, int sid, int seg, int lane, LAS unsigned char* ring) {
    const int b = sid >> 4, h = (sid >> 1) & 7, dir = sid & 1, c = lane & 31, hf = lane >> 5;
    const float ka0 = p.in[20][layer * 512 + h * 64 + c], ka1 = p.in[20][layer * 512 + h * 64 + 32 + c];
    const float rk0 = MODE == 2 ? p.in[21][layer * 512 + h * 64 + c] : 0.f, rk1 = MODE == 2 ? p.in[21][layer * 512 + h * 64 + 32 + c] : 0.f;
    const float* ST = (const float*)(p.ws + WS_ST);
    float* gh = (float*)(p.ws + WS_GH) + ((size_t)sid * NSEG + seg) * 2 * 4096;
    f32x16 TH[2][2], TG[MODE == 0 ? 2 : 1][2];
#pragma unroll
    for (int kb = 0; kb < 2; ++kb)
#pragma unroll
        for (int vb = 0; vb < 2; ++vb) {
            if (MODE == 2 && seg > 0) {
                const float* src = gh - 4096 + (32 * vb + c) * 64 + 32 * kb + 4 * hf;
#pragma unroll
                for (int q = 0; q < 4; ++q) { const f32x4 t = *(const f32x4*)(src + 8 * q); TH[kb][vb][4 * q] = t.x; TH[kb][vb][4 * q + 1] = t.y; TH[kb][vb][4 * q + 2] = t.z; TH[kb][vb][4 * q + 3] = t.w; }
            } else {
#pragma unroll
                for (int r = 0; r < 16; ++r) TH[kb][vb][r] = 0.f;
            }
            if (MODE == 0) {
#pragma unroll
                for (int r = 0; r < 16; ++r) TG[MODE == 0 ? kb : 0][vb][r] = (32 * kb + 8 * (r >> 2) + 4 * hf + (r & 3) == 32 * vb + c) ? 1.0f : 0.0f;
            }
        }
    const int s0 = seg * SEGL, s_end = s0 + SEGL;
    const int okk = dir ? 0 : 512, od = dir ? 1024 : 0, gsl = dir ? SL_KK * 64 : 0;
#pragma unroll 1
    for (int j = 0; j < SRING - 1; ++j) scan_dma(ST + ((size_t)scan_token(b, dir, s0 + j) * 8 + h) * (ST_SLOTS * 64) + gsl, ring + j * SREC, lane);
    int slot_i = 0;
#pragma unroll 1
    for (int s = s0; s < s_end; ++s) {
        if (s + SRING - 1 < s_end) {
            int nslot = slot_i + SRING - 1; if (nslot >= SRING) nslot -= SRING;
            scan_dma(ST + ((size_t)scan_token(b, dir, s + SRING - 1) * 8 + h) * (ST_SLOTS * 64) + gsl, ring + nslot * SREC, lane);
            asm volatile("s_waitcnt vmcnt(10)" ::: "memory");
        } else asm volatile("s_waitcnt vmcnt(0)" ::: "memory");
        const LAS unsigned char* rec = ring + slot_i * SREC;
        slot_i = slot_i + 1 == SRING ? 0 : slot_i + 1;
        float ph[2] = {0.f, 0.f}, pg[2] = {0.f, 0.f};
#pragma unroll
        for (int kb = 0; kb < 2; ++kb)
#pragma unroll
            for (int q = 0; q < 4; ++q) {
                const f32x4 a4 = *(const LAS f32x4*)(rec + okk + (32 * kb + 8 * q + 4 * hf) * 4);
#pragma unroll
                for (int j = 0; j < 4; ++j)
#pragma unroll
                    for (int vb = 0; vb < 2; ++vb) { ph[vb] = fmaf(TH[kb][vb][4 * q + j], a4[j], ph[vb]); if (MODE == 0) pg[vb] = fmaf(TG[MODE == 0 ? kb : 0][vb][4 * q + j], a4[j], pg[vb]); }
            }
        float sa[2], sg[2];
#pragma unroll
        for (int vb = 0; vb < 2; ++vb) { sa[vb] = xhalf_sum(ph[vb]); sg[vb] = MODE == 0 ? xhalf_sum(pg[vb]) : 0.f; }
#pragma unroll
        for (int kb = 0; kb < 2; ++kb)
#pragma unroll
            for (int q = 0; q < 4; ++q) {
                const f32x4 w4 = *(const LAS f32x4*)(rec + od + (32 * kb + 8 * q + 4 * hf) * 4);
#pragma unroll
                for (int j = 0; j < 4; ++j)
#pragma unroll
                    for (int vb = 0; vb < 2; ++vb) { TH[kb][vb][4 * q + j] *= w4[j]; if (MODE == 0) TG[MODE == 0 ? kb : 0][vb][4 * q + j] *= w4[j]; }
            }
        float aop[2], bop[2], bopg[2];
#pragma unroll
        for (int kb = 0; kb < 2; ++kb) {
            const float ag = *(const LAS float*)(rec + od + 256 + (32 * kb + c) * 4), x = *(const LAS float*)(rec + okk + (hf ? 768 : 0) + (32 * kb + c) * 4);
            aop[kb] = x * (hf ? fmaf(ag - 1.0f, kb ? ka1 : ka0, 1.0f) : -ag);
        }
        float bonus = 0.f;
        if (MODE == 2) {
            const float r0 = *(const LAS float*)(rec + okk + 256 + c * 4), r1 = *(const LAS float*)(rec + okk + 256 + (32 + c) * 4);
            bonus = fmaf(aop[0] * r0, rk0, aop[1] * r1 * rk1);
        }
#pragma unroll
        for (int vb = 0; vb < 2; ++vb) { const float vv = *(const LAS float*)(rec + okk + 512 + (32 * vb + c) * 4); bop[vb] = hf ? vv : sa[vb]; bopg[vb] = hf ? 0.f : sg[vb]; }
#pragma unroll
        for (int kb = 0; kb < 2; ++kb)
#pragma unroll
            for (int vb = 0; vb < 2; ++vb) {
                TH[kb][vb] = __builtin_amdgcn_mfma_f32_32x32x2f32(aop[kb], bop[vb], TH[kb][vb], 0, 0, 0);
                if (MODE == 0) TG[MODE == 0 ? kb : 0][vb] = __builtin_amdgcn_mfma_f32_32x32x2f32(aop[kb], bopg[vb], TG[MODE == 0 ? kb : 0][vb], 0, 0, 0);
            }
        if (MODE == 2) {
            float py[2] = {0.f, 0.f};
#pragma unroll
            for (int kb = 0; kb < 2; ++kb)
#pragma unroll
                for (int q = 0; q < 4; ++q) {
                    const f32x4 r4 = *(const LAS f32x4*)(rec + okk + 256 + (32 * kb + 8 * q + 4 * hf) * 4);
#pragma unroll
                    for (int j = 0; j < 4; ++j)
#pragma unroll
                        for (int vb = 0; vb < 2; ++vb) py[vb] = fmaf(TH[kb][vb][4 * q + j], r4[j], py[vb]);
                }
            const float y0 = xhalf_sum(py[0]), y1 = xhalf_sum(py[1]);
            float* yp = (float*)ST + ((size_t)scan_token(b, dir, s) * 8 + h) * (ST_SLOTS * 64) + (dir ? SL_W1 : SL_W0) * 64 + c;
            if (hf == 0) { yp[0] = y0; yp[32] = y1; }
            if (hf) yp[64] = bonus;
        }
    }
    if (MODE == 0) {
#pragma unroll
        for (int kb = 0; kb < 2; ++kb)
#pragma unroll
            for (int vb = 0; vb < 2; ++vb) {
                float* dg = gh + (32 * vb + c) * 64 + 32 * kb + 4 * hf; float* dh = dg + 4096;
#pragma unroll
                for (int q = 0; q < 4; ++q) {
                    *(f32x4*)(dg + 8 * q) = (f32x4){TG[MODE == 0 ? kb : 0][vb][4 * q], TG[MODE == 0 ? kb : 0][vb][4 * q + 1], TG[MODE == 0 ? kb : 0][vb][4 * q + 2], TG[MODE == 0 ? kb : 0][vb][4 * q + 3]};
                    *(f32x4*)(dh + 8 * q) = (f32x4){TH[kb][vb][4 * q], TH[kb][vb][4 * q + 1], TH[kb][vb][4 * q + 2], TH[kb][vb][4 * q + 3]};
                }
            }
    }
}
__device__ __forceinline__ void rwkv_combine(const Params& p, int sid, LAS unsigned char* lds, int wave, int lane) {
    float* gh0 = (float*)(p.ws + WS_GH) + (size_t)sid * NSEG * 2 * 4096;
    LAS float* Sx = (LAS float*)lds;
    const int tid = wave * 64 + lane;
    for (int e = tid; e < 4096; e += NTHREADS) Sx[(e >> 6) * 65 + (e & 63)] = gh0[4096 + e];
    __syncthreads();
    const int rb = (wave >> 1) & 1, cb = wave & 1, i32 = lane & 31, hf = lane >> 5;
    for (int i = 1; i < NSEG - 1; ++i) {
        float* gi = gh0 + (size_t)i * 2 * 4096;
        f32x16 d;
        if (wave < 4) {
            float bq[32];
#pragma unroll
            for (int q = 0; q < 32; ++q) bq[q] = gi[(2 * q + hf) * 64 + 32 * cb + i32];
#pragma unroll
            for (int r = 0; r < 16; ++r) d[r] = gi[4096 + (32 * rb + 8 * (r >> 2) + 4 * hf + (r & 3)) * 64 + 32 * cb + i32];
#pragma unroll
            for (int q = 0; q < 32; ++q) {
                const float aq = Sx[(32 * rb + i32) * 65 + 2 * q + hf];
                d = __builtin_amdgcn_mfma_f32_32x32x2f32(aq, bq[q], d, 0, 0, 0);
            }
#pragma unroll
            for (int r = 0; r < 16; ++r) gi[4096 + (32 * rb + 8 * (r >> 2) + 4 * hf + (r & 3)) * 64 + 32 * cb + i32] = d[r];
        }
        __syncthreads();
        if (wave < 4) {
#pragma unroll
            for (int r = 0; r < 16; ++r) Sx[(32 * rb + 8 * (r >> 2) + 4 * hf + (r & 3)) * 65 + 32 * cb + i32] = d[r];
        }
        __syncthreads();
    }
}

__device__ __forceinline__ void postmix_phase(const Params& p, int layer, float lam_init, int M, int gw, int NGW, int lane) {
    const bf16_t* P = (const bf16_t*)(p.ws + WS_P); const float* ST = (const float*)(p.ws + WS_ST);
    bf16_t* YB = (bf16_t*)(p.ws + WS_YB); bf16_t* YC = (bf16_t*)(p.ws + WS_YC);
    const float* lng = p.in[22] + layer * 512; const float* lnb = p.in[23] + layer * 512; const float* sg = p.in[25] + layer * 128;
    for (int m = gw; m < M; m += NGW) {
        {
            const int h = lane >> 3, kidx = (lane & 7) * 8, ch = lane * 8;
            const float* sp = ST + ((size_t)m * 8 + h) * (ST_SLOTS * 64) + kidx;
            float y[8], v[8], g[8], lg[8], lb[8];
            { float yb_[8]; ld8f(sp + SL_W0 * 64, y); ld8f(sp + SL_W1 * 64, yb_);
#pragma unroll
              for (int q = 0; q < 8; ++q) y[q] += yb_[q]; }
            ld8f(sp + SL_V * 64, v); ld8f(lng + ch, lg); ld8f(lnb + ch, lb);
            ld8bf(P + (size_t)m * PP + IC_RW + ch, g);
            float s = 0.f;
#pragma unroll
            for (int q = 0; q < 8; ++q) s += y[q];
            s += __shfl_xor(s, 1); s += __shfl_xor(s, 2); s += __shfl_xor(s, 4);
            float bn;
            { const f32x4 b0 = *(const f32x4*)(sp - kidx + SL_A0 * 64 + (lane & 7) * 4), b1 = *(const f32x4*)(sp - kidx + SL_A1 * 64 + (lane & 7) * 4);
              bn = ((b0.x + b0.y) + (b0.z + b0.w)) + ((b1.x + b1.y) + (b1.z + b1.w));
              bn += __shfl_xor(bn, 1); bn += __shfl_xor(bn, 2); bn += __shfl_xor(bn, 4); }
            const float mu = s * (1.0f / 64.0f);
            float var = 0.f;
#pragma unroll
            for (int q = 0; q < 8; ++q) { const float d = y[q] - mu; var += d * d; }
            var += __shfl_xor(var, 1); var += __shfl_xor(var, 2); var += __shfl_xor(var, 4);
            const float rstd = 1.0f / sqrtf(var * (1.0f / 64.0f) + 64e-5f);
            float o[8];
#pragma unroll
            for (int q = 0; q < 8; ++q) o[q] = (((y[q] - mu) * rstd) * lg[q] + lb[q] + bn * v[q]) * g[q];
            u32x4 w; w.x = pk2(o[0], o[1]); w.y = pk2(o[2], o[3]); w.z = pk2(o[4], o[5]); w.w = pk2(o[6], o[7]);
            *(u32x4*)(YB + (size_t)m * 512 + ch) = w;
        }
        *(u32x4*)((bf16_t*)(p.ws + WS_YA) + (size_t)m * 512 + lane * 8) = *(const u32x4*)(P + (size_t)m * PP + IC_QS + lane * 8);
        {
            const int e = (lane & 15) * 8;
            float x[8], gg[8];
            ld8bf(P + (size_t)m * PP + IC_QD + lane * 8, x); ld8f(sg + e, gg);
            float ss = 0.f;
#pragma unroll
            for (int q = 0; q < 8; ++q) ss += x[q] * x[q];
            ss += __shfl_xor(ss, 1); ss += __shfl_xor(ss, 2); ss += __shfl_xor(ss, 4); ss += __shfl_xor(ss, 8);
            const float rstd = (1.0f - lam_init) / sqrtf(ss * (1.0f / 128.0f) + 1e-5f);
            float o[8];
#pragma unroll
            for (int q = 0; q < 8; ++q) o[q] = x[q] * rstd * gg[q];
            u32x4 w; w.x = pk2(o[0], o[1]); w.y = pk2(o[2], o[3]); w.z = pk2(o[4], o[5]); w.w = pk2(o[6], o[7]);
            *(u32x4*)(YC + (size_t)m * 512 + lane * 8) = w;
        }
    }
}
#define XB_TMO      128
#define XB_XCNT(j)  (256  + 64 * (j))
#define XB_XSUB(j)  (1280 + 64 * (j))
#define XB_XGEN(j)  (2304 + 64 * (j))
#define XB_TOP      3328
#define XB_TOPGEN   3392
#define XCD_BAR_WORDS 3456
#define XB_SPIN_CAP (1u << 18)

__device__ __forceinline__ unsigned xb_ld(unsigned* p)              { return __hip_atomic_load(p, __ATOMIC_RELAXED, __HIP_MEMORY_SCOPE_AGENT); }
__device__ __forceinline__ unsigned xb_add(unsigned* p, unsigned v) { return __hip_atomic_fetch_add(p, v, __ATOMIC_RELAXED, __HIP_MEMORY_SCOPE_AGENT); }
__device__ __forceinline__ unsigned xb_xcc_id() { return (unsigned)__builtin_amdgcn_s_getreg((3 << 11) | 20) & 0xFu; }
#define XB_SPIN(cond, bar) do { unsigned _sp = 0; while (cond) { __builtin_amdgcn_s_sleep(1); \
    if ((++_sp & 255u) == 0u) { if (xb_ld(&(bar)[XB_TMO])) break; if (_sp > XB_SPIN_CAP) { atomicAdd(&(bar)[XB_TMO], 1u); break; } } } } while (0)

struct XcdBarrier {
    unsigned* bar; unsigned x;
    volatile LAS unsigned* st;
};

__device__ __forceinline__ XcdBarrier xcd_barrier_post(unsigned* bar, volatile LAS unsigned* st) {
    XcdBarrier b; b.bar = bar; b.x = xb_xcc_id(); b.st = st;
    if (threadIdx.x == 0) (void)xb_add(&bar[XB_XCNT(b.x)], 1u);
    return b;
}
__device__ __forceinline__ void xcd_barrier_complete(unsigned* bar, unsigned x, unsigned& nloc, unsigned& nx) {
    const unsigned G = gridDim.x * gridDim.y * gridDim.z;
    unsigned sum, cnt, mine, sp = 0u;
    for (;;) {
        sum = 0u; cnt = 0u; mine = 0u;
#pragma unroll
        for (unsigned j = 0; j < 16; ++j) { const unsigned c = xb_ld(&bar[XB_XCNT(j)]); sum += c; cnt += (c > 0u) ? 1u : 0u; mine = (j == x) ? c : mine; }
        if (sum == G) break;
        __builtin_amdgcn_s_sleep(1);
        if ((++sp & 255u) == 0u) { if (xb_ld(&bar[XB_TMO])) break; if (sp > XB_SPIN_CAP) { atomicAdd(&bar[XB_TMO], 1u); break; } }
    }
    nloc = mine > 0u ? mine : 1u; nx = cnt > 0u ? cnt : 1u;
}

__device__ __forceinline__ void xcd_barrier(const XcdBarrier& b) {
    asm volatile("s_waitcnt vmcnt(0)" ::: "memory");
    __syncthreads();
    if (threadIdx.x == 0) {
        unsigned* bar = b.bar;
        __builtin_amdgcn_s_waitcnt(0);
        unsigned nloc = b.st[0], nx = b.st[1];
        if (nloc == 0u) { xcd_barrier_complete(bar, b.x, nloc, nx); b.st[0] = nloc; b.st[1] = nx; }
        const unsigned old = xb_add(&bar[XB_XSUB(b.x)], 1u);
        const unsigned gen = old / nloc;
        if (old + 1u == (gen + 1u) * nloc) {
            __builtin_amdgcn_fence(__ATOMIC_RELEASE, "agent");
            asm volatile("s_waitcnt vmcnt(0)" ::: "memory");
            const unsigned og = xb_add(&bar[XB_TOP], 1u);
            const unsigned tg = og / nx;
            if (og + 1u == (tg + 1u) * nx) xb_add(&bar[XB_TOPGEN], 1u);
            else XB_SPIN(xb_ld(&bar[XB_TOPGEN]) == tg, bar);
            __builtin_amdgcn_fence(__ATOMIC_ACQUIRE, "agent");
            xb_add(&bar[XB_XGEN(b.x)], 1u);
            asm volatile("s_waitcnt vmcnt(0)" ::: "memory");
        } else {
            XB_SPIN(xb_ld(&bar[XB_XGEN(b.x)]) == gen, bar);
            __builtin_amdgcn_fence(__ATOMIC_ACQUIRE, "agent");
            asm volatile("s_waitcnt vmcnt(0)" ::: "memory");
        }
    }
    __syncthreads();
}

#ifndef MK_MULTI
#define MK_MULTI 0
#endif
constexpr int N_PHASES = 40;

constexpr int LDS_PARAMS = LDS_BYTES - 1024;
constexpr int LDS_XB = LDS_BYTES - 64;
constexpr int CW_BAR = 8192;
__device__ __forceinline__ unsigned long long uni64(unsigned long long v) {
    const unsigned lo = __builtin_amdgcn_readfirstlane((unsigned)v), hi = __builtin_amdgcn_readfirstlane((unsigned)(v >> 32));
    return ((unsigned long long)hi << 32) | lo;
}
__device__ __forceinline__ int opq(int v) { asm volatile("" : "+s"(v)); return v; }
__device__ __forceinline__ void load_params(LAS unsigned char* lds, Params& q) {
    LAS const unsigned long long* s = (LAS const unsigned long long*)(lds + LDS_PARAMS);
#pragma unroll
    for (int i = 0; i < 37; ++i) q.in[i] = (const float*)(const __attribute__((address_space(1))) float*)uni64(s[i]);
    q.out = (float*)(__attribute__((address_space(1))) float*)uni64(s[37]); q.ws = (unsigned char*)(__attribute__((address_space(1))) unsigned char*)uni64(s[38]); q.ph_lo = 0; q.ph_hi = 0;
}
__global__ void __launch_bounds__(NTHREADS, 2) mk_fwd(Params kp) {
    extern __shared__ __attribute__((aligned(16))) unsigned char lds_raw[];
    LAS unsigned char* lds = (LAS unsigned char*)lds_raw;
    cg::grid_group grid = cg::this_grid();
    if (threadIdx.x == 0) {
        LAS unsigned long long* s = (LAS unsigned long long*)(lds + LDS_PARAMS);
#pragma unroll
        for (int i = 0; i < 37; ++i) s[i] = (unsigned long long)kp.in[i];
        s[37] = (unsigned long long)kp.out; s[38] = (unsigned long long)kp.ws;
    }
    if (threadIdx.x < 2) ((LAS unsigned*)(lds + LDS_XB))[threadIdx.x] = 0u;
    __syncthreads();
#if !MK_MULTI
    (void)xcd_barrier_post((unsigned*)(kp.ws + WS_CTL) + CW_BAR, (volatile LAS unsigned*)(lds + LDS_XB));
#endif
    const int ph_lo = kp.ph_lo, ph_hi = kp.ph_hi;
    int ph = 0;
#define PH_BEGIN if (ph >= ph_lo && ph < ph_hi) { asm volatile("" ::: "memory"); Params p; load_params(lds, p); unsigned char* ws = p.ws; (void)ws; \
    int tid_ = threadIdx.x, bid_ = blockIdx.x, G_ = gridDim.x; asm volatile("" : "+v"(tid_), "+s"(bid_), "+s"(G_)); \
    const int tid = tid_, bid = bid_, G = G_, lane = tid & 63, wave = __builtin_amdgcn_readfirstlane(tid >> 6); const int gw = bid * NWAVES + wave, NGW = G * NWAVES; (void)gw; (void)NGW; (void)lane; (void)tid; (void)G; (void)bid;
#define GRID_SEAM() do { if (ph == 0) grid.sync(); else { XcdBarrier xb_; xb_.bar = (unsigned*)((unsigned char*)(__attribute__((address_space(1))) unsigned char*)uni64(((LAS const unsigned long long*)(lds + LDS_PARAMS))[38]) + WS_CTL) + CW_BAR; \
        xb_.x = xb_xcc_id(); xb_.st = (volatile LAS unsigned*)(lds + LDS_XB); xcd_barrier(xb_); } } while (0)
#define PH_END } if (ph >= ph_lo && ph + 1 < ph_hi) GRID_SEAM(); ++ph;

    using pg8::Gemm; using pg8::StaticOrder; using pg8::gemm_phase;

    PH_BEGIN
        convert_layer_weights(p, 0, lds, gw, NGW, wave, lane);
        __syncthreads();
        adaln_phase(p, lds, wave, lane);
    PH_END
    PH_BEGIN
        premix_phase(p, 0, true, NTOK, gw, NGW, lane);
    PH_END

#pragma clang loop unroll(full)
    for (int layer = 0; layer < 2; ++layer) {
        const int Ml = layer == 0 ? NTOK : NLAT;
        const float lam_init = 0.8f - 0.6f * expf(-0.3f * (float)layer);
        PH_BEGIN
            Gemm g{(const bf16_t*)(ws + WS_XN), (const bf16_t*)(ws + WS_WIN), NTOK, NIN1, opq(1024), 1024}; StaticOrder S; S.init(NTOK, NIN1, G, bid);
            EpiIn E{(bf16_t*)(ws + WS_P), (bf16_t*)(ws + WS_VTS), (bf16_t*)(ws + WS_VTD), (const float*)(ws + WS_ROPE)};
            gemm_phase<EpiIn, StaticOrder, true, true>(lds, g, S, E);
        PH_END
        PH_BEGIN
            rwkv_prepare_phase(p, layer, gw, NGW, lane);
        PH_END
        PH_BEGIN
            Gemm g{(const bf16_t*)(ws + WS_YA), (const bf16_t*)(ws + WS_LORA), NTOK, 2560, opq(128), 384}; LoraSched S; S.S.init(NTOK, 2560, G, bid);
            EpiLora E{(float*)(ws + WS_ST), (bf16_t*)(ws + WS_P), p.in[14] + layer * 1024, p.in[16] + layer * 1024};
            gemm_phase<EpiLora, LoraSched, true, true>(lds, g, S, E);
        PH_END
        PH_BEGIN
            for (int u = gw; u < 32 * (NSEG - 1); u += NGW) rwkv_segment<0>(p, layer, u / (NSEG - 1), u % (NSEG - 1), lane, lds + wave * SCAN_LDS);
        PH_END
        PH_BEGIN
            unsigned* qhead = (unsigned*)(ws + WS_CTL) + (layer == 0 ? CW_Q0 : CW_Q1);
            LAS int* ubox = (LAS int*)(lds + 65536);
            const int n_swa = 512 + (layer == 0 ? 16 : 0);
            if (bid < 32) rwkv_combine(p, bid, lds, wave, lane);
            if (bid >= 32 || G <= 32)
            for (;;) {
                if (tid == 0) ubox[0] = (int)atomicAdd(qhead, 1u);
                __syncthreads();
                const int u = ubox[0];
                __syncthreads();
                if (u >= n_swa) break;
                if (u < 512) swa_unit(lds, p, layer, u >> 8, (u >> 5) & 7, u & 31, false, wave, lane);
                else { const int v = u - 512; swa_unit(lds, p, layer, v >> 3, v & 7, 0, true, wave, lane); }
            }
        PH_END
        PH_BEGIN
            for (int u = gw; u < 32 * NSEG; u += NGW) rwkv_segment<2>(p, layer, u / NSEG, u % NSEG, lane, lds + wave * SCAN_LDS);
            asm volatile("s_waitcnt vmcnt(0)" ::: "memory");
            __syncthreads();
            float lam;
            { const float* lv = p.in[24] + layer * 256;
              const float s1 = wave_sum(lv[lane] * lv[64 + lane]), s2 = wave_sum(lv[128 + lane] * lv[192 + lane]);
              lam = expf(s1) - expf(s2) + lam_init; }
            for (int u = bid; u < 256; u += G) { const int v = G == 256 ? ((((u & 7) >> 2) << 7) | ((u & 3) << 5) | (u >> 3)) : u; diff_unit(lds, p, lam, v >> 7, (v >> 5) & 3, v & 31, false, wave, lane); }
            if (layer == 0) for (int u = bid; u < 8; u += G) diff_unit(lds, p, lam, u >> 2, u & 3, 0, true, wave, lane);
        PH_END
        PH_BEGIN
            postmix_phase(p, layer, lam_init, Ml, gw, NGW, lane);
            if (layer == 0) convert_ffn_weights(p, lds, gw, NGW, wave, lane);
            __syncthreads();
            Gemm g{(const bf16_t*)(ws + WS_XN), (const bf16_t*)(ws + WS_WIN) + (size_t)NIN1 * 1024, Ml, 3072, opq(1024), 1024}; StaticOrder S; S.init(Ml, 3072, G, bid);
            EpiGate E{(bf16_t*)(ws + WS_G)};
            gemm_phase<EpiGate, StaticOrder, true, true>(lds, g, S, E);
        PH_END
        PH_BEGIN
            StaticOrder S; S.init(Ml, 1024, G, bid);
            { Gemm g{(const bf16_t*)(ws + WS_YA), (const bf16_t*)(ws + WS_PRJ), Ml, 1024, opq(512), 512}; EpiMerge<0> E{(const bf16_t*)(ws + WS_G), (bf16_t*)(ws + WS_MF), (bf16_t*)(ws + WS_MB)};
              gemm_phase<EpiMerge<0>, StaticOrder, true, true>(lds, g, S, E); }
            { Gemm g{(const bf16_t*)(ws + WS_YB), (const bf16_t*)(ws + WS_PRJ) + 1024 * 512, Ml, 1024, opq(512), 512}; EpiMerge<1> E{(const bf16_t*)(ws + WS_G), (bf16_t*)(ws + WS_MF), (bf16_t*)(ws + WS_MB)};
              gemm_phase<EpiMerge<1>, StaticOrder, true, true>(lds, g, S, E); }
            { Gemm g{(const bf16_t*)(ws + WS_YC), (const bf16_t*)(ws + WS_PRJ) + 2 * 1024 * 512, Ml, 1024, opq(512), 512}; EpiMerge<2> E{(const bf16_t*)(ws + WS_G), (bf16_t*)(ws + WS_MF), (bf16_t*)(ws + WS_MB)};
              gemm_phase<EpiMerge<2>, StaticOrder, true, true>(lds, g, S, E); }
        PH_END
        PH_BEGIN
            Gemm g{(const bf16_t*)(ws + WS_MB), (const bf16_t*)(ws + WS_WOUT), Ml, 1024, opq(1024), 1024}; StaticOrder S; S.init(Ml, 1024, G, bid);
            EpiBf E{(bf16_t*)(ws + WS_MOUT), 1024};
            gemm_phase<EpiBf, StaticOrder, true, true>(lds, g, S, E);
        PH_END
        PH_BEGIN
            residual_phase(p, (const bf16_t*)(ws + WS_MOUT), nullptr, nullptr, layer == 0, layer, 2, p.in[7] + layer * 1024, true, p.in[8] + layer * 1024, layer, 3, layer == 1, Ml, gw, NGW, lane);
            if (layer == 0) convert_layer_weights(p, 1, lds, gw, NGW, wave, lane);
            else convert_moe_weights(p, lds, gw, NGW, wave, lane);
        PH_END
        if (layer == 0) {
            PH_BEGIN
                Gemm g{(const bf16_t*)(ws + WS_XN), (const bf16_t*)(ws + WS_FGU), NTOK, 2 * D_FF, opq(1024), 1024}; StaticOrder S; S.init(NTOK, 2 * D_FF, G, bid);
                EpiSwiglu E{(bf16_t*)(ws + WS_HID), D_FF, 1 << 20, 0};
                gemm_phase<EpiSwiglu, StaticOrder, true, true>(lds, g, S, E);
            PH_END
            PH_BEGIN
                Gemm g{(const bf16_t*)(ws + WS_HID), (const bf16_t*)(ws + WS_FD), NTOK, 1024, opq(D_FF), D_FF}; StaticOrder S; S.init(NTOK, 1024, G, bid);
                EpiBf E{(bf16_t*)(ws + WS_MF), 1024};
                gemm_phase<EpiBf, StaticOrder, true, true>(lds, g, S, E);
            PH_END
            PH_BEGIN
                residual_phase(p, (const bf16_t*)(ws + WS_MF), nullptr, nullptr, false, 0, 5, p.in[9], true, p.in[6] + 1024, 1, 0, false, NTOK, gw, NGW, lane);
            PH_END
        }
    }
    {
        {
            PH_BEGIN
                const unsigned* cnt = (const unsigned*)(ws + WS_CTL) + CW_CNT; int ts[9]; ts[0] = 0;
#pragma unroll
                for (int e = 0; e < 8; ++e) ts[e + 1] = ts[e] + (int)((__hip_atomic_load(cnt + e, __ATOMIC_RELAXED, __HIP_MEMORY_SCOPE_AGENT) + 255u) >> 8);
                const int* LIST = (const int*)(ws + WS_LIST); const bf16_t* XN = (const bf16_t*)(ws + WS_XN2); bf16_t* XG = (bf16_t*)(ws + WS_XG);
                for (int r = gw; r < ts[8] * 256; r += NGW) {
                    const int tile = r >> 8; int e = 0;
#pragma unroll
                    for (int q = 1; q < 8; ++q) e += (tile >= ts[q]) ? 1 : 0;
                    int tse = 0;
#pragma unroll
                    for (int q = 0; q < 8; ++q) tse = (q == e) ? ts[q] : tse;
                    const int slot = r - tse * 256;
                    u32x4 v0 = (u32x4){0u, 0u, 0u, 0u}, v1 = v0;
                    if (slot < (int)cnt[e]) { const int tk = LIST[e * 16384 + slot]; const u32x4* src = (const u32x4*)(XN + (size_t)(tk >> 1) * 1024); v0 = src[lane]; v1 = src[lane + 64]; }
                    u32x4* dst = (u32x4*)(XG + (size_t)r * 1024); dst[lane] = v0; dst[lane + 64] = v1;
                }
            PH_END
            PH_BEGIN
                const unsigned* cnt = (const unsigned*)(ws + WS_CTL) + CW_CNT; int ts[9]; ts[0] = 0;
#pragma unroll
                for (int e = 0; e < 8; ++e) ts[e + 1] = ts[e] + (int)((__hip_atomic_load(cnt + e, __ATOMIC_RELAXED, __HIP_MEMORY_SCOPE_AGENT) + 255u) >> 8);
                MoeSched S;
#pragma unroll
                for (int e = 0; e < 9; ++e) S.ts[e] = ts[e];
                S.pm_lo = 0; S.pm_hi = ts[8]; S.npn = 28; S.G = G; S.c = bid; S.a_local = false;
                Gemm g{(const bf16_t*)(ws + WS_XG), (const bf16_t*)(ws + WS_MGU), 0, 0, opq(1024), 1024};
                EpiSwiglu E{(bf16_t*)(ws + WS_HIDM), D_FFE, 28, 0};
                gemm_phase<EpiSwiglu, MoeSched, true, true>(lds, g, S, E);
            PH_END
            PH_BEGIN
                const unsigned* cnt = (const unsigned*)(ws + WS_CTL) + CW_CNT; int ts[9]; ts[0] = 0;
#pragma unroll
                for (int e = 0; e < 8; ++e) ts[e + 1] = ts[e] + (int)((__hip_atomic_load(cnt + e, __ATOMIC_RELAXED, __HIP_MEMORY_SCOPE_AGENT) + 255u) >> 8);
                MoeSched S;
#pragma unroll
                for (int e = 0; e < 9; ++e) S.ts[e] = ts[e];
                S.pm_lo = 0; S.pm_hi = ts[8]; S.npn = 4; S.G = G; S.c = bid; S.a_local = false;
                Gemm g{(const bf16_t*)(ws + WS_HIDM), (const bf16_t*)(ws + WS_MD), 0, 0, opq(D_FFE), D_FFE};
                EpiMoeDown E; E.FS = (bf16_t*)(ws + WS_FACC); E.slot1_off = ((long)WS_MGU - (long)WS_FACC) / 2; E.LIST = (const int*)(ws + WS_LIST); E.WTS = (const float*)(ws + WS_WTS); E.cnt = cnt; E.pm_lo = 0;
#pragma unroll
                for (int e = 0; e < 9; ++e) E.ts[e] = ts[e];
                gemm_phase<EpiMoeDown, MoeSched, true, true>(lds, g, S, E);
            PH_END
            PH_BEGIN
                residual_phase(p, (const bf16_t*)(ws + WS_FACC), (const bf16_t*)(ws + WS_MGU), nullptr, false, 1, 5, p.in[9] + 1024, false, nullptr, 0, 0, false, NLAT, gw, NGW, lane);
            PH_END
        }
    }
#undef PH_BEGIN
#undef PH_END
}

extern "C" void kernel_launch(void* const* d_in, const int* in_sizes, int n_in, void* d_out, int out_size, void* d_ws, size_t ws_size, hipStream_t stream) {
    static int grid = 0;
    if (grid == 0) {
        if (n_in != 37 || out_size != NLAT * DM || ws_size < WS_NEED) { fprintf(stderr, "kernel_launch: unexpected shapes (n_in %d out %d ws %zu need %zu)\n", n_in, out_size, ws_size, (size_t)WS_NEED); grid = -1; return; }
        int dev = 0, cus = 0, per_cu = 0;
        (void)hipGetDevice(&dev);
        (void)hipDeviceGetAttribute(&cus, hipDeviceAttributeMultiprocessorCount, dev);
        (void)hipFuncSetAttribute((const void*)mk_fwd, hipFuncAttributeMaxDynamicSharedMemorySize, LDS_BYTES);
        (void)hipOccupancyMaxActiveBlocksPerMultiprocessor(&per_cu, (const void*)mk_fwd, NTHREADS, LDS_BYTES);
        if (per_cu < 1) { fprintf(stderr, "kernel_launch: occupancy query reports %d blocks per CU\n", per_cu); grid = -1; return; }
        grid = cus;
        fprintf(stderr, "kernel_launch: grid %d (cus %d, per_cu %d), ws %zu\n", grid, cus, per_cu, ws_size);
    }
    if (grid < 0) return;
    (void)hipMemsetAsync((char*)d_ws + WS_CTL, 0, CTL_BYTES, stream);
    Params prm{};
    for (int i = 0; i < 37; ++i) prm.in[i] = (const float*)d_in[i];
    prm.out = (float*)d_out; prm.ws = (unsigned char*)d_ws;
#if MK_MULTI
    for (int ph = 0; ph < N_PHASES; ++ph) { prm.ph_lo = ph; prm.ph_hi = ph + 1; hipLaunchKernelGGL(mk_fwd, dim3(grid), dim3(NTHREADS), LDS_BYTES, stream, prm); }
#else
    prm.ph_lo = 0; prm.ph_hi = 1 << 20;
    void* args[] = {&prm};
    hipError_t e = hipLaunchCooperativeKernel((const void*)mk_fwd, dim3(grid), dim3(NTHREADS), args, LDS_BYTES, stream);
    if (e != hipSuccess) fprintf(stderr, "kernel_launch: cooperative launch failed: %s (grid %d)\n", hipGetErrorString(e), grid);
#endif
}
```

```cpp
#include <hip/hip_runtime.h>
#include <hip/hip_cooperative_groups.h>
#include <cstdio>
#include <cstdint>
namespace cg = cooperative_groups;
namespace pg8 {
#define PG8_LAS __attribute__((address_space(3)))
typedef unsigned short bf16_t;
typedef short bf16x8 __attribute__((ext_vector_type(8)));
typedef float f32x4 __attribute__((ext_vector_type(4)));
typedef unsigned u32x4 __attribute__((ext_vector_type(4)));
constexpr int BM = 256, BK = 64, HALF = 128, HTB = HALF * BK * 2  , STAGE_BYTES = 8 * HTB, NXCD = 8, WGM = 8;

__host__ __device__ __forceinline__ int lds_byte(int r, int c) { const int st = (r >> 4) * 2 + (c >> 5), rr = r & 15, cc = c & 31, ob = rr * 64 + cc * 2; return st * 1024 + (ob ^ (((ob >> 9) & 1) << 5)); }
__host__ __device__ __forceinline__ void stage_rc(int b, int& R, int& C) { const int st = b / 1024, sb = b % 1024, swz = sb ^ (((sb >> 9) & 1) << 5); R = (st >> 1) * 16 + swz / 64; C = (st & 1) * 32 + (swz % 64) / 2; }
__host__ __device__ __forceinline__ int perm32(int rho) { const int n = rho >> 4, i = rho & 15; return 8 * (i >> 2) + 4 * n + (i & 3); }

struct Unit { int pm, pn, koff, tail, kt; };
struct Gemm { const bf16_t* A; const bf16_t* Bt; int M, N, K, ld; };

struct StaticOrder {
    int nM, nN, nwg, G, c;
    __host__ __device__ void init(int M, int N, int G_, int c_) { nM = M / BM; nN = N / BM; nwg = nM * nN; G = G_; c = c_; }
    __host__ __device__ bool next(int i, Unit& u) const {
        const long L = (long)i * G + c; if (L >= nwg) return false;
        int wgid = (int)L; { const int q = nwg / NXCD, r = nwg % NXCD, xcd = wgid % NXCD, off = wgid / NXCD; wgid = (xcd < r ? xcd * (q + 1) : r * (q + 1) + (xcd - r) * q) + off; }
        const int nig = WGM * nN, gid = wgid / nig, fm = gid * WGM, gsz = (nM - fm) < WGM ? (nM - fm) : WGM;
        u.pm = fm + ((wgid % nig) % gsz); u.pn = (wgid % nig) / gsz; u.koff = 0; u.tail = -1; u.kt = 0; return true;
    }
    __device__ __forceinline__ void a_ready(const Unit&) const {}
    __device__ __forceinline__ void done(const Unit&) const {}
};

__device__ __forceinline__ unsigned cvt_pk_bf16(float lo, float hi) { unsigned r; asm volatile("v_cvt_pk_bf16_f32 %0, %1, %2" : "=v"(r) : "v"(lo), "v"(hi)); return r; }
typedef float f32x2 __attribute__((ext_vector_type(2)));
template <class Epi, class Sched, bool ALIGN_EPI = false, bool SP2 = false>
__device__ __forceinline__ void gemm_phase(PG8_LAS unsigned char* lds, const Gemm g, const Sched& S, const Epi& E) {
    int tid_ = threadIdx.x; asm volatile("" : "+v"(tid_)); const int tid = tid_, wid = __builtin_amdgcn_readfirstlane(tid >> 6), lane = tid & 63, wr = wid >> 2, wc = wid & 3, fr = lane & 15, fq = lane >> 4;
    const int K = g.ld, nt = g.K / BK;
    unsigned voffA[2], voffB[2];
#pragma unroll
    for (int i = 0; i < 2; ++i) { int R, C; stage_rc(tid * 16 + i * 8192, R, C); const int Rb = Epi::PERM ? ((R & ~31) + perm32(R & 31)) : R;
        voffA[i] = (unsigned)(R * K + C) * 2u; voffB[i] = (unsigned)(Rb * K + C) * 2u; }
    const size_t kstep = (size_t)(BK * 2);
    const size_t hstep = (size_t)HALF * K * 2;
    const size_t tstep = 2 * hstep;
    const unsigned ldsw = (unsigned)wid * 1024u;
    const int aoff = lds_byte(wr * 64 + fr, fq * 8), boff = lds_byte(wc * 32 + fr, fq * 8);
#define PG8_SA(b, h) (((b) * 2 + (h)) * HTB)
#define PG8_SB(b, h) ((4 + (b) * 2 + (h)) * HTB)
#define PG8_STAGE(bufoff, gbase, voff) do { _Pragma("unroll") for (int _i = 0; _i < 2; ++_i) \
        __builtin_amdgcn_global_load_lds((const unsigned*)((const char*)(gbase) + (voff)[_i]), (PG8_LAS unsigned*)(lds + (bufoff) + ldsw + _i * 8192), 16, 0, 0); } while (0)
#define PG8_LDA(dst, b, h) do { _Pragma("unroll") for (int m = 0; m < 4; ++m) _Pragma("unroll") for (int k = 0; k < 2; ++k) dst[m][k] = *(const PG8_LAS bf16x8*)(lds + PG8_SA(b, h) + aoff + m * 2048 + k * 1024); } while (0)
#define PG8_LDB(dst, b, h) do { _Pragma("unroll") for (int n = 0; n < 2; ++n) _Pragma("unroll") for (int k = 0; k < 2; ++k) dst[n][k] = *(const PG8_LAS bf16x8*)(lds + PG8_SB(b, h) + boff + n * 2048 + k * 1024); } while (0)
#define PG8_MMA(ai, bj, At, Bt) do { __builtin_amdgcn_s_setprio(1); _Pragma("unroll") for (int m = 0; m < 4; ++m) _Pragma("unroll") for (int n = 0; n < 2; ++n) _Pragma("unroll") for (int k = 0; k < 2; ++k) \
        acc[ai][bj][m][n] = __builtin_amdgcn_mfma_f32_16x16x32_bf16(Bt[n][k], At[m][k], acc[ai][bj][m][n], 0, 0, 0); __builtin_amdgcn_s_setprio(0); } while (0)
#define PG8_WAIT_V(n) asm volatile("s_waitcnt vmcnt(" #n ")" ::: "memory")
#define PG8_WAIT_L(n) asm volatile("s_waitcnt lgkmcnt(" #n ")" ::: "memory")
#define PG8_BAR __builtin_amdgcn_s_barrier()
#define PG8_SCHED __builtin_amdgcn_sched_barrier(0)
    Unit cur, nxt; int ui = 0;
    if (!S.next(0, cur)) return;
    f32x4 acc[2][2][4][2];
#pragma unroll
    for (int a = 0; a < 2; ++a)
#pragma unroll
        for (int b = 0; b < 2; ++b)
#pragma unroll
            for (int m = 0; m < 4; ++m)
#pragma unroll
                for (int n = 0; n < 2; ++n) acc[a][b][m][n] = (f32x4){0.f, 0.f, 0.f, 0.f};
    bf16x8 At[4][2], B0[2][2], B1[2][2];
    const char* cA = (const char*)g.A + (size_t)cur.pm * tstep + (size_t)cur.koff * 2; const char* cB = (const char*)g.Bt + (size_t)cur.pn * tstep + (size_t)cur.koff * 2;
    S.a_ready(cur);
    if constexpr (SP2) {
        PG8_STAGE(PG8_SB(0, 0), cB, voffB); PG8_STAGE(PG8_SB(0, 1), cB + hstep, voffB); PG8_STAGE(PG8_SA(0, 0), cA, voffA); PG8_STAGE(PG8_SA(0, 1), cA + hstep, voffA);
        if (wr == 1) PG8_BAR;
        PG8_WAIT_V(2); PG8_BAR;
        PG8_STAGE(PG8_SB(1, 0), cB + kstep, voffB); PG8_STAGE(PG8_SA(1, 0), cA + kstep, voffA); PG8_STAGE(PG8_SB(1, 1), cB + hstep + kstep, voffB);
        PG8_WAIT_V(6); PG8_BAR;
    } else {
        PG8_STAGE(PG8_SB(0, 0), cB, voffB); PG8_STAGE(PG8_SA(0, 0), cA, voffA); PG8_STAGE(PG8_SB(0, 1), cB + hstep, voffB); PG8_STAGE(PG8_SA(0, 1), cA + hstep, voffA);
        if (wr == 1) PG8_BAR;
        PG8_WAIT_V(4); PG8_BAR;
        PG8_STAGE(PG8_SB(1, 0), cB + kstep, voffB); PG8_STAGE(PG8_SA(1, 0), cA + kstep, voffA); PG8_STAGE(PG8_SB(1, 1), cB + hstep + kstep, voffB);
        PG8_WAIT_V(6); PG8_BAR;
    }
    for (;;) {
        const bool has_next = S.next(ui + 1, nxt);
        const char* nA = has_next ? (const char*)g.A + (size_t)nxt.pm * tstep + (size_t)nxt.koff * 2 : cA; const char* nB = has_next ? (const char*)g.Bt + (size_t)nxt.pn * tstep + (size_t)nxt.koff * 2 : cB;
        const int ntc = cur.kt ? cur.kt : nt;
        for (int t = 0; t < ntc; t += 2) {
            const bool last = (t == ntc - 2);
            const char* a1 = cA + (size_t)(t + 1) * kstep;
            const char* a2 = last ? nA : cA + (size_t)(t + 2) * kstep; const char* b2 = last ? nB : cB + (size_t)(t + 2) * kstep;
            const char* a3 = a2 + kstep; const char* b3 = b2 + kstep;
            if (last && has_next) S.a_ready(nxt);
            if constexpr (SP2) {
            PG8_LDB(B0, 0, 0); PG8_LDB(B1, 0, 1); PG8_SCHED; PG8_LDA(At, 0, 0); PG8_STAGE(PG8_SA(1, 1), a1 + hstep, voffA);
            PG8_WAIT_V(8); PG8_WAIT_L(0); PG8_BAR; PG8_MMA(0, 0, At, B0); PG8_MMA(0, 1, At, B1); PG8_BAR; PG8_SCHED;
            PG8_LDA(At, 0, 1); PG8_STAGE(PG8_SB(0, 0), b2, voffB); PG8_STAGE(PG8_SB(0, 1), b2 + hstep, voffB); PG8_STAGE(PG8_SA(0, 0), a2, voffA);
            PG8_WAIT_V(8); PG8_WAIT_L(0); PG8_BAR; PG8_MMA(1, 0, At, B0); PG8_MMA(1, 1, At, B1); PG8_BAR; PG8_SCHED;
            PG8_LDB(B0, 1, 0); PG8_LDB(B1, 1, 1); PG8_SCHED; PG8_LDA(At, 1, 0); PG8_STAGE(PG8_SA(0, 1), a2 + hstep, voffA);
            PG8_WAIT_V(8); PG8_WAIT_L(0); PG8_BAR; PG8_MMA(0, 0, At, B0); PG8_MMA(0, 1, At, B1); PG8_BAR; PG8_SCHED;
            PG8_LDA(At, 1, 1); PG8_STAGE(PG8_SB(1, 0), b3, voffB); PG8_STAGE(PG8_SB(1, 1), b3 + hstep, voffB); PG8_STAGE(PG8_SA(1, 0), a3, voffA);
            PG8_WAIT_V(8); PG8_WAIT_L(0); PG8_BAR; PG8_MMA(1, 0, At, B0); PG8_MMA(1, 1, At, B1); PG8_BAR; PG8_SCHED;
            } else {
            PG8_LDB(B0, 0, 0); PG8_SCHED; PG8_LDA(At, 0, 0); PG8_STAGE(PG8_SA(1, 1), a1 + hstep, voffA);
            PG8_WAIT_L(8); PG8_BAR; PG8_WAIT_L(0); PG8_MMA(0, 0, At, B0); PG8_BAR; PG8_SCHED;
            PG8_LDB(B1, 0, 1); PG8_STAGE(PG8_SB(0, 0), b2, voffB);
            PG8_BAR; PG8_WAIT_L(0); PG8_MMA(0, 1, At, B1); PG8_BAR;
            PG8_LDA(At, 0, 1); PG8_STAGE(PG8_SA(0, 0), a2, voffA);
            PG8_BAR; PG8_WAIT_L(0); PG8_MMA(1, 0, At, B0); PG8_BAR; PG8_SCHED;
            PG8_STAGE(PG8_SB(0, 1), b2 + hstep, voffB);
            PG8_WAIT_V(6); PG8_BAR; PG8_MMA(1, 1, At, B1); PG8_BAR;
            PG8_LDB(B0, 1, 0); PG8_SCHED; PG8_LDA(At, 1, 0); PG8_STAGE(PG8_SA(0, 1), a2 + hstep, voffA);
            PG8_WAIT_L(8); PG8_BAR; PG8_WAIT_L(0); PG8_MMA(0, 0, At, B0); PG8_BAR; PG8_SCHED;
            PG8_LDB(B1, 1, 1); PG8_STAGE(PG8_SB(1, 0), b3, voffB);
            PG8_BAR; PG8_WAIT_L(0); PG8_MMA(0, 1, At, B1); PG8_BAR;
            PG8_LDA(At, 1, 1); PG8_STAGE(PG8_SA(1, 0), a3, voffA);
            PG8_BAR; PG8_WAIT_L(0); PG8_MMA(1, 0, At, B0); PG8_BAR; PG8_SCHED;
            PG8_STAGE(PG8_SB(1, 1), b3 + hstep, voffB);
            PG8_WAIT_V(6); PG8_BAR; PG8_MMA(1, 1, At, B1); PG8_BAR;
            }
        }
        if constexpr (ALIGN_EPI) { if (wr == 0) PG8_BAR; }
        if constexpr (!Epi::AFTER_DRAIN) { E(acc, cur, wr, wc, fr, fq); S.done(cur); }
        if (!has_next) break;
#pragma unroll
        for (int a = 0; a < 2; ++a)
#pragma unroll
            for (int b = 0; b < 2; ++b)
#pragma unroll
                for (int m = 0; m < 4; ++m)
#pragma unroll
                    for (int n = 0; n < 2; ++n) acc[a][b][m][n] = (f32x4){0.f, 0.f, 0.f, 0.f};
        cur = nxt; cA = nA; cB = nB; ++ui;
        if constexpr (ALIGN_EPI) { if (wr == 1) PG8_BAR; }
    }
    PG8_WAIT_V(0);
    if constexpr (!ALIGN_EPI) { if (wr == 0) PG8_BAR; }
    PG8_BAR;
    if constexpr (Epi::AFTER_DRAIN) { E.fused(acc, cur, wr, wc, fr, fq, lds, wid, lane); S.done(cur); }
#undef PG8_SA
#undef PG8_SB
#undef PG8_STAGE
#undef PG8_LDA
#undef PG8_LDB
#undef PG8_MMA
#undef PG8_WAIT_V
#undef PG8_WAIT_L
#undef PG8_BAR
#undef PG8_SCHED
}
}

#define LAS __attribute__((address_space(3)))
typedef unsigned short bf16_t;
typedef short bf16x8 __attribute__((ext_vector_type(8)));
typedef float f32x4 __attribute__((ext_vector_type(4)));
typedef float f32x16 __attribute__((ext_vector_type(16)));
typedef unsigned u32x4 __attribute__((ext_vector_type(4)));
typedef unsigned u32x2 __attribute__((ext_vector_type(2)));

constexpr int NTHREADS = 512, NWAVES = 8;
constexpr int DM = 1024, SEQ = 8192, CTXL = 256, NLAT = 2 * SEQ, NCTX = 2 * CTXL, NTOK = NLAT + NCTX, KEYS = SEQ + CTXL;
constexpr int D_IN = 7296, D_FF = 2816, D_FFE = 3584, NEXP = 8;
constexpr int IC_QS = 0, IC_KS = 512, IC_RW = 640, IC_QD = 2560, IC_KD = 3072, PP = 3584, IC_VS = 3584, IC_VD = 3712, IC_PAD = 4224, NIN1 = 4352, WIN_ROWS = 7424;
constexpr int ST_SLOTS = 8;
constexpr int SL_W0 = 0, SL_A0 = 1, SL_KK = 2, SL_R = 3, SL_V = 4, SL_K = 5, SL_W1 = 6, SL_A1 = 7;
constexpr int MOE_TILES = 136, MOE_HALF = 68;

constexpr size_t MiB = 1u << 20;
constexpr size_t WS_CTL = 0, CTL_BYTES = 1 * MiB;
constexpr size_t WS_MODS = 1 * MiB;
constexpr size_t WS_ROPE = 1 * MiB + 256 * 1024;
constexpr size_t WS_HCTX = 2 * MiB;
constexpr size_t WS_LIST = 4 * MiB;
constexpr size_t WS_WTS = 4 * MiB + 512 * 1024;
constexpr size_t WS_WIN = 6 * MiB;
constexpr size_t WS_PRJ = WS_WIN + (size_t)WIN_ROWS * 1024 * 2;
constexpr size_t WS_WOUT = WS_PRJ + 3 * MiB;
constexpr size_t WS_LORA = WS_WOUT + 2 * MiB;
constexpr size_t WS_XN = 28 * MiB;
constexpr size_t WS_P = 61 * MiB;
constexpr size_t WS_VTS = 177 * MiB;
constexpr size_t WS_VTD = WS_VTS + 4608 * 1024;
constexpr size_t WS_ST = 198 * MiB;
constexpr size_t WS_YA = 495 * MiB;
constexpr size_t WS_YB = WS_YA + 16896ull * 512 * 2;
constexpr size_t WS_YC = WS_YB + 16896ull * 512 * 2;
constexpr size_t WS_END = WS_YC + 16896ull * 512 * 2;
constexpr size_t WS_G = WS_ST;
constexpr size_t WS_MF = WS_ST + 99 * MiB;
constexpr size_t WS_MB = WS_ST + 165 * MiB;
constexpr size_t WS_MOUT = WS_ST + 198 * MiB;
constexpr size_t WS_FGU = WS_VTS;
constexpr size_t WS_FD = WS_VTS + 11 * MiB;
constexpr size_t WS_HID = WS_P;
constexpr size_t WS_XN2 = 495 * MiB;
constexpr size_t WS_MGU = 6 * MiB;
constexpr size_t WS_MD = 118 * MiB;
constexpr size_t WS_XG = 174 * MiB;
constexpr size_t WS_FACC = 242 * MiB;
constexpr size_t WS_HIDM = 306 * MiB;
static_assert(WS_LORA + 2560 * 384 * 2 <= WS_XN && WS_XN + 16896ull * 1024 * 2 <= WS_P && WS_P + 16896ull * PP * 2 <= WS_VTS && WS_VTD + 2ull * 4 * 128 * KEYS * 2 <= WS_ST, "ws map 1");
static_assert(WS_ST + 16896ull * 8 * ST_SLOTS * 64 * 4 <= WS_YA && WS_END <= 545 * MiB, "ws map 2");
static_assert(WS_G + 16896ull * 3072 * 2 <= WS_MF && WS_MF + 16896ull * 1024 * 4 <= WS_MB && WS_MB + 16896ull * 1024 * 2 <= WS_MOUT && WS_MOUT + 16896ull * 1024 * 4 <= WS_YA, "ws map 3");
static_assert(WS_FGU + 5632ull * 1024 * 2 <= WS_FD && WS_FD + 1024ull * 2816 * 2 <= WS_ST && WS_HID + 16896ull * 2816 * 2 <= WS_VTS, "ws map 4");
static_assert(WS_MGU + 8ull * 7168 * 1024 * 2 <= WS_MD && WS_MD + 8ull * 1024 * 3584 * 2 <= WS_XG && WS_XG + 34816ull * 1024 * 2 <= WS_FACC && WS_FACC + 16384ull * 1024 * 4 <= WS_HIDM && WS_HIDM + 136ull * 256 * 3584 * 2 <= 560 * MiB, "ws map 5");
static_assert(WS_FACC + 16384ull * 1024 * 4 <= WS_MOUT && WS_XN2 + 16384ull * 1024 * 2 <= 560 * MiB && WS_XN2 >= WS_MOUT + 16896ull * 1024 * 4, "expert weights / gathered rows / accumulator must not touch MOUT or XN2 while they are live");
constexpr size_t WS_NEED = 560 * MiB;
constexpr int CW_CNT = 0;
constexpr int CW_Q0 = 64, CW_Q1 = 128;

constexpr int LDS_BYTES = 147456;

__device__ __forceinline__ unsigned f2bf(float f) { unsigned u = __builtin_bit_cast(unsigned, f); return (u + 0x7fffu + ((u >> 16) & 1u)) >> 16; }
typedef float f32x2_t __attribute__((ext_vector_type(2))); typedef __bf16 bf16x2_t __attribute__((ext_vector_type(2)));
__device__ __forceinline__ unsigned pk2(float lo, float hi) { const f32x2_t v = {lo, hi}; return __builtin_bit_cast(unsigned, __builtin_convertvector(v, bf16x2_t)); }
__device__ __forceinline__ float bflo(unsigned w) { return __uint_as_float(w << 16); }
__device__ __forceinline__ float bfhi(unsigned w) { return __uint_as_float(w & 0xffff0000u); }
__device__ __forceinline__ float wave_sum(float v) {
#pragma unroll
    for (int o = 1; o < 64; o <<= 1) v += __shfl_xor(v, o);
    return v;
}
__device__ __forceinline__ float sigmoidf_(float x) { return 1.0f / (1.0f + __expf(-x)); }
__device__ __forceinline__ float siluf_(float x) { return x / (1.0f + __expf(-x)); }
#define LDS_WAIT() asm volatile("s_waitcnt lgkmcnt(0)" ::: "memory")

struct Params {
    const float* in[37];
    float* out;
    unsigned char* ws;
    int ph_lo, ph_hi;
};

template <class F>
__device__ __forceinline__ void transpose_item(const float* __restrict__ W, int ldw, int k0, int n0, bf16_t* __restrict__ WT, int ldt, int dcol0, F rowmap, LAS float* scr, int lane) {
    f32x4 ld[8];
    { const float* src = W + (size_t)(k0 + (lane >> 3)) * ldw + n0 + 4 * (lane & 7);
#pragma unroll
      for (int j = 0; j < 8; ++j) ld[j] = *(const f32x4*)(src + (size_t)(8 * j) * ldw); }
#pragma unroll
    for (int j = 0; j < 8; ++j) { LAS float* d = scr + (8 * j + (lane >> 3)) * 33 + 4 * (lane & 7); d[0] = ld[j].x; d[1] = ld[j].y; d[2] = ld[j].z; d[3] = ld[j].w; }
    LDS_WAIT(); asm volatile("" ::: "memory");
    const int c = lane & 7;
#pragma unroll
    for (int j = 0; j < 4; ++j) {
        const int n = (lane >> 3) + 8 * j; const LAS float* s = scr + (8 * c) * 33 + n;
        u32x4 o; o.x = pk2(s[0 * 33], s[1 * 33]); o.y = pk2(s[2 * 33], s[3 * 33]); o.z = pk2(s[4 * 33], s[5 * 33]); o.w = pk2(s[6 * 33], s[7 * 33]);
        const int row = rowmap(n0 + n);
        if (row >= 0) *(u32x4*)(WT + (size_t)row * ldt + dcol0 + k0 + 8 * c) = o;
    }
    LDS_WAIT(); asm volatile("" ::: "memory");
}
struct RowId { __device__ __forceinline__ int operator()(int n) const { return n; } };
struct RowOff { int off; __device__ __forceinline__ int operator()(int n) const { return n + off; } };
struct RowWin {
    __device__ __forceinline__ int operator()(int n) const {
        if (n < 640) return n;
        if (n < 768) return n - 640 + IC_VS;
        if (n < 2688) return n - 768 + IC_RW;
        if (n < 3712) return n - 2688 + IC_QD;
        if (n < 4224) return n - 3712 + IC_VD;
        return n - 4224 + NIN1;
    }
};
struct RowGU { int up; __device__ __forceinline__ int operator()(int j) const { return (j >> 7) * 256 + (j & 127) + 128 * up; } };

template <class F>
__device__ __forceinline__ void convert_matrix(const float* W, int K, int N, bf16_t* WT, int ldt, int dcol0, F rowmap, LAS float* scr, int lane, int gw, int NGW) {
    const int nblk = N / 32, items = (K / 64) * nblk;
    for (int it = gw; it < items; it += NGW) { const int kb = it / nblk, nb = it % nblk; transpose_item(W, N, kb * 64, nb * 32, WT, ldt, dcol0, rowmap, scr, lane); }
}

__device__ __forceinline__ void lora_region(bf16_t* __restrict__ LT, const float* __restrict__ src, int row0, int klo, int kn, int gw, int NGW, int lane) {
    for (int i = gw * 64 + lane; i < 512 * 48; i += NGW * 64) {
        const int nn = i / 48, kc = (i % 48) * 8;
        u32x4 o = (u32x4){0u, 0u, 0u, 0u};
        if (kc >= klo && kc < klo + kn) {
            const float* s = src + (size_t)(kc - klo) * 512 + nn;
            o.x = pk2(s[0], s[512]); o.y = pk2(s[2 * 512], s[3 * 512]); o.z = pk2(s[4 * 512], s[5 * 512]); o.w = pk2(s[6 * 512], s[7 * 512]);
        }
        *(u32x4*)(LT + (size_t)(row0 + nn) * 384 + kc) = o;
    }
}
__device__ __forceinline__ void convert_layer_weights(const Params& p, int layer, LAS unsigned char* lds, int gw, int NGW, int wave, int lane) {
    LAS float* scr = (LAS float*)(lds + wave * 16384);
    unsigned char* ws = p.ws;
    bf16_t* WIN = (bf16_t*)(ws + WS_WIN);
    convert_matrix(p.in[10] + (size_t)layer * 1024 * D_IN, 1024, D_IN, WIN, 1024, 0, RowWin(), scr, lane, gw, NGW);
    for (int i = gw * 64 + lane; i < (NIN1 - IC_PAD) * 1024 / 8; i += NGW * 64) *(u32x4*)(WIN + (size_t)IC_PAD * 1024 + (size_t)i * 8) = (u32x4){0u, 0u, 0u, 0u};
    for (int j = 0; j < 3; ++j)
        convert_matrix(p.in[26 + j] + (size_t)layer * 512 * 1024, 512, 1024, (bf16_t*)(ws + WS_PRJ) + (size_t)j * 1024 * 512, 512, 0, RowId(), scr, lane, gw, NGW);
    convert_matrix(p.in[29] + (size_t)layer * 1024 * 1024, 1024, 1024, (bf16_t*)(ws + WS_WOUT), 1024, 0, RowId(), scr, lane, gw, NGW);
    bf16_t* LT = (bf16_t*)(ws + WS_LORA);
    lora_region(LT, p.in[15] + ((size_t)layer * 2 + 0) * 64 * 512, 0, 0, 64, gw, NGW, lane);
    lora_region(LT, p.in[15] + ((size_t)layer * 2 + 1) * 64 * 512, 512, 64, 64, gw, NGW, lane);
    lora_region(LT, p.in[17] + ((size_t)layer * 2 + 0) * 64 * 512, 1024, 128, 64, gw, NGW, lane);
    lora_region(LT, p.in[17] + ((size_t)layer * 2 + 1) * 64 * 512, 1536, 192, 64, gw, NGW, lane);
    lora_region(LT, p.in[18] + (size_t)layer * 128 * 512, 2048, 256, 128, gw, NGW, lane);
}
__device__ __forceinline__ void convert_ffn_weights(const Params& p, LAS unsigned char* lds, int gw, int NGW, int wave, int lane) {
    LAS float* scr = (LAS float*)(lds + wave * 16384);
    bf16_t* GU = (bf16_t*)(p.ws + WS_FGU); bf16_t* FD = (bf16_t*)(p.ws + WS_FD);
    convert_matrix(p.in[30], 1024, D_FF, GU, 1024, 0, RowGU{0}, scr, lane, gw, NGW);
    convert_matrix(p.in[31], 1024, D_FF, GU, 1024, 0, RowGU{1}, scr, lane, gw, NGW);
    convert_matrix(p.in[32], D_FF, 1024, FD, D_FF, 0, RowId(), scr, lane, gw, NGW);
}
__device__ __forceinline__ void convert_moe_weights(const Params& p, LAS unsigned char* lds, int gw, int NGW, int wave, int lane) {
    LAS float* scr = (LAS float*)(lds + wave * 16384);
    for (int e = 0; e < NEXP; ++e) {
        bf16_t* GU = (bf16_t*)(p.ws + WS_MGU) + (size_t)e * 7168 * 1024;
        convert_matrix(p.in[34] + (size_t)e * 1024 * D_FFE, 1024, D_FFE, GU, 1024, 0, RowGU{0}, scr, lane, gw, NGW);
        convert_matrix(p.in[35] + (size_t)e * 1024 * D_FFE, 1024, D_FFE, GU, 1024, 0, RowGU{1}, scr, lane, gw, NGW);
        convert_matrix(p.in[36] + (size_t)e * D_FFE * 1024, D_FFE, 1024, (bf16_t*)(p.ws + WS_MD) + (size_t)e * 1024 * D_FFE, D_FFE, 0, RowId(), scr, lane, gw, NGW);
    }
}

__device__ __forceinline__ void adaln_phase(const Params& p, LAS unsigned char* lds, int wave, int lane) {
    LAS float* red = (LAS float*)lds;
    float* MODS = (float*)(p.ws + WS_MODS);
    const float* c = p.in[1]; const float* cc = p.in[3];
    for (int it = blockIdx.x; it < 2 * 96; it += gridDim.x) {
        const int layer = it / 96, n = (it % 96) * 64 + lane;
        const float* W = p.in[4] + (size_t)layer * 1024 * 6144;
        float a0 = 0.f, a1 = 0.f, a2 = 0.f;
        for (int k = wave * 128; k < wave * 128 + 128; ++k) {
            const float w = W[(size_t)k * 6144 + n];
            a0 += siluf_(c[k]) * w; a1 += siluf_(c[1024 + k]) * w; a2 += siluf_(cc[k]) * w;
        }
        red[(wave * 3 + 0) * 64 + lane] = a0; red[(wave * 3 + 1) * 64 + lane] = a1; red[(wave * 3 + 2) * 64 + lane] = a2;
        __syncthreads();
        if (wave < 3) {
            float s = 0.f;
#pragma unroll
            for (int w = 0; w < 8; ++w) s += red[(w * 3 + wave) * 64 + lane];
            MODS[((size_t)layer * 3 + wave) * 6144 + n] = s + p.in[5][(size_t)layer * 6144 + n];
        }
        __syncthreads();
    }
    if (blockIdx.x == gridDim.x - 1) {
        float* rope = (float*)(p.ws + WS_ROPE);
        for (int i = threadIdx.x; i < 128 * 16; i += NTHREADS) {
            const int pos = i >> 4, j = i & 15;
            const float inv = powf(10000.0f, -(float)j / 16.0f);
            const float ang = (float)pos * inv;
            rope[2 * i] = cosf(ang); rope[2 * i + 1] = sinf(ang);
        }
    }
}

__device__ __forceinline__ const float* mods_row(const Params& p, int layer, int m) {
    const int r = m < NLAT ? (m >> 13) : 2;
    return (const float*)(p.ws + WS_MODS) + ((size_t)layer * 3 + r) * 6144;
}
__device__ __forceinline__ void load_row(const float* x, int lane, f32x4 (&v)[4]) {
#pragma unroll
    for (int j = 0; j < 4; ++j) v[j] = ((const f32x4*)x)[lane + 64 * j];
}
__device__ __forceinline__ float row_rstd(const f32x4 (&v)[4]) {
    float s = 0.f;
#pragma unroll
    for (int j = 0; j < 4; ++j) s += (v[j].x * v[j].x + v[j].y * v[j].y) + (v[j].z * v[j].z + v[j].w * v[j].w);
    return 1.0f / sqrtf(wave_sum(s) * (1.0f / 1024.0f) + 1e-6f);
}
__device__ __forceinline__ void normmod(const f32x4 (&h)[4], const float* g, const float* shift, const float* scale, int lane, f32x4 (&a)[4]) {
    const float rstd = row_rstd(h);
#pragma unroll
    for (int j = 0; j < 4; ++j) {
        const f32x4 gg = ((const f32x4*)g)[lane + 64 * j], sh = ((const f32x4*)shift)[lane + 64 * j], sc = ((const f32x4*)scale)[lane + 64 * j];
        a[j] = (h[j] * rstd * gg) * (sc + 1.0f) + sh;
    }
}
__device__ __forceinline__ void store_row_bf16(bf16_t* o, int lane, const f32x4 (&a)[4]) {
#pragma unroll
    for (int j = 0; j < 4; ++j) { u32x2 w; w.x = pk2(a[j].x, a[j].y); w.y = pk2(a[j].z, a[j].w); ((u32x2*)o)[lane + 64 * j] = w; }
}
__device__ __forceinline__ const float* h_in_row(const Params& p, int layer, int m) {
    if (layer == 0) return m < NLAT ? p.in[0] + (size_t)m * 1024 : p.in[2] + (size_t)(m - NLAT) * 1024;
    return m < NLAT ? p.out + (size_t)m * 1024 : (const float*)(p.ws + WS_HCTX) + (size_t)(m - NLAT) * 1024;
}
__device__ __forceinline__ float* h_out_row(const Params& p, int m) { return m < NLAT ? p.out + (size_t)m * 1024 : (float*)(p.ws + WS_HCTX) + (size_t)(m - NLAT) * 1024; }

__device__ __forceinline__ void premix_phase(const Params& p, int layer, bool first, int M, int gw, int NGW, int lane) {
    bf16_t* XN = (bf16_t*)(p.ws + WS_XN);
    for (int m = gw; m < M; m += NGW) {
        const float* hr = first ? h_in_row(p, 0, m) : h_out_row(p, m);
        f32x4 h[4], a[4]; load_row(hr, lane, h);
        const float* md = mods_row(p, layer, m);
        normmod(h, p.in[6] + layer * 1024, md, md + 1024, lane, a);
        store_row_bf16(XN + (size_t)m * 1024, lane, a);
    }
}
__device__ __forceinline__ void load_row_bf16(const bf16_t* x, int lane, f32x4 (&v)[4]) {
#pragma unroll
    for (int j = 0; j < 4; ++j) { const u32x2 w = ((const u32x2*)x)[lane + 64 * j]; v[j] = (f32x4){bflo(w.x), bfhi(w.x), bflo(w.y), bfhi(w.y)}; }
}
__device__ __forceinline__ void residual_phase(const Params& p, const bf16_t* src, const bf16_t* src2, const float* hin_base_layer0, bool hin_is_input, int layer, int gate_idx, const float* g1,
                                               bool write_xn, const float* g2, int mod_layer2, int shift_idx, bool route, int M, int gw, int NGW, int lane, LAS unsigned char* lds = nullptr,
                                               const float* part = nullptr, int nsl = 0) {
    bf16_t* XN = (bf16_t*)(p.ws + (route ? WS_XN2 : WS_XN));
    LAS int* rt = (LAS int*)lds;
    int rt_n = 0;
    const int wv = gw & (NWAVES - 1);
    for (int m = gw; m < M; m += NGW) {
        const float* hr = hin_is_input ? h_in_row(p, 0, m) : h_out_row(p, m);
        f32x4 h[4], s[4]; load_row(hr, lane, h);
        if (part && m >= NLAT) {
#pragma unroll
            for (int j = 0; j < 4; ++j) s[j] = (f32x4){0.f, 0.f, 0.f, 0.f};
            for (int sl = 0; sl < nsl; ++sl) { f32x4 t[4]; load_row(part + (size_t)(sl * 512 + (m - NLAT)) * 1024, lane, t);
#pragma unroll
                for (int j = 0; j < 4; ++j) s[j] += t[j]; }
        } else load_row_bf16(src + (size_t)m * 1024, lane, s);
        if (src2) { f32x4 s2[4]; load_row_bf16(src2 + (size_t)m * 1024, lane, s2);
#pragma unroll
            for (int j = 0; j < 4; ++j) s[j] += s2[j]; }
        const float rstd = row_rstd(s);
        const float* md = mods_row(p, layer, m);
#pragma unroll
        for (int j = 0; j < 4; ++j) {
            const f32x4 gg = ((const f32x4*)g1)[lane + 64 * j], gt = ((const f32x4*)(md + gate_idx * 1024))[lane + 64 * j];
            h[j] = h[j] + gt * (s[j] * rstd * gg);
        }
        float* ho = h_out_row(p, m);
#pragma unroll
        for (int j = 0; j < 4; ++j) ((f32x4*)ho)[lane + 64 * j] = h[j];
        if (write_xn) {
            f32x4 a[4]; const float* md2 = mods_row(p, mod_layer2, m);
            normmod(h, g2, md2 + shift_idx * 1024, md2 + (shift_idx + 1) * 1024, lane, a);
            store_row_bf16(XN + (size_t)m * 1024, lane, a);
            if (route) {
                const float* rw = p.in[33];
                float lg[8] = {0.f, 0.f, 0.f, 0.f, 0.f, 0.f, 0.f, 0.f};
#pragma unroll
                for (int j = 0; j < 4; ++j)
#pragma unroll
                    for (int q = 0; q < 4; ++q) {
                        const int k = 4 * (lane + 64 * j) + q; const float av = a[j][q];
                        const f32x4 w0 = ((const f32x4*)(rw + (size_t)k * 8))[0], w1 = ((const f32x4*)(rw + (size_t)k * 8))[1];
                        lg[0] += av * w0.x; lg[1] += av * w0.y; lg[2] += av * w0.z; lg[3] += av * w0.w; lg[4] += av * w1.x; lg[5] += av * w1.y; lg[6] += av * w1.z; lg[7] += av * w1.w;
                    }
#pragma unroll
                for (int e = 0; e < 8; ++e) lg[e] = wave_sum(lg[e]);
                int i1 = 0; float v1 = lg[0];
#pragma unroll
                for (int e = 1; e < 8; ++e) if (lg[e] > v1) { v1 = lg[e]; i1 = e; }
                int i2 = -1; float v2 = -3.0e38f;
#pragma unroll
                for (int e = 0; e < 8; ++e) if (e != i1 && lg[e] > v2) { v2 = lg[e]; i2 = e; }
                if (lane == 0) {
                    const float w1 = 1.0f / (1.0f + expf(v2 - v1));
                    const int q = rt_n * NWAVES + wv;
                    rt[q] = m; rt[64 + q] = i1; rt[128 + q] = i2; rt[192 + q] = (int)__float_as_uint(w1);
                }
                ++rt_n;
                if (rt_n == 64 / NWAVES || m + NGW >= M) {
                    __syncthreads();
                    if (wv == 0) {
                        const int n = rt_n * NWAVES; const bool act = lane < n;
                        const int rm = act ? rt[lane] : 0, e1 = act ? rt[64 + lane] : -1, e2 = act ? rt[128 + lane] : -1; const float w1 = __uint_as_float((unsigned)rt[192 + (act ? lane : 0)]);
                        unsigned* cnt = (unsigned*)(p.ws + WS_CTL) + CW_CNT; int* LIST = (int*)(p.ws + WS_LIST); float* WTS = (float*)(p.ws + WS_WTS);
                        const unsigned long long lt = (1ull << lane) - 1ull;
                        unsigned mycount = 0u; int r1 = 0, r2 = 0, c1sel = 0;
#pragma unroll
                        for (int e = 0; e < 8; ++e) {
                            const unsigned long long b1 = __ballot(e1 == e), b2 = __ballot(e2 == e);
                            const int c1 = __popcll(b1), c2 = __popcll(b2);
                            if (lane == e) mycount = (unsigned)(c1 + c2);
                            if (e1 == e) r1 = __popcll(b1 & lt);
                            if (e2 == e) { r2 = __popcll(b2 & lt); c1sel = c1; }
                        }
                        unsigned base = 0u;
                        if (lane < 8 && mycount) base = atomicAdd(cnt + lane, mycount);
                        const unsigned bs1 = (unsigned)__shfl((int)base, e1 < 0 ? 0 : e1), bs2 = (unsigned)__shfl((int)base, e2 < 0 ? 0 : e2);
                        if (act) {
                            const unsigned s1 = bs1 + (unsigned)r1, s2 = bs2 + (unsigned)(c1sel + r2);
                            LIST[e1 * 16384 + s1] = rm * 2; WTS[e1 * 16384 + s1] = w1;
                            LIST[e2 * 16384 + s2] = rm * 2 + 1; WTS[e2 * 16384 + s2] = 1.0f - w1;
                        }
                    }
                    __syncthreads();
                    rt_n = 0;
                }
            }
        }
    }
}

using pg8::Unit;
constexpr float QSCALE = 0.125f * 1.4426950408889634f;
__device__ __forceinline__ u32x2 pack4(const f32x4 v) { u32x2 w; w.x = pk2(v.x, v.y); w.y = pk2(v.z, v.w); return w; }
__device__ __forceinline__ f32x4 unpack4(const u32x2 w) { return (f32x4){bflo(w.x), bfhi(w.x), bflo(w.y), bfhi(w.y)}; }

struct EpiIn {
    static constexpr bool PERM = false, AFTER_DRAIN = false;
    bf16_t* P; bf16_t* VTS; bf16_t* VTD; const float* rope;
    __device__ __forceinline__ void operator()(const f32x4 (&acc)[2][2][4][2], const Unit& u, int wr, int wc, int fr, int fq) const {
#pragma unroll
        for (int ai = 0; ai < 2; ++ai)
#pragma unroll
            for (int m = 0; m < 4; ++m) {
                const int r = u.pm * 256 + ai * 128 + wr * 64 + m * 16 + fr;
                const bool lat = r < NLAT;
                const int t = r & (SEQ - 1);
                const int b = lat ? (r >> 13) : ((r - NLAT) >> 8);
                const int key = lat ? t : SEQ + ((r - NLAT) & 255);
#pragma unroll
                for (int bj = 0; bj < 2; ++bj) {
                    const int c32 = u.pn * 256 + bj * 128 + wc * 32;
                    f32x4 v0 = acc[ai][bj][m][0], v1 = acc[ai][bj][m][1];
                    if (c32 < PP) {
                        const bool rp = (c32 < IC_RW) || (c32 >= IC_QD);
                        if (rp && lat) {
                            const int pos = (c32 & 32) ? (t & 63) : (t >> 6);
                            const f32x4 cs0 = *(const f32x4*)(rope + (pos * 16 + 4 * fq) * 2), cs1 = *(const f32x4*)(rope + (pos * 16 + 4 * fq) * 2 + 4);
                            const f32x4 cc = (f32x4){cs0.x, cs0.z, cs1.x, cs1.z}, sn = (f32x4){cs0.y, cs0.w, cs1.y, cs1.w};
                            const f32x4 o0 = v0 * cc - v1 * sn, o1 = v0 * sn + v1 * cc;
                            v0 = o0; v1 = o1;
                        }
                        if (c32 < IC_KS || (c32 >= IC_QD && c32 < IC_KD)) { v0 = v0 * QSCALE; v1 = v1 * QSCALE; }
                        bf16_t* dst = P + (size_t)r * PP + c32 + 4 * fq;
                        *(u32x2*)dst = pack4(v0); *(u32x2*)(dst + 16) = pack4(v1);
                    } else {
                        const int cv = c32 - PP;
                        bf16_t* vt = nullptr; int dimbase = 0;
                        if (cv < 128) { vt = VTS + (size_t)((b * 2 + (cv >> 6)) * 64) * KEYS; dimbase = cv & 63; }
                        else if (cv < 640) { const int cd = cv - 128; vt = VTD + (size_t)((b * 4 + (cd >> 7)) * 128) * KEYS; dimbase = cd & 127; }
                        if (vt) {
                            const int kp = (key & ~12) | ((key & 4) << 1) | ((key & 8) >> 1);
#pragma unroll
                            for (int i = 0; i < 4; ++i) {
                                vt[(size_t)(dimbase + 4 * fq + i) * KEYS + kp] = (bf16_t)f2bf(v0[i]);
                                vt[(size_t)(dimbase + 16 + 4 * fq + i) * KEYS + kp] = (bf16_t)f2bf(v1[i]);
                            }
                        }
                    }
                }
            }
    }
};

struct EpiLora {
    static constexpr bool PERM = false, AFTER_DRAIN = false;
    float* ST; bf16_t* P; const float* w0; const float* a0;
    __device__ __forceinline__ void operator()(const f32x4 (&acc)[2][2][4][2], const Unit& u, int wr, int wc, int fr, int fq) const {
        const int reg = u.pn >> 1;
#pragma unroll
        for (int ai = 0; ai < 2; ++ai)
#pragma unroll
            for (int m = 0; m < 4; ++m) {
                const int r = u.pm * 256 + ai * 128 + wr * 64 + m * 16 + fr;
#pragma unroll
                for (int bj = 0; bj < 2; ++bj)
#pragma unroll
                    for (int n = 0; n < 2; ++n) {
                        const int ch = (u.pn & 1) * 256 + bj * 128 + wc * 32 + 16 * n + 4 * fq;
                        const int h = ch >> 6, kidx = ch & 63;
                        float* sp = ST + ((size_t)r * 8 + h) * (ST_SLOTS * 64) + kidx;
                        const f32x4 a = acc[ai][bj][m][n];
                        if (reg < 2) {
                            const f32x4 bias = *(const f32x4*)(w0 + reg * 512 + ch);
                            f32x4 o;
#pragma unroll
                            for (int i = 0; i < 4; ++i) {
                                const float x = -(bias[i] + a[i]);
                                const float sp_ = fmaxf(x, 0.f) + __logf(1.0f + __expf(-fabsf(x)));
                                o[i] = __expf(-__expf(-sp_ - 0.5f));
                            }
                            *(f32x4*)(sp + (reg ? SL_W1 : SL_W0) * 64) = o;
                        } else if (reg < 4) {
                            const int d = reg - 2;
                            const f32x4 bias = *(const f32x4*)(a0 + d * 512 + ch);
                            *(f32x4*)(sp + (d ? SL_A1 : SL_A0) * 64) = (f32x4){sigmoidf_(bias[0] + a[0]), sigmoidf_(bias[1] + a[1]), sigmoidf_(bias[2] + a[2]), sigmoidf_(bias[3] + a[3])};
                        } else {
                            *(u32x2*)(P + (size_t)r * PP + IC_RW + ch) = pack4(a);
                        }
                        asm volatile("" ::: "memory");
                    }
            }
    }
};

struct LoraSched {
    pg8::StaticOrder S;
    __device__ __forceinline__ bool next(int i, Unit& u) const { if (!S.next(i, u)) return false; const int reg = u.pn >> 1; u.koff = 128 * (reg < 4 ? (reg >> 1) : 2); return true; }
    __device__ __forceinline__ void a_ready(const Unit&) const {}
    __device__ __forceinline__ void done(const Unit&) const {}
};
struct EpiGate {
    static constexpr bool PERM = true, AFTER_DRAIN = false;
    bf16_t* G;
    __device__ __forceinline__ void operator()(const f32x4 (&acc)[2][2][4][2], const Unit& u, int wr, int wc, int fr, int fq) const {
#pragma unroll
        for (int ai = 0; ai < 2; ++ai)
#pragma unroll
            for (int m = 0; m < 4; ++m) {
                const int r = u.pm * 256 + ai * 128 + wr * 64 + m * 16 + fr;
#pragma unroll
                for (int bj = 0; bj < 2; ++bj) {
                    const int c = u.pn * 256 + bj * 128 + wc * 32 + 8 * fq;
                    const f32x4 a0 = acc[ai][bj][m][0], a1 = acc[ai][bj][m][1];
                    u32x4 w; w.x = pk2(sigmoidf_(a0.x), sigmoidf_(a0.y)); w.y = pk2(sigmoidf_(a0.z), sigmoidf_(a0.w)); w.z = pk2(sigmoidf_(a1.x), sigmoidf_(a1.y)); w.w = pk2(sigmoidf_(a1.z), sigmoidf_(a1.w));
                    *(u32x4*)(G + (size_t)r * 3072 + c) = w;
                }
            }
    }
};

template <int PASS> struct EpiMerge {
    static constexpr bool PERM = false, AFTER_DRAIN = false;
    const bf16_t* G; bf16_t* MF; bf16_t* MB;
    __device__ __forceinline__ void operator()(const f32x4 (&acc)[2][2][4][2], const Unit& u, int wr, int wc, int fr, int fq) const {
#pragma unroll
        for (int ai = 0; ai < 2; ++ai)
#pragma unroll
            for (int m = 0; m < 4; ++m) {
                const int r = u.pm * 256 + ai * 128 + wr * 64 + m * 16 + fr;
#pragma unroll
                for (int bj = 0; bj < 2; ++bj)
#pragma unroll
                    for (int n = 0; n < 2; ++n) {
                        const int c = u.pn * 256 + bj * 128 + wc * 32 + 16 * n + 4 * fq;
                        const f32x4 g = unpack4(*(const u32x2*)(G + (size_t)r * 3072 + PASS * 1024 + c));
                        f32x4 v = g * acc[ai][bj][m][n];
                        bf16_t* mp = MF + (size_t)r * 1024 + c;
                        if (PASS > 0) v += unpack4(*(const u32x2*)mp);
                        *(u32x2*)(PASS < 2 ? mp : MB + (size_t)r * 1024 + c) = pack4(v);
                    }
            }
    }
};

struct EpiBf {
    static constexpr bool PERM = true, AFTER_DRAIN = false;
    bf16_t* O; int ldc;
    __device__ __forceinline__ void operator()(const f32x4 (&acc)[2][2][4][2], const Unit& u, int wr, int wc, int fr, int fq) const {
#pragma unroll
        for (int ai = 0; ai < 2; ++ai)
#pragma unroll
            for (int m = 0; m < 4; ++m) {
                const int r = u.pm * 256 + ai * 128 + wr * 64 + m * 16 + fr;
#pragma unroll
                for (int bj = 0; bj < 2; ++bj) {
                    const int c = u.pn * 256 + bj * 128 + wc * 32 + 8 * fq;
                    const f32x4 a0 = acc[ai][bj][m][0], a1 = acc[ai][bj][m][1];
                    u32x4 w; w.x = pk2(a0.x, a0.y); w.y = pk2(a0.z, a0.w); w.z = pk2(a1.x, a1.y); w.w = pk2(a1.z, a1.w);
                    *(u32x4*)(O + (size_t)r * ldc + c) = w;
                }
            }
    }
};

struct TailSched {
    pg8::StaticOrder S; int nwg_main, nM_main, nN, nsl, kt, nitems, G, c;
    __device__ void init(int M_main, int N, int G_, int c_, int ntail, int kt_, int nsl_) { S.init(M_main, N, G_, c_); nwg_main = S.nwg; nM_main = M_main / pg8::BM; nN = N / pg8::BM; nsl = nsl_; kt = kt_; nitems = ntail * nN * nsl; G = G_; c = c_; }
    __device__ __forceinline__ bool next(int i, Unit& u) const {
        const long L = (long)i * G + c;
        if (L < nwg_main) return S.next(i, u);
        const int j = (int)(L - nwg_main); if (j >= nitems) return false;
        const int sl = j % nsl, tu = j / nsl;
        u.pm = nM_main + tu / nN; u.pn = tu % nN; u.koff = sl * kt * pg8::BK; u.tail = sl; u.kt = kt; return true;
    }
    __device__ __forceinline__ void a_ready(const Unit&) const {}
    __device__ __forceinline__ void done(const Unit&) const {}
};
struct EpiBfTail {
    static constexpr bool PERM = true, AFTER_DRAIN = false;
    bf16_t* O; int ldc; float* part; int row0, rows;
    __device__ __forceinline__ void operator()(const f32x4 (&acc)[2][2][4][2], const Unit& u, int wr, int wc, int fr, int fq) const {
        if (u.tail < 0) { EpiBf E{O, ldc}; E(acc, u, wr, wc, fr, fq); return; }
        float* base = part + (size_t)(u.tail * rows + (u.pm * 256 - row0) + wr * 64 + fr) * ldc + u.pn * 256 + wc * 32 + 8 * fq;
#pragma unroll
        for (int ai = 0; ai < 2; ++ai)
#pragma unroll
            for (int m = 0; m < 4; ++m)
#pragma unroll
                for (int bj = 0; bj < 2; ++bj) {
                    float* d = base + (size_t)(ai * 128 + m * 16) * ldc + bj * 128;
                    *(f32x4*)d = acc[ai][bj][m][0]; *(f32x4*)(d + 4) = acc[ai][bj][m][1];
                }
    }
};

struct EpiSwiglu {
    static constexpr bool PERM = true, AFTER_DRAIN = false;
    bf16_t* H; int ldh; int npn; int pm_sub;
    __device__ __forceinline__ void operator()(const f32x4 (&acc)[2][2][4][2], const Unit& u, int wr, int wc, int fr, int fq) const {
        const int pnn = u.pn % npn;
#pragma unroll
        for (int ai = 0; ai < 2; ++ai)
#pragma unroll
            for (int m = 0; m < 4; ++m) {
                const int r = (u.pm - pm_sub) * 256 + ai * 128 + wr * 64 + m * 16 + fr;
                const int hc = pnn * 128 + wc * 32 + 8 * fq;
                const f32x4 g0 = acc[ai][0][m][0], g1 = acc[ai][0][m][1], u0 = acc[ai][1][m][0], u1 = acc[ai][1][m][1];
                u32x4 w; w.x = pk2(siluf_(g0.x) * u0.x, siluf_(g0.y) * u0.y); w.y = pk2(siluf_(g0.z) * u0.z, siluf_(g0.w) * u0.w);
                w.z = pk2(siluf_(g1.x) * u1.x, siluf_(g1.y) * u1.y); w.w = pk2(siluf_(g1.z) * u1.z, siluf_(g1.w) * u1.w);
                *(u32x4*)(H + (size_t)r * ldh + hc) = w;
            }
    }
};

struct MoeSched {
    int ts[9]; int pm_lo, pm_hi, npn, G, c; bool a_local;
    __device__ __forceinline__ int expert_of(int pm) const { int e = 0;
#pragma unroll
        for (int q = 1; q < 8; ++q) e += (pm >= ts[q]) ? 1 : 0;
        return e; }
    __device__ __forceinline__ bool next(int i, Unit& u) const {
        const int n = (pm_hi - pm_lo) * npn; const long L = (long)i * G + c; if (L >= n) return false;
        const int pm = pm_lo + (int)L / npn, pnn = (int)L % npn;
        u.pm = a_local ? pm - pm_lo : pm; u.pn = expert_of(pm) * npn + pnn; u.koff = 0; u.tail = -1; u.kt = 0; return true;
    }
    __device__ __forceinline__ void a_ready(const Unit&) const {}
    __device__ __forceinline__ void done(const Unit&) const {}
};
struct EpiMoeDown {
    static constexpr bool PERM = false, AFTER_DRAIN = false;
    bf16_t* FS; long slot1_off; const int* LIST; const float* WTS; const unsigned* cnt; int ts[9]; int pm_lo;
    __device__ __forceinline__ void operator()(const f32x4 (&acc)[2][2][4][2], const Unit& u, int wr, int wc, int fr, int fq) const {
        const int e = u.pn >> 2, pnn = u.pn & 3, pmg = u.pm + pm_lo;
        int tse = 0;
#pragma unroll
        for (int q = 0; q < 8; ++q) tse = (q == e) ? ts[q] : tse;
        const int ne = (int)cnt[e];
#pragma unroll
        for (int ai = 0; ai < 2; ++ai)
#pragma unroll
            for (int m = 0; m < 4; ++m) {
                const int slot = (pmg - tse) * 256 + ai * 128 + wr * 64 + m * 16 + fr;
                if (slot < ne) {
                    const int tk = LIST[e * 16384 + slot]; const float w = WTS[e * 16384 + slot];
                    bf16_t* dst = FS + (long)(tk & 1) * slot1_off + (size_t)(tk >> 1) * 1024 + pnn * 256 + wc * 32 + 4 * fq;
#pragma unroll
                    for (int bj = 0; bj < 2; ++bj)
#pragma unroll
                        for (int n = 0; n < 2; ++n) *(u32x2*)(dst + bj * 128 + 16 * n) = pack4(acc[ai][bj][m][n] * w);
                }
            }
    }
};

constexpr float SC2 = 0.125f * 1.4426950408889634f;
constexpr float ATT_THR = 6.0f;
__device__ __forceinline__ float xhalf_max(float v) { auto rr = __builtin_amdgcn_permlane32_swap(__float_as_uint(v), __float_as_uint(v), false, false); return fmaxf(__uint_as_float(rr[0]), __uint_as_float(rr[1])); }
__device__ __forceinline__ float xhalf_sum(float v) { auto rr = __builtin_amdgcn_permlane32_swap(__float_as_uint(v), __float_as_uint(v), false, false); return __uint_as_float(rr[0]) + __uint_as_float(rr[1]); }

template <int DV, bool WINDOW, int ROT = 0>
__device__ __forceinline__ void attn_pass(LAS unsigned char* lds, const bf16_t* __restrict__ P, int qrow0, int qcol, int kcol, const bf16_t* __restrict__ VT,
                                          int lat_row0, int ctx_row0, int tile_lo, int tile_hi, bool has_ref, float m0, float l0, int qpos0,
                                          f32x16 (&o)[DV / 32], float& l_out, int wave, int lane) {
    constexpr int STG = 8192 + DV * 128, ND = 1 + DV / 64;
    int tid_ = threadIdx.x; asm volatile("" : "+v"(tid_)); const int tid = tid_; lane = tid & 63; const int qn = lane & 31, half = lane >> 5;
    bf16x8 qf[4];
    { const bf16_t* qp = P + (size_t)(qrow0 + wave * 32 + qn) * PP + qcol + half * 8;
#pragma unroll
      for (int ks = 0; ks < 4; ++ks) qf[ks] = *(const bf16x8*)(qp + ks * 16); }
    float mrun = has_ref ? m0 : 0.f, lrun = (half == 0) ? l0 : 0.f;
    bool need_ref = !has_ref;
    f32x16 negm;
#pragma unroll
    for (int i = 0; i < 16; ++i) negm[i] = -mrun;
#pragma unroll
    for (int db = 0; db < DV / 32; ++db)
#pragma unroll
        for (int i = 0; i < 16; ++i) o[db][i] = 0.f;
    const int nlat = tile_hi - tile_lo, nt = nlat + 4;
    const int drow = wave * 8 + (lane >> 3), dchk = ((lane & 7) ^ (4 * (wave & 1) + (lane >> 4))) * 8;
    const bf16_t* ksrc = P + (size_t)drow * PP + kcol + dchk;
    const bf16_t* vsrc = VT + (size_t)drow * KEYS + dchk;
#define ATT_DMA(ti_, sg_, vg_) do { const int id_ = (ti_) < nlat ? tile_lo + (ti_) : 128 + ((ti_) - nlat); \
        const int krow0_ = id_ < 128 ? lat_row0 + 64 * id_ : ctx_row0 + 64 * (id_ - 128); \
        LAS unsigned char* kst_ = (ROT ? lds + (sg_) * 8192 : lds + (sg_) * STG) + wave * 1024; LAS unsigned char* vst_ = (ROT ? lds + 24576 + (vg_) * (DV * 128) : lds + (sg_) * STG + 8192) + wave * 1024; \
        __builtin_amdgcn_global_load_lds((const unsigned*)(ksrc + (size_t)krow0_ * PP), (LAS unsigned*)kst_, 16, 0, 0); \
        _Pragma("unroll") for (int j_ = 0; j_ < DV / 64; ++j_) \
            __builtin_amdgcn_global_load_lds((const unsigned*)(vsrc + (size_t)(64 * j_) * KEYS + 64 * id_), (LAS unsigned*)(vst_ + j_ * 8192), 16, 0, 0); } while (0)
    __syncthreads();
    ATT_DMA(0, 0, 0);
    if (nt > 1) { ATT_DMA(1, 1, 1); asm volatile("s_waitcnt vmcnt(%0)" :: "n"(ND) : "memory"); } else asm volatile("s_waitcnt vmcnt(0)" ::: "memory");
    __syncthreads();
    int sg = 0, vg = 0;
    u32x4 pw[4];
#define ATT_PV(vs_) do { const LAS unsigned char* vs0_ = (vs_); \
        _Pragma("unroll") for (int g = 0; g < 4; ++g) { const bf16x8 pf = __builtin_bit_cast(bf16x8, pw[g]); \
            _Pragma("unroll") for (int db = 0; db < DV / 32; ++db) { \
                const bf16x8 vf = *(const LAS bf16x8*)(vs0_ + (32 * db + qn) * 128 + (((2 * g + half) ^ sw7) * 16)); \
                o[db] = __builtin_amdgcn_mfma_f32_32x32x16_bf16(vf, pf, o[db], 0, 0, 0); } } } while (0)
    const int sw7 = (qn >> 1) & 7;
    for (int ti = 0; ti < nt; ++ti) {
        if (ti + 2 < nt) { const int sg2 = sg == 0 ? 2 : sg - 1; ATT_DMA(ti + 2, sg2, (vg + 2) & 3); }
        const LAS unsigned char* Ks = ROT ? lds + sg * 8192 : lds + sg * STG; const LAS unsigned char* Vs = ROT ? lds + 24576 + vg * (DV * 128) : Ks + 8192;
        if (ROT == 2 && ti > 0) ATT_PV(lds + 24576 + ((vg + 3) & 3) * (DV * 128));
        const int id = ti < nlat ? tile_lo + ti : 128 + (ti - nlat);
        const bool islat = id < 128;
        bool skip = false;
        if (WINDOW && islat) { const int qw = qpos0 + wave * 32; skip = (64 * id + 63 < qw - 128 || 64 * id > qw + 31 + 128); }
        if (!skip) {
        f32x16 s[2];
#pragma unroll
        for (int mb = 0; mb < 2; ++mb) {
#pragma unroll
            for (int ks = 0; ks < 4; ++ks) {
                const bf16x8 kf = *(const LAS bf16x8*)(Ks + (32 * mb + qn) * 128 + (((2 * ks + half) ^ sw7) * 16));
                if (ks == 0) s[mb] = __builtin_amdgcn_mfma_f32_32x32x16_bf16(kf, qf[0], negm, 0, 0, 0);
                else s[mb] = __builtin_amdgcn_mfma_f32_32x32x16_bf16(kf, qf[ks], s[mb], 0, 0, 0);
            }
        }
        if (WINDOW && islat) {
            const int qpos = qpos0 + wave * 32 + qn;
#pragma unroll
            for (int mb = 0; mb < 2; ++mb)
#pragma unroll
                for (int i = 0; i < 16; ++i) { const int d = 64 * id + 32 * mb + 8 * (i >> 2) + 4 * half + (i & 3) - qpos; if (d > 128 || d < -128) s[mb][i] = -INFINITY; }
        }
        float mx = s[0][0];
#pragma unroll
        for (int mb = 0; mb < 2; ++mb)
#pragma unroll
            for (int i = 0; i < 16; ++i) mx = fmaxf(mx, s[mb][i]);
        mx = xhalf_max(mx);
        if (__builtin_expect(need_ref || __any(mx > ATT_THR), 0)) {
            const float delta = need_ref ? mx : fmaxf(mx, 0.f);
            if (!need_ref) {
                const float alpha = __builtin_amdgcn_exp2f(-delta);
                lrun *= alpha;
#pragma unroll
                for (int db = 0; db < DV / 32; ++db)
#pragma unroll
                    for (int i = 0; i < 16; ++i) o[db][i] *= alpha;
            }
            mrun += delta; need_ref = false;
#pragma unroll
            for (int mb = 0; mb < 2; ++mb)
#pragma unroll
                for (int i = 0; i < 16; ++i) s[mb][i] -= delta;
#pragma unroll
            for (int i = 0; i < 16; ++i) negm[i] = -mrun;
        }
        float rs = 0.f;
#pragma unroll
        for (int mb = 0; mb < 2; ++mb)
#pragma unroll
            for (int i = 0; i < 16; ++i) { const float pv = __builtin_amdgcn_exp2f(s[mb][i]); s[mb][i] = pv; rs += pv; }
        lrun += rs;
        if (ROT == 2) {
#pragma unroll
            for (int g = 0; g < 4; ++g) {
                const int mb = g >> 1, bs = 8 * (g & 1);
                pw[g].x = pk2(s[mb][bs + 0], s[mb][bs + 1]); pw[g].y = pk2(s[mb][bs + 2], s[mb][bs + 3]); pw[g].z = pk2(s[mb][bs + 4], s[mb][bs + 5]); pw[g].w = pk2(s[mb][bs + 6], s[mb][bs + 7]);
            }
        } else {
#pragma unroll
            for (int g = 0; g < 4; ++g) {
                const int mb = g >> 1, bs = 8 * (g & 1);
                u32x4 pq; pq.x = pk2(s[mb][bs + 0], s[mb][bs + 1]); pq.y = pk2(s[mb][bs + 2], s[mb][bs + 3]); pq.z = pk2(s[mb][bs + 4], s[mb][bs + 5]); pq.w = pk2(s[mb][bs + 6], s[mb][bs + 7]);
                const bf16x8 pf = __builtin_bit_cast(bf16x8, pq);
#pragma unroll
                for (int db = 0; db < DV / 32; ++db) {
                    const bf16x8 vf = *(const LAS bf16x8*)(Vs + (32 * db + qn) * 128 + (((2 * g + half) ^ sw7) * 16));
                    o[db] = __builtin_amdgcn_mfma_f32_32x32x16_bf16(vf, pf, o[db], 0, 0, 0);
                }
            }
        }
        }
        if (ti + 2 < nt) asm volatile("s_waitcnt vmcnt(%0)" :: "n"(ND) : "memory"); else asm volatile("s_waitcnt vmcnt(0)" ::: "memory");
        __syncthreads();
        sg = sg == 2 ? 0 : sg + 1; vg = (vg + 1) & 3;
    }
    if (ROT == 2) ATT_PV(lds + 24576 + ((vg + 3) & 3) * (DV * 128));
#undef ATT_DMA
#undef ATT_PV
    l_out = xhalf_sum(lrun);
}

__device__ __forceinline__ void swa_unit(LAS unsigned char* lds, const Params& p, int layer, int b, int hq, int qb, bool ctx, int wave, int lane, bool dry = false) {
    bf16_t* P = (bf16_t*)(p.ws + WS_P);
    const int kvh = hq >> 2;
    const bf16_t* VT = (const bf16_t*)(p.ws + WS_VTS) + (size_t)((b * 2 + kvh) * 64) * KEYS;
    const float sink2 = p.in[11][layer * 8 + hq] * 1.4426950408889634f;
    const int qrow0 = ctx ? NLAT + b * CTXL : b * SEQ + qb * 256;
    f32x16 o[2]; float l;
    if (ctx) attn_pass<64, false>(lds, P, qrow0, IC_QS + hq * 64, IC_KS + kvh * 64, VT, b * SEQ, NLAT + b * CTXL, 0, 0, true, sink2, 1.0f, 0, o, l, wave, lane);
    else {
        int lo = 4 * qb - 2; if (lo < 0) lo = 0; int hi = 4 * qb + 6; if (hi > 128) hi = 128;
        attn_pass<64, true>(lds, P, qrow0, IC_QS + hq * 64, IC_KS + kvh * 64, VT, b * SEQ, NLAT + b * CTXL, lo, hi, true, sink2, 1.0f, qb * 256, o, l, wave, lane);
    }
    const float inv = 1.0f / l; const int qn = lane & 31, half = lane >> 5;
    bf16_t* dst = P + (size_t)(qrow0 + wave * 32 + qn) * PP + IC_QS + hq * 64 + 4 * half;
#pragma unroll
    for (int db = 0; db < 2; ++db)
#pragma unroll
        for (int q4 = 0; q4 < 4; ++q4) {
            const f32x4 v = (f32x4){o[db][4 * q4] * inv, o[db][4 * q4 + 1] * inv, o[db][4 * q4 + 2] * inv, o[db][4 * q4 + 3] * inv};
            if (!dry) *(u32x2*)(dst + 32 * db + 8 * q4) = pack4(v);
        }
}
__device__ __forceinline__ void diff_unit(LAS unsigned char* lds, const Params& p, float lam, int b, int h, int qb, bool ctx, int unit, int wave, int lane, bool dry = false) {
    bf16_t* P = (bf16_t*)(p.ws + WS_P);
    const bf16_t* VT = (const bf16_t*)(p.ws + WS_VTD) + (size_t)((b * 4 + h) * 128) * KEYS;
    const int qrow0 = ctx ? NLAT + b * CTXL : b * SEQ + qb * 256;
    const int thi = ctx ? 0 : 128;
    unsigned* park = (unsigned*)(p.ws + WS_YA) + (size_t)(4 * unit) * 8192 + threadIdx.x;
#define PARK(w_) park[(size_t)((w_) >> 3) * 8192 + ((w_) & 7) * 512]
    f32x16 o[4]; float l;
    if (wave < 4) attn_pass<128, false, 1>(lds, P, qrow0, IC_QD + h * 128, IC_KD + h * 128, VT, b * SEQ, NLAT + b * CTXL, 0, thi, false, 0.f, 0.f, 0, o, l, wave, lane);
    else attn_pass<128, false, 2>(lds, P, qrow0, IC_QD + h * 128, IC_KD + h * 128, VT, b * SEQ, NLAT + b * CTXL, 0, thi, false, 0.f, 0.f, 0, o, l, wave, lane);
    { const float inv = 1.0f / l;
#pragma unroll
      for (int db = 0; db < 4; ++db)
#pragma unroll
          for (int i = 0; i < 8; ++i) PARK(db * 8 + i) = pk2(o[db][2 * i] * inv, o[db][2 * i + 1] * inv); }
    if (wave < 4) attn_pass<128, false, 1>(lds, P, qrow0, IC_QD + h * 128 + 64, IC_KD + h * 128 + 64, VT, b * SEQ, NLAT + b * CTXL, 0, thi, false, 0.f, 0.f, 0, o, l, wave, lane);
    else attn_pass<128, false, 2>(lds, P, qrow0, IC_QD + h * 128 + 64, IC_KD + h * 128 + 64, VT, b * SEQ, NLAT + b * CTXL, 0, thi, false, 0.f, 0.f, 0, o, l, wave, lane);
    const float inv = lam / l; const int qn = lane & 31, half = lane >> 5;
    bf16_t* dst = P + (size_t)(qrow0 + wave * 32 + qn) * PP + IC_QD + h * 128 + 4 * half;
#pragma unroll
    for (int db = 0; db < 4; ++db)
#pragma unroll
        for (int q4 = 0; q4 < 4; ++q4) {
            const unsigned pa = PARK(db * 8 + 2 * q4), pb = PARK(db * 8 + 2 * q4 + 1);
            const f32x4 v = (f32x4){bflo(pa) - o[db][4 * q4] * inv, bfhi(pa) - o[db][4 * q4 + 1] * inv, bflo(pb) - o[db][4 * q4 + 2] * inv, bfhi(pb) - o[db][4 * q4 + 3] * inv};
            if (!dry) *(u32x2*)(dst + 32 * db + 8 * q4) = pack4(v);
        }
#undef PARK
}

__device__ __forceinline__ void ld8bf(const bf16_t* p, float (&v)[8]) { const u32x4 w = *(const u32x4*)p; v[0] = bflo(w.x); v[1] = bfhi(w.x); v[2] = bflo(w.y); v[3] = bfhi(w.y); v[4] = bflo(w.z); v[5] = bfhi(w.z); v[6] = bflo(w.w); v[7] = bfhi(w.w); }
__device__ __forceinline__ void ld8f(const float* p, float (&v)[8]) { const f32x4 a = ((const f32x4*)p)[0], b = ((const f32x4*)p)[1]; v[0] = a.x; v[1] = a.y; v[2] = a.z; v[3] = a.w; v[4] = b.x; v[5] = b.y; v[6] = b.z; v[7] = b.w; }
__device__ __forceinline__ void st8f(float* p, const float (&v)[8]) { ((f32x4*)p)[0] = (f32x4){v[0], v[1], v[2], v[3]}; ((f32x4*)p)[1] = (f32x4){v[4], v[5], v[6], v[7]}; }

__device__ __forceinline__ void rwkv_prepare_phase(const Params& p, int layer, int gw, int NGW, int lane) {
    const bf16_t* P = (const bf16_t*)(p.ws + WS_P); float* ST = (float*)(p.ws + WS_ST); bf16_t* A2 = (bf16_t*)(p.ws + WS_YA);
    const float* mup = p.in[12] + layer * 1920; const float* mun = p.in[13] + layer * 1920; const float* k_k = p.in[19] + layer * 512;
    for (int m = gw; m < NTOK; m += NGW) {
        const int t = m < NLAT ? (m & (SEQ - 1)) : ((m - NLAT) & (CTXL - 1)), len = m < NLAT ? SEQ : CTXL;
        const bool hp = t > 0, hn = t < len - 1;
        const bf16_t* pr = P + (size_t)m * PP + IC_RW;
        const int h = lane >> 3, kidx = (lane & 7) * 8;
        float* sp = ST + ((size_t)m * 8 + h) * (ST_SLOTS * 64) + kidx;
#pragma unroll
        for (int sec = 0; sec < 4; ++sec) {
            if (sec == 3 && lane >= 48) break;
            const int col = sec < 3 ? sec * 512 + lane * 8 : 1536 + lane * 8;
            float c[8], pv[8], nx[8], a[8], bb[8], sh[8];
            ld8bf(pr + col, c);
            if (hp) ld8bf(pr - PP + col, pv); else {
#pragma unroll
                for (int q = 0; q < 8; ++q) pv[q] = 0.f; }
            if (hn) ld8bf(pr + PP + col, nx); else {
#pragma unroll
                for (int q = 0; q < 8; ++q) nx[q] = 0.f; }
            ld8f(mup + col, a); ld8f(mun + col, bb);
#pragma unroll
            for (int q = 0; q < 8; ++q) sh[q] = c[q] + a[q] * (pv[q] - c[q]) + bb[q] * (nx[q] - c[q]);
            if (sec == 0) st8f(sp + SL_R * 64, sh);
            else if (sec == 2) st8f(sp + SL_V * 64, sh);
            else if (sec == 1) {
                st8f(sp + SL_K * 64, sh);
                float kk[8], kkw[8]; ld8f(k_k + lane * 8, kkw);
                float ss = 0.f;
#pragma unroll
                for (int q = 0; q < 8; ++q) { kk[q] = sh[q] * kkw[q]; ss += kk[q] * kk[q]; }
                ss += __shfl_xor(ss, 1); ss += __shfl_xor(ss, 2); ss += __shfl_xor(ss, 4);
                const float inv = 1.0f / fmaxf(sqrtf(ss), 1e-12f);
#pragma unroll
                for (int q = 0; q < 8; ++q) kk[q] *= inv;
                st8f(sp + SL_KK * 64, kk);
            } else {
                float o[8];
#pragma unroll
                for (int q = 0; q < 8; ++q) o[q] = lane < 16 ? tanhf(sh[q]) : (lane < 32 ? sh[q] : sigmoidf_(sh[q]));
                u32x4 w; w.x = pk2(o[0], o[1]); w.y = pk2(o[2], o[3]); w.z = pk2(o[4], o[5]); w.w = pk2(o[6], o[7]);
                *(u32x4*)(A2 + (size_t)m * 384 + lane * 8) = w;
            }
        }
    }
}

constexpr int NSEG = 64, SEGL = KEYS / NSEG;
static_assert(SEGL * NSEG == KEYS && SEGL % 4 == 0, "segments");
constexpr size_t WS_GH = WS_YA;
static_assert(WS_GH + 32ull * NSEG * 2 * 4096 * 4 <= 560 * MiB, "GH fits behind the stream");
__device__ __forceinline__ int scan_token(int b, int dir, int s) {
    if (s < CTXL) return NLAT + b * CTXL + (dir ? CTXL - 1 - s : s);
    const int t = s - CTXL; return b * SEQ + (dir ? SEQ - 1 - t : t);
}
constexpr int SRING = 6, SREC = 6 * 64 * 4;
constexpr int SCAN_LDS = SRING * SREC;
__device__ __forceinline__ void scan_dma(const float* rec, LAS unsigned char* slot, int lane) {
    const float* q = rec + lane * 4;
    __builtin_amdgcn_global_load_lds((const unsigned*)q, (LAS unsigned*)slot, 16, 0, 0);
    if (lane < 32) __builtin_amdgcn_global_load_lds((const unsigned*)(q + 256), (LAS unsigned*)(slot + 1024), 16, 0, 0);
}
template <int MODE>
__device__ __forceinline__ void rwkv_segment(const Params& p, int layer, int sid, int seg, int lane, LAS unsigned char* ring) {
    const int b = sid >> 4, h = (sid >> 1) & 7, dir = sid & 1, c = lane & 31, hf = lane >> 5;
    const float ka0 = p.in[20][layer * 512 + h * 64 + c], ka1 = p.in[20][layer * 512 + h * 64 + 32 + c];
    const float rk0 = MODE == 2 ? p.in[21][layer * 512 + h * 64 + c] : 0.f, rk1 = MODE == 2 ? p.in[21][layer * 512 + h * 64 + 32 + c] : 0.f;
    const float* ST = (const float*)(p.ws + WS_ST);
    float* gh = (float*)(p.ws + WS_GH) + ((size_t)sid * NSEG + seg) * 2 * 4096;
    f32x16 TH[2][2], TG[MODE == 0 ? 2 : 1][2];
#pragma unroll
    for (int kb = 0; kb < 2; ++kb)
#pragma unroll
        for (int vb = 0; vb < 2; ++vb) {
            if (MODE == 2 && seg > 0) {
                const float* src = gh - 4096 + (32 * vb + c) * 64 + 32 * kb + 4 * hf;
#pragma unroll
                for (int q = 0; q < 4; ++q) { const f32x4 t = *(const f32x4*)(src + 8 * q); TH[kb][vb][4 * q] = t.x; TH[kb][vb][4 * q + 1] = t.y; TH[kb][vb][4 * q + 2] = t.z; TH[kb][vb][4 * q + 3] = t.w; }
            } else {
#pragma unroll
                for (int r = 0; r < 16; ++r) TH[kb][vb][r] = 0.f;
            }
            if (MODE == 0) {
#pragma unroll
                for (int r = 0; r < 16; ++r) TG[MODE == 0 ? kb : 0][vb][r] = (32 * kb + 8 * (r >> 2) + 4 * hf + (r & 3) == 32 * vb + c) ? 1.0f : 0.0f;
            }
        }
    const int s0 = seg * SEGL, s_end = s0 + SEGL;
    const int okk = dir ? 0 : 512, od = dir ? 1024 : 0, gsl = dir ? SL_KK * 64 : 0;
#pragma unroll 1
    for (int j = 0; j < SRING - 1; ++j) scan_dma(ST + ((size_t)scan_token(b, dir, s0 + j) * 8 + h) * (ST_SLOTS * 64) + gsl, ring + j * SREC, lane);
    int slot_i = 0;
#pragma unroll 1
    for (int s = s0; s < s_end; ++s) {
        if (s + SRING - 1 < s_end) {
            int nslot = slot_i + SRING - 1; if (nslot >= SRING) nslot -= SRING;
            scan_dma(ST + ((size_t)scan_token(b, dir, s + SRING - 1) * 8 + h) * (ST_SLOTS * 64) + gsl, ring + nslot * SREC, lane);
            asm volatile("s_waitcnt vmcnt(10)" ::: "memory");
        } else asm volatile("s_waitcnt vmcnt(0)" ::: "memory");
        const LAS unsigned char* rec = ring + slot_i * SREC;
        slot_i = slot_i + 1 == SRING ? 0 : slot_i + 1;
        f32x2_t ph[2] = {{0.f, 0.f}, {0.f, 0.f}}, pg[2] = {{0.f, 0.f}, {0.f, 0.f}};
#pragma unroll
        for (int kb = 0; kb < 2; ++kb)
#pragma unroll
            for (int q = 0; q < 4; ++q) {
                const f32x4 a4 = *(const LAS f32x4*)(rec + okk + (32 * kb + 8 * q + 4 * hf) * 4);
#pragma unroll
                for (int j = 0; j < 4; j += 2)
#pragma unroll
                    for (int vb = 0; vb < 2; ++vb) {
                        const f32x2_t a2 = {a4[j], a4[j + 1]};
                        ph[vb] = __builtin_elementwise_fma((f32x2_t){TH[kb][vb][4 * q + j], TH[kb][vb][4 * q + j + 1]}, a2, ph[vb]);
                        if (MODE == 0) pg[vb] = __builtin_elementwise_fma((f32x2_t){TG[MODE == 0 ? kb : 0][vb][4 * q + j], TG[MODE == 0 ? kb : 0][vb][4 * q + j + 1]}, a2, pg[vb]);
                    }
            }
        float sa[2], sg[2];
#pragma unroll
        for (int vb = 0; vb < 2; ++vb) { sa[vb] = xhalf_sum(ph[vb].x + ph[vb].y); sg[vb] = MODE == 0 ? xhalf_sum(pg[vb].x + pg[vb].y) : 0.f; }
#pragma unroll
        for (int kb = 0; kb < 2; ++kb)
#pragma unroll
            for (int q = 0; q < 4; ++q) {
                const f32x4 w4 = *(const LAS f32x4*)(rec + od + (32 * kb + 8 * q + 4 * hf) * 4);
#pragma unroll
                for (int j = 0; j < 4; ++j)
#pragma unroll
                    for (int vb = 0; vb < 2; ++vb) { TH[kb][vb][4 * q + j] *= w4[j]; if (MODE == 0) TG[MODE == 0 ? kb : 0][vb][4 * q + j] *= w4[j]; }
            }
        float aop[2], bop[2], bopg[2];
#pragma unroll
        for (int kb = 0; kb < 2; ++kb) {
            const float ag = *(const LAS float*)(rec + od + 256 + (32 * kb + c) * 4), x = *(const LAS float*)(rec + okk + (hf ? 768 : 0) + (32 * kb + c) * 4);
            aop[kb] = x * (hf ? fmaf(ag - 1.0f, kb ? ka1 : ka0, 1.0f) : -ag);
        }
        float bonus = 0.f;
        if (MODE == 2) {
            const float r0 = *(const LAS float*)(rec + okk + 256 + c * 4), r1 = *(const LAS float*)(rec + okk + 256 + (32 + c) * 4);
            bonus = fmaf(aop[0] * r0, rk0, aop[1] * r1 * rk1);
        }
#pragma unroll
        for (int vb = 0; vb < 2; ++vb) { const float vv = *(const LAS float*)(rec + okk + 512 + (32 * vb + c) * 4); bop[vb] = hf ? vv : sa[vb]; bopg[vb] = hf ? 0.f : sg[vb]; }
#pragma unroll
        for (int kb = 0; kb < 2; ++kb)
#pragma unroll
            for (int vb = 0; vb < 2; ++vb) {
                TH[kb][vb] = __builtin_amdgcn_mfma_f32_32x32x2f32(aop[kb], bop[vb], TH[kb][vb], 0, 0, 0);
                if (MODE == 0) TG[MODE == 0 ? kb : 0][vb] = __builtin_amdgcn_mfma_f32_32x32x2f32(aop[kb], bopg[vb], TG[MODE == 0 ? kb : 0][vb], 0, 0, 0);
            }
        if (MODE == 2) {
            f32x2_t py[2] = {{0.f, 0.f}, {0.f, 0.f}};
#pragma unroll
            for (int kb = 0; kb < 2; ++kb)
#pragma unroll
                for (int q = 0; q < 4; ++q) {
                    const f32x4 r4 = *(const LAS f32x4*)(rec + okk + 256 + (32 * kb + 8 * q + 4 * hf) * 4);
#pragma unroll
                    for (int j = 0; j < 4; j += 2)
#pragma unroll
                        for (int vb = 0; vb < 2; ++vb) py[vb] = __builtin_elementwise_fma((f32x2_t){TH[kb][vb][4 * q + j], TH[kb][vb][4 * q + j + 1]}, (f32x2_t){r4[j], r4[j + 1]}, py[vb]);
                }
            const float y0 = xhalf_sum(py[0].x + py[0].y), y1 = xhalf_sum(py[1].x + py[1].y);
            float* yp = (float*)ST + ((size_t)scan_token(b, dir, s) * 8 + h) * (ST_SLOTS * 64) + (dir ? SL_W1 : SL_W0) * 64 + c;
            if (hf == 0) { yp[0] = y0; yp[32] = y1; }
            if (hf) yp[64] = bonus;
        }
    }
    if (MODE == 0) {
#pragma unroll
        for (int kb = 0; kb < 2; ++kb)
#pragma unroll
            for (int vb = 0; vb < 2; ++vb) {
                float* dg = gh + (32 * vb + c) * 64 + 32 * kb + 4 * hf; float* dh = dg + 4096;
#pragma unroll
                for (int q = 0; q < 4; ++q) {
                    *(f32x4*)(dg + 8 * q) = (f32x4){TG[MODE == 0 ? kb : 0][vb][4 * q], TG[MODE == 0 ? kb : 0][vb][4 * q + 1], TG[MODE == 0 ? kb : 0][vb][4 * q + 2], TG[MODE == 0 ? kb : 0][vb][4 * q + 3]};
                    *(f32x4*)(dh + 8 * q) = (f32x4){TH[kb][vb][4 * q], TH[kb][vb][4 * q + 1], TH[kb][vb][4 * q + 2], TH[kb][vb][4 * q + 3]};
                }
            }
    }
}
__device__ __forceinline__ void rwkv_combine(const Params& p, int sid, LAS unsigned char* lds, int wave, int lane) {
    float* gh0 = (float*)(p.ws + WS_GH) + (size_t)sid * NSEG * 2 * 4096;
    LAS float* Sx = (LAS float*)lds;
    constexpr int CB0 = 20480;
    const int tid = wave * 64 + lane;
#define CMB_DMA(i_) do { const float* g_ = gh0 + (size_t)(i_) * 2 * 4096 + tid * 4; LAS unsigned char* b_ = lds + CB0 + ((i_) & 1) * 32768 + wave * 1024; \
        _Pragma("unroll") for (int j_ = 0; j_ < 4; ++j_) __builtin_amdgcn_global_load_lds((const unsigned*)(g_ + j_ * 2048), (LAS unsigned*)(b_ + j_ * 8192), 16, 0, 0); } while (0)
    CMB_DMA(1);
    for (int e = tid; e < 4096; e += NTHREADS) Sx[(e >> 6) * 65 + (e & 63)] = gh0[4096 + e];
    asm volatile("s_waitcnt vmcnt(0)" ::: "memory");
    __syncthreads();
    const int rb = (wave >> 1) & 1, cb = wave & 1, i32 = lane & 31, hf = lane >> 5;
    for (int i = 1; i < NSEG - 1; ++i) {
        float* gi = gh0 + (size_t)i * 2 * 4096;
        if (i + 1 < NSEG - 1) CMB_DMA(i + 1);
        f32x16 d;
        if (wave < 4) {
            const LAS float* gb = (const LAS float*)(lds + CB0 + (i & 1) * 32768);
            float bq[32];
#pragma unroll
            for (int q = 0; q < 32; ++q) bq[q] = gb[(2 * q + hf) * 64 + 32 * cb + i32];
#pragma unroll
            for (int r = 0; r < 16; ++r) d[r] = gb[4096 + (32 * rb + 8 * (r >> 2) + 4 * hf + (r & 3)) * 64 + 32 * cb + i32];
#pragma unroll
            for (int q = 0; q < 32; ++q) {
                const float aq = Sx[(32 * rb + i32) * 65 + 2 * q + hf];
                d = __builtin_amdgcn_mfma_f32_32x32x2f32(aq, bq[q], d, 0, 0, 0);
            }
#pragma unroll
            for (int r = 0; r < 16; ++r) gi[4096 + (32 * rb + 8 * (r >> 2) + 4 * hf + (r & 3)) * 64 + 32 * cb + i32] = d[r];
        }
        __syncthreads();
        if (wave < 4) {
#pragma unroll
            for (int r = 0; r < 16; ++r) Sx[(32 * rb + 8 * (r >> 2) + 4 * hf + (r & 3)) * 65 + 32 * cb + i32] = d[r];
            asm volatile("s_waitcnt vmcnt(16)" ::: "memory");
        } else asm volatile("s_waitcnt vmcnt(0)" ::: "memory");
        __syncthreads();
    }
#undef CMB_DMA
}

__device__ __forceinline__ void postmix_phase(const Params& p, int layer, float lam_init, int M, int gw, int NGW, int lane) {
    const bf16_t* P = (const bf16_t*)(p.ws + WS_P); const float* ST = (const float*)(p.ws + WS_ST);
    bf16_t* YB = (bf16_t*)(p.ws + WS_YB); bf16_t* YC = (bf16_t*)(p.ws + WS_YC);
    const float* lng = p.in[22] + layer * 512; const float* lnb = p.in[23] + layer * 512; const float* sg = p.in[25] + layer * 128;
    for (int m = gw; m < M; m += NGW) {
        {
            const int h = lane >> 3, kidx = (lane & 7) * 8, ch = lane * 8;
            const float* sp = ST + ((size_t)m * 8 + h) * (ST_SLOTS * 64) + kidx;
            float y[8], v[8], g[8], lg[8], lb[8];
            { float yb_[8]; ld8f(sp + SL_W0 * 64, y); ld8f(sp + SL_W1 * 64, yb_);
#pragma unroll
              for (int q = 0; q < 8; ++q) y[q] += yb_[q]; }
            ld8f(sp + SL_V * 64, v); ld8f(lng + ch, lg); ld8f(lnb + ch, lb);
            ld8bf(P + (size_t)m * PP + IC_RW + ch, g);
            float s = 0.f;
#pragma unroll
            for (int q = 0; q < 8; ++q) s += y[q];
            s += __shfl_xor(s, 1); s += __shfl_xor(s, 2); s += __shfl_xor(s, 4);
            float bn;
            { const f32x4 b0 = *(const f32x4*)(sp - kidx + SL_A0 * 64 + (lane & 7) * 4), b1 = *(const f32x4*)(sp - kidx + SL_A1 * 64 + (lane & 7) * 4);
              bn = ((b0.x + b0.y) + (b0.z + b0.w)) + ((b1.x + b1.y) + (b1.z + b1.w));
              bn += __shfl_xor(bn, 1); bn += __shfl_xor(bn, 2); bn += __shfl_xor(bn, 4); }
            const float mu = s * (1.0f / 64.0f);
            float var = 0.f;
#pragma unroll
            for (int q = 0; q < 8; ++q) { const float d = y[q] - mu; var += d * d; }
            var += __shfl_xor(var, 1); var += __shfl_xor(var, 2); var += __shfl_xor(var, 4);
            const float rstd = 1.0f / sqrtf(var * (1.0f / 64.0f) + 64e-5f);
            float o[8];
#pragma unroll
            for (int q = 0; q < 8; ++q) o[q] = (((y[q] - mu) * rstd) * lg[q] + lb[q] + bn * v[q]) * g[q];
            u32x4 w; w.x = pk2(o[0], o[1]); w.y = pk2(o[2], o[3]); w.z = pk2(o[4], o[5]); w.w = pk2(o[6], o[7]);
            *(u32x4*)(YB + (size_t)m * 512 + ch) = w;
        }
        *(u32x4*)((bf16_t*)(p.ws + WS_YA) + (size_t)m * 512 + lane * 8) = *(const u32x4*)(P + (size_t)m * PP + IC_QS + lane * 8);
        {
            const int e = (lane & 15) * 8;
            float x[8], gg[8];
            ld8bf(P + (size_t)m * PP + IC_QD + lane * 8, x); ld8f(sg + e, gg);
            float ss = 0.f;
#pragma unroll
            for (int q = 0; q < 8; ++q) ss += x[q] * x[q];
            ss += __shfl_xor(ss, 1); ss += __shfl_xor(ss, 2); ss += __shfl_xor(ss, 4); ss += __shfl_xor(ss, 8);
            const float rstd = (1.0f - lam_init) / sqrtf(ss * (1.0f / 128.0f) + 1e-5f);
            float o[8];
#pragma unroll
            for (int q = 0; q < 8; ++q) o[q] = x[q] * rstd * gg[q];
            u32x4 w; w.x = pk2(o[0], o[1]); w.y = pk2(o[2], o[3]); w.z = pk2(o[4], o[5]); w.w = pk2(o[6], o[7]);
            *(u32x4*)(YC + (size_t)m * 512 + lane * 8) = w;
        }
    }
}
#define XB_TMO      128
#define XB_XCNT(j)  (256  + 64 * (j))
#define XB_XSUB(j)  (1280 + 64 * (j))
#define XB_XGEN(j)  (2304 + 64 * (j))
#define XB_TOP      3328
#define XB_TOPGEN   3392
#define XCD_BAR_WORDS 3456
#define XB_SPIN_CAP (1u << 18)

__device__ __forceinline__ unsigned xb_ld(unsigned* p)              { return __hip_atomic_load(p, __ATOMIC_RELAXED, __HIP_MEMORY_SCOPE_AGENT); }
__device__ __forceinline__ unsigned xb_add(unsigned* p, unsigned v) { return __hip_atomic_fetch_add(p, v, __ATOMIC_RELAXED, __HIP_MEMORY_SCOPE_AGENT); }
__device__ __forceinline__ unsigned xb_xcc_id() { return (unsigned)__builtin_amdgcn_s_getreg((3 << 11) | 20) & 0xFu; }
#define XB_SPIN(cond, bar) do { unsigned _sp = 0; while (cond) { __builtin_amdgcn_s_sleep(1); \
    if ((++_sp & 255u) == 0u) { if (xb_ld(&(bar)[XB_TMO])) break; if (_sp > XB_SPIN_CAP) { atomicAdd(&(bar)[XB_TMO], 1u); break; } } } } while (0)

struct XcdBarrier {
    unsigned* bar; unsigned x;
    volatile LAS unsigned* st;
};

__device__ __forceinline__ XcdBarrier xcd_barrier_post(unsigned* bar, volatile LAS unsigned* st) {
    XcdBarrier b; b.bar = bar; b.x = xb_xcc_id(); b.st = st;
    if (threadIdx.x == 0) (void)xb_add(&bar[XB_XCNT(b.x)], 1u);
    return b;
}
__device__ __forceinline__ void xcd_barrier_complete(unsigned* bar, unsigned x, unsigned& nloc, unsigned& nx) {
    const unsigned G = gridDim.x * gridDim.y * gridDim.z;
    unsigned sum, cnt, mine, sp = 0u;
    for (;;) {
        sum = 0u; cnt = 0u; mine = 0u;
#pragma unroll
        for (unsigned j = 0; j < 16; ++j) { const unsigned c = xb_ld(&bar[XB_XCNT(j)]); sum += c; cnt += (c > 0u) ? 1u : 0u; mine = (j == x) ? c : mine; }
        if (sum == G) break;
        __builtin_amdgcn_s_sleep(1);
        if ((++sp & 255u) == 0u) { if (xb_ld(&bar[XB_TMO])) break; if (sp > XB_SPIN_CAP) { atomicAdd(&bar[XB_TMO], 1u); break; } }
    }
    nloc = mine > 0u ? mine : 1u; nx = cnt > 0u ? cnt : 1u;
}

__device__ __forceinline__ void xcd_barrier(const XcdBarrier& b) {
    asm volatile("s_waitcnt vmcnt(0)" ::: "memory");
    __syncthreads();
    if (threadIdx.x == 0) {
        unsigned* bar = b.bar;
        __builtin_amdgcn_s_waitcnt(0);
        unsigned nloc = b.st[0], nx = b.st[1];
        if (nloc == 0u) { xcd_barrier_complete(bar, b.x, nloc, nx); b.st[0] = nloc; b.st[1] = nx; }
        const unsigned old = xb_add(&bar[XB_XSUB(b.x)], 1u);
        const unsigned gen = old / nloc;
        if (old + 1u == (gen + 1u) * nloc) {
            __builtin_amdgcn_fence(__ATOMIC_RELEASE, "agent");
            asm volatile("s_waitcnt vmcnt(0)" ::: "memory");
            const unsigned og = xb_add(&bar[XB_TOP], 1u);
            const unsigned tg = og / nx;
            if (og + 1u == (tg + 1u) * nx) xb_add(&bar[XB_TOPGEN], 1u);
            else XB_SPIN(xb_ld(&bar[XB_TOPGEN]) == tg, bar);
            __builtin_amdgcn_fence(__ATOMIC_ACQUIRE, "agent");
            xb_add(&bar[XB_XGEN(b.x)], 1u);
            asm volatile("s_waitcnt vmcnt(0)" ::: "memory");
        } else {
            XB_SPIN(xb_ld(&bar[XB_XGEN(b.x)]) == gen, bar);
            __builtin_amdgcn_fence(__ATOMIC_ACQUIRE, "agent");
            asm volatile("s_waitcnt vmcnt(0)" ::: "memory");
        }
    }
    __syncthreads();
}

#ifndef MK_MULTI
#define MK_MULTI 0
#endif
constexpr int N_PHASES = 40;

#ifndef PROBE_MASK
#define PROBE_MASK 0ull
#endif
#ifndef PROBE_MASK2
#define PROBE_MASK2 0ull
#endif
#define PROBE_MULT 4ull
constexpr int LDS_PARAMS = LDS_BYTES - 1024;
constexpr int LDS_XB = LDS_BYTES - 64;
constexpr int CW_BAR = 8192;
__device__ __forceinline__ unsigned long long uni64(unsigned long long v) {
    const unsigned lo = __builtin_amdgcn_readfirstlane((unsigned)v), hi = __builtin_amdgcn_readfirstlane((unsigned)(v >> 32));
    return ((unsigned long long)hi << 32) | lo;
}
__device__ __forceinline__ int opq(int v) { asm volatile("" : "+s"(v)); return v; }
__device__ __forceinline__ void load_params(LAS unsigned char* lds, Params& q) {
    LAS const unsigned long long* s = (LAS const unsigned long long*)(lds + LDS_PARAMS);
#pragma unroll
    for (int i = 0; i < 37; ++i) q.in[i] = (const float*)(const __attribute__((address_space(1))) float*)uni64(s[i]);
    q.out = (float*)(__attribute__((address_space(1))) float*)uni64(s[37]); q.ws = (unsigned char*)(__attribute__((address_space(1))) unsigned char*)uni64(s[38]); q.ph_lo = 0; q.ph_hi = 0;
}
__global__ void __launch_bounds__(NTHREADS, 2) mk_fwd(Params kp) {
    extern __shared__ __attribute__((aligned(16))) unsigned char lds_raw[];
    LAS unsigned char* lds = (LAS unsigned char*)lds_raw;
    cg::grid_group grid = cg::this_grid();
    if (threadIdx.x == 0) {
        LAS unsigned long long* s = (LAS unsigned long long*)(lds + LDS_PARAMS);
#pragma unroll
        for (int i = 0; i < 37; ++i) s[i] = (unsigned long long)kp.in[i];
        s[37] = (unsigned long long)kp.out; s[38] = (unsigned long long)kp.ws;
    }
    if (threadIdx.x < 2) ((LAS unsigned*)(lds + LDS_XB))[threadIdx.x] = 0u;
    __syncthreads();
#if !MK_MULTI
    (void)xcd_barrier_post((unsigned*)(kp.ws + WS_CTL) + CW_BAR, (volatile LAS unsigned*)(lds + LDS_XB));
#endif
    const int ph_lo = kp.ph_lo, ph_hi = kp.ph_hi;
    int ph = 0;
    if ((PROBE_MASK | PROBE_MASK2) != 0ull && threadIdx.x == 0) { LAS unsigned long long* pt_ = (LAS unsigned long long*)(lds + LDS_PARAMS + 320); pt_[0] = __builtin_amdgcn_s_memrealtime(); pt_[1] = 0ull; }
#define PH_BEGIN if (ph >= ph_lo && ph < ph_hi) { asm volatile("" ::: "memory"); Params p; load_params(lds, p); unsigned char* ws = p.ws; (void)ws; \
    int tid_ = threadIdx.x, bid_ = blockIdx.x, G_ = gridDim.x; asm volatile("" : "+v"(tid_), "+s"(bid_), "+s"(G_)); \
    const int tid = tid_, bid = bid_, G = G_, lane = tid & 63, wave = __builtin_amdgcn_readfirstlane(tid >> 6); const int gw = bid * NWAVES + wave, NGW = G * NWAVES; (void)gw; (void)NGW; (void)lane; (void)tid; (void)G; (void)bid;
#define GRID_SEAM() do { if (ph == 0) grid.sync(); else { XcdBarrier xb_; xb_.bar = (unsigned*)((unsigned char*)(__attribute__((address_space(1))) unsigned char*)uni64(((LAS const unsigned long long*)(lds + LDS_PARAMS))[38]) + WS_CTL) + CW_BAR; \
        xb_.x = xb_xcc_id(); xb_.st = (volatile LAS unsigned*)(lds + LDS_XB); xcd_barrier(xb_); } } while (0)
#define PROBE_TICK() do { if ((PROBE_MASK | PROBE_MASK2) != 0ull && blockIdx.x == 0 && threadIdx.x == 0) { LAS unsigned long long* pt_ = (LAS unsigned long long*)(lds + LDS_PARAMS + 320); \
        const unsigned long long now_ = __builtin_amdgcn_s_memrealtime(); if ((PROBE_MASK >> ph) & 1ull) pt_[1] += now_ - pt_[0]; pt_[0] = now_; } } while (0)
#define PROBE_MID() do { if ((PROBE_MASK | PROBE_MASK2) != 0ull && blockIdx.x == 0 && threadIdx.x == 0) { LAS unsigned long long* pt_ = (LAS unsigned long long*)(lds + LDS_PARAMS + 320); \
        const unsigned long long now_ = __builtin_amdgcn_s_memrealtime(); if ((PROBE_MASK2 >> ph) & 1ull) pt_[1] += now_ - pt_[0]; pt_[0] = now_; } } while (0)
#define PH_END } if (ph >= ph_lo && ph + 1 < ph_hi) GRID_SEAM(); PROBE_TICK(); ++ph;

    using pg8::Gemm; using pg8::StaticOrder; using pg8::gemm_phase;

    PH_BEGIN
        convert_layer_weights(p, 0, lds, gw, NGW, wave, lane);
        __syncthreads();
        adaln_phase(p, lds, wave, lane);
    PH_END
    PH_BEGIN
        premix_phase(p, 0, true, NTOK, gw, NGW, lane);
    PH_END

#pragma clang loop unroll(full)
    for (int layer = 0; layer < 2; ++layer) {
        const int Ml = layer == 0 ? NTOK : NLAT;
        const float lam_init = 0.8f - 0.6f * expf(-0.3f * (float)layer);
        PH_BEGIN
            Gemm g{(const bf16_t*)(ws + WS_XN), (const bf16_t*)(ws + WS_WIN), NTOK, NIN1, opq(1024), 1024}; StaticOrder S; S.init(NTOK, NIN1, G, bid);
            EpiIn E{(bf16_t*)(ws + WS_P), (bf16_t*)(ws + WS_VTS), (bf16_t*)(ws + WS_VTD), (const float*)(ws + WS_ROPE)};
            gemm_phase<EpiIn, StaticOrder, true, true>(lds, g, S, E);
        PH_END
        PH_BEGIN
            rwkv_prepare_phase(p, layer, gw, NGW, lane);
        PH_END
        PH_BEGIN
            Gemm g{(const bf16_t*)(ws + WS_YA), (const bf16_t*)(ws + WS_LORA), NTOK, 2560, opq(128), 384}; LoraSched S; S.S.init(NTOK, 2560, G, bid);
            EpiLora E{(float*)(ws + WS_ST), (bf16_t*)(ws + WS_P), p.in[14] + layer * 1024, p.in[16] + layer * 1024};
            gemm_phase<EpiLora, LoraSched, true, true>(lds, g, S, E);
        PH_END
        PH_BEGIN
            for (int u = gw; u < 32 * (NSEG - 1); u += NGW) rwkv_segment<0>(p, layer, u / (NSEG - 1), u % (NSEG - 1), lane, lds + wave * SCAN_LDS);
        PH_END
        PH_BEGIN
            unsigned* qhead = (unsigned*)(ws + WS_CTL) + (layer == 0 ? CW_Q0 : CW_Q1);
            LAS int* ubox = (LAS int*)(lds + 65536);
            const int n_swa = 512 + (layer == 0 ? 16 : 0);
            if (bid < 32) rwkv_combine(p, bid, lds, wave, lane);
            if (bid >= 32 || G <= 32)
            for (;;) {
                if (tid == 0) ubox[0] = (int)atomicAdd(qhead, 1u);
                __syncthreads();
                const int u = ubox[0];
                __syncthreads();
                if (u >= n_swa) break;
                if (u < 512) swa_unit(lds, p, layer, u >> 8, (u >> 5) & 7, u & 31, false, wave, lane);
                else { const int v = u - 512; swa_unit(lds, p, layer, v >> 3, v & 7, 0, true, wave, lane); }
            }
        PH_END
        PH_BEGIN
            for (int u = gw; u < 32 * NSEG; u += NGW) rwkv_segment<2>(p, layer, u / NSEG, u % NSEG, lane, lds + wave * SCAN_LDS);
            asm volatile("s_waitcnt vmcnt(0)" ::: "memory");
            __syncthreads();
            PROBE_MID();
            float lam;
            { const float* lv = p.in[24] + layer * 256;
              const float s1 = wave_sum(lv[lane] * lv[64 + lane]), s2 = wave_sum(lv[128 + lane] * lv[192 + lane]);
              lam = expf(s1) - expf(s2) + lam_init; }
            for (int u = bid; u < 256; u += G) { const int v = G == 256 ? ((((u & 7) >> 2) << 7) | ((u & 3) << 5) | (u >> 3)) : u; diff_unit(lds, p, lam, v >> 7, (v >> 5) & 3, v & 31, false, v, wave, lane); }
            if (layer == 0) for (int u = bid; u < 8; u += G) diff_unit(lds, p, lam, u >> 2, u & 3, 0, true, 256 + u, wave, lane);
        PH_END
        PH_BEGIN
            postmix_phase(p, layer, lam_init, Ml, gw, NGW, lane);
            if (layer == 0) convert_ffn_weights(p, lds, gw, NGW, wave, lane);
            __syncthreads();
            Gemm g{(const bf16_t*)(ws + WS_XN), (const bf16_t*)(ws + WS_WIN) + (size_t)NIN1 * 1024, Ml, 3072, opq(1024), 1024}; StaticOrder S; S.init(Ml, 3072, G, bid);
            EpiGate E{(bf16_t*)(ws + WS_G)};
            gemm_phase<EpiGate, StaticOrder, true, true>(lds, g, S, E);
        PH_END
        PH_BEGIN
            StaticOrder S; S.init(Ml, 1024, G, bid);
            { Gemm g{(const bf16_t*)(ws + WS_YA), (const bf16_t*)(ws + WS_PRJ), Ml, 1024, opq(512), 512}; EpiMerge<0> E{(const bf16_t*)(ws + WS_G), (bf16_t*)(ws + WS_MF), (bf16_t*)(ws + WS_MB)};
              gemm_phase<EpiMerge<0>, StaticOrder, true, true>(lds, g, S, E); }
            { Gemm g{(const bf16_t*)(ws + WS_YB), (const bf16_t*)(ws + WS_PRJ) + 1024 * 512, Ml, 1024, opq(512), 512}; EpiMerge<1> E{(const bf16_t*)(ws + WS_G), (bf16_t*)(ws + WS_MF), (bf16_t*)(ws + WS_MB)};
              gemm_phase<EpiMerge<1>, StaticOrder, true, true>(lds, g, S, E); }
            { Gemm g{(const bf16_t*)(ws + WS_YC), (const bf16_t*)(ws + WS_PRJ) + 2 * 1024 * 512, Ml, 1024, opq(512), 512}; EpiMerge<2> E{(const bf16_t*)(ws + WS_G), (bf16_t*)(ws + WS_MF), (bf16_t*)(ws + WS_MB)};
              gemm_phase<EpiMerge<2>, StaticOrder, true, true>(lds, g, S, E); }
        PH_END
        PH_BEGIN
            Gemm g{(const bf16_t*)(ws + WS_MB), (const bf16_t*)(ws + WS_WOUT), Ml, 1024, opq(1024), 1024};
            if (layer == 0) {
                TailSched S; S.init(NLAT, 1024, G, bid, (NTOK - NLAT) / 256, 2, 8);
                EpiBfTail E{(bf16_t*)(ws + WS_MOUT), 1024, (float*)(ws + WS_P), NLAT, NTOK - NLAT};
                gemm_phase<EpiBfTail, TailSched, true, true>(lds, g, S, E);
            } else {
                StaticOrder S; S.init(Ml, 1024, G, bid);
                EpiBf E{(bf16_t*)(ws + WS_MOUT), 1024};
                gemm_phase<EpiBf, StaticOrder, true, true>(lds, g, S, E);
            }
        PH_END
        PH_BEGIN
            residual_phase(p, (const bf16_t*)(ws + WS_MOUT), nullptr, nullptr, layer == 0, layer, 2, p.in[7] + layer * 1024, true, p.in[8] + layer * 1024, layer, 3, layer == 1, Ml, gw, NGW, lane, lds, layer == 0 ? (const float*)(ws + WS_P) : nullptr, 8);
            __syncthreads();
            if (layer == 0) convert_layer_weights(p, 1, lds, gw, NGW, wave, lane);
            else convert_moe_weights(p, lds, gw, NGW, wave, lane);
        PH_END
        if (layer == 0) {
            PH_BEGIN
                Gemm g{(const bf16_t*)(ws + WS_XN), (const bf16_t*)(ws + WS_FGU), NTOK, 2 * D_FF, opq(1024), 1024}; StaticOrder S; S.init(NTOK, 2 * D_FF, G, bid);
                EpiSwiglu E{(bf16_t*)(ws + WS_HID), D_FF, 1 << 20, 0};
                gemm_phase<EpiSwiglu, StaticOrder, true, true>(lds, g, S, E);
            PH_END
            PH_BEGIN
                Gemm g{(const bf16_t*)(ws + WS_HID), (const bf16_t*)(ws + WS_FD), NTOK, 1024, opq(D_FF), D_FF};
                TailSched S; S.init(NLAT, 1024, G, bid, (NTOK - NLAT) / 256, 4, D_FF / 256);
                EpiBfTail E{(bf16_t*)(ws + WS_MF), 1024, (float*)(ws + WS_P + 92 * MiB), NLAT, NTOK - NLAT};
                gemm_phase<EpiBfTail, TailSched, true, true>(lds, g, S, E);
            PH_END
            PH_BEGIN
                residual_phase(p, (const bf16_t*)(ws + WS_MF), nullptr, nullptr, false, 0, 5, p.in[9], true, p.in[6] + 1024, 1, 0, false, NTOK, gw, NGW, lane, nullptr, (const float*)(ws + WS_P + 92 * MiB), D_FF / 256);
            PH_END
        }
    }
    {
        {
            PH_BEGIN
                const unsigned* cnt = (const unsigned*)(ws + WS_CTL) + CW_CNT; int ts[9]; ts[0] = 0;
#pragma unroll
                for (int e = 0; e < 8; ++e) ts[e + 1] = ts[e] + (int)((__hip_atomic_load(cnt + e, __ATOMIC_RELAXED, __HIP_MEMORY_SCOPE_AGENT) + 255u) >> 8);
                const int* LIST = (const int*)(ws + WS_LIST); const bf16_t* XN = (const bf16_t*)(ws + WS_XN2); bf16_t* XG = (bf16_t*)(ws + WS_XG);
                for (int r = gw; r < ts[8] * 256; r += NGW) {
                    const int tile = r >> 8; int e = 0;
#pragma unroll
                    for (int q = 1; q < 8; ++q) e += (tile >= ts[q]) ? 1 : 0;
                    int tse = 0;
#pragma unroll
                    for (int q = 0; q < 8; ++q) tse = (q == e) ? ts[q] : tse;
                    const int slot = r - tse * 256;
                    u32x4 v0 = (u32x4){0u, 0u, 0u, 0u}, v1 = v0;
                    if (slot < (int)cnt[e]) { const int tk = LIST[e * 16384 + slot]; const u32x4* src = (const u32x4*)(XN + (size_t)(tk >> 1) * 1024); v0 = src[lane]; v1 = src[lane + 64]; }
                    u32x4* dst = (u32x4*)(XG + (size_t)r * 1024); dst[lane] = v0; dst[lane + 64] = v1;
                }
            PH_END
            PH_BEGIN
                const unsigned* cnt = (const unsigned*)(ws + WS_CTL) + CW_CNT; int ts[9]; ts[0] = 0;
#pragma unroll
                for (int e = 0; e < 8; ++e) ts[e + 1] = ts[e] + (int)((__hip_atomic_load(cnt + e, __ATOMIC_RELAXED, __HIP_MEMORY_SCOPE_AGENT) + 255u) >> 8);
                MoeSched S;
#pragma unroll
                for (int e = 0; e < 9; ++e) S.ts[e] = ts[e];
                S.pm_lo = 0; S.pm_hi = ts[8]; S.npn = 28; S.G = G; S.c = bid; S.a_local = false;
                Gemm g{(const bf16_t*)(ws + WS_XG), (const bf16_t*)(ws + WS_MGU), 0, 0, opq(1024), 1024};
                EpiSwiglu E{(bf16_t*)(ws + WS_HIDM), D_FFE, 28, 0};
                gemm_phase<EpiSwiglu, MoeSched, true, true>(lds, g, S, E);
            PH_END
            PH_BEGIN
                const unsigned* cnt = (const unsigned*)(ws + WS_CTL) + CW_CNT; int ts[9]; ts[0] = 0;
#pragma unroll
                for (int e = 0; e < 8; ++e) ts[e + 1] = ts[e] + (int)((__hip_atomic_load(cnt + e, __ATOMIC_RELAXED, __HIP_MEMORY_SCOPE_AGENT) + 255u) >> 8);
                MoeSched S;
#pragma unroll
                for (int e = 0; e < 9; ++e) S.ts[e] = ts[e];
                S.pm_lo = 0; S.pm_hi = ts[8]; S.npn = 4; S.G = G; S.c = bid; S.a_local = false;
                Gemm g{(const bf16_t*)(ws + WS_HIDM), (const bf16_t*)(ws + WS_MD), 0, 0, opq(D_FFE), D_FFE};
                EpiMoeDown E; E.FS = (bf16_t*)(ws + WS_FACC); E.slot1_off = ((long)WS_MGU - (long)WS_FACC) / 2; E.LIST = (const int*)(ws + WS_LIST); E.WTS = (const float*)(ws + WS_WTS); E.cnt = cnt; E.pm_lo = 0;
#pragma unroll
                for (int e = 0; e < 9; ++e) E.ts[e] = ts[e];
                gemm_phase<EpiMoeDown, MoeSched, true, true>(lds, g, S, E);
            PH_END
            PH_BEGIN
                residual_phase(p, (const bf16_t*)(ws + WS_FACC), (const bf16_t*)(ws + WS_MGU), nullptr, false, 1, 5, p.in[9] + 1024, false, nullptr, 0, 0, false, NLAT, gw, NGW, lane);
            PH_END
        }
    }
    if ((PROBE_MASK | PROBE_MASK2) != 0ull && blockIdx.x == 0 && threadIdx.x == 0) {
        LAS unsigned long long* pt_ = (LAS unsigned long long*)(lds + LDS_PARAMS + 320);
        const unsigned long long t0_ = pt_[0], want_ = PROBE_MULT * pt_[1];
        while (__builtin_amdgcn_s_memrealtime() - t0_ < want_) __builtin_amdgcn_s_sleep(32);
    }
#undef PH_BEGIN
#undef PH_END
}

extern "C" void kernel_launch(void* const* d_in, const int* in_sizes, int n_in, void* d_out, int out_size, void* d_ws, size_t ws_size, hipStream_t stream) {
    static int grid = 0;
    if (grid == 0) {
        if (n_in != 37 || out_size != NLAT * DM || ws_size < WS_NEED) { fprintf(stderr, "kernel_launch: unexpected shapes (n_in %d out %d ws %zu need %zu)\n", n_in, out_size, ws_size, (size_t)WS_NEED); grid = -1; return; }
        int dev = 0, cus = 0, per_cu = 0;
        (void)hipGetDevice(&dev);
        (void)hipDeviceGetAttribute(&cus, hipDeviceAttributeMultiprocessorCount, dev);
        (void)hipFuncSetAttribute((const void*)mk_fwd, hipFuncAttributeMaxDynamicSharedMemorySize, LDS_BYTES);
        (void)hipOccupancyMaxActiveBlocksPerMultiprocessor(&per_cu, (const void*)mk_fwd, NTHREADS, LDS_BYTES);
        if (per_cu < 1) { fprintf(stderr, "kernel_launch: occupancy query reports %d blocks per CU\n", per_cu); grid = -1; return; }
        grid = cus;
        fprintf(stderr, "kernel_launch: grid %d (cus %d, per_cu %d), ws %zu\n", grid, cus, per_cu, ws_size);
    }
    if (grid < 0) return;
    (void)hipMemsetAsync((char*)d_ws + WS_CTL, 0, CTL_BYTES, stream);
    Params prm{};
    for (int i = 0; i < 37; ++i) prm.in[i] = (const float*)d_in[i];
    prm.out = (float*)d_out; prm.ws = (unsigned char*)d_ws;
#if MK_MULTI
    for (int ph = 0; ph < N_PHASES; ++ph) { prm.ph_lo = ph; prm.ph_hi = ph + 1; hipLaunchKernelGGL(mk_fwd, dim3(grid), dim3(NTHREADS), LDS_BYTES, stream, prm); }
#else
    prm.ph_lo = 0; prm.ph_hi = 1 << 20;
    void* args[] = {&prm};
    hipError_t e = hipLaunchCooperativeKernel((const void*)mk_fwd, dim3(grid), dim3(NTHREADS), args, LDS_BYTES, stream);
    if (e != hipSuccess) fprintf(stderr, "kernel_launch: cooperative launch failed: %s (grid %d)\n", hipGetErrorString(e), grid);
#endif
}
```

```cpp
#include <hip/hip_runtime.h>
#include <hip/hip_cooperative_groups.h>
#include <cstdio>
#include <cstdint>
namespace cg = cooperative_groups;
namespace pg8 {
#define PG8_LAS __attribute__((address_space(3)))
typedef unsigned short bf16_t;
typedef short bf16x8 __attribute__((ext_vector_type(8)));
typedef float f32x4 __attribute__((ext_vector_type(4)));
typedef unsigned u32x4 __attribute__((ext_vector_type(4)));
constexpr int BM = 256, BK = 64, HALF = 128, HTB = HALF * BK * 2  , STAGE_BYTES = 8 * HTB, NXCD = 8, WGM = 8;

__host__ __device__ __forceinline__ int lds_byte(int r, int c) { const int st = (r >> 4) * 2 + (c >> 5), rr = r & 15, cc = c & 31, ob = rr * 64 + cc * 2; return st * 1024 + (ob ^ (((ob >> 9) & 1) << 5)); }
__host__ __device__ __forceinline__ void stage_rc(int b, int& R, int& C) { const int st = b / 1024, sb = b % 1024, swz = sb ^ (((sb >> 9) & 1) << 5); R = (st >> 1) * 16 + swz / 64; C = (st & 1) * 32 + (swz % 64) / 2; }
__host__ __device__ __forceinline__ int perm32(int rho) { const int n = rho >> 4, i = rho & 15; return 8 * (i >> 2) + 4 * n + (i & 3); }

struct Unit { int pm, pn, koff, tail, kt; };
struct Gemm { const bf16_t* A; const bf16_t* Bt; int M, N, K, ld; };

struct StaticOrder {
    int nM, nN, nwg, G, c;
    __host__ __device__ void init(int M, int N, int G_, int c_) { nM = M / BM; nN = N / BM; nwg = nM * nN; G = G_; c = c_; }
    __host__ __device__ bool next(int i, Unit& u) const {
        const long L = (long)i * G + c; if (L >= nwg) return false;
        int wgid = (int)L; { const int q = nwg / NXCD, r = nwg % NXCD, xcd = wgid % NXCD, off = wgid / NXCD; wgid = (xcd < r ? xcd * (q + 1) : r * (q + 1) + (xcd - r) * q) + off; }
        const int nig = WGM * nN, gid = wgid / nig, fm = gid * WGM, gsz = (nM - fm) < WGM ? (nM - fm) : WGM;
        u.pm = fm + ((wgid % nig) % gsz); u.pn = (wgid % nig) / gsz; u.koff = 0; u.tail = -1; u.kt = 0; return true;
    }
    __device__ __forceinline__ void a_ready(const Unit&) const {}
    __device__ __forceinline__ void done(const Unit&) const {}
};

__device__ __forceinline__ unsigned cvt_pk_bf16(float lo, float hi) { unsigned r; asm volatile("v_cvt_pk_bf16_f32 %0, %1, %2" : "=v"(r) : "v"(lo), "v"(hi)); return r; }
typedef float f32x2 __attribute__((ext_vector_type(2)));
template <class Epi, class Sched, bool ALIGN_EPI = false, bool SP2 = false>
__device__ __forceinline__ void gemm_phase(PG8_LAS unsigned char* lds, const Gemm g, const Sched& S, const Epi& E) {
    int tid_ = threadIdx.x; asm volatile("" : "+v"(tid_)); const int tid = tid_, wid = __builtin_amdgcn_readfirstlane(tid >> 6), lane = tid & 63, wr = wid >> 2, wc = wid & 3, fr = lane & 15, fq = lane >> 4;
    const int K = g.ld, nt = g.K / BK;
    unsigned voffA[2], voffB[2];
#pragma unroll
    for (int i = 0; i < 2; ++i) { int R, C; stage_rc(tid * 16 + i * 8192, R, C); const int Rb = Epi::PERM ? ((R & ~31) + perm32(R & 31)) : R;
        voffA[i] = (unsigned)(R * K + C) * 2u; voffB[i] = (unsigned)(Rb * K + C) * 2u; }
    const size_t kstep = (size_t)(BK * 2);
    const size_t hstep = (size_t)HALF * K * 2;
    const size_t tstep = 2 * hstep;
    const unsigned ldsw = (unsigned)wid * 1024u;
    const int aoff = lds_byte(wr * 64 + fr, fq * 8), boff = lds_byte(wc * 32 + fr, fq * 8);
#define PG8_SA(b, h) (((b) * 2 + (h)) * HTB)
#define PG8_SB(b, h) ((4 + (b) * 2 + (h)) * HTB)
#define PG8_STAGE(bufoff, gbase, voff) do { _Pragma("unroll") for (int _i = 0; _i < 2; ++_i) \
        __builtin_amdgcn_global_load_lds((const unsigned*)((const char*)(gbase) + (voff)[_i]), (PG8_LAS unsigned*)(lds + (bufoff) + ldsw + _i * 8192), 16, 0, 0); } while (0)
#define PG8_LDA(dst, b, h) do { _Pragma("unroll") for (int m = 0; m < 4; ++m) _Pragma("unroll") for (int k = 0; k < 2; ++k) dst[m][k] = *(const PG8_LAS bf16x8*)(lds + PG8_SA(b, h) + aoff + m * 2048 + k * 1024); } while (0)
#define PG8_LDB(dst, b, h) do { _Pragma("unroll") for (int n = 0; n < 2; ++n) _Pragma("unroll") for (int k = 0; k < 2; ++k) dst[n][k] = *(const PG8_LAS bf16x8*)(lds + PG8_SB(b, h) + boff + n * 2048 + k * 1024); } while (0)
#define PG8_MMA(ai, bj, At, Bt) do { __builtin_amdgcn_s_setprio(1); _Pragma("unroll") for (int m = 0; m < 4; ++m) _Pragma("unroll") for (int n = 0; n < 2; ++n) _Pragma("unroll") for (int k = 0; k < 2; ++k) \
        acc[ai][bj][m][n] = __builtin_amdgcn_mfma_f32_16x16x32_bf16(Bt[n][k], At[m][k], acc[ai][bj][m][n], 0, 0, 0); __builtin_amdgcn_s_setprio(0); } while (0)
#define PG8_WAIT_V(n) asm volatile("s_waitcnt vmcnt(" #n ")" ::: "memory")
#define PG8_WAIT_L(n) asm volatile("s_waitcnt lgkmcnt(" #n ")" ::: "memory")
#define PG8_BAR __builtin_amdgcn_s_barrier()
#define PG8_SCHED __builtin_amdgcn_sched_barrier(0)
    Unit cur, nxt; int ui = 0;
    if (!S.next(0, cur)) return;
    f32x4 acc[2][2][4][2];
#pragma unroll
    for (int a = 0; a < 2; ++a)
#pragma unroll
        for (int b = 0; b < 2; ++b)
#pragma unroll
            for (int m = 0; m < 4; ++m)
#pragma unroll
                for (int n = 0; n < 2; ++n) acc[a][b][m][n] = (f32x4){0.f, 0.f, 0.f, 0.f};
    bf16x8 At[4][2], B0[2][2], B1[2][2];
    const char* cA = (const char*)g.A + (size_t)cur.pm * tstep + (size_t)cur.koff * 2; const char* cB = (const char*)g.Bt + (size_t)cur.pn * tstep + (size_t)cur.koff * 2;
    S.a_ready(cur);
    if constexpr (SP2) {
        PG8_STAGE(PG8_SB(0, 0), cB, voffB); PG8_STAGE(PG8_SB(0, 1), cB + hstep, voffB); PG8_STAGE(PG8_SA(0, 0), cA, voffA); PG8_STAGE(PG8_SA(0, 1), cA + hstep, voffA);
        if (wr == 1) PG8_BAR;
        PG8_WAIT_V(2); PG8_BAR;
        PG8_STAGE(PG8_SB(1, 0), cB + kstep, voffB); PG8_STAGE(PG8_SA(1, 0), cA + kstep, voffA); PG8_STAGE(PG8_SB(1, 1), cB + hstep + kstep, voffB);
        PG8_WAIT_V(6); PG8_BAR;
    } else {
        PG8_STAGE(PG8_SB(0, 0), cB, voffB); PG8_STAGE(PG8_SA(0, 0), cA, voffA); PG8_STAGE(PG8_SB(0, 1), cB + hstep, voffB); PG8_STAGE(PG8_SA(0, 1), cA + hstep, voffA);
        if (wr == 1) PG8_BAR;
        PG8_WAIT_V(4); PG8_BAR;
        PG8_STAGE(PG8_SB(1, 0), cB + kstep, voffB); PG8_STAGE(PG8_SA(1, 0), cA + kstep, voffA); PG8_STAGE(PG8_SB(1, 1), cB + hstep + kstep, voffB);
        PG8_WAIT_V(6); PG8_BAR;
    }
    for (;;) {
        const bool has_next = S.next(ui + 1, nxt);
        const char* nA = has_next ? (const char*)g.A + (size_t)nxt.pm * tstep + (size_t)nxt.koff * 2 : cA; const char* nB = has_next ? (const char*)g.Bt + (size_t)nxt.pn * tstep + (size_t)nxt.koff * 2 : cB;
        const int ntc = cur.kt ? cur.kt : nt;
        for (int t = 0; t < ntc; t += 2) {
            const bool last = (t == ntc - 2);
            const char* a1 = cA + (size_t)(t + 1) * kstep;
            const char* a2 = last ? nA : cA + (size_t)(t + 2) * kstep; const char* b2 = last ? nB : cB + (size_t)(t + 2) * kstep;
            const char* a3 = a2 + kstep; const char* b3 = b2 + kstep;
            if (last && has_next) S.a_ready(nxt);
            if constexpr (SP2) {
            PG8_LDB(B0, 0, 0); PG8_LDB(B1, 0, 1); PG8_SCHED; PG8_LDA(At, 0, 0); PG8_STAGE(PG8_SA(1, 1), a1 + hstep, voffA);
            PG8_WAIT_V(8); PG8_WAIT_L(0); PG8_BAR; PG8_MMA(0, 0, At, B0); PG8_MMA(0, 1, At, B1); PG8_BAR; PG8_SCHED;
            PG8_LDA(At, 0, 1); PG8_STAGE(PG8_SB(0, 0), b2, voffB); PG8_STAGE(PG8_SB(0, 1), b2 + hstep, voffB); PG8_STAGE(PG8_SA(0, 0), a2, voffA);
            PG8_WAIT_V(8); PG8_WAIT_L(0); PG8_BAR; PG8_MMA(1, 0, At, B0); PG8_MMA(1, 1, At, B1); PG8_BAR; PG8_SCHED;
            PG8_LDB(B0, 1, 0); PG8_LDB(B1, 1, 1); PG8_SCHED; PG8_LDA(At, 1, 0); PG8_STAGE(PG8_SA(0, 1), a2 + hstep, voffA);
            PG8_WAIT_V(8); PG8_WAIT_L(0); PG8_BAR; PG8_MMA(0, 0, At, B0); PG8_MMA(0, 1, At, B1); PG8_BAR; PG8_SCHED;
            PG8_LDA(At, 1, 1); PG8_STAGE(PG8_SB(1, 0), b3, voffB); PG8_STAGE(PG8_SB(1, 1), b3 + hstep, voffB); PG8_STAGE(PG8_SA(1, 0), a3, voffA);
            PG8_WAIT_V(8); PG8_WAIT_L(0); PG8_BAR; PG8_MMA(1, 0, At, B0); PG8_MMA(1, 1, At, B1); PG8_BAR; PG8_SCHED;
            } else {
            PG8_LDB(B0, 0, 0); PG8_SCHED; PG8_LDA(At, 0, 0); PG8_STAGE(PG8_SA(1, 1), a1 + hstep, voffA);
            PG8_WAIT_L(8); PG8_BAR; PG8_WAIT_L(0); PG8_MMA(0, 0, At, B0); PG8_BAR; PG8_SCHED;
            PG8_LDB(B1, 0, 1); PG8_STAGE(PG8_SB(0, 0), b2, voffB);
            PG8_BAR; PG8_WAIT_L(0); PG8_MMA(0, 1, At, B1); PG8_BAR;
            PG8_LDA(At, 0, 1); PG8_STAGE(PG8_SA(0, 0), a2, voffA);
            PG8_BAR; PG8_WAIT_L(0); PG8_MMA(1, 0, At, B0); PG8_BAR; PG8_SCHED;
            PG8_STAGE(PG8_SB(0, 1), b2 + hstep, voffB);
            PG8_WAIT_V(6); PG8_BAR; PG8_MMA(1, 1, At, B1); PG8_BAR;
            PG8_LDB(B0, 1, 0); PG8_SCHED; PG8_LDA(At, 1, 0); PG8_STAGE(PG8_SA(0, 1), a2 + hstep, voffA);
            PG8_WAIT_L(8); PG8_BAR; PG8_WAIT_L(0); PG8_MMA(0, 0, At, B0); PG8_BAR; PG8_SCHED;
            PG8_LDB(B1, 1, 1); PG8_STAGE(PG8_SB(1, 0), b3, voffB);
            PG8_BAR; PG8_WAIT_L(0); PG8_MMA(0, 1, At, B1); PG8_BAR;
            PG8_LDA(At, 1, 1); PG8_STAGE(PG8_SA(1, 0), a3, voffA);
            PG8_BAR; PG8_WAIT_L(0); PG8_MMA(1, 0, At, B0); PG8_BAR; PG8_SCHED;
            PG8_STAGE(PG8_SB(1, 1), b3 + hstep, voffB);
            PG8_WAIT_V(6); PG8_BAR; PG8_MMA(1, 1, At, B1); PG8_BAR;
            }
        }
        if constexpr (ALIGN_EPI) { if (wr == 0) PG8_BAR; }
        if constexpr (!Epi::AFTER_DRAIN) { E(acc, cur, wr, wc, fr, fq); S.done(cur); }
        if (!has_next) break;
#pragma unroll
        for (int a = 0; a < 2; ++a)
#pragma unroll
            for (int b = 0; b < 2; ++b)
#pragma unroll
                for (int m = 0; m < 4; ++m)
#pragma unroll
                    for (int n = 0; n < 2; ++n) acc[a][b][m][n] = (f32x4){0.f, 0.f, 0.f, 0.f};
        cur = nxt; cA = nA; cB = nB; ++ui;
        if constexpr (ALIGN_EPI) { if (wr == 1) PG8_BAR; }
    }
    PG8_WAIT_V(0);
    if constexpr (!ALIGN_EPI) { if (wr == 0) PG8_BAR; }
    PG8_BAR;
    if constexpr (Epi::AFTER_DRAIN) { E.fused(acc, cur, wr, wc, fr, fq, lds, wid, lane); S.done(cur); }
#undef PG8_SA
#undef PG8_SB
#undef PG8_STAGE
#undef PG8_LDA
#undef PG8_LDB
#undef PG8_MMA
#undef PG8_WAIT_V
#undef PG8_WAIT_L
#undef PG8_BAR
#undef PG8_SCHED
}
}

#define LAS __attribute__((address_space(3)))
typedef unsigned short bf16_t;
typedef short bf16x8 __attribute__((ext_vector_type(8)));
typedef float f32x4 __attribute__((ext_vector_type(4)));
typedef float f32x16 __attribute__((ext_vector_type(16)));
typedef unsigned u32x4 __attribute__((ext_vector_type(4)));
typedef unsigned u32x2 __attribute__((ext_vector_type(2)));

constexpr int NTHREADS = 512, NWAVES = 8;
constexpr int DM = 1024, SEQ = 8192, CTXL = 256, NLAT = 2 * SEQ, NCTX = 2 * CTXL, NTOK = NLAT + NCTX, KEYS = SEQ + CTXL;
constexpr int D_IN = 7296, D_FF = 2816, D_FFE = 3584, NEXP = 8;
constexpr int IC_QS = 0, IC_KS = 512, IC_RW = 640, IC_QD = 2560, IC_KD = 3072, PP = 3584, IC_VS = 3584, IC_VD = 3712, IC_PAD = 4224, NIN1 = 4352, WIN_ROWS = 7424;
constexpr int ST_SLOTS = 8;
constexpr int SL_W0 = 0, SL_A0 = 1, SL_KK = 2, SL_R = 3, SL_V = 4, SL_K = 5, SL_W1 = 6, SL_A1 = 7;
constexpr int MOE_TILES = 136, MOE_HALF = 68;

constexpr size_t MiB = 1u << 20;
constexpr size_t WS_CTL = 0, CTL_BYTES = 1 * MiB;
constexpr size_t WS_MODS = 1 * MiB;
constexpr size_t WS_ROPE = 1 * MiB + 256 * 1024;
constexpr size_t WS_HCTX = 2 * MiB;
constexpr size_t WS_LIST = 4 * MiB;
constexpr size_t WS_WTS = 4 * MiB + 512 * 1024;
constexpr size_t WS_WIN = 6 * MiB;
constexpr size_t WS_PRJ = WS_WIN + (size_t)WIN_ROWS * 1024 * 2;
constexpr size_t WS_WOUT = WS_PRJ + 3 * MiB;
constexpr size_t WS_LORA = WS_WOUT + 2 * MiB;
constexpr size_t WS_XN = 28 * MiB;
constexpr size_t WS_P = 61 * MiB;
constexpr size_t WS_VTS = 177 * MiB;
constexpr size_t WS_VTD = WS_VTS + 4608 * 1024;
constexpr size_t WS_ST = 198 * MiB;
constexpr size_t WS_YA = 495 * MiB;
constexpr size_t WS_YB = WS_YA + 16896ull * 512 * 2;
constexpr size_t WS_YC = WS_YB + 16896ull * 512 * 2;
constexpr size_t WS_END = WS_YC + 16896ull * 512 * 2;
constexpr size_t WS_G = WS_ST;
constexpr size_t WS_MF = WS_ST + 99 * MiB;
constexpr size_t WS_MB = WS_ST + 165 * MiB;
constexpr size_t WS_MOUT = WS_ST + 198 * MiB;
constexpr size_t WS_FGU = WS_VTS;
constexpr size_t WS_FD = WS_VTS + 11 * MiB;
constexpr size_t WS_HID = WS_P;
constexpr size_t WS_XN2 = 495 * MiB;
constexpr size_t WS_MGU = 6 * MiB;
constexpr size_t WS_MD = 118 * MiB;
constexpr size_t WS_XG = 174 * MiB;
constexpr size_t WS_FACC = 242 * MiB;
constexpr size_t WS_HIDM = 306 * MiB;
static_assert(WS_LORA + 2560 * 384 * 2 <= WS_XN && WS_XN + 16896ull * 1024 * 2 <= WS_P && WS_P + 16896ull * PP * 2 <= WS_VTS && WS_VTD + 2ull * 4 * 128 * KEYS * 2 <= WS_ST, "ws map 1");
static_assert(WS_ST + 16896ull * 8 * ST_SLOTS * 64 * 4 <= WS_YA && WS_END <= 545 * MiB, "ws map 2");
static_assert(WS_G + 16896ull * 3072 * 2 <= WS_MF && WS_MF + 16896ull * 1024 * 4 <= WS_MB && WS_MB + 16896ull * 1024 * 2 <= WS_MOUT && WS_MOUT + 16896ull * 1024 * 4 <= WS_YA, "ws map 3");
static_assert(WS_FGU + 5632ull * 1024 * 2 <= WS_FD && WS_FD + 1024ull * 2816 * 2 <= WS_ST && WS_HID + 16896ull * 2816 * 2 <= WS_VTS, "ws map 4");
static_assert(WS_MGU + 8ull * 7168 * 1024 * 2 <= WS_MD && WS_MD + 8ull * 1024 * 3584 * 2 <= WS_XG && WS_XG + 34816ull * 1024 * 2 <= WS_FACC && WS_FACC + 16384ull * 1024 * 4 <= WS_HIDM && WS_HIDM + 136ull * 256 * 3584 * 2 <= 560 * MiB, "ws map 5");
static_assert(WS_FACC + 16384ull * 1024 * 4 <= WS_MOUT && WS_XN2 + 16384ull * 1024 * 2 <= 560 * MiB && WS_XN2 >= WS_MOUT + 16896ull * 1024 * 4, "expert weights / gathered rows / accumulator must not touch MOUT or XN2 while they are live");
constexpr size_t WS_NEED = 560 * MiB;
constexpr int CW_CNT = 0;
constexpr int CW_Q0 = 64, CW_Q1 = 128;

constexpr int LDS_BYTES = 147456;

__device__ __forceinline__ unsigned f2bf(float f) { unsigned u = __builtin_bit_cast(unsigned, f); return (u + 0x7fffu + ((u >> 16) & 1u)) >> 16; }
typedef float f32x2_t __attribute__((ext_vector_type(2))); typedef __bf16 bf16x2_t __attribute__((ext_vector_type(2)));
__device__ __forceinline__ unsigned pk2(float lo, float hi) { const f32x2_t v = {lo, hi}; return __builtin_bit_cast(unsigned, __builtin_convertvector(v, bf16x2_t)); }
__device__ __forceinline__ float bflo(unsigned w) { return __uint_as_float(w << 16); }
__device__ __forceinline__ float bfhi(unsigned w) { return __uint_as_float(w & 0xffff0000u); }
__device__ __forceinline__ float wave_sum(float v) {
#pragma unroll
    for (int o = 1; o < 64; o <<= 1) v += __shfl_xor(v, o);
    return v;
}
__device__ __forceinline__ float sigmoidf_(float x) { return 1.0f / (1.0f + __expf(-x)); }
__device__ __forceinline__ float siluf_(float x) { return x / (1.0f + __expf(-x)); }
#define LDS_WAIT() asm volatile("s_waitcnt lgkmcnt(0)" ::: "memory")

struct Params {
    const float* in[37];
    float* out;
    unsigned char* ws;
    int ph_lo, ph_hi;
};

template <class F>
__device__ __forceinline__ void transpose_item(const float* __restrict__ W, int ldw, int k0, int n0, bf16_t* __restrict__ WT, int ldt, int dcol0, F rowmap, LAS float* scr, int lane) {
    f32x4 ld[8];
    { const float* src = W + (size_t)(k0 + (lane >> 3)) * ldw + n0 + 4 * (lane & 7);
#pragma unroll
      for (int j = 0; j < 8; ++j) ld[j] = *(const f32x4*)(src + (size_t)(8 * j) * ldw); }
#pragma unroll
    for (int j = 0; j < 8; ++j) { LAS float* d = scr + (8 * j + (lane >> 3)) * 33 + 4 * (lane & 7); d[0] = ld[j].x; d[1] = ld[j].y; d[2] = ld[j].z; d[3] = ld[j].w; }
    LDS_WAIT(); asm volatile("" ::: "memory");
    const int c = lane & 7;
#pragma unroll
    for (int j = 0; j < 4; ++j) {
        const int n = (lane >> 3) + 8 * j; const LAS float* s = scr + (8 * c) * 33 + n;
        u32x4 o; o.x = pk2(s[0 * 33], s[1 * 33]); o.y = pk2(s[2 * 33], s[3 * 33]); o.z = pk2(s[4 * 33], s[5 * 33]); o.w = pk2(s[6 * 33], s[7 * 33]);
        const int row = rowmap(n0 + n);
        if (row >= 0) *(u32x4*)(WT + (size_t)row * ldt + dcol0 + k0 + 8 * c) = o;
    }
    LDS_WAIT(); asm volatile("" ::: "memory");
}
struct RowId { __device__ __forceinline__ int operator()(int n) const { return n; } };
struct RowOff { int off; __device__ __forceinline__ int operator()(int n) const { return n + off; } };
struct RowWin {
    __device__ __forceinline__ int operator()(int n) const {
        if (n < 640) return n;
        if (n < 768) return n - 640 + IC_VS;
        if (n < 2688) return n - 768 + IC_RW;
        if (n < 3712) return n - 2688 + IC_QD;
        if (n < 4224) return n - 3712 + IC_VD;
        return n - 4224 + NIN1;
    }
};
struct RowGU { int up; __device__ __forceinline__ int operator()(int j) const { return (j >> 7) * 256 + (j & 127) + 128 * up; } };

template <class F>
__device__ __forceinline__ void convert_matrix(const float* W, int K, int N, bf16_t* WT, int ldt, int dcol0, F rowmap, LAS float* scr, int lane, int gw, int NGW) {
    const int nblk = N / 32, items = (K / 64) * nblk;
    for (int it = gw; it < items; it += NGW) { const int kb = it / nblk, nb = it % nblk; transpose_item(W, N, kb * 64, nb * 32, WT, ldt, dcol0, rowmap, scr, lane); }
}

__device__ __forceinline__ void lora_region(bf16_t* __restrict__ LT, const float* __restrict__ src, int row0, int klo, int kn, int gw, int NGW, int lane) {
    for (int i = gw * 64 + lane; i < 512 * 48; i += NGW * 64) {
        const int nn = i / 48, kc = (i % 48) * 8;
        u32x4 o = (u32x4){0u, 0u, 0u, 0u};
        if (kc >= klo && kc < klo + kn) {
            const float* s = src + (size_t)(kc - klo) * 512 + nn;
            o.x = pk2(s[0], s[512]); o.y = pk2(s[2 * 512], s[3 * 512]); o.z = pk2(s[4 * 512], s[5 * 512]); o.w = pk2(s[6 * 512], s[7 * 512]);
        }
        *(u32x4*)(LT + (size_t)(row0 + nn) * 384 + kc) = o;
    }
}
__device__ __forceinline__ void convert_layer_weights(const Params& p, int layer, LAS unsigned char* lds, int gw, int NGW, int wave, int lane) {
    LAS float* scr = (LAS float*)(lds + wave * 16384);
    unsigned char* ws = p.ws;
    bf16_t* WIN = (bf16_t*)(ws + WS_WIN);
    convert_matrix(p.in[10] + (size_t)layer * 1024 * D_IN, 1024, D_IN, WIN, 1024, 0, RowWin(), scr, lane, gw, NGW);
    for (int i = gw * 64 + lane; i < (NIN1 - IC_PAD) * 1024 / 8; i += NGW * 64) *(u32x4*)(WIN + (size_t)IC_PAD * 1024 + (size_t)i * 8) = (u32x4){0u, 0u, 0u, 0u};
    for (int j = 0; j < 3; ++j)
        convert_matrix(p.in[26 + j] + (size_t)layer * 512 * 1024, 512, 1024, (bf16_t*)(ws + WS_PRJ) + (size_t)j * 1024 * 512, 512, 0, RowId(), scr, lane, gw, NGW);
    convert_matrix(p.in[29] + (size_t)layer * 1024 * 1024, 1024, 1024, (bf16_t*)(ws + WS_WOUT), 1024, 0, RowId(), scr, lane, gw, NGW);
    bf16_t* LT = (bf16_t*)(ws + WS_LORA);
    lora_region(LT, p.in[15] + ((size_t)layer * 2 + 0) * 64 * 512, 0, 0, 64, gw, NGW, lane);
    lora_region(LT, p.in[15] + ((size_t)layer * 2 + 1) * 64 * 512, 512, 64, 64, gw, NGW, lane);
    lora_region(LT, p.in[17] + ((size_t)layer * 2 + 0) * 64 * 512, 1024, 128, 64, gw, NGW, lane);
    lora_region(LT, p.in[17] + ((size_t)layer * 2 + 1) * 64 * 512, 1536, 192, 64, gw, NGW, lane);
    lora_region(LT, p.in[18] + (size_t)layer * 128 * 512, 2048, 256, 128, gw, NGW, lane);
}
__device__ __forceinline__ void convert_ffn_weights(const Params& p, LAS unsigned char* lds, int gw, int NGW, int wave, int lane) {
    LAS float* scr = (LAS float*)(lds + wave * 16384);
    bf16_t* GU = (bf16_t*)(p.ws + WS_FGU); bf16_t* FD = (bf16_t*)(p.ws + WS_FD);
    convert_matrix(p.in[30], 1024, D_FF, GU, 1024, 0, RowGU{0}, scr, lane, gw, NGW);
    convert_matrix(p.in[31], 1024, D_FF, GU, 1024, 0, RowGU{1}, scr, lane, gw, NGW);
    convert_matrix(p.in[32], D_FF, 1024, FD, D_FF, 0, RowId(), scr, lane, gw, NGW);
}
__device__ __forceinline__ void convert_moe_weights(const Params& p, LAS unsigned char* lds, int gw, int NGW, int wave, int lane) {
    LAS float* scr = (LAS float*)(lds + wave * 16384);
    for (int e = 0; e < NEXP; ++e) {
        bf16_t* GU = (bf16_t*)(p.ws + WS_MGU) + (size_t)e * 7168 * 1024;
        convert_matrix(p.in[34] + (size_t)e * 1024 * D_FFE, 1024, D_FFE, GU, 1024, 0, RowGU{0}, scr, lane, gw, NGW);
        convert_matrix(p.in[35] + (size_t)e * 1024 * D_FFE, 1024, D_FFE, GU, 1024, 0, RowGU{1}, scr, lane, gw, NGW);
        convert_matrix(p.in[36] + (size_t)e * D_FFE * 1024, D_FFE, 1024, (bf16_t*)(p.ws + WS_MD) + (size_t)e * 1024 * D_FFE, D_FFE, 0, RowId(), scr, lane, gw, NGW);
    }
}

__device__ __forceinline__ void adaln_phase(const Params& p, LAS unsigned char* lds, int wave, int lane) {
    LAS float* red = (LAS float*)lds;
    float* MODS = (float*)(p.ws + WS_MODS);
    const float* c = p.in[1]; const float* cc = p.in[3];
    for (int it = blockIdx.x; it < 2 * 96; it += gridDim.x) {
        const int layer = it / 96, n = (it % 96) * 64 + lane;
        const float* W = p.in[4] + (size_t)layer * 1024 * 6144;
        float a0 = 0.f, a1 = 0.f, a2 = 0.f;
        for (int k = wave * 128; k < wave * 128 + 128; ++k) {
            const float w = W[(size_t)k * 6144 + n];
            a0 += siluf_(c[k]) * w; a1 += siluf_(c[1024 + k]) * w; a2 += siluf_(cc[k]) * w;
        }
        red[(wave * 3 + 0) * 64 + lane] = a0; red[(wave * 3 + 1) * 64 + lane] = a1; red[(wave * 3 + 2) * 64 + lane] = a2;
        __syncthreads();
        if (wave < 3) {
            float s = 0.f;
#pragma unroll
            for (int w = 0; w < 8; ++w) s += red[(w * 3 + wave) * 64 + lane];
            MODS[((size_t)layer * 3 + wave) * 6144 + n] = s + p.in[5][(size_t)layer * 6144 + n];
        }
        __syncthreads();
    }
    if (blockIdx.x == gridDim.x - 1) {
        float* rope = (float*)(p.ws + WS_ROPE);
        for (int i = threadIdx.x; i < 128 * 16; i += NTHREADS) {
            const int pos = i >> 4, j = i & 15;
            const float inv = powf(10000.0f, -(float)j / 16.0f);
            const float ang = (float)pos * inv;
            rope[2 * i] = cosf(ang); rope[2 * i + 1] = sinf(ang);
        }
    }
}

__device__ __forceinline__ const float* mods_row(const Params& p, int layer, int m) {
    const int r = m < NLAT ? (m >> 13) : 2;
    return (const float*)(p.ws + WS_MODS) + ((size_t)layer * 3 + r) * 6144;
}
__device__ __forceinline__ void load_row(const float* x, int lane, f32x4 (&v)[4]) {
#pragma unroll
    for (int j = 0; j < 4; ++j) v[j] = ((const f32x4*)x)[lane + 64 * j];
}
__device__ __forceinline__ float row_rstd(const f32x4 (&v)[4]) {
    float s = 0.f;
#pragma unroll
    for (int j = 0; j < 4; ++j) s += (v[j].x * v[j].x + v[j].y * v[j].y) + (v[j].z * v[j].z + v[j].w * v[j].w);
    return 1.0f / sqrtf(wave_sum(s) * (1.0f / 1024.0f) + 1e-6f);
}
__device__ __forceinline__ void normmod(const f32x4 (&h)[4], const float* g, const float* shift, const float* scale, int lane, f32x4 (&a)[4]) {
    const float rstd = row_rstd(h);
#pragma unroll
    for (int j = 0; j < 4; ++j) {
        const f32x4 gg = ((const f32x4*)g)[lane + 64 * j], sh = ((const f32x4*)shift)[lane + 64 * j], sc = ((const f32x4*)scale)[lane + 64 * j];
        a[j] = (h[j] * rstd * gg) * (sc + 1.0f) + sh;
    }
}
__device__ __forceinline__ void store_row_bf16(bf16_t* o, int lane, const f32x4 (&a)[4]) {
#pragma unroll
    for (int j = 0; j < 4; ++j) { u32x2 w; w.x = pk2(a[j].x, a[j].y); w.y = pk2(a[j].z, a[j].w); ((u32x2*)o)[lane + 64 * j] = w; }
}
__device__ __forceinline__ const float* h_in_row(const Params& p, int layer, int m) {
    if (layer == 0) return m < NLAT ? p.in[0] + (size_t)m * 1024 : p.in[2] + (size_t)(m - NLAT) * 1024;
    return m < NLAT ? p.out + (size_t)m * 1024 : (const float*)(p.ws + WS_HCTX) + (size_t)(m - NLAT) * 1024;
}
__device__ __forceinline__ float* h_out_row(const Params& p, int m) { return m < NLAT ? p.out + (size_t)m * 1024 : (float*)(p.ws + WS_HCTX) + (size_t)(m - NLAT) * 1024; }

__device__ __forceinline__ void premix_phase(const Params& p, int layer, bool first, int M, int gw, int NGW, int lane) {
    bf16_t* XN = (bf16_t*)(p.ws + WS_XN);
    for (int m = gw; m < M; m += NGW) {
        const float* hr = first ? h_in_row(p, 0, m) : h_out_row(p, m);
        f32x4 h[4], a[4]; load_row(hr, lane, h);
        const float* md = mods_row(p, layer, m);
        normmod(h, p.in[6] + layer * 1024, md, md + 1024, lane, a);
        store_row_bf16(XN + (size_t)m * 1024, lane, a);
    }
}
__device__ __forceinline__ void load_row_bf16(const bf16_t* x, int lane, f32x4 (&v)[4]) {
#pragma unroll
    for (int j = 0; j < 4; ++j) { const u32x2 w = ((const u32x2*)x)[lane + 64 * j]; v[j] = (f32x4){bflo(w.x), bfhi(w.x), bflo(w.y), bfhi(w.y)}; }
}
__device__ __forceinline__ void residual_phase(const Params& p, const bf16_t* src, const bf16_t* src2, const float* hin_base_layer0, bool hin_is_input, int layer, int gate_idx, const float* g1,
                                               bool write_xn, const float* g2, int mod_layer2, int shift_idx, bool route, int M, int gw, int NGW, int lane, LAS unsigned char* lds = nullptr,
                                               const float* part = nullptr, int nsl = 0) {
    bf16_t* XN = (bf16_t*)(p.ws + (route ? WS_XN2 : WS_XN));
    LAS int* rt = (LAS int*)lds;
    int rt_n = 0;
    const int wv = gw & (NWAVES - 1);
    for (int m = gw; m < M; m += NGW) {
        const float* hr = hin_is_input ? h_in_row(p, 0, m) : h_out_row(p, m);
        f32x4 h[4], s[4]; load_row(hr, lane, h);
        if (part && m >= NLAT) {
#pragma unroll
            for (int j = 0; j < 4; ++j) s[j] = (f32x4){0.f, 0.f, 0.f, 0.f};
            for (int sl = 0; sl < nsl; ++sl) { f32x4 t[4]; load_row(part + (size_t)(sl * 512 + (m - NLAT)) * 1024, lane, t);
#pragma unroll
                for (int j = 0; j < 4; ++j) s[j] += t[j]; }
        } else load_row_bf16(src + (size_t)m * 1024, lane, s);
        if (src2) { f32x4 s2[4]; load_row_bf16(src2 + (size_t)m * 1024, lane, s2);
#pragma unroll
            for (int j = 0; j < 4; ++j) s[j] += s2[j]; }
        const float rstd = row_rstd(s);
        const float* md = mods_row(p, layer, m);
#pragma unroll
        for (int j = 0; j < 4; ++j) {
            const f32x4 gg = ((const f32x4*)g1)[lane + 64 * j], gt = ((const f32x4*)(md + gate_idx * 1024))[lane + 64 * j];
            h[j] = h[j] + gt * (s[j] * rstd * gg);
        }
        float* ho = h_out_row(p, m);
#pragma unroll
        for (int j = 0; j < 4; ++j) ((f32x4*)ho)[lane + 64 * j] = h[j];
        if (write_xn) {
            f32x4 a[4]; const float* md2 = mods_row(p, mod_layer2, m);
            normmod(h, g2, md2 + shift_idx * 1024, md2 + (shift_idx + 1) * 1024, lane, a);
            store_row_bf16(XN + (size_t)m * 1024, lane, a);
            if (route) {
                const float* rw = p.in[33];
                float lg[8] = {0.f, 0.f, 0.f, 0.f, 0.f, 0.f, 0.f, 0.f};
#pragma unroll
                for (int j = 0; j < 4; ++j)
#pragma unroll
                    for (int q = 0; q < 4; ++q) {
                        const int k = 4 * (lane + 64 * j) + q; const float av = a[j][q];
                        const f32x4 w0 = ((const f32x4*)(rw + (size_t)k * 8))[0], w1 = ((const f32x4*)(rw + (size_t)k * 8))[1];
                        lg[0] += av * w0.x; lg[1] += av * w0.y; lg[2] += av * w0.z; lg[3] += av * w0.w; lg[4] += av * w1.x; lg[5] += av * w1.y; lg[6] += av * w1.z; lg[7] += av * w1.w;
                    }
#pragma unroll
                for (int e = 0; e < 8; ++e) lg[e] = wave_sum(lg[e]);
                int i1 = 0; float v1 = lg[0];
#pragma unroll
                for (int e = 1; e < 8; ++e) if (lg[e] > v1) { v1 = lg[e]; i1 = e; }
                int i2 = -1; float v2 = -3.0e38f;
#pragma unroll
                for (int e = 0; e < 8; ++e) if (e != i1 && lg[e] > v2) { v2 = lg[e]; i2 = e; }
                if (lane == 0) {
                    const float w1 = 1.0f / (1.0f + expf(v2 - v1));
                    const int q = rt_n * NWAVES + wv;
                    rt[q] = m; rt[64 + q] = i1; rt[128 + q] = i2; rt[192 + q] = (int)__float_as_uint(w1);
                }
                ++rt_n;
                if (rt_n == 64 / NWAVES || m + NGW >= M) {
                    __syncthreads();
                    if (wv == 0) {
                        const int n = rt_n * NWAVES; const bool act = lane < n;
                        const int rm = act ? rt[lane] : 0, e1 = act ? rt[64 + lane] : -1, e2 = act ? rt[128 + lane] : -1; const float w1 = __uint_as_float((unsigned)rt[192 + (act ? lane : 0)]);
                        unsigned* cnt = (unsigned*)(p.ws + WS_CTL) + CW_CNT; int* LIST = (int*)(p.ws + WS_LIST); float* WTS = (float*)(p.ws + WS_WTS);
                        const unsigned long long lt = (1ull << lane) - 1ull;
                        unsigned mycount = 0u; int r1 = 0, r2 = 0, c1sel = 0;
#pragma unroll
                        for (int e = 0; e < 8; ++e) {
                            const unsigned long long b1 = __ballot(e1 == e), b2 = __ballot(e2 == e);
                            const int c1 = __popcll(b1), c2 = __popcll(b2);
                            if (lane == e) mycount = (unsigned)(c1 + c2);
                            if (e1 == e) r1 = __popcll(b1 & lt);
                            if (e2 == e) { r2 = __popcll(b2 & lt); c1sel = c1; }
                        }
                        unsigned base = 0u;
                        if (lane < 8 && mycount) base = atomicAdd(cnt + lane, mycount);
                        const unsigned bs1 = (unsigned)__shfl((int)base, e1 < 0 ? 0 : e1), bs2 = (unsigned)__shfl((int)base, e2 < 0 ? 0 : e2);
                        if (act) {
                            const unsigned s1 = bs1 + (unsigned)r1, s2 = bs2 + (unsigned)(c1sel + r2);
                            LIST[e1 * 16384 + s1] = rm * 2; WTS[e1 * 16384 + s1] = w1;
                            LIST[e2 * 16384 + s2] = rm * 2 + 1; WTS[e2 * 16384 + s2] = 1.0f - w1;
                        }
                    }
                    __syncthreads();
                    rt_n = 0;
                }
            }
        }
    }
}

using pg8::Unit;
constexpr float QSCALE = 0.125f * 1.4426950408889634f;
__device__ __forceinline__ u32x2 pack4(const f32x4 v) { u32x2 w; w.x = pk2(v.x, v.y); w.y = pk2(v.z, v.w); return w; }
__device__ __forceinline__ f32x4 unpack4(const u32x2 w) { return (f32x4){bflo(w.x), bfhi(w.x), bflo(w.y), bfhi(w.y)}; }

struct EpiIn {
    static constexpr bool PERM = false, AFTER_DRAIN = false;
    bf16_t* P; bf16_t* VTS; bf16_t* VTD; const float* rope;
    __device__ __forceinline__ void operator()(const f32x4 (&acc)[2][2][4][2], const Unit& u, int wr, int wc, int fr, int fq) const {
#pragma unroll
        for (int ai = 0; ai < 2; ++ai)
#pragma unroll
            for (int m = 0; m < 4; ++m) {
                const int r = u.pm * 256 + ai * 128 + wr * 64 + m * 16 + fr;
                const bool lat = r < NLAT;
                const int t = r & (SEQ - 1);
                const int b = lat ? (r >> 13) : ((r - NLAT) >> 8);
                const int key = lat ? t : SEQ + ((r - NLAT) & 255);
#pragma unroll
                for (int bj = 0; bj < 2; ++bj) {
                    const int c32 = u.pn * 256 + bj * 128 + wc * 32;
                    f32x4 v0 = acc[ai][bj][m][0], v1 = acc[ai][bj][m][1];
                    if (c32 < PP) {
                        const bool rp = (c32 < IC_RW) || (c32 >= IC_QD);
                        if (rp && lat) {
                            const int pos = (c32 & 32) ? (t & 63) : (t >> 6);
                            const f32x4 cs0 = *(const f32x4*)(rope + (pos * 16 + 4 * fq) * 2), cs1 = *(const f32x4*)(rope + (pos * 16 + 4 * fq) * 2 + 4);
                            const f32x4 cc = (f32x4){cs0.x, cs0.z, cs1.x, cs1.z}, sn = (f32x4){cs0.y, cs0.w, cs1.y, cs1.w};
                            const f32x4 o0 = v0 * cc - v1 * sn, o1 = v0 * sn + v1 * cc;
                            v0 = o0; v1 = o1;
                        }
                        if (c32 < IC_KS || (c32 >= IC_QD && c32 < IC_KD)) { v0 = v0 * QSCALE; v1 = v1 * QSCALE; }
                        bf16_t* dst = P + (size_t)r * PP + c32 + 4 * fq;
                        *(u32x2*)dst = pack4(v0); *(u32x2*)(dst + 16) = pack4(v1);
                    } else {
                        const int cv = c32 - PP;
                        bf16_t* vt = nullptr; int dimbase = 0;
                        if (cv < 128) { vt = VTS + (size_t)((b * 2 + (cv >> 6)) * 64) * KEYS; dimbase = cv & 63; }
                        else if (cv < 640) { const int cd = cv - 128; vt = VTD + (size_t)((b * 4 + (cd >> 7)) * 128) * KEYS; dimbase = cd & 127; }
                        if (vt) {
                            const int kp = (key & ~12) | ((key & 4) << 1) | ((key & 8) >> 1);
#pragma unroll
                            for (int i = 0; i < 4; ++i) {
                                vt[(size_t)(dimbase + 4 * fq + i) * KEYS + kp] = (bf16_t)f2bf(v0[i]);
                                vt[(size_t)(dimbase + 16 + 4 * fq + i) * KEYS + kp] = (bf16_t)f2bf(v1[i]);
                            }
                        }
                    }
                }
            }
    }
};

struct EpiLora {
    static constexpr bool PERM = false, AFTER_DRAIN = false;
    float* ST; bf16_t* P; const float* w0; const float* a0;
    __device__ __forceinline__ void operator()(const f32x4 (&acc)[2][2][4][2], const Unit& u, int wr, int wc, int fr, int fq) const {
        const int reg = u.pn >> 1;
#pragma unroll
        for (int ai = 0; ai < 2; ++ai)
#pragma unroll
            for (int m = 0; m < 4; ++m) {
                const int r = u.pm * 256 + ai * 128 + wr * 64 + m * 16 + fr;
#pragma unroll
                for (int bj = 0; bj < 2; ++bj)
#pragma unroll
                    for (int n = 0; n < 2; ++n) {
                        const int ch = (u.pn & 1) * 256 + bj * 128 + wc * 32 + 16 * n + 4 * fq;
                        const int h = ch >> 6, kidx = ch & 63;
                        float* sp = ST + ((size_t)r * 8 + h) * (ST_SLOTS * 64) + kidx;
                        const f32x4 a = acc[ai][bj][m][n];
                        if (reg < 2) {
                            const f32x4 bias = *(const f32x4*)(w0 + reg * 512 + ch);
                            f32x4 o;
#pragma unroll
                            for (int i = 0; i < 4; ++i) {
                                const float x = -(bias[i] + a[i]);
                                const float sp_ = fmaxf(x, 0.f) + __logf(1.0f + __expf(-fabsf(x)));
                                o[i] = __expf(-__expf(-sp_ - 0.5f));
                            }
                            *(f32x4*)(sp + (reg ? SL_W1 : SL_W0) * 64) = o;
                        } else if (reg < 4) {
                            const int d = reg - 2;
                            const f32x4 bias = *(const f32x4*)(a0 + d * 512 + ch);
                            *(f32x4*)(sp + (d ? SL_A1 : SL_A0) * 64) = (f32x4){sigmoidf_(bias[0] + a[0]), sigmoidf_(bias[1] + a[1]), sigmoidf_(bias[2] + a[2]), sigmoidf_(bias[3] + a[3])};
                        } else {
                            *(u32x2*)(P + (size_t)r * PP + IC_RW + ch) = pack4(a);
                        }
                        asm volatile("" ::: "memory");
                    }
            }
    }
};

struct LoraSched {
    pg8::StaticOrder S;
    __device__ __forceinline__ bool next(int i, Unit& u) const { if (!S.next(i, u)) return false; const int reg = u.pn >> 1; u.koff = 128 * (reg < 4 ? (reg >> 1) : 2); return true; }
    __device__ __forceinline__ void a_ready(const Unit&) const {}
    __device__ __forceinline__ void done(const Unit&) const {}
};
struct EpiGate {
    static constexpr bool PERM = true, AFTER_DRAIN = false;
    bf16_t* G;
    __device__ __forceinline__ void operator()(const f32x4 (&acc)[2][2][4][2], const Unit& u, int wr, int wc, int fr, int fq) const {
#pragma unroll
        for (int ai = 0; ai < 2; ++ai)
#pragma unroll
            for (int m = 0; m < 4; ++m) {
                const int r = u.pm * 256 + ai * 128 + wr * 64 + m * 16 + fr;
#pragma unroll
                for (int bj = 0; bj < 2; ++bj) {
                    const int c = u.pn * 256 + bj * 128 + wc * 32 + 8 * fq;
                    const f32x4 a0 = acc[ai][bj][m][0], a1 = acc[ai][bj][m][1];
                    u32x4 w; w.x = pk2(sigmoidf_(a0.x), sigmoidf_(a0.y)); w.y = pk2(sigmoidf_(a0.z), sigmoidf_(a0.w)); w.z = pk2(sigmoidf_(a1.x), sigmoidf_(a1.y)); w.w = pk2(sigmoidf_(a1.z), sigmoidf_(a1.w));
                    *(u32x4*)(G + (size_t)r * 3072 + c) = w;
                }
            }
    }
};

struct MergeSched {
    pg8::StaticOrder S; int nMtot;
    __device__ __forceinline__ bool next(int i, Unit& u) const { const int pass = i % 3; if (!S.next(i / 3, u)) return false; u.pm += pass * nMtot; u.pn += pass * 4; u.tail = pass; return true; }
    __device__ __forceinline__ void a_ready(const Unit&) const {}
    __device__ __forceinline__ void done(const Unit&) const {}
};
struct EpiMergeF {
    static constexpr bool PERM = true, AFTER_DRAIN = false;
    const bf16_t* G; bf16_t* MF; bf16_t* MB; int nMtot;
    __device__ __forceinline__ void operator()(const f32x4 (&acc)[2][2][4][2], const Unit& u, int wr, int wc, int fr, int fq) const {
        const int pass = u.tail, pm = u.pm - pass * nMtot, pn = u.pn - 4 * pass;
        bf16_t* dstb = pass < 2 ? MF : MB;
#pragma unroll
        for (int ai = 0; ai < 2; ++ai)
#pragma unroll
            for (int m = 0; m < 4; ++m) {
                const int r = pm * 256 + ai * 128 + wr * 64 + m * 16 + fr;
#pragma unroll
                for (int bj = 0; bj < 2; ++bj) {
                    const int c = pn * 256 + bj * 128 + wc * 32 + 8 * fq;
                    const u32x4 gw = *(const u32x4*)(G + (size_t)r * 3072 + pass * 1024 + c);
                    f32x4 v0 = unpack4((u32x2){gw.x, gw.y}) * acc[ai][bj][m][0], v1 = unpack4((u32x2){gw.z, gw.w}) * acc[ai][bj][m][1];
                    if (pass > 0) { const u32x4 mw = *(const u32x4*)(MF + (size_t)r * 1024 + c); v0 += unpack4((u32x2){mw.x, mw.y}); v1 += unpack4((u32x2){mw.z, mw.w}); }
                    const u32x2 p0 = pack4(v0), p1 = pack4(v1);
                    *(u32x4*)(dstb + (size_t)r * 1024 + c) = (u32x4){p0.x, p0.y, p1.x, p1.y};
                }
            }
    }
};
template <int PASS> struct EpiMerge {
    static constexpr bool PERM = false, AFTER_DRAIN = false;
    const bf16_t* G; bf16_t* MF; bf16_t* MB;
    __device__ __forceinline__ void operator()(const f32x4 (&acc)[2][2][4][2], const Unit& u, int wr, int wc, int fr, int fq) const {
#pragma unroll
        for (int ai = 0; ai < 2; ++ai)
#pragma unroll
            for (int m = 0; m < 4; ++m) {
                const int r = u.pm * 256 + ai * 128 + wr * 64 + m * 16 + fr;
#pragma unroll
                for (int bj = 0; bj < 2; ++bj)
#pragma unroll
                    for (int n = 0; n < 2; ++n) {
                        const int c = u.pn * 256 + bj * 128 + wc * 32 + 16 * n + 4 * fq;
                        const f32x4 g = unpack4(*(const u32x2*)(G + (size_t)r * 3072 + PASS * 1024 + c));
                        f32x4 v = g * acc[ai][bj][m][n];
                        bf16_t* mp = MF + (size_t)r * 1024 + c;
                        if (PASS > 0) v += unpack4(*(const u32x2*)mp);
                        *(u32x2*)(PASS < 2 ? mp : MB + (size_t)r * 1024 + c) = pack4(v);
                    }
            }
    }
};

struct EpiBf {
    static constexpr bool PERM = true, AFTER_DRAIN = false;
    bf16_t* O; int ldc;
    __device__ __forceinline__ void operator()(const f32x4 (&acc)[2][2][4][2], const Unit& u, int wr, int wc, int fr, int fq) const {
#pragma unroll
        for (int ai = 0; ai < 2; ++ai)
#pragma unroll
            for (int m = 0; m < 4; ++m) {
                const int r = u.pm * 256 + ai * 128 + wr * 64 + m * 16 + fr;
#pragma unroll
                for (int bj = 0; bj < 2; ++bj) {
                    const int c = u.pn * 256 + bj * 128 + wc * 32 + 8 * fq;
                    const f32x4 a0 = acc[ai][bj][m][0], a1 = acc[ai][bj][m][1];
                    u32x4 w; w.x = pk2(a0.x, a0.y); w.y = pk2(a0.z, a0.w); w.z = pk2(a1.x, a1.y); w.w = pk2(a1.z, a1.w);
                    *(u32x4*)(O + (size_t)r * ldc + c) = w;
                }
            }
    }
};

struct TailSched {
    pg8::StaticOrder S; int nwg_main, nM_main, nN, nsl, kt, nitems, G, c;
    __device__ void init(int M_main, int N, int G_, int c_, int ntail, int kt_, int nsl_) { S.init(M_main, N, G_, c_); nwg_main = S.nwg; nM_main = M_main / pg8::BM; nN = N / pg8::BM; nsl = nsl_; kt = kt_; nitems = ntail * nN * nsl; G = G_; c = c_; }
    __device__ __forceinline__ bool next(int i, Unit& u) const {
        const long L = (long)i * G + c;
        if (L < nwg_main) return S.next(i, u);
        const int j = (int)(L - nwg_main); if (j >= nitems) return false;
        const int sl = j % nsl, tu = j / nsl;
        u.pm = nM_main + tu / nN; u.pn = tu % nN; u.koff = sl * kt * pg8::BK; u.tail = sl; u.kt = kt; return true;
    }
    __device__ __forceinline__ void a_ready(const Unit&) const {}
    __device__ __forceinline__ void done(const Unit&) const {}
};
struct EpiBfTail {
    static constexpr bool PERM = true, AFTER_DRAIN = false;
    bf16_t* O; int ldc; float* part; int row0, rows;
    __device__ __forceinline__ void operator()(const f32x4 (&acc)[2][2][4][2], const Unit& u, int wr, int wc, int fr, int fq) const {
        if (u.tail < 0) { EpiBf E{O, ldc}; E(acc, u, wr, wc, fr, fq); return; }
        float* base = part + (size_t)(u.tail * rows + (u.pm * 256 - row0) + wr * 64 + fr) * ldc + u.pn * 256 + wc * 32 + 8 * fq;
#pragma unroll
        for (int ai = 0; ai < 2; ++ai)
#pragma unroll
            for (int m = 0; m < 4; ++m)
#pragma unroll
                for (int bj = 0; bj < 2; ++bj) {
                    float* d = base + (size_t)(ai * 128 + m * 16) * ldc + bj * 128;
                    *(f32x4*)d = acc[ai][bj][m][0]; *(f32x4*)(d + 4) = acc[ai][bj][m][1];
                }
    }
};

struct EpiSwiglu {
    static constexpr bool PERM = true, AFTER_DRAIN = false;
    bf16_t* H; int ldh; int npn; int pm_sub;
    __device__ __forceinline__ void operator()(const f32x4 (&acc)[2][2][4][2], const Unit& u, int wr, int wc, int fr, int fq) const {
        const int pnn = u.pn % npn;
#pragma unroll
        for (int ai = 0; ai < 2; ++ai)
#pragma unroll
            for (int m = 0; m < 4; ++m) {
                const int r = (u.pm - pm_sub) * 256 + ai * 128 + wr * 64 + m * 16 + fr;
                const int hc = pnn * 128 + wc * 32 + 8 * fq;
                const f32x4 g0 = acc[ai][0][m][0], g1 = acc[ai][0][m][1], u0 = acc[ai][1][m][0], u1 = acc[ai][1][m][1];
                u32x4 w; w.x = pk2(siluf_(g0.x) * u0.x, siluf_(g0.y) * u0.y); w.y = pk2(siluf_(g0.z) * u0.z, siluf_(g0.w) * u0.w);
                w.z = pk2(siluf_(g1.x) * u1.x, siluf_(g1.y) * u1.y); w.w = pk2(siluf_(g1.z) * u1.z, siluf_(g1.w) * u1.w);
                *(u32x4*)(H + (size_t)r * ldh + hc) = w;
            }
    }
};

struct MoeSched {
    int ts[9]; int pm_lo, pm_hi, npn, G, c; bool a_local;
    __device__ __forceinline__ int expert_of(int pm) const { int e = 0;
#pragma unroll
        for (int q = 1; q < 8; ++q) e += (pm >= ts[q]) ? 1 : 0;
        return e; }
    __device__ __forceinline__ bool next(int i, Unit& u) const {
        const int n = (pm_hi - pm_lo) * npn; const long L = (long)i * G + c; if (L >= n) return false;
        const int pm = pm_lo + (int)L / npn, pnn = (int)L % npn;
        u.pm = a_local ? pm - pm_lo : pm; u.pn = expert_of(pm) * npn + pnn; u.koff = 0; u.tail = -1; u.kt = 0; return true;
    }
    __device__ __forceinline__ void a_ready(const Unit&) const {}
    __device__ __forceinline__ void done(const Unit&) const {}
};
struct EpiMoeDown {
    static constexpr bool PERM = false, AFTER_DRAIN = false;
    bf16_t* FS; long slot1_off; const int* LIST; const float* WTS; const unsigned* cnt; int ts[9]; int pm_lo;
    __device__ __forceinline__ void operator()(const f32x4 (&acc)[2][2][4][2], const Unit& u, int wr, int wc, int fr, int fq) const {
        const int e = u.pn >> 2, pnn = u.pn & 3, pmg = u.pm + pm_lo;
        int tse = 0;
#pragma unroll
        for (int q = 0; q < 8; ++q) tse = (q == e) ? ts[q] : tse;
        const int ne = (int)cnt[e];
#pragma unroll
        for (int ai = 0; ai < 2; ++ai)
#pragma unroll
            for (int m = 0; m < 4; ++m) {
                const int slot = (pmg - tse) * 256 + ai * 128 + wr * 64 + m * 16 + fr;
                if (slot < ne) {
                    const int tk = LIST[e * 16384 + slot]; const float w = WTS[e * 16384 + slot];
                    bf16_t* dst = FS + (long)(tk & 1) * slot1_off + (size_t)(tk >> 1) * 1024 + pnn * 256 + wc * 32 + 4 * fq;
#pragma unroll
                    for (int bj = 0; bj < 2; ++bj)
#pragma unroll
                        for (int n = 0; n < 2; ++n) *(u32x2*)(dst + bj * 128 + 16 * n) = pack4(acc[ai][bj][m][n] * w);
                }
            }
    }
};

constexpr float SC2 = 0.125f * 1.4426950408889634f;
constexpr float ATT_THR = 6.0f;
__device__ __forceinline__ float xhalf_max(float v) { auto rr = __builtin_amdgcn_permlane32_swap(__float_as_uint(v), __float_as_uint(v), false, false); return fmaxf(__uint_as_float(rr[0]), __uint_as_float(rr[1])); }
__device__ __forceinline__ float xhalf_sum(float v) { auto rr = __builtin_amdgcn_permlane32_swap(__float_as_uint(v), __float_as_uint(v), false, false); return __uint_as_float(rr[0]) + __uint_as_float(rr[1]); }

template <int DV, bool WINDOW, int ROT = 0>
__device__ __forceinline__ void attn_pass(LAS unsigned char* lds, const bf16_t* __restrict__ P, int qrow0, int qcol, int kcol, const bf16_t* __restrict__ VT,
                                          int lat_row0, int ctx_row0, int tile_lo, int tile_hi, bool has_ref, float m0, float l0, int qpos0,
                                          f32x16 (&o)[DV / 32], float& l_out, int wave, int lane) {
    constexpr int STG = 8192 + DV * 128, ND = 1 + DV / 64;
    int tid_ = threadIdx.x; asm volatile("" : "+v"(tid_)); const int tid = tid_; lane = tid & 63; const int qn = lane & 31, half = lane >> 5;
    bf16x8 qf[4];
    { const bf16_t* qp = P + (size_t)(qrow0 + wave * 32 + qn) * PP + qcol + half * 8;
#pragma unroll
      for (int ks = 0; ks < 4; ++ks) qf[ks] = *(const bf16x8*)(qp + ks * 16); }
    float mrun = has_ref ? m0 : 0.f, lrun = (half == 0) ? l0 : 0.f;
    bool need_ref = !has_ref;
    f32x16 negm;
#pragma unroll
    for (int i = 0; i < 16; ++i) negm[i] = -mrun;
#pragma unroll
    for (int db = 0; db < DV / 32; ++db)
#pragma unroll
        for (int i = 0; i < 16; ++i) o[db][i] = 0.f;
    const int nlat = tile_hi - tile_lo, nt = nlat + 4;
    const int drow = wave * 8 + (lane >> 3), dchk = ((lane & 7) ^ (4 * (wave & 1) + (lane >> 4))) * 8;
    const bf16_t* ksrc = P + (size_t)drow * PP + kcol + dchk;
    const bf16_t* vsrc = VT + (size_t)drow * KEYS + dchk;
#define ATT_DMA(ti_, sg_, vg_) do { const int id_ = (ti_) < nlat ? tile_lo + (ti_) : 128 + ((ti_) - nlat); \
        const int krow0_ = id_ < 128 ? lat_row0 + 64 * id_ : ctx_row0 + 64 * (id_ - 128); \
        LAS unsigned char* kst_ = (ROT ? lds + (sg_) * 8192 : lds + (sg_) * STG) + wave * 1024; LAS unsigned char* vst_ = (ROT ? lds + 24576 + (vg_) * (DV * 128) : lds + (sg_) * STG + 8192) + wave * 1024; \
        __builtin_amdgcn_global_load_lds((const unsigned*)(ksrc + (size_t)krow0_ * PP), (LAS unsigned*)kst_, 16, 0, 0); \
        _Pragma("unroll") for (int j_ = 0; j_ < DV / 64; ++j_) \
            __builtin_amdgcn_global_load_lds((const unsigned*)(vsrc + (size_t)(64 * j_) * KEYS + 64 * id_), (LAS unsigned*)(vst_ + j_ * 8192), 16, 0, 0); } while (0)
    __syncthreads();
    ATT_DMA(0, 0, 0);
    if (nt > 1) { ATT_DMA(1, 1, 1); asm volatile("s_waitcnt vmcnt(%0)" :: "n"(ND) : "memory"); } else asm volatile("s_waitcnt vmcnt(0)" ::: "memory");
    __syncthreads();
    int sg = 0, vg = 0;
    u32x4 pw[4];
#define ATT_PV(vs_) do { const LAS unsigned char* vs0_ = (vs_); \
        _Pragma("unroll") for (int g = 0; g < 4; ++g) { const bf16x8 pf = __builtin_bit_cast(bf16x8, pw[g]); \
            _Pragma("unroll") for (int db = 0; db < DV / 32; ++db) { \
                const bf16x8 vf = *(const LAS bf16x8*)(vs0_ + (32 * db + qn) * 128 + (((2 * g + half) ^ sw7) * 16)); \
                o[db] = __builtin_amdgcn_mfma_f32_32x32x16_bf16(vf, pf, o[db], 0, 0, 0); } } } while (0)
    const int sw7 = (qn >> 1) & 7;
    for (int ti = 0; ti < nt; ++ti) {
        if (ti + 2 < nt) { const int sg2 = sg == 0 ? 2 : sg - 1; ATT_DMA(ti + 2, sg2, (vg + 2) & 3); }
        const LAS unsigned char* Ks = ROT ? lds + sg * 8192 : lds + sg * STG; const LAS unsigned char* Vs = ROT ? lds + 24576 + vg * (DV * 128) : Ks + 8192;
        if (ROT == 2 && ti > 0) ATT_PV(lds + 24576 + ((vg + 3) & 3) * (DV * 128));
        const int id = ti < nlat ? tile_lo + ti : 128 + (ti - nlat);
        const bool islat = id < 128;
        bool skip = false;
        if (WINDOW && islat) { const int qw = qpos0 + wave * 32; skip = (64 * id + 63 < qw - 128 || 64 * id > qw + 31 + 128); }
        if (!skip) {
        f32x16 s[2];
#pragma unroll
        for (int mb = 0; mb < 2; ++mb) {
#pragma unroll
            for (int ks = 0; ks < 4; ++ks) {
                const bf16x8 kf = *(const LAS bf16x8*)(Ks + (32 * mb + qn) * 128 + (((2 * ks + half) ^ sw7) * 16));
                if (ks == 0) s[mb] = __builtin_amdgcn_mfma_f32_32x32x16_bf16(kf, qf[0], negm, 0, 0, 0);
                else s[mb] = __builtin_amdgcn_mfma_f32_32x32x16_bf16(kf, qf[ks], s[mb], 0, 0, 0);
            }
        }
        if (WINDOW && islat) {
            const int qpos = qpos0 + wave * 32 + qn;
#pragma unroll
            for (int mb = 0; mb < 2; ++mb)
#pragma unroll
                for (int i = 0; i < 16; ++i) { const int d = 64 * id + 32 * mb + 8 * (i >> 2) + 4 * half + (i & 3) - qpos; if (d > 128 || d < -128) s[mb][i] = -INFINITY; }
        }
        float mx = s[0][0];
#pragma unroll
        for (int mb = 0; mb < 2; ++mb)
#pragma unroll
            for (int i = 0; i < 16; ++i) mx = fmaxf(mx, s[mb][i]);
        mx = xhalf_max(mx);
        if (__builtin_expect(need_ref || __any(mx > ATT_THR), 0)) {
            const float delta = need_ref ? mx : fmaxf(mx, 0.f);
            if (!need_ref) {
                const float alpha = __builtin_amdgcn_exp2f(-delta);
                lrun *= alpha;
#pragma unroll
                for (int db = 0; db < DV / 32; ++db)
#pragma unroll
                    for (int i = 0; i < 16; ++i) o[db][i] *= alpha;
            }
            mrun += delta; need_ref = false;
#pragma unroll
            for (int mb = 0; mb < 2; ++mb)
#pragma unroll
                for (int i = 0; i < 16; ++i) s[mb][i] -= delta;
#pragma unroll
            for (int i = 0; i < 16; ++i) negm[i] = -mrun;
        }
        float rs = 0.f;
#pragma unroll
        for (int mb = 0; mb < 2; ++mb)
#pragma unroll
            for (int i = 0; i < 16; ++i) { const float pv = __builtin_amdgcn_exp2f(s[mb][i]); s[mb][i] = pv; rs += pv; }
        lrun += rs;
        if (ROT == 2) {
#pragma unroll
            for (int g = 0; g < 4; ++g) {
                const int mb = g >> 1, bs = 8 * (g & 1);
                pw[g].x = pk2(s[mb][bs + 0], s[mb][bs + 1]); pw[g].y = pk2(s[mb][bs + 2], s[mb][bs + 3]); pw[g].z = pk2(s[mb][bs + 4], s[mb][bs + 5]); pw[g].w = pk2(s[mb][bs + 6], s[mb][bs + 7]);
            }
        } else {
#pragma unroll
            for (int g = 0; g < 4; ++g) {
                const int mb = g >> 1, bs = 8 * (g & 1);
                u32x4 pq; pq.x = pk2(s[mb][bs + 0], s[mb][bs + 1]); pq.y = pk2(s[mb][bs + 2], s[mb][bs + 3]); pq.z = pk2(s[mb][bs + 4], s[mb][bs + 5]); pq.w = pk2(s[mb][bs + 6], s[mb][bs + 7]);
                const bf16x8 pf = __builtin_bit_cast(bf16x8, pq);
#pragma unroll
                for (int db = 0; db < DV / 32; ++db) {
                    const bf16x8 vf = *(const LAS bf16x8*)(Vs + (32 * db + qn) * 128 + (((2 * g + half) ^ sw7) * 16));
                    o[db] = __builtin_amdgcn_mfma_f32_32x32x16_bf16(vf, pf, o[db], 0, 0, 0);
                }
            }
        }
        }
        if (ti + 2 < nt) asm volatile("s_waitcnt vmcnt(%0)" :: "n"(ND) : "memory"); else asm volatile("s_waitcnt vmcnt(0)" ::: "memory");
        __syncthreads();
        sg = sg == 2 ? 0 : sg + 1; vg = (vg + 1) & 3;
    }
    if (ROT == 2) ATT_PV(lds + 24576 + ((vg + 3) & 3) * (DV * 128));
#undef ATT_DMA
#undef ATT_PV
    l_out = xhalf_sum(lrun);
}

__device__ __forceinline__ void swa_unit(LAS unsigned char* lds, const Params& p, int layer, int b, int hq, int qb, bool ctx, int wave, int lane, bool dry = false) {
    bf16_t* P = (bf16_t*)(p.ws + WS_P);
    const int kvh = hq >> 2;
    const bf16_t* VT = (const bf16_t*)(p.ws + WS_VTS) + (size_t)((b * 2 + kvh) * 64) * KEYS;
    const float sink2 = p.in[11][layer * 8 + hq] * 1.4426950408889634f;
    const int qrow0 = ctx ? NLAT + b * CTXL : b * SEQ + qb * 256;
    f32x16 o[2]; float l;
    if (ctx) attn_pass<64, false>(lds, P, qrow0, IC_QS + hq * 64, IC_KS + kvh * 64, VT, b * SEQ, NLAT + b * CTXL, 0, 0, true, sink2, 1.0f, 0, o, l, wave, lane);
    else {
        int lo = 4 * qb - 2; if (lo < 0) lo = 0; int hi = 4 * qb + 6; if (hi > 128) hi = 128;
        attn_pass<64, true>(lds, P, qrow0, IC_QS + hq * 64, IC_KS + kvh * 64, VT, b * SEQ, NLAT + b * CTXL, lo, hi, true, sink2, 1.0f, qb * 256, o, l, wave, lane);
    }
    const float inv = 1.0f / l; const int qn = lane & 31, half = lane >> 5;
    bf16_t* dst = P + (size_t)(qrow0 + wave * 32 + qn) * PP + IC_QS + hq * 64 + 4 * half;
#pragma unroll
    for (int db = 0; db < 2; ++db)
#pragma unroll
        for (int q4 = 0; q4 < 4; ++q4) {
            const f32x4 v = (f32x4){o[db][4 * q4] * inv, o[db][4 * q4 + 1] * inv, o[db][4 * q4 + 2] * inv, o[db][4 * q4 + 3] * inv};
            if (!dry) *(u32x2*)(dst + 32 * db + 8 * q4) = pack4(v);
        }
}
__device__ __forceinline__ void diff_unit(LAS unsigned char* lds, const Params& p, float lam, int b, int h, int qb, bool ctx, int unit, int wave, int lane, bool dry = false) {
    bf16_t* P = (bf16_t*)(p.ws + WS_P);
    const bf16_t* VT = (const bf16_t*)(p.ws + WS_VTD) + (size_t)((b * 4 + h) * 128) * KEYS;
    const int qrow0 = ctx ? NLAT + b * CTXL : b * SEQ + qb * 256;
    const int thi = ctx ? 0 : 128;
    unsigned* park = (unsigned*)(p.ws + WS_YA) + (size_t)(4 * unit) * 8192 + threadIdx.x;
#define PARK(w_) park[(size_t)((w_) >> 3) * 8192 + ((w_) & 7) * 512]
    f32x16 o[4]; float l;
    if (wave < 4) attn_pass<128, false, 1>(lds, P, qrow0, IC_QD + h * 128, IC_KD + h * 128, VT, b * SEQ, NLAT + b * CTXL, 0, thi, false, 0.f, 0.f, 0, o, l, wave, lane);
    else attn_pass<128, false, 2>(lds, P, qrow0, IC_QD + h * 128, IC_KD + h * 128, VT, b * SEQ, NLAT + b * CTXL, 0, thi, false, 0.f, 0.f, 0, o, l, wave, lane);
    { const float inv = 1.0f / l;
#pragma unroll
      for (int db = 0; db < 4; ++db)
#pragma unroll
          for (int i = 0; i < 8; ++i) PARK(db * 8 + i) = pk2(o[db][2 * i] * inv, o[db][2 * i + 1] * inv); }
    if (wave < 4) attn_pass<128, false, 1>(lds, P, qrow0, IC_QD + h * 128 + 64, IC_KD + h * 128 + 64, VT, b * SEQ, NLAT + b * CTXL, 0, thi, false, 0.f, 0.f, 0, o, l, wave, lane);
    else attn_pass<128, false, 2>(lds, P, qrow0, IC_QD + h * 128 + 64, IC_KD + h * 128 + 64, VT, b * SEQ, NLAT + b * CTXL, 0, thi, false, 0.f, 0.f, 0, o, l, wave, lane);
    const float inv = lam / l; const int qn = lane & 31, half = lane >> 5;
    bf16_t* dst = P + (size_t)(qrow0 + wave * 32 + qn) * PP + IC_QD + h * 128 + 4 * half;
#pragma unroll
    for (int db = 0; db < 4; ++db)
#pragma unroll
        for (int q4 = 0; q4 < 4; ++q4) {
            const unsigned pa = PARK(db * 8 + 2 * q4), pb = PARK(db * 8 + 2 * q4 + 1);
            const f32x4 v = (f32x4){bflo(pa) - o[db][4 * q4] * inv, bfhi(pa) - o[db][4 * q4 + 1] * inv, bflo(pb) - o[db][4 * q4 + 2] * inv, bfhi(pb) - o[db][4 * q4 + 3] * inv};
            if (!dry) *(u32x2*)(dst + 32 * db + 8 * q4) = pack4(v);
        }
#undef PARK
}

__device__ __forceinline__ void ld8bf(const bf16_t* p, float (&v)[8]) { const u32x4 w = *(const u32x4*)p; v[0] = bflo(w.x); v[1] = bfhi(w.x); v[2] = bflo(w.y); v[3] = bfhi(w.y); v[4] = bflo(w.z); v[5] = bfhi(w.z); v[6] = bflo(w.w); v[7] = bfhi(w.w); }
__device__ __forceinline__ void ld8f(const float* p, float (&v)[8]) { const f32x4 a = ((const f32x4*)p)[0], b = ((const f32x4*)p)[1]; v[0] = a.x; v[1] = a.y; v[2] = a.z; v[3] = a.w; v[4] = b.x; v[5] = b.y; v[6] = b.z; v[7] = b.w; }
__device__ __forceinline__ void st8f(float* p, const float (&v)[8]) { ((f32x4*)p)[0] = (f32x4){v[0], v[1], v[2], v[3]}; ((f32x4*)p)[1] = (f32x4){v[4], v[5], v[6], v[7]}; }

__device__ __forceinline__ void rwkv_prepare_phase(const Params& p, int layer, int gw, int NGW, int lane) {
    const bf16_t* P = (const bf16_t*)(p.ws + WS_P); float* ST = (float*)(p.ws + WS_ST); bf16_t* A2 = (bf16_t*)(p.ws + WS_YA);
    const float* mup = p.in[12] + layer * 1920; const float* mun = p.in[13] + layer * 1920; const float* k_k = p.in[19] + layer * 512;
    for (int m = gw; m < NTOK; m += NGW) {
        const int t = m < NLAT ? (m & (SEQ - 1)) : ((m - NLAT) & (CTXL - 1)), len = m < NLAT ? SEQ : CTXL;
        const bool hp = t > 0, hn = t < len - 1;
        const bf16_t* pr = P + (size_t)m * PP + IC_RW;
        const int h = lane >> 3, l4 = (lane & 7) * 4;
        float* sp = ST + ((size_t)m * 8 + h) * (ST_SLOTS * 64) + l4;
#pragma unroll
        for (int sec = 0; sec < 3; ++sec) {
            const int col = sec * 512 + h * 64 + l4;
            float sh[8];
#pragma unroll
            for (int hv = 0; hv < 2; ++hv) {
                const int cc = col + 32 * hv;
                const u32x2 cw = *(const u32x2*)(pr + cc);
                u32x2 pw_ = (u32x2){0u, 0u}, nw_ = (u32x2){0u, 0u};
                if (hp) pw_ = *(const u32x2*)(pr - PP + cc);
                if (hn) nw_ = *(const u32x2*)(pr + PP + cc);
                const f32x4 a = *(const f32x4*)(mup + cc), bb = *(const f32x4*)(mun + cc);
                const float c[4] = {bflo(cw.x), bfhi(cw.x), bflo(cw.y), bfhi(cw.y)};
                const float pv[4] = {hp ? bflo(pw_.x) : 0.f, hp ? bfhi(pw_.x) : 0.f, hp ? bflo(pw_.y) : 0.f, hp ? bfhi(pw_.y) : 0.f};
                const float nx[4] = {hn ? bflo(nw_.x) : 0.f, hn ? bfhi(nw_.x) : 0.f, hn ? bflo(nw_.y) : 0.f, hn ? bfhi(nw_.y) : 0.f};
#pragma unroll
                for (int q = 0; q < 4; ++q) sh[4 * hv + q] = c[q] + a[q] * (pv[q] - c[q]) + bb[q] * (nx[q] - c[q]);
            }
            const int slot = sec == 0 ? SL_R : (sec == 1 ? SL_K : SL_V);
            *(f32x4*)(sp + slot * 64) = (f32x4){sh[0], sh[1], sh[2], sh[3]}; *(f32x4*)(sp + slot * 64 + 32) = (f32x4){sh[4], sh[5], sh[6], sh[7]};
            if (sec == 1) {
                const f32x4 w0 = *(const f32x4*)(k_k + h * 64 + l4), w1 = *(const f32x4*)(k_k + h * 64 + 32 + l4);
                float kk[8]; float ss = 0.f;
#pragma unroll
                for (int q = 0; q < 4; ++q) { kk[q] = sh[q] * w0[q]; kk[4 + q] = sh[4 + q] * w1[q]; ss += kk[q] * kk[q] + kk[4 + q] * kk[4 + q]; }
                ss += __shfl_xor(ss, 1); ss += __shfl_xor(ss, 2); ss += __shfl_xor(ss, 4);
                const float inv = 1.0f / fmaxf(sqrtf(ss), 1e-12f);
                *(f32x4*)(sp + SL_KK * 64) = (f32x4){kk[0] * inv, kk[1] * inv, kk[2] * inv, kk[3] * inv}; *(f32x4*)(sp + SL_KK * 64 + 32) = (f32x4){kk[4] * inv, kk[5] * inv, kk[6] * inv, kk[7] * inv};
            }
        }
        if (lane < 48) {
            const int col = 1536 + lane * 8;
            float c[8], pv[8], nx[8], a[8], bb[8], sh[8];
            ld8bf(pr + col, c);
            if (hp) ld8bf(pr - PP + col, pv); else {
#pragma unroll
                for (int q = 0; q < 8; ++q) pv[q] = 0.f; }
            if (hn) ld8bf(pr + PP + col, nx); else {
#pragma unroll
                for (int q = 0; q < 8; ++q) nx[q] = 0.f; }
            ld8f(mup + col, a); ld8f(mun + col, bb);
#pragma unroll
            for (int q = 0; q < 8; ++q) sh[q] = c[q] + a[q] * (pv[q] - c[q]) + bb[q] * (nx[q] - c[q]);
            float o[8];
#pragma unroll
            for (int q = 0; q < 8; ++q) o[q] = lane < 16 ? tanhf(sh[q]) : (lane < 32 ? sh[q] : sigmoidf_(sh[q]));
            u32x4 w; w.x = pk2(o[0], o[1]); w.y = pk2(o[2], o[3]); w.z = pk2(o[4], o[5]); w.w = pk2(o[6], o[7]);
            *(u32x4*)(A2 + (size_t)m * 384 + lane * 8) = w;
        }
    }
}

constexpr int NSEG = 64, SEGL = KEYS / NSEG;
static_assert(SEGL * NSEG == KEYS && SEGL % 4 == 0, "segments");
constexpr size_t WS_GH = WS_YA;
static_assert(WS_GH + 32ull * NSEG * 2 * 4096 * 4 <= 560 * MiB, "GH fits behind the stream");
__device__ __forceinline__ int scan_token(int b, int dir, int s) {
    if (s < CTXL) return NLAT + b * CTXL + (dir ? CTXL - 1 - s : s);
    const int t = s - CTXL; return b * SEQ + (dir ? SEQ - 1 - t : t);
}
constexpr int SRING = 6, SREC = 6 * 64 * 4;
constexpr int SCAN_LDS = SRING * SREC;
__device__ __forceinline__ void scan_dma(const float* rec, LAS unsigned char* slot, int lane) {
    const float* q = rec + lane * 4;
    __builtin_amdgcn_global_load_lds((const unsigned*)q, (LAS unsigned*)slot, 16, 0, 0);
    if (lane < 32) __builtin_amdgcn_global_load_lds((const unsigned*)(q + 256), (LAS unsigned*)(slot + 1024), 16, 0, 0);
}
template <int MODE>
__device__ __forceinline__ void rwkv_segment(const Params& p, int layer, int sid, int seg, int lane, LAS unsigned char* ring) {
    const int b = sid >> 4, h = (sid >> 1) & 7, dir = sid & 1, c = lane & 31, hf = lane >> 5;
    const float ka0 = p.in[20][layer * 512 + h * 64 + c], ka1 = p.in[20][layer * 512 + h * 64 + 32 + c];
    const float rk0 = MODE == 2 ? p.in[21][layer * 512 + h * 64 + c] : 0.f, rk1 = MODE == 2 ? p.in[21][layer * 512 + h * 64 + 32 + c] : 0.f;
    const float* ST = (const float*)(p.ws + WS_ST);
    float* gh = (float*)(p.ws + WS_GH) + ((size_t)sid * NSEG + seg) * 2 * 4096;
    f32x16 TH[2][2], TG[MODE == 0 ? 2 : 1][2];
#pragma unroll
    for (int kb = 0; kb < 2; ++kb)
#pragma unroll
        for (int vb = 0; vb < 2; ++vb) {
            if (MODE == 2 && seg > 0) {
                const float* src = gh - 4096 + (32 * vb + c) * 64 + 32 * kb + 4 * hf;
#pragma unroll
                for (int q = 0; q < 4; ++q) { const f32x4 t = *(const f32x4*)(src + 8 * q); TH[kb][vb][4 * q] = t.x; TH[kb][vb][4 * q + 1] = t.y; TH[kb][vb][4 * q + 2] = t.z; TH[kb][vb][4 * q + 3] = t.w; }
            } else {
#pragma unroll
                for (int r = 0; r < 16; ++r) TH[kb][vb][r] = 0.f;
            }
            if (MODE == 0) {
#pragma unroll
                for (int r = 0; r < 16; ++r) TG[MODE == 0 ? kb : 0][vb][r] = (32 * kb + 8 * (r >> 2) + 4 * hf + (r & 3) == 32 * vb + c) ? 1.0f : 0.0f;
            }
        }
    const int s0 = seg * SEGL, s_end = s0 + SEGL;
    const int okk = dir ? 0 : 512, od = dir ? 1024 : 0, gsl = dir ? SL_KK * 64 : 0;
#pragma unroll 1
    for (int j = 0; j < SRING - 1; ++j) scan_dma(ST + ((size_t)scan_token(b, dir, s0 + j) * 8 + h) * (ST_SLOTS * 64) + gsl, ring + j * SREC, lane);
    int slot_i = 0;
#pragma unroll 1
    for (int s = s0; s < s_end; ++s) {
        if (s + SRING - 1 < s_end) {
            int nslot = slot_i + SRING - 1; if (nslot >= SRING) nslot -= SRING;
            scan_dma(ST + ((size_t)scan_token(b, dir, s + SRING - 1) * 8 + h) * (ST_SLOTS * 64) + gsl, ring + nslot * SREC, lane);
            asm volatile("s_waitcnt vmcnt(10)" ::: "memory");
        } else asm volatile("s_waitcnt vmcnt(0)" ::: "memory");
        const LAS unsigned char* rec = ring + slot_i * SREC;
        slot_i = slot_i + 1 == SRING ? 0 : slot_i + 1;
        f32x2_t ph[2] = {{0.f, 0.f}, {0.f, 0.f}}, pg[2] = {{0.f, 0.f}, {0.f, 0.f}};
#pragma unroll
        for (int kb = 0; kb < 2; ++kb)
#pragma unroll
            for (int q = 0; q < 4; ++q) {
                const f32x4 a4 = *(const LAS f32x4*)(rec + okk + (32 * kb + 8 * q + 4 * hf) * 4);
#pragma unroll
                for (int j = 0; j < 4; j += 2)
#pragma unroll
                    for (int vb = 0; vb < 2; ++vb) {
                        const f32x2_t a2 = {a4[j], a4[j + 1]};
                        ph[vb] = __builtin_elementwise_fma((f32x2_t){TH[kb][vb][4 * q + j], TH[kb][vb][4 * q + j + 1]}, a2, ph[vb]);
                        if (MODE == 0) pg[vb] = __builtin_elementwise_fma((f32x2_t){TG[MODE == 0 ? kb : 0][vb][4 * q + j], TG[MODE == 0 ? kb : 0][vb][4 * q + j + 1]}, a2, pg[vb]);
                    }
            }
        float sa[2], sg[2];
#pragma unroll
        for (int vb = 0; vb < 2; ++vb) { sa[vb] = xhalf_sum(ph[vb].x + ph[vb].y); sg[vb] = MODE == 0 ? xhalf_sum(pg[vb].x + pg[vb].y) : 0.f; }
#pragma unroll
        for (int kb = 0; kb < 2; ++kb)
#pragma unroll
            for (int q = 0; q < 4; ++q) {
                const f32x4 w4 = *(const LAS f32x4*)(rec + od + (32 * kb + 8 * q + 4 * hf) * 4);
#pragma unroll
                for (int j = 0; j < 4; ++j)
#pragma unroll
                    for (int vb = 0; vb < 2; ++vb) { TH[kb][vb][4 * q + j] *= w4[j]; if (MODE == 0) TG[MODE == 0 ? kb : 0][vb][4 * q + j] *= w4[j]; }
            }
        float aop[2], bop[2], bopg[2];
#pragma unroll
        for (int kb = 0; kb < 2; ++kb) {
            const float ag = *(const LAS float*)(rec + od + 256 + (32 * kb + c) * 4), x = *(const LAS float*)(rec + okk + (hf ? 768 : 0) + (32 * kb + c) * 4);
            aop[kb] = x * (hf ? fmaf(ag - 1.0f, kb ? ka1 : ka0, 1.0f) : -ag);
        }
        float bonus = 0.f;
        if (MODE == 2) {
            const float r0 = *(const LAS float*)(rec + okk + 256 + c * 4), r1 = *(const LAS float*)(rec + okk + 256 + (32 + c) * 4);
            bonus = fmaf(aop[0] * r0, rk0, aop[1] * r1 * rk1);
        }
#pragma unroll
        for (int vb = 0; vb < 2; ++vb) { const float vv = *(const LAS float*)(rec + okk + 512 + (32 * vb + c) * 4); bop[vb] = hf ? vv : sa[vb]; bopg[vb] = hf ? 0.f : sg[vb]; }
#pragma unroll
        for (int kb = 0; kb < 2; ++kb)
#pragma unroll
            for (int vb = 0; vb < 2; ++vb) {
                TH[kb][vb] = __builtin_amdgcn_mfma_f32_32x32x2f32(aop[kb], bop[vb], TH[kb][vb], 0, 0, 0);
                if (MODE == 0) TG[MODE == 0 ? kb : 0][vb] = __builtin_amdgcn_mfma_f32_32x32x2f32(aop[kb], bopg[vb], TG[MODE == 0 ? kb : 0][vb], 0, 0, 0);
            }
        if (MODE == 2) {
            f32x2_t py[2] = {{0.f, 0.f}, {0.f, 0.f}};
#pragma unroll
            for (int kb = 0; kb < 2; ++kb)
#pragma unroll
                for (int q = 0; q < 4; ++q) {
                    const f32x4 r4 = *(const LAS f32x4*)(rec + okk + 256 + (32 * kb + 8 * q + 4 * hf) * 4);
#pragma unroll
                    for (int j = 0; j < 4; j += 2)
#pragma unroll
                        for (int vb = 0; vb < 2; ++vb) py[vb] = __builtin_elementwise_fma((f32x2_t){TH[kb][vb][4 * q + j], TH[kb][vb][4 * q + j + 1]}, (f32x2_t){r4[j], r4[j + 1]}, py[vb]);
                }
            const float y0 = xhalf_sum(py[0].x + py[0].y), y1 = xhalf_sum(py[1].x + py[1].y);
            float* yp = (float*)ST + ((size_t)scan_token(b, dir, s) * 8 + h) * (ST_SLOTS * 64) + (dir ? SL_W1 : SL_W0) * 64 + c;
            if (hf == 0) { yp[0] = y0; yp[32] = y1; }
            if (hf) yp[64] = bonus;
        }
    }
    if (MODE == 0) {
#pragma unroll
        for (int kb = 0; kb < 2; ++kb)
#pragma unroll
            for (int vb = 0; vb < 2; ++vb) {
                float* dg = gh + (32 * vb + c) * 64 + 32 * kb + 4 * hf; float* dh = dg + 4096;
#pragma unroll
                for (int q = 0; q < 4; ++q) {
                    *(f32x4*)(dg + 8 * q) = (f32x4){TG[MODE == 0 ? kb : 0][vb][4 * q], TG[MODE == 0 ? kb : 0][vb][4 * q + 1], TG[MODE == 0 ? kb : 0][vb][4 * q + 2], TG[MODE == 0 ? kb : 0][vb][4 * q + 3]};
                    *(f32x4*)(dh + 8 * q) = (f32x4){TH[kb][vb][4 * q], TH[kb][vb][4 * q + 1], TH[kb][vb][4 * q + 2], TH[kb][vb][4 * q + 3]};
                }
            }
    }
}
__device__ __forceinline__ void rwkv_combine(const Params& p, int sid, LAS unsigned char* lds, int wave, int lane) {
    float* gh0 = (float*)(p.ws + WS_GH) + (size_t)sid * NSEG * 2 * 4096;
    LAS float* Sx = (LAS float*)lds;
    constexpr int CB0 = 20480;
    const int tid = wave * 64 + lane;
#define CMB_DMA(i_) do { const float* g_ = gh0 + (size_t)(i_) * 2 * 4096 + tid * 4; LAS unsigned char* b_ = lds + CB0 + ((i_) & 1) * 32768 + wave * 1024; \
        _Pragma("unroll") for (int j_ = 0; j_ < 4; ++j_) __builtin_amdgcn_global_load_lds((const unsigned*)(g_ + j_ * 2048), (LAS unsigned*)(b_ + j_ * 8192), 16, 0, 0); } while (0)
    CMB_DMA(1);
    for (int e = tid; e < 4096; e += NTHREADS) Sx[(e >> 6) * 65 + (e & 63)] = gh0[4096 + e];
    asm volatile("s_waitcnt vmcnt(0)" ::: "memory");
    __syncthreads();
    const int rb = (wave >> 1) & 1, cb = wave & 1, i32 = lane & 31, hf = lane >> 5;
    for (int i = 1; i < NSEG - 1; ++i) {
        float* gi = gh0 + (size_t)i * 2 * 4096;
        if (i + 1 < NSEG - 1) CMB_DMA(i + 1);
        f32x16 d;
        if (wave < 4) {
            const LAS float* gb = (const LAS float*)(lds + CB0 + (i & 1) * 32768);
            float bq[32];
#pragma unroll
            for (int q = 0; q < 32; ++q) bq[q] = gb[(2 * q + hf) * 64 + 32 * cb + i32];
#pragma unroll
            for (int r = 0; r < 16; ++r) d[r] = gb[4096 + (32 * rb + 8 * (r >> 2) + 4 * hf + (r & 3)) * 64 + 32 * cb + i32];
#pragma unroll
            for (int q = 0; q < 32; ++q) {
                const float aq = Sx[(32 * rb + i32) * 65 + 2 * q + hf];
                d = __builtin_amdgcn_mfma_f32_32x32x2f32(aq, bq[q], d, 0, 0, 0);
            }
#pragma unroll
            for (int r = 0; r < 16; ++r) gi[4096 + (32 * rb + 8 * (r >> 2) + 4 * hf + (r & 3)) * 64 + 32 * cb + i32] = d[r];
        }
        __syncthreads();
        if (wave < 4) {
#pragma unroll
            for (int r = 0; r < 16; ++r) Sx[(32 * rb + 8 * (r >> 2) + 4 * hf + (r & 3)) * 65 + 32 * cb + i32] = d[r];
            asm volatile("s_waitcnt vmcnt(16)" ::: "memory");
        } else asm volatile("s_waitcnt vmcnt(0)" ::: "memory");
        __syncthreads();
    }
#undef CMB_DMA
}

__device__ __forceinline__ void postmix_phase(const Params& p, int layer, float lam_init, int M, int gw, int NGW, int lane) {
    const bf16_t* P = (const bf16_t*)(p.ws + WS_P); const float* ST = (const float*)(p.ws + WS_ST);
    bf16_t* YB = (bf16_t*)(p.ws + WS_YB); bf16_t* YC = (bf16_t*)(p.ws + WS_YC);
    const float* lng = p.in[22] + layer * 512; const float* lnb = p.in[23] + layer * 512; const float* sg = p.in[25] + layer * 128;
    for (int m = gw; m < M; m += NGW) {
        {
            const int h = lane >> 3, kidx = (lane & 7) * 8, ch = lane * 8;
            const float* sp = ST + ((size_t)m * 8 + h) * (ST_SLOTS * 64) + kidx;
            float y[8], v[8], g[8], lg[8], lb[8];
            { float yb_[8]; ld8f(sp + SL_W0 * 64, y); ld8f(sp + SL_W1 * 64, yb_);
#pragma unroll
              for (int q = 0; q < 8; ++q) y[q] += yb_[q]; }
            ld8f(sp + SL_V * 64, v); ld8f(lng + ch, lg); ld8f(lnb + ch, lb);
            ld8bf(P + (size_t)m * PP + IC_RW + ch, g);
            float s = 0.f;
#pragma unroll
            for (int q = 0; q < 8; ++q) s += y[q];
            s += __shfl_xor(s, 1); s += __shfl_xor(s, 2); s += __shfl_xor(s, 4);
            float bn;
            { const f32x4 b0 = *(const f32x4*)(sp - kidx + SL_A0 * 64 + (lane & 7) * 4), b1 = *(const f32x4*)(sp - kidx + SL_A1 * 64 + (lane & 7) * 4);
              bn = ((b0.x + b0.y) + (b0.z + b0.w)) + ((b1.x + b1.y) + (b1.z + b1.w));
              bn += __shfl_xor(bn, 1); bn += __shfl_xor(bn, 2); bn += __shfl_xor(bn, 4); }
            const float mu = s * (1.0f / 64.0f);
            float var = 0.f;
#pragma unroll
            for (int q = 0; q < 8; ++q) { const float d = y[q] - mu; var += d * d; }
            var += __shfl_xor(var, 1); var += __shfl_xor(var, 2); var += __shfl_xor(var, 4);
            const float rstd = 1.0f / sqrtf(var * (1.0f / 64.0f) + 64e-5f);
            float o[8];
#pragma unroll
            for (int q = 0; q < 8; ++q) o[q] = (((y[q] - mu) * rstd) * lg[q] + lb[q] + bn * v[q]) * g[q];
            u32x4 w; w.x = pk2(o[0], o[1]); w.y = pk2(o[2], o[3]); w.z = pk2(o[4], o[5]); w.w = pk2(o[6], o[7]);
            *(u32x4*)(YB + (size_t)m * 512 + ch) = w;
        }
        *(u32x4*)((bf16_t*)(p.ws + WS_YA) + (size_t)m * 512 + lane * 8) = *(const u32x4*)(P + (size_t)m * PP + IC_QS + lane * 8);
        {
            const int e = (lane & 15) * 8;
            float x[8], gg[8];
            ld8bf(P + (size_t)m * PP + IC_QD + lane * 8, x); ld8f(sg + e, gg);
            float ss = 0.f;
#pragma unroll
            for (int q = 0; q < 8; ++q) ss += x[q] * x[q];
            ss += __shfl_xor(ss, 1); ss += __shfl_xor(ss, 2); ss += __shfl_xor(ss, 4); ss += __shfl_xor(ss, 8);
            const float rstd = (1.0f - lam_init) / sqrtf(ss * (1.0f / 128.0f) + 1e-5f);
            float o[8];
#pragma unroll
            for (int q = 0; q < 8; ++q) o[q] = x[q] * rstd * gg[q];
            u32x4 w; w.x = pk2(o[0], o[1]); w.y = pk2(o[2], o[3]); w.z = pk2(o[4], o[5]); w.w = pk2(o[6], o[7]);
            *(u32x4*)(YC + (size_t)m * 512 + lane * 8) = w;
        }
    }
}
#define XB_TMO      128
#define XB_XCNT(j)  (256  + 64 * (j))
#define XB_XSUB(j)  (1280 + 64 * (j))
#define XB_XGEN(j)  (2304 + 64 * (j))
#define XB_TOP      3328
#define XB_TOPGEN   3392
#define XCD_BAR_WORDS 3456
#define XB_SPIN_CAP (1u << 18)

__device__ __forceinline__ unsigned xb_ld(unsigned* p)              { return __hip_atomic_load(p, __ATOMIC_RELAXED, __HIP_MEMORY_SCOPE_AGENT); }
__device__ __forceinline__ unsigned xb_add(unsigned* p, unsigned v) { return __hip_atomic_fetch_add(p, v, __ATOMIC_RELAXED, __HIP_MEMORY_SCOPE_AGENT); }
__device__ __forceinline__ unsigned xb_xcc_id() { return (unsigned)__builtin_amdgcn_s_getreg((3 << 11) | 20) & 0xFu; }
#define XB_SPIN(cond, bar) do { unsigned _sp = 0; while (cond) { __builtin_amdgcn_s_sleep(1); \
    if ((++_sp & 255u) == 0u) { if (xb_ld(&(bar)[XB_TMO])) break; if (_sp > XB_SPIN_CAP) { atomicAdd(&(bar)[XB_TMO], 1u); break; } } } } while (0)

struct XcdBarrier {
    unsigned* bar; unsigned x;
    volatile LAS unsigned* st;
};

__device__ __forceinline__ XcdBarrier xcd_barrier_post(unsigned* bar, volatile LAS unsigned* st) {
    XcdBarrier b; b.bar = bar; b.x = xb_xcc_id(); b.st = st;
    if (threadIdx.x == 0) (void)xb_add(&bar[XB_XCNT(b.x)], 1u);
    return b;
}
__device__ __forceinline__ void xcd_barrier_complete(unsigned* bar, unsigned x, unsigned& nloc, unsigned& nx) {
    const unsigned G = gridDim.x * gridDim.y * gridDim.z;
    unsigned sum, cnt, mine, sp = 0u;
    for (;;) {
        sum = 0u; cnt = 0u; mine = 0u;
#pragma unroll
        for (unsigned j = 0; j < 16; ++j) { const unsigned c = xb_ld(&bar[XB_XCNT(j)]); sum += c; cnt += (c > 0u) ? 1u : 0u; mine = (j == x) ? c : mine; }
        if (sum == G) break;
        __builtin_amdgcn_s_sleep(1);
        if ((++sp & 255u) == 0u) { if (xb_ld(&bar[XB_TMO])) break; if (sp > XB_SPIN_CAP) { atomicAdd(&bar[XB_TMO], 1u); break; } }
    }
    nloc = mine > 0u ? mine : 1u; nx = cnt > 0u ? cnt : 1u;
}

__device__ __forceinline__ void xcd_barrier(const XcdBarrier& b) {
    asm volatile("s_waitcnt vmcnt(0)" ::: "memory");
    __syncthreads();
    if (threadIdx.x == 0) {
        unsigned* bar = b.bar;
        __builtin_amdgcn_s_waitcnt(0);
        unsigned nloc = b.st[0], nx = b.st[1];
        if (nloc == 0u) { xcd_barrier_complete(bar, b.x, nloc, nx); b.st[0] = nloc; b.st[1] = nx; }
        const unsigned old = xb_add(&bar[XB_XSUB(b.x)], 1u);
        const unsigned gen = old / nloc;
        if (old + 1u == (gen + 1u) * nloc) {
            __builtin_amdgcn_fence(__ATOMIC_RELEASE, "agent");
            asm volatile("s_waitcnt vmcnt(0)" ::: "memory");
            const unsigned og = xb_add(&bar[XB_TOP], 1u);
            const unsigned tg = og / nx;
            if (og + 1u == (tg + 1u) * nx) xb_add(&bar[XB_TOPGEN], 1u);
            else XB_SPIN(xb_ld(&bar[XB_TOPGEN]) == tg, bar);
            __builtin_amdgcn_fence(__ATOMIC_ACQUIRE, "agent");
            xb_add(&bar[XB_XGEN(b.x)], 1u);
            asm volatile("s_waitcnt vmcnt(0)" ::: "memory");
        } else {
            XB_SPIN(xb_ld(&bar[XB_XGEN(b.x)]) == gen, bar);
            __builtin_amdgcn_fence(__ATOMIC_ACQUIRE, "agent");
            asm volatile("s_waitcnt vmcnt(0)" ::: "memory");
        }
    }
    __syncthreads();
}

#ifndef MK_MULTI
#define MK_MULTI 0
#endif
constexpr int N_PHASES = 40;

#ifndef PROBE_MASK
#define PROBE_MASK 0ull
#endif
#ifndef PROBE_MASK2
#define PROBE_MASK2 0ull
#endif
#define PROBE_MULT 4ull
constexpr int LDS_PARAMS = LDS_BYTES - 1024;
constexpr int LDS_XB = LDS_BYTES - 64;
constexpr int CW_BAR = 8192;
__device__ __forceinline__ unsigned long long uni64(unsigned long long v) {
    const unsigned lo = __builtin_amdgcn_readfirstlane((unsigned)v), hi = __builtin_amdgcn_readfirstlane((unsigned)(v >> 32));
    return ((unsigned long long)hi << 32) | lo;
}
__device__ __forceinline__ int opq(int v) { asm volatile("" : "+s"(v)); return v; }
__device__ __forceinline__ void load_params(LAS unsigned char* lds, Params& q) {
    LAS const unsigned long long* s = (LAS const unsigned long long*)(lds + LDS_PARAMS);
#pragma unroll
    for (int i = 0; i < 37; ++i) q.in[i] = (const float*)(const __attribute__((address_space(1))) float*)uni64(s[i]);
    q.out = (float*)(__attribute__((address_space(1))) float*)uni64(s[37]); q.ws = (unsigned char*)(__attribute__((address_space(1))) unsigned char*)uni64(s[38]); q.ph_lo = 0; q.ph_hi = 0;
}
__global__ void __launch_bounds__(NTHREADS, 2) mk_fwd(Params kp) {
    extern __shared__ __attribute__((aligned(16))) unsigned char lds_raw[];
    LAS unsigned char* lds = (LAS unsigned char*)lds_raw;
    cg::grid_group grid = cg::this_grid();
    if (threadIdx.x == 0) {
        LAS unsigned long long* s = (LAS unsigned long long*)(lds + LDS_PARAMS);
#pragma unroll
        for (int i = 0; i < 37; ++i) s[i] = (unsigned long long)kp.in[i];
        s[37] = (unsigned long long)kp.out; s[38] = (unsigned long long)kp.ws;
    }
    if (threadIdx.x < 2) ((LAS unsigned*)(lds + LDS_XB))[threadIdx.x] = 0u;
    __syncthreads();
#if !MK_MULTI
    (void)xcd_barrier_post((unsigned*)(kp.ws + WS_CTL) + CW_BAR, (volatile LAS unsigned*)(lds + LDS_XB));
#endif
    const int ph_lo = kp.ph_lo, ph_hi = kp.ph_hi;
    int ph = 0;
    if ((PROBE_MASK | PROBE_MASK2) != 0ull && threadIdx.x == 0) { LAS unsigned long long* pt_ = (LAS unsigned long long*)(lds + LDS_PARAMS + 320); pt_[0] = __builtin_amdgcn_s_memrealtime(); pt_[1] = 0ull; }
#define PH_BEGIN if (ph >= ph_lo && ph < ph_hi) { asm volatile("" ::: "memory"); Params p; load_params(lds, p); unsigned char* ws = p.ws; (void)ws; \
    int tid_ = threadIdx.x, bid_ = blockIdx.x, G_ = gridDim.x; asm volatile("" : "+v"(tid_), "+s"(bid_), "+s"(G_)); \
    const int tid = tid_, bid = bid_, G = G_, lane = tid & 63, wave = __builtin_amdgcn_readfirstlane(tid >> 6); const int gw = bid * NWAVES + wave, NGW = G * NWAVES; (void)gw; (void)NGW; (void)lane; (void)tid; (void)G; (void)bid;
#define GRID_SEAM() do { if (ph == 0) grid.sync(); else { XcdBarrier xb_; xb_.bar = (unsigned*)((unsigned char*)(__attribute__((address_space(1))) unsigned char*)uni64(((LAS const unsigned long long*)(lds + LDS_PARAMS))[38]) + WS_CTL) + CW_BAR; \
        xb_.x = xb_xcc_id(); xb_.st = (volatile LAS unsigned*)(lds + LDS_XB); xcd_barrier(xb_); } } while (0)
#define PROBE_TICK() do { if ((PROBE_MASK | PROBE_MASK2) != 0ull && blockIdx.x == 0 && threadIdx.x == 0) { LAS unsigned long long* pt_ = (LAS unsigned long long*)(lds + LDS_PARAMS + 320); \
        const unsigned long long now_ = __builtin_amdgcn_s_memrealtime(); if ((PROBE_MASK >> ph) & 1ull) pt_[1] += now_ - pt_[0]; pt_[0] = now_; } } while (0)
#define PROBE_MID() do { if ((PROBE_MASK | PROBE_MASK2) != 0ull && blockIdx.x == 0 && threadIdx.x == 0) { LAS unsigned long long* pt_ = (LAS unsigned long long*)(lds + LDS_PARAMS + 320); \
        const unsigned long long now_ = __builtin_amdgcn_s_memrealtime(); if ((PROBE_MASK2 >> ph) & 1ull) pt_[1] += now_ - pt_[0]; pt_[0] = now_; } } while (0)
#define PH_END } if (ph >= ph_lo && ph + 1 < ph_hi) GRID_SEAM(); PROBE_TICK(); ++ph;

    using pg8::Gemm; using pg8::StaticOrder; using pg8::gemm_phase;

    PH_BEGIN
        convert_layer_weights(p, 0, lds, gw, NGW, wave, lane);
        __syncthreads();
        adaln_phase(p, lds, wave, lane);
    PH_END
    PH_BEGIN
        premix_phase(p, 0, true, NTOK, gw, NGW, lane);
    PH_END

#pragma clang loop unroll(full)
    for (int layer = 0; layer < 2; ++layer) {
        const int Ml = layer == 0 ? NTOK : NLAT;
        const float lam_init = 0.8f - 0.6f * expf(-0.3f * (float)layer);
        PH_BEGIN
            Gemm g{(const bf16_t*)(ws + WS_XN), (const bf16_t*)(ws + WS_WIN), NTOK, NIN1, opq(1024), 1024}; StaticOrder S; S.init(NTOK, NIN1, G, bid);
            EpiIn E{(bf16_t*)(ws + WS_P), (bf16_t*)(ws + WS_VTS), (bf16_t*)(ws + WS_VTD), (const float*)(ws + WS_ROPE)};
            gemm_phase<EpiIn, StaticOrder, true, true>(lds, g, S, E);
        PH_END
        PH_BEGIN
            rwkv_prepare_phase(p, layer, gw, NGW, lane);
        PH_END
        PH_BEGIN
            Gemm g{(const bf16_t*)(ws + WS_YA), (const bf16_t*)(ws + WS_LORA), NTOK, 2560, opq(128), 384}; LoraSched S; S.S.init(NTOK, 2560, G, bid);
            EpiLora E{(float*)(ws + WS_ST), (bf16_t*)(ws + WS_P), p.in[14] + layer * 1024, p.in[16] + layer * 1024};
            gemm_phase<EpiLora, LoraSched, true, true>(lds, g, S, E);
        PH_END
        PH_BEGIN
            for (int u = gw; u < 32 * (NSEG - 1); u += NGW) rwkv_segment<0>(p, layer, u / (NSEG - 1), u % (NSEG - 1), lane, lds + wave * SCAN_LDS);
        PH_END
        PH_BEGIN
            unsigned* qhead = (unsigned*)(ws + WS_CTL) + (layer == 0 ? CW_Q0 : CW_Q1);
            LAS int* ubox = (LAS int*)(lds + 65536);
            const int n_swa = 512 + (layer == 0 ? 16 : 0);
            if (bid < 32) rwkv_combine(p, bid, lds, wave, lane);
            if (bid >= 32 || G <= 32)
            for (;;) {
                if (tid == 0) ubox[0] = (int)atomicAdd(qhead, 1u);
                __syncthreads();
                const int u = ubox[0];
                __syncthreads();
                if (u >= n_swa) break;
                if (u < 512) swa_unit(lds, p, layer, u >> 8, (u >> 5) & 7, u & 31, false, wave, lane);
                else { const int v = u - 512; swa_unit(lds, p, layer, v >> 3, v & 7, 0, true, wave, lane); }
            }
        PH_END
        PH_BEGIN
            for (int u = gw; u < 32 * NSEG; u += NGW) rwkv_segment<2>(p, layer, u / NSEG, u % NSEG, lane, lds + wave * SCAN_LDS);
            asm volatile("s_waitcnt vmcnt(0)" ::: "memory");
            __syncthreads();
            PROBE_MID();
            float lam;
            { const float* lv = p.in[24] + layer * 256;
              const float s1 = wave_sum(lv[lane] * lv[64 + lane]), s2 = wave_sum(lv[128 + lane] * lv[192 + lane]);
              lam = expf(s1) - expf(s2) + lam_init; }
            for (int u = bid; u < 256; u += G) { const int v = G == 256 ? ((((u & 7) >> 2) << 7) | ((u & 3) << 5) | (u >> 3)) : u; diff_unit(lds, p, lam, v >> 7, (v >> 5) & 3, v & 31, false, v, wave, lane); }
            if (layer == 0) for (int u = bid; u < 8; u += G) diff_unit(lds, p, lam, u >> 2, u & 3, 0, true, 256 + u, wave, lane);
        PH_END
        PH_BEGIN
            postmix_phase(p, layer, lam_init, Ml, gw, NGW, lane);
            if (layer == 0) convert_ffn_weights(p, lds, gw, NGW, wave, lane);
            __syncthreads();
            Gemm g{(const bf16_t*)(ws + WS_XN), (const bf16_t*)(ws + WS_WIN) + (size_t)NIN1 * 1024, Ml, 3072, opq(1024), 1024}; StaticOrder S; S.init(Ml, 3072, G, bid);
            EpiGate E{(bf16_t*)(ws + WS_G)};
            gemm_phase<EpiGate, StaticOrder, true, true>(lds, g, S, E);
        PH_END
        PH_BEGIN
            MergeSched S; S.S.init(Ml, 1024, G, bid); S.nMtot = NTOK / 256;
            Gemm g{(const bf16_t*)(ws + WS_YA), (const bf16_t*)(ws + WS_PRJ), Ml, 1024, opq(512), 512};
            EpiMergeF E{(const bf16_t*)(ws + WS_G), (bf16_t*)(ws + WS_MF), (bf16_t*)(ws + WS_MB), NTOK / 256};
            gemm_phase<EpiMergeF, MergeSched, true, true>(lds, g, S, E);
        PH_END
        PH_BEGIN
            Gemm g{(const bf16_t*)(ws + WS_MB), (const bf16_t*)(ws + WS_WOUT), Ml, 1024, opq(1024), 1024};
            if (layer == 0) {
                TailSched S; S.init(NLAT, 1024, G, bid, (NTOK - NLAT) / 256, 2, 8);
                EpiBfTail E{(bf16_t*)(ws + WS_MOUT), 1024, (float*)(ws + WS_P), NLAT, NTOK - NLAT};
                gemm_phase<EpiBfTail, TailSched, true, true>(lds, g, S, E);
            } else {
                StaticOrder S; S.init(Ml, 1024, G, bid);
                EpiBf E{(bf16_t*)(ws + WS_MOUT), 1024};
                gemm_phase<EpiBf, StaticOrder, true, true>(lds, g, S, E);
            }
        PH_END
        PH_BEGIN
            residual_phase(p, (const bf16_t*)(ws + WS_MOUT), nullptr, nullptr, layer == 0, layer, 2, p.in[7] + layer * 1024, true, p.in[8] + layer * 1024, layer, 3, layer == 1, Ml, gw, NGW, lane, lds, layer == 0 ? (const float*)(ws + WS_P) : nullptr, 8);
            __syncthreads();
            if (layer == 0) convert_layer_weights(p, 1, lds, gw, NGW, wave, lane);
            else convert_moe_weights(p, lds, gw, NGW, wave, lane);
        PH_END
        if (layer == 0) {
            PH_BEGIN
                Gemm g{(const bf16_t*)(ws + WS_XN), (const bf16_t*)(ws + WS_FGU), NTOK, 2 * D_FF, opq(1024), 1024}; StaticOrder S; S.init(NTOK, 2 * D_FF, G, bid);
                EpiSwiglu E{(bf16_t*)(ws + WS_HID), D_FF, 1 << 20, 0};
                gemm_phase<EpiSwiglu, StaticOrder, true, true>(lds, g, S, E);
            PH_END
            PH_BEGIN
                Gemm g{(const bf16_t*)(ws + WS_HID), (const bf16_t*)(ws + WS_FD), NTOK, 1024, opq(D_FF), D_FF};
                TailSched S; S.init(NLAT, 1024, G, bid, (NTOK - NLAT) / 256, 4, D_FF / 256);
                EpiBfTail E{(bf16_t*)(ws + WS_MF), 1024, (float*)(ws + WS_P + 92 * MiB), NLAT, NTOK - NLAT};
                gemm_phase<EpiBfTail, TailSched, true, true>(lds, g, S, E);
            PH_END
            PH_BEGIN
                residual_phase(p, (const bf16_t*)(ws + WS_MF), nullptr, nullptr, false, 0, 5, p.in[9], true, p.in[6] + 1024, 1, 0, false, NTOK, gw, NGW, lane, nullptr, (const float*)(ws + WS_P + 92 * MiB), D_FF / 256);
            PH_END
        }
    }
    {
        {
            PH_BEGIN
                const unsigned* cnt = (const unsigned*)(ws + WS_CTL) + CW_CNT; int ts[9]; ts[0] = 0;
#pragma unroll
                for (int e = 0; e < 8; ++e) ts[e + 1] = ts[e] + (int)((__hip_atomic_load(cnt + e, __ATOMIC_RELAXED, __HIP_MEMORY_SCOPE_AGENT) + 255u) >> 8);
                const int* LIST = (const int*)(ws + WS_LIST); const bf16_t* XN = (const bf16_t*)(ws + WS_XN2); bf16_t* XG = (bf16_t*)(ws + WS_XG);
                for (int r = gw; r < ts[8] * 256; r += NGW) {
                    const int tile = r >> 8; int e = 0;
#pragma unroll
                    for (int q = 1; q < 8; ++q) e += (tile >= ts[q]) ? 1 : 0;
                    int tse = 0;
#pragma unroll
                    for (int q = 0; q < 8; ++q) tse = (q == e) ? ts[q] : tse;
                    const int slot = r - tse * 256;
                    u32x4 v0 = (u32x4){0u, 0u, 0u, 0u}, v1 = v0;
                    if (slot < (int)cnt[e]) { const int tk = LIST[e * 16384 + slot]; const u32x4* src = (const u32x4*)(XN + (size_t)(tk >> 1) * 1024); v0 = src[lane]; v1 = src[lane + 64]; }
                    u32x4* dst = (u32x4*)(XG + (size_t)r * 1024); dst[lane] = v0; dst[lane + 64] = v1;
                }
            PH_END
            PH_BEGIN
                const unsigned* cnt = (const unsigned*)(ws + WS_CTL) + CW_CNT; int ts[9]; ts[0] = 0;
#pragma unroll
                for (int e = 0; e < 8; ++e) ts[e + 1] = ts[e] + (int)((__hip_atomic_load(cnt + e, __ATOMIC_RELAXED, __HIP_MEMORY_SCOPE_AGENT) + 255u) >> 8);
                MoeSched S;
#pragma unroll
                for (int e = 0; e < 9; ++e) S.ts[e] = ts[e];
                S.pm_lo = 0; S.pm_hi = ts[8]; S.npn = 28; S.G = G; S.c = bid; S.a_local = false;
                Gemm g{(const bf16_t*)(ws + WS_XG), (const bf16_t*)(ws + WS_MGU), 0, 0, opq(1024), 1024};
                EpiSwiglu E{(bf16_t*)(ws + WS_HIDM), D_FFE, 28, 0};
                gemm_phase<EpiSwiglu, MoeSched, true, true>(lds, g, S, E);
            PH_END
            PH_BEGIN
                const unsigned* cnt = (const unsigned*)(ws + WS_CTL) + CW_CNT; int ts[9]; ts[0] = 0;
#pragma unroll
                for (int e = 0; e < 8; ++e) ts[e + 1] = ts[e] + (int)((__hip_atomic_load(cnt + e, __ATOMIC_RELAXED, __HIP_MEMORY_SCOPE_AGENT) + 255u) >> 8);
                MoeSched S;
#pragma unroll
                for (int e = 0; e < 9; ++e) S.ts[e] = ts[e];
                S.pm_lo = 0; S.pm_hi = ts[8]; S.npn = 4; S.G = G; S.c = bid; S.a_local = false;
                Gemm g{(const bf16_t*)(ws + WS_HIDM), (const bf16_t*)(ws + WS_MD), 0, 0, opq(D_FFE), D_FFE};
                EpiMoeDown E; E.FS = (bf16_t*)(ws + WS_FACC); E.slot1_off = ((long)WS_MGU - (long)WS_FACC) / 2; E.LIST = (const int*)(ws + WS_LIST); E.WTS = (const float*)(ws + WS_WTS); E.cnt = cnt; E.pm_lo = 0;
#pragma unroll
                for (int e = 0; e < 9; ++e) E.ts[e] = ts[e];
                gemm_phase<EpiMoeDown, MoeSched, true, true>(lds, g, S, E);
            PH_END
            PH_BEGIN
                residual_phase(p, (const bf16_t*)(ws + WS_FACC), (const bf16_t*)(ws + WS_MGU), nullptr, false, 1, 5, p.in[9] + 1024, false, nullptr, 0, 0, false, NLAT, gw, NGW, lane);
            PH_END
        }
    }
    if ((PROBE_MASK | PROBE_MASK2) != 0ull && blockIdx.x == 0 && threadIdx.x == 0) {
        LAS unsigned long long* pt_ = (LAS unsigned long long*)(lds + LDS_PARAMS + 320);
        const unsigned long long t0_ = pt_[0], want_ = PROBE_MULT * pt_[1];
        while (__builtin_amdgcn_s_memrealtime() - t0_ < want_) __builtin_amdgcn_s_sleep(32);
    }
#undef PH_BEGIN
#undef PH_END
}

extern "C" void kernel_launch(void* const* d_in, const int* in_sizes, int n_in, void* d_out, int out_size, void* d_ws, size_t ws_size, hipStream_t stream) {
    static int grid = 0;
    if (grid == 0) {
        if (n_in != 37 || out_size != NLAT * DM || ws_size < WS_NEED) { fprintf(stderr, "kernel_launch: unexpected shapes (n_in %d out %d ws %zu need %zu)\n", n_in, out_size, ws_size, (size_t)WS_NEED); grid = -1; return; }
        int dev = 0, cus = 0, per_cu = 0;
        (void)hipGetDevice(&dev);
        (void)hipDeviceGetAttribute(&cus, hipDeviceAttributeMultiprocessorCount, dev);
        (void)hipFuncSetAttribute((const void*)mk_fwd, hipFuncAttributeMaxDynamicSharedMemorySize, LDS_BYTES);
        (void)hipOccupancyMaxActiveBlocksPerMultiprocessor(&per_cu, (const void*)mk_fwd, NTHREADS, LDS_BYTES);
        if (per_cu < 1) { fprintf(stderr, "kernel_launch: occupancy query reports %d blocks per CU\n", per_cu); grid = -1; return; }
        grid = cus;
        fprintf(stderr, "kernel_launch: grid %d (cus %d, per_cu %d), ws %zu\n", grid, cus, per_cu, ws_size);
    }
    if (grid < 0) return;
    (void)hipMemsetAsync((char*)d_ws + WS_CTL, 0, CTL_BYTES, stream);
    Params prm{};
    for (int i = 0; i < 37; ++i) prm.in[i] = (const float*)d_in[i];
    prm.out = (float*)d_out; prm.ws = (unsigned char*)d_ws;
#if MK_MULTI
    for (int ph = 0; ph < N_PHASES; ++ph) { prm.ph_lo = ph; prm.ph_hi = ph + 1; hipLaunchKernelGGL(mk_fwd, dim3(grid), dim3(NTHREADS), LDS_BYTES, stream, prm); }
#else
    prm.ph_lo = 0; prm.ph_hi = 1 << 20;
    void* args[] = {&prm};
    hipError_t e = hipLaunchCooperativeKernel((const void*)mk_fwd, dim3(grid), dim3(NTHREADS), args, LDS_BYTES, stream);
    if (e != hipSuccess) fprintf(stderr, "kernel_launch: cooperative launch failed: %s (grid %d)\n", hipGetErrorString(e), grid);
#endif
}
```

```cpp
#include <hip/hip_runtime.h>
#include <hip/hip_cooperative_groups.h>
#include <cstdio>
#include <cstdint>
namespace cg = cooperative_groups;
namespace pg8 {
#define PG8_LAS __attribute__((address_space(3)))
typedef unsigned short bf16_t;
typedef short bf16x8 __attribute__((ext_vector_type(8)));
typedef float f32x4 __attribute__((ext_vector_type(4)));
typedef unsigned u32x4 __attribute__((ext_vector_type(4)));
constexpr int BM = 256, BK = 64, HALF = 128, HTB = HALF * BK * 2  , STAGE_BYTES = 8 * HTB, NXCD = 8, WGM = 8;

__host__ __device__ __forceinline__ int lds_byte(int r, int c) { const int st = (r >> 4) * 2 + (c >> 5), rr = r & 15, cc = c & 31, ob = rr * 64 + cc * 2; return st * 1024 + (ob ^ (((ob >> 9) & 1) << 5)); }
__host__ __device__ __forceinline__ void stage_rc(int b, int& R, int& C) { const int st = b / 1024, sb = b % 1024, swz = sb ^ (((sb >> 9) & 1) << 5); R = (st >> 1) * 16 + swz / 64; C = (st & 1) * 32 + (swz % 64) / 2; }
__host__ __device__ __forceinline__ int perm32(int rho) { const int n = rho >> 4, i = rho & 15; return 8 * (i >> 2) + 4 * n + (i & 3); }

struct Unit { int pm, pn, koff, tail, kt; };
struct Gemm { const bf16_t* A; const bf16_t* Bt; int M, N, K, ld; };

struct StaticOrder {
    int nM, nN, nwg, G, c;
    __host__ __device__ void init(int M, int N, int G_, int c_) { nM = M / BM; nN = N / BM; nwg = nM * nN; G = G_; c = c_; }
    __host__ __device__ bool next(int i, Unit& u) const {
        const long L = (long)i * G + c; if (L >= nwg) return false;
        int wgid = (int)L; { const int q = nwg / NXCD, r = nwg % NXCD, xcd = wgid % NXCD, off = wgid / NXCD; wgid = (xcd < r ? xcd * (q + 1) : r * (q + 1) + (xcd - r) * q) + off; }
        const int nig = WGM * nN, gid = wgid / nig, fm = gid * WGM, gsz = (nM - fm) < WGM ? (nM - fm) : WGM;
        u.pm = fm + ((wgid % nig) % gsz); u.pn = (wgid % nig) / gsz; u.koff = 0; u.tail = -1; u.kt = 0; return true;
    }
    __device__ __forceinline__ void a_ready(const Unit&) const {}
    __device__ __forceinline__ void done(const Unit&) const {}
};

__device__ __forceinline__ unsigned cvt_pk_bf16(float lo, float hi) { unsigned r; asm volatile("v_cvt_pk_bf16_f32 %0, %1, %2" : "=v"(r) : "v"(lo), "v"(hi)); return r; }
typedef float f32x2 __attribute__((ext_vector_type(2)));
template <class Epi, class Sched, bool ALIGN_EPI = false, bool SP2 = false>
__device__ __forceinline__ void gemm_phase(PG8_LAS unsigned char* lds, const Gemm g, const Sched& S, const Epi& E) {
    int tid_ = threadIdx.x; asm volatile("" : "+v"(tid_)); const int tid = tid_, wid = __builtin_amdgcn_readfirstlane(tid >> 6), lane = tid & 63, wr = wid >> 2, wc = wid & 3, fr = lane & 15, fq = lane >> 4;
    const int K = g.ld, nt = g.K / BK;
    unsigned voffA[2], voffB[2];
#pragma unroll
    for (int i = 0; i < 2; ++i) { int R, C; stage_rc(tid * 16 + i * 8192, R, C); const int Rb = Epi::PERM ? ((R & ~31) + perm32(R & 31)) : R;
        voffA[i] = (unsigned)(R * K + C) * 2u; voffB[i] = (unsigned)(Rb * K + C) * 2u; }
    const size_t kstep = (size_t)(BK * 2);
    const size_t hstep = (size_t)HALF * K * 2;
    const size_t tstep = 2 * hstep;
    const unsigned ldsw = (unsigned)wid * 1024u;
    const int aoff = lds_byte(wr * 64 + fr, fq * 8), boff = lds_byte(wc * 32 + fr, fq * 8);
#define PG8_SA(b, h) (((b) * 2 + (h)) * HTB)
#define PG8_SB(b, h) ((4 + (b) * 2 + (h)) * HTB)
#define PG8_STAGE(bufoff, gbase, voff) do { _Pragma("unroll") for (int _i = 0; _i < 2; ++_i) \
        __builtin_amdgcn_global_load_lds((const unsigned*)((const char*)(gbase) + (voff)[_i]), (PG8_LAS unsigned*)(lds + (bufoff) + ldsw + _i * 8192), 16, 0, 0); } while (0)
#define PG8_LDA(dst, b, h) do { _Pragma("unroll") for (int m = 0; m < 4; ++m) _Pragma("unroll") for (int k = 0; k < 2; ++k) dst[m][k] = *(const PG8_LAS bf16x8*)(lds + PG8_SA(b, h) + aoff + m * 2048 + k * 1024); } while (0)
#define PG8_LDB(dst, b, h) do { _Pragma("unroll") for (int n = 0; n < 2; ++n) _Pragma("unroll") for (int k = 0; k < 2; ++k) dst[n][k] = *(const PG8_LAS bf16x8*)(lds + PG8_SB(b, h) + boff + n * 2048 + k * 1024); } while (0)
#define PG8_MMA(ai, bj, At, Bt) do { __builtin_amdgcn_s_setprio(1); _Pragma("unroll") for (int m = 0; m < 4; ++m) _Pragma("unroll") for (int n = 0; n < 2; ++n) _Pragma("unroll") for (int k = 0; k < 2; ++k) \
        acc[ai][bj][m][n] = __builtin_amdgcn_mfma_f32_16x16x32_bf16(Bt[n][k], At[m][k], acc[ai][bj][m][n], 0, 0, 0); __builtin_amdgcn_s_setprio(0); } while (0)
#define PG8_WAIT_V(n) asm volatile("s_waitcnt vmcnt(" #n ")" ::: "memory")
#define PG8_WAIT_L(n) asm volatile("s_waitcnt lgkmcnt(" #n ")" ::: "memory")
#define PG8_BAR __builtin_amdgcn_s_barrier()
#define PG8_SCHED __builtin_amdgcn_sched_barrier(0)
    Unit cur, nxt; int ui = 0;
    if (!S.next(0, cur)) return;
    f32x4 acc[2][2][4][2];
#pragma unroll
    for (int a = 0; a < 2; ++a)
#pragma unroll
        for (int b = 0; b < 2; ++b)
#pragma unroll
            for (int m = 0; m < 4; ++m)
#pragma unroll
                for (int n = 0; n < 2; ++n) acc[a][b][m][n] = (f32x4){0.f, 0.f, 0.f, 0.f};
    bf16x8 At[4][2], B0[2][2], B1[2][2];
    const char* cA = (const char*)g.A + (size_t)cur.pm * tstep + (size_t)cur.koff * 2; const char* cB = (const char*)g.Bt + (size_t)cur.pn * tstep + (size_t)cur.koff * 2;
    S.a_ready(cur);
    if constexpr (SP2) {
        PG8_STAGE(PG8_SB(0, 0), cB, voffB); PG8_STAGE(PG8_SB(0, 1), cB + hstep, voffB); PG8_STAGE(PG8_SA(0, 0), cA, voffA); PG8_STAGE(PG8_SA(0, 1), cA + hstep, voffA);
        if (wr == 1) PG8_BAR;
        PG8_WAIT_V(2); PG8_BAR;
        PG8_STAGE(PG8_SB(1, 0), cB + kstep, voffB); PG8_STAGE(PG8_SA(1, 0), cA + kstep, voffA); PG8_STAGE(PG8_SB(1, 1), cB + hstep + kstep, voffB);
        PG8_WAIT_V(6); PG8_BAR;
    } else {
        PG8_STAGE(PG8_SB(0, 0), cB, voffB); PG8_STAGE(PG8_SA(0, 0), cA, voffA); PG8_STAGE(PG8_SB(0, 1), cB + hstep, voffB); PG8_STAGE(PG8_SA(0, 1), cA + hstep, voffA);
        if (wr == 1) PG8_BAR;
        PG8_WAIT_V(4); PG8_BAR;
        PG8_STAGE(PG8_SB(1, 0), cB + kstep, voffB); PG8_STAGE(PG8_SA(1, 0), cA + kstep, voffA); PG8_STAGE(PG8_SB(1, 1), cB + hstep + kstep, voffB);
        PG8_WAIT_V(6); PG8_BAR;
    }
    for (;;) {
        const bool has_next = S.next(ui + 1, nxt);
        const char* nA = has_next ? (const char*)g.A + (size_t)nxt.pm * tstep + (size_t)nxt.koff * 2 : cA; const char* nB = has_next ? (const char*)g.Bt + (size_t)nxt.pn * tstep + (size_t)nxt.koff * 2 : cB;
        const int ntc = cur.kt ? cur.kt : nt;
        for (int t = 0; t < ntc; t += 2) {
            const bool last = (t == ntc - 2);
            const char* a1 = cA + (size_t)(t + 1) * kstep;
            const char* a2 = last ? nA : cA + (size_t)(t + 2) * kstep; const char* b2 = last ? nB : cB + (size_t)(t + 2) * kstep;
            const char* a3 = a2 + kstep; const char* b3 = b2 + kstep;
            if (last && has_next) S.a_ready(nxt);
            if constexpr (SP2) {
            PG8_LDB(B0, 0, 0); PG8_LDB(B1, 0, 1); PG8_SCHED; PG8_LDA(At, 0, 0); PG8_STAGE(PG8_SA(1, 1), a1 + hstep, voffA);
            PG8_WAIT_V(8); PG8_WAIT_L(0); PG8_BAR; PG8_MMA(0, 0, At, B0); PG8_MMA(0, 1, At, B1); PG8_BAR; PG8_SCHED;
            PG8_LDA(At, 0, 1); PG8_STAGE(PG8_SB(0, 0), b2, voffB); PG8_STAGE(PG8_SB(0, 1), b2 + hstep, voffB); PG8_STAGE(PG8_SA(0, 0), a2, voffA);
            PG8_WAIT_V(8); PG8_WAIT_L(0); PG8_BAR; PG8_MMA(1, 0, At, B0); PG8_MMA(1, 1, At, B1); PG8_BAR; PG8_SCHED;
            PG8_LDB(B0, 1, 0); PG8_LDB(B1, 1, 1); PG8_SCHED; PG8_LDA(At, 1, 0); PG8_STAGE(PG8_SA(0, 1), a2 + hstep, voffA);
            PG8_WAIT_V(8); PG8_WAIT_L(0); PG8_BAR; PG8_MMA(0, 0, At, B0); PG8_MMA(0, 1, At, B1); PG8_BAR; PG8_SCHED;
            PG8_LDA(At, 1, 1); PG8_STAGE(PG8_SB(1, 0), b3, voffB); PG8_STAGE(PG8_SB(1, 1), b3 + hstep, voffB); PG8_STAGE(PG8_SA(1, 0), a3, voffA);
            PG8_WAIT_V(8); PG8_WAIT_L(0); PG8_BAR; PG8_MMA(1, 0, At, B0); PG8_MMA(1, 1, At, B1); PG8_BAR; PG8_SCHED;
            } else {
            PG8_LDB(B0, 0, 0); PG8_SCHED; PG8_LDA(At, 0, 0); PG8_STAGE(PG8_SA(1, 1), a1 + hstep, voffA);
            PG8_WAIT_L(8); PG8_BAR; PG8_WAIT_L(0); PG8_MMA(0, 0, At, B0); PG8_BAR; PG8_SCHED;
            PG8_LDB(B1, 0, 1); PG8_STAGE(PG8_SB(0, 0), b2, voffB);
            PG8_BAR; PG8_WAIT_L(0); PG8_MMA(0, 1, At, B1); PG8_BAR;
            PG8_LDA(At, 0, 1); PG8_STAGE(PG8_SA(0, 0), a2, voffA);
            PG8_BAR; PG8_WAIT_L(0); PG8_MMA(1, 0, At, B0); PG8_BAR; PG8_SCHED;
            PG8_STAGE(PG8_SB(0, 1), b2 + hstep, voffB);
            PG8_WAIT_V(6); PG8_BAR; PG8_MMA(1, 1, At, B1); PG8_BAR;
            PG8_LDB(B0, 1, 0); PG8_SCHED; PG8_LDA(At, 1, 0); PG8_STAGE(PG8_SA(0, 1), a2 + hstep, voffA);
            PG8_WAIT_L(8); PG8_BAR; PG8_WAIT_L(0); PG8_MMA(0, 0, At, B0); PG8_BAR; PG8_SCHED;
            PG8_LDB(B1, 1, 1); PG8_STAGE(PG8_SB(1, 0), b3, voffB);
            PG8_BAR; PG8_WAIT_L(0); PG8_MMA(0, 1, At, B1); PG8_BAR;
            PG8_LDA(At, 1, 1); PG8_STAGE(PG8_SA(1, 0), a3, voffA);
            PG8_BAR; PG8_WAIT_L(0); PG8_MMA(1, 0, At, B0); PG8_BAR; PG8_SCHED;
            PG8_STAGE(PG8_SB(1, 1), b3 + hstep, voffB);
            PG8_WAIT_V(6); PG8_BAR; PG8_MMA(1, 1, At, B1); PG8_BAR;
            }
        }
        if constexpr (ALIGN_EPI) { if (wr == 0) PG8_BAR; }
        if constexpr (!Epi::AFTER_DRAIN) { E(acc, cur, wr, wc, fr, fq); S.done(cur); }
        if (!has_next) break;
#pragma unroll
        for (int a = 0; a < 2; ++a)
#pragma unroll
            for (int b = 0; b < 2; ++b)
#pragma unroll
                for (int m = 0; m < 4; ++m)
#pragma unroll
                    for (int n = 0; n < 2; ++n) acc[a][b][m][n] = (f32x4){0.f, 0.f, 0.f, 0.f};
        cur = nxt; cA = nA; cB = nB; ++ui;
        if constexpr (ALIGN_EPI) { if (wr == 1) PG8_BAR; }
    }
    PG8_WAIT_V(0);
    if constexpr (!ALIGN_EPI) { if (wr == 0) PG8_BAR; }
    PG8_BAR;
    if constexpr (Epi::AFTER_DRAIN) { E.fused(acc, cur, wr, wc, fr, fq, lds, wid, lane); S.done(cur); }
#undef PG8_SA
#undef PG8_SB
#undef PG8_STAGE
#undef PG8_LDA
#undef PG8_LDB
#undef PG8_MMA
#undef PG8_WAIT_V
#undef PG8_WAIT_L
#undef PG8_BAR
#undef PG8_SCHED
}
}

#define LAS __attribute__((address_space(3)))
typedef unsigned short bf16_t;
typedef short bf16x8 __attribute__((ext_vector_type(8)));
typedef float f32x4 __attribute__((ext_vector_type(4)));
typedef float f32x16 __attribute__((ext_vector_type(16)));
typedef unsigned u32x4 __attribute__((ext_vector_type(4)));
typedef unsigned u32x2 __attribute__((ext_vector_type(2)));

constexpr int NTHREADS = 512, NWAVES = 8;
constexpr int DM = 1024, SEQ = 8192, CTXL = 256, NLAT = 2 * SEQ, NCTX = 2 * CTXL, NTOK = NLAT + NCTX, KEYS = SEQ + CTXL;
constexpr int D_IN = 7296, D_FF = 2816, D_FFE = 3584, NEXP = 8;
constexpr int IC_QS = 0, IC_KS = 512, IC_RW = 640, IC_QD = 2560, IC_KD = 3072, PP = 3584, IC_VS = 3584, IC_VD = 3712, IC_PAD = 4224, NIN1 = 4352, WIN_ROWS = 7424;
constexpr int ST_SLOTS = 8;
constexpr int SL_W0 = 0, SL_A0 = 1, SL_KK = 2, SL_R = 3, SL_V = 4, SL_K = 5, SL_W1 = 6, SL_A1 = 7;
constexpr int MOE_TILES = 136, MOE_HALF = 68;

constexpr size_t MiB = 1u << 20;
constexpr size_t WS_CTL = 0, CTL_BYTES = 1 * MiB;
constexpr size_t WS_MODS = 1 * MiB;
constexpr size_t WS_ROPE = 1 * MiB + 256 * 1024;
constexpr size_t WS_HCTX = 2 * MiB;
constexpr size_t WS_LIST = 4 * MiB;
constexpr size_t WS_WTS = 4 * MiB + 512 * 1024;
constexpr size_t WS_WIN = 6 * MiB;
constexpr size_t WS_PRJ = WS_WIN + (size_t)WIN_ROWS * 1024 * 2;
constexpr size_t WS_WOUT = WS_PRJ + 3 * MiB;
constexpr size_t WS_LORA = WS_WOUT + 2 * MiB;
constexpr size_t WS_XN = 28 * MiB;
constexpr size_t WS_P = 61 * MiB;
constexpr size_t WS_VTS = 177 * MiB;
constexpr size_t WS_VTD = WS_VTS + 4608 * 1024;
constexpr size_t WS_ST = 198 * MiB;
constexpr size_t WS_YA = 495 * MiB;
constexpr size_t WS_YB = WS_YA + 16896ull * 512 * 2;
constexpr size_t WS_YC = WS_YB + 16896ull * 512 * 2;
constexpr size_t WS_END = WS_YC + 16896ull * 512 * 2;
constexpr size_t WS_G = WS_ST;
constexpr size_t WS_MF = WS_ST + 99 * MiB;
constexpr size_t WS_MB = WS_ST + 165 * MiB;
constexpr size_t WS_MOUT = WS_ST + 198 * MiB;
constexpr size_t WS_FGU = WS_VTS;
constexpr size_t WS_FD = WS_VTS + 11 * MiB;
constexpr size_t WS_HID = WS_P;
constexpr size_t WS_XN2 = 495 * MiB;
constexpr size_t WS_MGU = 6 * MiB;
constexpr size_t WS_MD = 118 * MiB;
constexpr size_t WS_XG = 174 * MiB;
constexpr size_t WS_FACC = 242 * MiB;
constexpr size_t WS_HIDM = 306 * MiB;
static_assert(WS_LORA + 2560 * 384 * 2 <= WS_XN && WS_XN + 16896ull * 1024 * 2 <= WS_P && WS_P + 16896ull * PP * 2 <= WS_VTS && WS_VTD + 2ull * 4 * 128 * KEYS * 2 <= WS_ST, "ws map 1");
static_assert(WS_ST + 16896ull * 8 * ST_SLOTS * 64 * 4 <= WS_YA && WS_END <= 545 * MiB, "ws map 2");
static_assert(WS_G + 16896ull * 3072 * 2 <= WS_MF && WS_MF + 16896ull * 1024 * 4 <= WS_MB && WS_MB + 16896ull * 1024 * 2 <= WS_MOUT && WS_MOUT + 16896ull * 1024 * 4 <= WS_YA, "ws map 3");
static_assert(WS_FGU + 5632ull * 1024 * 2 <= WS_FD && WS_FD + 1024ull * 2816 * 2 <= WS_ST && WS_HID + 16896ull * 2816 * 2 <= WS_VTS, "ws map 4");
static_assert(WS_MGU + 8ull * 7168 * 1024 * 2 <= WS_MD && WS_MD + 8ull * 1024 * 3584 * 2 <= WS_XG && WS_XG + 34816ull * 1024 * 2 <= WS_FACC && WS_FACC + 16384ull * 1024 * 4 <= WS_HIDM && WS_HIDM + 136ull * 256 * 3584 * 2 <= 560 * MiB, "ws map 5");
static_assert(WS_FACC + 16384ull * 1024 * 4 <= WS_MOUT && WS_XN2 + 16384ull * 1024 * 2 <= 560 * MiB && WS_XN2 >= WS_MOUT + 16896ull * 1024 * 4, "expert weights / gathered rows / accumulator must not touch MOUT or XN2 while they are live");
constexpr size_t WS_NEED = 560 * MiB;
constexpr int CW_CNT = 0;
constexpr int CW_Q0 = 64, CW_Q1 = 128;

constexpr int LDS_BYTES = 147456;

__device__ __forceinline__ unsigned f2bf(float f) { unsigned u = __builtin_bit_cast(unsigned, f); return (u + 0x7fffu + ((u >> 16) & 1u)) >> 16; }
typedef float f32x2_t __attribute__((ext_vector_type(2))); typedef __bf16 bf16x2_t __attribute__((ext_vector_type(2)));
__device__ __forceinline__ unsigned pk2(float lo, float hi) { const f32x2_t v = {lo, hi}; return __builtin_bit_cast(unsigned, __builtin_convertvector(v, bf16x2_t)); }
__device__ __forceinline__ float bflo(unsigned w) { return __uint_as_float(w << 16); }
__device__ __forceinline__ float bfhi(unsigned w) { return __uint_as_float(w & 0xffff0000u); }
__device__ __forceinline__ float wave_sum(float v) {
#pragma unroll
    for (int o = 1; o < 64; o <<= 1) v += __shfl_xor(v, o);
    return v;
}
__device__ __forceinline__ float sigmoidf_(float x) { return 1.0f / (1.0f + __expf(-x)); }
__device__ __forceinline__ float siluf_(float x) { return x / (1.0f + __expf(-x)); }
#define LDS_WAIT() asm volatile("s_waitcnt lgkmcnt(0)" ::: "memory")

struct Params {
    const float* in[37];
    float* out;
    unsigned char* ws;
    int ph_lo, ph_hi;
};

template <class F>
__device__ __forceinline__ void transpose_item(const float* __restrict__ W, int ldw, int k0, int n0, bf16_t* __restrict__ WT, int ldt, int dcol0, F rowmap, LAS float* scr, int lane) {
    f32x4 ld[8];
    { const float* src = W + (size_t)(k0 + (lane >> 3)) * ldw + n0 + 4 * (lane & 7);
#pragma unroll
      for (int j = 0; j < 8; ++j) ld[j] = *(const f32x4*)(src + (size_t)(8 * j) * ldw); }
#pragma unroll
    for (int j = 0; j < 8; ++j) { LAS float* d = scr + (8 * j + (lane >> 3)) * 33 + 4 * (lane & 7); d[0] = ld[j].x; d[1] = ld[j].y; d[2] = ld[j].z; d[3] = ld[j].w; }
    LDS_WAIT(); asm volatile("" ::: "memory");
    const int c = lane & 7;
#pragma unroll
    for (int j = 0; j < 4; ++j) {
        const int n = (lane >> 3) + 8 * j; const LAS float* s = scr + (8 * c) * 33 + n;
        u32x4 o; o.x = pk2(s[0 * 33], s[1 * 33]); o.y = pk2(s[2 * 33], s[3 * 33]); o.z = pk2(s[4 * 33], s[5 * 33]); o.w = pk2(s[6 * 33], s[7 * 33]);
        const int row = rowmap(n0 + n);
        if (row >= 0) *(u32x4*)(WT + (size_t)row * ldt + dcol0 + k0 + 8 * c) = o;
    }
    LDS_WAIT(); asm volatile("" ::: "memory");
}
struct RowId { __device__ __forceinline__ int operator()(int n) const { return n; } };
struct RowOff { int off; __device__ __forceinline__ int operator()(int n) const { return n + off; } };
struct RowWin {
    __device__ __forceinline__ int operator()(int n) const {
        if (n < 640) return n;
        if (n < 768) return n - 640 + IC_VS;
        if (n < 2688) return n - 768 + IC_RW;
        if (n < 3712) return n - 2688 + IC_QD;
        if (n < 4224) return n - 3712 + IC_VD;
        return n - 4224 + NIN1;
    }
};
struct RowGU { int up; __device__ __forceinline__ int operator()(int j) const { return (j >> 7) * 256 + (j & 127) + 128 * up; } };

template <class F>
__device__ __forceinline__ void convert_matrix(const float* W, int K, int N, bf16_t* WT, int ldt, int dcol0, F rowmap, LAS float* scr, int lane, int gw, int NGW) {
    const int nblk = N / 32, items = (K / 64) * nblk;
    for (int it = gw; it < items; it += NGW) { const int kb = it / nblk, nb = it % nblk; transpose_item(W, N, kb * 64, nb * 32, WT, ldt, dcol0, rowmap, scr, lane); }
}

__device__ __forceinline__ void lora_region(bf16_t* __restrict__ LT, const float* __restrict__ src, int row0, int klo, int kn, int gw, int NGW, int lane) {
    for (int i = gw * 64 + lane; i < 512 * 48; i += NGW * 64) {
        const int nn = i / 48, kc = (i % 48) * 8;
        u32x4 o = (u32x4){0u, 0u, 0u, 0u};
        if (kc >= klo && kc < klo + kn) {
            const float* s = src + (size_t)(kc - klo) * 512 + nn;
            o.x = pk2(s[0], s[512]); o.y = pk2(s[2 * 512], s[3 * 512]); o.z = pk2(s[4 * 512], s[5 * 512]); o.w = pk2(s[6 * 512], s[7 * 512]);
        }
        *(u32x4*)(LT + (size_t)(row0 + nn) * 384 + kc) = o;
    }
}
__device__ __forceinline__ void convert_layer_weights(const Params& p, int layer, LAS unsigned char* lds, int gw, int NGW, int wave, int lane) {
    LAS float* scr = (LAS float*)(lds + wave * 16384);
    unsigned char* ws = p.ws;
    bf16_t* WIN = (bf16_t*)(ws + WS_WIN);
    convert_matrix(p.in[10] + (size_t)layer * 1024 * D_IN, 1024, D_IN, WIN, 1024, 0, RowWin(), scr, lane, gw, NGW);
    for (int i = gw * 64 + lane; i < (NIN1 - IC_PAD) * 1024 / 8; i += NGW * 64) *(u32x4*)(WIN + (size_t)IC_PAD * 1024 + (size_t)i * 8) = (u32x4){0u, 0u, 0u, 0u};
    for (int j = 0; j < 3; ++j)
        convert_matrix(p.in[26 + j] + (size_t)layer * 512 * 1024, 512, 1024, (bf16_t*)(ws + WS_PRJ) + (size_t)j * 1024 * 512, 512, 0, RowId(), scr, lane, gw, NGW);
    convert_matrix(p.in[29] + (size_t)layer * 1024 * 1024, 1024, 1024, (bf16_t*)(ws + WS_WOUT), 1024, 0, RowId(), scr, lane, gw, NGW);
    bf16_t* LT = (bf16_t*)(ws + WS_LORA);
    lora_region(LT, p.in[15] + ((size_t)layer * 2 + 0) * 64 * 512, 0, 0, 64, gw, NGW, lane);
    lora_region(LT, p.in[15] + ((size_t)layer * 2 + 1) * 64 * 512, 512, 64, 64, gw, NGW, lane);
    lora_region(LT, p.in[17] + ((size_t)layer * 2 + 0) * 64 * 512, 1024, 128, 64, gw, NGW, lane);
    lora_region(LT, p.in[17] + ((size_t)layer * 2 + 1) * 64 * 512, 1536, 192, 64, gw, NGW, lane);
    lora_region(LT, p.in[18] + (size_t)layer * 128 * 512, 2048, 256, 128, gw, NGW, lane);
}
__device__ __forceinline__ void convert_ffn_weights(const Params& p, LAS unsigned char* lds, int gw, int NGW, int wave, int lane) {
    LAS float* scr = (LAS float*)(lds + wave * 16384);
    bf16_t* GU = (bf16_t*)(p.ws + WS_FGU); bf16_t* FD = (bf16_t*)(p.ws + WS_FD);
    convert_matrix(p.in[30], 1024, D_FF, GU, 1024, 0, RowGU{0}, scr, lane, gw, NGW);
    convert_matrix(p.in[31], 1024, D_FF, GU, 1024, 0, RowGU{1}, scr, lane, gw, NGW);
    convert_matrix(p.in[32], D_FF, 1024, FD, D_FF, 0, RowId(), scr, lane, gw, NGW);
}
__device__ __forceinline__ void convert_moe_weights(const Params& p, LAS unsigned char* lds, int gw, int NGW, int wave, int lane) {
    LAS float* scr = (LAS float*)(lds + wave * 16384);
    for (int e = 0; e < NEXP; ++e) {
        bf16_t* GU = (bf16_t*)(p.ws + WS_MGU) + (size_t)e * 7168 * 1024;
        convert_matrix(p.in[34] + (size_t)e * 1024 * D_FFE, 1024, D_FFE, GU, 1024, 0, RowGU{0}, scr, lane, gw, NGW);
        convert_matrix(p.in[35] + (size_t)e * 1024 * D_FFE, 1024, D_FFE, GU, 1024, 0, RowGU{1}, scr, lane, gw, NGW);
        convert_matrix(p.in[36] + (size_t)e * D_FFE * 1024, D_FFE, 1024, (bf16_t*)(p.ws + WS_MD) + (size_t)e * 1024 * D_FFE, D_FFE, 0, RowId(), scr, lane, gw, NGW);
    }
}

__device__ __forceinline__ void adaln_phase(const Params& p, LAS unsigned char* lds, int wave, int lane) {
    LAS float* red = (LAS float*)lds;
    float* MODS = (float*)(p.ws + WS_MODS);
    const float* c = p.in[1]; const float* cc = p.in[3];
    for (int it = blockIdx.x; it < 2 * 96; it += gridDim.x) {
        const int layer = it / 96, n = (it % 96) * 64 + lane;
        const float* W = p.in[4] + (size_t)layer * 1024 * 6144;
        float a0 = 0.f, a1 = 0.f, a2 = 0.f;
        for (int k = wave * 128; k < wave * 128 + 128; ++k) {
            const float w = W[(size_t)k * 6144 + n];
            a0 += siluf_(c[k]) * w; a1 += siluf_(c[1024 + k]) * w; a2 += siluf_(cc[k]) * w;
        }
        red[(wave * 3 + 0) * 64 + lane] = a0; red[(wave * 3 + 1) * 64 + lane] = a1; red[(wave * 3 + 2) * 64 + lane] = a2;
        __syncthreads();
        if (wave < 3) {
            float s = 0.f;
#pragma unroll
            for (int w = 0; w < 8; ++w) s += red[(w * 3 + wave) * 64 + lane];
            MODS[((size_t)layer * 3 + wave) * 6144 + n] = s + p.in[5][(size_t)layer * 6144 + n];
        }
        __syncthreads();
    }
    if (blockIdx.x == gridDim.x - 1) {
        float* rope = (float*)(p.ws + WS_ROPE);
        for (int i = threadIdx.x; i < 128 * 16; i += NTHREADS) {
            const int pos = i >> 4, j = i & 15;
            const float inv = powf(10000.0f, -(float)j / 16.0f);
            const float ang = (float)pos * inv;
            rope[2 * i] = cosf(ang); rope[2 * i + 1] = sinf(ang);
        }
    }
}

__device__ __forceinline__ const float* mods_row(const Params& p, int layer, int m) {
    const int r = m < NLAT ? (m >> 13) : 2;
    return (const float*)(p.ws + WS_MODS) + ((size_t)layer * 3 + r) * 6144;
}
__device__ __forceinline__ void load_row(const float* x, int lane, f32x4 (&v)[4]) {
#pragma unroll
    for (int j = 0; j < 4; ++j) v[j] = ((const f32x4*)x)[lane + 64 * j];
}
__device__ __forceinline__ float row_rstd(const f32x4 (&v)[4]) {
    float s = 0.f;
#pragma unroll
    for (int j = 0; j < 4; ++j) s += (v[j].x * v[j].x + v[j].y * v[j].y) + (v[j].z * v[j].z + v[j].w * v[j].w);
    return 1.0f / sqrtf(wave_sum(s) * (1.0f / 1024.0f) + 1e-6f);
}
__device__ __forceinline__ void normmod(const f32x4 (&h)[4], const float* g, const float* shift, const float* scale, int lane, f32x4 (&a)[4]) {
    const float rstd = row_rstd(h);
#pragma unroll
    for (int j = 0; j < 4; ++j) {
        const f32x4 gg = ((const f32x4*)g)[lane + 64 * j], sh = ((const f32x4*)shift)[lane + 64 * j], sc = ((const f32x4*)scale)[lane + 64 * j];
        a[j] = (h[j] * rstd * gg) * (sc + 1.0f) + sh;
    }
}
__device__ __forceinline__ void store_row_bf16(bf16_t* o, int lane, const f32x4 (&a)[4]) {
#pragma unroll
    for (int j = 0; j < 4; ++j) { u32x2 w; w.x = pk2(a[j].x, a[j].y); w.y = pk2(a[j].z, a[j].w); ((u32x2*)o)[lane + 64 * j] = w; }
}
__device__ __forceinline__ const float* h_in_row(const Params& p, int layer, int m) {
    if (layer == 0) return m < NLAT ? p.in[0] + (size_t)m * 1024 : p.in[2] + (size_t)(m - NLAT) * 1024;
    return m < NLAT ? p.out + (size_t)m * 1024 : (const float*)(p.ws + WS_HCTX) + (size_t)(m - NLAT) * 1024;
}
__device__ __forceinline__ float* h_out_row(const Params& p, int m) { return m < NLAT ? p.out + (size_t)m * 1024 : (float*)(p.ws + WS_HCTX) + (size_t)(m - NLAT) * 1024; }

__device__ __forceinline__ void premix_phase(const Params& p, int layer, bool first, int M, int gw, int NGW, int lane) {
    bf16_t* XN = (bf16_t*)(p.ws + WS_XN);
    for (int m = gw; m < M; m += NGW) {
        const float* hr = first ? h_in_row(p, 0, m) : h_out_row(p, m);
        f32x4 h[4], a[4]; load_row(hr, lane, h);
        const float* md = mods_row(p, layer, m);
        normmod(h, p.in[6] + layer * 1024, md, md + 1024, lane, a);
        store_row_bf16(XN + (size_t)m * 1024, lane, a);
    }
}
__device__ __forceinline__ void load_row_bf16(const bf16_t* x, int lane, f32x4 (&v)[4]) {
#pragma unroll
    for (int j = 0; j < 4; ++j) { const u32x2 w = ((const u32x2*)x)[lane + 64 * j]; v[j] = (f32x4){bflo(w.x), bfhi(w.x), bflo(w.y), bfhi(w.y)}; }
}
__device__ __forceinline__ void residual_phase(const Params& p, const bf16_t* src, const bf16_t* src2, const float* hin_base_layer0, bool hin_is_input, int layer, int gate_idx, const float* g1,
                                               bool write_xn, const float* g2, int mod_layer2, int shift_idx, bool route, int M, int gw, int NGW, int lane, LAS unsigned char* lds = nullptr,
                                               const float* part = nullptr, int nsl = 0) {
    bf16_t* XN = (bf16_t*)(p.ws + (route ? WS_XN2 : WS_XN));
    LAS int* rt = (LAS int*)lds;
    int rt_n = 0;
    const int wv = gw & (NWAVES - 1);
    for (int m = gw; m < M; m += NGW) {
        const float* hr = hin_is_input ? h_in_row(p, 0, m) : h_out_row(p, m);
        f32x4 h[4], s[4]; load_row(hr, lane, h);
        if (part && m >= NLAT) {
#pragma unroll
            for (int j = 0; j < 4; ++j) s[j] = (f32x4){0.f, 0.f, 0.f, 0.f};
            for (int sl = 0; sl < nsl; ++sl) { f32x4 t[4]; load_row(part + (size_t)(sl * 512 + (m - NLAT)) * 1024, lane, t);
#pragma unroll
                for (int j = 0; j < 4; ++j) s[j] += t[j]; }
        } else load_row_bf16(src + (size_t)m * 1024, lane, s);
        if (src2) { f32x4 s2[4]; load_row_bf16(src2 + (size_t)m * 1024, lane, s2);
#pragma unroll
            for (int j = 0; j < 4; ++j) s[j] += s2[j]; }
        const float rstd = row_rstd(s);
        const float* md = mods_row(p, layer, m);
#pragma unroll
        for (int j = 0; j < 4; ++j) {
            const f32x4 gg = ((const f32x4*)g1)[lane + 64 * j], gt = ((const f32x4*)(md + gate_idx * 1024))[lane + 64 * j];
            h[j] = h[j] + gt * (s[j] * rstd * gg);
        }
        float* ho = h_out_row(p, m);
#pragma unroll
        for (int j = 0; j < 4; ++j) ((f32x4*)ho)[lane + 64 * j] = h[j];
        if (write_xn) {
            f32x4 a[4]; const float* md2 = mods_row(p, mod_layer2, m);
            normmod(h, g2, md2 + shift_idx * 1024, md2 + (shift_idx + 1) * 1024, lane, a);
            store_row_bf16(XN + (size_t)m * 1024, lane, a);
            if (route) {
                const float* rw = p.in[33];
                float lg[8] = {0.f, 0.f, 0.f, 0.f, 0.f, 0.f, 0.f, 0.f};
#pragma unroll
                for (int j = 0; j < 4; ++j)
#pragma unroll
                    for (int q = 0; q < 4; ++q) {
                        const int k = 4 * (lane + 64 * j) + q; const float av = a[j][q];
                        const f32x4 w0 = ((const f32x4*)(rw + (size_t)k * 8))[0], w1 = ((const f32x4*)(rw + (size_t)k * 8))[1];
                        lg[0] += av * w0.x; lg[1] += av * w0.y; lg[2] += av * w0.z; lg[3] += av * w0.w; lg[4] += av * w1.x; lg[5] += av * w1.y; lg[6] += av * w1.z; lg[7] += av * w1.w;
                    }
#pragma unroll
                for (int e = 0; e < 8; ++e) lg[e] = wave_sum(lg[e]);
                int i1 = 0; float v1 = lg[0];
#pragma unroll
                for (int e = 1; e < 8; ++e) if (lg[e] > v1) { v1 = lg[e]; i1 = e; }
                int i2 = -1; float v2 = -3.0e38f;
#pragma unroll
                for (int e = 0; e < 8; ++e) if (e != i1 && lg[e] > v2) { v2 = lg[e]; i2 = e; }
                if (lane == 0) {
                    const float w1 = 1.0f / (1.0f + expf(v2 - v1));
                    const int q = rt_n * NWAVES + wv;
                    rt[q] = m; rt[64 + q] = i1; rt[128 + q] = i2; rt[192 + q] = (int)__float_as_uint(w1);
                }
                ++rt_n;
                if (rt_n == 64 / NWAVES || m + NGW >= M) {
                    __syncthreads();
                    if (wv == 0) {
                        const int n = rt_n * NWAVES; const bool act = lane < n;
                        const int rm = act ? rt[lane] : 0, e1 = act ? rt[64 + lane] : -1, e2 = act ? rt[128 + lane] : -1; const float w1 = __uint_as_float((unsigned)rt[192 + (act ? lane : 0)]);
                        unsigned* cnt = (unsigned*)(p.ws + WS_CTL) + CW_CNT; int* LIST = (int*)(p.ws + WS_LIST); float* WTS = (float*)(p.ws + WS_WTS);
                        const unsigned long long lt = (1ull << lane) - 1ull;
                        unsigned mycount = 0u; int r1 = 0, r2 = 0, c1sel = 0;
#pragma unroll
                        for (int e = 0; e < 8; ++e) {
                            const unsigned long long b1 = __ballot(e1 == e), b2 = __ballot(e2 == e);
                            const int c1 = __popcll(b1), c2 = __popcll(b2);
                            if (lane == e) mycount = (unsigned)(c1 + c2);
                            if (e1 == e) r1 = __popcll(b1 & lt);
                            if (e2 == e) { r2 = __popcll(b2 & lt); c1sel = c1; }
                        }
                        unsigned base = 0u;
                        if (lane < 8 && mycount) base = atomicAdd(cnt + lane, mycount);
                        const unsigned bs1 = (unsigned)__shfl((int)base, e1 < 0 ? 0 : e1), bs2 = (unsigned)__shfl((int)base, e2 < 0 ? 0 : e2);
                        if (act) {
                            const unsigned s1 = bs1 + (unsigned)r1, s2 = bs2 + (unsigned)(c1sel + r2);
                            LIST[e1 * 16384 + s1] = rm * 2; WTS[e1 * 16384 + s1] = w1;
                            LIST[e2 * 16384 + s2] = rm * 2 + 1; WTS[e2 * 16384 + s2] = 1.0f - w1;
                        }
                    }
                    __syncthreads();
                    rt_n = 0;
                }
            }
        }
    }
}

using pg8::Unit;
constexpr float QSCALE = 0.125f * 1.4426950408889634f;
__device__ __forceinline__ u32x2 pack4(const f32x4 v) { u32x2 w; w.x = pk2(v.x, v.y); w.y = pk2(v.z, v.w); return w; }
__device__ __forceinline__ f32x4 unpack4(const u32x2 w) { return (f32x4){bflo(w.x), bfhi(w.x), bflo(w.y), bfhi(w.y)}; }

struct EpiIn {
    static constexpr bool PERM = false, AFTER_DRAIN = false;
    bf16_t* P; bf16_t* VTS; bf16_t* VTD; const float* rope;
    __device__ __forceinline__ void operator()(const f32x4 (&acc)[2][2][4][2], const Unit& u, int wr, int wc, int fr, int fq) const {
#pragma unroll
        for (int ai = 0; ai < 2; ++ai)
#pragma unroll
            for (int m = 0; m < 4; ++m) {
                const int r = u.pm * 256 + ai * 128 + wr * 64 + m * 16 + fr;
                const bool lat = r < NLAT;
                const int t = r & (SEQ - 1);
                const int b = lat ? (r >> 13) : ((r - NLAT) >> 8);
                const int key = lat ? t : SEQ + ((r - NLAT) & 255);
#pragma unroll
                for (int bj = 0; bj < 2; ++bj) {
                    const int c32 = u.pn * 256 + bj * 128 + wc * 32;
                    f32x4 v0 = acc[ai][bj][m][0], v1 = acc[ai][bj][m][1];
                    if (c32 < PP) {
                        const bool rp = (c32 < IC_RW) || (c32 >= IC_QD);
                        if (rp && lat) {
                            const int pos = (c32 & 32) ? (t & 63) : (t >> 6);
                            const f32x4 cs0 = *(const f32x4*)(rope + (pos * 16 + 4 * fq) * 2), cs1 = *(const f32x4*)(rope + (pos * 16 + 4 * fq) * 2 + 4);
                            const f32x4 cc = (f32x4){cs0.x, cs0.z, cs1.x, cs1.z}, sn = (f32x4){cs0.y, cs0.w, cs1.y, cs1.w};
                            const f32x4 o0 = v0 * cc - v1 * sn, o1 = v0 * sn + v1 * cc;
                            v0 = o0; v1 = o1;
                        }
                        if (c32 < IC_KS || (c32 >= IC_QD && c32 < IC_KD)) { v0 = v0 * QSCALE; v1 = v1 * QSCALE; }
                        bf16_t* dst = P + (size_t)r * PP + c32 + 4 * fq;
                        *(u32x2*)dst = pack4(v0); *(u32x2*)(dst + 16) = pack4(v1);
                    } else {
                        const int cv = c32 - PP;
                        bf16_t* vt = nullptr; int dimbase = 0;
                        if (cv < 128) { vt = VTS + (size_t)((b * 2 + (cv >> 6)) * 64) * KEYS; dimbase = cv & 63; }
                        else if (cv < 640) { const int cd = cv - 128; vt = VTD + (size_t)((b * 4 + (cd >> 7)) * 128) * KEYS; dimbase = cd & 127; }
                        if (vt) {
                            const int kp = (key & ~12) | ((key & 4) << 1) | ((key & 8) >> 1);
#pragma unroll
                            for (int i = 0; i < 4; ++i) {
                                vt[(size_t)(dimbase + 4 * fq + i) * KEYS + kp] = (bf16_t)f2bf(v0[i]);
                                vt[(size_t)(dimbase + 16 + 4 * fq + i) * KEYS + kp] = (bf16_t)f2bf(v1[i]);
                            }
                        }
                    }
                }
            }
    }
};

struct EpiLora {
    static constexpr bool PERM = false, AFTER_DRAIN = false;
    float* ST; bf16_t* P; const float* w0; const float* a0;
    __device__ __forceinline__ void operator()(const f32x4 (&acc)[2][2][4][2], const Unit& u, int wr, int wc, int fr, int fq) const {
        const int reg = u.pn >> 1;
#pragma unroll
        for (int ai = 0; ai < 2; ++ai)
#pragma unroll
            for (int m = 0; m < 4; ++m) {
                const int r = u.pm * 256 + ai * 128 + wr * 64 + m * 16 + fr;
#pragma unroll
                for (int bj = 0; bj < 2; ++bj)
#pragma unroll
                    for (int n = 0; n < 2; ++n) {
                        const int ch = (u.pn & 1) * 256 + bj * 128 + wc * 32 + 16 * n + 4 * fq;
                        const int h = ch >> 6, kidx = ch & 63;
                        float* sp = ST + ((size_t)r * 8 + h) * (ST_SLOTS * 64) + kidx;
                        const f32x4 a = acc[ai][bj][m][n];
                        if (reg < 2) {
                            const f32x4 bias = *(const f32x4*)(w0 + reg * 512 + ch);
                            f32x4 o;
#pragma unroll
                            for (int i = 0; i < 4; ++i) {
                                const float x = -(bias[i] + a[i]);
                                const float sp_ = fmaxf(x, 0.f) + __logf(1.0f + __expf(-fabsf(x)));
                                o[i] = __expf(-__expf(-sp_ - 0.5f));
                            }
                            *(f32x4*)(sp + (reg ? SL_W1 : SL_W0) * 64) = o;
                        } else if (reg < 4) {
                            const int d = reg - 2;
                            const f32x4 bias = *(const f32x4*)(a0 + d * 512 + ch);
                            *(f32x4*)(sp + (d ? SL_A1 : SL_A0) * 64) = (f32x4){sigmoidf_(bias[0] + a[0]), sigmoidf_(bias[1] + a[1]), sigmoidf_(bias[2] + a[2]), sigmoidf_(bias[3] + a[3])};
                        } else {
                            *(u32x2*)(P + (size_t)r * PP + IC_RW + ch) = pack4(a);
                        }
                        asm volatile("" ::: "memory");
                    }
            }
    }
};

struct LoraSched {
    pg8::StaticOrder S;
    __device__ __forceinline__ bool next(int i, Unit& u) const { if (!S.next(i, u)) return false; const int reg = u.pn >> 1; u.koff = 128 * (reg < 4 ? (reg >> 1) : 2); return true; }
    __device__ __forceinline__ void a_ready(const Unit&) const {}
    __device__ __forceinline__ void done(const Unit&) const {}
};
struct EpiGate {
    static constexpr bool PERM = true, AFTER_DRAIN = false;
    bf16_t* G;
    __device__ __forceinline__ void operator()(const f32x4 (&acc)[2][2][4][2], const Unit& u, int wr, int wc, int fr, int fq) const {
#pragma unroll
        for (int ai = 0; ai < 2; ++ai)
#pragma unroll
            for (int m = 0; m < 4; ++m) {
                const int r = u.pm * 256 + ai * 128 + wr * 64 + m * 16 + fr;
#pragma unroll
                for (int bj = 0; bj < 2; ++bj) {
                    const int c = u.pn * 256 + bj * 128 + wc * 32 + 8 * fq;
                    const f32x4 a0 = acc[ai][bj][m][0], a1 = acc[ai][bj][m][1];
                    u32x4 w; w.x = pk2(sigmoidf_(a0.x), sigmoidf_(a0.y)); w.y = pk2(sigmoidf_(a0.z), sigmoidf_(a0.w)); w.z = pk2(sigmoidf_(a1.x), sigmoidf_(a1.y)); w.w = pk2(sigmoidf_(a1.z), sigmoidf_(a1.w));
                    *(u32x4*)(G + (size_t)r * 3072 + c) = w;
                }
            }
    }
};

struct MergeSched {
    pg8::StaticOrder S; int nMtot;
    __device__ __forceinline__ bool next(int i, Unit& u) const { const int pass = i % 3; if (!S.next(i / 3, u)) return false; u.pm += pass * nMtot; u.pn += pass * 4; u.tail = pass; return true; }
    __device__ __forceinline__ void a_ready(const Unit&) const {}
    __device__ __forceinline__ void done(const Unit&) const {}
};
struct EpiMergeF {
    static constexpr bool PERM = true, AFTER_DRAIN = false;
    const bf16_t* G; bf16_t* MF; bf16_t* MB; int nMtot;
    __device__ __forceinline__ void operator()(const f32x4 (&acc)[2][2][4][2], const Unit& u, int wr, int wc, int fr, int fq) const {
        const int pass = u.tail, pm = u.pm - pass * nMtot, pn = u.pn - 4 * pass;
        bf16_t* dstb = pass < 2 ? MF : MB;
#pragma unroll
        for (int ai = 0; ai < 2; ++ai)
#pragma unroll
            for (int m = 0; m < 4; ++m) {
                const int r = pm * 256 + ai * 128 + wr * 64 + m * 16 + fr;
#pragma unroll
                for (int bj = 0; bj < 2; ++bj) {
                    const int c = pn * 256 + bj * 128 + wc * 32 + 8 * fq;
                    const u32x4 gw = *(const u32x4*)(G + (size_t)r * 3072 + pass * 1024 + c);
                    f32x4 v0 = unpack4((u32x2){gw.x, gw.y}) * acc[ai][bj][m][0], v1 = unpack4((u32x2){gw.z, gw.w}) * acc[ai][bj][m][1];
                    if (pass > 0) { const u32x4 mw = *(const u32x4*)(MF + (size_t)r * 1024 + c); v0 += unpack4((u32x2){mw.x, mw.y}); v1 += unpack4((u32x2){mw.z, mw.w}); }
                    const u32x2 p0 = pack4(v0), p1 = pack4(v1);
                    *(u32x4*)(dstb + (size_t)r * 1024 + c) = (u32x4){p0.x, p0.y, p1.x, p1.y};
                }
            }
    }
};
template <int PASS> struct EpiMerge {
    static constexpr bool PERM = false, AFTER_DRAIN = false;
    const bf16_t* G; bf16_t* MF; bf16_t* MB;
    __device__ __forceinline__ void operator()(const f32x4 (&acc)[2][2][4][2], const Unit& u, int wr, int wc, int fr, int fq) const {
#pragma unroll
        for (int ai = 0; ai < 2; ++ai)
#pragma unroll
            for (int m = 0; m < 4; ++m) {
                const int r = u.pm * 256 + ai * 128 + wr * 64 + m * 16 + fr;
#pragma unroll
                for (int bj = 0; bj < 2; ++bj)
#pragma unroll
                    for (int n = 0; n < 2; ++n) {
                        const int c = u.pn * 256 + bj * 128 + wc * 32 + 16 * n + 4 * fq;
                        const f32x4 g = unpack4(*(const u32x2*)(G + (size_t)r * 3072 + PASS * 1024 + c));
                        f32x4 v = g * acc[ai][bj][m][n];
                        bf16_t* mp = MF + (size_t)r * 1024 + c;
                        if (PASS > 0) v += unpack4(*(const u32x2*)mp);
                        *(u32x2*)(PASS < 2 ? mp : MB + (size_t)r * 1024 + c) = pack4(v);
                    }
            }
    }
};

struct EpiBf {
    static constexpr bool PERM = true, AFTER_DRAIN = false;
    bf16_t* O; int ldc;
    __device__ __forceinline__ void operator()(const f32x4 (&acc)[2][2][4][2], const Unit& u, int wr, int wc, int fr, int fq) const {
#pragma unroll
        for (int ai = 0; ai < 2; ++ai)
#pragma unroll
            for (int m = 0; m < 4; ++m) {
                const int r = u.pm * 256 + ai * 128 + wr * 64 + m * 16 + fr;
#pragma unroll
                for (int bj = 0; bj < 2; ++bj) {
                    const int c = u.pn * 256 + bj * 128 + wc * 32 + 8 * fq;
                    const f32x4 a0 = acc[ai][bj][m][0], a1 = acc[ai][bj][m][1];
                    u32x4 w; w.x = pk2(a0.x, a0.y); w.y = pk2(a0.z, a0.w); w.z = pk2(a1.x, a1.y); w.w = pk2(a1.z, a1.w);
                    *(u32x4*)(O + (size_t)r * ldc + c) = w;
                }
            }
    }
};

struct TailSched {
    pg8::StaticOrder S; int nwg_main, nM_main, nN, nsl, kt, nitems, G, c;
    __device__ void init(int M_main, int N, int G_, int c_, int ntail, int kt_, int nsl_) { S.init(M_main, N, G_, c_); nwg_main = S.nwg; nM_main = M_main / pg8::BM; nN = N / pg8::BM; nsl = nsl_; kt = kt_; nitems = ntail * nN * nsl; G = G_; c = c_; }
    __device__ __forceinline__ bool next(int i, Unit& u) const {
        const long L = (long)i * G + c;
        if (L < nwg_main) return S.next(i, u);
        const int j = (int)(L - nwg_main); if (j >= nitems) return false;
        const int sl = j % nsl, tu = j / nsl;
        u.pm = nM_main + tu / nN; u.pn = tu % nN; u.koff = sl * kt * pg8::BK; u.tail = sl; u.kt = kt; return true;
    }
    __device__ __forceinline__ void a_ready(const Unit&) const {}
    __device__ __forceinline__ void done(const Unit&) const {}
};
struct EpiBfTail {
    static constexpr bool PERM = true, AFTER_DRAIN = false;
    bf16_t* O; int ldc; float* part; int row0, rows;
    __device__ __forceinline__ void operator()(const f32x4 (&acc)[2][2][4][2], const Unit& u, int wr, int wc, int fr, int fq) const {
        if (u.tail < 0) { EpiBf E{O, ldc}; E(acc, u, wr, wc, fr, fq); return; }
        float* base = part + (size_t)(u.tail * rows + (u.pm * 256 - row0) + wr * 64 + fr) * ldc + u.pn * 256 + wc * 32 + 8 * fq;
#pragma unroll
        for (int ai = 0; ai < 2; ++ai)
#pragma unroll
            for (int m = 0; m < 4; ++m)
#pragma unroll
                for (int bj = 0; bj < 2; ++bj) {
                    float* d = base + (size_t)(ai * 128 + m * 16) * ldc + bj * 128;
                    *(f32x4*)d = acc[ai][bj][m][0]; *(f32x4*)(d + 4) = acc[ai][bj][m][1];
                }
    }
};

struct EpiSwiglu {
    static constexpr bool PERM = true, AFTER_DRAIN = false;
    bf16_t* H; int ldh; int npn; int pm_sub;
    __device__ __forceinline__ void operator()(const f32x4 (&acc)[2][2][4][2], const Unit& u, int wr, int wc, int fr, int fq) const {
        const int pnn = u.pn % npn;
#pragma unroll
        for (int ai = 0; ai < 2; ++ai)
#pragma unroll
            for (int m = 0; m < 4; ++m) {
                const int r = (u.pm - pm_sub) * 256 + ai * 128 + wr * 64 + m * 16 + fr;
                const int hc = pnn * 128 + wc * 32 + 8 * fq;
                const f32x4 g0 = acc[ai][0][m][0], g1 = acc[ai][0][m][1], u0 = acc[ai][1][m][0], u1 = acc[ai][1][m][1];
                u32x4 w; w.x = pk2(siluf_(g0.x) * u0.x, siluf_(g0.y) * u0.y); w.y = pk2(siluf_(g0.z) * u0.z, siluf_(g0.w) * u0.w);
                w.z = pk2(siluf_(g1.x) * u1.x, siluf_(g1.y) * u1.y); w.w = pk2(siluf_(g1.z) * u1.z, siluf_(g1.w) * u1.w);
                *(u32x4*)(H + (size_t)r * ldh + hc) = w;
            }
    }
};

struct MoeSched {
    int ts[9]; int pm_lo, pm_hi, npn, G, c; bool a_local;
    __device__ __forceinline__ int expert_of(int pm) const { int e = 0;
#pragma unroll
        for (int q = 1; q < 8; ++q) e += (pm >= ts[q]) ? 1 : 0;
        return e; }
    __device__ __forceinline__ bool next(int i, Unit& u) const {
        const int n = (pm_hi - pm_lo) * npn; const long L = (long)i * G + c; if (L >= n) return false;
        const int pm = pm_lo + (int)L / npn, pnn = (int)L % npn;
        u.pm = a_local ? pm - pm_lo : pm; u.pn = expert_of(pm) * npn + pnn; u.koff = 0; u.tail = -1; u.kt = 0; return true;
    }
    __device__ __forceinline__ void a_ready(const Unit&) const {}
    __device__ __forceinline__ void done(const Unit&) const {}
};
struct EpiMoeDown {
    static constexpr bool PERM = false, AFTER_DRAIN = false;
    bf16_t* FS; long slot1_off; const int* LIST; const float* WTS; const unsigned* cnt; int ts[9]; int pm_lo;
    __device__ __forceinline__ void operator()(const f32x4 (&acc)[2][2][4][2], const Unit& u, int wr, int wc, int fr, int fq) const {
        const int e = u.pn >> 2, pnn = u.pn & 3, pmg = u.pm + pm_lo;
        int tse = 0;
#pragma unroll
        for (int q = 0; q < 8; ++q) tse = (q == e) ? ts[q] : tse;
        const int ne = (int)cnt[e];
#pragma unroll
        for (int ai = 0; ai < 2; ++ai)
#pragma unroll
            for (int m = 0; m < 4; ++m) {
                const int slot = (pmg - tse) * 256 + ai * 128 + wr * 64 + m * 16 + fr;
                if (slot < ne) {
                    const int tk = LIST[e * 16384 + slot]; const float w = WTS[e * 16384 + slot];
                    bf16_t* dst = FS + (long)(tk & 1) * slot1_off + (size_t)(tk >> 1) * 1024 + pnn * 256 + wc * 32 + 4 * fq;
#pragma unroll
                    for (int bj = 0; bj < 2; ++bj)
#pragma unroll
                        for (int n = 0; n < 2; ++n) *(u32x2*)(dst + bj * 128 + 16 * n) = pack4(acc[ai][bj][m][n] * w);
                }
            }
    }
};

constexpr float SC2 = 0.125f * 1.4426950408889634f;
constexpr float ATT_THR = 6.0f;
__device__ __forceinline__ float xhalf_max(float v) { auto rr = __builtin_amdgcn_permlane32_swap(__float_as_uint(v), __float_as_uint(v), false, false); return fmaxf(__uint_as_float(rr[0]), __uint_as_float(rr[1])); }
__device__ __forceinline__ float xhalf_sum(float v) { auto rr = __builtin_amdgcn_permlane32_swap(__float_as_uint(v), __float_as_uint(v), false, false); return __uint_as_float(rr[0]) + __uint_as_float(rr[1]); }

template <int DV, bool WINDOW, int ROT = 0>
__device__ __forceinline__ void attn_pass(LAS unsigned char* lds, const bf16_t* __restrict__ P, int qrow0, int qcol, int kcol, const bf16_t* __restrict__ VT,
                                          int lat_row0, int ctx_row0, int tile_lo, int tile_hi, bool has_ref, float m0, float l0, int qpos0,
                                          f32x16 (&o)[DV / 32], float& l_out, int wave, int lane) {
    constexpr int STG = 8192 + DV * 128, ND = 1 + DV / 64;
    int tid_ = threadIdx.x; asm volatile("" : "+v"(tid_)); const int tid = tid_; lane = tid & 63; const int qn = lane & 31, half = lane >> 5;
    bf16x8 qf[4];
    { const bf16_t* qp = P + (size_t)(qrow0 + wave * 32 + qn) * PP + qcol + half * 8;
#pragma unroll
      for (int ks = 0; ks < 4; ++ks) qf[ks] = *(const bf16x8*)(qp + ks * 16); }
    float mrun = has_ref ? m0 : 0.f, lrun = (half == 0) ? l0 : 0.f;
    bool need_ref = !has_ref;
    f32x16 negm;
#pragma unroll
    for (int i = 0; i < 16; ++i) negm[i] = -mrun;
#pragma unroll
    for (int db = 0; db < DV / 32; ++db)
#pragma unroll
        for (int i = 0; i < 16; ++i) o[db][i] = 0.f;
    const int nlat = tile_hi - tile_lo, nt = nlat + 4;
    const int drow = wave * 8 + (lane >> 3), dchk = ((lane & 7) ^ (4 * (wave & 1) + (lane >> 4))) * 8;
    const bf16_t* ksrc = P + (size_t)drow * PP + kcol + dchk;
    const bf16_t* vsrc = VT + (size_t)drow * KEYS + dchk;
#define ATT_DMA(ti_, sg_, vg_) do { const int id_ = (ti_) < nlat ? tile_lo + (ti_) : 128 + ((ti_) - nlat); \
        const int krow0_ = id_ < 128 ? lat_row0 + 64 * id_ : ctx_row0 + 64 * (id_ - 128); \
        LAS unsigned char* kst_ = (ROT ? lds + (sg_) * 8192 : lds + (sg_) * STG) + wave * 1024; LAS unsigned char* vst_ = (ROT ? lds + 24576 + (vg_) * (DV * 128) : lds + (sg_) * STG + 8192) + wave * 1024; \
        __builtin_amdgcn_global_load_lds((const unsigned*)(ksrc + (size_t)krow0_ * PP), (LAS unsigned*)kst_, 16, 0, 0); \
        _Pragma("unroll") for (int j_ = 0; j_ < DV / 64; ++j_) \
            __builtin_amdgcn_global_load_lds((const unsigned*)(vsrc + (size_t)(64 * j_) * KEYS + 64 * id_), (LAS unsigned*)(vst_ + j_ * 8192), 16, 0, 0); } while (0)
    __syncthreads();
    ATT_DMA(0, 0, 0);
    if (nt > 1) { ATT_DMA(1, 1, 1); asm volatile("s_waitcnt vmcnt(%0)" :: "n"(ND) : "memory"); } else asm volatile("s_waitcnt vmcnt(0)" ::: "memory");
    __syncthreads();
    int sg = 0, vg = 0;
    u32x4 pw[4];
#define ATT_PV(vs_) do { const LAS unsigned char* vs0_ = (vs_); \
        _Pragma("unroll") for (int g = 0; g < 4; ++g) { const bf16x8 pf = __builtin_bit_cast(bf16x8, pw[g]); \
            _Pragma("unroll") for (int db = 0; db < DV / 32; ++db) { \
                const bf16x8 vf = *(const LAS bf16x8*)(vs0_ + (32 * db + qn) * 128 + (((2 * g + half) ^ sw7) * 16)); \
                o[db] = __builtin_amdgcn_mfma_f32_32x32x16_bf16(vf, pf, o[db], 0, 0, 0); } } } while (0)
    const int sw7 = (qn >> 1) & 7;
    for (int ti = 0; ti < nt; ++ti) {
        if (ti + 2 < nt) { const int sg2 = sg == 0 ? 2 : sg - 1; ATT_DMA(ti + 2, sg2, (vg + 2) & 3); }
        const LAS unsigned char* Ks = ROT ? lds + sg * 8192 : lds + sg * STG; const LAS unsigned char* Vs = ROT ? lds + 24576 + vg * (DV * 128) : Ks + 8192;
        if (ROT == 2 && ti > 0) ATT_PV(lds + 24576 + ((vg + 3) & 3) * (DV * 128));
        const int id = ti < nlat ? tile_lo + ti : 128 + (ti - nlat);
        const bool islat = id < 128;
        bool skip = false;
        if (WINDOW && islat) { const int qw = qpos0 + wave * 32; skip = (64 * id + 63 < qw - 128 || 64 * id > qw + 31 + 128); }
        if (!skip) {
        f32x16 s[2];
#pragma unroll
        for (int mb = 0; mb < 2; ++mb) {
#pragma unroll
            for (int ks = 0; ks < 4; ++ks) {
                const bf16x8 kf = *(const LAS bf16x8*)(Ks + (32 * mb + qn) * 128 + (((2 * ks + half) ^ sw7) * 16));
                if (ks == 0) s[mb] = __builtin_amdgcn_mfma_f32_32x32x16_bf16(kf, qf[0], negm, 0, 0, 0);
                else s[mb] = __builtin_amdgcn_mfma_f32_32x32x16_bf16(kf, qf[ks], s[mb], 0, 0, 0);
            }
        }
        if (WINDOW && islat) {
            const int qpos = qpos0 + wave * 32 + qn;
#pragma unroll
            for (int mb = 0; mb < 2; ++mb)
#pragma unroll
                for (int i = 0; i < 16; ++i) { const int d = 64 * id + 32 * mb + 8 * (i >> 2) + 4 * half + (i & 3) - qpos; if (d > 128 || d < -128) s[mb][i] = -INFINITY; }
        }
        float mx = s[0][0];
#pragma unroll
        for (int mb = 0; mb < 2; ++mb)
#pragma unroll
            for (int i = 0; i < 16; ++i) mx = fmaxf(mx, s[mb][i]);
        mx = xhalf_max(mx);
        if (__builtin_expect(need_ref || __any(mx > ATT_THR), 0)) {
            const float delta = need_ref ? mx : fmaxf(mx, 0.f);
            if (!need_ref) {
                const float alpha = __builtin_amdgcn_exp2f(-delta);
                lrun *= alpha;
#pragma unroll
                for (int db = 0; db < DV / 32; ++db)
#pragma unroll
                    for (int i = 0; i < 16; ++i) o[db][i] *= alpha;
            }
            mrun += delta; need_ref = false;
#pragma unroll
            for (int mb = 0; mb < 2; ++mb)
#pragma unroll
                for (int i = 0; i < 16; ++i) s[mb][i] -= delta;
#pragma unroll
            for (int i = 0; i < 16; ++i) negm[i] = -mrun;
        }
        float rs = 0.f;
#pragma unroll
        for (int mb = 0; mb < 2; ++mb)
#pragma unroll
            for (int i = 0; i < 16; ++i) { const float pv = __builtin_amdgcn_exp2f(s[mb][i]); s[mb][i] = pv; rs += pv; }
        lrun += rs;
        if (ROT == 2) {
#pragma unroll
            for (int g = 0; g < 4; ++g) {
                const int mb = g >> 1, bs = 8 * (g & 1);
                pw[g].x = pk2(s[mb][bs + 0], s[mb][bs + 1]); pw[g].y = pk2(s[mb][bs + 2], s[mb][bs + 3]); pw[g].z = pk2(s[mb][bs + 4], s[mb][bs + 5]); pw[g].w = pk2(s[mb][bs + 6], s[mb][bs + 7]);
            }
        } else {
#pragma unroll
            for (int g = 0; g < 4; ++g) {
                const int mb = g >> 1, bs = 8 * (g & 1);
                u32x4 pq; pq.x = pk2(s[mb][bs + 0], s[mb][bs + 1]); pq.y = pk2(s[mb][bs + 2], s[mb][bs + 3]); pq.z = pk2(s[mb][bs + 4], s[mb][bs + 5]); pq.w = pk2(s[mb][bs + 6], s[mb][bs + 7]);
                const bf16x8 pf = __builtin_bit_cast(bf16x8, pq);
#pragma unroll
                for (int db = 0; db < DV / 32; ++db) {
                    const bf16x8 vf = *(const LAS bf16x8*)(Vs + (32 * db + qn) * 128 + (((2 * g + half) ^ sw7) * 16));
                    o[db] = __builtin_amdgcn_mfma_f32_32x32x16_bf16(vf, pf, o[db], 0, 0, 0);
                }
            }
        }
        }
        if (ti + 2 < nt) asm volatile("s_waitcnt vmcnt(%0)" :: "n"(ND) : "memory"); else asm volatile("s_waitcnt vmcnt(0)" ::: "memory");
        __syncthreads();
        sg = sg == 2 ? 0 : sg + 1; vg = (vg + 1) & 3;
    }
    if (ROT == 2) ATT_PV(lds + 24576 + ((vg + 3) & 3) * (DV * 128));
#undef ATT_DMA
#undef ATT_PV
    l_out = xhalf_sum(lrun);
}

__device__ __forceinline__ void swa_unit(LAS unsigned char* lds, const Params& p, int layer, int b, int hq, int qb, bool ctx, int wave, int lane, bool dry = false) {
    bf16_t* P = (bf16_t*)(p.ws + WS_P);
    const int kvh = hq >> 2;
    const bf16_t* VT = (const bf16_t*)(p.ws + WS_VTS) + (size_t)((b * 2 + kvh) * 64) * KEYS;
    const float sink2 = p.in[11][layer * 8 + hq] * 1.4426950408889634f;
    const int qrow0 = ctx ? NLAT + b * CTXL : b * SEQ + qb * 256;
    f32x16 o[2]; float l;
    if (ctx) attn_pass<64, false>(lds, P, qrow0, IC_QS + hq * 64, IC_KS + kvh * 64, VT, b * SEQ, NLAT + b * CTXL, 0, 0, true, sink2, 1.0f, 0, o, l, wave, lane);
    else {
        int lo = 4 * qb - 2; if (lo < 0) lo = 0; int hi = 4 * qb + 6; if (hi > 128) hi = 128;
        attn_pass<64, true>(lds, P, qrow0, IC_QS + hq * 64, IC_KS + kvh * 64, VT, b * SEQ, NLAT + b * CTXL, lo, hi, true, sink2, 1.0f, qb * 256, o, l, wave, lane);
    }
    const float inv = 1.0f / l; const int qn = lane & 31, half = lane >> 5;
    bf16_t* dst = P + (size_t)(qrow0 + wave * 32 + qn) * PP + IC_QS + hq * 64 + 4 * half;
#pragma unroll
    for (int db = 0; db < 2; ++db)
#pragma unroll
        for (int q4 = 0; q4 < 4; ++q4) {
            const f32x4 v = (f32x4){o[db][4 * q4] * inv, o[db][4 * q4 + 1] * inv, o[db][4 * q4 + 2] * inv, o[db][4 * q4 + 3] * inv};
            if (!dry) *(u32x2*)(dst + 32 * db + 8 * q4) = pack4(v);
        }
}
__device__ __forceinline__ void diff_unit(LAS unsigned char* lds, const Params& p, float lam, int b, int h, int qb, bool ctx, int park0, int pstride, int wave, int lane, bool dry = false) {
    bf16_t* P = (bf16_t*)(p.ws + WS_P);
    const bf16_t* VT = (const bf16_t*)(p.ws + WS_VTD) + (size_t)((b * 4 + h) * 128) * KEYS;
    const int qrow0 = ctx ? NLAT + b * CTXL : b * SEQ + qb * 256;
    const int thi = ctx ? 0 : 128;
    unsigned* park = (unsigned*)(p.ws + WS_YA) + threadIdx.x;
#define PARK(w_) park[(size_t)(park0 + ((w_) >> 3) * pstride) * 8192 + ((w_) & 7) * 512]
    f32x16 o[4]; float l;
    if (wave < 4) attn_pass<128, false, 1>(lds, P, qrow0, IC_QD + h * 128, IC_KD + h * 128, VT, b * SEQ, NLAT + b * CTXL, 0, thi, false, 0.f, 0.f, 0, o, l, wave, lane);
    else attn_pass<128, false, 2>(lds, P, qrow0, IC_QD + h * 128, IC_KD + h * 128, VT, b * SEQ, NLAT + b * CTXL, 0, thi, false, 0.f, 0.f, 0, o, l, wave, lane);
    { const float inv = 1.0f / l;
#pragma unroll
      for (int db = 0; db < 4; ++db)
#pragma unroll
          for (int i = 0; i < 8; ++i) PARK(db * 8 + i) = pk2(o[db][2 * i] * inv, o[db][2 * i + 1] * inv); }
    if (wave < 4) attn_pass<128, false, 1>(lds, P, qrow0, IC_QD + h * 128 + 64, IC_KD + h * 128 + 64, VT, b * SEQ, NLAT + b * CTXL, 0, thi, false, 0.f, 0.f, 0, o, l, wave, lane);
    else attn_pass<128, false, 2>(lds, P, qrow0, IC_QD + h * 128 + 64, IC_KD + h * 128 + 64, VT, b * SEQ, NLAT + b * CTXL, 0, thi, false, 0.f, 0.f, 0, o, l, wave, lane);
    const float inv = lam / l; const int qn = lane & 31, half = lane >> 5;
    bf16_t* dst = P + (size_t)(qrow0 + wave * 32 + qn) * PP + IC_QD + h * 128 + 4 * half;
#pragma unroll
    for (int db = 0; db < 4; ++db)
#pragma unroll
        for (int q4 = 0; q4 < 4; ++q4) {
            const unsigned pa = PARK(db * 8 + 2 * q4), pb = PARK(db * 8 + 2 * q4 + 1);
            const f32x4 v = (f32x4){bflo(pa) - o[db][4 * q4] * inv, bfhi(pa) - o[db][4 * q4 + 1] * inv, bflo(pb) - o[db][4 * q4 + 2] * inv, bfhi(pb) - o[db][4 * q4 + 3] * inv};
            if (!dry) *(u32x2*)(dst + 32 * db + 8 * q4) = pack4(v);
        }
#undef PARK
}

__device__ __forceinline__ void ld8bf(const bf16_t* p, float (&v)[8]) { const u32x4 w = *(const u32x4*)p; v[0] = bflo(w.x); v[1] = bfhi(w.x); v[2] = bflo(w.y); v[3] = bfhi(w.y); v[4] = bflo(w.z); v[5] = bfhi(w.z); v[6] = bflo(w.w); v[7] = bfhi(w.w); }
__device__ __forceinline__ void ld8f(const float* p, float (&v)[8]) { const f32x4 a = ((const f32x4*)p)[0], b = ((const f32x4*)p)[1]; v[0] = a.x; v[1] = a.y; v[2] = a.z; v[3] = a.w; v[4] = b.x; v[5] = b.y; v[6] = b.z; v[7] = b.w; }
__device__ __forceinline__ void st8f(float* p, const float (&v)[8]) { ((f32x4*)p)[0] = (f32x4){v[0], v[1], v[2], v[3]}; ((f32x4*)p)[1] = (f32x4){v[4], v[5], v[6], v[7]}; }

__device__ __forceinline__ void rwkv_prepare_phase(const Params& p, int layer, int gw, int NGW, int lane) {
    const bf16_t* P = (const bf16_t*)(p.ws + WS_P); float* ST = (float*)(p.ws + WS_ST); bf16_t* A2 = (bf16_t*)(p.ws + WS_YA);
    const float* mup = p.in[12] + layer * 1920; const float* mun = p.in[13] + layer * 1920; const float* k_k = p.in[19] + layer * 512;
    for (int m = gw; m < NTOK; m += NGW) {
        const int t = m < NLAT ? (m & (SEQ - 1)) : ((m - NLAT) & (CTXL - 1)), len = m < NLAT ? SEQ : CTXL;
        const bool hp = t > 0, hn = t < len - 1;
        const bf16_t* pr = P + (size_t)m * PP + IC_RW;
        const int h = lane >> 3, l4 = (lane & 7) * 4;
        float* sp = ST + ((size_t)m * 8 + h) * (ST_SLOTS * 64) + l4;
#pragma unroll
        for (int sec = 0; sec < 3; ++sec) {
            const int col = sec * 512 + h * 64 + l4;
            float sh[8];
#pragma unroll
            for (int hv = 0; hv < 2; ++hv) {
                const int cc = col + 32 * hv;
                const u32x2 cw = *(const u32x2*)(pr + cc);
                u32x2 pw_ = (u32x2){0u, 0u}, nw_ = (u32x2){0u, 0u};
                if (hp) pw_ = *(const u32x2*)(pr - PP + cc);
                if (hn) nw_ = *(const u32x2*)(pr + PP + cc);
                const f32x4 a = *(const f32x4*)(mup + cc), bb = *(const f32x4*)(mun + cc);
                const float c[4] = {bflo(cw.x), bfhi(cw.x), bflo(cw.y), bfhi(cw.y)};
                const float pv[4] = {hp ? bflo(pw_.x) : 0.f, hp ? bfhi(pw_.x) : 0.f, hp ? bflo(pw_.y) : 0.f, hp ? bfhi(pw_.y) : 0.f};
                const float nx[4] = {hn ? bflo(nw_.x) : 0.f, hn ? bfhi(nw_.x) : 0.f, hn ? bflo(nw_.y) : 0.f, hn ? bfhi(nw_.y) : 0.f};
#pragma unroll
                for (int q = 0; q < 4; ++q) sh[4 * hv + q] = c[q] + a[q] * (pv[q] - c[q]) + bb[q] * (nx[q] - c[q]);
            }
            const int slot = sec == 0 ? SL_R : (sec == 1 ? SL_K : SL_V);
            *(f32x4*)(sp + slot * 64) = (f32x4){sh[0], sh[1], sh[2], sh[3]}; *(f32x4*)(sp + slot * 64 + 32) = (f32x4){sh[4], sh[5], sh[6], sh[7]};
            if (sec == 1) {
                const f32x4 w0 = *(const f32x4*)(k_k + h * 64 + l4), w1 = *(const f32x4*)(k_k + h * 64 + 32 + l4);
                float kk[8]; float ss = 0.f;
#pragma unroll
                for (int q = 0; q < 4; ++q) { kk[q] = sh[q] * w0[q]; kk[4 + q] = sh[4 + q] * w1[q]; ss += kk[q] * kk[q] + kk[4 + q] * kk[4 + q]; }
                ss += __shfl_xor(ss, 1); ss += __shfl_xor(ss, 2); ss += __shfl_xor(ss, 4);
                const float inv = 1.0f / fmaxf(sqrtf(ss), 1e-12f);
                *(f32x4*)(sp + SL_KK * 64) = (f32x4){kk[0] * inv, kk[1] * inv, kk[2] * inv, kk[3] * inv}; *(f32x4*)(sp + SL_KK * 64 + 32) = (f32x4){kk[4] * inv, kk[5] * inv, kk[6] * inv, kk[7] * inv};
            }
        }
        if (lane < 48) {
            const int col = 1536 + lane * 8;
            float c[8], pv[8], nx[8], a[8], bb[8], sh[8];
            ld8bf(pr + col, c);
            if (hp) ld8bf(pr - PP + col, pv); else {
#pragma unroll
                for (int q = 0; q < 8; ++q) pv[q] = 0.f; }
            if (hn) ld8bf(pr + PP + col, nx); else {
#pragma unroll
                for (int q = 0; q < 8; ++q) nx[q] = 0.f; }
            ld8f(mup + col, a); ld8f(mun + col, bb);
#pragma unroll
            for (int q = 0; q < 8; ++q) sh[q] = c[q] + a[q] * (pv[q] - c[q]) + bb[q] * (nx[q] - c[q]);
            float o[8];
#pragma unroll
            for (int q = 0; q < 8; ++q) o[q] = lane < 16 ? tanhf(sh[q]) : (lane < 32 ? sh[q] : sigmoidf_(sh[q]));
            u32x4 w; w.x = pk2(o[0], o[1]); w.y = pk2(o[2], o[3]); w.z = pk2(o[4], o[5]); w.w = pk2(o[6], o[7]);
            *(u32x4*)(A2 + (size_t)m * 384 + lane * 8) = w;
        }
    }
}

constexpr int NSEG = 64, SEGL = KEYS / NSEG;
static_assert(SEGL * NSEG == KEYS && SEGL % 4 == 0, "segments");
constexpr size_t WS_GH = WS_YA;
static_assert(WS_GH + 32ull * NSEG * 2 * 4096 * 4 <= 560 * MiB, "GH fits behind the stream");
__device__ __forceinline__ int scan_token(int b, int dir, int s) {
    if (s < CTXL) return NLAT + b * CTXL + (dir ? CTXL - 1 - s : s);
    const int t = s - CTXL; return b * SEQ + (dir ? SEQ - 1 - t : t);
}
constexpr int SRING = 6, SREC = 6 * 64 * 4;
constexpr int SCAN_LDS = SRING * SREC;
__device__ __forceinline__ void scan_dma(const float* rec, LAS unsigned char* slot, int lane) {
    const float* q = rec + lane * 4;
    __builtin_amdgcn_global_load_lds((const unsigned*)q, (LAS unsigned*)slot, 16, 0, 0);
    if (lane < 32) __builtin_amdgcn_global_load_lds((const unsigned*)(q + 256), (LAS unsigned*)(slot + 1024), 16, 0, 0);
}
template <int MODE>
__device__ __forceinline__ void rwkv_segment(const Params& p, int layer, int sid, int seg, int lane, LAS unsigned char* ring) {
    const int b = sid >> 4, h = (sid >> 1) & 7, dir = sid & 1, c = lane & 31, hf = lane >> 5;
    const float ka0 = p.in[20][layer * 512 + h * 64 + c], ka1 = p.in[20][layer * 512 + h * 64 + 32 + c];
    const float rk0 = MODE == 2 ? p.in[21][layer * 512 + h * 64 + c] : 0.f, rk1 = MODE == 2 ? p.in[21][layer * 512 + h * 64 + 32 + c] : 0.f;
    const float* ST = (const float*)(p.ws + WS_ST);
    float* gh = (float*)(p.ws + WS_GH) + ((size_t)sid * NSEG + seg) * 2 * 4096;
    f32x16 TH[2][2], TG[MODE == 0 ? 2 : 1][2];
#pragma unroll
    for (int kb = 0; kb < 2; ++kb)
#pragma unroll
        for (int vb = 0; vb < 2; ++vb) {
            if (MODE == 2 && seg > 0) {
                const float* src = gh - 4096 + (32 * vb + c) * 64 + 32 * kb + 4 * hf;
#pragma unroll
                for (int q = 0; q < 4; ++q) { const f32x4 t = *(const f32x4*)(src + 8 * q); TH[kb][vb][4 * q] = t.x; TH[kb][vb][4 * q + 1] = t.y; TH[kb][vb][4 * q + 2] = t.z; TH[kb][vb][4 * q + 3] = t.w; }
            } else {
#pragma unroll
                for (int r = 0; r < 16; ++r) TH[kb][vb][r] = 0.f;
            }
            if (MODE == 0) {
#pragma unroll
                for (int r = 0; r < 16; ++r) TG[MODE == 0 ? kb : 0][vb][r] = (32 * kb + 8 * (r >> 2) + 4 * hf + (r & 3) == 32 * vb + c) ? 1.0f : 0.0f;
            }
        }
    const int s0 = seg * SEGL, s_end = s0 + SEGL;
    const int okk = dir ? 0 : 512, od = dir ? 1024 : 0, gsl = dir ? SL_KK * 64 : 0;
#pragma unroll 1
    for (int j = 0; j < SRING - 1; ++j) scan_dma(ST + ((size_t)scan_token(b, dir, s0 + j) * 8 + h) * (ST_SLOTS * 64) + gsl, ring + j * SREC, lane);
    int slot_i = 0;
#pragma unroll 1
    for (int s = s0; s < s_end; ++s) {
        if (s + SRING - 1 < s_end) {
            int nslot = slot_i + SRING - 1; if (nslot >= SRING) nslot -= SRING;
            scan_dma(ST + ((size_t)scan_token(b, dir, s + SRING - 1) * 8 + h) * (ST_SLOTS * 64) + gsl, ring + nslot * SREC, lane);
            asm volatile("s_waitcnt vmcnt(10)" ::: "memory");
        } else asm volatile("s_waitcnt vmcnt(0)" ::: "memory");
        const LAS unsigned char* rec = ring + slot_i * SREC;
        slot_i = slot_i + 1 == SRING ? 0 : slot_i + 1;
        f32x2_t ph[2] = {{0.f, 0.f}, {0.f, 0.f}}, pg[2] = {{0.f, 0.f}, {0.f, 0.f}};
#pragma unroll
        for (int kb = 0; kb < 2; ++kb)
#pragma unroll
            for (int q = 0; q < 4; ++q) {
                const f32x4 a4 = *(const LAS f32x4*)(rec + okk + (32 * kb + 8 * q + 4 * hf) * 4);
#pragma unroll
                for (int j = 0; j < 4; j += 2)
#pragma unroll
                    for (int vb = 0; vb < 2; ++vb) {
                        const f32x2_t a2 = {a4[j], a4[j + 1]};
                        ph[vb] = __builtin_elementwise_fma((f32x2_t){TH[kb][vb][4 * q + j], TH[kb][vb][4 * q + j + 1]}, a2, ph[vb]);
                        if (MODE == 0) pg[vb] = __builtin_elementwise_fma((f32x2_t){TG[MODE == 0 ? kb : 0][vb][4 * q + j], TG[MODE == 0 ? kb : 0][vb][4 * q + j + 1]}, a2, pg[vb]);
                    }
            }
        float sa[2], sg[2];
#pragma unroll
        for (int vb = 0; vb < 2; ++vb) { sa[vb] = xhalf_sum(ph[vb].x + ph[vb].y); sg[vb] = MODE == 0 ? xhalf_sum(pg[vb].x + pg[vb].y) : 0.f; }
#pragma unroll
        for (int kb = 0; kb < 2; ++kb)
#pragma unroll
            for (int q = 0; q < 4; ++q) {
                const f32x4 w4 = *(const LAS f32x4*)(rec + od + (32 * kb + 8 * q + 4 * hf) * 4);
#pragma unroll
                for (int j = 0; j < 4; ++j)
#pragma unroll
                    for (int vb = 0; vb < 2; ++vb) { TH[kb][vb][4 * q + j] *= w4[j]; if (MODE == 0) TG[MODE == 0 ? kb : 0][vb][4 * q + j] *= w4[j]; }
            }
        float aop[2], bop[2], bopg[2];
#pragma unroll
        for (int kb = 0; kb < 2; ++kb) {
            const float ag = *(const LAS float*)(rec + od + 256 + (32 * kb + c) * 4), x = *(const LAS float*)(rec + okk + (hf ? 768 : 0) + (32 * kb + c) * 4);
            aop[kb] = x * (hf ? fmaf(ag - 1.0f, kb ? ka1 : ka0, 1.0f) : -ag);
        }
        float bonus = 0.f;
        if (MODE == 2) {
            const float r0 = *(const LAS float*)(rec + okk + 256 + c * 4), r1 = *(const LAS float*)(rec + okk + 256 + (32 + c) * 4);
            bonus = fmaf(aop[0] * r0, rk0, aop[1] * r1 * rk1);
        }
#pragma unroll
        for (int vb = 0; vb < 2; ++vb) { const float vv = *(const LAS float*)(rec + okk + 512 + (32 * vb + c) * 4); bop[vb] = hf ? vv : sa[vb]; bopg[vb] = hf ? 0.f : sg[vb]; }
#pragma unroll
        for (int kb = 0; kb < 2; ++kb)
#pragma unroll
            for (int vb = 0; vb < 2; ++vb) {
                TH[kb][vb] = __builtin_amdgcn_mfma_f32_32x32x2f32(aop[kb], bop[vb], TH[kb][vb], 0, 0, 0);
                if (MODE == 0) TG[MODE == 0 ? kb : 0][vb] = __builtin_amdgcn_mfma_f32_32x32x2f32(aop[kb], bopg[vb], TG[MODE == 0 ? kb : 0][vb], 0, 0, 0);
            }
        if (MODE == 2) {
            f32x2_t py[2] = {{0.f, 0.f}, {0.f, 0.f}};
#pragma unroll
            for (int kb = 0; kb < 2; ++kb)
#pragma unroll
                for (int q = 0; q < 4; ++q) {
                    const f32x4 r4 = *(const LAS f32x4*)(rec + okk + 256 + (32 * kb + 8 * q + 4 * hf) * 4);
#pragma unroll
                    for (int j = 0; j < 4; j += 2)
#pragma unroll
                        for (int vb = 0; vb < 2; ++vb) py[vb] = __builtin_elementwise_fma((f32x2_t){TH[kb][vb][4 * q + j], TH[kb][vb][4 * q + j + 1]}, (f32x2_t){r4[j], r4[j + 1]}, py[vb]);
                }
            const float y0 = xhalf_sum(py[0].x + py[0].y), y1 = xhalf_sum(py[1].x + py[1].y);
            float* yp = (float*)ST + ((size_t)scan_token(b, dir, s) * 8 + h) * (ST_SLOTS * 64) + (dir ? SL_W1 : SL_W0) * 64 + c;
            if (hf == 0) { yp[0] = y0; yp[32] = y1; }
            if (hf) yp[64] = bonus;
        }
    }
    if (MODE == 0) {
#pragma unroll
        for (int kb = 0; kb < 2; ++kb)
#pragma unroll
            for (int vb = 0; vb < 2; ++vb) {
                float* dg = gh + (32 * vb + c) * 64 + 32 * kb + 4 * hf; float* dh = dg + 4096;
#pragma unroll
                for (int q = 0; q < 4; ++q) {
                    *(f32x4*)(dg + 8 * q) = (f32x4){TG[MODE == 0 ? kb : 0][vb][4 * q], TG[MODE == 0 ? kb : 0][vb][4 * q + 1], TG[MODE == 0 ? kb : 0][vb][4 * q + 2], TG[MODE == 0 ? kb : 0][vb][4 * q + 3]};
                    *(f32x4*)(dh + 8 * q) = (f32x4){TH[kb][vb][4 * q], TH[kb][vb][4 * q + 1], TH[kb][vb][4 * q + 2], TH[kb][vb][4 * q + 3]};
                }
            }
    }
}
__device__ __forceinline__ void rwkv_combine(const Params& p, int sid, LAS unsigned char* lds, int wave, int lane) {
    float* gh0 = (float*)(p.ws + WS_GH) + (size_t)sid * NSEG * 2 * 4096;
    LAS float* Sx = (LAS float*)lds;
    constexpr int CB0 = 20480;
    const int tid = wave * 64 + lane;
#define CMB_DMA(i_) do { const float* g_ = gh0 + (size_t)(i_) * 2 * 4096 + tid * 4; LAS unsigned char* b_ = lds + CB0 + ((i_) & 1) * 32768 + wave * 1024; \
        _Pragma("unroll") for (int j_ = 0; j_ < 4; ++j_) __builtin_amdgcn_global_load_lds((const unsigned*)(g_ + j_ * 2048), (LAS unsigned*)(b_ + j_ * 8192), 16, 0, 0); } while (0)
    CMB_DMA(1);
    for (int e = tid; e < 4096; e += NTHREADS) Sx[(e >> 6) * 65 + (e & 63)] = gh0[4096 + e];
    asm volatile("s_waitcnt vmcnt(0)" ::: "memory");
    __syncthreads();
    const int rb = (wave >> 1) & 1, cb = wave & 1, i32 = lane & 31, hf = lane >> 5;
    for (int i = 1; i < NSEG - 1; ++i) {
        float* gi = gh0 + (size_t)i * 2 * 4096;
        if (i + 1 < NSEG - 1) CMB_DMA(i + 1);
        f32x16 d;
        if (wave < 4) {
            const LAS float* gb = (const LAS float*)(lds + CB0 + (i & 1) * 32768);
            float bq[32];
#pragma unroll
            for (int q = 0; q < 32; ++q) bq[q] = gb[(2 * q + hf) * 64 + 32 * cb + i32];
#pragma unroll
            for (int r = 0; r < 16; ++r) d[r] = gb[4096 + (32 * rb + 8 * (r >> 2) + 4 * hf + (r & 3)) * 64 + 32 * cb + i32];
#pragma unroll
            for (int q = 0; q < 32; ++q) {
                const float aq = Sx[(32 * rb + i32) * 65 + 2 * q + hf];
                d = __builtin_amdgcn_mfma_f32_32x32x2f32(aq, bq[q], d, 0, 0, 0);
            }
#pragma unroll
            for (int r = 0; r < 16; ++r) gi[4096 + (32 * rb + 8 * (r >> 2) + 4 * hf + (r & 3)) * 64 + 32 * cb + i32] = d[r];
        }
        __syncthreads();
        if (wave < 4) {
#pragma unroll
            for (int r = 0; r < 16; ++r) Sx[(32 * rb + 8 * (r >> 2) + 4 * hf + (r & 3)) * 65 + 32 * cb + i32] = d[r];
            asm volatile("s_waitcnt vmcnt(16)" ::: "memory");
        } else asm volatile("s_waitcnt vmcnt(0)" ::: "memory");
        __syncthreads();
    }
#undef CMB_DMA
}

__device__ __forceinline__ void postmix_phase(const Params& p, int layer, float lam_init, int M, int gw, int NGW, int lane) {
    const bf16_t* P = (const bf16_t*)(p.ws + WS_P); const float* ST = (const float*)(p.ws + WS_ST);
    bf16_t* YB = (bf16_t*)(p.ws + WS_YB); bf16_t* YC = (bf16_t*)(p.ws + WS_YC);
    const float* lng = p.in[22] + layer * 512; const float* lnb = p.in[23] + layer * 512; const float* sg = p.in[25] + layer * 128;
    for (int m = gw; m < M; m += NGW) {
        {
            const int h = lane >> 3, kidx = (lane & 7) * 8, ch = lane * 8;
            const float* sp = ST + ((size_t)m * 8 + h) * (ST_SLOTS * 64) + kidx;
            float y[8], v[8], g[8], lg[8], lb[8];
            { float yb_[8]; ld8f(sp + SL_W0 * 64, y); ld8f(sp + SL_W1 * 64, yb_);
#pragma unroll
              for (int q = 0; q < 8; ++q) y[q] += yb_[q]; }
            ld8f(sp + SL_V * 64, v); ld8f(lng + ch, lg); ld8f(lnb + ch, lb);
            ld8bf(P + (size_t)m * PP + IC_RW + ch, g);
            float s = 0.f;
#pragma unroll
            for (int q = 0; q < 8; ++q) s += y[q];
            s += __shfl_xor(s, 1); s += __shfl_xor(s, 2); s += __shfl_xor(s, 4);
            float bn;
            { const f32x4 b0 = *(const f32x4*)(sp - kidx + SL_A0 * 64 + (lane & 7) * 4), b1 = *(const f32x4*)(sp - kidx + SL_A1 * 64 + (lane & 7) * 4);
              bn = ((b0.x + b0.y) + (b0.z + b0.w)) + ((b1.x + b1.y) + (b1.z + b1.w));
              bn += __shfl_xor(bn, 1); bn += __shfl_xor(bn, 2); bn += __shfl_xor(bn, 4); }
            const float mu = s * (1.0f / 64.0f);
            float var = 0.f;
#pragma unroll
            for (int q = 0; q < 8; ++q) { const float d = y[q] - mu; var += d * d; }
            var += __shfl_xor(var, 1); var += __shfl_xor(var, 2); var += __shfl_xor(var, 4);
            const float rstd = 1.0f / sqrtf(var * (1.0f / 64.0f) + 64e-5f);
            float o[8];
#pragma unroll
            for (int q = 0; q < 8; ++q) o[q] = (((y[q] - mu) * rstd) * lg[q] + lb[q] + bn * v[q]) * g[q];
            u32x4 w; w.x = pk2(o[0], o[1]); w.y = pk2(o[2], o[3]); w.z = pk2(o[4], o[5]); w.w = pk2(o[6], o[7]);
            *(u32x4*)(YB + (size_t)m * 512 + ch) = w;
        }
        *(u32x4*)((bf16_t*)(p.ws + WS_YA) + (size_t)m * 512 + lane * 8) = *(const u32x4*)(P + (size_t)m * PP + IC_QS + lane * 8);
        {
            const int e = (lane & 15) * 8;
            float x[8], gg[8];
            ld8bf(P + (size_t)m * PP + IC_QD + lane * 8, x); ld8f(sg + e, gg);
            float ss = 0.f;
#pragma unroll
            for (int q = 0; q < 8; ++q) ss += x[q] * x[q];
            ss += __shfl_xor(ss, 1); ss += __shfl_xor(ss, 2); ss += __shfl_xor(ss, 4); ss += __shfl_xor(ss, 8);
            const float rstd = (1.0f - lam_init) / sqrtf(ss * (1.0f / 128.0f) + 1e-5f);
            float o[8];
#pragma unroll
            for (int q = 0; q < 8; ++q) o[q] = x[q] * rstd * gg[q];
            u32x4 w; w.x = pk2(o[0], o[1]); w.y = pk2(o[2], o[3]); w.z = pk2(o[4], o[5]); w.w = pk2(o[6], o[7]);
            *(u32x4*)(YC + (size_t)m * 512 + lane * 8) = w;
        }
    }
}
#define XB_TMO      128
#define XB_XCNT(j)  (256  + 64 * (j))
#define XB_XSUB(j)  (1280 + 64 * (j))
#define XB_XGEN(j)  (2304 + 64 * (j))
#define XB_TOP      3328
#define XB_TOPGEN   3392
#define XCD_BAR_WORDS 3456
#define XB_SPIN_CAP (1u << 18)

__device__ __forceinline__ unsigned xb_ld(unsigned* p)              { return __hip_atomic_load(p, __ATOMIC_RELAXED, __HIP_MEMORY_SCOPE_AGENT); }
__device__ __forceinline__ unsigned xb_add(unsigned* p, unsigned v) { return __hip_atomic_fetch_add(p, v, __ATOMIC_RELAXED, __HIP_MEMORY_SCOPE_AGENT); }
__device__ __forceinline__ unsigned xb_xcc_id() { return (unsigned)__builtin_amdgcn_s_getreg((3 << 11) | 20) & 0xFu; }
#define XB_SPIN(cond, bar) do { unsigned _sp = 0; while (cond) { __builtin_amdgcn_s_sleep(1); \
    if ((++_sp & 255u) == 0u) { if (xb_ld(&(bar)[XB_TMO])) break; if (_sp > XB_SPIN_CAP) { atomicAdd(&(bar)[XB_TMO], 1u); break; } } } } while (0)

struct XcdBarrier {
    unsigned* bar; unsigned x;
    volatile LAS unsigned* st;
};

__device__ __forceinline__ XcdBarrier xcd_barrier_post(unsigned* bar, volatile LAS unsigned* st) {
    XcdBarrier b; b.bar = bar; b.x = xb_xcc_id(); b.st = st;
    if (threadIdx.x == 0) (void)xb_add(&bar[XB_XCNT(b.x)], 1u);
    return b;
}
__device__ __forceinline__ void xcd_barrier_complete(unsigned* bar, unsigned x, unsigned& nloc, unsigned& nx) {
    const unsigned G = gridDim.x * gridDim.y * gridDim.z;
    unsigned sum, cnt, mine, sp = 0u;
    for (;;) {
        sum = 0u; cnt = 0u; mine = 0u;
#pragma unroll
        for (unsigned j = 0; j < 16; ++j) { const unsigned c = xb_ld(&bar[XB_XCNT(j)]); sum += c; cnt += (c > 0u) ? 1u : 0u; mine = (j == x) ? c : mine; }
        if (sum == G) break;
        __builtin_amdgcn_s_sleep(1);
        if ((++sp & 255u) == 0u) { if (xb_ld(&bar[XB_TMO])) break; if (sp > XB_SPIN_CAP) { atomicAdd(&bar[XB_TMO], 1u); break; } }
    }
    nloc = mine > 0u ? mine : 1u; nx = cnt > 0u ? cnt : 1u;
}

__device__ __forceinline__ void xcd_barrier(const XcdBarrier& b) {
    asm volatile("s_waitcnt vmcnt(0)" ::: "memory");
    __syncthreads();
    if (threadIdx.x == 0) {
        unsigned* bar = b.bar;
        __builtin_amdgcn_s_waitcnt(0);
        unsigned nloc = b.st[0], nx = b.st[1];
        if (nloc == 0u) { xcd_barrier_complete(bar, b.x, nloc, nx); b.st[0] = nloc; b.st[1] = nx; }
        const unsigned old = xb_add(&bar[XB_XSUB(b.x)], 1u);
        const unsigned gen = old / nloc;
        if (old + 1u == (gen + 1u) * nloc) {
            __builtin_amdgcn_fence(__ATOMIC_RELEASE, "agent");
            asm volatile("s_waitcnt vmcnt(0)" ::: "memory");
            const unsigned og = xb_add(&bar[XB_TOP], 1u);
            const unsigned tg = og / nx;
            if (og + 1u == (tg + 1u) * nx) xb_add(&bar[XB_TOPGEN], 1u);
            else XB_SPIN(xb_ld(&bar[XB_TOPGEN]) == tg, bar);
            __builtin_amdgcn_fence(__ATOMIC_ACQUIRE, "agent");
            xb_add(&bar[XB_XGEN(b.x)], 1u);
            asm volatile("s_waitcnt vmcnt(0)" ::: "memory");
        } else {
            XB_SPIN(xb_ld(&bar[XB_XGEN(b.x)]) == gen, bar);
            __builtin_amdgcn_fence(__ATOMIC_ACQUIRE, "agent");
            asm volatile("s_waitcnt vmcnt(0)" ::: "memory");
        }
    }
    __syncthreads();
}

#ifndef MK_MULTI
#define MK_MULTI 0
#endif
constexpr int N_PHASES = 40;

#ifndef PROBE_MASK
#define PROBE_MASK 0ull
#endif
#ifndef PROBE_MASK2
#define PROBE_MASK2 0ull
#endif
#define PROBE_MULT 4ull
constexpr int LDS_PARAMS = LDS_BYTES - 1024;
constexpr int LDS_XB = LDS_BYTES - 64;
constexpr int CW_BAR = 8192;
__device__ __forceinline__ unsigned long long uni64(unsigned long long v) {
    const unsigned lo = __builtin_amdgcn_readfirstlane((unsigned)v), hi = __builtin_amdgcn_readfirstlane((unsigned)(v >> 32));
    return ((unsigned long long)hi << 32) | lo;
}
__device__ __forceinline__ int opq(int v) { asm volatile("" : "+s"(v)); return v; }
__device__ __forceinline__ void load_params(LAS unsigned char* lds, Params& q) {
    LAS const unsigned long long* s = (LAS const unsigned long long*)(lds + LDS_PARAMS);
#pragma unroll
    for (int i = 0; i < 37; ++i) q.in[i] = (const float*)(const __attribute__((address_space(1))) float*)uni64(s[i]);
    q.out = (float*)(__attribute__((address_space(1))) float*)uni64(s[37]); q.ws = (unsigned char*)(__attribute__((address_space(1))) unsigned char*)uni64(s[38]); q.ph_lo = 0; q.ph_hi = 0;
}
__global__ void __launch_bounds__(NTHREADS, 2) mk_fwd(Params kp) {
    extern __shared__ __attribute__((aligned(16))) unsigned char lds_raw[];
    LAS unsigned char* lds = (LAS unsigned char*)lds_raw;
    cg::grid_group grid = cg::this_grid();
    if (threadIdx.x == 0) {
        LAS unsigned long long* s = (LAS unsigned long long*)(lds + LDS_PARAMS);
#pragma unroll
        for (int i = 0; i < 37; ++i) s[i] = (unsigned long long)kp.in[i];
        s[37] = (unsigned long long)kp.out; s[38] = (unsigned long long)kp.ws;
    }
    if (threadIdx.x < 2) ((LAS unsigned*)(lds + LDS_XB))[threadIdx.x] = 0u;
    __syncthreads();
#if !MK_MULTI
    (void)xcd_barrier_post((unsigned*)(kp.ws + WS_CTL) + CW_BAR, (volatile LAS unsigned*)(lds + LDS_XB));
#endif
    const int ph_lo = kp.ph_lo, ph_hi = kp.ph_hi;
    int ph = 0;
    if ((PROBE_MASK | PROBE_MASK2) != 0ull && threadIdx.x == 0) { LAS unsigned long long* pt_ = (LAS unsigned long long*)(lds + LDS_PARAMS + 320); pt_[0] = __builtin_amdgcn_s_memrealtime(); pt_[1] = 0ull; }
#define PH_BEGIN if (ph >= ph_lo && ph < ph_hi) { asm volatile("" ::: "memory"); Params p; load_params(lds, p); unsigned char* ws = p.ws; (void)ws; \
    int tid_ = threadIdx.x, bid_ = blockIdx.x, G_ = gridDim.x; asm volatile("" : "+v"(tid_), "+s"(bid_), "+s"(G_)); \
    const int tid = tid_, bid = bid_, G = G_, lane = tid & 63, wave = __builtin_amdgcn_readfirstlane(tid >> 6); const int gw = bid * NWAVES + wave, NGW = G * NWAVES; (void)gw; (void)NGW; (void)lane; (void)tid; (void)G; (void)bid;
#define GRID_SEAM() do { { XcdBarrier xb_; xb_.bar = (unsigned*)((unsigned char*)(__attribute__((address_space(1))) unsigned char*)uni64(((LAS const unsigned long long*)(lds + LDS_PARAMS))[38]) + WS_CTL) + CW_BAR; \
        xb_.x = xb_xcc_id(); xb_.st = (volatile LAS unsigned*)(lds + LDS_XB); xcd_barrier(xb_); } } while (0)
#define PROBE_TICK() do { if ((PROBE_MASK | PROBE_MASK2) != 0ull && blockIdx.x == 0 && threadIdx.x == 0) { LAS unsigned long long* pt_ = (LAS unsigned long long*)(lds + LDS_PARAMS + 320); \
        const unsigned long long now_ = __builtin_amdgcn_s_memrealtime(); if ((PROBE_MASK >> ph) & 1ull) pt_[1] += now_ - pt_[0]; pt_[0] = now_; } } while (0)
#define PROBE_MID() do { if ((PROBE_MASK | PROBE_MASK2) != 0ull && blockIdx.x == 0 && threadIdx.x == 0) { LAS unsigned long long* pt_ = (LAS unsigned long long*)(lds + LDS_PARAMS + 320); \
        const unsigned long long now_ = __builtin_amdgcn_s_memrealtime(); if ((PROBE_MASK2 >> ph) & 1ull) pt_[1] += now_ - pt_[0]; pt_[0] = now_; } } while (0)
#define PH_END } if (ph >= ph_lo && ph + 1 < ph_hi) GRID_SEAM(); PROBE_TICK(); ++ph;

    using pg8::Gemm; using pg8::StaticOrder; using pg8::gemm_phase;

    PH_BEGIN
        convert_layer_weights(p, 0, lds, gw, NGW, wave, lane);
        __syncthreads();
        adaln_phase(p, lds, wave, lane);
    PH_END
    PH_BEGIN
        premix_phase(p, 0, true, NTOK, gw, NGW, lane);
    PH_END

#pragma clang loop unroll(full)
    for (int layer = 0; layer < 2; ++layer) {
        const int Ml = layer == 0 ? NTOK : NLAT;
        const float lam_init = 0.8f - 0.6f * expf(-0.3f * (float)layer);
        PH_BEGIN
            Gemm g{(const bf16_t*)(ws + WS_XN), (const bf16_t*)(ws + WS_WIN), NTOK, NIN1, opq(1024), 1024}; StaticOrder S; S.init(NTOK, NIN1, G, bid);
            EpiIn E{(bf16_t*)(ws + WS_P), (bf16_t*)(ws + WS_VTS), (bf16_t*)(ws + WS_VTD), (const float*)(ws + WS_ROPE)};
            gemm_phase<EpiIn, StaticOrder, true, true>(lds, g, S, E);
        PH_END
        PH_BEGIN
            rwkv_prepare_phase(p, layer, gw, NGW, lane);
        PH_END
        PH_BEGIN
            Gemm g{(const bf16_t*)(ws + WS_YA), (const bf16_t*)(ws + WS_LORA), NTOK, 2560, opq(128), 384}; LoraSched S; S.S.init(NTOK, 2560, G, bid);
            EpiLora E{(float*)(ws + WS_ST), (bf16_t*)(ws + WS_P), p.in[14] + layer * 1024, p.in[16] + layer * 1024};
            gemm_phase<EpiLora, LoraSched, true, true>(lds, g, S, E);
        PH_END
        PH_BEGIN
            for (int u = gw; u < 32 * (NSEG - 1); u += NGW) rwkv_segment<0>(p, layer, u / (NSEG - 1), u % (NSEG - 1), lane, lds + wave * SCAN_LDS);
        PH_END
        PH_BEGIN
            unsigned* qhead = (unsigned*)(ws + WS_CTL) + (layer == 0 ? CW_Q0 : CW_Q1);
            LAS int* ubox = (LAS int*)(lds + 131072);
            const int n_swa = 512 + (layer == 0 ? 16 + 8 : 0);
            if (bid < 32) rwkv_combine(p, bid, lds, wave, lane);
            if (bid >= 32 || G <= 32)
            for (;;) {
                if (tid == 0) ubox[0] = (int)atomicAdd(qhead, 1u);
                __syncthreads();
                const int u = ubox[0];
                __syncthreads();
                if (u >= n_swa) break;
                if (u < 512) swa_unit(lds, p, layer, u >> 8, (u >> 5) & 7, u & 31, false, wave, lane);
                else if (u < 528) { const int v = u - 512; swa_unit(lds, p, layer, v >> 3, v & 7, 0, true, wave, lane); }
                else { const int v = u - 528; float lamq; { const float* lv = p.in[24] + layer * 256; const float s1 = wave_sum(lv[lane] * lv[64 + lane]), s2 = wave_sum(lv[128 + lane] * lv[192 + lane]); lamq = expf(s1) - expf(s2) + lam_init; }
                       diff_unit(lds, p, lamq, v >> 2, v & 3, 0, true, (4 * v) * NSEG + NSEG - 1, NSEG, wave, lane); }
            }
        PH_END
        PH_BEGIN
            for (int u = gw; u < 32 * NSEG; u += NGW) rwkv_segment<2>(p, layer, u / NSEG, u % NSEG, lane, lds + wave * SCAN_LDS);
            asm volatile("s_waitcnt vmcnt(0)" ::: "memory");
            __syncthreads();
            PROBE_MID();
            float lam;
            { const float* lv = p.in[24] + layer * 256;
              const float s1 = wave_sum(lv[lane] * lv[64 + lane]), s2 = wave_sum(lv[128 + lane] * lv[192 + lane]);
              lam = expf(s1) - expf(s2) + lam_init; }
            for (int u = bid; u < 256; u += G) { const int v = G == 256 ? ((((u & 7) >> 2) << 7) | ((u & 3) << 5) | (u >> 3)) : u; diff_unit(lds, p, lam, v >> 7, (v >> 5) & 3, v & 31, false, 4 * v, 1, wave, lane); }
        PH_END
        PH_BEGIN
            postmix_phase(p, layer, lam_init, Ml, gw, NGW, lane);
            if (layer == 0) convert_ffn_weights(p, lds, gw, NGW, wave, lane);
            __syncthreads();
            Gemm g{(const bf16_t*)(ws + WS_XN), (const bf16_t*)(ws + WS_WIN) + (size_t)NIN1 * 1024, Ml, 3072, opq(1024), 1024}; StaticOrder S; S.init(Ml, 3072, G, bid);
            EpiGate E{(bf16_t*)(ws + WS_G)};
            gemm_phase<EpiGate, StaticOrder, true, true>(lds, g, S, E);
        PH_END
        PH_BEGIN
            MergeSched S; S.S.init(Ml, 1024, G, bid); S.nMtot = NTOK / 256;
            Gemm g{(const bf16_t*)(ws + WS_YA), (const bf16_t*)(ws + WS_PRJ), Ml, 1024, opq(512), 512};
            EpiMergeF E{(const bf16_t*)(ws + WS_G), (bf16_t*)(ws + WS_MF), (bf16_t*)(ws + WS_MB), NTOK / 256};
            gemm_phase<EpiMergeF, MergeSched, true, true>(lds, g, S, E);
        PH_END
        PH_BEGIN
            Gemm g{(const bf16_t*)(ws + WS_MB), (const bf16_t*)(ws + WS_WOUT), Ml, 1024, opq(1024), 1024};
            if (layer == 0) {
                TailSched S; S.init(NLAT, 1024, G, bid, (NTOK - NLAT) / 256, 2, 8);
                EpiBfTail E{(bf16_t*)(ws + WS_MOUT), 1024, (float*)(ws + WS_P), NLAT, NTOK - NLAT};
                gemm_phase<EpiBfTail, TailSched, true, true>(lds, g, S, E);
            } else {
                StaticOrder S; S.init(Ml, 1024, G, bid);
                EpiBf E{(bf16_t*)(ws + WS_MOUT), 1024};
                gemm_phase<EpiBf, StaticOrder, true, true>(lds, g, S, E);
            }
        PH_END
        PH_BEGIN
            residual_phase(p, (const bf16_t*)(ws + WS_MOUT), nullptr, nullptr, layer == 0, layer, 2, p.in[7] + layer * 1024, true, p.in[8] + layer * 1024, layer, 3, layer == 1, Ml, gw, NGW, lane, lds, layer == 0 ? (const float*)(ws + WS_P) : nullptr, 8);
            __syncthreads();
            if (layer == 0) convert_layer_weights(p, 1, lds, gw, NGW, wave, lane);
            else convert_moe_weights(p, lds, gw, NGW, wave, lane);
        PH_END
        if (layer == 0) {
            PH_BEGIN
                Gemm g{(const bf16_t*)(ws + WS_XN), (const bf16_t*)(ws + WS_FGU), NTOK, 2 * D_FF, opq(1024), 1024}; StaticOrder S; S.init(NTOK, 2 * D_FF, G, bid);
                EpiSwiglu E{(bf16_t*)(ws + WS_HID), D_FF, 1 << 20, 0};
                gemm_phase<EpiSwiglu, StaticOrder, true, true>(lds, g, S, E);
            PH_END
            PH_BEGIN
                Gemm g{(const bf16_t*)(ws + WS_HID), (const bf16_t*)(ws + WS_FD), NTOK, 1024, opq(D_FF), D_FF};
                TailSched S; S.init(NLAT, 1024, G, bid, (NTOK - NLAT) / 256, 4, D_FF / 256);
                EpiBfTail E{(bf16_t*)(ws + WS_MF), 1024, (float*)(ws + WS_P + 92 * MiB), NLAT, NTOK - NLAT};
                gemm_phase<EpiBfTail, TailSched, true, true>(lds, g, S, E);
            PH_END
            PH_BEGIN
                residual_phase(p, (const bf16_t*)(ws + WS_MF), nullptr, nullptr, false, 0, 5, p.in[9], true, p.in[6] + 1024, 1, 0, false, NTOK, gw, NGW, lane, nullptr, (const float*)(ws + WS_P + 92 * MiB), D_FF / 256);
            PH_END
        }
    }
    {
        {
            PH_BEGIN
                const unsigned* cnt = (const unsigned*)(ws + WS_CTL) + CW_CNT; int ts[9]; ts[0] = 0;
#pragma unroll
                for (int e = 0; e < 8; ++e) ts[e + 1] = ts[e] + (int)((__hip_atomic_load(cnt + e, __ATOMIC_RELAXED, __HIP_MEMORY_SCOPE_AGENT) + 255u) >> 8);
                const int* LIST = (const int*)(ws + WS_LIST); const bf16_t* XN = (const bf16_t*)(ws + WS_XN2); bf16_t* XG = (bf16_t*)(ws + WS_XG);
                for (int r = gw; r < ts[8] * 256; r += NGW) {
                    const int tile = r >> 8; int e = 0;
#pragma unroll
                    for (int q = 1; q < 8; ++q) e += (tile >= ts[q]) ? 1 : 0;
                    int tse = 0;
#pragma unroll
                    for (int q = 0; q < 8; ++q) tse = (q == e) ? ts[q] : tse;
                    const int slot = r - tse * 256;
                    u32x4 v0 = (u32x4){0u, 0u, 0u, 0u}, v1 = v0;
                    if (slot < (int)cnt[e]) { const int tk = LIST[e * 16384 + slot]; const u32x4* src = (const u32x4*)(XN + (size_t)(tk >> 1) * 1024); v0 = src[lane]; v1 = src[lane + 64]; }
                    u32x4* dst = (u32x4*)(XG + (size_t)r * 1024); dst[lane] = v0; dst[lane + 64] = v1;
                }
            PH_END
            PH_BEGIN
                const unsigned* cnt = (const unsigned*)(ws + WS_CTL) + CW_CNT; int ts[9]; ts[0] = 0;
#pragma unroll
                for (int e = 0; e < 8; ++e) ts[e + 1] = ts[e] + (int)((__hip_atomic_load(cnt + e, __ATOMIC_RELAXED, __HIP_MEMORY_SCOPE_AGENT) + 255u) >> 8);
                MoeSched S;
#pragma unroll
                for (int e = 0; e < 9; ++e) S.ts[e] = ts[e];
                S.pm_lo = 0; S.pm_hi = ts[8]; S.npn = 28; S.G = G; S.c = bid; S.a_local = false;
                Gemm g{(const bf16_t*)(ws + WS_XG), (const bf16_t*)(ws + WS_MGU), 0, 0, opq(1024), 1024};
                EpiSwiglu E{(bf16_t*)(ws + WS_HIDM), D_FFE, 28, 0};
                gemm_phase<EpiSwiglu, MoeSched, true, true>(lds, g, S, E);
            PH_END
            PH_BEGIN
                const unsigned* cnt = (const unsigned*)(ws + WS_CTL) + CW_CNT; int ts[9]; ts[0] = 0;
#pragma unroll
                for (int e = 0; e < 8; ++e) ts[e + 1] = ts[e] + (int)((__hip_atomic_load(cnt + e, __ATOMIC_RELAXED, __HIP_MEMORY_SCOPE_AGENT) + 255u) >> 8);
                MoeSched S;
#pragma unroll
                for (int e = 0; e < 9; ++e) S.ts[e] = ts[e];
                S.pm_lo = 0; S.pm_hi = ts[8]; S.npn = 4; S.G = G; S.c = bid; S.a_local = false;
                Gemm g{(const bf16_t*)(ws + WS_HIDM), (const bf16_t*)(ws + WS_MD), 0, 0, opq(D_FFE), D_FFE};
                EpiMoeDown E; E.FS = (bf16_t*)(ws + WS_FACC); E.slot1_off = ((long)WS_MGU - (long)WS_FACC) / 2; E.LIST = (const int*)(ws + WS_LIST); E.WTS = (const float*)(ws + WS_WTS); E.cnt = cnt; E.pm_lo = 0;
#pragma unroll
                for (int e = 0; e < 9; ++e) E.ts[e] = ts[e];
                gemm_phase<EpiMoeDown, MoeSched, true, true>(lds, g, S, E);
            PH_END
            PH_BEGIN
                residual_phase(p, (const bf16_t*)(ws + WS_FACC), (const bf16_t*)(ws + WS_MGU), nullptr, false, 1, 5, p.in[9] + 1024, false, nullptr, 0, 0, false, NLAT, gw, NGW, lane);
            PH_END
        }
    }
    if ((PROBE_MASK | PROBE_MASK2) != 0ull && blockIdx.x == 0 && threadIdx.x == 0) {
        LAS unsigned long long* pt_ = (LAS unsigned long long*)(lds + LDS_PARAMS + 320);
        const unsigned long long t0_ = pt_[0], want_ = PROBE_MULT * pt_[1];
        while (__builtin_amdgcn_s_memrealtime() - t0_ < want_) __builtin_amdgcn_s_sleep(32);
    }
#undef PH_BEGIN
#undef PH_END
}

extern "C" void kernel_launch(void* const* d_in, const int* in_sizes, int n_in, void* d_out, int out_size, void* d_ws, size_t ws_size, hipStream_t stream) {
    static int grid = 0;
    if (grid == 0) {
        if (n_in != 37 || out_size != NLAT * DM || ws_size < WS_NEED) { fprintf(stderr, "kernel_launch: unexpected shapes (n_in %d out %d ws %zu need %zu)\n", n_in, out_size, ws_size, (size_t)WS_NEED); grid = -1; return; }
        int dev = 0, cus = 0, per_cu = 0;
        (void)hipGetDevice(&dev);
        (void)hipDeviceGetAttribute(&cus, hipDeviceAttributeMultiprocessorCount, dev);
        (void)hipFuncSetAttribute((const void*)mk_fwd, hipFuncAttributeMaxDynamicSharedMemorySize, LDS_BYTES);
        (void)hipOccupancyMaxActiveBlocksPerMultiprocessor(&per_cu, (const void*)mk_fwd, NTHREADS, LDS_BYTES);
        if (per_cu < 1) { fprintf(stderr, "kernel_launch: occupancy query reports %d blocks per CU\n", per_cu); grid = -1; return; }
        grid = cus;
        fprintf(stderr, "kernel_launch: grid %d (cus %d, per_cu %d), ws %zu\n", grid, cus, per_cu, ws_size);
    }
    if (grid < 0) return;
    (void)hipMemsetAsync((char*)d_ws + WS_CTL, 0, CTL_BYTES, stream);
    Params prm{};
    for (int i = 0; i < 37; ++i) prm.in[i] = (const float*)d_in[i];
    prm.out = (float*)d_out; prm.ws = (unsigned char*)d_ws;
#if MK_MULTI
    for (int ph = 0; ph < N_PHASES; ++ph) { prm.ph_lo = ph; prm.ph_hi = ph + 1; hipLaunchKernelGGL(mk_fwd, dim3(grid), dim3(NTHREADS), LDS_BYTES, stream, prm); }
#else
    prm.ph_lo = 0; prm.ph_hi = 1 << 20;
    void* args[] = {&prm};
    hipError_t e = hipLaunchCooperativeKernel((const void*)mk_fwd, dim3(grid), dim3(NTHREADS), args, LDS_BYTES, stream);
    if (e != hipSuccess) fprintf(stderr, "kernel_launch: cooperative launch failed: %s (grid %d)\n", hipGetErrorString(e), grid);
#endif
}
```

```cpp
#include <hip/hip_runtime.h>
#include <hip/hip_cooperative_groups.h>
#include <cstdio>
#include <cstdint>
namespace cg = cooperative_groups;
namespace pg8 {
#define PG8_LAS __attribute__((address_space(3)))
typedef unsigned short bf16_t;
typedef short bf16x8 __attribute__((ext_vector_type(8)));
typedef float f32x4 __attribute__((ext_vector_type(4)));
typedef unsigned u32x4 __attribute__((ext_vector_type(4)));
constexpr int BM = 256, BK = 64, HALF = 128, HTB = HALF * BK * 2  , STAGE_BYTES = 8 * HTB, NXCD = 8, WGM = 8;

__host__ __device__ __forceinline__ int lds_byte(int r, int c) { const int st = (r >> 4) * 2 + (c >> 5), rr = r & 15, cc = c & 31, ob = rr * 64 + cc * 2; return st * 1024 + (ob ^ (((ob >> 9) & 1) << 5)); }
__host__ __device__ __forceinline__ void stage_rc(int b, int& R, int& C) { const int st = b / 1024, sb = b % 1024, swz = sb ^ (((sb >> 9) & 1) << 5); R = (st >> 1) * 16 + swz / 64; C = (st & 1) * 32 + (swz % 64) / 2; }
__host__ __device__ __forceinline__ int perm32(int rho) { const int n = rho >> 4, i = rho & 15; return 8 * (i >> 2) + 4 * n + (i & 3); }

struct Unit { int pm, pn, koff, tail, kt; };
struct Gemm { const bf16_t* A; const bf16_t* Bt; int M, N, K, ld; };

struct StaticOrder {
    int nM, nN, nwg, G, c;
    __host__ __device__ void init(int M, int N, int G_, int c_) { nM = M / BM; nN = N / BM; nwg = nM * nN; G = G_; c = c_; }
    __host__ __device__ bool next(int i, Unit& u) const {
        const long L = (long)i * G + c; if (L >= nwg) return false;
        int wgid = (int)L; { const int q = nwg / NXCD, r = nwg % NXCD, xcd = wgid % NXCD, off = wgid / NXCD; wgid = (xcd < r ? xcd * (q + 1) : r * (q + 1) + (xcd - r) * q) + off; }
        const int nig = WGM * nN, gid = wgid / nig, fm = gid * WGM, gsz = (nM - fm) < WGM ? (nM - fm) : WGM;
        u.pm = fm + ((wgid % nig) % gsz); u.pn = (wgid % nig) / gsz; u.koff = 0; u.tail = -1; u.kt = 0; return true;
    }
    __device__ __forceinline__ void a_ready(const Unit&) const {}
    __device__ __forceinline__ void done(const Unit&) const {}
};

__device__ __forceinline__ unsigned cvt_pk_bf16(float lo, float hi) { unsigned r; asm volatile("v_cvt_pk_bf16_f32 %0, %1, %2" : "=v"(r) : "v"(lo), "v"(hi)); return r; }
typedef float f32x2 __attribute__((ext_vector_type(2)));
template <class Epi, class Sched, bool ALIGN_EPI = false, bool SP2 = false>
__device__ __forceinline__ void gemm_phase(PG8_LAS unsigned char* lds, const Gemm g, const Sched& S, const Epi& E) {
    int tid_ = threadIdx.x; asm volatile("" : "+v"(tid_)); const int tid = tid_, wid = __builtin_amdgcn_readfirstlane(tid >> 6), lane = tid & 63, wr = wid >> 2, wc = wid & 3, fr = lane & 15, fq = lane >> 4;
    const int K = g.ld, nt = g.K / BK;
    unsigned voffA[2], voffB[2];
#pragma unroll
    for (int i = 0; i < 2; ++i) { int R, C; stage_rc(tid * 16 + i * 8192, R, C); const int Rb = Epi::PERM ? ((R & ~31) + perm32(R & 31)) : R;
        voffA[i] = (unsigned)(R * K + C) * 2u; voffB[i] = (unsigned)(Rb * K + C) * 2u; }
    const size_t kstep = (size_t)(BK * 2);
    const size_t hstep = (size_t)HALF * K * 2;
    const size_t tstep = 2 * hstep;
    const unsigned ldsw = (unsigned)wid * 1024u;
    const int aoff = lds_byte(wr * 64 + fr, fq * 8), boff = lds_byte(wc * 32 + fr, fq * 8);
#define PG8_SA(b, h) (((b) * 2 + (h)) * HTB)
#define PG8_SB(b, h) ((4 + (b) * 2 + (h)) * HTB)
#define PG8_STAGE(bufoff, gbase, voff) do { _Pragma("unroll") for (int _i = 0; _i < 2; ++_i) \
        __builtin_amdgcn_global_load_lds((const unsigned*)((const char*)(gbase) + (voff)[_i]), (PG8_LAS unsigned*)(lds + (bufoff) + ldsw + _i * 8192), 16, 0, 0); } while (0)
#define PG8_LDA(dst, b, h) do { _Pragma("unroll") for (int m = 0; m < 4; ++m) _Pragma("unroll") for (int k = 0; k < 2; ++k) dst[m][k] = *(const PG8_LAS bf16x8*)(lds + PG8_SA(b, h) + aoff + m * 2048 + k * 1024); } while (0)
#define PG8_LDB(dst, b, h) do { _Pragma("unroll") for (int n = 0; n < 2; ++n) _Pragma("unroll") for (int k = 0; k < 2; ++k) dst[n][k] = *(const PG8_LAS bf16x8*)(lds + PG8_SB(b, h) + boff + n * 2048 + k * 1024); } while (0)
#define PG8_MMA(ai, bj, At, Bt) do { __builtin_amdgcn_s_setprio(1); _Pragma("unroll") for (int m = 0; m < 4; ++m) _Pragma("unroll") for (int n = 0; n < 2; ++n) _Pragma("unroll") for (int k = 0; k < 2; ++k) \
        acc[ai][bj][m][n] = __builtin_amdgcn_mfma_f32_16x16x32_bf16(Bt[n][k], At[m][k], acc[ai][bj][m][n], 0, 0, 0); __builtin_amdgcn_s_setprio(0); } while (0)
#define PG8_WAIT_V(n) asm volatile("s_waitcnt vmcnt(" #n ")" ::: "memory")
#define PG8_WAIT_L(n) asm volatile("s_waitcnt lgkmcnt(" #n ")" ::: "memory")
#define PG8_BAR __builtin_amdgcn_s_barrier()
#define PG8_SCHED __builtin_amdgcn_sched_barrier(0)
    Unit cur, nxt; int ui = 0;
    if (!S.next(0, cur)) return;
    f32x4 acc[2][2][4][2];
#pragma unroll
    for (int a = 0; a < 2; ++a)
#pragma unroll
        for (int b = 0; b < 2; ++b)
#pragma unroll
            for (int m = 0; m < 4; ++m)
#pragma unroll
                for (int n = 0; n < 2; ++n) acc[a][b][m][n] = (f32x4){0.f, 0.f, 0.f, 0.f};
    bf16x8 At[4][2], B0[2][2], B1[2][2];
    const char* cA = (const char*)g.A + (size_t)cur.pm * tstep + (size_t)cur.koff * 2; const char* cB = (const char*)g.Bt + (size_t)cur.pn * tstep + (size_t)cur.koff * 2;
    S.a_ready(cur);
    if constexpr (SP2) {
        PG8_STAGE(PG8_SB(0, 0), cB, voffB); PG8_STAGE(PG8_SB(0, 1), cB + hstep, voffB); PG8_STAGE(PG8_SA(0, 0), cA, voffA); PG8_STAGE(PG8_SA(0, 1), cA + hstep, voffA);
        if (wr == 1) PG8_BAR;
        PG8_WAIT_V(2); PG8_BAR;
        PG8_STAGE(PG8_SB(1, 0), cB + kstep, voffB); PG8_STAGE(PG8_SA(1, 0), cA + kstep, voffA); PG8_STAGE(PG8_SB(1, 1), cB + hstep + kstep, voffB);
        PG8_WAIT_V(6); PG8_BAR;
    } else {
        PG8_STAGE(PG8_SB(0, 0), cB, voffB); PG8_STAGE(PG8_SA(0, 0), cA, voffA); PG8_STAGE(PG8_SB(0, 1), cB + hstep, voffB); PG8_STAGE(PG8_SA(0, 1), cA + hstep, voffA);
        if (wr == 1) PG8_BAR;
        PG8_WAIT_V(4); PG8_BAR;
        PG8_STAGE(PG8_SB(1, 0), cB + kstep, voffB); PG8_STAGE(PG8_SA(1, 0), cA + kstep, voffA); PG8_STAGE(PG8_SB(1, 1), cB + hstep + kstep, voffB);
        PG8_WAIT_V(6); PG8_BAR;
    }
    for (;;) {
        const bool has_next = S.next(ui + 1, nxt);
        const char* nA = has_next ? (const char*)g.A + (size_t)nxt.pm * tstep + (size_t)nxt.koff * 2 : cA; const char* nB = has_next ? (const char*)g.Bt + (size_t)nxt.pn * tstep + (size_t)nxt.koff * 2 : cB;
        const int ntc = cur.kt ? cur.kt : nt;
        for (int t = 0; t < ntc; t += 2) {
            const bool last = (t == ntc - 2);
            const char* a1 = cA + (size_t)(t + 1) * kstep;
            const char* a2 = last ? nA : cA + (size_t)(t + 2) * kstep; const char* b2 = last ? nB : cB + (size_t)(t + 2) * kstep;
            const char* a3 = a2 + kstep; const char* b3 = b2 + kstep;
            if (last && has_next) S.a_ready(nxt);
            if constexpr (SP2) {
            PG8_LDB(B0, 0, 0); PG8_LDB(B1, 0, 1); PG8_SCHED; PG8_LDA(At, 0, 0); PG8_STAGE(PG8_SA(1, 1), a1 + hstep, voffA);
            PG8_WAIT_V(8); PG8_WAIT_L(0); PG8_BAR; PG8_MMA(0, 0, At, B0); PG8_MMA(0, 1, At, B1); PG8_BAR; PG8_SCHED;
            PG8_LDA(At, 0, 1); PG8_STAGE(PG8_SB(0, 0), b2, voffB); PG8_STAGE(PG8_SB(0, 1), b2 + hstep, voffB); PG8_STAGE(PG8_SA(0, 0), a2, voffA);
            PG8_WAIT_V(8); PG8_WAIT_L(0); PG8_BAR; PG8_MMA(1, 0, At, B0); PG8_MMA(1, 1, At, B1); PG8_BAR; PG8_SCHED;
            PG8_LDB(B0, 1, 0); PG8_LDB(B1, 1, 1); PG8_SCHED; PG8_LDA(At, 1, 0); PG8_STAGE(PG8_SA(0, 1), a2 + hstep, voffA);
            PG8_WAIT_V(8); PG8_WAIT_L(0); PG8_BAR; PG8_MMA(0, 0, At, B0); PG8_MMA(0, 1, At, B1); PG8_BAR; PG8_SCHED;
            PG8_LDA(At, 1, 1); PG8_STAGE(PG8_SB(1, 0), b3, voffB); PG8_STAGE(PG8_SB(1, 1), b3 + hstep, voffB); PG8_STAGE(PG8_SA(1, 0), a3, voffA);
            PG8_WAIT_V(8); PG8_WAIT_L(0); PG8_BAR; PG8_MMA(1, 0, At, B0); PG8_MMA(1, 1, At, B1); PG8_BAR; PG8_SCHED;
            } else {
            PG8_LDB(B0, 0, 0); PG8_SCHED; PG8_LDA(At, 0, 0); PG8_STAGE(PG8_SA(1, 1), a1 + hstep, voffA);
            PG8_WAIT_L(8); PG8_BAR; PG8_WAIT_L(0); PG8_MMA(0, 0, At, B0); PG8_BAR; PG8_SCHED;
            PG8_LDB(B1, 0, 1); PG8_STAGE(PG8_SB(0, 0), b2, voffB);
            PG8_BAR; PG8_WAIT_L(0); PG8_MMA(0, 1, At, B1); PG8_BAR;
            PG8_LDA(At, 0, 1); PG8_STAGE(PG8_SA(0, 0), a2, voffA);
            PG8_BAR; PG8_WAIT_L(0); PG8_MMA(1, 0, At, B0); PG8_BAR; PG8_SCHED;
            PG8_STAGE(PG8_SB(0, 1), b2 + hstep, voffB);
            PG8_WAIT_V(6); PG8_BAR; PG8_MMA(1, 1, At, B1); PG8_BAR;
            PG8_LDB(B0, 1, 0); PG8_SCHED; PG8_LDA(At, 1, 0); PG8_STAGE(PG8_SA(0, 1), a2 + hstep, voffA);
            PG8_WAIT_L(8); PG8_BAR; PG8_WAIT_L(0); PG8_MMA(0, 0, At, B0); PG8_BAR; PG8_SCHED;
            PG8_LDB(B1, 1, 1); PG8_STAGE(PG8_SB(1, 0), b3, voffB);
            PG8_BAR; PG8_WAIT_L(0); PG8_MMA(0, 1, At, B1); PG8_BAR;
            PG8_LDA(At, 1, 1); PG8_STAGE(PG8_SA(1, 0), a3, voffA);
            PG8_BAR; PG8_WAIT_L(0); PG8_MMA(1, 0, At, B0); PG8_BAR; PG8_SCHED;
            PG8_STAGE(PG8_SB(1, 1), b3 + hstep, voffB);
            PG8_WAIT_V(6); PG8_BAR; PG8_MMA(1, 1, At, B1); PG8_BAR;
            }
        }
        if constexpr (ALIGN_EPI) { if (wr == 0) PG8_BAR; }
        if constexpr (!Epi::AFTER_DRAIN) { E(acc, cur, wr, wc, fr, fq); S.done(cur); }
        if (!has_next) break;
#pragma unroll
        for (int a = 0; a < 2; ++a)
#pragma unroll
            for (int b = 0; b < 2; ++b)
#pragma unroll
                for (int m = 0; m < 4; ++m)
#pragma unroll
                    for (int n = 0; n < 2; ++n) acc[a][b][m][n] = (f32x4){0.f, 0.f, 0.f, 0.f};
        cur = nxt; cA = nA; cB = nB; ++ui;
        if constexpr (ALIGN_EPI) { if (wr == 1) PG8_BAR; }
    }
    PG8_WAIT_V(0);
    if constexpr (!ALIGN_EPI) { if (wr == 0) PG8_BAR; }
    PG8_BAR;
    if constexpr (Epi::AFTER_DRAIN) { E.fused(acc, cur, wr, wc, fr, fq, lds, wid, lane); S.done(cur); }
#undef PG8_SA
#undef PG8_SB
#undef PG8_STAGE
#undef PG8_LDA
#undef PG8_LDB
#undef PG8_MMA
#undef PG8_WAIT_V
#undef PG8_WAIT_L
#undef PG8_BAR
#undef PG8_SCHED
}
}

#define LAS __attribute__((address_space(3)))
typedef unsigned short bf16_t;
typedef short bf16x8 __attribute__((ext_vector_type(8)));
typedef float f32x4 __attribute__((ext_vector_type(4)));
typedef float f32x16 __attribute__((ext_vector_type(16)));
typedef unsigned u32x4 __attribute__((ext_vector_type(4)));
typedef unsigned u32x2 __attribute__((ext_vector_type(2)));

constexpr int NTHREADS = 512, NWAVES = 8;
constexpr int DM = 1024, SEQ = 8192, CTXL = 256, NLAT = 2 * SEQ, NCTX = 2 * CTXL, NTOK = NLAT + NCTX, KEYS = SEQ + CTXL;
constexpr int D_IN = 7296, D_FF = 2816, D_FFE = 3584, NEXP = 8;
constexpr int IC_QS = 0, IC_KS = 512, IC_RW = 640, IC_QD = 2560, IC_KD = 3072, PP = 3584, IC_VS = 3584, IC_VD = 3712, IC_PAD = 4224, NIN1 = 4352, WIN_ROWS = 7424;
constexpr int ST_SLOTS = 8;
constexpr int SL_W0 = 0, SL_A0 = 1, SL_KK = 2, SL_R = 3, SL_V = 4, SL_K = 5, SL_W1 = 6, SL_A1 = 7;
constexpr int MOE_TILES = 136, MOE_HALF = 68;

constexpr size_t MiB = 1u << 20;
constexpr size_t WS_CTL = 0, CTL_BYTES = 1 * MiB;
constexpr size_t WS_MODS = 1 * MiB;
constexpr size_t WS_ROPE = 1 * MiB + 256 * 1024;
constexpr size_t WS_HCTX = 2 * MiB;
constexpr size_t WS_LIST = 4 * MiB;
constexpr size_t WS_WTS = 4 * MiB + 512 * 1024;
constexpr size_t WS_WIN = 6 * MiB;
constexpr size_t WS_PRJ = WS_WIN + (size_t)WIN_ROWS * 1024 * 2;
constexpr size_t WS_WOUT = WS_PRJ + 3 * MiB;
constexpr size_t WS_LORA = WS_WOUT + 2 * MiB;
constexpr size_t WS_XN = 28 * MiB;
constexpr size_t WS_P = 61 * MiB;
constexpr size_t WS_VTS = 177 * MiB;
constexpr size_t WS_VTD = WS_VTS + 4608 * 1024;
constexpr size_t WS_ST = 198 * MiB;
constexpr size_t WS_YA = 495 * MiB;
constexpr size_t WS_YB = WS_YA + 16896ull * 512 * 2;
constexpr size_t WS_YC = WS_YB + 16896ull * 512 * 2;
constexpr size_t WS_END = WS_YC + 16896ull * 512 * 2;
constexpr size_t WS_G = WS_ST;
constexpr size_t WS_MF = WS_ST + 99 * MiB;
constexpr size_t WS_MB = WS_ST + 165 * MiB;
constexpr size_t WS_MOUT = WS_ST + 198 * MiB;
constexpr size_t WS_FGU = WS_VTS;
constexpr size_t WS_FD = WS_VTS + 11 * MiB;
constexpr size_t WS_HID = WS_P;
constexpr size_t WS_XN2 = 495 * MiB;
constexpr size_t WS_MGU = 6 * MiB;
constexpr size_t WS_MD = 118 * MiB;
constexpr size_t WS_XG = 174 * MiB;
constexpr size_t WS_FACC = 242 * MiB;
constexpr size_t WS_HIDM = 306 * MiB;
static_assert(WS_LORA + 2560 * 384 * 2 <= WS_XN && WS_XN + 16896ull * 1024 * 2 <= WS_P && WS_P + 16896ull * PP * 2 <= WS_VTS && WS_VTD + 2ull * 4 * 128 * KEYS * 2 <= WS_ST, "ws map 1");
static_assert(WS_ST + 16896ull * 8 * ST_SLOTS * 64 * 4 <= WS_YA && WS_END <= 545 * MiB, "ws map 2");
static_assert(WS_G + 16896ull * 3072 * 2 <= WS_MF && WS_MF + 16896ull * 1024 * 4 <= WS_MB && WS_MB + 16896ull * 1024 * 2 <= WS_MOUT && WS_MOUT + 16896ull * 1024 * 4 <= WS_YA, "ws map 3");
static_assert(WS_FGU + 5632ull * 1024 * 2 <= WS_FD && WS_FD + 1024ull * 2816 * 2 <= WS_ST && WS_HID + 16896ull * 2816 * 2 <= WS_VTS, "ws map 4");
static_assert(WS_MGU + 8ull * 7168 * 1024 * 2 <= WS_MD && WS_MD + 8ull * 1024 * 3584 * 2 <= WS_XG && WS_XG + 34816ull * 1024 * 2 <= WS_FACC && WS_FACC + 16384ull * 1024 * 4 <= WS_HIDM && WS_HIDM + 136ull * 256 * 3584 * 2 <= 560 * MiB, "ws map 5");
static_assert(WS_FACC + 16384ull * 1024 * 4 <= WS_MOUT && WS_XN2 + 16384ull * 1024 * 2 <= 560 * MiB && WS_XN2 >= WS_MOUT + 16896ull * 1024 * 4, "expert weights / gathered rows / accumulator must not touch MOUT or XN2 while they are live");
constexpr size_t WS_NEED = 560 * MiB;
constexpr int CW_CNT = 0;
constexpr int CW_Q0 = 64, CW_Q1 = 128;

constexpr int LDS_BYTES = 147456;

__device__ __forceinline__ unsigned f2bf(float f) { unsigned u = __builtin_bit_cast(unsigned, f); return (u + 0x7fffu + ((u >> 16) & 1u)) >> 16; }
typedef float f32x2_t __attribute__((ext_vector_type(2))); typedef __bf16 bf16x2_t __attribute__((ext_vector_type(2)));
__device__ __forceinline__ unsigned pk2(float lo, float hi) { const f32x2_t v = {lo, hi}; return __builtin_bit_cast(unsigned, __builtin_convertvector(v, bf16x2_t)); }
__device__ __forceinline__ float bflo(unsigned w) { return __uint_as_float(w << 16); }
__device__ __forceinline__ float bfhi(unsigned w) { return __uint_as_float(w & 0xffff0000u); }
__device__ __forceinline__ float wave_sum(float v) {
#pragma unroll
    for (int o = 1; o < 64; o <<= 1) v += __shfl_xor(v, o);
    return v;
}
__device__ __forceinline__ float sigmoidf_(float x) { return __builtin_amdgcn_rcpf(1.0f + __expf(-x)); }
__device__ __forceinline__ float siluf_(float x) { return x * __builtin_amdgcn_rcpf(1.0f + __expf(-x)); }
#define LDS_WAIT() asm volatile("s_waitcnt lgkmcnt(0)" ::: "memory")

struct Params {
    const float* in[37];
    float* out;
    unsigned char* ws;
    int ph_lo, ph_hi;
};

template <class F>
__device__ __forceinline__ void transpose_item(const float* __restrict__ W, int ldw, int k0, int n0, bf16_t* __restrict__ WT, int ldt, int dcol0, F rowmap, LAS float* scr, int lane) {
    f32x4 ld[8];
    { const float* src = W + (size_t)(k0 + (lane >> 3)) * ldw + n0 + 4 * (lane & 7);
#pragma unroll
      for (int j = 0; j < 8; ++j) ld[j] = *(const f32x4*)(src + (size_t)(8 * j) * ldw); }
#pragma unroll
    for (int j = 0; j < 8; ++j) { LAS float* d = scr + (8 * j + (lane >> 3)) * 33 + 4 * (lane & 7); d[0] = ld[j].x; d[1] = ld[j].y; d[2] = ld[j].z; d[3] = ld[j].w; }
    LDS_WAIT(); asm volatile("" ::: "memory");
    const int c = lane & 7;
#pragma unroll
    for (int j = 0; j < 4; ++j) {
        const int n = (lane >> 3) + 8 * j; const LAS float* s = scr + (8 * c) * 33 + n;
        u32x4 o; o.x = pk2(s[0 * 33], s[1 * 33]); o.y = pk2(s[2 * 33], s[3 * 33]); o.z = pk2(s[4 * 33], s[5 * 33]); o.w = pk2(s[6 * 33], s[7 * 33]);
        const int row = rowmap(n0 + n);
        if (row >= 0) *(u32x4*)(WT + (size_t)row * ldt + dcol0 + k0 + 8 * c) = o;
    }
    LDS_WAIT(); asm volatile("" ::: "memory");
}
struct RowId { __device__ __forceinline__ int operator()(int n) const { return n; } };
struct RowOff { int off; __device__ __forceinline__ int operator()(int n) const { return n + off; } };
struct RowWin {
    __device__ __forceinline__ int operator()(int n) const {
        if (n < 640) return n;
        if (n < 768) return n - 640 + IC_VS;
        if (n < 2688) return n - 768 + IC_RW;
        if (n < 3712) return n - 2688 + IC_QD;
        if (n < 4224) return n - 3712 + IC_VD;
        return n - 4224 + NIN1;
    }
};
struct RowGU { int up; __device__ __forceinline__ int operator()(int j) const { return (j >> 7) * 256 + (j & 127) + 128 * up; } };

template <class F>
__device__ __forceinline__ void convert_matrix(const float* W, int K, int N, bf16_t* WT, int ldt, int dcol0, F rowmap, LAS float* scr, int lane, int gw, int NGW) {
    const int nblk = N / 32, items = (K / 64) * nblk;
    for (int it = gw; it < items; it += NGW) { const int kb = it / nblk, nb = it % nblk; transpose_item(W, N, kb * 64, nb * 32, WT, ldt, dcol0, rowmap, scr, lane); }
}

__device__ __forceinline__ void lora_region(bf16_t* __restrict__ LT, const float* __restrict__ src, int row0, int klo, int kn, int gw, int NGW, int lane) {
    for (int i = gw * 64 + lane; i < 512 * 48; i += NGW * 64) {
        const int nn = i / 48, kc = (i % 48) * 8;
        u32x4 o = (u32x4){0u, 0u, 0u, 0u};
        if (kc >= klo && kc < klo + kn) {
            const float* s = src + (size_t)(kc - klo) * 512 + nn;
            o.x = pk2(s[0], s[512]); o.y = pk2(s[2 * 512], s[3 * 512]); o.z = pk2(s[4 * 512], s[5 * 512]); o.w = pk2(s[6 * 512], s[7 * 512]);
        }
        *(u32x4*)(LT + (size_t)(row0 + nn) * 384 + kc) = o;
    }
}
__device__ __forceinline__ void convert_layer_weights(const Params& p, int layer, LAS unsigned char* lds, int gw, int NGW, int wave, int lane) {
    LAS float* scr = (LAS float*)(lds + wave * 16384);
    unsigned char* ws = p.ws;
    bf16_t* WIN = (bf16_t*)(ws + WS_WIN);
    convert_matrix(p.in[10] + (size_t)layer * 1024 * D_IN, 1024, D_IN, WIN, 1024, 0, RowWin(), scr, lane, gw, NGW);
    for (int i = gw * 64 + lane; i < (NIN1 - IC_PAD) * 1024 / 8; i += NGW * 64) *(u32x4*)(WIN + (size_t)IC_PAD * 1024 + (size_t)i * 8) = (u32x4){0u, 0u, 0u, 0u};
    for (int j = 0; j < 3; ++j)
        convert_matrix(p.in[26 + j] + (size_t)layer * 512 * 1024, 512, 1024, (bf16_t*)(ws + WS_PRJ) + (size_t)j * 1024 * 512, 512, 0, RowId(), scr, lane, gw, NGW);
    convert_matrix(p.in[29] + (size_t)layer * 1024 * 1024, 1024, 1024, (bf16_t*)(ws + WS_WOUT), 1024, 0, RowId(), scr, lane, gw, NGW);
    bf16_t* LT = (bf16_t*)(ws + WS_LORA);
    lora_region(LT, p.in[15] + ((size_t)layer * 2 + 0) * 64 * 512, 0, 0, 64, gw, NGW, lane);
    lora_region(LT, p.in[15] + ((size_t)layer * 2 + 1) * 64 * 512, 512, 64, 64, gw, NGW, lane);
    lora_region(LT, p.in[17] + ((size_t)layer * 2 + 0) * 64 * 512, 1024, 128, 64, gw, NGW, lane);
    lora_region(LT, p.in[17] + ((size_t)layer * 2 + 1) * 64 * 512, 1536, 192, 64, gw, NGW, lane);
    lora_region(LT, p.in[18] + (size_t)layer * 128 * 512, 2048, 256, 128, gw, NGW, lane);
}
__device__ __forceinline__ void convert_ffn_weights(const Params& p, LAS unsigned char* lds, int gw, int NGW, int wave, int lane) {
    LAS float* scr = (LAS float*)(lds + wave * 16384);
    bf16_t* GU = (bf16_t*)(p.ws + WS_FGU); bf16_t* FD = (bf16_t*)(p.ws + WS_FD);
    convert_matrix(p.in[30], 1024, D_FF, GU, 1024, 0, RowGU{0}, scr, lane, gw, NGW);
    convert_matrix(p.in[31], 1024, D_FF, GU, 1024, 0, RowGU{1}, scr, lane, gw, NGW);
    convert_matrix(p.in[32], D_FF, 1024, FD, D_FF, 0, RowId(), scr, lane, gw, NGW);
}
__device__ __forceinline__ void convert_moe_weights(const Params& p, LAS unsigned char* lds, int gw, int NGW, int wave, int lane) {
    LAS float* scr = (LAS float*)(lds + wave * 16384);
    for (int e = 0; e < NEXP; ++e) {
        bf16_t* GU = (bf16_t*)(p.ws + WS_MGU) + (size_t)e * 7168 * 1024;
        convert_matrix(p.in[34] + (size_t)e * 1024 * D_FFE, 1024, D_FFE, GU, 1024, 0, RowGU{0}, scr, lane, gw, NGW);
        convert_matrix(p.in[35] + (size_t)e * 1024 * D_FFE, 1024, D_FFE, GU, 1024, 0, RowGU{1}, scr, lane, gw, NGW);
        convert_matrix(p.in[36] + (size_t)e * D_FFE * 1024, D_FFE, 1024, (bf16_t*)(p.ws + WS_MD) + (size_t)e * 1024 * D_FFE, D_FFE, 0, RowId(), scr, lane, gw, NGW);
    }
}

__device__ __forceinline__ void adaln_phase(const Params& p, LAS unsigned char* lds, int wave, int lane) {
    LAS float* red = (LAS float*)lds;
    LAS float* sc = (LAS float*)(lds + 8192);
    float* MODS = (float*)(p.ws + WS_MODS);
    const float* c = p.in[1]; const float* cc = p.in[3];
    for (int i = threadIdx.x; i < 3072; i += NTHREADS) sc[i] = siluf_(i < 2048 ? c[i] : cc[i - 2048]);
    __syncthreads();
    for (int it = blockIdx.x; it < 2 * 96; it += gridDim.x) {
        const int layer = it / 96, n = (it % 96) * 64 + lane;
        const float* W = p.in[4] + (size_t)layer * 1024 * 6144 + (size_t)(wave * 128) * 6144 + n;
        const LAS float* s0 = sc + wave * 128;
        float a0 = 0.f, a1 = 0.f, a2 = 0.f;
#pragma unroll 1
        for (int k0 = 0; k0 < 128; k0 += 16) {
            float w[16];
#pragma unroll
            for (int j = 0; j < 16; ++j) w[j] = W[(size_t)(k0 + j) * 6144];
#pragma unroll
            for (int j = 0; j < 16; j += 4) {
                const f32x4 x0 = *(const LAS f32x4*)(s0 + k0 + j), x1 = *(const LAS f32x4*)(s0 + 1024 + k0 + j), x2 = *(const LAS f32x4*)(s0 + 2048 + k0 + j);
#pragma unroll
                for (int q = 0; q < 4; ++q) { a0 += x0[q] * w[j + q]; a1 += x1[q] * w[j + q]; a2 += x2[q] * w[j + q]; }
            }
        }
        red[(wave * 3 + 0) * 64 + lane] = a0; red[(wave * 3 + 1) * 64 + lane] = a1; red[(wave * 3 + 2) * 64 + lane] = a2;
        __syncthreads();
        if (wave < 3) {
            float s = 0.f;
#pragma unroll
            for (int w = 0; w < 8; ++w) s += red[(w * 3 + wave) * 64 + lane];
            MODS[((size_t)layer * 3 + wave) * 6144 + n] = s + p.in[5][(size_t)layer * 6144 + n];
        }
        __syncthreads();
    }
    if (blockIdx.x == gridDim.x - 1) {
        float* rope = (float*)(p.ws + WS_ROPE);
        for (int i = threadIdx.x; i < 128 * 16; i += NTHREADS) {
            const int pos = i >> 4, j = i & 15;
            const float inv = powf(10000.0f, -(float)j / 16.0f);
            const float ang = (float)pos * inv;
            rope[2 * i] = cosf(ang); rope[2 * i + 1] = sinf(ang);
        }
    }
}

__device__ __forceinline__ const float* mods_row(const Params& p, int layer, int m) {
    const int r = m < NLAT ? (m >> 13) : 2;
    return (const float*)(p.ws + WS_MODS) + ((size_t)layer * 3 + r) * 6144;
}
__device__ __forceinline__ void load_row(const float* x, int lane, f32x4 (&v)[4]) {
#pragma unroll
    for (int j = 0; j < 4; ++j) v[j] = ((const f32x4*)x)[lane + 64 * j];
}
__device__ __forceinline__ float row_rstd(const f32x4 (&v)[4]) {
    float s = 0.f;
#pragma unroll
    for (int j = 0; j < 4; ++j) s += (v[j].x * v[j].x + v[j].y * v[j].y) + (v[j].z * v[j].z + v[j].w * v[j].w);
    return __builtin_amdgcn_rsqf(wave_sum(s) * (1.0f / 1024.0f) + 1e-6f);
}
__device__ __forceinline__ void normmod(const f32x4 (&h)[4], const float* g, const float* shift, const float* scale, int lane, f32x4 (&a)[4]) {
    const float rstd = row_rstd(h);
#pragma unroll
    for (int j = 0; j < 4; ++j) {
        const f32x4 gg = ((const f32x4*)g)[lane + 64 * j], sh = ((const f32x4*)shift)[lane + 64 * j], sc = ((const f32x4*)scale)[lane + 64 * j];
        a[j] = (h[j] * rstd * gg) * (sc + 1.0f) + sh;
    }
}
__device__ __forceinline__ void normmod_r(const f32x4 (&h)[4], const f32x4 (&g)[4], const f32x4 (&sh)[4], const f32x4 (&sc)[4], f32x4 (&a)[4]) {
    const float rstd = row_rstd(h);
#pragma unroll
    for (int j = 0; j < 4; ++j) a[j] = (h[j] * rstd * g[j]) * (sc[j] + 1.0f) + sh[j];
}
__device__ __forceinline__ void store_row_bf16(bf16_t* o, int lane, const f32x4 (&a)[4]) {
#pragma unroll
    for (int j = 0; j < 4; ++j) { u32x2 w; w.x = pk2(a[j].x, a[j].y); w.y = pk2(a[j].z, a[j].w); ((u32x2*)o)[lane + 64 * j] = w; }
}
__device__ __forceinline__ const float* h_in_row(const Params& p, int layer, int m) {
    if (layer == 0) return m < NLAT ? p.in[0] + (size_t)m * 1024 : p.in[2] + (size_t)(m - NLAT) * 1024;
    return m < NLAT ? p.out + (size_t)m * 1024 : (const float*)(p.ws + WS_HCTX) + (size_t)(m - NLAT) * 1024;
}
__device__ __forceinline__ float* h_out_row(const Params& p, int m) { return m < NLAT ? p.out + (size_t)m * 1024 : (float*)(p.ws + WS_HCTX) + (size_t)(m - NLAT) * 1024; }

__device__ __forceinline__ void premix_phase(const Params& p, int layer, bool first, int M, int gw, int NGW, int lane) {
    bf16_t* XN = (bf16_t*)(p.ws + WS_XN);
    f32x4 G0[4], SH[4], SC[4]; load_row(p.in[6] + layer * 1024, lane, G0);
    int cur_r = -1;
    for (int m = gw; m < M; m += NGW) {
        const float* hr = first ? h_in_row(p, 0, m) : h_out_row(p, m);
        f32x4 h[4], a[4]; load_row(hr, lane, h);
        const int r = m < NLAT ? (m >> 13) : 2;
        if (r != cur_r) { const float* md = mods_row(p, layer, m); load_row(md, lane, SH); load_row(md + 1024, lane, SC); cur_r = r; }
        normmod_r(h, G0, SH, SC, a);
        store_row_bf16(XN + (size_t)m * 1024, lane, a);
    }
}
__device__ __forceinline__ void load_row_bf16(const bf16_t* x, int lane, f32x4 (&v)[4]) {
#pragma unroll
    for (int j = 0; j < 4; ++j) { const u32x2 w = ((const u32x2*)x)[lane + 64 * j]; v[j] = (f32x4){bflo(w.x), bfhi(w.x), bflo(w.y), bfhi(w.y)}; }
}
__device__ __forceinline__ void residual_phase(const Params& p, const bf16_t* src, const bf16_t* src2, const float* hin_base_layer0, bool hin_is_input, int layer, int gate_idx, const float* g1,
                                               bool write_xn, const float* g2, int mod_layer2, int shift_idx, bool route, int M, int gw, int NGW, int lane, LAS unsigned char* lds = nullptr,
                                               const float* part = nullptr, int nsl = 0) {
    bf16_t* XN = (bf16_t*)(p.ws + (route ? WS_XN2 : WS_XN));
    LAS int* rt = (LAS int*)lds;
    LAS float* rwl = (LAS float*)(lds + 4096);
    int rt_n = 0;
    const int wv = gw & (NWAVES - 1);
    if (route) {
        const float* rw = p.in[33];
        for (int i = wv * 64 + lane; i < 8192; i += NTHREADS) rwl[(i & 7) * 1024 + (i >> 3)] = rw[i];
        __syncthreads();
    }
    f32x4 G1[4], G2[4], GT[4], SH[4], SC[4]; load_row(g1, lane, G1);
    if (write_xn) load_row(g2, lane, G2);
    int cur_r = -1;
    for (int m = gw; m < M; m += NGW) {
        const float* hr = hin_is_input ? h_in_row(p, 0, m) : h_out_row(p, m);
        { const int r = m < NLAT ? (m >> 13) : 2;
          if (r != cur_r) {
              load_row(mods_row(p, layer, m) + gate_idx * 1024, lane, GT);
              if (write_xn) { const float* md2 = mods_row(p, mod_layer2, m); load_row(md2 + shift_idx * 1024, lane, SH); load_row(md2 + (shift_idx + 1) * 1024, lane, SC); }
              cur_r = r; } }
        f32x4 h[4], s[4]; load_row(hr, lane, h);
        if (part && m >= NLAT) {
#pragma unroll
            for (int j = 0; j < 4; ++j) s[j] = (f32x4){0.f, 0.f, 0.f, 0.f};
#pragma unroll 2
            for (int sl = 0; sl < nsl; ++sl) { f32x4 t[4]; load_row(part + (size_t)(sl * 512 + (m - NLAT)) * 1024, lane, t);
#pragma unroll
                for (int j = 0; j < 4; ++j) s[j] += t[j]; }
        } else load_row_bf16(src + (size_t)m * 1024, lane, s);
        if (src2) { f32x4 s2[4]; load_row_bf16(src2 + (size_t)m * 1024, lane, s2);
#pragma unroll
            for (int j = 0; j < 4; ++j) s[j] += s2[j]; }
        const float rstd = row_rstd(s);
#pragma unroll
        for (int j = 0; j < 4; ++j) h[j] = h[j] + GT[j] * (s[j] * rstd * G1[j]);
        float* ho = h_out_row(p, m);
#pragma unroll
        for (int j = 0; j < 4; ++j) ((f32x4*)ho)[lane + 64 * j] = h[j];
        if (write_xn) {
            f32x4 a[4];
            normmod_r(h, G2, SH, SC, a);
            store_row_bf16(XN + (size_t)m * 1024, lane, a);
            if (route) {
                float lg[8] = {0.f, 0.f, 0.f, 0.f, 0.f, 0.f, 0.f, 0.f};
#pragma unroll
                for (int j = 0; j < 4; ++j)
#pragma unroll
                    for (int e = 0; e < 8; ++e) {
                        const f32x4 w = *(const LAS f32x4*)(rwl + e * 1024 + 4 * (lane + 64 * j));
                        lg[e] += a[j][0] * w.x; lg[e] += a[j][1] * w.y; lg[e] += a[j][2] * w.z; lg[e] += a[j][3] * w.w;
                    }
#pragma unroll
                for (int e = 0; e < 8; ++e) lg[e] = wave_sum(lg[e]);
                int i1 = 0; float v1 = lg[0];
#pragma unroll
                for (int e = 1; e < 8; ++e) if (lg[e] > v1) { v1 = lg[e]; i1 = e; }
                int i2 = -1; float v2 = -3.0e38f;
#pragma unroll
                for (int e = 0; e < 8; ++e) if (e != i1 && lg[e] > v2) { v2 = lg[e]; i2 = e; }
                if (lane == 0) {
                    const float w1 = 1.0f / (1.0f + expf(v2 - v1));
                    const int q = rt_n * NWAVES + wv;
                    rt[q] = m; rt[64 + q] = i1; rt[128 + q] = i2; rt[192 + q] = (int)__float_as_uint(w1);
                }
                ++rt_n;
                if (rt_n == 64 / NWAVES || m + NGW >= M) {
                    __syncthreads();
                    if (wv == 0) {
                        const int n = rt_n * NWAVES; const bool act = lane < n;
                        const int rm = act ? rt[lane] : 0, e1 = act ? rt[64 + lane] : -1, e2 = act ? rt[128 + lane] : -1; const float w1 = __uint_as_float((unsigned)rt[192 + (act ? lane : 0)]);
                        unsigned* cnt = (unsigned*)(p.ws + WS_CTL) + CW_CNT; int* LIST = (int*)(p.ws + WS_LIST); float* WTS = (float*)(p.ws + WS_WTS);
                        const unsigned long long lt = (1ull << lane) - 1ull;
                        unsigned mycount = 0u; int r1 = 0, r2 = 0, c1sel = 0;
#pragma unroll
                        for (int e = 0; e < 8; ++e) {
                            const unsigned long long b1 = __ballot(e1 == e), b2 = __ballot(e2 == e);
                            const int c1 = __popcll(b1), c2 = __popcll(b2);
                            if (lane == e) mycount = (unsigned)(c1 + c2);
                            if (e1 == e) r1 = __popcll(b1 & lt);
                            if (e2 == e) { r2 = __popcll(b2 & lt); c1sel = c1; }
                        }
                        unsigned base = 0u;
                        if (lane < 8 && mycount) base = atomicAdd(cnt + lane, mycount);
                        const unsigned bs1 = (unsigned)__shfl((int)base, e1 < 0 ? 0 : e1), bs2 = (unsigned)__shfl((int)base, e2 < 0 ? 0 : e2);
                        if (act) {
                            const unsigned s1 = bs1 + (unsigned)r1, s2 = bs2 + (unsigned)(c1sel + r2);
                            LIST[e1 * 16384 + s1] = rm * 2; WTS[e1 * 16384 + s1] = w1;
                            LIST[e2 * 16384 + s2] = rm * 2 + 1; WTS[e2 * 16384 + s2] = 1.0f - w1;
                        }
                    }
                    __syncthreads();
                    rt_n = 0;
                }
            }
        }
    }
}

using pg8::Unit;
constexpr float QSCALE = 0.125f * 1.4426950408889634f;
__device__ __forceinline__ u32x2 pack4(const f32x4 v) { u32x2 w; w.x = pk2(v.x, v.y); w.y = pk2(v.z, v.w); return w; }
__device__ __forceinline__ f32x4 unpack4(const u32x2 w) { return (f32x4){bflo(w.x), bfhi(w.x), bflo(w.y), bfhi(w.y)}; }

struct EpiIn {
    static constexpr bool PERM = false, AFTER_DRAIN = false;
    bf16_t* P; bf16_t* VTS; bf16_t* VTD; const float* rope;
    __device__ __forceinline__ void operator()(const f32x4 (&acc)[2][2][4][2], const Unit& u, int wr, int wc, int fr, int fq) const {
#pragma unroll
        for (int ai = 0; ai < 2; ++ai)
#pragma unroll
            for (int m = 0; m < 4; ++m) {
                const int r = u.pm * 256 + ai * 128 + wr * 64 + m * 16 + fr;
                const bool lat = r < NLAT;
                const int t = r & (SEQ - 1);
                const int b = lat ? (r >> 13) : ((r - NLAT) >> 8);
                const int key = lat ? t : SEQ + ((r - NLAT) & 255);
#pragma unroll
                for (int bj = 0; bj < 2; ++bj) {
                    const int c32 = u.pn * 256 + bj * 128 + wc * 32;
                    f32x4 v0 = acc[ai][bj][m][0], v1 = acc[ai][bj][m][1];
                    if (c32 < PP) {
                        const bool rp = (c32 < IC_RW) || (c32 >= IC_QD);
                        if (rp && lat) {
                            const int pos = (c32 & 32) ? (t & 63) : (t >> 6);
                            const f32x4 cs0 = *(const f32x4*)(rope + (pos * 16 + 4 * fq) * 2), cs1 = *(const f32x4*)(rope + (pos * 16 + 4 * fq) * 2 + 4);
                            const f32x4 cc = (f32x4){cs0.x, cs0.z, cs1.x, cs1.z}, sn = (f32x4){cs0.y, cs0.w, cs1.y, cs1.w};
                            const f32x4 o0 = v0 * cc - v1 * sn, o1 = v0 * sn + v1 * cc;
                            v0 = o0; v1 = o1;
                        }
                        if (c32 < IC_KS || (c32 >= IC_QD && c32 < IC_KD)) { v0 = v0 * QSCALE; v1 = v1 * QSCALE; }
                        bf16_t* dst = P + (size_t)r * PP + c32 + 4 * fq;
                        *(u32x2*)dst = pack4(v0); *(u32x2*)(dst + 16) = pack4(v1);
                    } else {
                        const int cv = c32 - PP;
                        bf16_t* vt = nullptr; int dimbase = 0;
                        if (cv < 128) { vt = VTS + (size_t)((b * 2 + (cv >> 6)) * 64) * KEYS; dimbase = cv & 63; }
                        else if (cv < 640) { const int cd = cv - 128; vt = VTD + (size_t)((b * 4 + (cd >> 7)) * 128) * KEYS; dimbase = cd & 127; }
                        if (vt) {
                            const int kp = (key & ~12) | ((key & 4) << 1) | ((key & 8) >> 1);
#pragma unroll
                            for (int i = 0; i < 4; ++i) {
                                vt[(size_t)(dimbase + 4 * fq + i) * KEYS + kp] = (bf16_t)f2bf(v0[i]);
                                vt[(size_t)(dimbase + 16 + 4 * fq + i) * KEYS + kp] = (bf16_t)f2bf(v1[i]);
                            }
                        }
                    }
                }
            }
    }
};

struct EpiLora {
    static constexpr bool PERM = false, AFTER_DRAIN = false;
    float* ST; bf16_t* P; const float* w0; const float* a0;
    __device__ __forceinline__ void operator()(const f32x4 (&acc)[2][2][4][2], const Unit& u, int wr, int wc, int fr, int fq) const {
        const int reg = u.pn >> 1;
        f32x4 biasv[2][2];
#pragma unroll
        for (int bj = 0; bj < 2; ++bj)
#pragma unroll
            for (int n = 0; n < 2; ++n) {
                const int ch = (u.pn & 1) * 256 + bj * 128 + wc * 32 + 16 * n + 4 * fq;
                biasv[bj][n] = reg < 2 ? *(const f32x4*)(w0 + reg * 512 + ch) : (reg < 4 ? *(const f32x4*)(a0 + (reg - 2) * 512 + ch) : (f32x4){0.f, 0.f, 0.f, 0.f});
            }
#pragma unroll
        for (int ai = 0; ai < 2; ++ai)
#pragma unroll
            for (int m = 0; m < 4; ++m) {
                const int r = u.pm * 256 + ai * 128 + wr * 64 + m * 16 + fr;
#pragma unroll
                for (int bj = 0; bj < 2; ++bj)
#pragma unroll
                    for (int n = 0; n < 2; ++n) {
                        const int ch = (u.pn & 1) * 256 + bj * 128 + wc * 32 + 16 * n + 4 * fq;
                        const int h = ch >> 6, kidx = ch & 63;
                        float* sp = ST + ((size_t)r * 8 + h) * (ST_SLOTS * 64) + kidx;
                        const f32x4 a = acc[ai][bj][m][n];
                        if (reg < 2) {
                            const f32x4 bias = biasv[bj][n];
                            f32x4 o;
#pragma unroll
                            for (int i = 0; i < 4; ++i) {
                                o[i] = __expf(-0.6065306597126334f * sigmoidf_(bias[i] + a[i]));
                            }
                            *(f32x4*)(sp + (reg ? SL_W1 : SL_W0) * 64) = o;
                        } else if (reg < 4) {
                            const int d = reg - 2;
                            const f32x4 bias = biasv[bj][n];
                            *(f32x4*)(sp + (d ? SL_A1 : SL_A0) * 64) = (f32x4){sigmoidf_(bias[0] + a[0]), sigmoidf_(bias[1] + a[1]), sigmoidf_(bias[2] + a[2]), sigmoidf_(bias[3] + a[3])};
                        } else {
                            *(u32x2*)(P + (size_t)r * PP + IC_RW + ch) = pack4(a);
                        }
                        asm volatile("" ::: "memory");
                    }
            }
    }
};

struct LoraSched {
    pg8::StaticOrder S;
    __device__ __forceinline__ bool next(int i, Unit& u) const { if (!S.next(i, u)) return false; const int reg = u.pn >> 1; u.koff = 128 * (reg < 4 ? (reg >> 1) : 2); return true; }
    __device__ __forceinline__ void a_ready(const Unit&) const {}
    __device__ __forceinline__ void done(const Unit&) const {}
};
__device__ __forceinline__ size_t gate_tile_off(int pm, int pn, int nM, int G) {
    constexpr int nN = 12, WGM = pg8::WGM, NX = pg8::NXCD;
    const int nwg = nM * nN, gid = pm / WGM, fm = gid * WGM, gsz = (nM - fm) < WGM ? (nM - fm) : WGM;
    const int wgid = gid * (WGM * nN) + pn * gsz + (pm - fm);
    const int q = nwg / NX, r = nwg % NX;
    int xcd, off;
    if (wgid < r * (q + 1)) { xcd = wgid / (q + 1); off = wgid % (q + 1); } else { const int w2 = wgid - r * (q + 1); xcd = r + w2 / q; off = w2 % q; }
    const int L = off * NX + xcd, c = L % G, k = L / G;
    return (size_t)(8 * c + 8 * G * k) * (8 * ST_SLOTS * 64 * 2);
}
struct EpiGate {
    static constexpr bool PERM = true, AFTER_DRAIN = false;
    bf16_t* G; int nM, nwg;
    __device__ __forceinline__ void operator()(const f32x4 (&acc)[2][2][4][2], const Unit& u, int wr, int wc, int fr, int fq) const {
        bf16_t* blob = G + gate_tile_off(u.pm, u.pn, nM, nwg);
#pragma unroll
        for (int ai = 0; ai < 2; ++ai)
#pragma unroll
            for (int m = 0; m < 4; ++m) {
                const int r = ai * 128 + wr * 64 + m * 16 + fr;
#pragma unroll
                for (int bj = 0; bj < 2; ++bj) {
                    const int c = bj * 128 + wc * 32 + 8 * fq;
                    const f32x4 a0 = acc[ai][bj][m][0], a1 = acc[ai][bj][m][1];
                    u32x4 w; w.x = pk2(sigmoidf_(a0.x), sigmoidf_(a0.y)); w.y = pk2(sigmoidf_(a0.z), sigmoidf_(a0.w)); w.z = pk2(sigmoidf_(a1.x), sigmoidf_(a1.y)); w.w = pk2(sigmoidf_(a1.z), sigmoidf_(a1.w));
                    *(u32x4*)(blob + r * 256 + c) = w;
                }
            }
    }
};

struct MergeSched {
    pg8::StaticOrder S; int nMtot;
    __device__ __forceinline__ bool next(int i, Unit& u) const { const int pass = i % 3; if (!S.next(i / 3, u)) return false; u.pm += pass * nMtot; u.pn += pass * 4; u.tail = pass; return true; }
    __device__ __forceinline__ void a_ready(const Unit&) const {}
    __device__ __forceinline__ void done(const Unit&) const {}
};
struct EpiMergeF {
    static constexpr bool PERM = true, AFTER_DRAIN = false;
    const bf16_t* G; bf16_t* MF; bf16_t* MB; int nMtot; int nMg, nwg;
    __device__ __forceinline__ void operator()(const f32x4 (&acc)[2][2][4][2], const Unit& u, int wr, int wc, int fr, int fq) const {
        const int pass = u.tail, pm = u.pm - pass * nMtot, pn = u.pn - 4 * pass;
        const bf16_t* gblob = G + gate_tile_off(pm, 4 * pass + pn, nMg, nwg);
        bf16_t* dstb = pass < 2 ? MF : MB;
#pragma unroll
        for (int ai = 0; ai < 2; ++ai) {
            u32x4 gwv[4][2], mwv[4][2];
#pragma unroll
            for (int m = 0; m < 4; ++m)
#pragma unroll
                for (int bj = 0; bj < 2; ++bj) {
                    const int rl = ai * 128 + wr * 64 + m * 16 + fr, cl = bj * 128 + wc * 32 + 8 * fq;
                    gwv[m][bj] = *(const u32x4*)(gblob + rl * 256 + cl);
                    mwv[m][bj] = pass > 0 ? *(const u32x4*)(MF + (size_t)(pm * 256 + rl) * 1024 + pn * 256 + cl) : (u32x4){0u, 0u, 0u, 0u};
                }
#pragma unroll
            for (int m = 0; m < 4; ++m)
#pragma unroll
                for (int bj = 0; bj < 2; ++bj) {
                    const int r = pm * 256 + ai * 128 + wr * 64 + m * 16 + fr, c = pn * 256 + bj * 128 + wc * 32 + 8 * fq;
                    const u32x4 gw = gwv[m][bj], mw = mwv[m][bj];
                    f32x4 v0 = unpack4((u32x2){gw.x, gw.y}) * acc[ai][bj][m][0], v1 = unpack4((u32x2){gw.z, gw.w}) * acc[ai][bj][m][1];
                    if (pass > 0) { v0 += unpack4((u32x2){mw.x, mw.y}); v1 += unpack4((u32x2){mw.z, mw.w}); }
                    const u32x2 p0 = pack4(v0), p1 = pack4(v1);
                    *(u32x4*)(dstb + (size_t)r * 1024 + c) = (u32x4){p0.x, p0.y, p1.x, p1.y};
                }
        }
    }
};
template <int PASS> struct EpiMerge {
    static constexpr bool PERM = false, AFTER_DRAIN = false;
    const bf16_t* G; bf16_t* MF; bf16_t* MB;
    __device__ __forceinline__ void operator()(const f32x4 (&acc)[2][2][4][2], const Unit& u, int wr, int wc, int fr, int fq) const {
#pragma unroll
        for (int ai = 0; ai < 2; ++ai)
#pragma unroll
            for (int m = 0; m < 4; ++m) {
                const int r = u.pm * 256 + ai * 128 + wr * 64 + m * 16 + fr;
#pragma unroll
                for (int bj = 0; bj < 2; ++bj)
#pragma unroll
                    for (int n = 0; n < 2; ++n) {
                        const int c = u.pn * 256 + bj * 128 + wc * 32 + 16 * n + 4 * fq;
                        const f32x4 g = unpack4(*(const u32x2*)(G + (size_t)r * 3072 + PASS * 1024 + c));
                        f32x4 v = g * acc[ai][bj][m][n];
                        bf16_t* mp = MF + (size_t)r * 1024 + c;
                        if (PASS > 0) v += unpack4(*(const u32x2*)mp);
                        *(u32x2*)(PASS < 2 ? mp : MB + (size_t)r * 1024 + c) = pack4(v);
                    }
            }
    }
};

struct EpiBf {
    static constexpr bool PERM = true, AFTER_DRAIN = false;
    bf16_t* O; int ldc;
    __device__ __forceinline__ void operator()(const f32x4 (&acc)[2][2][4][2], const Unit& u, int wr, int wc, int fr, int fq) const {
#pragma unroll
        for (int ai = 0; ai < 2; ++ai)
#pragma unroll
            for (int m = 0; m < 4; ++m) {
                const int r = u.pm * 256 + ai * 128 + wr * 64 + m * 16 + fr;
#pragma unroll
                for (int bj = 0; bj < 2; ++bj) {
                    const int c = u.pn * 256 + bj * 128 + wc * 32 + 8 * fq;
                    const f32x4 a0 = acc[ai][bj][m][0], a1 = acc[ai][bj][m][1];
                    u32x4 w; w.x = pk2(a0.x, a0.y); w.y = pk2(a0.z, a0.w); w.z = pk2(a1.x, a1.y); w.w = pk2(a1.z, a1.w);
                    *(u32x4*)(O + (size_t)r * ldc + c) = w;
                }
            }
    }
};

struct TailSched {
    pg8::StaticOrder S; int nwg_main, nM_main, nN, nsl, kt, nitems, G, c;
    __device__ void init(int M_main, int N, int G_, int c_, int ntail, int kt_, int nsl_) { S.init(M_main, N, G_, c_); nwg_main = S.nwg; nM_main = M_main / pg8::BM; nN = N / pg8::BM; nsl = nsl_; kt = kt_; nitems = ntail * nN * nsl; G = G_; c = c_; }
    __device__ __forceinline__ bool next(int i, Unit& u) const {
        const long L = (long)i * G + c;
        if (L < nwg_main) return S.next(i, u);
        const int j = (int)(L - nwg_main); if (j >= nitems) return false;
        const int sl = j % nsl, tu = j / nsl;
        u.pm = nM_main + tu / nN; u.pn = tu % nN; u.koff = sl * kt * pg8::BK; u.tail = sl; u.kt = kt; return true;
    }
    __device__ __forceinline__ void a_ready(const Unit&) const {}
    __device__ __forceinline__ void done(const Unit&) const {}
};
struct EpiBfTail {
    static constexpr bool PERM = true, AFTER_DRAIN = false;
    bf16_t* O; int ldc; float* part; int row0, rows;
    __device__ __forceinline__ void operator()(const f32x4 (&acc)[2][2][4][2], const Unit& u, int wr, int wc, int fr, int fq) const {
        if (u.tail < 0) { EpiBf E{O, ldc}; E(acc, u, wr, wc, fr, fq); return; }
        float* base = part + (size_t)(u.tail * rows + (u.pm * 256 - row0) + wr * 64 + fr) * ldc + u.pn * 256 + wc * 32 + 8 * fq;
#pragma unroll
        for (int ai = 0; ai < 2; ++ai)
#pragma unroll
            for (int m = 0; m < 4; ++m)
#pragma unroll
                for (int bj = 0; bj < 2; ++bj) {
                    float* d = base + (size_t)(ai * 128 + m * 16) * ldc + bj * 128;
                    *(f32x4*)d = acc[ai][bj][m][0]; *(f32x4*)(d + 4) = acc[ai][bj][m][1];
                }
    }
};

struct EpiSwiglu {
    static constexpr bool PERM = true, AFTER_DRAIN = false;
    bf16_t* H; int ldh; int npn; int pm_sub;
    __device__ __forceinline__ void operator()(const f32x4 (&acc)[2][2][4][2], const Unit& u, int wr, int wc, int fr, int fq) const {
        const int pnn = u.pn % npn;
#pragma unroll
        for (int ai = 0; ai < 2; ++ai)
#pragma unroll
            for (int m = 0; m < 4; ++m) {
                const int r = (u.pm - pm_sub) * 256 + ai * 128 + wr * 64 + m * 16 + fr;
                const int hc = pnn * 128 + wc * 32 + 8 * fq;
                const f32x4 g0 = acc[ai][0][m][0], g1 = acc[ai][0][m][1], u0 = acc[ai][1][m][0], u1 = acc[ai][1][m][1];
                u32x4 w; w.x = pk2(siluf_(g0.x) * u0.x, siluf_(g0.y) * u0.y); w.y = pk2(siluf_(g0.z) * u0.z, siluf_(g0.w) * u0.w);
                w.z = pk2(siluf_(g1.x) * u1.x, siluf_(g1.y) * u1.y); w.w = pk2(siluf_(g1.z) * u1.z, siluf_(g1.w) * u1.w);
                *(u32x4*)(H + (size_t)r * ldh + hc) = w;
            }
    }
};

struct MoeSched {
    int ts[9]; int pm_lo, pm_hi, npn, G, c; bool a_local;
    __device__ __forceinline__ int expert_of(int pm) const { int e = 0;
#pragma unroll
        for (int q = 1; q < 8; ++q) e += (pm >= ts[q]) ? 1 : 0;
        return e; }
    __device__ __forceinline__ bool next(int i, Unit& u) const {
        const int n = (pm_hi - pm_lo) * npn; const long L = (long)i * G + c; if (L >= n) return false;
        const int pm = pm_lo + (int)L / npn, pnn = (int)L % npn;
        u.pm = a_local ? pm - pm_lo : pm; u.pn = expert_of(pm) * npn + pnn; u.koff = 0; u.tail = -1; u.kt = 0; return true;
    }
    __device__ __forceinline__ void a_ready(const Unit&) const {}
    __device__ __forceinline__ void done(const Unit&) const {}
};
struct EpiMoeDown {
    static constexpr bool PERM = true, AFTER_DRAIN = false;
    bf16_t* FS; long slot1_off; const int* LIST; const float* WTS; const unsigned* cnt; int ts[9]; int pm_lo;
    __device__ __forceinline__ void operator()(const f32x4 (&acc)[2][2][4][2], const Unit& u, int wr, int wc, int fr, int fq) const {
        const int e = u.pn >> 2, pnn = u.pn & 3, pmg = u.pm + pm_lo;
        int tse = 0;
#pragma unroll
        for (int q = 0; q < 8; ++q) tse = (q == e) ? ts[q] : tse;
        const int ne = (int)cnt[e];
        int tkv[2][4]; float wv[2][4];
#pragma unroll
        for (int ai = 0; ai < 2; ++ai)
#pragma unroll
            for (int m = 0; m < 4; ++m) {
                const int slot = (pmg - tse) * 256 + ai * 128 + wr * 64 + m * 16 + fr;
                const bool ok = slot < ne;
                tkv[ai][m] = ok ? LIST[e * 16384 + slot] : -1; wv[ai][m] = ok ? WTS[e * 16384 + slot] : 0.f;
            }
#pragma unroll
        for (int ai = 0; ai < 2; ++ai)
#pragma unroll
            for (int m = 0; m < 4; ++m) {
                if (tkv[ai][m] >= 0) {
                    const int tk = tkv[ai][m]; const float w = wv[ai][m];
                    bf16_t* dst = FS + (long)(tk & 1) * slot1_off + (size_t)(tk >> 1) * 1024 + pnn * 256 + wc * 32 + 8 * fq;
#pragma unroll
                    for (int bj = 0; bj < 2; ++bj) { const u32x2 p0 = pack4(acc[ai][bj][m][0] * w), p1 = pack4(acc[ai][bj][m][1] * w); *(u32x4*)(dst + bj * 128) = (u32x4){p0.x, p0.y, p1.x, p1.y}; }
                }
            }
    }
};

constexpr float SC2 = 0.125f * 1.4426950408889634f;
constexpr float ATT_THR = 6.0f;
__device__ __forceinline__ float xhalf_max(float v) { auto rr = __builtin_amdgcn_permlane32_swap(__float_as_uint(v), __float_as_uint(v), false, false); return fmaxf(__uint_as_float(rr[0]), __uint_as_float(rr[1])); }
__device__ __forceinline__ float xhalf_sum(float v) { auto rr = __builtin_amdgcn_permlane32_swap(__float_as_uint(v), __float_as_uint(v), false, false); return __uint_as_float(rr[0]) + __uint_as_float(rr[1]); }

template <int DV, bool WINDOW, int ROT = 0>
__device__ __forceinline__ void attn_pass(LAS unsigned char* lds, const bf16_t* __restrict__ P, int qrow0, int qcol, int kcol, const bf16_t* __restrict__ VT,
                                          int lat_row0, int ctx_row0, int tile_lo, int tile_hi, bool has_ref, float m0, float l0, int qpos0,
                                          f32x16 (&o)[DV / 32], float& l_out, int wave, int lane) {
    constexpr int STG = 8192 + DV * 128, ND = 1 + DV / 64;
    int tid_ = threadIdx.x; asm volatile("" : "+v"(tid_)); const int tid = tid_; lane = tid & 63; const int qn = lane & 31, half = lane >> 5;
    bf16x8 qf[4];
    { const bf16_t* qp = P + (size_t)(qrow0 + wave * 32 + qn) * PP + qcol + half * 8;
#pragma unroll
      for (int ks = 0; ks < 4; ++ks) qf[ks] = *(const bf16x8*)(qp + ks * 16); }
    float mrun = has_ref ? m0 : 0.f, lrun = (half == 0) ? l0 : 0.f;
    bool need_ref = !has_ref;
    f32x16 negm;
#pragma unroll
    for (int i = 0; i < 16; ++i) negm[i] = -mrun;
#pragma unroll
    for (int db = 0; db < DV / 32; ++db)
#pragma unroll
        for (int i = 0; i < 16; ++i) o[db][i] = 0.f;
    const int nlat = tile_hi - tile_lo, nt = nlat + 4;
    const int drow = wave * 8 + (lane >> 3), dchk = ((lane & 7) ^ (4 * (wave & 1) + (lane >> 4))) * 8;
    const bf16_t* ksrc = P + (size_t)drow * PP + kcol + dchk;
    const bf16_t* vsrc = VT + (size_t)drow * KEYS + dchk;
#define ATT_DMA(ti_, sg_, vg_) do { const int id_ = (ti_) < nlat ? tile_lo + (ti_) : 128 + ((ti_) - nlat); \
        const int krow0_ = id_ < 128 ? lat_row0 + 64 * id_ : ctx_row0 + 64 * (id_ - 128); \
        LAS unsigned char* kst_ = (ROT ? lds + (sg_) * 8192 : lds + (sg_) * STG) + wave * 1024; LAS unsigned char* vst_ = (ROT ? lds + 24576 + (vg_) * (DV * 128) : lds + (sg_) * STG + 8192) + wave * 1024; \
        __builtin_amdgcn_global_load_lds((const unsigned*)(ksrc + (size_t)krow0_ * PP), (LAS unsigned*)kst_, 16, 0, 0); \
        _Pragma("unroll") for (int j_ = 0; j_ < DV / 64; ++j_) \
            __builtin_amdgcn_global_load_lds((const unsigned*)(vsrc + (size_t)(64 * j_) * KEYS + 64 * id_), (LAS unsigned*)(vst_ + j_ * 8192), 16, 0, 0); } while (0)
    __syncthreads();
    ATT_DMA(0, 0, 0);
    if (nt > 1) { ATT_DMA(1, 1, 1); asm volatile("s_waitcnt vmcnt(%0)" :: "n"(ND) : "memory"); } else asm volatile("s_waitcnt vmcnt(0)" ::: "memory");
    __syncthreads();
    int sg = 0, vg = 0;
    u32x4 pw[4];
#define ATT_PV(vs_) do { const LAS unsigned char* vs0_ = (vs_); \
        _Pragma("unroll") for (int g = 0; g < 4; ++g) { const bf16x8 pf = __builtin_bit_cast(bf16x8, pw[g]); \
            _Pragma("unroll") for (int db = 0; db < DV / 32; ++db) { \
                const bf16x8 vf = *(const LAS bf16x8*)(vs0_ + (32 * db + qn) * 128 + (((2 * g + half) ^ sw7) * 16)); \
                o[db] = __builtin_amdgcn_mfma_f32_32x32x16_bf16(vf, pf, o[db], 0, 0, 0); } } } while (0)
    const int sw7 = (qn >> 1) & 7;
    for (int ti = 0; ti < nt; ++ti) {
        if (ti + 2 < nt) { const int sg2 = sg == 0 ? 2 : sg - 1; ATT_DMA(ti + 2, sg2, (vg + 2) & 3); }
        const LAS unsigned char* Ks = ROT ? lds + sg * 8192 : lds + sg * STG; const LAS unsigned char* Vs = ROT ? lds + 24576 + vg * (DV * 128) : Ks + 8192;
        if (ROT == 2 && ti > 0) ATT_PV(lds + 24576 + ((vg + 3) & 3) * (DV * 128));
        const int id = ti < nlat ? tile_lo + ti : 128 + (ti - nlat);
        const bool islat = id < 128;
        bool skip = false;
        if (WINDOW && islat) { const int qw = qpos0 + wave * 32; skip = (64 * id + 63 < qw - 128 || 64 * id > qw + 31 + 128); }
        if (!skip) {
        f32x16 s[2];
#pragma unroll
        for (int mb = 0; mb < 2; ++mb) {
#pragma unroll
            for (int ks = 0; ks < 4; ++ks) {
                const bf16x8 kf = *(const LAS bf16x8*)(Ks + (32 * mb + qn) * 128 + (((2 * ks + half) ^ sw7) * 16));
                if (ks == 0) s[mb] = __builtin_amdgcn_mfma_f32_32x32x16_bf16(kf, qf[0], negm, 0, 0, 0);
                else s[mb] = __builtin_amdgcn_mfma_f32_32x32x16_bf16(kf, qf[ks], s[mb], 0, 0, 0);
            }
        }
        if (WINDOW && islat) {
            const int qpos = qpos0 + wave * 32 + qn;
#pragma unroll
            for (int mb = 0; mb < 2; ++mb)
#pragma unroll
                for (int i = 0; i < 16; ++i) { const int d = 64 * id + 32 * mb + 8 * (i >> 2) + 4 * half + (i & 3) - qpos; if (d > 128 || d < -128) s[mb][i] = -INFINITY; }
        }
        float mx = s[0][0];
#pragma unroll
        for (int mb = 0; mb < 2; ++mb)
#pragma unroll
            for (int i = 0; i < 16; ++i) mx = fmaxf(mx, s[mb][i]);
        mx = xhalf_max(mx);
        if (__builtin_expect(need_ref || __any(mx > ATT_THR), 0)) {
            const float delta = need_ref ? mx : fmaxf(mx, 0.f);
            if (!need_ref) {
                const float alpha = __builtin_amdgcn_exp2f(-delta);
                lrun *= alpha;
#pragma unroll
                for (int db = 0; db < DV / 32; ++db)
#pragma unroll
                    for (int i = 0; i < 16; ++i) o[db][i] *= alpha;
            }
            mrun += delta; need_ref = false;
#pragma unroll
            for (int mb = 0; mb < 2; ++mb)
#pragma unroll
                for (int i = 0; i < 16; ++i) s[mb][i] -= delta;
#pragma unroll
            for (int i = 0; i < 16; ++i) negm[i] = -mrun;
        }
        float rs = 0.f;
#pragma unroll
        for (int mb = 0; mb < 2; ++mb)
#pragma unroll
            for (int i = 0; i < 16; ++i) { const float pv = __builtin_amdgcn_exp2f(s[mb][i]); s[mb][i] = pv; rs += pv; }
        lrun += rs;
        if (ROT == 2) {
#pragma unroll
            for (int g = 0; g < 4; ++g) {
                const int mb = g >> 1, bs = 8 * (g & 1);
                pw[g].x = pk2(s[mb][bs + 0], s[mb][bs + 1]); pw[g].y = pk2(s[mb][bs + 2], s[mb][bs + 3]); pw[g].z = pk2(s[mb][bs + 4], s[mb][bs + 5]); pw[g].w = pk2(s[mb][bs + 6], s[mb][bs + 7]);
            }
        } else {
#pragma unroll
            for (int g = 0; g < 4; ++g) {
                const int mb = g >> 1, bs = 8 * (g & 1);
                u32x4 pq; pq.x = pk2(s[mb][bs + 0], s[mb][bs + 1]); pq.y = pk2(s[mb][bs + 2], s[mb][bs + 3]); pq.z = pk2(s[mb][bs + 4], s[mb][bs + 5]); pq.w = pk2(s[mb][bs + 6], s[mb][bs + 7]);
                const bf16x8 pf = __builtin_bit_cast(bf16x8, pq);
#pragma unroll
                for (int db = 0; db < DV / 32; ++db) {
                    const bf16x8 vf = *(const LAS bf16x8*)(Vs + (32 * db + qn) * 128 + (((2 * g + half) ^ sw7) * 16));
                    o[db] = __builtin_amdgcn_mfma_f32_32x32x16_bf16(vf, pf, o[db], 0, 0, 0);
                }
            }
        }
        }
        if (ti + 2 < nt) asm volatile("s_waitcnt vmcnt(%0)" :: "n"(ND) : "memory"); else asm volatile("s_waitcnt vmcnt(0)" ::: "memory");
        __syncthreads();
        sg = sg == 2 ? 0 : sg + 1; vg = (vg + 1) & 3;
    }
    if (ROT == 2) ATT_PV(lds + 24576 + ((vg + 3) & 3) * (DV * 128));
#undef ATT_DMA
#undef ATT_PV
    l_out = xhalf_sum(lrun);
}

__device__ __forceinline__ void swa_unit(LAS unsigned char* lds, const Params& p, int layer, int b, int hq, int qb, bool ctx, int wave, int lane, bool dry = false) {
    bf16_t* P = (bf16_t*)(p.ws + WS_P);
    const int kvh = hq >> 2;
    const bf16_t* VT = (const bf16_t*)(p.ws + WS_VTS) + (size_t)((b * 2 + kvh) * 64) * KEYS;
    const float sink2 = p.in[11][layer * 8 + hq] * 1.4426950408889634f;
    const int qrow0 = ctx ? NLAT + b * CTXL : b * SEQ + qb * 256;
    f32x16 o[2]; float l;
    if (ctx) attn_pass<64, false>(lds, P, qrow0, IC_QS + hq * 64, IC_KS + kvh * 64, VT, b * SEQ, NLAT + b * CTXL, 0, 0, true, sink2, 1.0f, 0, o, l, wave, lane);
    else {
        int lo = 4 * qb - 2; if (lo < 0) lo = 0; int hi = 4 * qb + 6; if (hi > 128) hi = 128;
        attn_pass<64, true>(lds, P, qrow0, IC_QS + hq * 64, IC_KS + kvh * 64, VT, b * SEQ, NLAT + b * CTXL, lo, hi, true, sink2, 1.0f, qb * 256, o, l, wave, lane);
    }
    const float inv = 1.0f / l; const int qn = lane & 31, half = lane >> 5;
    bf16_t* dst = P + (size_t)(qrow0 + wave * 32 + qn) * PP + IC_QS + hq * 64 + 4 * half;
#pragma unroll
    for (int db = 0; db < 2; ++db)
#pragma unroll
        for (int q4 = 0; q4 < 4; ++q4) {
            const f32x4 v = (f32x4){o[db][4 * q4] * inv, o[db][4 * q4 + 1] * inv, o[db][4 * q4 + 2] * inv, o[db][4 * q4 + 3] * inv};
            if (!dry) *(u32x2*)(dst + 32 * db + 8 * q4) = pack4(v);
        }
}
__device__ __forceinline__ void diff_unit(LAS unsigned char* lds, const Params& p, float lam, int b, int h, int qb, bool ctx, int park0, int pstride, int wave, int lane, bool dry = false) {
    bf16_t* P = (bf16_t*)(p.ws + WS_P);
    const bf16_t* VT = (const bf16_t*)(p.ws + WS_VTD) + (size_t)((b * 4 + h) * 128) * KEYS;
    const int qrow0 = ctx ? NLAT + b * CTXL : b * SEQ + qb * 256;
    const int thi = ctx ? 0 : 128;
    unsigned* park = (unsigned*)(p.ws + WS_YA) + threadIdx.x;
#define PARK(w_) park[(size_t)(park0 + ((w_) >> 3) * pstride) * 8192 + ((w_) & 7) * 512]
    f32x16 o[4]; float l;
    if (wave < 4) attn_pass<128, false, 1>(lds, P, qrow0, IC_QD + h * 128, IC_KD + h * 128, VT, b * SEQ, NLAT + b * CTXL, 0, thi, false, 0.f, 0.f, 0, o, l, wave, lane);
    else attn_pass<128, false, 2>(lds, P, qrow0, IC_QD + h * 128, IC_KD + h * 128, VT, b * SEQ, NLAT + b * CTXL, 0, thi, false, 0.f, 0.f, 0, o, l, wave, lane);
    { const float inv = 1.0f / l;
#pragma unroll
      for (int db = 0; db < 4; ++db)
#pragma unroll
          for (int i = 0; i < 8; ++i) PARK(db * 8 + i) = pk2(o[db][2 * i] * inv, o[db][2 * i + 1] * inv); }
    if (wave < 4) attn_pass<128, false, 1>(lds, P, qrow0, IC_QD + h * 128 + 64, IC_KD + h * 128 + 64, VT, b * SEQ, NLAT + b * CTXL, 0, thi, false, 0.f, 0.f, 0, o, l, wave, lane);
    else attn_pass<128, false, 2>(lds, P, qrow0, IC_QD + h * 128 + 64, IC_KD + h * 128 + 64, VT, b * SEQ, NLAT + b * CTXL, 0, thi, false, 0.f, 0.f, 0, o, l, wave, lane);
    const float inv = lam / l; const int qn = lane & 31, half = lane >> 5;
    bf16_t* dst = P + (size_t)(qrow0 + wave * 32 + qn) * PP + IC_QD + h * 128 + 4 * half;
    unsigned pkv[32];
#pragma unroll
    for (int w = 0; w < 32; ++w) pkv[w] = PARK(w);
#pragma unroll
    for (int db = 0; db < 4; ++db)
#pragma unroll
        for (int q4 = 0; q4 < 4; ++q4) {
            const unsigned pa = pkv[db * 8 + 2 * q4], pb = pkv[db * 8 + 2 * q4 + 1];
            const f32x4 v = (f32x4){bflo(pa) - o[db][4 * q4] * inv, bfhi(pa) - o[db][4 * q4 + 1] * inv, bflo(pb) - o[db][4 * q4 + 2] * inv, bfhi(pb) - o[db][4 * q4 + 3] * inv};
            if (!dry) *(u32x2*)(dst + 32 * db + 8 * q4) = pack4(v);
        }
#undef PARK
}

__device__ __forceinline__ void ld8bf(const bf16_t* p, float (&v)[8]) { const u32x4 w = *(const u32x4*)p; v[0] = bflo(w.x); v[1] = bfhi(w.x); v[2] = bflo(w.y); v[3] = bfhi(w.y); v[4] = bflo(w.z); v[5] = bfhi(w.z); v[6] = bflo(w.w); v[7] = bfhi(w.w); }
__device__ __forceinline__ void ld8f(const float* p, float (&v)[8]) { const f32x4 a = ((const f32x4*)p)[0], b = ((const f32x4*)p)[1]; v[0] = a.x; v[1] = a.y; v[2] = a.z; v[3] = a.w; v[4] = b.x; v[5] = b.y; v[6] = b.z; v[7] = b.w; }
__device__ __forceinline__ void st8f(float* p, const float (&v)[8]) { ((f32x4*)p)[0] = (f32x4){v[0], v[1], v[2], v[3]}; ((f32x4*)p)[1] = (f32x4){v[4], v[5], v[6], v[7]}; }

__device__ __forceinline__ void rwkv_prepare_phase(const Params& p, int layer, int gw, int NGW, int lane) {
    const bf16_t* P = (const bf16_t*)(p.ws + WS_P); float* ST = (float*)(p.ws + WS_ST); bf16_t* A2 = (bf16_t*)(p.ws + WS_YA);
    const float* mup = p.in[12] + layer * 1920; const float* mun = p.in[13] + layer * 1920; const float* k_k = p.in[19] + layer * 512;
    for (int m = gw; m < NTOK; m += NGW) {
        const int t = m < NLAT ? (m & (SEQ - 1)) : ((m - NLAT) & (CTXL - 1)), len = m < NLAT ? SEQ : CTXL;
        const bool hp = t > 0, hn = t < len - 1;
        const bf16_t* pr = P + (size_t)m * PP + IC_RW;
        const int h = lane >> 3, l4 = (lane & 7) * 4;
        float* sp = ST + ((size_t)m * 8 + h) * (ST_SLOTS * 64) + l4;
#pragma unroll
        for (int sec = 0; sec < 3; ++sec) {
            const int col = sec * 512 + h * 64 + l4;
            float sh[8];
#pragma unroll
            for (int hv = 0; hv < 2; ++hv) {
                const int cc = col + 32 * hv;
                const u32x2 cw = *(const u32x2*)(pr + cc);
                u32x2 pw_ = (u32x2){0u, 0u}, nw_ = (u32x2){0u, 0u};
                if (hp) pw_ = *(const u32x2*)(pr - PP + cc);
                if (hn) nw_ = *(const u32x2*)(pr + PP + cc);
                const f32x4 a = *(const f32x4*)(mup + cc), bb = *(const f32x4*)(mun + cc);
                const float c[4] = {bflo(cw.x), bfhi(cw.x), bflo(cw.y), bfhi(cw.y)};
                const float pv[4] = {hp ? bflo(pw_.x) : 0.f, hp ? bfhi(pw_.x) : 0.f, hp ? bflo(pw_.y) : 0.f, hp ? bfhi(pw_.y) : 0.f};
                const float nx[4] = {hn ? bflo(nw_.x) : 0.f, hn ? bfhi(nw_.x) : 0.f, hn ? bflo(nw_.y) : 0.f, hn ? bfhi(nw_.y) : 0.f};
#pragma unroll
                for (int q = 0; q < 4; ++q) sh[4 * hv + q] = c[q] + a[q] * (pv[q] - c[q]) + bb[q] * (nx[q] - c[q]);
            }
            const int slot = sec == 0 ? SL_R : (sec == 1 ? SL_K : SL_V);
            *(f32x4*)(sp + slot * 64) = (f32x4){sh[0], sh[1], sh[2], sh[3]}; *(f32x4*)(sp + slot * 64 + 32) = (f32x4){sh[4], sh[5], sh[6], sh[7]};
            if (sec == 1) {
                const f32x4 w0 = *(const f32x4*)(k_k + h * 64 + l4), w1 = *(const f32x4*)(k_k + h * 64 + 32 + l4);
                float kk[8]; float ss = 0.f;
#pragma unroll
                for (int q = 0; q < 4; ++q) { kk[q] = sh[q] * w0[q]; kk[4 + q] = sh[4 + q] * w1[q]; ss += kk[q] * kk[q] + kk[4 + q] * kk[4 + q]; }
                ss += __shfl_xor(ss, 1); ss += __shfl_xor(ss, 2); ss += __shfl_xor(ss, 4);
                const float inv = 1.0f / fmaxf(sqrtf(ss), 1e-12f);
                *(f32x4*)(sp + SL_KK * 64) = (f32x4){kk[0] * inv, kk[1] * inv, kk[2] * inv, kk[3] * inv}; *(f32x4*)(sp + SL_KK * 64 + 32) = (f32x4){kk[4] * inv, kk[5] * inv, kk[6] * inv, kk[7] * inv};
            }
        }
        if (lane < 48) {
            const int col = 1536 + lane * 8;
            float c[8], pv[8], nx[8], a[8], bb[8], sh[8];
            ld8bf(pr + col, c);
            if (hp) ld8bf(pr - PP + col, pv); else {
#pragma unroll
                for (int q = 0; q < 8; ++q) pv[q] = 0.f; }
            if (hn) ld8bf(pr + PP + col, nx); else {
#pragma unroll
                for (int q = 0; q < 8; ++q) nx[q] = 0.f; }
            ld8f(mup + col, a); ld8f(mun + col, bb);
#pragma unroll
            for (int q = 0; q < 8; ++q) sh[q] = c[q] + a[q] * (pv[q] - c[q]) + bb[q] * (nx[q] - c[q]);
            float o[8];
#pragma unroll
            for (int q = 0; q < 8; ++q) o[q] = lane < 16 ? tanhf(sh[q]) : (lane < 32 ? sh[q] : sigmoidf_(sh[q]));
            u32x4 w; w.x = pk2(o[0], o[1]); w.y = pk2(o[2], o[3]); w.z = pk2(o[4], o[5]); w.w = pk2(o[6], o[7]);
            *(u32x4*)(A2 + (size_t)m * 384 + lane * 8) = w;
        }
    }
}

constexpr int NSEG = 64, SEGL = KEYS / NSEG;
static_assert(SEGL * NSEG == KEYS && SEGL % 4 == 0, "segments");
constexpr size_t WS_GH = WS_YA;
static_assert(WS_GH + 32ull * NSEG * 2 * 4096 * 4 <= 560 * MiB, "GH fits behind the stream");
__device__ __forceinline__ int scan_token(int b, int dir, int s) {
    if (s < CTXL) return NLAT + b * CTXL + (dir ? CTXL - 1 - s : s);
    const int t = s - CTXL; return b * SEQ + (dir ? SEQ - 1 - t : t);
}
constexpr int SRING = 8, SREC = 6 * 64 * 4;
constexpr int SCAN_LDS = SRING * SREC;
__device__ __forceinline__ void scan_dma(const float* rec, LAS unsigned char* slot, int lane) {
    const float* q = rec + lane * 4;
    __builtin_amdgcn_global_load_lds((const unsigned*)q, (LAS unsigned*)slot, 16, 0, 0);
    if (lane < 32) __builtin_amdgcn_global_load_lds((const unsigned*)(q + 256), (LAS unsigned*)(slot + 1024), 16, 0, 0);
}
template <int MODE>
__device__ __forceinline__ void rwkv_segment(const Params& p, int layer, int sid, int seg, int lane, LAS unsigned char* ring) {
    const int b = sid >> 4, h = (sid >> 1) & 7, dir = sid & 1, c = lane & 31, hf = lane >> 5;
    const float ka0 = p.in[20][layer * 512 + h * 64 + c], ka1 = p.in[20][layer * 512 + h * 64 + 32 + c];
    const float rk0 = MODE == 2 ? p.in[21][layer * 512 + h * 64 + c] : 0.f, rk1 = MODE == 2 ? p.in[21][layer * 512 + h * 64 + 32 + c] : 0.f;
    const float* ST = (const float*)(p.ws + WS_ST);
    float* gh = (float*)(p.ws + WS_GH) + ((size_t)sid * NSEG + seg) * 2 * 4096;
    f32x16 TH[2][2], TG[MODE == 0 ? 2 : 1][2];
#pragma unroll
    for (int kb = 0; kb < 2; ++kb)
#pragma unroll
        for (int vb = 0; vb < 2; ++vb) {
            if (MODE == 2 && seg > 0) {
                const float* src = gh - 4096 + (32 * vb + c) * 64 + 32 * kb + 4 * hf;
#pragma unroll
                for (int q = 0; q < 4; ++q) { const f32x4 t = *(const f32x4*)(src + 8 * q); TH[kb][vb][4 * q] = t.x; TH[kb][vb][4 * q + 1] = t.y; TH[kb][vb][4 * q + 2] = t.z; TH[kb][vb][4 * q + 3] = t.w; }
            } else {
#pragma unroll
                for (int r = 0; r < 16; ++r) TH[kb][vb][r] = 0.f;
            }
        }
    const int s0 = seg * SEGL, s_end = s0 + SEGL;
    const int okk = dir ? 0 : 512, od = dir ? 1024 : 0, gsl = dir ? SL_KK * 64 : 0;
#pragma unroll 1
    for (int j = 0; j < SRING - 1; ++j) scan_dma(ST + ((size_t)scan_token(b, dir, s0 + j) * 8 + h) * (ST_SLOTS * 64) + gsl, ring + j * SREC, lane);
    const int cm4 = c - 4 * hf;
    if (MODE == 0) {
#pragma unroll
        for (int kb = 0; kb < 2; ++kb)
#pragma unroll
            for (int vb = 0; vb < 2; ++vb)
#pragma unroll
                for (int r = 0; r < 16; ++r) TG[MODE == 0 ? kb : 0][vb][r] = (kb == vb && cm4 == 8 * (r >> 2) + (r & 3)) ? 1.0f : 0.0f;
    }
    float cv[2][16], cA[2] = {1.0f, 1.0f};
#pragma unroll
    for (int kb = 0; kb < 2; ++kb)
#pragma unroll
        for (int r = 0; r < 16; ++r) cv[kb][r] = 1.0f;
    int slot_i = 0;
#pragma unroll 1
    for (int s = s0; s < s_end; ++s) {
        if (s + SRING - 1 < s_end) {
            int nslot = slot_i + SRING - 1; if (nslot >= SRING) nslot -= SRING;
            scan_dma(ST + ((size_t)scan_token(b, dir, s + SRING - 1) * 8 + h) * (ST_SLOTS * 64) + gsl, ring + nslot * SREC, lane);
            asm volatile("s_waitcnt vmcnt(14)" ::: "memory");
        } else asm volatile("s_waitcnt vmcnt(0)" ::: "memory");
        const LAS unsigned char* rec = ring + slot_i * SREC;
        slot_i = slot_i + 1 == SRING ? 0 : slot_i + 1;
        f32x2_t ph[2] = {{0.f, 0.f}, {0.f, 0.f}}, pg[2] = {{0.f, 0.f}, {0.f, 0.f}};
#pragma unroll
        for (int kb = 0; kb < 2; ++kb)
#pragma unroll
            for (int q = 0; q < 4; ++q) {
                const f32x4 a4 = *(const LAS f32x4*)(rec + okk + (32 * kb + 8 * q + 4 * hf) * 4);
#pragma unroll
                for (int j = 0; j < 4; j += 2)
#pragma unroll
                    for (int vb = 0; vb < 2; ++vb) {
                        const f32x2_t a2 = MODE == 0 ? (f32x2_t){a4[j] * cv[kb][4 * q + j], a4[j + 1] * cv[kb][4 * q + j + 1]} : (f32x2_t){a4[j], a4[j + 1]};
                        ph[vb] = __builtin_elementwise_fma((f32x2_t){TH[kb][vb][4 * q + j], TH[kb][vb][4 * q + j + 1]}, a2, ph[vb]);
                        if (MODE == 0) pg[vb] = __builtin_elementwise_fma((f32x2_t){TG[MODE == 0 ? kb : 0][vb][4 * q + j], TG[MODE == 0 ? kb : 0][vb][4 * q + j + 1]}, a2, pg[vb]);
                    }
            }
        float sa[2], sg[2];
#pragma unroll
        for (int vb = 0; vb < 2; ++vb) { sa[vb] = xhalf_sum(ph[vb].x + ph[vb].y); sg[vb] = MODE == 0 ? xhalf_sum(pg[vb].x + pg[vb].y) : 0.f; }
        if (MODE == 0) __builtin_amdgcn_sched_barrier(0);
#pragma unroll
        for (int kb = 0; kb < 2; ++kb)
#pragma unroll
            for (int q = 0; q < 4; ++q) {
                const f32x4 w4 = *(const LAS f32x4*)(rec + od + (32 * kb + 8 * q + 4 * hf) * 4);
#pragma unroll
                for (int j = 0; j < 4; ++j) {
                    if (MODE == 0) cv[kb][4 * q + j] *= w4[j];
                    else {
#pragma unroll
                        for (int vb = 0; vb < 2; ++vb) TH[kb][vb][4 * q + j] *= w4[j];
                    }
                }
            }
        float aop[2], bop[2], bopg[2];
#pragma unroll
        for (int kb = 0; kb < 2; ++kb) {
            const float ag = *(const LAS float*)(rec + od + 256 + (32 * kb + c) * 4), x = *(const LAS float*)(rec + okk + (hf ? 768 : 0) + (32 * kb + c) * 4);
            aop[kb] = x * (hf ? fmaf(ag - 1.0f, kb ? ka1 : ka0, 1.0f) : -ag);
            if (MODE == 0) { cA[kb] *= *(const LAS float*)(rec + od + (32 * kb + c) * 4); aop[kb] *= __builtin_amdgcn_rcpf(cA[kb]); }
        }
        float bonus = 0.f;
        if (MODE == 2) {
            const float r0 = *(const LAS float*)(rec + okk + 256 + c * 4), r1 = *(const LAS float*)(rec + okk + 256 + (32 + c) * 4);
            bonus = fmaf(aop[0] * r0, rk0, aop[1] * r1 * rk1);
        }
#pragma unroll
        for (int vb = 0; vb < 2; ++vb) { const float vv = *(const LAS float*)(rec + okk + 512 + (32 * vb + c) * 4); bop[vb] = hf ? vv : sa[vb]; bopg[vb] = hf ? 0.f : sg[vb]; }
#pragma unroll
        for (int kb = 0; kb < 2; ++kb)
#pragma unroll
            for (int vb = 0; vb < 2; ++vb) {
                TH[kb][vb] = __builtin_amdgcn_mfma_f32_32x32x2f32(aop[kb], bop[vb], TH[kb][vb], 0, 0, 0);
                if (MODE == 0) TG[MODE == 0 ? kb : 0][vb] = __builtin_amdgcn_mfma_f32_32x32x2f32(aop[kb], bopg[vb], TG[MODE == 0 ? kb : 0][vb], 0, 0, 0);
            }
        if (MODE == 0 && ((((s - s0) & 31) == 31) || s == s_end - 1)) {
#pragma unroll
            for (int kb = 0; kb < 2; ++kb)
#pragma unroll
                for (int r = 0; r < 16; ++r) {
#pragma unroll
                    for (int vb = 0; vb < 2; ++vb) { TH[kb][vb][r] *= cv[kb][r]; TG[MODE == 0 ? kb : 0][vb][r] *= cv[kb][r]; }
                    cv[kb][r] = 1.0f;
                }
            cA[0] = 1.0f; cA[1] = 1.0f;
        }
        if (MODE == 2) {
            f32x2_t py[2] = {{0.f, 0.f}, {0.f, 0.f}};
#pragma unroll
            for (int kb = 0; kb < 2; ++kb)
#pragma unroll
                for (int q = 0; q < 4; ++q) {
                    const f32x4 r4 = *(const LAS f32x4*)(rec + okk + 256 + (32 * kb + 8 * q + 4 * hf) * 4);
#pragma unroll
                    for (int j = 0; j < 4; j += 2)
#pragma unroll
                        for (int vb = 0; vb < 2; ++vb) py[vb] = __builtin_elementwise_fma((f32x2_t){TH[kb][vb][4 * q + j], TH[kb][vb][4 * q + j + 1]}, (f32x2_t){r4[j], r4[j + 1]}, py[vb]);
                }
            const float y0 = xhalf_sum(py[0].x + py[0].y), y1 = xhalf_sum(py[1].x + py[1].y);
            float* yp = (float*)ST + ((size_t)scan_token(b, dir, s) * 8 + h) * (ST_SLOTS * 64) + (dir ? SL_W1 : SL_W0) * 64 + c;
            if (hf == 0) { yp[0] = y0; yp[32] = y1; }
            if (hf) yp[64] = bonus;
        }
    }
    if (MODE == 0) {
#pragma unroll
        for (int kb = 0; kb < 2; ++kb)
#pragma unroll
            for (int vb = 0; vb < 2; ++vb) {
                float* dg = gh + (32 * vb + c) * 64 + 32 * kb + 4 * hf; float* dh = dg + 4096;
#pragma unroll
                for (int q = 0; q < 4; ++q) {
                    *(f32x4*)(dg + 8 * q) = (f32x4){TG[MODE == 0 ? kb : 0][vb][4 * q], TG[MODE == 0 ? kb : 0][vb][4 * q + 1], TG[MODE == 0 ? kb : 0][vb][4 * q + 2], TG[MODE == 0 ? kb : 0][vb][4 * q + 3]};
                    *(f32x4*)(dh + 8 * q) = (f32x4){TH[kb][vb][4 * q], TH[kb][vb][4 * q + 1], TH[kb][vb][4 * q + 2], TH[kb][vb][4 * q + 3]};
                }
            }
    }
}
__device__ __forceinline__ void rwkv_combine(const Params& p, int sid, LAS unsigned char* lds, int wave, int lane) {
    float* gh0 = (float*)(p.ws + WS_GH) + (size_t)sid * NSEG * 2 * 4096;
    constexpr int SXB = 64 * 65 * 4 + 256, CB0 = 2 * SXB + 256;
    const int tid = wave * 64 + lane;
#define CMB_DMA(i_) do { const float* g_ = gh0 + (size_t)(i_) * 2 * 4096 + tid * 4; LAS unsigned char* b_ = lds + CB0 + ((i_) & 1) * 32768 + wave * 1024; \
        _Pragma("unroll") for (int j_ = 0; j_ < 4; ++j_) __builtin_amdgcn_global_load_lds((const unsigned*)(g_ + j_ * 2048), (LAS unsigned*)(b_ + j_ * 8192), 16, 0, 0); } while (0)
    CMB_DMA(1);
    { LAS float* Sx = (LAS float*)(lds + SXB);
      for (int e = tid; e < 4096; e += NTHREADS) Sx[(e >> 6) * 65 + (e & 63)] = gh0[4096 + e]; }
    asm volatile("s_waitcnt vmcnt(0)" ::: "memory");
    __syncthreads();
    const int rb = (wave >> 1) & 1, cb = wave & 1, i32 = lane & 31, hf = lane >> 5;
    for (int i = 1; i < NSEG - 1; ++i) {
        float* gi = gh0 + (size_t)i * 2 * 4096;
        if (i + 1 < NSEG - 1) CMB_DMA(i + 1);
        if (wave < 4) {
            const LAS float* Sx = (const LAS float*)(lds + (i & 1) * SXB); LAS float* Sn = (LAS float*)(lds + ((i + 1) & 1) * SXB);
            const LAS float* gb = (const LAS float*)(lds + CB0 + (i & 1) * 32768);
            float bq[32]; f32x16 d;
#pragma unroll
            for (int q = 0; q < 32; ++q) bq[q] = gb[(2 * q + hf) * 64 + 32 * cb + i32];
#pragma unroll
            for (int r = 0; r < 16; ++r) d[r] = gb[4096 + (32 * rb + 8 * (r >> 2) + 4 * hf + (r & 3)) * 64 + 32 * cb + i32];
#pragma unroll
            for (int q = 0; q < 32; ++q) {
                const float aq = Sx[(32 * rb + i32) * 65 + 2 * q + hf];
                d = __builtin_amdgcn_mfma_f32_32x32x2f32(aq, bq[q], d, 0, 0, 0);
            }
#pragma unroll
            for (int r = 0; r < 16; ++r) Sn[(32 * rb + 8 * (r >> 2) + 4 * hf + (r & 3)) * 65 + 32 * cb + i32] = d[r];
#pragma unroll
            for (int r = 0; r < 16; ++r) gi[4096 + (32 * rb + 8 * (r >> 2) + 4 * hf + (r & 3)) * 64 + 32 * cb + i32] = d[r];
            asm volatile("s_waitcnt vmcnt(16)" ::: "memory");
        } else asm volatile("s_waitcnt vmcnt(0)" ::: "memory");
        __syncthreads();
    }
#undef CMB_DMA
}

__device__ __forceinline__ void postmix_phase(const Params& p, int layer, float lam_init, int M, int gw, int NGW, int lane) {
    const bf16_t* P = (const bf16_t*)(p.ws + WS_P); const float* ST = (const float*)(p.ws + WS_ST);
    bf16_t* YB = (bf16_t*)(p.ws + WS_YB); bf16_t* YC = (bf16_t*)(p.ws + WS_YC);
    const float* lng = p.in[22] + layer * 512; const float* lnb = p.in[23] + layer * 512; const float* sg = p.in[25] + layer * 128;
    for (int m = gw; m < M; m += NGW) {
        {
            const int h = lane >> 3, kidx = (lane & 7) * 8, ch = lane * 8;
            const float* sp = ST + ((size_t)m * 8 + h) * (ST_SLOTS * 64) + kidx;
            float y[8], v[8], g[8], lg[8], lb[8];
            { float yb_[8]; ld8f(sp + SL_W0 * 64, y); ld8f(sp + SL_W1 * 64, yb_);
#pragma unroll
              for (int q = 0; q < 8; ++q) y[q] += yb_[q]; }
            ld8f(sp + SL_V * 64, v); ld8f(lng + ch, lg); ld8f(lnb + ch, lb);
            ld8bf(P + (size_t)m * PP + IC_RW + ch, g);
            float s = 0.f;
#pragma unroll
            for (int q = 0; q < 8; ++q) s += y[q];
            s += __shfl_xor(s, 1); s += __shfl_xor(s, 2); s += __shfl_xor(s, 4);
            float bn;
            { const f32x4 b0 = *(const f32x4*)(sp - kidx + SL_A0 * 64 + (lane & 7) * 4), b1 = *(const f32x4*)(sp - kidx + SL_A1 * 64 + (lane & 7) * 4);
              bn = ((b0.x + b0.y) + (b0.z + b0.w)) + ((b1.x + b1.y) + (b1.z + b1.w));
              bn += __shfl_xor(bn, 1); bn += __shfl_xor(bn, 2); bn += __shfl_xor(bn, 4); }
            const float mu = s * (1.0f / 64.0f);
            float var = 0.f;
#pragma unroll
            for (int q = 0; q < 8; ++q) { const float d = y[q] - mu; var += d * d; }
            var += __shfl_xor(var, 1); var += __shfl_xor(var, 2); var += __shfl_xor(var, 4);
            const float rstd = 1.0f / sqrtf(var * (1.0f / 64.0f) + 64e-5f);
            float o[8];
#pragma unroll
            for (int q = 0; q < 8; ++q) o[q] = (((y[q] - mu) * rstd) * lg[q] + lb[q] + bn * v[q]) * g[q];
            u32x4 w; w.x = pk2(o[0], o[1]); w.y = pk2(o[2], o[3]); w.z = pk2(o[4], o[5]); w.w = pk2(o[6], o[7]);
            *(u32x4*)(YB + (size_t)m * 512 + ch) = w;
        }
        *(u32x4*)((bf16_t*)(p.ws + WS_YA) + (size_t)m * 512 + lane * 8) = *(const u32x4*)(P + (size_t)m * PP + IC_QS + lane * 8);
        {
            const int e = (lane & 15) * 8;
            float x[8], gg[8];
            ld8bf(P + (size_t)m * PP + IC_QD + lane * 8, x); ld8f(sg + e, gg);
            float ss = 0.f;
#pragma unroll
            for (int q = 0; q < 8; ++q) ss += x[q] * x[q];
            ss += __shfl_xor(ss, 1); ss += __shfl_xor(ss, 2); ss += __shfl_xor(ss, 4); ss += __shfl_xor(ss, 8);
            const float rstd = (1.0f - lam_init) / sqrtf(ss * (1.0f / 128.0f) + 1e-5f);
            float o[8];
#pragma unroll
            for (int q = 0; q < 8; ++q) o[q] = x[q] * rstd * gg[q];
            u32x4 w; w.x = pk2(o[0], o[1]); w.y = pk2(o[2], o[3]); w.z = pk2(o[4], o[5]); w.w = pk2(o[6], o[7]);
            *(u32x4*)(YC + (size_t)m * 512 + lane * 8) = w;
        }
    }
}
#define XB_TMO      128
#define XB_XCNT(j)  (256  + 64 * (j))
#define XB_XSUB(j)  (1280 + 64 * (j))
#define XB_XGEN(j)  (2304 + 64 * (j))
#define XB_TOP      3328
#define XB_TOPGEN   3392
#define XCD_BAR_WORDS 3456
#define XB_SPIN_CAP (1u << 18)

__device__ __forceinline__ unsigned xb_ld(unsigned* p)              { return __hip_atomic_load(p, __ATOMIC_RELAXED, __HIP_MEMORY_SCOPE_AGENT); }
__device__ __forceinline__ unsigned xb_add(unsigned* p, unsigned v) { return __hip_atomic_fetch_add(p, v, __ATOMIC_RELAXED, __HIP_MEMORY_SCOPE_AGENT); }
__device__ __forceinline__ unsigned xb_xcc_id() { return (unsigned)__builtin_amdgcn_s_getreg((3 << 11) | 20) & 0xFu; }
#define XB_SPIN(cond, bar) do { unsigned _sp = 0; while (cond) { __builtin_amdgcn_s_sleep(1); \
    if ((++_sp & 255u) == 0u) { if (xb_ld(&(bar)[XB_TMO])) break; if (_sp > XB_SPIN_CAP) { atomicAdd(&(bar)[XB_TMO], 1u); break; } } } } while (0)

struct XcdBarrier {
    unsigned* bar; unsigned x;
    volatile LAS unsigned* st;
};

__device__ __forceinline__ XcdBarrier xcd_barrier_post(unsigned* bar, volatile LAS unsigned* st) {
    XcdBarrier b; b.bar = bar; b.x = xb_xcc_id(); b.st = st;
    if (threadIdx.x == 0) (void)xb_add(&bar[XB_XCNT(b.x)], 1u);
    return b;
}
__device__ __forceinline__ void xcd_barrier_complete(unsigned* bar, unsigned x, unsigned& nloc, unsigned& nx) {
    const unsigned G = gridDim.x * gridDim.y * gridDim.z;
    unsigned sum, cnt, mine, sp = 0u;
    for (;;) {
        sum = 0u; cnt = 0u; mine = 0u;
#pragma unroll
        for (unsigned j = 0; j < 16; ++j) { const unsigned c = xb_ld(&bar[XB_XCNT(j)]); sum += c; cnt += (c > 0u) ? 1u : 0u; mine = (j == x) ? c : mine; }
        if (sum == G) break;
        __builtin_amdgcn_s_sleep(1);
        if ((++sp & 255u) == 0u) { if (xb_ld(&bar[XB_TMO])) break; if (sp > XB_SPIN_CAP) { atomicAdd(&bar[XB_TMO], 1u); break; } }
    }
    nloc = mine > 0u ? mine : 1u; nx = cnt > 0u ? cnt : 1u;
}

__device__ __forceinline__ void xcd_barrier(const XcdBarrier& b) {
    asm volatile("s_waitcnt vmcnt(0)" ::: "memory");
    __syncthreads();
    if (threadIdx.x == 0) {
        unsigned* bar = b.bar;
        __builtin_amdgcn_s_waitcnt(0);
        unsigned nloc = b.st[0], nx = b.st[1];
        if (nloc == 0u) { xcd_barrier_complete(bar, b.x, nloc, nx); b.st[0] = nloc; b.st[1] = nx; }
        const unsigned old = xb_add(&bar[XB_XSUB(b.x)], 1u);
        const unsigned gen = old / nloc;
        if (old + 1u == (gen + 1u) * nloc) {
            __builtin_amdgcn_fence(__ATOMIC_RELEASE, "agent");
            asm volatile("s_waitcnt vmcnt(0)" ::: "memory");
            const unsigned og = xb_add(&bar[XB_TOP], 1u);
            const unsigned tg = og / nx;
            if (og + 1u == (tg + 1u) * nx) xb_add(&bar[XB_TOPGEN], 1u);
            else XB_SPIN(xb_ld(&bar[XB_TOPGEN]) == tg, bar);
            __builtin_amdgcn_fence(__ATOMIC_ACQUIRE, "agent");
            xb_add(&bar[XB_XGEN(b.x)], 1u);
            asm volatile("s_waitcnt vmcnt(0)" ::: "memory");
        } else {
            XB_SPIN(xb_ld(&bar[XB_XGEN(b.x)]) == gen, bar);
            __builtin_amdgcn_fence(__ATOMIC_ACQUIRE, "agent");
            asm volatile("s_waitcnt vmcnt(0)" ::: "memory");
        }
    }
    __syncthreads();
}

#ifndef MK_MULTI
#define MK_MULTI 0
#endif
constexpr int N_PHASES = 40;

#ifndef PROBE_MASK
#define PROBE_MASK 0ull
#endif
#ifndef PROBE_MASK2
#define PROBE_MASK2 0ull
#endif
#define PROBE_MULT 4ull
constexpr int LDS_PARAMS = LDS_BYTES - 1024;
constexpr int LDS_XB = LDS_BYTES - 64;
constexpr int CW_BAR = 8192;
__device__ __forceinline__ unsigned long long uni64(unsigned long long v) {
    const unsigned lo = __builtin_amdgcn_readfirstlane((unsigned)v), hi = __builtin_amdgcn_readfirstlane((unsigned)(v >> 32));
    return ((unsigned long long)hi << 32) | lo;
}
__device__ __forceinline__ int opq(int v) { asm volatile("" : "+s"(v)); return v; }
__device__ __forceinline__ void load_params(LAS unsigned char* lds, Params& q) {
    LAS const unsigned long long* s = (LAS const unsigned long long*)(lds + LDS_PARAMS);
#pragma unroll
    for (int i = 0; i < 37; ++i) q.in[i] = (const float*)(const __attribute__((address_space(1))) float*)uni64(s[i]);
    q.out = (float*)(__attribute__((address_space(1))) float*)uni64(s[37]); q.ws = (unsigned char*)(__attribute__((address_space(1))) unsigned char*)uni64(s[38]); q.ph_lo = 0; q.ph_hi = 0;
}
__global__ void __launch_bounds__(NTHREADS, 2) mk_fwd(Params kp) {
    extern __shared__ __attribute__((aligned(16))) unsigned char lds_raw[];
    LAS unsigned char* lds = (LAS unsigned char*)lds_raw;
    cg::grid_group grid = cg::this_grid();
    if (threadIdx.x == 0) {
        LAS unsigned long long* s = (LAS unsigned long long*)(lds + LDS_PARAMS);
#pragma unroll
        for (int i = 0; i < 37; ++i) s[i] = (unsigned long long)kp.in[i];
        s[37] = (unsigned long long)kp.out; s[38] = (unsigned long long)kp.ws;
    }
    if (threadIdx.x < 2) ((LAS unsigned*)(lds + LDS_XB))[threadIdx.x] = 0u;
    __syncthreads();
#if !MK_MULTI
    (void)xcd_barrier_post((unsigned*)(kp.ws + WS_CTL) + CW_BAR, (volatile LAS unsigned*)(lds + LDS_XB));
#endif
    const int ph_lo = kp.ph_lo, ph_hi = kp.ph_hi;
    int ph = 0;
    if ((PROBE_MASK | PROBE_MASK2) != 0ull && threadIdx.x == 0) { LAS unsigned long long* pt_ = (LAS unsigned long long*)(lds + LDS_PARAMS + 320); pt_[0] = __builtin_amdgcn_s_memrealtime(); pt_[1] = 0ull; }
#define PH_BEGIN if (ph >= ph_lo && ph < ph_hi) { asm volatile("" ::: "memory"); Params p; load_params(lds, p); unsigned char* ws = p.ws; (void)ws; \
    int tid_ = threadIdx.x, bid_ = blockIdx.x, G_ = gridDim.x; asm volatile("" : "+v"(tid_), "+s"(bid_), "+s"(G_)); \
    const int tid = tid_, bid = bid_, G = G_, lane = tid & 63, wave = __builtin_amdgcn_readfirstlane(tid >> 6); const int gw = bid * NWAVES + wave, NGW = G * NWAVES; (void)gw; (void)NGW; (void)lane; (void)tid; (void)G; (void)bid;
#define GRID_SEAM() do { { XcdBarrier xb_; xb_.bar = (unsigned*)((unsigned char*)(__attribute__((address_space(1))) unsigned char*)uni64(((LAS const unsigned long long*)(lds + LDS_PARAMS))[38]) + WS_CTL) + CW_BAR; \
        xb_.x = xb_xcc_id(); xb_.st = (volatile LAS unsigned*)(lds + LDS_XB); xcd_barrier(xb_); } } while (0)
#define PROBE_TICK() do { if ((PROBE_MASK | PROBE_MASK2) != 0ull && blockIdx.x == 0 && threadIdx.x == 0) { LAS unsigned long long* pt_ = (LAS unsigned long long*)(lds + LDS_PARAMS + 320); \
        const unsigned long long now_ = __builtin_amdgcn_s_memrealtime(); if ((PROBE_MASK >> ph) & 1ull) pt_[1] += now_ - pt_[0]; pt_[0] = now_; } } while (0)
#define PROBE_MID() do { if ((PROBE_MASK | PROBE_MASK2) != 0ull && blockIdx.x == 0 && threadIdx.x == 0) { LAS unsigned long long* pt_ = (LAS unsigned long long*)(lds + LDS_PARAMS + 320); \
        const unsigned long long now_ = __builtin_amdgcn_s_memrealtime(); if ((PROBE_MASK2 >> ph) & 1ull) pt_[1] += now_ - pt_[0]; pt_[0] = now_; } } while (0)
#define PH_END } if (ph >= ph_lo && ph + 1 < ph_hi) GRID_SEAM(); PROBE_TICK(); ++ph;

    using pg8::Gemm; using pg8::StaticOrder; using pg8::gemm_phase;

    PH_BEGIN
        convert_layer_weights(p, 0, lds, gw, NGW, wave, lane);
        __syncthreads();
        adaln_phase(p, lds, wave, lane);
    PH_END
    PH_BEGIN
        premix_phase(p, 0, true, NTOK, gw, NGW, lane);
    PH_END

#pragma clang loop unroll(full)
    for (int layer = 0; layer < 2; ++layer) {
        const int Ml = layer == 0 ? NTOK : NLAT;
        const float lam_init = 0.8f - 0.6f * expf(-0.3f * (float)layer);
        PH_BEGIN
            Gemm g{(const bf16_t*)(ws + WS_XN), (const bf16_t*)(ws + WS_WIN), NTOK, NIN1, opq(1024), 1024}; StaticOrder S; S.init(NTOK, NIN1, G, bid);
            EpiIn E{(bf16_t*)(ws + WS_P), (bf16_t*)(ws + WS_VTS), (bf16_t*)(ws + WS_VTD), (const float*)(ws + WS_ROPE)};
            gemm_phase<EpiIn, StaticOrder, true, true>(lds, g, S, E);
        PH_END
        PH_BEGIN
            rwkv_prepare_phase(p, layer, gw, NGW, lane);
        PH_END
        PH_BEGIN
            Gemm g{(const bf16_t*)(ws + WS_YA), (const bf16_t*)(ws + WS_LORA), NTOK, 2560, opq(128), 384}; LoraSched S; S.S.init(NTOK, 2560, G, bid);
            EpiLora E{(float*)(ws + WS_ST), (bf16_t*)(ws + WS_P), p.in[14] + layer * 1024, p.in[16] + layer * 1024};
            gemm_phase<EpiLora, LoraSched, true, true>(lds, g, S, E);
        PH_END
        PH_BEGIN
            for (int u = gw; u < 32 * (NSEG - 1); u += NGW) rwkv_segment<0>(p, layer, u / (NSEG - 1), u % (NSEG - 1), lane, lds + wave * SCAN_LDS);
        PH_END
        PH_BEGIN
            unsigned* qhead = (unsigned*)(ws + WS_CTL) + (layer == 0 ? CW_Q0 : CW_Q1);
            LAS int* ubox = (LAS int*)(lds + 131072);
            const int n_swa = 512 + (layer == 0 ? 16 + 8 : 0);
            if (bid < 32) rwkv_combine(p, bid, lds, wave, lane);
            if (bid >= 32 || G <= 32)
            for (;;) {
                if (tid == 0) ubox[0] = (int)atomicAdd(qhead, 1u);
                __syncthreads();
                const int u = ubox[0];
                __syncthreads();
                if (u >= n_swa) break;
                if (u < 512) swa_unit(lds, p, layer, u >> 8, (u >> 5) & 7, u & 31, false, wave, lane);
                else if (u < 528) { const int v = u - 512; swa_unit(lds, p, layer, v >> 3, v & 7, 0, true, wave, lane); }
                else { const int v = u - 528; float lamq; { const float* lv = p.in[24] + layer * 256; const float s1 = wave_sum(lv[lane] * lv[64 + lane]), s2 = wave_sum(lv[128 + lane] * lv[192 + lane]); lamq = expf(s1) - expf(s2) + lam_init; }
                       diff_unit(lds, p, lamq, v >> 2, v & 3, 0, true, (4 * v) * NSEG + NSEG - 1, NSEG, wave, lane); }
            }
        PH_END
        PH_BEGIN
            for (int u = gw; u < 32 * NSEG; u += NGW) rwkv_segment<2>(p, layer, u / NSEG, u % NSEG, lane, lds + wave * SCAN_LDS);
            asm volatile("s_waitcnt vmcnt(0)" ::: "memory");
            __syncthreads();
            PROBE_MID();
            float lam;
            { const float* lv = p.in[24] + layer * 256;
              const float s1 = wave_sum(lv[lane] * lv[64 + lane]), s2 = wave_sum(lv[128 + lane] * lv[192 + lane]);
              lam = expf(s1) - expf(s2) + lam_init; }
            for (int u = bid; u < 256; u += G) { const int v = G == 256 ? ((((u & 7) >> 2) << 7) | ((u & 3) << 5) | (u >> 3)) : u; diff_unit(lds, p, lam, v >> 7, (v >> 5) & 3, v & 31, false, 4 * v, 1, wave, lane); }
        PH_END
        PH_BEGIN
            postmix_phase(p, layer, lam_init, Ml, gw, NGW, lane);
            if (layer == 0) convert_ffn_weights(p, lds, gw, NGW, wave, lane);
            __syncthreads();
            Gemm g{(const bf16_t*)(ws + WS_XN), (const bf16_t*)(ws + WS_WIN) + (size_t)NIN1 * 1024, Ml, 3072, opq(1024), 1024}; StaticOrder S; S.init(Ml, 3072, G, bid);
            EpiGate E{(bf16_t*)(ws + WS_G), Ml / 256, G};
            gemm_phase<EpiGate, StaticOrder, true, true>(lds, g, S, E);
        PH_END
        PH_BEGIN
            MergeSched S; S.S.init(Ml, 1024, G, bid); S.nMtot = NTOK / 256;
            Gemm g{(const bf16_t*)(ws + WS_YA), (const bf16_t*)(ws + WS_PRJ), Ml, 1024, opq(512), 512};
            EpiMergeF E{(const bf16_t*)(ws + WS_G), (bf16_t*)(ws + WS_MF), (bf16_t*)(ws + WS_MB), NTOK / 256, Ml / 256, G};
            gemm_phase<EpiMergeF, MergeSched, true, true>(lds, g, S, E);
        PH_END
        PH_BEGIN
            Gemm g{(const bf16_t*)(ws + WS_MB), (const bf16_t*)(ws + WS_WOUT), Ml, 1024, opq(1024), 1024};
            if (layer == 0) {
                TailSched S; S.init(NLAT, 1024, G, bid, (NTOK - NLAT) / 256, 2, 8);
                EpiBfTail E{(bf16_t*)(ws + WS_MOUT), 1024, (float*)(ws + WS_P), NLAT, NTOK - NLAT};
                gemm_phase<EpiBfTail, TailSched, true, true>(lds, g, S, E);
            } else {
                StaticOrder S; S.init(Ml, 1024, G, bid);
                EpiBf E{(bf16_t*)(ws + WS_MOUT), 1024};
                gemm_phase<EpiBf, StaticOrder, true, true>(lds, g, S, E);
            }
        PH_END
        PH_BEGIN
            residual_phase(p, (const bf16_t*)(ws + WS_MOUT), nullptr, nullptr, layer == 0, layer, 2, p.in[7] + layer * 1024, true, p.in[8] + layer * 1024, layer, 3, layer == 1, Ml, gw, NGW, lane, lds, layer == 0 ? (const float*)(ws + WS_P) : nullptr, 8);
            __syncthreads();
            if (layer == 0) convert_layer_weights(p, 1, lds, gw, NGW, wave, lane);
            else convert_moe_weights(p, lds, gw, NGW, wave, lane);
        PH_END
        if (layer == 0) {
            PH_BEGIN
                Gemm g{(const bf16_t*)(ws + WS_XN), (const bf16_t*)(ws + WS_FGU), NTOK, 2 * D_FF, opq(1024), 1024}; StaticOrder S; S.init(NTOK, 2 * D_FF, G, bid);
                EpiSwiglu E{(bf16_t*)(ws + WS_HID), D_FF, 1 << 20, 0};
                gemm_phase<EpiSwiglu, StaticOrder, true, true>(lds, g, S, E);
            PH_END
            PH_BEGIN
                Gemm g{(const bf16_t*)(ws + WS_HID), (const bf16_t*)(ws + WS_FD), NTOK, 1024, opq(D_FF), D_FF};
                TailSched S; S.init(NLAT, 1024, G, bid, (NTOK - NLAT) / 256, 4, D_FF / 256);
                EpiBfTail E{(bf16_t*)(ws + WS_MF), 1024, (float*)(ws + WS_P + 92 * MiB), NLAT, NTOK - NLAT};
                gemm_phase<EpiBfTail, TailSched, true, true>(lds, g, S, E);
            PH_END
            PH_BEGIN
                residual_phase(p, (const bf16_t*)(ws + WS_MF), nullptr, nullptr, false, 0, 5, p.in[9], true, p.in[6] + 1024, 1, 0, false, NTOK, gw, NGW, lane, nullptr, (const float*)(ws + WS_P + 92 * MiB), D_FF / 256);
            PH_END
        }
    }
    {
        {
            PH_BEGIN
                const unsigned* cnt = (const unsigned*)(ws + WS_CTL) + CW_CNT; int ts[9]; ts[0] = 0;
#pragma unroll
                for (int e = 0; e < 8; ++e) ts[e + 1] = ts[e] + (int)((__hip_atomic_load(cnt + e, __ATOMIC_RELAXED, __HIP_MEMORY_SCOPE_AGENT) + 255u) >> 8);
                const int* LIST = (const int*)(ws + WS_LIST); const bf16_t* XN = (const bf16_t*)(ws + WS_XN2); bf16_t* XG = (bf16_t*)(ws + WS_XG);
                for (int r = gw; r < ts[8] * 256; r += NGW) {
                    const int tile = r >> 8; int e = 0;
#pragma unroll
                    for (int q = 1; q < 8; ++q) e += (tile >= ts[q]) ? 1 : 0;
                    int tse = 0;
#pragma unroll
                    for (int q = 0; q < 8; ++q) tse = (q == e) ? ts[q] : tse;
                    const int slot = r - tse * 256;
                    u32x4 v0 = (u32x4){0u, 0u, 0u, 0u}, v1 = v0;
                    if (slot < (int)cnt[e]) { const int tk = LIST[e * 16384 + slot]; const u32x4* src = (const u32x4*)(XN + (size_t)(tk >> 1) * 1024); v0 = src[lane]; v1 = src[lane + 64]; }
                    u32x4* dst = (u32x4*)(XG + (size_t)r * 1024); dst[lane] = v0; dst[lane + 64] = v1;
                }
            PH_END
            PH_BEGIN
                const unsigned* cnt = (const unsigned*)(ws + WS_CTL) + CW_CNT; int ts[9]; ts[0] = 0;
#pragma unroll
                for (int e = 0; e < 8; ++e) ts[e + 1] = ts[e] + (int)((__hip_atomic_load(cnt + e, __ATOMIC_RELAXED, __HIP_MEMORY_SCOPE_AGENT) + 255u) >> 8);
                MoeSched S;
#pragma unroll
                for (int e = 0; e < 9; ++e) S.ts[e] = ts[e];
                S.pm_lo = 0; S.pm_hi = ts[8]; S.npn = 28; S.G = G; S.c = bid; S.a_local = false;
                Gemm g{(const bf16_t*)(ws + WS_XG), (const bf16_t*)(ws + WS_MGU), 0, 0, opq(1024), 1024};
                EpiSwiglu E{(bf16_t*)(ws + WS_HIDM), D_FFE, 28, 0};
                gemm_phase<EpiSwiglu, MoeSched, true, true>(lds, g, S, E);
            PH_END
            PH_BEGIN
                const unsigned* cnt = (const unsigned*)(ws + WS_CTL) + CW_CNT; int ts[9]; ts[0] = 0;
#pragma unroll
                for (int e = 0; e < 8; ++e) ts[e + 1] = ts[e] + (int)((__hip_atomic_load(cnt + e, __ATOMIC_RELAXED, __HIP_MEMORY_SCOPE_AGENT) + 255u) >> 8);
                MoeSched S;
#pragma unroll
                for (int e = 0; e < 9; ++e) S.ts[e] = ts[e];
                S.pm_lo = 0; S.pm_hi = ts[8]; S.npn = 4; S.G = G; S.c = bid; S.a_local = false;
                Gemm g{(const bf16_t*)(ws + WS_HIDM), (const bf16_t*)(ws + WS_MD), 0, 0, opq(D_FFE), D_FFE};
                EpiMoeDown E; E.FS = (bf16_t*)(ws + WS_FACC); E.slot1_off = ((long)WS_MGU - (long)WS_FACC) / 2; E.LIST = (const int*)(ws + WS_LIST); E.WTS = (const float*)(ws + WS_WTS); E.cnt = cnt; E.pm_lo = 0;
#pragma unroll
                for (int e = 0; e < 9; ++e) E.ts[e] = ts[e];
                gemm_phase<EpiMoeDown, MoeSched, true, true>(lds, g, S, E);
            PH_END
            PH_BEGIN
                residual_phase(p, (const bf16_t*)(ws + WS_FACC), (const bf16_t*)(ws + WS_MGU), nullptr, false, 1, 5, p.in[9] + 1024, false, nullptr, 0, 0, false, NLAT, gw, NGW, lane);
            PH_END
        }
    }
    if ((PROBE_MASK | PROBE_MASK2) != 0ull && blockIdx.x == 0 && threadIdx.x == 0) {
        LAS unsigned long long* pt_ = (LAS unsigned long long*)(lds + LDS_PARAMS + 320);
        const unsigned long long t0_ = pt_[0], want_ = PROBE_MULT * pt_[1];
        while (__builtin_amdgcn_s_memrealtime() - t0_ < want_) __builtin_amdgcn_s_sleep(32);
    }
#undef PH_BEGIN
#undef PH_END
}

extern "C" void kernel_launch(void* const* d_in, const int* in_sizes, int n_in, void* d_out, int out_size, void* d_ws, size_t ws_size, hipStream_t stream) {
    static int grid = 0;
    if (grid == 0) {
        if (n_in != 37 || out_size != NLAT * DM || ws_size < WS_NEED) { fprintf(stderr, "kernel_launch: unexpected shapes (n_in %d out %d ws %zu need %zu)\n", n_in, out_size, ws_size, (size_t)WS_NEED); grid = -1; return; }
        int dev = 0, cus = 0, per_cu = 0;
        (void)hipGetDevice(&dev);
        (void)hipDeviceGetAttribute(&cus, hipDeviceAttributeMultiprocessorCount, dev);
        (void)hipFuncSetAttribute((const void*)mk_fwd, hipFuncAttributeMaxDynamicSharedMemorySize, LDS_BYTES);
        (void)hipOccupancyMaxActiveBlocksPerMultiprocessor(&per_cu, (const void*)mk_fwd, NTHREADS, LDS_BYTES);
        if (per_cu < 1) { fprintf(stderr, "kernel_launch: occupancy query reports %d blocks per CU\n", per_cu); grid = -1; return; }
        grid = cus;
        fprintf(stderr, "kernel_launch: grid %d (cus %d, per_cu %d), ws %zu\n", grid, cus, per_cu, ws_size);
    }
    if (grid < 0) return;
    (void)hipMemsetAsync((char*)d_ws + WS_CTL, 0, CTL_BYTES, stream);
    Params prm{};
    for (int i = 0; i < 37; ++i) prm.in[i] = (const float*)d_in[i];
    prm.out = (float*)d_out; prm.ws = (unsigned char*)d_ws;
#if MK_MULTI
    for (int ph = 0; ph < N_PHASES; ++ph) { prm.ph_lo = ph; prm.ph_hi = ph + 1; hipLaunchKernelGGL(mk_fwd, dim3(grid), dim3(NTHREADS), LDS_BYTES, stream, prm); }
#else
    prm.ph_lo = 0; prm.ph_hi = 1 << 20;
    void* args[] = {&prm};
    hipError_t e = hipLaunchCooperativeKernel((const void*)mk_fwd, dim3(grid), dim3(NTHREADS), args, LDS_BYTES, stream);
    if (e != hipSuccess) fprintf(stderr, "kernel_launch: cooperative launch failed: %s (grid %d)\n", hipGetErrorString(e), grid);
#endif
}
```
